# Optimizing an MI355X kernel written in HIP

```python
import math
import jax, jax.numpy as jnp
from jax import lax
import numpy as np

D_MODEL = 1024
BATCH = 8
SEQ = 2048
DEPTH = 1

ROPE_THETA = 500000.0
EPS = 1e-6
Q_BLOCK = 128
NEG = -1e30

MLA_HEADS = 8
MLA_NOPE = 64
MLA_ROPE = 32
MLA_QK = MLA_NOPE + MLA_ROPE
MLA_V = 64
MLA_Q_LORA = 768
MLA_KV_LORA = 256

NSA_HEADS = 8
NSA_KV_GROUPS = 2
NSA_REP = NSA_HEADS // NSA_KV_GROUPS
NSA_HEAD = 64
NSA_ROT = NSA_HEAD // 4
CMP_LEN = 32
CMP_STRIDE = 16
CMP_HIDDEN = 256
SEL_LEN = 64
SEL_TOP = 8
SEL_Q_BLOCK = 64
WINDOW = 256
N_NSA_BRANCH = 3
FORCE_BONUS = 1e4
KV_W = NSA_KV_GROUPS * NSA_HEAD

N_BRANCH = 2
D_FF = -(-8 * D_MODEL // (3 * 256)) * 256
N_MOD = 6

IN_SIZES = (MLA_Q_LORA, MLA_KV_LORA, MLA_ROPE, NSA_HEADS * NSA_HEAD,
            KV_W, KV_W, KV_W, KV_W, KV_W, KV_W,
            NSA_HEADS * N_NSA_BRANCH, D_MODEL, D_MODEL)
D_IN = sum(IN_SIZES)

kernel_name = "hybrid_mla_nsa_adaln_block"


def rms_norm(x, gain):
    xf = x.astype(jnp.float32)
    y = xf * lax.rsqrt(jnp.mean(xf * xf, axis=-1, keepdims=True) + EPS)
    return (y * gain.astype(jnp.float32)).astype(x.dtype)


def rope_angles(pos, dim):
    inv = ROPE_THETA ** (-jnp.arange(0, dim, 2, dtype=jnp.float32) / dim)
    ang = pos.astype(jnp.float32)[..., None] * inv
    return jnp.cos(ang), jnp.sin(ang)


def apply_rope(x, cos, sin):
    x1, x2 = jnp.split(x, 2, axis=-1)
    cos = cos.astype(x.dtype)
    sin = sin.astype(x.dtype)
    return jnp.concatenate([x1 * cos - x2 * sin, x2 * cos + x1 * sin], axis=-1)


def partial_rope(x, cos, sin):
    return jnp.concatenate([apply_rope(x[..., :NSA_ROT], cos, sin), x[..., NSA_ROT:]], axis=-1)


def causal_block_attention(q, k, v, scale):
    B, S, H, Dk = q.shape
    nb = S // Q_BLOCK
    qb = q.reshape(B, nb, Q_BLOCK, H, Dk).transpose(1, 0, 2, 3, 4)
    kpos = jnp.arange(S)

    def one(args):
        qi, i = args
        s = jnp.einsum('bqhd,bkhd->bhqk', qi, k).astype(jnp.float32) * scale
        qpos = i * Q_BLOCK + jnp.arange(Q_BLOCK)
        s = jnp.where(kpos[None, :] <= qpos[:, None], s, NEG)
        p = jax.nn.softmax(s, axis=-1).astype(v.dtype)
        return jnp.einsum('bhqk,bkhd->bqhd', p, v)

    o = lax.map(one, (qb, jnp.arange(nb)))
    return o.transpose(1, 0, 2, 3, 4).reshape(B, S, H, v.shape[-1])


def mla_attention(c_q, c_kv, k_pe, cos, sin, q_a_gain, w_q_b, kv_a_gain, w_kv_b, q_gain, k_gain):
    B, S, _ = c_q.shape
    q = (rms_norm(c_q, q_a_gain) @ w_q_b).reshape(B, S, MLA_HEADS, MLA_QK)
    kv = (rms_norm(c_kv, kv_a_gain) @ w_kv_b).reshape(B, S, MLA_HEADS, MLA_NOPE + MLA_V)
    k_nope, v = kv[..., :MLA_NOPE], kv[..., MLA_NOPE:]
    k = jnp.concatenate([k_nope, jnp.broadcast_to(k_pe[:, :, None, :], (B, S, MLA_HEADS, MLA_ROPE))], axis=-1)
    q = rms_norm(q, q_gain)
    k = rms_norm(k, k_gain)
    cos_h, sin_h = cos[:, :, None], sin[:, :, None]
    q = jnp.concatenate([q[..., :MLA_NOPE], apply_rope(q[..., MLA_NOPE:], cos_h, sin_h)], axis=-1)
    k = jnp.concatenate([k[..., :MLA_NOPE], apply_rope(k[..., MLA_NOPE:], cos_h, sin_h)], axis=-1)
    o = causal_block_attention(q, k, v, MLA_QK ** -0.5)
    return o.reshape(B, S, MLA_HEADS * MLA_V)


def nsa_attention(q, k_c, v_c, k_s, v_s, k_w, v_w, g_logit, cos, sin,
                  q_gain, kc_gain, ks_gain, kw_gain,
                  cmp_pos_k, cmp_w1_k, cmp_w2_k, cmp_pos_v, cmp_w1_v, cmp_w2_v):
    B, S, H, Dh = q.shape
    G, R = NSA_KV_GROUPS, NSA_REP
    f32 = jnp.float32
    scale = Dh ** -0.5
    cos_t, sin_t = cos[:, :, None], sin[:, :, None]
    q = partial_rope(rms_norm(q, q_gain), cos_t, sin_t)
    qg = q.reshape(B, S, G, R, Dh)
    t_idx = jnp.arange(S)

    n_cmp = (S - CMP_LEN) // CMP_STRIDE + 1
    starts = jnp.arange(n_cmp) * CMP_STRIDE
    blk_idx = starts[:, None] + jnp.arange(CMP_LEN)[None, :]

    def compress(t, pos_emb, w1, w2):
        blocks = t[:, blk_idx] + pos_emb[None, None, :, None, :]
        flat = blocks.transpose(0, 1, 3, 2, 4).reshape(B, n_cmp, G, CMP_LEN * Dh)
        return jax.nn.silu(flat @ w1) @ w2

    cmp_end = starts + CMP_LEN - 1
    kc = compress(k_c, cmp_pos_k, cmp_w1_k, cmp_w2_k)
    vc = compress(v_c, cmp_pos_v, cmp_w1_v, cmp_w2_v)
    kc = partial_rope(rms_norm(kc, kc_gain), cos[:, cmp_end][:, :, None], sin[:, cmp_end][:, :, None])
    s_c = jnp.einsum('bsgrd,bngd->bgrsn', qg, kc).astype(f32) * scale
    valid_c = cmp_end[None, :] <= t_idx[:, None]
    p_c = jax.nn.softmax(jnp.where(valid_c, s_c, NEG), axis=-1) * valid_c
    o_c = jnp.einsum('bgrsn,bngd->bsgrd', p_c.astype(vc.dtype), vc)

    n_sel = S // SEL_LEN
    sel_start = jnp.arange(n_sel) * SEL_LEN
    overlap = ((starts[:, None] < sel_start[None, :] + SEL_LEN) &
               (starts[:, None] + CMP_LEN > sel_start[None, :])).astype(f32)
    imp = jnp.einsum('bgrsn,nj->bgsj', p_c, overlap)
    cur = t_idx // SEL_LEN
    j = jnp.arange(n_sel)
    forced = (j[None, :] == 0) | (j[None, :] == cur[:, None]) | (j[None, :] == cur[:, None] - 1)
    imp = jnp.where(forced, imp + FORCE_BONUS, imp)
    imp = jnp.where(j[None, :] <= cur[:, None], imp, NEG)
    top = min(SEL_TOP, n_sel)
    _, sel_idx = lax.top_k(imp, top)

    ks = partial_rope(rms_norm(k_s, ks_gain), cos_t, sin_t)
    k_blocks = ks.reshape(B, n_sel, SEL_LEN, G, Dh).transpose(0, 3, 1, 2, 4)
    v_blocks = v_s.reshape(B, n_sel, SEL_LEN, G, Dh).transpose(0, 3, 1, 2, 4)
    nqb = S // SEL_Q_BLOCK
    q_chunks = qg.reshape(B, nqb, SEL_Q_BLOCK, G, R, Dh).transpose(1, 0, 2, 3, 4, 5)
    idx_chunks = sel_idx.reshape(B, G, nqb, SEL_Q_BLOCK, top).transpose(2, 0, 1, 3, 4)
    gather = jax.vmap(jax.vmap(lambda blk, ix: blk[ix]))

    def sel_chunk(args):
        qi, ix, ci = args
        kg = gather(k_blocks, ix)
        vg = gather(v_blocks, ix)
        s = jnp.einsum('bqgrd,bgqnld->bgrqnl', qi, kg).astype(f32) * scale
        tok = ix[..., None] * SEL_LEN + jnp.arange(SEL_LEN)
        qt = ci * SEL_Q_BLOCK + jnp.arange(SEL_Q_BLOCK)
        mask = tok <= qt[None, None, :, None, None]
        s = jnp.where(mask[:, :, None], s, NEG)
        sh = s.shape
        p = jax.nn.softmax(s.reshape(sh[0], sh[1], sh[2], sh[3], -1), axis=-1).reshape(sh)
        return jnp.einsum('bgrqnl,bgqnld->bqgrd', p.astype(vg.dtype), vg)

    o_s = lax.map(sel_chunk, (q_chunks, idx_chunks, jnp.arange(nqb)))
    o_s = o_s.transpose(1, 0, 2, 3, 4, 5).reshape(B, S, G, R, Dh)

    kw = partial_rope(rms_norm(k_w, kw_gain), cos_t, sin_t)
    nqw = S // Q_BLOCK
    span = WINDOW + Q_BLOCK
    kw_pad = jnp.pad(kw, ((0, 0), (WINDOW, 0), (0, 0), (0, 0)))
    vw_pad = jnp.pad(v_w, ((0, 0), (WINDOW, 0), (0, 0), (0, 0)))
    band = jnp.arange(nqw)[:, None] * Q_BLOCK + jnp.arange(span)[None, :]
    kb = kw_pad[:, band]
    vb = vw_pad[:, band]
    qb = qg.reshape(B, nqw, Q_BLOCK, G, R, Dh)
    s_w = jnp.einsum('bcqgrd,bckgd->bcgrqk', qb, kb).astype(f32) * scale
    key_t = band - WINDOW
    q_t = jnp.arange(nqw)[:, None] * Q_BLOCK + jnp.arange(Q_BLOCK)[None, :]
    diff = q_t[:, :, None] - key_t[:, None, :]
    mask_w = (diff >= 0) & (diff < WINDOW) & (key_t[:, None, :] >= 0)
    s_w = jnp.where(mask_w[None, :, None, None], s_w, NEG)
    p_w = jax.nn.softmax(s_w, axis=-1).astype(vb.dtype)
    o_w = jnp.einsum('bcgrqk,bckgd->bcqgrd', p_w, vb).reshape(B, S, G, R, Dh)

    g = jax.nn.sigmoid(g_logit).reshape(B, S, G, R, N_NSA_BRANCH, 1)
    o = g[..., 0, :] * o_c + g[..., 1, :] * o_s + g[..., 2, :] * o_w
    return o.reshape(B, S, H * Dh)


def setup_inputs(seed: int = 0) -> dict:
    key = jax.random.key(seed)

    def nrm(i, shape, scale):
        return jax.random.normal(jax.random.fold_in(key, i), shape, jnp.float32) * scale

    def gain(i, n):
        return 1.0 + nrm(i, (DEPTH, n), 0.02)

    L = DEPTH
    offset = jax.random.randint(jax.random.fold_in(key, 99), (BATCH, 1), 0, 4096)
    positions = (offset + jnp.arange(SEQ)[None, :]).astype(jnp.int32)
    return {
        "x": nrm(0, (BATCH, SEQ, D_MODEL), 1.0),
        "c": nrm(1, (BATCH, D_MODEL), 1.0),
        "positions": positions,
        "ada_w": nrm(2, (L, D_MODEL, N_MOD * D_MODEL), 0.5 * D_MODEL ** -0.5),
        "ada_b": nrm(3, (L, N_MOD * D_MODEL), 0.02),
        "norm1_gain": gain(4, D_MODEL),
        "w_in": nrm(5, (L, D_MODEL, D_IN), D_MODEL ** -0.5),
        "mla_q_a_gain": gain(6, MLA_Q_LORA),
        "mla_w_q_b": nrm(7, (L, MLA_Q_LORA, MLA_HEADS * MLA_QK), MLA_Q_LORA ** -0.5),
        "mla_kv_a_gain": gain(8, MLA_KV_LORA),
        "mla_w_kv_b": nrm(9, (L, MLA_KV_LORA, MLA_HEADS * (MLA_NOPE + MLA_V)), MLA_KV_LORA ** -0.5),
        "mla_q_gain": gain(10, MLA_QK),
        "mla_k_gain": gain(11, MLA_QK),
        "nsa_q_gain": gain(12, NSA_HEAD),
        "nsa_kc_gain": gain(13, NSA_HEAD),
        "nsa_ks_gain": gain(14, NSA_HEAD),
        "nsa_kw_gain": gain(15, NSA_HEAD),
        "cmp_pos_k": nrm(16, (L, CMP_LEN, NSA_HEAD), 0.1),
        "cmp_w1_k": nrm(17, (L, CMP_LEN * NSA_HEAD, CMP_HIDDEN), (CMP_LEN * NSA_HEAD) ** -0.5),
        "cmp_w2_k": nrm(18, (L, CMP_HIDDEN, NSA_HEAD), CMP_HIDDEN ** -0.5),
        "cmp_pos_v": nrm(19, (L, CMP_LEN, NSA_HEAD), 0.1),
        "cmp_w1_v": nrm(20, (L, CMP_LEN * NSA_HEAD, CMP_HIDDEN), (CMP_LEN * NSA_HEAD) ** -0.5),
        "cmp_w2_v": nrm(21, (L, CMP_HIDDEN, NSA_HEAD), CMP_HIDDEN ** -0.5),
        "w_o_mla": nrm(22, (L, MLA_HEADS * MLA_V, D_MODEL), (MLA_HEADS * MLA_V) ** -0.5),
        "w_o_nsa": nrm(23, (L, NSA_HEADS * NSA_HEAD, D_MODEL), (NSA_HEADS * NSA_HEAD) ** -0.5),
        "w_out": nrm(24, (L, D_MODEL, D_MODEL), D_MODEL ** -0.5),
        "norm2_gain": gain(25, D_MODEL),
        "ffn_w_gate": nrm(26, (L, D_MODEL, D_FF), D_MODEL ** -0.5),
        "ffn_w_up": nrm(27, (L, D_MODEL, D_FF), D_MODEL ** -0.5),
        "ffn_w_down": nrm(28, (L, D_FF, D_MODEL), D_FF ** -0.5),
    }


def reference(x, c, positions, ada_w, ada_b, norm1_gain, w_in,
              mla_q_a_gain, mla_w_q_b, mla_kv_a_gain, mla_w_kv_b, mla_q_gain, mla_k_gain,
              nsa_q_gain, nsa_kc_gain, nsa_ks_gain, nsa_kw_gain,
              cmp_pos_k, cmp_w1_k, cmp_w2_k, cmp_pos_v, cmp_w1_v, cmp_w2_v,
              w_o_mla, w_o_nsa, w_out, norm2_gain, ffn_w_gate, ffn_w_up, ffn_w_down):
    B, S, _ = x.shape
    mla_cos, mla_sin = rope_angles(positions, MLA_ROPE)
    nsa_cos, nsa_sin = rope_angles(positions, NSA_ROT)
    split_at = np.cumsum(IN_SIZES)[:-1]
    for l in range(DEPTH):
        mod = jax.nn.silu(c) @ ada_w[l] + ada_b[l]
        sh1, sc1, gt1, sh2, sc2, gt2 = [m[:, None, :] for m in jnp.split(mod, N_MOD, axis=-1)]

        h = rms_norm(x, norm1_gain[l]) * (1.0 + sc1) + sh1
        z = h @ w_in[l]
        (c_q, c_kv, k_pe, q_n, k_c, v_c, k_s, v_s, k_w, v_w,
         g_nsa, g_mla_merge, g_nsa_merge) = jnp.split(z, split_at, axis=-1)
        y_mla = mla_attention(c_q, c_kv, k_pe, mla_cos, mla_sin,
                              mla_q_a_gain[l], mla_w_q_b[l], mla_kv_a_gain[l], mla_w_kv_b[l],
                              mla_q_gain[l], mla_k_gain[l]) @ w_o_mla[l]
        kvs = lambda t: t.reshape(B, S, NSA_KV_GROUPS, NSA_HEAD)
        y_nsa = nsa_attention(q_n.reshape(B, S, NSA_HEADS, NSA_HEAD),
                              kvs(k_c), kvs(v_c), kvs(k_s), kvs(v_s), kvs(k_w), kvs(v_w),
                              g_nsa.reshape(B, S, NSA_HEADS, N_NSA_BRANCH), nsa_cos, nsa_sin,
                              nsa_q_gain[l], nsa_kc_gain[l], nsa_ks_gain[l], nsa_kw_gain[l],
                              cmp_pos_k[l], cmp_w1_k[l], cmp_w2_k[l],
                              cmp_pos_v[l], cmp_w1_v[l], cmp_w2_v[l]) @ w_o_nsa[l]
        merged = jax.nn.sigmoid(g_mla_merge) * y_mla + jax.nn.sigmoid(g_nsa_merge) * y_nsa
        x = x + gt1 * (merged @ w_out[l])

        h2 = rms_norm(x, norm2_gain[l]) * (1.0 + sc2) + sh2
        x = x + gt2 * ((jax.nn.silu(h2 @ ffn_w_gate[l]) * (h2 @ ffn_w_up[l])) @ ffn_w_down[l])
    return x
```

```cpp
#include <hip/hip_runtime.h>
#include <hip/hip_cooperative_groups.h>
#include <cstdint>
#include <cstdio>
namespace cg = cooperative_groups;

typedef unsigned short bf16_t;
typedef unsigned u32x4 __attribute__((ext_vector_type(4)));
typedef unsigned u32x2 __attribute__((ext_vector_type(2)));
typedef float f32x4 __attribute__((ext_vector_type(4)));
typedef float f32x2 __attribute__((ext_vector_type(2)));
#define DI __device__ __forceinline__

constexpr int NB = 8, SEQ = 2048, DM = 1024, MT = NB * SEQ;
constexpr int DFF = 2816, NMOD = 6;
constexpr int ZN = 4608;
constexpr float EPS = 1e-6f;
constexpr float LOG2E = 1.4426950408889634f;
constexpr float C2N = 0.125f * LOG2E;
constexpr float C2M = 0.10206207261596575f * LOG2E;
constexpr int NTHR = 512, NWAVE = 8;
constexpr int O_CQ = 0, O_CKV = 768, O_KPE = 1024, O_QN = 1056, O_KC = 1568, O_VC = 1696, O_KS = 1824, O_VS = 1952, O_KW = 2080, O_VW = 2208,
              O_GN = 2336, O_GM = 2360, O_GNM = 3384, D_IN = 4408;

constexpr size_t MiB = 1u << 20;
constexpr size_t WS_CTL = 0;
constexpr size_t WS_MOD = 1 * MiB;
constexpr size_t WS_CB1 = 1 * MiB + 256 * 1024;
constexpr size_t WS_SSQPE = 1 * MiB + 320 * 1024;
constexpr size_t WS_SSQKN = 1 * MiB + 512 * 1024;
constexpr size_t WS_SSQA = 2 * MiB;
constexpr size_t WS_KCF = 3 * MiB;
constexpr size_t WS_VCF = 3 * MiB + 256 * 1024;
constexpr size_t WS_CW2 = 3 * MiB + 512 * 1024;
constexpr size_t WS_WIN = 4 * MiB;
constexpr size_t WS_WQB = 13 * MiB;
constexpr size_t WS_WKVB = 15 * MiB;
constexpr size_t WS_WO = 16 * MiB;
constexpr size_t WS_WOUT = 18 * MiB;
constexpr size_t WS_WGU = 20 * MiB;
constexpr size_t WS_WD = 31 * MiB;
constexpr size_t WS_CW1 = 37 * MiB;
constexpr size_t WS_R0 = 40 * MiB;
constexpr size_t WS_R1 = 72 * MiB;
constexpr size_t WS_R2 = 104 * MiB;
constexpr size_t WS_QN = 168 * MiB;
constexpr size_t WS_KC = 184 * MiB, WS_VC = 188 * MiB, WS_KS = 192 * MiB, WS_VS = 196 * MiB, WS_KW = 200 * MiB, WS_VW = 204 * MiB;
constexpr size_t WS_KPE = 208 * MiB;
constexpr size_t WS_GN = 209 * MiB;
constexpr size_t WS_KN = 210 * MiB;
constexpr size_t WS_VM = 226 * MiB;
constexpr size_t WS_CMPH = 244 * MiB;
constexpr size_t WS_ROPE = 248 * MiB;
constexpr size_t WS_HID = 168 * MiB;
constexpr size_t WS_END = 256 * MiB;

struct Params {
    const float* in[30];
    float* out;
    unsigned char* ws;
};
enum { I_X = 0, I_C, I_POS, I_ADAW, I_ADAB, I_N1G, I_WIN, I_QAG, I_WQB, I_KVAG, I_WKVB, I_MQG, I_MKG, I_NQG, I_NKCG, I_NKSG, I_NKWG,
       I_CPK, I_CW1K, I_CW2K, I_CPV, I_CW1V, I_CW2V, I_WOM, I_WON, I_WOUT, I_N2G, I_WG, I_WU, I_WDN };

template <class T> DI T* wsp(const Params& p, size_t off) { return (T*)(p.ws + off); }

DI unsigned f2bf(float f) { unsigned u = __float_as_uint(f); return (u + 0x7fffu + ((u >> 16) & 1u)) >> 16; }
DI unsigned pk2(float lo, float hi) { return f2bf(lo) | (f2bf(hi) << 16); }
DI float bf2f(unsigned short b) { return __uint_as_float(((unsigned)b) << 16); }
DI float bflo(unsigned w) { return __uint_as_float(w << 16); }
DI float bfhi(unsigned w) { return __uint_as_float(w & 0xffff0000u); }
DI void unpack8(const u32x4 w, float (&f)[8]) { f[0] = bflo(w.x); f[1] = bfhi(w.x); f[2] = bflo(w.y); f[3] = bfhi(w.y); f[4] = bflo(w.z); f[5] = bfhi(w.z); f[6] = bflo(w.w); f[7] = bfhi(w.w); }
DI u32x4 pack8(const float (&f)[8]) { u32x4 w; w.x = pk2(f[0], f[1]); w.y = pk2(f[2], f[3]); w.z = pk2(f[4], f[5]); w.w = pk2(f[6], f[7]); return w; }
DI float sigmoidf(float x) { return 1.0f / (1.0f + __expf(-x)); }
DI float siluf(float x) { return x / (1.0f + __expf(-x)); }
DI float wave_sum(float v) {
#pragma unroll
    for (int o = 1; o < 64; o <<= 1) v += __shfl_xor(v, o);
    return v;
}
DI void sincos_rad(float ang, float& c, float& s) {
    double rev = (double)ang * 0.15915494309189535; rev -= __builtin_rint(rev);
    const float fr = (float)rev; s = __builtin_amdgcn_sinf(fr); c = __builtin_amdgcn_cosf(fr);
}
#define LAS __attribute__((address_space(3)))
DI void transpose_item(const float* W, int ldw, int c0, int ncols, const float* rs, bf16_t* dst, int ldd, int n0, int k0, float* scr, int lane) {
    if (c0 >= 0) {
#pragma unroll 8
        for (int i = 0; i < 32; ++i) { const int kk = 2 * i + (lane >> 5), cc = lane & 31;
            float v = (cc < ncols) ? W[(size_t)(k0 + kk) * ldw + c0 + cc] : 0.f; if (rs) v *= rs[k0 + kk]; scr[kk * 33 + cc] = v; }
    } else {
#pragma unroll 8
        for (int i = 0; i < 32; ++i) { const int kk = 2 * i + (lane >> 5), cc = lane & 31; scr[kk * 33 + cc] = 0.f; }
    }
    __builtin_amdgcn_s_waitcnt(0xc07f);
    asm volatile("" ::: "memory");
    const int c = lane & 7;
#pragma unroll
    for (int j = 0; j < 4; ++j) { const int n = (lane >> 3) + 8 * j; const float* s = scr + (8 * c) * 33 + n;
        u32x4 o; o.x = pk2(s[0 * 33], s[1 * 33]); o.y = pk2(s[2 * 33], s[3 * 33]); o.z = pk2(s[4 * 33], s[5 * 33]); o.w = pk2(s[6 * 33], s[7 * 33]);
        *(u32x4*)(dst + (size_t)(n0 + n) * ldd + k0 + 8 * c) = o; }
    __builtin_amdgcn_s_waitcnt(0xc07f);
    asm volatile("" ::: "memory");
}
DI int zsrc(int s, int L0, int& ncols) {
    ncols = 32;
    if (s < 16) return 64 * s + L0;
    if (s == 16) { if (L0 == 0) return O_KPE; ncols = 24; return O_GN; }
    if (s < 25) return O_QN + 64 * (s - 17) + L0;
    if (s < 27) return O_KC + 64 * (s - 25) + L0;
    if (s < 29) return O_VC + 64 * (s - 27) + L0;
    if (s < 31) return O_KS + 64 * (s - 29) + L0;
    if (s < 33) return O_VS + 64 * (s - 31) + L0;
    if (s < 35) return O_KW + 64 * (s - 33) + L0;
    if (s < 37) return O_VW + 64 * (s - 35) + L0;
    if (s < 40) return -1;
    if (s < 56) return O_GM + 64 * (s - 40) + L0;
    return O_GNM + 64 * (s - 56) + L0;
}
DI void stage_weights(const Params& p, int gw, int ngw, float* scr, int lane) {
    constexpr int I_IN = (ZN / 32) * (DM / 64);
    constexpr int I_QB = (768 / 32) * (768 / 64);
    constexpr int I_KVB = (1024 / 32) * (256 / 64);
    constexpr int I_O = (1024 / 32) * (1024 / 64);
    constexpr int I_OUT = I_O;
    constexpr int I_GU = (5632 / 32) * (1024 / 64);
    constexpr int I_D = (1024 / 32) * (DFF / 64);
    constexpr int I_C1 = 2 * (256 / 32) * (2048 / 64);
    constexpr int NITEMS = I_IN + I_QB + I_KVB + I_O + I_OUT + I_GU + I_D + I_C1;
    for (int it = gw; it < NITEMS; it += ngw) {
        int r = it;
        if (r < I_IN) { const int nb = r / 16, kb = r % 16; const int pn = nb >> 3, bj = (nb >> 2) & 1, wc = nb & 3; int nc; const int c0 = zsrc(4 * pn + wc, 32 * bj, nc);
            transpose_item(p.in[I_WIN], D_IN, c0, nc, nullptr, wsp<bf16_t>(p, WS_WIN), DM, nb * 32, kb * 64, scr, lane); continue; } r -= I_IN;
        if (r < I_QB) { const int nb = r / 12, kb = r % 12; transpose_item(p.in[I_WQB], 768, nb * 32, 32, p.in[I_QAG], wsp<bf16_t>(p, WS_WQB), 768, nb * 32, kb * 64, scr, lane); continue; } r -= I_QB;
        if (r < I_KVB) { const int nb = r / 4, kb = r % 4; const int pn = nb >> 3, bj = (nb >> 2) & 1, wc = nb & 3, s = 4 * pn + wc;
            const int c0 = (s < 8) ? (128 * s + 32 * bj) : (128 * (s - 8) + 64 + 32 * bj);
            transpose_item(p.in[I_WKVB], 1024, c0, 32, p.in[I_KVAG], wsp<bf16_t>(p, WS_WKVB), 256, nb * 32, kb * 64, scr, lane); continue; } r -= I_KVB;
        if (r < I_O) { const int nb = r / 16, kb = r % 16;
            if (kb < 8) transpose_item(p.in[I_WOM], 1024, nb * 32, 32, nullptr, wsp<bf16_t>(p, WS_WO), 1024, nb * 32, kb * 64, scr, lane);
            else transpose_item(p.in[I_WON] - (size_t)512 * 1024, 1024, nb * 32, 32, nullptr, wsp<bf16_t>(p, WS_WO), 1024, nb * 32, kb * 64, scr, lane);
            continue; } r -= I_O;
        if (r < I_OUT) { const int nb = r / 16, kb = r % 16; transpose_item(p.in[I_WOUT], 1024, nb * 32, 32, nullptr, wsp<bf16_t>(p, WS_WOUT), 1024, nb * 32, kb * 64, scr, lane); continue; } r -= I_OUT;
        if (r < I_GU) { const int nb = r / 16, kb = r % 16; const int pn = nb >> 3, bj = (nb >> 2) & 1, wc = nb & 3, s = 4 * pn + wc;
            transpose_item(bj ? p.in[I_WU] : p.in[I_WG], DFF, 32 * s, 32, nullptr, wsp<bf16_t>(p, WS_WGU), 1024, nb * 32, kb * 64, scr, lane); continue; } r -= I_GU;
        if (r < I_D) { const int nb = r / 44, kb = r % 44; transpose_item(p.in[I_WDN], 1024, nb * 32, 32, nullptr, wsp<bf16_t>(p, WS_WD), DFF, nb * 32, kb * 64, scr, lane); continue; } r -= I_D;
        { const int kv = r / 256, rr = r % 256, nb = rr / 32, kb = rr % 32;
          transpose_item(kv ? p.in[I_CW1V] : p.in[I_CW1K], 256, nb * 32, 32, nullptr, wsp<bf16_t>(p, WS_CW1) + (size_t)kv * 256 * 2048, 2048, nb * 32, kb * 64, scr, lane); }
    }
}
DI void stage_mod(const Params& p, int bid, int nb, float* lds) {
    const int tid = threadIdx.x, wave = tid >> 6, lane = tid & 63, nwv = blockDim.x >> 6;
    for (int u = bid; u < 104; u += nb) {
        float acc[8];
#pragma unroll
        for (int b = 0; b < 8; ++b) acc[b] = 0.f;
        if (u < 96) {
            const int n = u * 64 + lane; const float* W = p.in[I_ADAW]; const float* c = p.in[I_C];
            for (int k = wave * (1024 / nwv); k < (wave + 1) * (1024 / nwv); ++k) { const float w = W[(size_t)k * 6144 + n];
#pragma unroll
                for (int b = 0; b < 8; ++b) acc[b] += siluf(c[b * 1024 + k]) * w; }
        } else {
            const int kv = (u - 96) >> 2, n = ((u - 96) & 3) * 64 + lane; const float* W = kv ? p.in[I_CW1V] : p.in[I_CW1K]; const float* pos = kv ? p.in[I_CPV] : p.in[I_CPK];
            for (int k = wave * (2048 / nwv); k < (wave + 1) * (2048 / nwv); ++k) acc[0] += pos[k] * W[(size_t)k * 256 + n];
        }
        __syncthreads();
#pragma unroll
        for (int b = 0; b < 8; ++b) lds[(wave * 8 + b) * 64 + lane] = acc[b];
        __syncthreads();
        if (wave == 0) {
#pragma unroll
            for (int b = 0; b < 8; ++b) { float s = 0.f;
                for (int w = 0; w < nwv; ++w) s += lds[(w * 8 + b) * 64 + lane];
                if (u < 96) wsp<float>(p, WS_MOD)[b * 6144 + u * 64 + lane] = s + p.in[I_ADAB][u * 64 + lane];
                else if (b == 0) wsp<float>(p, WS_CB1)[(u - 96) * 64 + lane] = s; }
        }
    }
    __syncthreads();
}
DI void stage_rope(const Params& p, int gtid, int ngt) {
    float* T = wsp<float>(p, WS_ROPE); const int* pos = (const int*)p.in[I_POS];
    for (int i = gtid; i < MT * 24; i += ngt) {
        const int row = i / 24, j = i % 24; const float ps = (float)pos[row]; float inv, c, s;
        if (j < 16) inv = (float)pow(500000.0, -(double)j / 16.0); else inv = (float)pow(500000.0, -(double)(j - 16) / 8.0);
        sincos_rad(ps * inv, c, s);
        if (j < 16) { T[(size_t)row * 16 + j] = c; T[(size_t)MT * 16 + (size_t)row * 16 + j] = s; }
        else { T[(size_t)MT * 32 + (size_t)row * 8 + (j - 16)] = c; T[(size_t)MT * 40 + (size_t)row * 8 + (j - 16)] = s; }
    }
}
DI const float* ropeCM(const Params& p) { return wsp<float>(p, WS_ROPE); }
DI const float* ropeSM(const Params& p) { return wsp<float>(p, WS_ROPE) + (size_t)MT * 16; }
DI const float* ropeCN(const Params& p) { return wsp<float>(p, WS_ROPE) + (size_t)MT * 32; }
DI const float* ropeSN(const Params& p) { return wsp<float>(p, WS_ROPE) + (size_t)MT * 40; }

DI void stage_normmod(const float* X, const float* gain, const float* mod, int sh_idx, int sc_idx, bf16_t* Hout, int gw, int ngw, int lane) {
    for (int m = gw; m < MT; m += ngw) {
        const int b = m / SEQ; const f32x4* xr = (const f32x4*)(X + (size_t)m * DM) + lane;
        f32x4 v[4]; float s = 0.f;
#pragma unroll
        for (int j = 0; j < 4; ++j) { v[j] = xr[64 * j]; s += (v[j].x * v[j].x + v[j].y * v[j].y) + (v[j].z * v[j].z + v[j].w * v[j].w); }
        const float rstd = rsqrtf(wave_sum(s) * (1.f / DM) + EPS);
        const f32x4* g4 = (const f32x4*)gain + lane; const f32x4* sc4 = (const f32x4*)(mod + b * 6144 + sc_idx * 1024) + lane; const f32x4* sh4 = (const f32x4*)(mod + b * 6144 + sh_idx * 1024) + lane;
        u32x2* o8 = (u32x2*)(Hout + (size_t)m * DM) + lane;
#pragma unroll
        for (int j = 0; j < 4; ++j) { const f32x4 g = g4[64 * j], sc = sc4[64 * j], sh = sh4[64 * j];
            const f32x4 y = v[j] * rstd * g * (1.0f + sc) + sh; u32x2 w; w.x = pk2(y.x, y.y); w.y = pk2(y.z, y.w); o8[64 * j] = w; }
    }
}
DI void store8bf(bf16_t* dst, const float (&f)[8]) { *(u32x4*)dst = pack8(f); }
DI float ssq16(const float (&v)[2][8]) { float q = 0.f;
#pragma unroll
    for (int b = 0; b < 2; ++b)
#pragma unroll
        for (int j = 0; j < 8; ++j) q += v[b][j] * v[b][j];
    q += __shfl_xor(q, 16); q += __shfl_xor(q, 32); return q; }

struct EpiZ {
    static constexpr bool HAS_MID = false;
    Params p;
    DI void mid(int, int, int, int, float (&)[2][8]) const {}
    DI void normrope(int row, int fq, float (&v)[2][8], const float* gain, float post, bf16_t* dst) const {
        const float rstd = rsqrtf(ssq16(v) * (1.f / 64.f) + EPS);
#pragma unroll
        for (int b = 0; b < 2; ++b) { const f32x4 g0 = *(const f32x4*)(gain + 32 * b + 8 * fq), g1 = *(const f32x4*)(gain + 32 * b + 8 * fq + 4);
            v[b][0] *= rstd * g0.x; v[b][1] *= rstd * g0.y; v[b][2] *= rstd * g0.z; v[b][3] *= rstd * g0.w; v[b][4] *= rstd * g1.x; v[b][5] *= rstd * g1.y; v[b][6] *= rstd * g1.z; v[b][7] *= rstd * g1.w; }
        const float* cs = ropeCN(p) + (size_t)row * 8; const float* sn = ropeSN(p) + (size_t)row * 8;
#pragma unroll
        for (int j = 0; j < 8; ++j) { const float own = v[0][j], oth = __shfl_xor(own, 16); const float c = cs[j], s = sn[j];
            if (fq == 0) v[0][j] = own * c - oth * s; else if (fq == 1) v[0][j] = own * c + oth * s; }
#pragma unroll
        for (int b = 0; b < 2; ++b) {
#pragma unroll
            for (int j = 0; j < 8; ++j) v[b][j] *= post;
            store8bf(dst + 32 * b + 8 * fq, v[b]); }
    }
    DI void apply(int row, int pn, int wc, int fq, float (&v)[2][8]) const {
        const int s = 4 * pn + wc;
        if (s < 16) {
            bf16_t* d = wsp<bf16_t>(p, WS_R1) + (size_t)row * 1024 + 64 * s + 8 * fq;
            const float q = ssq16(v); store8bf(d, v[0]); store8bf(d + 32, v[1]);
            if (fq == 0) wsp<float>(p, WS_SSQA)[(size_t)row * 16 + s] = q;
        } else if (s == 16) {
            float q = 0.f;
#pragma unroll
            for (int j = 0; j < 8; ++j) q += v[0][j] * v[0][j];
            q += __shfl_xor(q, 16); q += __shfl_xor(q, 32);
            if (fq == 0) wsp<float>(p, WS_SSQPE)[row] = q;
            const float* kg = p.in[I_MKG] + 64 + 8 * fq; const int i0 = 8 * (fq & 1);
            const float* cs = ropeCM(p) + (size_t)row * 16 + i0; const float* sn = ropeSM(p) + (size_t)row * 16 + i0;
            float o[8];
#pragma unroll
            for (int j = 0; j < 8; ++j) { const float own = v[0][j] * kg[j], oth = __shfl_xor(own, 32); o[j] = (fq < 2) ? own * cs[j] - oth * sn[j] : own * cs[j] + oth * sn[j]; }
            store8bf(wsp<bf16_t>(p, WS_KPE) + (size_t)row * 32 + 8 * fq, o);
#pragma unroll
            for (int j = 0; j < 8; ++j) o[j] = sigmoidf(v[1][j]);
            store8bf(wsp<bf16_t>(p, WS_GN) + (size_t)row * 32 + 8 * fq, o);
        } else if (s < 25) {
            normrope(row, fq, v, p.in[I_NQG], C2N, wsp<bf16_t>(p, WS_QN) + (size_t)row * 512 + 64 * (s - 17));
        } else if (s < 37) {
            const int t = (s - 25) >> 1, g = (s - 25) & 1;
            bf16_t* d = wsp<bf16_t>(p, WS_KC + (size_t)t * 4 * MiB) + (size_t)row * 128 + 64 * g;
            if (t == 2) normrope(row, fq, v, p.in[I_NKSG], 1.0f, d);
            else if (t == 4) normrope(row, fq, v, p.in[I_NKWG], 1.0f, d);
            else { store8bf(d + 8 * fq, v[0]); store8bf(d + 32 + 8 * fq, v[1]); }
        } else if (s < 40) {
        } else {
            bf16_t* d = wsp<bf16_t>(p, WS_R2) + (size_t)row * 2048 + 64 * (s - 40) + 8 * fq;
#pragma unroll
            for (int b = 0; b < 2; ++b) { float o[8];
#pragma unroll
                for (int j = 0; j < 8; ++j) o[j] = sigmoidf(v[b][j]);
                store8bf(d + 32 * b, o); }
        }
    }
};
struct EpiQ {
    static constexpr bool HAS_MID = false;
    Params p;
    DI void mid(int, int, int, int, float (&)[2][8]) const {}
    DI void apply(int row, int pn, int wc, int fq, float (&v)[2][8]) const {
        const float* sq = wsp<float>(p, WS_SSQA) + (size_t)row * 16; float s = 0.f;
#pragma unroll
        for (int i = 0; i < 12; ++i) s += sq[i];
        const float rstd = rsqrtf(s * (1.f / 768.f) + EPS);
        bf16_t* d = wsp<bf16_t>(p, WS_R0) + (size_t)row * 768 + 256 * pn + 32 * wc + 8 * fq;
#pragma unroll
        for (int b = 0; b < 2; ++b) { float o[8];
#pragma unroll
            for (int j = 0; j < 8; ++j) o[j] = v[b][j] * rstd;
            store8bf(d + 128 * b, o); }
    }
};
struct EpiKV {
    static constexpr bool HAS_MID = false;
    Params p;
    DI void mid(int, int, int, int, float (&)[2][8]) const {}
    DI void apply(int row, int pn, int wc, int fq, float (&v)[2][8]) const {
        const int s = 4 * pn + wc;
        const float* sq = wsp<float>(p, WS_SSQA) + (size_t)row * 16 + 12;
        const float rstd = rsqrtf(((sq[0] + sq[1]) + (sq[2] + sq[3])) * (1.f / 256.f) + EPS);
#pragma unroll
        for (int b = 0; b < 2; ++b)
#pragma unroll
            for (int j = 0; j < 8; ++j) v[b][j] *= rstd;
        if (s < 8) { const float q = ssq16(v); if (fq == 0) wsp<float>(p, WS_SSQKN)[(size_t)row * 8 + s] = q;
            bf16_t* d = wsp<bf16_t>(p, WS_KN) + (size_t)row * 512 + 64 * s + 8 * fq; store8bf(d, v[0]); store8bf(d + 32, v[1]); }
        else { bf16_t* d = wsp<bf16_t>(p, WS_VM) + (size_t)row * 512 + 64 * (s - 8) + 8 * fq; store8bf(d, v[0]); store8bf(d + 32, v[1]); }
    }
};
struct EpiMerge {
    static constexpr bool HAS_MID = true;
    Params p;
    DI void mid(int row, int pn, int wc, int fq, float (&v)[2][8]) const {
        const bf16_t* g = wsp<bf16_t>(p, WS_R2) + (size_t)row * 2048 + 256 * pn + 32 * wc + 8 * fq;
#pragma unroll
        for (int b = 0; b < 2; ++b) { float s1[8], s2[8]; unpack8(*(const u32x4*)(g + 128 * b), s1); unpack8(*(const u32x4*)(g + 1024 + 128 * b), s2);
#pragma unroll
            for (int j = 0; j < 8; ++j) v[b][j] *= s1[j] / s2[j]; }
    }
    DI void apply(int row, int pn, int wc, int fq, float (&v)[2][8]) const {
        const bf16_t* g = wsp<bf16_t>(p, WS_R2) + (size_t)row * 2048 + 1024 + 256 * pn + 32 * wc + 8 * fq;
        bf16_t* d = wsp<bf16_t>(p, WS_R0) + (size_t)row * 1024 + 256 * pn + 32 * wc + 8 * fq;
#pragma unroll
        for (int b = 0; b < 2; ++b) { float s2[8], o[8]; unpack8(*(const u32x4*)(g + 128 * b), s2);
#pragma unroll
            for (int j = 0; j < 8; ++j) o[j] = v[b][j] * s2[j];
            store8bf(d + 128 * b, o); }
    }
};
struct EpiOut {
    static constexpr bool HAS_MID = false;
    Params p;
    DI void mid(int, int, int, int, float (&)[2][8]) const {}
    DI void apply(int row, int pn, int wc, int fq, float (&v)[2][8]) const {
        const int b_ = row / SEQ, col = 256 * pn + 32 * wc + 8 * fq;
        const float* gt = wsp<float>(p, WS_MOD) + b_ * 6144 + 2 * 1024 + col; const float* x = p.in[I_X] + (size_t)row * DM + col; float* d = wsp<float>(p, WS_R2) + (size_t)row * DM + col;
#pragma unroll
        for (int b = 0; b < 2; ++b)
#pragma unroll
            for (int h = 0; h < 2; ++h) { const f32x4 g = *(const f32x4*)(gt + 128 * b + 4 * h), xv = *(const f32x4*)(x + 128 * b + 4 * h);
                f32x4 o; o.x = xv.x + g.x * v[b][4 * h]; o.y = xv.y + g.y * v[b][4 * h + 1]; o.z = xv.z + g.z * v[b][4 * h + 2]; o.w = xv.w + g.w * v[b][4 * h + 3]; *(f32x4*)(d + 128 * b + 4 * h) = o; }
    }
};
struct EpiGU {
    static constexpr bool HAS_MID = false;
    Params p;
    DI void mid(int, int, int, int, float (&)[2][8]) const {}
    DI void apply(int row, int pn, int wc, int fq, float (&v)[2][8]) const {
        const int s = 4 * pn + wc; float o[8];
#pragma unroll
        for (int j = 0; j < 8; ++j) o[j] = siluf(v[0][j]) * v[1][j];
        store8bf(wsp<bf16_t>(p, WS_HID) + (size_t)row * DFF + 32 * s + 8 * fq, o);
    }
};
struct EpiDown {
    static constexpr bool HAS_MID = false;
    Params p;
    DI void mid(int, int, int, int, float (&)[2][8]) const {}
    DI void apply(int row, int pn, int wc, int fq, float (&v)[2][8]) const {
        const int b_ = row / SEQ, col = 256 * pn + 32 * wc + 8 * fq;
        const float* gt = wsp<float>(p, WS_MOD) + b_ * 6144 + 5 * 1024 + col; const float* x = wsp<float>(p, WS_R2) + (size_t)row * DM + col; float* d = p.out + (size_t)row * DM + col;
#pragma unroll
        for (int b = 0; b < 2; ++b)
#pragma unroll
            for (int h = 0; h < 2; ++h) { const f32x4 g = *(const f32x4*)(gt + 128 * b + 4 * h), xv = *(const f32x4*)(x + 128 * b + 4 * h);
                f32x4 o; o.x = xv.x + g.x * v[b][4 * h]; o.y = xv.y + g.y * v[b][4 * h + 1]; o.z = xv.z + g.z * v[b][4 * h + 2]; o.w = xv.w + g.w * v[b][4 * h + 3]; *(f32x4*)(d + 128 * b + 4 * h) = o; }
    }
};

template <class Epi>
DI void gemm_naive(const bf16_t* A, int lda, const bf16_t* Bt, int ldb, int M, int N, int K, int kmid, const Epi& E, int gw, int ngw) {
    const int lane = threadIdx.x & 63, fr = lane & 15, fq = lane >> 4;
    const int nslots = N / 64; const long total = (long)(M / 16) * nslots;
    for (long u = gw; u < total; u += ngw) {
        const int rg = (int)(u / nslots), s = (int)(u % nslots), pn = s >> 2, wc = s & 3, row = rg * 16 + fr;
        float v[2][8];
#pragma unroll
        for (int b = 0; b < 2; ++b)
#pragma unroll
            for (int j = 0; j < 8; ++j) v[b][j] = 0.f;
        const bf16_t* a = A + (size_t)row * lda; const bf16_t* bb = Bt + (size_t)(256 * pn + 32 * wc + 8 * fq) * ldb;
        for (int k = 0; k < K; k += 8) {
            if (Epi::HAS_MID && k == kmid) E.mid(row, pn, wc, fq, v);
            float af[8]; unpack8(*(const u32x4*)(a + k), af);
#pragma unroll
            for (int b = 0; b < 2; ++b)
#pragma unroll
                for (int j = 0; j < 8; ++j) { float bf[8]; unpack8(*(const u32x4*)(bb + (size_t)(128 * b + j) * ldb + k), bf); float d = 0.f;
#pragma unroll
                    for (int e = 0; e < 8; ++e) d += af[e] * bf[e];
                    v[b][j] += d; }
        }
        E.apply(row, pn, wc, fq, v);
    }
}
DI void cmp_hidden_naive(const Params& p, int gtid, int ngt) {
    float* H = wsp<float>(p, WS_CMPH);
    for (int idx = gtid; idx < 2 * 2 * 1024 * 256; idx += ngt) {
        const int j = idx & 255, r = (idx >> 8) & 1023, g = (idx >> 18) & 1, kv = idx >> 19;
        if ((r & 127) == 127) { H[idx] = 0.f; continue; }
        const bf16_t* src = wsp<bf16_t>(p, kv ? WS_VC : WS_KC) + (size_t)(16 * r) * 128 + g * 64;
        const bf16_t* w = wsp<bf16_t>(p, WS_CW1) + (size_t)kv * 256 * 2048 + (size_t)j * 2048;
        float acc = 0.f;
        for (int l = 0; l < 32; ++l)
#pragma unroll
            for (int d8 = 0; d8 < 8; ++d8) { float a[8], b[8]; unpack8(*(const u32x4*)(src + l * 128 + d8 * 8), a); unpack8(*(const u32x4*)(w + l * 64 + d8 * 8), b);
#pragma unroll
                for (int e = 0; e < 8; ++e) acc += a[e] * b[e]; }
        H[idx] = siluf(acc + wsp<float>(p, WS_CB1)[kv * 256 + j]);
    }
}
DI void cmp_out(const Params& p, int gw, int ngw, int lane) {
    const float* H = wsp<float>(p, WS_CMPH);
    for (int u = gw; u < 2 * 2 * 1024; u += ngw) {
        const int r = u & 1023, g = (u >> 10) & 1, kv = u >> 11; const int b = r >> 7, n = r & 127;
        bf16_t* dst = wsp<bf16_t>(p, kv ? WS_VCF : WS_KCF) + (size_t)r * 128 + g * 64 + lane;
        if (n == 127) { *dst = 0; continue; }
        const float* h = H + (size_t)u * 256; const float* w2 = (kv ? p.in[I_CW2V] : p.in[I_CW2K]) + lane;
        float acc = 0.f;
        for (int j = 0; j < 256; ++j) acc += h[j] * w2[j * 64];
        if (kv == 0) {
            const float rstd = rsqrtf(wave_sum(acc * acc) * (1.f / 64.f) + EPS);
            float y = acc * rstd * p.in[I_NKCG][lane];
            const int prow = b * SEQ + 16 * n + 31; const float oth = __shfl_xor(y, 8);
            if (lane < 16) { const float c = ropeCN(p)[(size_t)prow * 8 + (lane & 7)], s = ropeSN(p)[(size_t)prow * 8 + (lane & 7)]; y = (lane < 8) ? y * c - oth * s : y * c + oth * s; }
            acc = y;
        }
        *dst = (bf16_t)f2bf(acc);
    }
}

DI unsigned select_blocks(const float (&imp)[32], int cur) {
    if (cur < 8) return (2u << cur) - 1u;
    unsigned mask = 1u | (1u << cur) | (1u << (cur - 1));
#pragma unroll 1
    for (int it = 0; it < 5; ++it) {
        float best = -1.0f; int bi = 1;
#pragma unroll
        for (int j = 1; j < 32; ++j) { const bool ok = (j <= cur - 2) && !((mask >> j) & 1u); if (ok && imp[j] > best) { best = imp[j]; bi = j; } }
        mask |= 1u << bi;
    }
    return mask;
}

DI float dot64(const float (&q)[64], const bf16_t* k) { float acc = 0.f;
#pragma unroll
    for (int c = 0; c < 8; ++c) { float kf[8]; unpack8(*(const u32x4*)(k + 8 * c), kf);
#pragma unroll
        for (int e = 0; e < 8; ++e) acc += q[8 * c + e] * kf[e]; }
    return acc; }
DI void axpy64(float (&o)[64], float pw, const bf16_t* v) {
#pragma unroll
    for (int c = 0; c < 8; ++c) { float vf[8]; unpack8(*(const u32x4*)(v + 8 * c), vf);
#pragma unroll
        for (int e = 0; e < 8; ++e) o[8 * c + e] += pw * vf[e]; } }
DI void nsa_naive(const Params& p, int bid, int nb, float* lds) {
    float* impL = lds + threadIdx.x * 33;
    const bf16_t* QN = wsp<bf16_t>(p, WS_QN); const bf16_t* KCF = wsp<bf16_t>(p, WS_KCF); const bf16_t* VCF = wsp<bf16_t>(p, WS_VCF);
    const bf16_t* KS = wsp<bf16_t>(p, WS_KS); const bf16_t* VS = wsp<bf16_t>(p, WS_VS); const bf16_t* KW = wsp<bf16_t>(p, WS_KW); const bf16_t* VW = wsp<bf16_t>(p, WS_VW);
    const bf16_t* GN = wsp<bf16_t>(p, WS_GN); bf16_t* OC = wsp<bf16_t>(p, WS_R1);
    for (int idx = bid * blockDim.x + threadIdx.x; idx < MT * 2; idx += nb * blockDim.x) {
        const int t = idx & (SEQ - 1), g = (idx >> 11) & 1, b = idx >> 12; const int row = b * SEQ + t, cur = t >> 6;
        const int nvalid = (t >= 31) ? ((t - 31) >> 4) + 1 : 0;
        for (int j = 0; j < 32; ++j) impL[j] = 0.f;
        float q[64];
        for (int r = 0; r < 4; ++r) {
#pragma unroll
            for (int c = 0; c < 8; ++c) { float f[8]; unpack8(*(const u32x4*)(QN + (size_t)row * 512 + (g * 4 + r) * 64 + 8 * c), f);
#pragma unroll
                for (int e = 0; e < 8; ++e) q[8 * c + e] = f[e]; }
            float m = -INFINITY;
            for (int n = 0; n < nvalid; ++n) m = fmaxf(m, dot64(q, KCF + (size_t)(b * 128 + n) * 128 + g * 64));
            float l = 0.f;
            for (int n = 0; n < nvalid; ++n) l += __builtin_amdgcn_exp2f(dot64(q, KCF + (size_t)(b * 128 + n) * 128 + g * 64) - m);
            const float rl = (nvalid > 0) ? 1.f / l : 0.f;
            for (int n = 0; n < nvalid; ++n) { const float pw = __builtin_amdgcn_exp2f(dot64(q, KCF + (size_t)(b * 128 + n) * 128 + g * 64) - m) * rl;
                impL[n >> 2] += pw; if ((n & 3) == 3 && (n >> 2) + 1 < 32) impL[(n >> 2) + 1] += pw; }
        }
        float imp[32];
#pragma unroll
        for (int j = 0; j < 32; ++j) imp[j] = impL[j];
        const unsigned mask = select_blocks(imp, cur);
        for (int r = 0; r < 4; ++r) {
            const int hh = g * 4 + r;
#pragma unroll
            for (int c = 0; c < 8; ++c) { float f[8]; unpack8(*(const u32x4*)(QN + (size_t)row * 512 + hh * 64 + 8 * c), f);
#pragma unroll
                for (int e = 0; e < 8; ++e) q[8 * c + e] = f[e]; }
            float ot[64];
#pragma unroll
            for (int d = 0; d < 64; ++d) ot[d] = 0.f;
            const float g0 = bf2f(GN[(size_t)row * 32 + hh * 3 + 0]), g1 = bf2f(GN[(size_t)row * 32 + hh * 3 + 1]), g2 = bf2f(GN[(size_t)row * 32 + hh * 3 + 2]);
            for (int br = 0; br < 3; ++br) {
                float o[64];
#pragma unroll
                for (int d = 0; d < 64; ++d) o[d] = 0.f;
                float m = -INFINITY, l = 0.f;
                if (br == 0) {
                    for (int n = 0; n < nvalid; ++n) { const float s = dot64(q, KCF + (size_t)(b * 128 + n) * 128 + g * 64);
                        if (s > m) { const float f = __builtin_amdgcn_exp2f(m - s); l *= f;
#pragma unroll
                            for (int d = 0; d < 64; ++d) o[d] *= f;
                            m = s; }
                        const float pw = __builtin_amdgcn_exp2f(s - m); l += pw; axpy64(o, pw, VCF + (size_t)(b * 128 + n) * 128 + g * 64); }
                } else {
                    const int k0 = (br == 1) ? 0 : ((t - 255 > 0) ? t - 255 : 0);
                    for (int k = k0; k <= t; ++k) {
                        if (br == 1 && !((mask >> (k >> 6)) & 1u)) { k |= 63; continue; }
                        const size_t kr = (size_t)(b * SEQ + k) * 128 + g * 64;
                        const float s = dot64(q, (br == 1 ? KS : KW) + kr);
                        if (s > m) { const float f = __builtin_amdgcn_exp2f(m - s); l *= f;
#pragma unroll
                            for (int d = 0; d < 64; ++d) o[d] *= f;
                            m = s; }
                        const float pw = __builtin_amdgcn_exp2f(s - m); l += pw; axpy64(o, pw, (br == 1 ? VS : VW) + kr); }
                }
                const float gg = (br == 0 ? g0 : br == 1 ? g1 : g2) * ((l > 0.f) ? 1.f / l : 0.f);
#pragma unroll
                for (int d = 0; d < 64; ++d) ot[d] += gg * o[d];
            }
#pragma unroll
            for (int c = 0; c < 8; ++c) { float f[8];
#pragma unroll
                for (int e = 0; e < 8; ++e) f[e] = ot[8 * c + e];
                *(u32x4*)(OC + (size_t)row * 1024 + 512 + hh * 64 + 8 * c) = pack8(f); }
        }
    }
}

DI void mla_qprep(const Params& p, int row, int h, float (&q)[96]) {
    const bf16_t* src = wsp<bf16_t>(p, WS_R0) + (size_t)row * 768 + h * 96; float ss = 0.f;
#pragma unroll
    for (int c = 0; c < 12; ++c) { float f[8]; unpack8(*(const u32x4*)(src + 8 * c), f);
#pragma unroll
        for (int e = 0; e < 8; ++e) { q[8 * c + e] = f[e]; ss += f[e] * f[e]; } }
    const float rstd = rsqrtf(ss * (1.f / 96.f) + EPS); const float* qg = p.in[I_MQG]; const float* kg = p.in[I_MKG];
#pragma unroll
    for (int d = 0; d < 96; ++d) q[d] *= rstd * qg[d];
    const float* cs = ropeCM(p) + (size_t)row * 16; const float* sn = ropeSM(p) + (size_t)row * 16;
#pragma unroll
    for (int i = 0; i < 16; ++i) { const float x1 = q[64 + i], x2 = q[80 + i]; q[64 + i] = x1 * cs[i] - x2 * sn[i]; q[80 + i] = x2 * cs[i] + x1 * sn[i]; }
#pragma unroll
    for (int d = 0; d < 64; ++d) q[d] *= kg[d] * C2M;
#pragma unroll
    for (int d = 64; d < 96; ++d) q[d] *= C2M;
}
DI void mla_naive(const Params& p, int gtid, int ngt) {
    const bf16_t* KN = wsp<bf16_t>(p, WS_KN); const bf16_t* KPE = wsp<bf16_t>(p, WS_KPE); const bf16_t* VM = wsp<bf16_t>(p, WS_VM);
    const float* sqk = wsp<float>(p, WS_SSQKN); const float* sqp = wsp<float>(p, WS_SSQPE); bf16_t* OC = wsp<bf16_t>(p, WS_R1);
    for (int idx = gtid; idx < MT * 8; idx += ngt) {
        const int t = idx & (SEQ - 1), h = (idx >> 11) & 7, b = idx >> 14; const int row = b * SEQ + t;
        float q[96]; mla_qprep(p, row, h, q);
        float o[64];
#pragma unroll
        for (int d = 0; d < 64; ++d) o[d] = 0.f;
        float m = -INFINITY, l = 0.f;
        for (int k = 0; k <= t; ++k) {
            const int kr = b * SEQ + k; const bf16_t* kn = KN + (size_t)kr * 512 + h * 64; const bf16_t* kp = KPE + (size_t)kr * 32; float acc = 0.f;
#pragma unroll
            for (int c = 0; c < 8; ++c) { float kf[8]; unpack8(*(const u32x4*)(kn + 8 * c), kf);
#pragma unroll
                for (int e = 0; e < 8; ++e) acc += q[8 * c + e] * kf[e]; }
#pragma unroll
            for (int c = 0; c < 4; ++c) { float kf[8]; unpack8(*(const u32x4*)(kp + 8 * c), kf);
#pragma unroll
                for (int e = 0; e < 8; ++e) acc += q[64 + 8 * c + e] * kf[e]; }
            const float s = acc * rsqrtf((sqk[(size_t)kr * 8 + h] + sqp[kr]) * (1.f / 96.f) + EPS);
            if (s > m) { const float f = __builtin_amdgcn_exp2f(m - s); l *= f;
#pragma unroll
                for (int d = 0; d < 64; ++d) o[d] *= f;
                m = s; }
            const float pw = __builtin_amdgcn_exp2f(s - m); l += pw; axpy64(o, pw, VM + (size_t)kr * 512 + h * 64);
        }
        const float rl = 1.f / l;
#pragma unroll
        for (int c = 0; c < 8; ++c) { float f[8];
#pragma unroll
            for (int e = 0; e < 8; ++e) f[e] = o[8 * c + e] * rl;
            *(u32x4*)(OC + (size_t)row * 1024 + h * 64 + 8 * c) = pack8(f); }
    }
}
enum { ST_P0 = 0, ST_NORM1, ST_GEMM_Z, ST_GEMM_Q, ST_GEMM_KV, ST_CMP_H, ST_CMP_O, ST_MLA, ST_NSA, ST_GEMM_MERGE, ST_GEMM_OUT, ST_NORM2, ST_GEMM_GU, ST_GEMM_DOWN };

template <int ST> __global__ void __launch_bounds__(256) stage_kernel(Params p) {
    __shared__ __attribute__((aligned(16))) float lds[256 * 34];
    const int tid = threadIdx.x, lane = tid & 63, wave = tid >> 6, nwv = blockDim.x >> 6;
    const int gw = blockIdx.x * nwv + wave, ngw = gridDim.x * nwv, gtid = blockIdx.x * blockDim.x + tid, ngt = gridDim.x * blockDim.x;
    if constexpr (ST == ST_P0) { stage_weights(p, gw, ngw, lds + wave * (64 * 33), lane); __syncthreads(); stage_mod(p, blockIdx.x, gridDim.x, lds); stage_rope(p, gtid, ngt); }
    if constexpr (ST == ST_NORM1) stage_normmod(p.in[I_X], p.in[I_N1G], wsp<float>(p, WS_MOD), 0, 1, wsp<bf16_t>(p, WS_R0), gw, ngw, lane);
    if constexpr (ST == ST_GEMM_Z) { EpiZ E{p}; gemm_naive(wsp<bf16_t>(p, WS_R0), 1024, wsp<bf16_t>(p, WS_WIN), 1024, MT, ZN, 1024, 0, E, gw, ngw); }
    if constexpr (ST == ST_GEMM_Q) { EpiQ E{p}; gemm_naive(wsp<bf16_t>(p, WS_R1), 1024, wsp<bf16_t>(p, WS_WQB), 768, MT, 768, 768, 0, E, gw, ngw); }
    if constexpr (ST == ST_GEMM_KV) { EpiKV E{p}; gemm_naive(wsp<bf16_t>(p, WS_R1) + 768, 1024, wsp<bf16_t>(p, WS_WKVB), 256, MT, 1024, 256, 0, E, gw, ngw); }
    if constexpr (ST == ST_CMP_H) cmp_hidden_naive(p, gtid, ngt);
    if constexpr (ST == ST_CMP_O) cmp_out(p, gw, ngw, lane);
    if constexpr (ST == ST_MLA) mla_naive(p, gtid, ngt);
    if constexpr (ST == ST_NSA) nsa_naive(p, blockIdx.x, gridDim.x, lds);
    if constexpr (ST == ST_GEMM_MERGE) { EpiMerge E{p}; gemm_naive(wsp<bf16_t>(p, WS_R1), 1024, wsp<bf16_t>(p, WS_WO), 1024, MT, 1024, 1024, 512, E, gw, ngw); }
    if constexpr (ST == ST_GEMM_OUT) { EpiOut E{p}; gemm_naive(wsp<bf16_t>(p, WS_R0), 1024, wsp<bf16_t>(p, WS_WOUT), 1024, MT, 1024, 1024, 0, E, gw, ngw); }
    if constexpr (ST == ST_NORM2) stage_normmod(wsp<float>(p, WS_R2), p.in[I_N2G], wsp<float>(p, WS_MOD), 3, 4, wsp<bf16_t>(p, WS_R1), gw, ngw, lane);
    if constexpr (ST == ST_GEMM_GU) { EpiGU E{p}; gemm_naive(wsp<bf16_t>(p, WS_R1), 1024, wsp<bf16_t>(p, WS_WGU), 1024, MT, 5632, 1024, 0, E, gw, ngw); }
    if constexpr (ST == ST_GEMM_DOWN) { EpiDown E{p}; gemm_naive(wsp<bf16_t>(p, WS_HID), DFF, wsp<bf16_t>(p, WS_WD), DFF, MT, 1024, DFF, 0, E, gw, ngw); }
}

extern "C" void kernel_launch(void* const* d_in, const int* in_sizes, int n_in, void* d_out, int out_size, void* d_ws, size_t ws_size, hipStream_t stream) {
    if (n_in != 30 || out_size != MT * DM || ws_size < WS_END) { fprintf(stderr, "kernel_launch: unexpected shapes (n_in %d out %d ws %zu)\n", n_in, out_size, ws_size); return; }
    Params p{};
    for (int i = 0; i < 30; ++i) p.in[i] = (const float*)d_in[i];
    p.out = (float*)d_out; p.ws = (unsigned char*)d_ws;
    const int G = 2048;
#define LAUNCH(ST) hipLaunchKernelGGL(stage_kernel<ST>, dim3(G), dim3(256), 0, stream, p)
    LAUNCH(ST_P0); LAUNCH(ST_NORM1); LAUNCH(ST_GEMM_Z); LAUNCH(ST_GEMM_Q); LAUNCH(ST_GEMM_KV); LAUNCH(ST_CMP_H); LAUNCH(ST_CMP_O);
    LAUNCH(ST_MLA); LAUNCH(ST_NSA); LAUNCH(ST_GEMM_MERGE); LAUNCH(ST_GEMM_OUT); LAUNCH(ST_NORM2); LAUNCH(ST_GEMM_GU); LAUNCH(ST_GEMM_DOWN);
#undef LAUNCH
}
```

```cpp
#include <hip/hip_runtime.h>
#include <hip/hip_cooperative_groups.h>
#include <cstdint>
#include <cstdio>
namespace cg = cooperative_groups;

typedef unsigned short bf16_t;
typedef unsigned u32x4 __attribute__((ext_vector_type(4)));
typedef unsigned u32x2 __attribute__((ext_vector_type(2)));
typedef float f32x4 __attribute__((ext_vector_type(4)));
typedef float f32x2 __attribute__((ext_vector_type(2)));
#define DI __device__ __forceinline__

constexpr int NB = 8, SEQ = 2048, DM = 1024, MT = NB * SEQ;
constexpr int DFF = 2816, NMOD = 6;
constexpr int ZN = 4608;
constexpr float EPS = 1e-6f;
constexpr float LOG2E = 1.4426950408889634f;
constexpr float C2N = 0.125f * LOG2E;
constexpr float C2M = 0.10206207261596575f * LOG2E;
constexpr int NTHR = 512, NWAVE = 8;
constexpr int O_CQ = 0, O_CKV = 768, O_KPE = 1024, O_QN = 1056, O_KC = 1568, O_VC = 1696, O_KS = 1824, O_VS = 1952, O_KW = 2080, O_VW = 2208,
              O_GN = 2336, O_GM = 2360, O_GNM = 3384, D_IN = 4408;

constexpr size_t MiB = 1u << 20;
constexpr size_t WS_CTL = 0;
constexpr size_t WS_MOD = 1 * MiB;
constexpr size_t WS_CB1 = 1 * MiB + 256 * 1024;
constexpr size_t WS_SSQPE = 1 * MiB + 320 * 1024;
constexpr size_t WS_SSQKN = 1 * MiB + 512 * 1024;
constexpr size_t WS_SSQA = 2 * MiB;
constexpr size_t WS_KCF = 3 * MiB;
constexpr size_t WS_VCF = 3 * MiB + 256 * 1024;
constexpr size_t WS_CW2 = 3 * MiB + 512 * 1024;
constexpr size_t WS_WIN = 4 * MiB;
constexpr size_t WS_WQB = 13 * MiB;
constexpr size_t WS_WKVB = 15 * MiB;
constexpr size_t WS_WO = 16 * MiB;
constexpr size_t WS_WOUT = 18 * MiB;
constexpr size_t WS_WGU = 20 * MiB;
constexpr size_t WS_WD = 31 * MiB;
constexpr size_t WS_CW1 = 37 * MiB;
constexpr size_t WS_R0 = 40 * MiB;
constexpr size_t WS_R1 = 72 * MiB;
constexpr size_t WS_R2 = 104 * MiB;
constexpr size_t WS_QN = 168 * MiB;
constexpr size_t WS_KC = 184 * MiB, WS_VC = 188 * MiB, WS_KS = 192 * MiB, WS_VS = 196 * MiB, WS_KW = 200 * MiB, WS_VW = 204 * MiB;
constexpr size_t WS_KPE = 208 * MiB;
constexpr size_t WS_GN = 209 * MiB;
constexpr size_t WS_KN = 210 * MiB;
constexpr size_t WS_VM = 226 * MiB;
constexpr size_t WS_CMPH = 244 * MiB;
constexpr size_t WS_ROPE = 248 * MiB;
constexpr size_t WS_HID = 168 * MiB;
constexpr size_t WS_END = 256 * MiB;

struct Params {
    const float* in[30];
    float* out;
    unsigned char* ws;
};
enum { I_X = 0, I_C, I_POS, I_ADAW, I_ADAB, I_N1G, I_WIN, I_QAG, I_WQB, I_KVAG, I_WKVB, I_MQG, I_MKG, I_NQG, I_NKCG, I_NKSG, I_NKWG,
       I_CPK, I_CW1K, I_CW2K, I_CPV, I_CW1V, I_CW2V, I_WOM, I_WON, I_WOUT, I_N2G, I_WG, I_WU, I_WDN };

template <class T> DI T* wsp(const Params& p, size_t off) { return (T*)(p.ws + off); }

DI unsigned f2bf(float f) { unsigned u = __float_as_uint(f); return (u + 0x7fffu + ((u >> 16) & 1u)) >> 16; }
DI unsigned pk2(float lo, float hi) { return f2bf(lo) | (f2bf(hi) << 16); }
DI float bf2f(unsigned short b) { return __uint_as_float(((unsigned)b) << 16); }
DI float bflo(unsigned w) { return __uint_as_float(w << 16); }
DI float bfhi(unsigned w) { return __uint_as_float(w & 0xffff0000u); }
DI void unpack8(const u32x4 w, float (&f)[8]) { f[0] = bflo(w.x); f[1] = bfhi(w.x); f[2] = bflo(w.y); f[3] = bfhi(w.y); f[4] = bflo(w.z); f[5] = bfhi(w.z); f[6] = bflo(w.w); f[7] = bfhi(w.w); }
DI u32x4 pack8(const float (&f)[8]) { u32x4 w; w.x = pk2(f[0], f[1]); w.y = pk2(f[2], f[3]); w.z = pk2(f[4], f[5]); w.w = pk2(f[6], f[7]); return w; }
DI float sigmoidf(float x) { return 1.0f / (1.0f + __expf(-x)); }
DI float siluf(float x) { return x / (1.0f + __expf(-x)); }
DI float wave_sum(float v) {
#pragma unroll
    for (int o = 1; o < 64; o <<= 1) v += __shfl_xor(v, o);
    return v;
}
DI void sincos_rad(float ang, float& c, float& s) {
    double rev = (double)ang * 0.15915494309189535; rev -= __builtin_rint(rev);
    const float fr = (float)rev; s = __builtin_amdgcn_sinf(fr); c = __builtin_amdgcn_cosf(fr);
}
#define LAS __attribute__((address_space(3)))
DI void transpose_item(const float* W, int ldw, int c0, int ncols, const float* rs, bf16_t* dst, int ldd, int n0, int k0, float* scr, int lane) {
    if (c0 >= 0) {
#pragma unroll 8
        for (int i = 0; i < 32; ++i) { const int kk = 2 * i + (lane >> 5), cc = lane & 31;
            float v = (cc < ncols) ? W[(size_t)(k0 + kk) * ldw + c0 + cc] : 0.f; if (rs) v *= rs[k0 + kk]; scr[kk * 33 + cc] = v; }
    } else {
#pragma unroll 8
        for (int i = 0; i < 32; ++i) { const int kk = 2 * i + (lane >> 5), cc = lane & 31; scr[kk * 33 + cc] = 0.f; }
    }
    __builtin_amdgcn_s_waitcnt(0xc07f);
    asm volatile("" ::: "memory");
    const int c = lane & 7;
#pragma unroll
    for (int j = 0; j < 4; ++j) { const int n = (lane >> 3) + 8 * j; const float* s = scr + (8 * c) * 33 + n;
        u32x4 o; o.x = pk2(s[0 * 33], s[1 * 33]); o.y = pk2(s[2 * 33], s[3 * 33]); o.z = pk2(s[4 * 33], s[5 * 33]); o.w = pk2(s[6 * 33], s[7 * 33]);
        *(u32x4*)(dst + (size_t)(n0 + n) * ldd + k0 + 8 * c) = o; }
    __builtin_amdgcn_s_waitcnt(0xc07f);
    asm volatile("" ::: "memory");
}
DI int zsrc(int s, int L0, int& ncols) {
    ncols = 32;
    if (s < 16) return 64 * s + L0;
    if (s == 16) { if (L0 == 0) return O_KPE; ncols = 24; return O_GN; }
    if (s < 25) return O_QN + 64 * (s - 17) + L0;
    if (s < 27) return O_KC + 64 * (s - 25) + L0;
    if (s < 29) return O_VC + 64 * (s - 27) + L0;
    if (s < 31) return O_KS + 64 * (s - 29) + L0;
    if (s < 33) return O_VS + 64 * (s - 31) + L0;
    if (s < 35) return O_KW + 64 * (s - 33) + L0;
    if (s < 37) return O_VW + 64 * (s - 35) + L0;
    if (s < 40) return -1;
    if (s < 56) return O_GM + 64 * (s - 40) + L0;
    return O_GNM + 64 * (s - 56) + L0;
}
DI void stage_weights(const Params& p, int gw, int ngw, float* scr, int lane) {
    constexpr int I_IN = (ZN / 32) * (DM / 64);
    constexpr int I_QB = (768 / 32) * (768 / 64);
    constexpr int I_KVB = (1024 / 32) * (256 / 64);
    constexpr int I_O = (1024 / 32) * (1024 / 64);
    constexpr int I_OUT = I_O;
    constexpr int I_GU = (5632 / 32) * (1024 / 64);
    constexpr int I_D = (1024 / 32) * (DFF / 64);
    constexpr int I_C1 = 2 * (256 / 32) * (2048 / 64);
    constexpr int NITEMS = I_IN + I_QB + I_KVB + I_O + I_OUT + I_GU + I_D + I_C1;
    for (int it = gw; it < NITEMS; it += ngw) {
        int r = it;
        if (r < I_IN) { const int nb = r / 16, kb = r % 16; const int pn = nb >> 3, bj = (nb >> 2) & 1, wc = nb & 3; int nc; const int c0 = zsrc(4 * pn + wc, 32 * bj, nc);
            transpose_item(p.in[I_WIN], D_IN, c0, nc, nullptr, wsp<bf16_t>(p, WS_WIN), DM, nb * 32, kb * 64, scr, lane); continue; } r -= I_IN;
        if (r < I_QB) { const int nb = r / 12, kb = r % 12; transpose_item(p.in[I_WQB], 768, nb * 32, 32, p.in[I_QAG], wsp<bf16_t>(p, WS_WQB), 768, nb * 32, kb * 64, scr, lane); continue; } r -= I_QB;
        if (r < I_KVB) { const int nb = r / 4, kb = r % 4; const int pn = nb >> 3, bj = (nb >> 2) & 1, wc = nb & 3, s = 4 * pn + wc;
            const int c0 = (s < 8) ? (128 * s + 32 * bj) : (128 * (s - 8) + 64 + 32 * bj);
            transpose_item(p.in[I_WKVB], 1024, c0, 32, p.in[I_KVAG], wsp<bf16_t>(p, WS_WKVB), 256, nb * 32, kb * 64, scr, lane); continue; } r -= I_KVB;
        if (r < I_O) { const int nb = r / 16, kb = r % 16;
            if (kb < 8) transpose_item(p.in[I_WOM], 1024, nb * 32, 32, nullptr, wsp<bf16_t>(p, WS_WO), 1024, nb * 32, kb * 64, scr, lane);
            else transpose_item(p.in[I_WON] - (size_t)512 * 1024, 1024, nb * 32, 32, nullptr, wsp<bf16_t>(p, WS_WO), 1024, nb * 32, kb * 64, scr, lane);
            continue; } r -= I_O;
        if (r < I_OUT) { const int nb = r / 16, kb = r % 16; transpose_item(p.in[I_WOUT], 1024, nb * 32, 32, nullptr, wsp<bf16_t>(p, WS_WOUT), 1024, nb * 32, kb * 64, scr, lane); continue; } r -= I_OUT;
        if (r < I_GU) { const int nb = r / 16, kb = r % 16; const int pn = nb >> 3, bj = (nb >> 2) & 1, wc = nb & 3, s = 4 * pn + wc;
            transpose_item(bj ? p.in[I_WU] : p.in[I_WG], DFF, 32 * s, 32, nullptr, wsp<bf16_t>(p, WS_WGU), 1024, nb * 32, kb * 64, scr, lane); continue; } r -= I_GU;
        if (r < I_D) { const int nb = r / 44, kb = r % 44; transpose_item(p.in[I_WDN], 1024, nb * 32, 32, nullptr, wsp<bf16_t>(p, WS_WD), DFF, nb * 32, kb * 64, scr, lane); continue; } r -= I_D;
        { const int kv = r / 256, rr = r % 256, nb = rr / 32, kb = rr % 32;
          transpose_item(kv ? p.in[I_CW1V] : p.in[I_CW1K], 256, nb * 32, 32, nullptr, wsp<bf16_t>(p, WS_CW1) + (size_t)kv * 256 * 2048, 2048, nb * 32, kb * 64, scr, lane); }
    }
}
DI void stage_mod(const Params& p, int bid, int nb, float* lds) {
    const int tid = threadIdx.x, wave = tid >> 6, lane = tid & 63, nwv = blockDim.x >> 6;
    for (int u = bid; u < 104; u += nb) {
        float acc[8];
#pragma unroll
        for (int b = 0; b < 8; ++b) acc[b] = 0.f;
        if (u < 96) {
            const int n = u * 64 + lane; const float* W = p.in[I_ADAW]; const float* c = p.in[I_C];
            for (int k = wave * (1024 / nwv); k < (wave + 1) * (1024 / nwv); ++k) { const float w = W[(size_t)k * 6144 + n];
#pragma unroll
                for (int b = 0; b < 8; ++b) acc[b] += siluf(c[b * 1024 + k]) * w; }
        } else {
            const int kv = (u - 96) >> 2, n = ((u - 96) & 3) * 64 + lane; const float* W = kv ? p.in[I_CW1V] : p.in[I_CW1K]; const float* pos = kv ? p.in[I_CPV] : p.in[I_CPK];
            for (int k = wave * (2048 / nwv); k < (wave + 1) * (2048 / nwv); ++k) acc[0] += pos[k] * W[(size_t)k * 256 + n];
        }
        __syncthreads();
#pragma unroll
        for (int b = 0; b < 8; ++b) lds[(wave * 8 + b) * 64 + lane] = acc[b];
        __syncthreads();
        if (wave == 0) {
#pragma unroll
            for (int b = 0; b < 8; ++b) { float s = 0.f;
                for (int w = 0; w < nwv; ++w) s += lds[(w * 8 + b) * 64 + lane];
                if (u < 96) wsp<float>(p, WS_MOD)[b * 6144 + u * 64 + lane] = s + p.in[I_ADAB][u * 64 + lane];
                else if (b == 0) wsp<float>(p, WS_CB1)[(u - 96) * 64 + lane] = s; }
        }
    }
    __syncthreads();
}
DI void stage_rope(const Params& p, int gtid, int ngt) {
    float* T = wsp<float>(p, WS_ROPE); const int* pos = (const int*)p.in[I_POS];
    for (int i = gtid; i < MT * 24; i += ngt) {
        const int row = i / 24, j = i % 24; const float ps = (float)pos[row]; float inv, c, s;
        if (j < 16) inv = (float)pow(500000.0, -(double)j / 16.0); else inv = (float)pow(500000.0, -(double)(j - 16) / 8.0);
        sincos_rad(ps * inv, c, s);
        if (j < 16) { T[(size_t)row * 16 + j] = c; T[(size_t)MT * 16 + (size_t)row * 16 + j] = s; }
        else { T[(size_t)MT * 32 + (size_t)row * 8 + (j - 16)] = c; T[(size_t)MT * 40 + (size_t)row * 8 + (j - 16)] = s; }
    }
}
DI const float* ropeCM(const Params& p) { return wsp<float>(p, WS_ROPE); }
DI const float* ropeSM(const Params& p) { return wsp<float>(p, WS_ROPE) + (size_t)MT * 16; }
DI const float* ropeCN(const Params& p) { return wsp<float>(p, WS_ROPE) + (size_t)MT * 32; }
DI const float* ropeSN(const Params& p) { return wsp<float>(p, WS_ROPE) + (size_t)MT * 40; }

DI void stage_normmod(const float* X, const float* gain, const float* mod, int sh_idx, int sc_idx, bf16_t* Hout, int gw, int ngw, int lane) {
    for (int m = gw; m < MT; m += ngw) {
        const int b = m / SEQ; const f32x4* xr = (const f32x4*)(X + (size_t)m * DM) + lane;
        f32x4 v[4]; float s = 0.f;
#pragma unroll
        for (int j = 0; j < 4; ++j) { v[j] = xr[64 * j]; s += (v[j].x * v[j].x + v[j].y * v[j].y) + (v[j].z * v[j].z + v[j].w * v[j].w); }
        const float rstd = rsqrtf(wave_sum(s) * (1.f / DM) + EPS);
        const f32x4* g4 = (const f32x4*)gain + lane; const f32x4* sc4 = (const f32x4*)(mod + b * 6144 + sc_idx * 1024) + lane; const f32x4* sh4 = (const f32x4*)(mod + b * 6144 + sh_idx * 1024) + lane;
        u32x2* o8 = (u32x2*)(Hout + (size_t)m * DM) + lane;
#pragma unroll
        for (int j = 0; j < 4; ++j) { const f32x4 g = g4[64 * j], sc = sc4[64 * j], sh = sh4[64 * j];
            const f32x4 y = v[j] * rstd * g * (1.0f + sc) + sh; u32x2 w; w.x = pk2(y.x, y.y); w.y = pk2(y.z, y.w); o8[64 * j] = w; }
    }
}
DI void store8bf(bf16_t* dst, const float (&f)[8]) { *(u32x4*)dst = pack8(f); }
DI float ssq16(const float (&v)[2][8]) { float q = 0.f;
#pragma unroll
    for (int b = 0; b < 2; ++b)
#pragma unroll
        for (int j = 0; j < 8; ++j) q += v[b][j] * v[b][j];
    q += __shfl_xor(q, 16); q += __shfl_xor(q, 32); return q; }

struct EpiZ {
    static constexpr bool HAS_MID = false; static constexpr int NTYPES = 7;
    Params p;
    DI void mid(int, int, int, int, float (&)[2][8]) const {}
    DI int type(int pn, int wc) const { const int s = 4 * pn + wc;
        if (s < 16) return 0; if (s == 16) return 1; if (s < 25) return 2; if (s < 37) { const int t = (s - 25) >> 1; return (t == 2 || t == 4) ? 3 : 4; } if (s < 40) return 5; return 6; }
    DI void normrope(int row, int fq, float (&v)[2][8], const float* gain, float post, bf16_t* dst) const {
        const float rstd = rsqrtf(ssq16(v) * (1.f / 64.f) + EPS);
#pragma unroll
        for (int b = 0; b < 2; ++b) { const f32x4 g0 = *(const f32x4*)(gain + 32 * b + 8 * fq), g1 = *(const f32x4*)(gain + 32 * b + 8 * fq + 4);
            v[b][0] *= rstd * g0.x; v[b][1] *= rstd * g0.y; v[b][2] *= rstd * g0.z; v[b][3] *= rstd * g0.w; v[b][4] *= rstd * g1.x; v[b][5] *= rstd * g1.y; v[b][6] *= rstd * g1.z; v[b][7] *= rstd * g1.w; }
        const float* cs = ropeCN(p) + (size_t)row * 8; const float* sn = ropeSN(p) + (size_t)row * 8;
#pragma unroll
        for (int j = 0; j < 8; ++j) { const float own = v[0][j], oth = __shfl_xor(own, 16); const float c = cs[j], s = sn[j];
            if (fq == 0) v[0][j] = own * c - oth * s; else if (fq == 1) v[0][j] = own * c + oth * s; }
#pragma unroll
        for (int b = 0; b < 2; ++b) {
#pragma unroll
            for (int j = 0; j < 8; ++j) v[b][j] *= post;
            store8bf(dst + 32 * b + 8 * fq, v[b]); }
    }
    template <int T> DI void apply(int row, int pn, int wc, int fq, float (&v)[2][8]) const {
        const int s = 4 * pn + wc;
        if constexpr (T == 0) {
            bf16_t* d = wsp<bf16_t>(p, WS_R1) + (size_t)row * 1024 + 64 * s + 8 * fq;
            const float q = ssq16(v); store8bf(d, v[0]); store8bf(d + 32, v[1]);
            if (fq == 0) wsp<float>(p, WS_SSQA)[(size_t)row * 16 + s] = q;
        } else if constexpr (T == 1) {
            float q = 0.f;
#pragma unroll
            for (int j = 0; j < 8; ++j) q += v[0][j] * v[0][j];
            q += __shfl_xor(q, 16); q += __shfl_xor(q, 32);
            if (fq == 0) wsp<float>(p, WS_SSQPE)[row] = q;
            const float* kg = p.in[I_MKG] + 64 + 8 * fq; const int i0 = 8 * (fq & 1);
            const float* cs = ropeCM(p) + (size_t)row * 16 + i0; const float* sn = ropeSM(p) + (size_t)row * 16 + i0;
            float o[8];
#pragma unroll
            for (int j = 0; j < 8; ++j) { const float own = v[0][j] * kg[j], oth = __shfl_xor(own, 32); o[j] = (fq < 2) ? own * cs[j] - oth * sn[j] : own * cs[j] + oth * sn[j]; }
            store8bf(wsp<bf16_t>(p, WS_KPE) + (size_t)row * 32 + 8 * fq, o);
#pragma unroll
            for (int j = 0; j < 8; ++j) o[j] = sigmoidf(v[1][j]);
            store8bf(wsp<bf16_t>(p, WS_GN) + (size_t)row * 32 + 8 * fq, o);
        } else if constexpr (T == 2) {
            normrope(row, fq, v, p.in[I_NQG], C2N, wsp<bf16_t>(p, WS_QN) + (size_t)row * 512 + 64 * (s - 17));
        } else if constexpr (T == 3 || T == 4) {
            const int t = (s - 25) >> 1, g = (s - 25) & 1;
            bf16_t* d = wsp<bf16_t>(p, WS_KC + (size_t)t * 4 * MiB) + (size_t)row * 128 + 64 * g;
            if constexpr (T == 3) normrope(row, fq, v, (t == 2) ? p.in[I_NKSG] : p.in[I_NKWG], 1.0f, d);
            else { store8bf(d + 8 * fq, v[0]); store8bf(d + 32 + 8 * fq, v[1]); }
        } else if constexpr (T == 5) {
        } else {
            bf16_t* d = wsp<bf16_t>(p, WS_R2) + (size_t)row * 2048 + 64 * (s - 40) + 8 * fq;
#pragma unroll
            for (int b = 0; b < 2; ++b) { float o[8];
#pragma unroll
                for (int j = 0; j < 8; ++j) o[j] = sigmoidf(v[b][j]);
                store8bf(d + 32 * b, o); }
        }
    }
};
struct EpiQ {
    static constexpr bool HAS_MID = false; static constexpr int NTYPES = 1;
    Params p;
    DI int type(int, int) const { return 0; }
    DI void mid(int, int, int, int, float (&)[2][8]) const {}
    template <int T> DI void apply(int row, int pn, int wc, int fq, float (&v)[2][8]) const {
        const float* sq = wsp<float>(p, WS_SSQA) + (size_t)row * 16; float s = 0.f;
#pragma unroll
        for (int i = 0; i < 12; ++i) s += sq[i];
        const float rstd = rsqrtf(s * (1.f / 768.f) + EPS);
        bf16_t* d = wsp<bf16_t>(p, WS_R0) + (size_t)row * 768 + 256 * pn + 32 * wc + 8 * fq;
#pragma unroll
        for (int b = 0; b < 2; ++b) { float o[8];
#pragma unroll
            for (int j = 0; j < 8; ++j) o[j] = v[b][j] * rstd;
            store8bf(d + 128 * b, o); }
    }
};
struct EpiKV {
    static constexpr bool HAS_MID = false; static constexpr int NTYPES = 1;
    Params p;
    DI int type(int, int) const { return 0; }
    DI void mid(int, int, int, int, float (&)[2][8]) const {}
    template <int T> DI void apply(int row, int pn, int wc, int fq, float (&v)[2][8]) const {
        const int s = 4 * pn + wc;
        const float* sq = wsp<float>(p, WS_SSQA) + (size_t)row * 16 + 12;
        const float rstd = rsqrtf(((sq[0] + sq[1]) + (sq[2] + sq[3])) * (1.f / 256.f) + EPS);
#pragma unroll
        for (int b = 0; b < 2; ++b)
#pragma unroll
            for (int j = 0; j < 8; ++j) v[b][j] *= rstd;
        if (s < 8) { const float q = ssq16(v); if (fq == 0) wsp<float>(p, WS_SSQKN)[(size_t)row * 8 + s] = q;
            bf16_t* d = wsp<bf16_t>(p, WS_KN) + (size_t)row * 512 + 64 * s + 8 * fq; store8bf(d, v[0]); store8bf(d + 32, v[1]); }
        else { bf16_t* d = wsp<bf16_t>(p, WS_VM) + (size_t)row * 512 + 64 * (s - 8) + 8 * fq; store8bf(d, v[0]); store8bf(d + 32, v[1]); }
    }
};
struct EpiMerge {
    static constexpr bool HAS_MID = true; static constexpr int NTYPES = 1;
    Params p;
    DI int type(int, int) const { return 0; }
    DI void mid(int row, int pn, int wc, int fq, float (&v)[2][8]) const {
        const bf16_t* g = wsp<bf16_t>(p, WS_R2) + (size_t)row * 2048 + 256 * pn + 32 * wc + 8 * fq;
#pragma unroll
        for (int b = 0; b < 2; ++b) { float s1[8], s2[8]; unpack8(*(const u32x4*)(g + 128 * b), s1); unpack8(*(const u32x4*)(g + 1024 + 128 * b), s2);
#pragma unroll
            for (int j = 0; j < 8; ++j) v[b][j] *= s1[j] * __builtin_amdgcn_rcpf(s2[j]); }
    }
    template <int T> DI void apply(int row, int pn, int wc, int fq, float (&v)[2][8]) const {
        const bf16_t* g = wsp<bf16_t>(p, WS_R2) + (size_t)row * 2048 + 1024 + 256 * pn + 32 * wc + 8 * fq;
        bf16_t* d = wsp<bf16_t>(p, WS_R0) + (size_t)row * 1024 + 256 * pn + 32 * wc + 8 * fq;
#pragma unroll
        for (int b = 0; b < 2; ++b) { float s2[8], o[8]; unpack8(*(const u32x4*)(g + 128 * b), s2);
#pragma unroll
            for (int j = 0; j < 8; ++j) o[j] = v[b][j] * s2[j];
            store8bf(d + 128 * b, o); }
    }
};
struct EpiOut {
    static constexpr bool HAS_MID = false; static constexpr int NTYPES = 1;
    Params p;
    DI int type(int, int) const { return 0; }
    DI void mid(int, int, int, int, float (&)[2][8]) const {}
    template <int T> DI void apply(int row, int pn, int wc, int fq, float (&v)[2][8]) const {
        const int b_ = row / SEQ, col = 256 * pn + 32 * wc + 8 * fq;
        const float* gt = wsp<float>(p, WS_MOD) + b_ * 6144 + 2 * 1024 + col; const float* x = p.in[I_X] + (size_t)row * DM + col; float* d = wsp<float>(p, WS_R2) + (size_t)row * DM + col;
#pragma unroll
        for (int b = 0; b < 2; ++b)
#pragma unroll
            for (int h = 0; h < 2; ++h) { const f32x4 g = *(const f32x4*)(gt + 128 * b + 4 * h), xv = *(const f32x4*)(x + 128 * b + 4 * h);
                f32x4 o; o.x = xv.x + g.x * v[b][4 * h]; o.y = xv.y + g.y * v[b][4 * h + 1]; o.z = xv.z + g.z * v[b][4 * h + 2]; o.w = xv.w + g.w * v[b][4 * h + 3]; *(f32x4*)(d + 128 * b + 4 * h) = o; }
    }
};
struct EpiGU {
    static constexpr bool HAS_MID = false; static constexpr int NTYPES = 1;
    Params p;
    DI int type(int, int) const { return 0; }
    DI void mid(int, int, int, int, float (&)[2][8]) const {}
    template <int T> DI void apply(int row, int pn, int wc, int fq, float (&v)[2][8]) const {
        const int s = 4 * pn + wc; float o[8];
#pragma unroll
        for (int j = 0; j < 8; ++j) o[j] = siluf(v[0][j]) * v[1][j];
        store8bf(wsp<bf16_t>(p, WS_HID) + (size_t)row * DFF + 32 * s + 8 * fq, o);
    }
};
struct EpiDown {
    static constexpr bool HAS_MID = false; static constexpr int NTYPES = 1;
    Params p;
    DI int type(int, int) const { return 0; }
    DI void mid(int, int, int, int, float (&)[2][8]) const {}
    template <int T> DI void apply(int row, int pn, int wc, int fq, float (&v)[2][8]) const {
        const int b_ = row / SEQ, col = 256 * pn + 32 * wc + 8 * fq;
        const float* gt = wsp<float>(p, WS_MOD) + b_ * 6144 + 5 * 1024 + col; const float* x = wsp<float>(p, WS_R2) + (size_t)row * DM + col; float* d = p.out + (size_t)row * DM + col;
#pragma unroll
        for (int b = 0; b < 2; ++b)
#pragma unroll
            for (int h = 0; h < 2; ++h) { const f32x4 g = *(const f32x4*)(gt + 128 * b + 4 * h), xv = *(const f32x4*)(x + 128 * b + 4 * h);
                f32x4 o; o.x = xv.x + g.x * v[b][4 * h]; o.y = xv.y + g.y * v[b][4 * h + 1]; o.z = xv.z + g.z * v[b][4 * h + 2]; o.w = xv.w + g.w * v[b][4 * h + 3]; *(f32x4*)(d + 128 * b + 4 * h) = o; }
    }
};

template <class Epi, int T> DI void apply_dispatch(const Epi& E, int ty, int row, int pn, int wc, int fq, float (&v)[2][8]) {
    if constexpr (T < Epi::NTYPES) { if (ty == T) E.template apply<T>(row, pn, wc, fq, v); else apply_dispatch<Epi, T + 1>(E, ty, row, pn, wc, fq, v); }
}
template <class Epi>
DI void gemm_naive(const bf16_t* A, int lda, const bf16_t* Bt, int ldb, int M, int N, int K, int kmid, const Epi& E, int gw, int ngw) {
    const int lane = threadIdx.x & 63, fr = lane & 15, fq = lane >> 4;
    const int nslots = N / 64; const long total = (long)(M / 16) * nslots;
    for (long u = gw; u < total; u += ngw) {
        const int rg = (int)(u / nslots), s = (int)(u % nslots), pn = s >> 2, wc = s & 3, row = rg * 16 + fr;
        float v[2][8];
#pragma unroll
        for (int b = 0; b < 2; ++b)
#pragma unroll
            for (int j = 0; j < 8; ++j) v[b][j] = 0.f;
        const bf16_t* a = A + (size_t)row * lda; const bf16_t* bb = Bt + (size_t)(256 * pn + 32 * wc + 8 * fq) * ldb;
        for (int k = 0; k < K; k += 8) {
            if (Epi::HAS_MID && k == kmid) E.mid(row, pn, wc, fq, v);
            float af[8]; unpack8(*(const u32x4*)(a + k), af);
#pragma unroll
            for (int b = 0; b < 2; ++b)
#pragma unroll
                for (int j = 0; j < 8; ++j) { float bf[8]; unpack8(*(const u32x4*)(bb + (size_t)(128 * b + j) * ldb + k), bf); float d = 0.f;
#pragma unroll
                    for (int e = 0; e < 8; ++e) d += af[e] * bf[e];
                    v[b][j] += d; }
        }
        apply_dispatch<Epi, 0>(E, E.type(pn, wc), row, pn, wc, fq, v);
    }
}
namespace pg8 {
#define PG8_LAS __attribute__((address_space(3)))
typedef short bf16x8 __attribute__((ext_vector_type(8)));
constexpr int BM = 256, BK = 64, HALF = 128, HTB = HALF * BK * 2  , STAGE_BYTES = 8 * HTB, NXCD = 8, WGM = 8;

__host__ __device__ __forceinline__ int lds_byte(int r, int c) { const int st = (r >> 4) * 2 + (c >> 5), rr = r & 15, cc = c & 31, ob = rr * 64 + cc * 2; return st * 1024 + (ob ^ (((ob >> 9) & 1) << 5)); }
__host__ __device__ __forceinline__ void stage_rc(int b, int& R, int& C) { const int st = b / 1024, sb = b % 1024, swz = sb ^ (((sb >> 9) & 1) << 5); R = (st >> 1) * 16 + swz / 64; C = (st & 1) * 32 + (swz % 64) / 2; }
__host__ __device__ __forceinline__ int perm32(int rho) { const int n = rho >> 4, i = rho & 15; return 8 * (i >> 2) + 4 * n + (i & 3); }

struct Unit { int pm, pn; };
struct Gemm { const bf16_t* A; const bf16_t* Bt; int M, N, K, lda; };

struct StaticOrder {
    int nM, nN, nwg, G, c;
    __host__ __device__ void init(int M, int N, int G_, int c_) { nM = M / BM; nN = N / BM; nwg = nM * nN; G = G_; c = c_; }
    __host__ __device__ bool next(int i, Unit& u) const {
        const long L = (long)i * G + c; if (L >= nwg) return false;
        int wgid = (int)L; { const int q = nwg / NXCD, r = nwg % NXCD, xcd = wgid % NXCD, off = wgid / NXCD; wgid = (xcd < r ? xcd * (q + 1) : r * (q + 1) + (xcd - r) * q) + off; }
        const int nig = WGM * nN, gid = wgid / nig, fm = gid * WGM, gsz = (nM - fm) < WGM ? (nM - fm) : WGM;
        u.pm = fm + ((wgid % nig) % gsz); u.pn = (wgid % nig) / gsz; return true;
    }
    __device__ __forceinline__ void a_ready(const Unit&) const {}
    __device__ __forceinline__ void done(const Unit&) const {}
};

template <class Epi, class Sched, bool ALIGN_EPI = false, bool SP2 = false>
__device__ __forceinline__ void gemm_phase(PG8_LAS unsigned char* lds, const Gemm g, const Sched& S, const Epi& E) {
    const int tid = threadIdx.x, wid = __builtin_amdgcn_readfirstlane(tid >> 6), lane = tid & 63, wr = wid >> 2, wc = wid & 3, fr = lane & 15, fq = lane >> 4;
    const int K = g.K, nt = K / BK;
    unsigned voffA[2], voffB[2];
#pragma unroll
    for (int i = 0; i < 2; ++i) { int R, C; stage_rc(tid * 16 + i * 8192, R, C); const int Rb = Epi::PERM ? ((R & ~31) + perm32(R & 31)) : R;
        voffA[i] = (unsigned)(R * g.lda + C) * 2u; voffB[i] = (unsigned)(Rb * K + C) * 2u; }
    const size_t kstep = (size_t)(BK * 2);
    const size_t hstepB = (size_t)HALF * K * 2, hstepA = (size_t)HALF * g.lda * 2;
    const size_t tstepB = 2 * hstepB, tstepA = 2 * hstepA;
    const unsigned ldsw = (unsigned)wid * 1024u;
    const int aoff = lds_byte(wr * 64 + fr, fq * 8), boff = lds_byte(wc * 32 + fr, fq * 8);
#define PG8_SA(b, h) (((b) * 2 + (h)) * HTB)
#define PG8_SB(b, h) ((4 + (b) * 2 + (h)) * HTB)
#define PG8_STAGE(bufoff, gbase, voff) do { _Pragma("unroll") for (int _i = 0; _i < 2; ++_i) \
        __builtin_amdgcn_global_load_lds((const unsigned*)((const char*)(gbase) + (voff)[_i]), (PG8_LAS unsigned*)(lds + (bufoff) + ldsw + _i * 8192), 16, 0, 0); } while (0)
#define PG8_LDA(dst, b, h) do { _Pragma("unroll") for (int m = 0; m < 4; ++m) _Pragma("unroll") for (int k = 0; k < 2; ++k) dst[m][k] = *(const PG8_LAS bf16x8*)(lds + PG8_SA(b, h) + aoff + m * 2048 + k * 1024); } while (0)
#define PG8_LDB(dst, b, h) do { _Pragma("unroll") for (int n = 0; n < 2; ++n) _Pragma("unroll") for (int k = 0; k < 2; ++k) dst[n][k] = *(const PG8_LAS bf16x8*)(lds + PG8_SB(b, h) + boff + n * 2048 + k * 1024); } while (0)
#define PG8_MMA(ai, bj, At, Bt) do { __builtin_amdgcn_s_setprio(1); _Pragma("unroll") for (int m = 0; m < 4; ++m) _Pragma("unroll") for (int n = 0; n < 2; ++n) _Pragma("unroll") for (int k = 0; k < 2; ++k) \
        acc[ai][bj][m][n] = __builtin_amdgcn_mfma_f32_16x16x32_bf16(Bt[n][k], At[m][k], acc[ai][bj][m][n], 0, 0, 0); __builtin_amdgcn_s_setprio(0); } while (0)
#define PG8_WAIT_V(n) asm volatile("s_waitcnt vmcnt(" #n ")" ::: "memory")
#define PG8_WAIT_L(n) asm volatile("s_waitcnt lgkmcnt(" #n ")" ::: "memory")
#define PG8_BAR __builtin_amdgcn_s_barrier()
#define PG8_SCHED __builtin_amdgcn_sched_barrier(0)
    Unit cur, nxt; int ui = 0;
    if (!S.next(0, cur)) return;
    f32x4 acc[2][2][4][2];
#pragma unroll
    for (int a = 0; a < 2; ++a)
#pragma unroll
        for (int b = 0; b < 2; ++b)
#pragma unroll
            for (int m = 0; m < 4; ++m)
#pragma unroll
                for (int n = 0; n < 2; ++n) acc[a][b][m][n] = (f32x4){0.f, 0.f, 0.f, 0.f};
    bf16x8 At[4][2], B0[2][2], B1[2][2];
    const char* cA = (const char*)g.A + (size_t)cur.pm * tstepA; const char* cB = (const char*)g.Bt + (size_t)cur.pn * tstepB;
    S.a_ready(cur);
    if constexpr (SP2) {
        PG8_STAGE(PG8_SB(0, 0), cB, voffB); PG8_STAGE(PG8_SB(0, 1), cB + hstepB, voffB); PG8_STAGE(PG8_SA(0, 0), cA, voffA); PG8_STAGE(PG8_SA(0, 1), cA + hstepA, voffA);
        if (wr == 1) PG8_BAR;
        PG8_WAIT_V(2); PG8_BAR;
        PG8_STAGE(PG8_SB(1, 0), cB + kstep, voffB); PG8_STAGE(PG8_SA(1, 0), cA + kstep, voffA); PG8_STAGE(PG8_SB(1, 1), cB + hstepB + kstep, voffB);
        PG8_WAIT_V(6); PG8_BAR;
    } else {
        PG8_STAGE(PG8_SB(0, 0), cB, voffB); PG8_STAGE(PG8_SA(0, 0), cA, voffA); PG8_STAGE(PG8_SB(0, 1), cB + hstepB, voffB); PG8_STAGE(PG8_SA(0, 1), cA + hstepA, voffA);
        if (wr == 1) PG8_BAR;
        PG8_WAIT_V(4); PG8_BAR;
        PG8_STAGE(PG8_SB(1, 0), cB + kstep, voffB); PG8_STAGE(PG8_SA(1, 0), cA + kstep, voffA); PG8_STAGE(PG8_SB(1, 1), cB + hstepB + kstep, voffB);
        PG8_WAIT_V(6); PG8_BAR;
    }
    for (;;) {
        const bool has_next = S.next(ui + 1, nxt);
        const char* nA = has_next ? (const char*)g.A + (size_t)nxt.pm * tstepA : cA; const char* nB = has_next ? (const char*)g.Bt + (size_t)nxt.pn * tstepB : cB;
        for (int hh_ = 0; hh_ < (Epi::HAS_MID ? 2 : 1); ++hh_) {
        if constexpr (Epi::HAS_MID) { if (hh_ == 1) E.mid(acc, cur, wr, wc, fr, fq); }
        const int t0_ = Epi::HAS_MID ? hh_ * (nt >> 1) : 0, t1_ = Epi::HAS_MID ? (hh_ + 1) * (nt >> 1) : nt;
        for (int t = t0_; t < t1_; t += 2) {
            const bool last = (t == nt - 2);
            const char* a1 = cA + (size_t)(t + 1) * kstep;
            const char* a2 = last ? nA : cA + (size_t)(t + 2) * kstep; const char* b2 = last ? nB : cB + (size_t)(t + 2) * kstep;
            const char* a3 = a2 + kstep; const char* b3 = b2 + kstep;
            if (last && has_next) S.a_ready(nxt);
            if constexpr (SP2) {
            PG8_LDB(B0, 0, 0); PG8_LDB(B1, 0, 1); PG8_SCHED; PG8_LDA(At, 0, 0); PG8_STAGE(PG8_SA(1, 1), a1 + hstepA, voffA);
            PG8_WAIT_V(8); PG8_WAIT_L(0); PG8_BAR; PG8_MMA(0, 0, At, B0); PG8_MMA(0, 1, At, B1); PG8_BAR; PG8_SCHED;
            PG8_LDA(At, 0, 1); PG8_STAGE(PG8_SB(0, 0), b2, voffB); PG8_STAGE(PG8_SB(0, 1), b2 + hstepB, voffB); PG8_STAGE(PG8_SA(0, 0), a2, voffA);
            PG8_WAIT_V(8); PG8_WAIT_L(0); PG8_BAR; PG8_MMA(1, 0, At, B0); PG8_MMA(1, 1, At, B1); PG8_BAR; PG8_SCHED;
            PG8_LDB(B0, 1, 0); PG8_LDB(B1, 1, 1); PG8_SCHED; PG8_LDA(At, 1, 0); PG8_STAGE(PG8_SA(0, 1), a2 + hstepA, voffA);
            PG8_WAIT_V(8); PG8_WAIT_L(0); PG8_BAR; PG8_MMA(0, 0, At, B0); PG8_MMA(0, 1, At, B1); PG8_BAR; PG8_SCHED;
            PG8_LDA(At, 1, 1); PG8_STAGE(PG8_SB(1, 0), b3, voffB); PG8_STAGE(PG8_SB(1, 1), b3 + hstepB, voffB); PG8_STAGE(PG8_SA(1, 0), a3, voffA);
            PG8_WAIT_V(8); PG8_WAIT_L(0); PG8_BAR; PG8_MMA(1, 0, At, B0); PG8_MMA(1, 1, At, B1); PG8_BAR; PG8_SCHED;
            } else {
            PG8_LDB(B0, 0, 0); PG8_SCHED; PG8_LDA(At, 0, 0); PG8_STAGE(PG8_SA(1, 1), a1 + hstepA, voffA);
            PG8_WAIT_L(8); PG8_BAR; PG8_WAIT_L(0); PG8_MMA(0, 0, At, B0); PG8_BAR; PG8_SCHED;
            PG8_LDB(B1, 0, 1); PG8_STAGE(PG8_SB(0, 0), b2, voffB);
            PG8_BAR; PG8_WAIT_L(0); PG8_MMA(0, 1, At, B1); PG8_BAR;
            PG8_LDA(At, 0, 1); PG8_STAGE(PG8_SA(0, 0), a2, voffA);
            PG8_BAR; PG8_WAIT_L(0); PG8_MMA(1, 0, At, B0); PG8_BAR; PG8_SCHED;
            PG8_STAGE(PG8_SB(0, 1), b2 + hstepB, voffB);
            PG8_WAIT_V(6); PG8_BAR; PG8_MMA(1, 1, At, B1); PG8_BAR;
            PG8_LDB(B0, 1, 0); PG8_SCHED; PG8_LDA(At, 1, 0); PG8_STAGE(PG8_SA(0, 1), a2 + hstepA, voffA);
            PG8_WAIT_L(8); PG8_BAR; PG8_WAIT_L(0); PG8_MMA(0, 0, At, B0); PG8_BAR; PG8_SCHED;
            PG8_LDB(B1, 1, 1); PG8_STAGE(PG8_SB(1, 0), b3, voffB);
            PG8_BAR; PG8_WAIT_L(0); PG8_MMA(0, 1, At, B1); PG8_BAR;
            PG8_LDA(At, 1, 1); PG8_STAGE(PG8_SA(1, 0), a3, voffA);
            PG8_BAR; PG8_WAIT_L(0); PG8_MMA(1, 0, At, B0); PG8_BAR; PG8_SCHED;
            PG8_STAGE(PG8_SB(1, 1), b3 + hstepB, voffB);
            PG8_WAIT_V(6); PG8_BAR; PG8_MMA(1, 1, At, B1); PG8_BAR;
            }
        }
        }
        if constexpr (ALIGN_EPI) { if (wr == 0) PG8_BAR; }
        if constexpr (!Epi::AFTER_DRAIN) { E(acc, cur, wr, wc, fr, fq); S.done(cur); }
        if (!has_next) break;
#pragma unroll
        for (int a = 0; a < 2; ++a)
#pragma unroll
            for (int b = 0; b < 2; ++b)
#pragma unroll
                for (int m = 0; m < 4; ++m)
#pragma unroll
                    for (int n = 0; n < 2; ++n) acc[a][b][m][n] = (f32x4){0.f, 0.f, 0.f, 0.f};
        cur = nxt; cA = nA; cB = nB; ++ui;
        if constexpr (ALIGN_EPI) { if (wr == 1) PG8_BAR; }
    }
    PG8_WAIT_V(0);
    if constexpr (!ALIGN_EPI) { if (wr == 0) PG8_BAR; }
    PG8_BAR;
    if constexpr (Epi::AFTER_DRAIN) { E.fused(acc, cur, wr, wc, fr, fq, lds, wid, lane); S.done(cur); }
#undef PG8_SA
#undef PG8_SB
#undef PG8_STAGE
#undef PG8_LDA
#undef PG8_LDB
#undef PG8_MMA
#undef PG8_WAIT_V
#undef PG8_WAIT_L
#undef PG8_BAR
#undef PG8_SCHED
}
}

template <class SE> struct EpiAdapt {
    static constexpr bool PERM = true, AFTER_DRAIN = false, HAS_MID = SE::HAS_MID;
    SE se;
    template <int T> DI void run(f32x4 (&acc)[2][2][4][2], const pg8::Unit& u, int wr, int wc, int fr, int fq) const {
#pragma unroll
        for (int ai = 0; ai < 2; ++ai)
#pragma unroll
            for (int m = 0; m < 4; ++m) {
                int row = u.pm * 256 + ai * 128 + wr * 64 + m * 16 + fr; asm volatile("" : "+v"(row)); float v[2][8];
#pragma unroll
                for (int bj = 0; bj < 2; ++bj)
#pragma unroll
                    for (int n = 0; n < 2; ++n) { v[bj][4 * n] = acc[ai][bj][m][n][0]; v[bj][4 * n + 1] = acc[ai][bj][m][n][1]; v[bj][4 * n + 2] = acc[ai][bj][m][n][2]; v[bj][4 * n + 3] = acc[ai][bj][m][n][3]; }
                se.template apply<T>(row, u.pn, wc, fq, v);
                asm volatile("" ::: "memory");
            }
    }
    template <int T> DI void disp(int ty, f32x4 (&acc)[2][2][4][2], const pg8::Unit& u, int wr, int wc, int fr, int fq) const {
        if constexpr (T < SE::NTYPES) { if (ty == T) run<T>(acc, u, wr, wc, fr, fq); else disp<T + 1>(ty, acc, u, wr, wc, fr, fq); }
    }
    DI void operator()(f32x4 (&acc)[2][2][4][2], const pg8::Unit& u, int wr, int wc, int fr, int fq) const { disp<0>(se.type(u.pn, wc), acc, u, wr, wc, fr, fq); }
    DI void mid(f32x4 (&acc)[2][2][4][2], const pg8::Unit& u, int wr, int wc, int fr, int fq) const {
#pragma unroll
        for (int ai = 0; ai < 2; ++ai)
#pragma unroll
            for (int m = 0; m < 4; ++m) {
                int row = u.pm * 256 + ai * 128 + wr * 64 + m * 16 + fr; asm volatile("" : "+v"(row)); float v[2][8];
#pragma unroll
                for (int bj = 0; bj < 2; ++bj)
#pragma unroll
                    for (int n = 0; n < 2; ++n) { v[bj][4 * n] = acc[ai][bj][m][n][0]; v[bj][4 * n + 1] = acc[ai][bj][m][n][1]; v[bj][4 * n + 2] = acc[ai][bj][m][n][2]; v[bj][4 * n + 3] = acc[ai][bj][m][n][3]; }
                se.mid(row, u.pn, wc, fq, v);
                asm volatile("" ::: "memory");
#pragma unroll
                for (int bj = 0; bj < 2; ++bj)
#pragma unroll
                    for (int n = 0; n < 2; ++n) { acc[ai][bj][m][n][0] = v[bj][4 * n]; acc[ai][bj][m][n][1] = v[bj][4 * n + 1]; acc[ai][bj][m][n][2] = v[bj][4 * n + 2]; acc[ai][bj][m][n][3] = v[bj][4 * n + 3]; }
            }
    }
};
template <class SE> DI void gemm_fast(PG8_LAS unsigned char* lds, const bf16_t* A, int lda, const bf16_t* Bt, int M, int N, int K, const SE& se, int G, int c) {
    pg8::Gemm g{A, Bt, M, N, K, lda}; pg8::StaticOrder S; S.init(M, N, G, c);
    EpiAdapt<SE> E{se};
    pg8::gemm_phase<EpiAdapt<SE>, pg8::StaticOrder, true, true>(lds, g, S, E);
}
DI void cmp_hidden_naive(const Params& p, int gtid, int ngt) {
    float* H = wsp<float>(p, WS_CMPH);
    for (int idx = gtid; idx < 2 * 2 * 1024 * 256; idx += ngt) {
        const int j = idx & 255, r = (idx >> 8) & 1023, g = (idx >> 18) & 1, kv = idx >> 19;
        if ((r & 127) == 127) { H[idx] = 0.f; continue; }
        const bf16_t* src = wsp<bf16_t>(p, kv ? WS_VC : WS_KC) + (size_t)(16 * r) * 128 + g * 64;
        const bf16_t* w = wsp<bf16_t>(p, WS_CW1) + (size_t)kv * 256 * 2048 + (size_t)j * 2048;
        float acc = 0.f;
        for (int l = 0; l < 32; ++l)
#pragma unroll
            for (int d8 = 0; d8 < 8; ++d8) { float a[8], b[8]; unpack8(*(const u32x4*)(src + l * 128 + d8 * 8), a); unpack8(*(const u32x4*)(w + l * 64 + d8 * 8), b);
#pragma unroll
                for (int e = 0; e < 8; ++e) acc += a[e] * b[e]; }
        H[idx] = siluf(acc + wsp<float>(p, WS_CB1)[kv * 256 + j]);
    }
}
DI void cmp_out(const Params& p, int gw, int ngw, int lane) {
    const float* H = wsp<float>(p, WS_CMPH);
    for (int u = gw; u < 2 * 2 * 1024; u += ngw) {
        const int r = u & 1023, g = (u >> 10) & 1, kv = u >> 11; const int b = r >> 7, n = r & 127;
        bf16_t* dst = wsp<bf16_t>(p, kv ? WS_VCF : WS_KCF) + (size_t)r * 128 + g * 64 + lane;
        if (n == 127) { *dst = 0; continue; }
        const float* h = H + (size_t)u * 256; const float* w2 = (kv ? p.in[I_CW2V] : p.in[I_CW2K]) + lane;
        float acc = 0.f;
        for (int j = 0; j < 256; ++j) acc += h[j] * w2[j * 64];
        if (kv == 0) {
            const float rstd = rsqrtf(wave_sum(acc * acc) * (1.f / 64.f) + EPS);
            float y = acc * rstd * p.in[I_NKCG][lane];
            const int prow = b * SEQ + 16 * n + 31; const float oth = __shfl_xor(y, 8);
            if (lane < 16) { const float c = ropeCN(p)[(size_t)prow * 8 + (lane & 7)], s = ropeSN(p)[(size_t)prow * 8 + (lane & 7)]; y = (lane < 8) ? y * c - oth * s : y * c + oth * s; }
            acc = y;
        }
        *dst = (bf16_t)f2bf(acc);
    }
}

DI unsigned select_blocks(const float (&imp)[32], int cur) {
    if (cur < 8) return (2u << cur) - 1u;
    unsigned mask = 1u | (1u << cur) | (1u << (cur - 1));
#pragma unroll 1
    for (int it = 0; it < 5; ++it) {
        float best = -1.0f; int bi = 1;
#pragma unroll
        for (int j = 1; j < 32; ++j) { const bool ok = (j <= cur - 2) && !((mask >> j) & 1u); if (ok && imp[j] > best) { best = imp[j]; bi = j; } }
        mask |= 1u << bi;
    }
    return mask;
}

DI float dot64(const float (&q)[64], const bf16_t* k) { float acc = 0.f;
#pragma unroll
    for (int c = 0; c < 8; ++c) { float kf[8]; unpack8(*(const u32x4*)(k + 8 * c), kf);
#pragma unroll
        for (int e = 0; e < 8; ++e) acc += q[8 * c + e] * kf[e]; }
    return acc; }
DI void axpy64(float (&o)[64], float pw, const bf16_t* v) {
#pragma unroll
    for (int c = 0; c < 8; ++c) { float vf[8]; unpack8(*(const u32x4*)(v + 8 * c), vf);
#pragma unroll
        for (int e = 0; e < 8; ++e) o[8 * c + e] += pw * vf[e]; } }
DI void nsa_naive(const Params& p, int bid, int nb, float* lds) {
    float* impL = lds + threadIdx.x * 33;
    const bf16_t* QN = wsp<bf16_t>(p, WS_QN); const bf16_t* KCF = wsp<bf16_t>(p, WS_KCF); const bf16_t* VCF = wsp<bf16_t>(p, WS_VCF);
    const bf16_t* KS = wsp<bf16_t>(p, WS_KS); const bf16_t* VS = wsp<bf16_t>(p, WS_VS); const bf16_t* KW = wsp<bf16_t>(p, WS_KW); const bf16_t* VW = wsp<bf16_t>(p, WS_VW);
    const bf16_t* GN = wsp<bf16_t>(p, WS_GN); bf16_t* OC = wsp<bf16_t>(p, WS_R1);
    for (int idx = bid * blockDim.x + threadIdx.x; idx < MT * 2; idx += nb * blockDim.x) {
        const int t = idx & (SEQ - 1), g = (idx >> 11) & 1, b = idx >> 12; const int row = b * SEQ + t, cur = t >> 6;
        const int nvalid = (t >= 31) ? ((t - 31) >> 4) + 1 : 0;
        for (int j = 0; j < 32; ++j) impL[j] = 0.f;
        float q[64];
        for (int r = 0; r < 4; ++r) {
#pragma unroll
            for (int c = 0; c < 8; ++c) { float f[8]; unpack8(*(const u32x4*)(QN + (size_t)row * 512 + (g * 4 + r) * 64 + 8 * c), f);
#pragma unroll
                for (int e = 0; e < 8; ++e) q[8 * c + e] = f[e]; }
            float m = -INFINITY;
            for (int n = 0; n < nvalid; ++n) m = fmaxf(m, dot64(q, KCF + (size_t)(b * 128 + n) * 128 + g * 64));
            float l = 0.f;
            for (int n = 0; n < nvalid; ++n) l += __builtin_amdgcn_exp2f(dot64(q, KCF + (size_t)(b * 128 + n) * 128 + g * 64) - m);
            const float rl = (nvalid > 0) ? 1.f / l : 0.f;
            for (int n = 0; n < nvalid; ++n) { const float pw = __builtin_amdgcn_exp2f(dot64(q, KCF + (size_t)(b * 128 + n) * 128 + g * 64) - m) * rl;
                impL[n >> 2] += pw; if ((n & 3) == 3 && (n >> 2) + 1 < 32) impL[(n >> 2) + 1] += pw; }
        }
        float imp[32];
#pragma unroll
        for (int j = 0; j < 32; ++j) imp[j] = impL[j];
        const unsigned mask = select_blocks(imp, cur);
        for (int r = 0; r < 4; ++r) {
            const int hh = g * 4 + r;
#pragma unroll
            for (int c = 0; c < 8; ++c) { float f[8]; unpack8(*(const u32x4*)(QN + (size_t)row * 512 + hh * 64 + 8 * c), f);
#pragma unroll
                for (int e = 0; e < 8; ++e) q[8 * c + e] = f[e]; }
            float ot[64];
#pragma unroll
            for (int d = 0; d < 64; ++d) ot[d] = 0.f;
            const float g0 = bf2f(GN[(size_t)row * 32 + hh * 3 + 0]), g1 = bf2f(GN[(size_t)row * 32 + hh * 3 + 1]), g2 = bf2f(GN[(size_t)row * 32 + hh * 3 + 2]);
            for (int br = 0; br < 3; ++br) {
                float o[64];
#pragma unroll
                for (int d = 0; d < 64; ++d) o[d] = 0.f;
                float m = -INFINITY, l = 0.f;
                if (br == 0) {
                    for (int n = 0; n < nvalid; ++n) { const float s = dot64(q, KCF + (size_t)(b * 128 + n) * 128 + g * 64);
                        if (s > m) { const float f = __builtin_amdgcn_exp2f(m - s); l *= f;
#pragma unroll
                            for (int d = 0; d < 64; ++d) o[d] *= f;
                            m = s; }
                        const float pw = __builtin_amdgcn_exp2f(s - m); l += pw; axpy64(o, pw, VCF + (size_t)(b * 128 + n) * 128 + g * 64); }
                } else {
                    const int k0 = (br == 1) ? 0 : ((t - 255 > 0) ? t - 255 : 0);
                    for (int k = k0; k <= t; ++k) {
                        if (br == 1 && !((mask >> (k >> 6)) & 1u)) { k |= 63; continue; }
                        const size_t kr = (size_t)(b * SEQ + k) * 128 + g * 64;
                        const float s = dot64(q, (br == 1 ? KS : KW) + kr);
                        if (s > m) { const float f = __builtin_amdgcn_exp2f(m - s); l *= f;
#pragma unroll
                            for (int d = 0; d < 64; ++d) o[d] *= f;
                            m = s; }
                        const float pw = __builtin_amdgcn_exp2f(s - m); l += pw; axpy64(o, pw, (br == 1 ? VS : VW) + kr); }
                }
                const float gg = (br == 0 ? g0 : br == 1 ? g1 : g2) * ((l > 0.f) ? 1.f / l : 0.f);
#pragma unroll
                for (int d = 0; d < 64; ++d) ot[d] += gg * o[d];
            }
#pragma unroll
            for (int c = 0; c < 8; ++c) { float f[8];
#pragma unroll
                for (int e = 0; e < 8; ++e) f[e] = ot[8 * c + e];
                *(u32x4*)(OC + (size_t)row * 1024 + 512 + hh * 64 + 8 * c) = pack8(f); }
        }
    }
}

DI void mla_qprep(const Params& p, int row, int h, float (&q)[96]) {
    const bf16_t* src = wsp<bf16_t>(p, WS_R0) + (size_t)row * 768 + h * 96; float ss = 0.f;
#pragma unroll
    for (int c = 0; c < 12; ++c) { float f[8]; unpack8(*(const u32x4*)(src + 8 * c), f);
#pragma unroll
        for (int e = 0; e < 8; ++e) { q[8 * c + e] = f[e]; ss += f[e] * f[e]; } }
    const float rstd = rsqrtf(ss * (1.f / 96.f) + EPS); const float* qg = p.in[I_MQG]; const float* kg = p.in[I_MKG];
#pragma unroll
    for (int d = 0; d < 96; ++d) q[d] *= rstd * qg[d];
    const float* cs = ropeCM(p) + (size_t)row * 16; const float* sn = ropeSM(p) + (size_t)row * 16;
#pragma unroll
    for (int i = 0; i < 16; ++i) { const float x1 = q[64 + i], x2 = q[80 + i]; q[64 + i] = x1 * cs[i] - x2 * sn[i]; q[80 + i] = x2 * cs[i] + x1 * sn[i]; }
#pragma unroll
    for (int d = 0; d < 64; ++d) q[d] *= kg[d] * C2M;
#pragma unroll
    for (int d = 64; d < 96; ++d) q[d] *= C2M;
}
DI void mla_naive(const Params& p, int gtid, int ngt) {
    const bf16_t* KN = wsp<bf16_t>(p, WS_KN); const bf16_t* KPE = wsp<bf16_t>(p, WS_KPE); const bf16_t* VM = wsp<bf16_t>(p, WS_VM);
    const float* sqk = wsp<float>(p, WS_SSQKN); const float* sqp = wsp<float>(p, WS_SSQPE); bf16_t* OC = wsp<bf16_t>(p, WS_R1);
    for (int idx = gtid; idx < MT * 8; idx += ngt) {
        const int t = idx & (SEQ - 1), h = (idx >> 11) & 7, b = idx >> 14; const int row = b * SEQ + t;
        float q[96]; mla_qprep(p, row, h, q);
        float o[64];
#pragma unroll
        for (int d = 0; d < 64; ++d) o[d] = 0.f;
        float m = -INFINITY, l = 0.f;
        for (int k = 0; k <= t; ++k) {
            const int kr = b * SEQ + k; const bf16_t* kn = KN + (size_t)kr * 512 + h * 64; const bf16_t* kp = KPE + (size_t)kr * 32; float acc = 0.f;
#pragma unroll
            for (int c = 0; c < 8; ++c) { float kf[8]; unpack8(*(const u32x4*)(kn + 8 * c), kf);
#pragma unroll
                for (int e = 0; e < 8; ++e) acc += q[8 * c + e] * kf[e]; }
#pragma unroll
            for (int c = 0; c < 4; ++c) { float kf[8]; unpack8(*(const u32x4*)(kp + 8 * c), kf);
#pragma unroll
                for (int e = 0; e < 8; ++e) acc += q[64 + 8 * c + e] * kf[e]; }
            const float s = acc * rsqrtf((sqk[(size_t)kr * 8 + h] + sqp[kr]) * (1.f / 96.f) + EPS);
            if (s > m) { const float f = __builtin_amdgcn_exp2f(m - s); l *= f;
#pragma unroll
                for (int d = 0; d < 64; ++d) o[d] *= f;
                m = s; }
            const float pw = __builtin_amdgcn_exp2f(s - m); l += pw; axpy64(o, pw, VM + (size_t)kr * 512 + h * 64);
        }
        const float rl = 1.f / l;
#pragma unroll
        for (int c = 0; c < 8; ++c) { float f[8];
#pragma unroll
            for (int e = 0; e < 8; ++e) f[e] = o[8 * c + e] * rl;
            *(u32x4*)(OC + (size_t)row * 1024 + h * 64 + 8 * c) = pack8(f); }
    }
}
enum { ST_P0 = 0, ST_NORM1, ST_GEMM_Z, ST_GEMM_Q, ST_GEMM_KV, ST_CMP_H, ST_CMP_O, ST_MLA, ST_NSA, ST_GEMM_MERGE, ST_GEMM_OUT, ST_NORM2, ST_GEMM_GU, ST_GEMM_DOWN };
constexpr int LDS_BYTES = 147456;

template <int ST> __global__ void __launch_bounds__(256) stage_kernel(Params p) {
    __shared__ __attribute__((aligned(16))) float lds[256 * 34];
    const int tid = threadIdx.x, lane = tid & 63, wave = tid >> 6, nwv = blockDim.x >> 6;
    const int gw = blockIdx.x * nwv + wave, ngw = gridDim.x * nwv, gtid = blockIdx.x * blockDim.x + tid, ngt = gridDim.x * blockDim.x;
    if constexpr (ST == ST_P0) { stage_weights(p, gw, ngw, lds + wave * (64 * 33), lane); __syncthreads(); stage_mod(p, blockIdx.x, gridDim.x, lds); stage_rope(p, gtid, ngt); }
    if constexpr (ST == ST_NORM1) stage_normmod(p.in[I_X], p.in[I_N1G], wsp<float>(p, WS_MOD), 0, 1, wsp<bf16_t>(p, WS_R0), gw, ngw, lane);
    if constexpr (ST == ST_CMP_H) cmp_hidden_naive(p, gtid, ngt);
    if constexpr (ST == ST_CMP_O) cmp_out(p, gw, ngw, lane);
    if constexpr (ST == ST_MLA) mla_naive(p, gtid, ngt);
    if constexpr (ST == ST_NSA) nsa_naive(p, blockIdx.x, gridDim.x, lds);
    if constexpr (ST == ST_NORM2) stage_normmod(wsp<float>(p, WS_R2), p.in[I_N2G], wsp<float>(p, WS_MOD), 3, 4, wsp<bf16_t>(p, WS_R1), gw, ngw, lane);
}
template <int ST> __global__ void __launch_bounds__(512, 2) gemm_kernel(Params p) {
    extern __shared__ __attribute__((aligned(16))) unsigned char dlds[];
    PG8_LAS unsigned char* lds = (PG8_LAS unsigned char*)dlds; const int G = gridDim.x, c = blockIdx.x;
    if constexpr (ST == ST_GEMM_Z) { EpiZ E{p}; gemm_fast(lds, wsp<bf16_t>(p, WS_R0), 1024, wsp<bf16_t>(p, WS_WIN), MT, ZN, 1024, E, G, c); }
    if constexpr (ST == ST_GEMM_Q) { EpiQ E{p}; gemm_fast(lds, wsp<bf16_t>(p, WS_R1), 1024, wsp<bf16_t>(p, WS_WQB), MT, 768, 768, E, G, c); }
    if constexpr (ST == ST_GEMM_KV) { EpiKV E{p}; gemm_fast(lds, wsp<bf16_t>(p, WS_R1) + 768, 1024, wsp<bf16_t>(p, WS_WKVB), MT, 1024, 256, E, G, c); }
    if constexpr (ST == ST_GEMM_MERGE) { EpiMerge E{p}; gemm_fast(lds, wsp<bf16_t>(p, WS_R1), 1024, wsp<bf16_t>(p, WS_WO), MT, 1024, 1024, E, G, c); }
    if constexpr (ST == ST_GEMM_OUT) { EpiOut E{p}; gemm_fast(lds, wsp<bf16_t>(p, WS_R0), 1024, wsp<bf16_t>(p, WS_WOUT), MT, 1024, 1024, E, G, c); }
    if constexpr (ST == ST_GEMM_GU) { EpiGU E{p}; gemm_fast(lds, wsp<bf16_t>(p, WS_R1), 1024, wsp<bf16_t>(p, WS_WGU), MT, 5632, 1024, E, G, c); }
    if constexpr (ST == ST_GEMM_DOWN) { EpiDown E{p}; gemm_fast(lds, wsp<bf16_t>(p, WS_HID), DFF, wsp<bf16_t>(p, WS_WD), MT, 1024, DFF, E, G, c); }
}

extern "C" void kernel_launch(void* const* d_in, const int* in_sizes, int n_in, void* d_out, int out_size, void* d_ws, size_t ws_size, hipStream_t stream) {
    if (n_in != 30 || out_size != MT * DM || ws_size < WS_END) { fprintf(stderr, "kernel_launch: unexpected shapes (n_in %d out %d ws %zu)\n", n_in, out_size, ws_size); return; }
    Params p{};
    for (int i = 0; i < 30; ++i) p.in[i] = (const float*)d_in[i];
    p.out = (float*)d_out; p.ws = (unsigned char*)d_ws;
    static bool attr_done = false;
#define GATTR(ST) hipFuncSetAttribute((const void*)gemm_kernel<ST>, hipFuncAttributeMaxDynamicSharedMemorySize, LDS_BYTES)
    if (!attr_done) { GATTR(ST_GEMM_Z); GATTR(ST_GEMM_Q); GATTR(ST_GEMM_KV); GATTR(ST_GEMM_MERGE); GATTR(ST_GEMM_OUT); GATTR(ST_GEMM_GU); GATTR(ST_GEMM_DOWN); attr_done = true; }
    const int G = 2048;
#define LAUNCH(ST) hipLaunchKernelGGL(stage_kernel<ST>, dim3(G), dim3(256), 0, stream, p)
#define GLAUNCH(ST) hipLaunchKernelGGL(gemm_kernel<ST>, dim3(256), dim3(512), LDS_BYTES, stream, p)
    LAUNCH(ST_P0); LAUNCH(ST_NORM1); GLAUNCH(ST_GEMM_Z); GLAUNCH(ST_GEMM_Q); GLAUNCH(ST_GEMM_KV); LAUNCH(ST_CMP_H); LAUNCH(ST_CMP_O);
    LAUNCH(ST_MLA); LAUNCH(ST_NSA); GLAUNCH(ST_GEMM_MERGE); GLAUNCH(ST_GEMM_OUT); LAUNCH(ST_NORM2); GLAUNCH(ST_GEMM_GU); GLAUNCH(ST_GEMM_DOWN);
#undef LAUNCH
}
```

```cpp
#include <hip/hip_runtime.h>
#include <hip/hip_cooperative_groups.h>
#include <cstdint>
#include <cstdio>
namespace cg = cooperative_groups;

typedef unsigned short bf16_t;
typedef unsigned u32x4 __attribute__((ext_vector_type(4)));
typedef unsigned u32x2 __attribute__((ext_vector_type(2)));
typedef float f32x4 __attribute__((ext_vector_type(4)));
typedef float f32x2 __attribute__((ext_vector_type(2)));
#define DI __device__ __forceinline__

constexpr int NB = 8, SEQ = 2048, DM = 1024, MT = NB * SEQ;
constexpr int DFF = 2816, NMOD = 6;
constexpr int ZN = 4608;
constexpr float EPS = 1e-6f;
constexpr float LOG2E = 1.4426950408889634f;
constexpr float C2N = 0.125f * LOG2E;
constexpr float C2M = 0.10206207261596575f * LOG2E;
constexpr int NTHR = 512, NWAVE = 8;
constexpr int O_CQ = 0, O_CKV = 768, O_KPE = 1024, O_QN = 1056, O_KC = 1568, O_VC = 1696, O_KS = 1824, O_VS = 1952, O_KW = 2080, O_VW = 2208,
              O_GN = 2336, O_GM = 2360, O_GNM = 3384, D_IN = 4408;

constexpr size_t MiB = 1u << 20;
constexpr size_t WS_CTL = 0;
constexpr size_t WS_MOD = 1 * MiB;
constexpr size_t WS_CB1 = 1 * MiB + 256 * 1024;
constexpr size_t WS_SSQPE = 1 * MiB + 320 * 1024;
constexpr size_t WS_SSQKN = 1 * MiB + 512 * 1024;
constexpr size_t WS_SSQA = 2 * MiB;
constexpr size_t WS_KCF = 3 * MiB;
constexpr size_t WS_VCF = 3 * MiB + 256 * 1024;
constexpr size_t WS_CW2 = 3 * MiB + 512 * 1024;
constexpr size_t WS_WIN = 4 * MiB;
constexpr size_t WS_WQB = 13 * MiB;
constexpr size_t WS_WKVB = 15 * MiB;
constexpr size_t WS_WO = 16 * MiB;
constexpr size_t WS_WOUT = 18 * MiB;
constexpr size_t WS_WGU = 20 * MiB;
constexpr size_t WS_WD = 31 * MiB;
constexpr size_t WS_CW1 = 37 * MiB;
constexpr size_t WS_R0 = 40 * MiB;
constexpr size_t WS_R1 = 72 * MiB;
constexpr size_t WS_R2 = 104 * MiB;
constexpr size_t WS_QN = 168 * MiB;
constexpr size_t WS_KC = 184 * MiB, WS_VC = 188 * MiB, WS_KS = 192 * MiB, WS_VS = 196 * MiB, WS_KW = 200 * MiB, WS_VW = 204 * MiB;
constexpr size_t WS_KPE = 208 * MiB;
constexpr size_t WS_GN = 209 * MiB;
constexpr size_t WS_KN = 210 * MiB;
constexpr size_t WS_VM = 226 * MiB;
constexpr size_t WS_CMPH = 244 * MiB;
constexpr size_t WS_ROPE = 248 * MiB;
constexpr size_t WS_HID = 168 * MiB;
constexpr size_t WS_END = 256 * MiB;

struct Params {
    const float* in[30];
    float* out;
    unsigned char* ws;
};
enum { I_X = 0, I_C, I_POS, I_ADAW, I_ADAB, I_N1G, I_WIN, I_QAG, I_WQB, I_KVAG, I_WKVB, I_MQG, I_MKG, I_NQG, I_NKCG, I_NKSG, I_NKWG,
       I_CPK, I_CW1K, I_CW2K, I_CPV, I_CW1V, I_CW2V, I_WOM, I_WON, I_WOUT, I_N2G, I_WG, I_WU, I_WDN };

template <class T> DI T* wsp(const Params& p, size_t off) { return (T*)(p.ws + off); }

DI unsigned f2bf(float f) { unsigned u = __float_as_uint(f); return (u + 0x7fffu + ((u >> 16) & 1u)) >> 16; }
DI unsigned pk2(float lo, float hi) { return f2bf(lo) | (f2bf(hi) << 16); }
DI float bf2f(unsigned short b) { return __uint_as_float(((unsigned)b) << 16); }
DI float bflo(unsigned w) { return __uint_as_float(w << 16); }
DI float bfhi(unsigned w) { return __uint_as_float(w & 0xffff0000u); }
DI void unpack8(const u32x4 w, float (&f)[8]) { f[0] = bflo(w.x); f[1] = bfhi(w.x); f[2] = bflo(w.y); f[3] = bfhi(w.y); f[4] = bflo(w.z); f[5] = bfhi(w.z); f[6] = bflo(w.w); f[7] = bfhi(w.w); }
DI u32x4 pack8(const float (&f)[8]) { u32x4 w; w.x = pk2(f[0], f[1]); w.y = pk2(f[2], f[3]); w.z = pk2(f[4], f[5]); w.w = pk2(f[6], f[7]); return w; }
DI float sigmoidf(float x) { return 1.0f / (1.0f + __expf(-x)); }
DI float siluf(float x) { return x / (1.0f + __expf(-x)); }
DI float wave_sum(float v) {
#pragma unroll
    for (int o = 1; o < 64; o <<= 1) v += __shfl_xor(v, o);
    return v;
}
DI void sincos_rad(float ang, float& c, float& s) {
    double rev = (double)ang * 0.15915494309189535; rev -= __builtin_rint(rev);
    const float fr = (float)rev; s = __builtin_amdgcn_sinf(fr); c = __builtin_amdgcn_cosf(fr);
}
#define LAS __attribute__((address_space(3)))
DI void transpose_item(const float* W, int ldw, int c0, int ncols, const float* rs, bf16_t* dst, int ldd, int n0, int k0, float* scr, int lane) {
    if (c0 >= 0) {
#pragma unroll 8
        for (int i = 0; i < 32; ++i) { const int kk = 2 * i + (lane >> 5), cc = lane & 31;
            float v = (cc < ncols) ? W[(size_t)(k0 + kk) * ldw + c0 + cc] : 0.f; if (rs) v *= rs[k0 + kk]; scr[kk * 33 + cc] = v; }
    } else {
#pragma unroll 8
        for (int i = 0; i < 32; ++i) { const int kk = 2 * i + (lane >> 5), cc = lane & 31; scr[kk * 33 + cc] = 0.f; }
    }
    __builtin_amdgcn_s_waitcnt(0xc07f);
    asm volatile("" ::: "memory");
    const int c = lane & 7;
#pragma unroll
    for (int j = 0; j < 4; ++j) { const int n = (lane >> 3) + 8 * j; const float* s = scr + (8 * c) * 33 + n;
        u32x4 o; o.x = pk2(s[0 * 33], s[1 * 33]); o.y = pk2(s[2 * 33], s[3 * 33]); o.z = pk2(s[4 * 33], s[5 * 33]); o.w = pk2(s[6 * 33], s[7 * 33]);
        *(u32x4*)(dst + (size_t)(n0 + n) * ldd + k0 + 8 * c) = o; }
    __builtin_amdgcn_s_waitcnt(0xc07f);
    asm volatile("" ::: "memory");
}
DI int zsrc(int s, int L0, int& ncols) {
    ncols = 32;
    if (s < 16) return 64 * s + L0;
    if (s == 16) { if (L0 == 0) return O_KPE; ncols = 24; return O_GN; }
    if (s < 25) return O_QN + 64 * (s - 17) + L0;
    if (s < 27) return O_KC + 64 * (s - 25) + L0;
    if (s < 29) return O_VC + 64 * (s - 27) + L0;
    if (s < 31) return O_KS + 64 * (s - 29) + L0;
    if (s < 33) return O_VS + 64 * (s - 31) + L0;
    if (s < 35) return O_KW + 64 * (s - 33) + L0;
    if (s < 37) return O_VW + 64 * (s - 35) + L0;
    if (s < 40) return -1;
    if (s < 56) return O_GM + 64 * (s - 40) + L0;
    return O_GNM + 64 * (s - 56) + L0;
}
DI void stage_weights(const Params& p, int gw, int ngw, float* scr, int lane) {
    constexpr int I_IN = (ZN / 32) * (DM / 64);
    constexpr int I_QB = (768 / 32) * (768 / 64);
    constexpr int I_KVB = (1024 / 32) * (256 / 64);
    constexpr int I_O = (1024 / 32) * (1024 / 64);
    constexpr int I_OUT = I_O;
    constexpr int I_GU = (5632 / 32) * (1024 / 64);
    constexpr int I_D = (1024 / 32) * (DFF / 64);
    constexpr int I_C1 = 2 * (256 / 32) * (2048 / 64);
    constexpr int NITEMS = I_IN + I_QB + I_KVB + I_O + I_OUT + I_GU + I_D + I_C1;
    for (int it = gw; it < NITEMS; it += ngw) {
        int r = it;
        if (r < I_IN) { const int nb = r / 16, kb = r % 16; const int pn = nb >> 3, bj = (nb >> 2) & 1, wc = nb & 3; int nc; const int c0 = zsrc(4 * pn + wc, 32 * bj, nc);
            transpose_item(p.in[I_WIN], D_IN, c0, nc, nullptr, wsp<bf16_t>(p, WS_WIN), DM, nb * 32, kb * 64, scr, lane); continue; } r -= I_IN;
        if (r < I_QB) { const int nb = r / 12, kb = r % 12; transpose_item(p.in[I_WQB], 768, nb * 32, 32, p.in[I_QAG], wsp<bf16_t>(p, WS_WQB), 768, nb * 32, kb * 64, scr, lane); continue; } r -= I_QB;
        if (r < I_KVB) { const int nb = r / 4, kb = r % 4; const int pn = nb >> 3, bj = (nb >> 2) & 1, wc = nb & 3, s = 4 * pn + wc;
            const int c0 = (s < 8) ? (128 * s + 32 * bj) : (128 * (s - 8) + 64 + 32 * bj);
            transpose_item(p.in[I_WKVB], 1024, c0, 32, p.in[I_KVAG], wsp<bf16_t>(p, WS_WKVB), 256, nb * 32, kb * 64, scr, lane); continue; } r -= I_KVB;
        if (r < I_O) { const int nb = r / 16, kb = r % 16;
            if (kb < 8) transpose_item(p.in[I_WOM], 1024, nb * 32, 32, nullptr, wsp<bf16_t>(p, WS_WO), 1024, nb * 32, kb * 64, scr, lane);
            else transpose_item(p.in[I_WON] - (size_t)512 * 1024, 1024, nb * 32, 32, nullptr, wsp<bf16_t>(p, WS_WO), 1024, nb * 32, kb * 64, scr, lane);
            continue; } r -= I_O;
        if (r < I_OUT) { const int nb = r / 16, kb = r % 16; transpose_item(p.in[I_WOUT], 1024, nb * 32, 32, nullptr, wsp<bf16_t>(p, WS_WOUT), 1024, nb * 32, kb * 64, scr, lane); continue; } r -= I_OUT;
        if (r < I_GU) { const int nb = r / 16, kb = r % 16; const int pn = nb >> 3, bj = (nb >> 2) & 1, wc = nb & 3, s = 4 * pn + wc;
            transpose_item(bj ? p.in[I_WU] : p.in[I_WG], DFF, 32 * s, 32, nullptr, wsp<bf16_t>(p, WS_WGU), 1024, nb * 32, kb * 64, scr, lane); continue; } r -= I_GU;
        if (r < I_D) { const int nb = r / 44, kb = r % 44; transpose_item(p.in[I_WDN], 1024, nb * 32, 32, nullptr, wsp<bf16_t>(p, WS_WD), DFF, nb * 32, kb * 64, scr, lane); continue; } r -= I_D;
        { const int kv = r / 256, rr = r % 256, nb = rr / 32, kb = rr % 32;
          transpose_item(kv ? p.in[I_CW1V] : p.in[I_CW1K], 256, nb * 32, 32, nullptr, wsp<bf16_t>(p, WS_CW1) + (size_t)kv * 256 * 2048, 2048, nb * 32, kb * 64, scr, lane); }
    }
}
DI void stage_mod(const Params& p, int bid, int nb, float* lds) {
    const int tid = threadIdx.x, wave = tid >> 6, lane = tid & 63, nwv = blockDim.x >> 6;
    for (int u = bid; u < 104; u += nb) {
        float acc[8];
#pragma unroll
        for (int b = 0; b < 8; ++b) acc[b] = 0.f;
        if (u < 96) {
            const int n = u * 64 + lane; const float* W = p.in[I_ADAW]; const float* c = p.in[I_C];
            for (int k = wave * (1024 / nwv); k < (wave + 1) * (1024 / nwv); ++k) { const float w = W[(size_t)k * 6144 + n];
#pragma unroll
                for (int b = 0; b < 8; ++b) acc[b] += siluf(c[b * 1024 + k]) * w; }
        } else {
            const int kv = (u - 96) >> 2, n = ((u - 96) & 3) * 64 + lane; const float* W = kv ? p.in[I_CW1V] : p.in[I_CW1K]; const float* pos = kv ? p.in[I_CPV] : p.in[I_CPK];
            for (int k = wave * (2048 / nwv); k < (wave + 1) * (2048 / nwv); ++k) acc[0] += pos[k] * W[(size_t)k * 256 + n];
        }
        __syncthreads();
#pragma unroll
        for (int b = 0; b < 8; ++b) lds[(wave * 8 + b) * 64 + lane] = acc[b];
        __syncthreads();
        if (wave == 0) {
#pragma unroll
            for (int b = 0; b < 8; ++b) { float s = 0.f;
                for (int w = 0; w < nwv; ++w) s += lds[(w * 8 + b) * 64 + lane];
                if (u < 96) wsp<float>(p, WS_MOD)[b * 6144 + u * 64 + lane] = s + p.in[I_ADAB][u * 64 + lane];
                else if (b == 0) wsp<float>(p, WS_CB1)[(u - 96) * 64 + lane] = s; }
        }
    }
    __syncthreads();
}
DI void stage_rope(const Params& p, int gtid, int ngt) {
    float* T = wsp<float>(p, WS_ROPE); const int* pos = (const int*)p.in[I_POS];
    for (int i = gtid; i < MT * 24; i += ngt) {
        const int row = i / 24, j = i % 24; const float ps = (float)pos[row]; float inv, c, s;
        if (j < 16) inv = (float)pow(500000.0, -(double)j / 16.0); else inv = (float)pow(500000.0, -(double)(j - 16) / 8.0);
        sincos_rad(ps * inv, c, s);
        if (j < 16) { T[(size_t)row * 16 + j] = c; T[(size_t)MT * 16 + (size_t)row * 16 + j] = s; }
        else { T[(size_t)MT * 32 + (size_t)row * 8 + (j - 16)] = c; T[(size_t)MT * 40 + (size_t)row * 8 + (j - 16)] = s; }
    }
}
DI const float* ropeCM(const Params& p) { return wsp<float>(p, WS_ROPE); }
DI const float* ropeSM(const Params& p) { return wsp<float>(p, WS_ROPE) + (size_t)MT * 16; }
DI const float* ropeCN(const Params& p) { return wsp<float>(p, WS_ROPE) + (size_t)MT * 32; }
DI const float* ropeSN(const Params& p) { return wsp<float>(p, WS_ROPE) + (size_t)MT * 40; }

DI void stage_normmod(const float* X, const float* gain, const float* mod, int sh_idx, int sc_idx, bf16_t* Hout, int gw, int ngw, int lane) {
    for (int m = gw; m < MT; m += ngw) {
        const int b = m / SEQ; const f32x4* xr = (const f32x4*)(X + (size_t)m * DM) + lane;
        f32x4 v[4]; float s = 0.f;
#pragma unroll
        for (int j = 0; j < 4; ++j) { v[j] = xr[64 * j]; s += (v[j].x * v[j].x + v[j].y * v[j].y) + (v[j].z * v[j].z + v[j].w * v[j].w); }
        const float rstd = rsqrtf(wave_sum(s) * (1.f / DM) + EPS);
        const f32x4* g4 = (const f32x4*)gain + lane; const f32x4* sc4 = (const f32x4*)(mod + b * 6144 + sc_idx * 1024) + lane; const f32x4* sh4 = (const f32x4*)(mod + b * 6144 + sh_idx * 1024) + lane;
        u32x2* o8 = (u32x2*)(Hout + (size_t)m * DM) + lane;
#pragma unroll
        for (int j = 0; j < 4; ++j) { const f32x4 g = g4[64 * j], sc = sc4[64 * j], sh = sh4[64 * j];
            const f32x4 y = v[j] * rstd * g * (1.0f + sc) + sh; u32x2 w; w.x = pk2(y.x, y.y); w.y = pk2(y.z, y.w); o8[64 * j] = w; }
    }
}
DI void store8bf(bf16_t* dst, const float (&f)[8]) { *(u32x4*)dst = pack8(f); }
DI float ssq16(const float (&v)[2][8]) { float q = 0.f;
#pragma unroll
    for (int b = 0; b < 2; ++b)
#pragma unroll
        for (int j = 0; j < 8; ++j) q += v[b][j] * v[b][j];
    q += __shfl_xor(q, 16); q += __shfl_xor(q, 32); return q; }

struct EpiZ {
    static constexpr bool HAS_MID = false; static constexpr int NTYPES = 7;
    Params p;
    DI void mid(int, int, int, int, float (&)[2][8]) const {}
    DI int type(int pn, int wc) const { const int s = 4 * pn + wc;
        if (s < 16) return 0; if (s == 16) return 1; if (s < 25) return 2; if (s < 37) { const int t = (s - 25) >> 1; return (t == 2 || t == 4) ? 3 : 4; } if (s < 40) return 5; return 6; }
    DI void normrope(int row, int fq, float (&v)[2][8], const float* gain, float post, bf16_t* dst) const {
        const float rstd = rsqrtf(ssq16(v) * (1.f / 64.f) + EPS);
#pragma unroll
        for (int b = 0; b < 2; ++b) { const f32x4 g0 = *(const f32x4*)(gain + 32 * b + 8 * fq), g1 = *(const f32x4*)(gain + 32 * b + 8 * fq + 4);
            v[b][0] *= rstd * g0.x; v[b][1] *= rstd * g0.y; v[b][2] *= rstd * g0.z; v[b][3] *= rstd * g0.w; v[b][4] *= rstd * g1.x; v[b][5] *= rstd * g1.y; v[b][6] *= rstd * g1.z; v[b][7] *= rstd * g1.w; }
        const float* cs = ropeCN(p) + (size_t)row * 8; const float* sn = ropeSN(p) + (size_t)row * 8;
#pragma unroll
        for (int j = 0; j < 8; ++j) { const float own = v[0][j], oth = __shfl_xor(own, 16); const float c = cs[j], s = sn[j];
            if (fq == 0) v[0][j] = own * c - oth * s; else if (fq == 1) v[0][j] = own * c + oth * s; }
#pragma unroll
        for (int b = 0; b < 2; ++b) {
#pragma unroll
            for (int j = 0; j < 8; ++j) v[b][j] *= post;
            store8bf(dst + 32 * b + 8 * fq, v[b]); }
    }
    template <int T> DI void apply(int row, int pn, int wc, int fq, float (&v)[2][8]) const {
        const int s = 4 * pn + wc;
        if constexpr (T == 0) {
            bf16_t* d = wsp<bf16_t>(p, WS_R1) + (size_t)row * 1024 + 64 * s + 8 * fq;
            const float q = ssq16(v); store8bf(d, v[0]); store8bf(d + 32, v[1]);
            if (fq == 0) wsp<float>(p, WS_SSQA)[(size_t)row * 16 + s] = q;
        } else if constexpr (T == 1) {
            float q = 0.f;
#pragma unroll
            for (int j = 0; j < 8; ++j) q += v[0][j] * v[0][j];
            q += __shfl_xor(q, 16); q += __shfl_xor(q, 32);
            if (fq == 0) wsp<float>(p, WS_SSQPE)[row] = q;
            const float* kg = p.in[I_MKG] + 64 + 8 * fq; const int i0 = 8 * (fq & 1);
            const float* cs = ropeCM(p) + (size_t)row * 16 + i0; const float* sn = ropeSM(p) + (size_t)row * 16 + i0;
            float o[8];
#pragma unroll
            for (int j = 0; j < 8; ++j) { const float own = v[0][j] * kg[j], oth = __shfl_xor(own, 32); o[j] = (fq < 2) ? own * cs[j] - oth * sn[j] : own * cs[j] + oth * sn[j]; }
            store8bf(wsp<bf16_t>(p, WS_KPE) + (size_t)row * 32 + 8 * fq, o);
#pragma unroll
            for (int j = 0; j < 8; ++j) o[j] = sigmoidf(v[1][j]);
            store8bf(wsp<bf16_t>(p, WS_GN) + (size_t)row * 32 + 8 * fq, o);
        } else if constexpr (T == 2) {
            normrope(row, fq, v, p.in[I_NQG], C2N, wsp<bf16_t>(p, WS_QN) + (size_t)row * 512 + 64 * (s - 17));
        } else if constexpr (T == 3 || T == 4) {
            const int t = (s - 25) >> 1, g = (s - 25) & 1;
            bf16_t* d = wsp<bf16_t>(p, WS_KC + (size_t)t * 4 * MiB) + (size_t)row * 128 + 64 * g;
            if constexpr (T == 3) normrope(row, fq, v, (t == 2) ? p.in[I_NKSG] : p.in[I_NKWG], 1.0f, d);
            else { store8bf(d + 8 * fq, v[0]); store8bf(d + 32 + 8 * fq, v[1]); }
        } else if constexpr (T == 5) {
        } else {
            bf16_t* d = wsp<bf16_t>(p, WS_R2) + (size_t)row * 2048 + 64 * (s - 40) + 8 * fq;
#pragma unroll
            for (int b = 0; b < 2; ++b) { float o[8];
#pragma unroll
                for (int j = 0; j < 8; ++j) o[j] = sigmoidf(v[b][j]);
                store8bf(d + 32 * b, o); }
        }
    }
};
struct EpiQ {
    static constexpr bool HAS_MID = false; static constexpr int NTYPES = 1;
    Params p;
    DI int type(int, int) const { return 0; }
    DI void mid(int, int, int, int, float (&)[2][8]) const {}
    template <int T> DI void apply(int row, int pn, int wc, int fq, float (&v)[2][8]) const {
        const float* sq = wsp<float>(p, WS_SSQA) + (size_t)row * 16; float s = 0.f;
#pragma unroll
        for (int i = 0; i < 12; ++i) s += sq[i];
        const float rstd = rsqrtf(s * (1.f / 768.f) + EPS);
        bf16_t* d = wsp<bf16_t>(p, WS_R0) + (size_t)row * 768 + 256 * pn + 32 * wc + 8 * fq;
#pragma unroll
        for (int b = 0; b < 2; ++b) { float o[8];
#pragma unroll
            for (int j = 0; j < 8; ++j) o[j] = v[b][j] * rstd;
            store8bf(d + 128 * b, o); }
    }
};
struct EpiKV {
    static constexpr bool HAS_MID = false; static constexpr int NTYPES = 1;
    Params p;
    DI int type(int, int) const { return 0; }
    DI void mid(int, int, int, int, float (&)[2][8]) const {}
    template <int T> DI void apply(int row, int pn, int wc, int fq, float (&v)[2][8]) const {
        const int s = 4 * pn + wc;
        const float* sq = wsp<float>(p, WS_SSQA) + (size_t)row * 16 + 12;
        const float rstd = rsqrtf(((sq[0] + sq[1]) + (sq[2] + sq[3])) * (1.f / 256.f) + EPS);
#pragma unroll
        for (int b = 0; b < 2; ++b)
#pragma unroll
            for (int j = 0; j < 8; ++j) v[b][j] *= rstd;
        if (s < 8) { const float q = ssq16(v); if (fq == 0) wsp<float>(p, WS_SSQKN)[(size_t)row * 8 + s] = q;
            bf16_t* d = wsp<bf16_t>(p, WS_KN) + (size_t)row * 512 + 64 * s + 8 * fq; store8bf(d, v[0]); store8bf(d + 32, v[1]); }
        else { bf16_t* d = wsp<bf16_t>(p, WS_VM) + (size_t)row * 512 + 64 * (s - 8) + 8 * fq; store8bf(d, v[0]); store8bf(d + 32, v[1]); }
    }
};
struct EpiMerge {
    static constexpr bool HAS_MID = true; static constexpr int NTYPES = 1;
    Params p;
    DI int type(int, int) const { return 0; }
    DI void mid(int row, int pn, int wc, int fq, float (&v)[2][8]) const {
        const bf16_t* g = wsp<bf16_t>(p, WS_R2) + (size_t)row * 2048 + 256 * pn + 32 * wc + 8 * fq;
#pragma unroll
        for (int b = 0; b < 2; ++b) { float s1[8], s2[8]; unpack8(*(const u32x4*)(g + 128 * b), s1); unpack8(*(const u32x4*)(g + 1024 + 128 * b), s2);
#pragma unroll
            for (int j = 0; j < 8; ++j) v[b][j] *= s1[j] * __builtin_amdgcn_rcpf(s2[j]); }
    }
    template <int T> DI void apply(int row, int pn, int wc, int fq, float (&v)[2][8]) const {
        const bf16_t* g = wsp<bf16_t>(p, WS_R2) + (size_t)row * 2048 + 1024 + 256 * pn + 32 * wc + 8 * fq;
        bf16_t* d = wsp<bf16_t>(p, WS_R0) + (size_t)row * 1024 + 256 * pn + 32 * wc + 8 * fq;
#pragma unroll
        for (int b = 0; b < 2; ++b) { float s2[8], o[8]; unpack8(*(const u32x4*)(g + 128 * b), s2);
#pragma unroll
            for (int j = 0; j < 8; ++j) o[j] = v[b][j] * s2[j];
            store8bf(d + 128 * b, o); }
    }
};
struct EpiOut {
    static constexpr bool HAS_MID = false; static constexpr int NTYPES = 1;
    Params p;
    DI int type(int, int) const { return 0; }
    DI void mid(int, int, int, int, float (&)[2][8]) const {}
    template <int T> DI void apply(int row, int pn, int wc, int fq, float (&v)[2][8]) const {
        const int b_ = row / SEQ, col = 256 * pn + 32 * wc + 8 * fq;
        const float* gt = wsp<float>(p, WS_MOD) + b_ * 6144 + 2 * 1024 + col; const float* x = p.in[I_X] + (size_t)row * DM + col; float* d = wsp<float>(p, WS_R2) + (size_t)row * DM + col;
#pragma unroll
        for (int b = 0; b < 2; ++b)
#pragma unroll
            for (int h = 0; h < 2; ++h) { const f32x4 g = *(const f32x4*)(gt + 128 * b + 4 * h), xv = *(const f32x4*)(x + 128 * b + 4 * h);
                f32x4 o; o.x = xv.x + g.x * v[b][4 * h]; o.y = xv.y + g.y * v[b][4 * h + 1]; o.z = xv.z + g.z * v[b][4 * h + 2]; o.w = xv.w + g.w * v[b][4 * h + 3]; *(f32x4*)(d + 128 * b + 4 * h) = o; }
    }
};
struct EpiGU {
    static constexpr bool HAS_MID = false; static constexpr int NTYPES = 1;
    Params p;
    DI int type(int, int) const { return 0; }
    DI void mid(int, int, int, int, float (&)[2][8]) const {}
    template <int T> DI void apply(int row, int pn, int wc, int fq, float (&v)[2][8]) const {
        const int s = 4 * pn + wc; float o[8];
#pragma unroll
        for (int j = 0; j < 8; ++j) o[j] = siluf(v[0][j]) * v[1][j];
        store8bf(wsp<bf16_t>(p, WS_HID) + (size_t)row * DFF + 32 * s + 8 * fq, o);
    }
};
struct EpiDown {
    static constexpr bool HAS_MID = false; static constexpr int NTYPES = 1;
    Params p;
    DI int type(int, int) const { return 0; }
    DI void mid(int, int, int, int, float (&)[2][8]) const {}
    template <int T> DI void apply(int row, int pn, int wc, int fq, float (&v)[2][8]) const {
        const int b_ = row / SEQ, col = 256 * pn + 32 * wc + 8 * fq;
        const float* gt = wsp<float>(p, WS_MOD) + b_ * 6144 + 5 * 1024 + col; const float* x = wsp<float>(p, WS_R2) + (size_t)row * DM + col; float* d = p.out + (size_t)row * DM + col;
#pragma unroll
        for (int b = 0; b < 2; ++b)
#pragma unroll
            for (int h = 0; h < 2; ++h) { const f32x4 g = *(const f32x4*)(gt + 128 * b + 4 * h), xv = *(const f32x4*)(x + 128 * b + 4 * h);
                f32x4 o; o.x = xv.x + g.x * v[b][4 * h]; o.y = xv.y + g.y * v[b][4 * h + 1]; o.z = xv.z + g.z * v[b][4 * h + 2]; o.w = xv.w + g.w * v[b][4 * h + 3]; *(f32x4*)(d + 128 * b + 4 * h) = o; }
    }
};

template <class Epi, int T> DI void apply_dispatch(const Epi& E, int ty, int row, int pn, int wc, int fq, float (&v)[2][8]) {
    if constexpr (T < Epi::NTYPES) { if (ty == T) E.template apply<T>(row, pn, wc, fq, v); else apply_dispatch<Epi, T + 1>(E, ty, row, pn, wc, fq, v); }
}
template <class Epi>
DI void gemm_naive(const bf16_t* A, int lda, const bf16_t* Bt, int ldb, int M, int N, int K, int kmid, const Epi& E, int gw, int ngw) {
    const int lane = threadIdx.x & 63, fr = lane & 15, fq = lane >> 4;
    const int nslots = N / 64; const long total = (long)(M / 16) * nslots;
    for (long u = gw; u < total; u += ngw) {
        const int rg = (int)(u / nslots), s = (int)(u % nslots), pn = s >> 2, wc = s & 3, row = rg * 16 + fr;
        float v[2][8];
#pragma unroll
        for (int b = 0; b < 2; ++b)
#pragma unroll
            for (int j = 0; j < 8; ++j) v[b][j] = 0.f;
        const bf16_t* a = A + (size_t)row * lda; const bf16_t* bb = Bt + (size_t)(256 * pn + 32 * wc + 8 * fq) * ldb;
        for (int k = 0; k < K; k += 8) {
            if (Epi::HAS_MID && k == kmid) E.mid(row, pn, wc, fq, v);
            float af[8]; unpack8(*(const u32x4*)(a + k), af);
#pragma unroll
            for (int b = 0; b < 2; ++b)
#pragma unroll
                for (int j = 0; j < 8; ++j) { float bf[8]; unpack8(*(const u32x4*)(bb + (size_t)(128 * b + j) * ldb + k), bf); float d = 0.f;
#pragma unroll
                    for (int e = 0; e < 8; ++e) d += af[e] * bf[e];
                    v[b][j] += d; }
        }
        apply_dispatch<Epi, 0>(E, E.type(pn, wc), row, pn, wc, fq, v);
    }
}
namespace pg8 {
#define PG8_LAS __attribute__((address_space(3)))
typedef short bf16x8 __attribute__((ext_vector_type(8)));
constexpr int BM = 256, BK = 64, HALF = 128, HTB = HALF * BK * 2  , STAGE_BYTES = 8 * HTB, NXCD = 8, WGM = 8;

__host__ __device__ __forceinline__ int lds_byte(int r, int c) { const int st = (r >> 4) * 2 + (c >> 5), rr = r & 15, cc = c & 31, ob = rr * 64 + cc * 2; return st * 1024 + (ob ^ (((ob >> 9) & 1) << 5)); }
__host__ __device__ __forceinline__ void stage_rc(int b, int& R, int& C) { const int st = b / 1024, sb = b % 1024, swz = sb ^ (((sb >> 9) & 1) << 5); R = (st >> 1) * 16 + swz / 64; C = (st & 1) * 32 + (swz % 64) / 2; }
__host__ __device__ __forceinline__ int perm32(int rho) { const int n = rho >> 4, i = rho & 15; return 8 * (i >> 2) + 4 * n + (i & 3); }

struct Unit { int pm, pn; };
struct Gemm { const bf16_t* A; const bf16_t* Bt; int M, N, K, lda; };

struct StaticOrder {
    int nM, nN, nwg, G, c;
    __host__ __device__ void init(int M, int N, int G_, int c_) { nM = M / BM; nN = N / BM; nwg = nM * nN; G = G_; c = c_; }
    __host__ __device__ bool next(int i, Unit& u) const {
        const long L = (long)i * G + c; if (L >= nwg) return false;
        int wgid = (int)L; { const int q = nwg / NXCD, r = nwg % NXCD, xcd = wgid % NXCD, off = wgid / NXCD; wgid = (xcd < r ? xcd * (q + 1) : r * (q + 1) + (xcd - r) * q) + off; }
        const int nig = WGM * nN, gid = wgid / nig, fm = gid * WGM, gsz = (nM - fm) < WGM ? (nM - fm) : WGM;
        u.pm = fm + ((wgid % nig) % gsz); u.pn = (wgid % nig) / gsz; return true;
    }
    __device__ __forceinline__ void a_ready(const Unit&) const {}
    __device__ __forceinline__ void done(const Unit&) const {}
};

template <class Epi, class Sched, bool ALIGN_EPI = false, bool SP2 = false>
__device__ __forceinline__ void gemm_phase(PG8_LAS unsigned char* lds, const Gemm g, const Sched& S, const Epi& E) {
    const int tid = threadIdx.x, wid = __builtin_amdgcn_readfirstlane(tid >> 6), lane = tid & 63, wr = wid >> 2, wc = wid & 3, fr = lane & 15, fq = lane >> 4;
    const int K = g.K, nt = K / BK;
    unsigned voffA[2], voffB[2];
#pragma unroll
    for (int i = 0; i < 2; ++i) { int R, C; stage_rc(tid * 16 + i * 8192, R, C); const int Rb = Epi::PERM ? ((R & ~31) + perm32(R & 31)) : R;
        voffA[i] = (unsigned)(R * g.lda + C) * 2u; voffB[i] = (unsigned)(Rb * K + C) * 2u; }
    const size_t kstep = (size_t)(BK * 2);
    const size_t hstepB = (size_t)HALF * K * 2, hstepA = (size_t)HALF * g.lda * 2;
    const size_t tstepB = 2 * hstepB, tstepA = 2 * hstepA;
    const unsigned ldsw = (unsigned)wid * 1024u;
    const int aoff = lds_byte(wr * 64 + fr, fq * 8), boff = lds_byte(wc * 32 + fr, fq * 8);
#define PG8_SA(b, h) (((b) * 2 + (h)) * HTB)
#define PG8_SB(b, h) ((4 + (b) * 2 + (h)) * HTB)
#define PG8_STAGE(bufoff, gbase, voff) do { _Pragma("unroll") for (int _i = 0; _i < 2; ++_i) \
        __builtin_amdgcn_global_load_lds((const unsigned*)((const char*)(gbase) + (voff)[_i]), (PG8_LAS unsigned*)(lds + (bufoff) + ldsw + _i * 8192), 16, 0, 0); } while (0)
#define PG8_LDA(dst, b, h) do { _Pragma("unroll") for (int m = 0; m < 4; ++m) _Pragma("unroll") for (int k = 0; k < 2; ++k) dst[m][k] = *(const PG8_LAS bf16x8*)(lds + PG8_SA(b, h) + aoff + m * 2048 + k * 1024); } while (0)
#define PG8_LDB(dst, b, h) do { _Pragma("unroll") for (int n = 0; n < 2; ++n) _Pragma("unroll") for (int k = 0; k < 2; ++k) dst[n][k] = *(const PG8_LAS bf16x8*)(lds + PG8_SB(b, h) + boff + n * 2048 + k * 1024); } while (0)
#define PG8_MMA(ai, bj, At, Bt) do { __builtin_amdgcn_s_setprio(1); _Pragma("unroll") for (int m = 0; m < 4; ++m) _Pragma("unroll") for (int n = 0; n < 2; ++n) _Pragma("unroll") for (int k = 0; k < 2; ++k) \
        acc[ai][bj][m][n] = __builtin_amdgcn_mfma_f32_16x16x32_bf16(Bt[n][k], At[m][k], acc[ai][bj][m][n], 0, 0, 0); __builtin_amdgcn_s_setprio(0); } while (0)
#define PG8_WAIT_V(n) asm volatile("s_waitcnt vmcnt(" #n ")" ::: "memory")
#define PG8_WAIT_L(n) asm volatile("s_waitcnt lgkmcnt(" #n ")" ::: "memory")
#define PG8_BAR __builtin_amdgcn_s_barrier()
#define PG8_SCHED __builtin_amdgcn_sched_barrier(0)
    Unit cur, nxt; int ui = 0;
    if (!S.next(0, cur)) return;
    f32x4 acc[2][2][4][2];
#pragma unroll
    for (int a = 0; a < 2; ++a)
#pragma unroll
        for (int b = 0; b < 2; ++b)
#pragma unroll
            for (int m = 0; m < 4; ++m)
#pragma unroll
                for (int n = 0; n < 2; ++n) acc[a][b][m][n] = (f32x4){0.f, 0.f, 0.f, 0.f};
    bf16x8 At[4][2], B0[2][2], B1[2][2];
    const char* cA = (const char*)g.A + (size_t)cur.pm * tstepA; const char* cB = (const char*)g.Bt + (size_t)cur.pn * tstepB;
    S.a_ready(cur);
    if constexpr (SP2) {
        PG8_STAGE(PG8_SB(0, 0), cB, voffB); PG8_STAGE(PG8_SB(0, 1), cB + hstepB, voffB); PG8_STAGE(PG8_SA(0, 0), cA, voffA); PG8_STAGE(PG8_SA(0, 1), cA + hstepA, voffA);
        if (wr == 1) PG8_BAR;
        PG8_WAIT_V(2); PG8_BAR;
        PG8_STAGE(PG8_SB(1, 0), cB + kstep, voffB); PG8_STAGE(PG8_SA(1, 0), cA + kstep, voffA); PG8_STAGE(PG8_SB(1, 1), cB + hstepB + kstep, voffB);
        PG8_WAIT_V(6); PG8_BAR;
    } else {
        PG8_STAGE(PG8_SB(0, 0), cB, voffB); PG8_STAGE(PG8_SA(0, 0), cA, voffA); PG8_STAGE(PG8_SB(0, 1), cB + hstepB, voffB); PG8_STAGE(PG8_SA(0, 1), cA + hstepA, voffA);
        if (wr == 1) PG8_BAR;
        PG8_WAIT_V(4); PG8_BAR;
        PG8_STAGE(PG8_SB(1, 0), cB + kstep, voffB); PG8_STAGE(PG8_SA(1, 0), cA + kstep, voffA); PG8_STAGE(PG8_SB(1, 1), cB + hstepB + kstep, voffB);
        PG8_WAIT_V(6); PG8_BAR;
    }
    for (;;) {
        const bool has_next = S.next(ui + 1, nxt);
        const char* nA = has_next ? (const char*)g.A + (size_t)nxt.pm * tstepA : cA; const char* nB = has_next ? (const char*)g.Bt + (size_t)nxt.pn * tstepB : cB;
        for (int hh_ = 0; hh_ < (Epi::HAS_MID ? 2 : 1); ++hh_) {
        if constexpr (Epi::HAS_MID) { if (hh_ == 1) E.mid(acc, cur, wr, wc, fr, fq); }
        const int t0_ = Epi::HAS_MID ? hh_ * (nt >> 1) : 0, t1_ = Epi::HAS_MID ? (hh_ + 1) * (nt >> 1) : nt;
        for (int t = t0_; t < t1_; t += 2) {
            const bool last = (t == nt - 2);
            const char* a1 = cA + (size_t)(t + 1) * kstep;
            const char* a2 = last ? nA : cA + (size_t)(t + 2) * kstep; const char* b2 = last ? nB : cB + (size_t)(t + 2) * kstep;
            const char* a3 = a2 + kstep; const char* b3 = b2 + kstep;
            if (last && has_next) S.a_ready(nxt);
            if constexpr (SP2) {
            PG8_LDB(B0, 0, 0); PG8_LDB(B1, 0, 1); PG8_SCHED; PG8_LDA(At, 0, 0); PG8_STAGE(PG8_SA(1, 1), a1 + hstepA, voffA);
            PG8_WAIT_V(8); PG8_WAIT_L(0); PG8_BAR; PG8_MMA(0, 0, At, B0); PG8_MMA(0, 1, At, B1); PG8_BAR; PG8_SCHED;
            PG8_LDA(At, 0, 1); PG8_STAGE(PG8_SB(0, 0), b2, voffB); PG8_STAGE(PG8_SB(0, 1), b2 + hstepB, voffB); PG8_STAGE(PG8_SA(0, 0), a2, voffA);
            PG8_WAIT_V(8); PG8_WAIT_L(0); PG8_BAR; PG8_MMA(1, 0, At, B0); PG8_MMA(1, 1, At, B1); PG8_BAR; PG8_SCHED;
            PG8_LDB(B0, 1, 0); PG8_LDB(B1, 1, 1); PG8_SCHED; PG8_LDA(At, 1, 0); PG8_STAGE(PG8_SA(0, 1), a2 + hstepA, voffA);
            PG8_WAIT_V(8); PG8_WAIT_L(0); PG8_BAR; PG8_MMA(0, 0, At, B0); PG8_MMA(0, 1, At, B1); PG8_BAR; PG8_SCHED;
            PG8_LDA(At, 1, 1); PG8_STAGE(PG8_SB(1, 0), b3, voffB); PG8_STAGE(PG8_SB(1, 1), b3 + hstepB, voffB); PG8_STAGE(PG8_SA(1, 0), a3, voffA);
            PG8_WAIT_V(8); PG8_WAIT_L(0); PG8_BAR; PG8_MMA(1, 0, At, B0); PG8_MMA(1, 1, At, B1); PG8_BAR; PG8_SCHED;
            } else {
            PG8_LDB(B0, 0, 0); PG8_SCHED; PG8_LDA(At, 0, 0); PG8_STAGE(PG8_SA(1, 1), a1 + hstepA, voffA);
            PG8_WAIT_L(8); PG8_BAR; PG8_WAIT_L(0); PG8_MMA(0, 0, At, B0); PG8_BAR; PG8_SCHED;
            PG8_LDB(B1, 0, 1); PG8_STAGE(PG8_SB(0, 0), b2, voffB);
            PG8_BAR; PG8_WAIT_L(0); PG8_MMA(0, 1, At, B1); PG8_BAR;
            PG8_LDA(At, 0, 1); PG8_STAGE(PG8_SA(0, 0), a2, voffA);
            PG8_BAR; PG8_WAIT_L(0); PG8_MMA(1, 0, At, B0); PG8_BAR; PG8_SCHED;
            PG8_STAGE(PG8_SB(0, 1), b2 + hstepB, voffB);
            PG8_WAIT_V(6); PG8_BAR; PG8_MMA(1, 1, At, B1); PG8_BAR;
            PG8_LDB(B0, 1, 0); PG8_SCHED; PG8_LDA(At, 1, 0); PG8_STAGE(PG8_SA(0, 1), a2 + hstepA, voffA);
            PG8_WAIT_L(8); PG8_BAR; PG8_WAIT_L(0); PG8_MMA(0, 0, At, B0); PG8_BAR; PG8_SCHED;
            PG8_LDB(B1, 1, 1); PG8_STAGE(PG8_SB(1, 0), b3, voffB);
            PG8_BAR; PG8_WAIT_L(0); PG8_MMA(0, 1, At, B1); PG8_BAR;
            PG8_LDA(At, 1, 1); PG8_STAGE(PG8_SA(1, 0), a3, voffA);
            PG8_BAR; PG8_WAIT_L(0); PG8_MMA(1, 0, At, B0); PG8_BAR; PG8_SCHED;
            PG8_STAGE(PG8_SB(1, 1), b3 + hstepB, voffB);
            PG8_WAIT_V(6); PG8_BAR; PG8_MMA(1, 1, At, B1); PG8_BAR;
            }
        }
        }
        if constexpr (ALIGN_EPI) { if (wr == 0) PG8_BAR; }
        if constexpr (!Epi::AFTER_DRAIN) { E(acc, cur, wr, wc, fr, fq); S.done(cur); }
        if (!has_next) break;
#pragma unroll
        for (int a = 0; a < 2; ++a)
#pragma unroll
            for (int b = 0; b < 2; ++b)
#pragma unroll
                for (int m = 0; m < 4; ++m)
#pragma unroll
                    for (int n = 0; n < 2; ++n) acc[a][b][m][n] = (f32x4){0.f, 0.f, 0.f, 0.f};
        cur = nxt; cA = nA; cB = nB; ++ui;
        if constexpr (ALIGN_EPI) { if (wr == 1) PG8_BAR; }
    }
    PG8_WAIT_V(0);
    if constexpr (!ALIGN_EPI) { if (wr == 0) PG8_BAR; }
    PG8_BAR;
    if constexpr (Epi::AFTER_DRAIN) { E.fused(acc, cur, wr, wc, fr, fq, lds, wid, lane); S.done(cur); }
#undef PG8_SA
#undef PG8_SB
#undef PG8_STAGE
#undef PG8_LDA
#undef PG8_LDB
#undef PG8_MMA
#undef PG8_WAIT_V
#undef PG8_WAIT_L
#undef PG8_BAR
#undef PG8_SCHED
}
}

template <class SE> struct EpiAdapt {
    static constexpr bool PERM = true, AFTER_DRAIN = false, HAS_MID = SE::HAS_MID;
    SE se;
    template <int T> DI void run(f32x4 (&acc)[2][2][4][2], const pg8::Unit& u, int wr, int wc, int fr, int fq) const {
#pragma unroll
        for (int ai = 0; ai < 2; ++ai)
#pragma unroll
            for (int m = 0; m < 4; ++m) {
                int row = u.pm * 256 + ai * 128 + wr * 64 + m * 16 + fr; asm volatile("" : "+v"(row)); float v[2][8];
#pragma unroll
                for (int bj = 0; bj < 2; ++bj)
#pragma unroll
                    for (int n = 0; n < 2; ++n) { v[bj][4 * n] = acc[ai][bj][m][n][0]; v[bj][4 * n + 1] = acc[ai][bj][m][n][1]; v[bj][4 * n + 2] = acc[ai][bj][m][n][2]; v[bj][4 * n + 3] = acc[ai][bj][m][n][3]; }
                se.template apply<T>(row, u.pn, wc, fq, v);
                asm volatile("" ::: "memory");
            }
    }
    template <int T> DI void disp(int ty, f32x4 (&acc)[2][2][4][2], const pg8::Unit& u, int wr, int wc, int fr, int fq) const {
        if constexpr (T < SE::NTYPES) { if (ty == T) run<T>(acc, u, wr, wc, fr, fq); else disp<T + 1>(ty, acc, u, wr, wc, fr, fq); }
    }
    DI void operator()(f32x4 (&acc)[2][2][4][2], const pg8::Unit& u, int wr, int wc, int fr, int fq) const { disp<0>(se.type(u.pn, wc), acc, u, wr, wc, fr, fq); }
    DI void mid(f32x4 (&acc)[2][2][4][2], const pg8::Unit& u, int wr, int wc, int fr, int fq) const {
#pragma unroll
        for (int ai = 0; ai < 2; ++ai)
#pragma unroll
            for (int m = 0; m < 4; ++m) {
                int row = u.pm * 256 + ai * 128 + wr * 64 + m * 16 + fr; asm volatile("" : "+v"(row)); float v[2][8];
#pragma unroll
                for (int bj = 0; bj < 2; ++bj)
#pragma unroll
                    for (int n = 0; n < 2; ++n) { v[bj][4 * n] = acc[ai][bj][m][n][0]; v[bj][4 * n + 1] = acc[ai][bj][m][n][1]; v[bj][4 * n + 2] = acc[ai][bj][m][n][2]; v[bj][4 * n + 3] = acc[ai][bj][m][n][3]; }
                se.mid(row, u.pn, wc, fq, v);
                asm volatile("" ::: "memory");
#pragma unroll
                for (int bj = 0; bj < 2; ++bj)
#pragma unroll
                    for (int n = 0; n < 2; ++n) { acc[ai][bj][m][n][0] = v[bj][4 * n]; acc[ai][bj][m][n][1] = v[bj][4 * n + 1]; acc[ai][bj][m][n][2] = v[bj][4 * n + 2]; acc[ai][bj][m][n][3] = v[bj][4 * n + 3]; }
            }
    }
};
template <class SE> DI void gemm_fast(PG8_LAS unsigned char* lds, const bf16_t* A, int lda, const bf16_t* Bt, int M, int N, int K, const SE& se, int G, int c) {
    pg8::Gemm g{A, Bt, M, N, K, lda}; pg8::StaticOrder S; S.init(M, N, G, c);
    EpiAdapt<SE> E{se};
    pg8::gemm_phase<EpiAdapt<SE>, pg8::StaticOrder, true, true>(lds, g, S, E);
}
DI void cmp_hidden_naive(const Params& p, int gtid, int ngt) {
    float* H = wsp<float>(p, WS_CMPH);
    for (int idx = gtid; idx < 2 * 2 * 1024 * 256; idx += ngt) {
        const int j = idx & 255, r = (idx >> 8) & 1023, g = (idx >> 18) & 1, kv = idx >> 19;
        if ((r & 127) == 127) { H[idx] = 0.f; continue; }
        const bf16_t* src = wsp<bf16_t>(p, kv ? WS_VC : WS_KC) + (size_t)(16 * r) * 128 + g * 64;
        const bf16_t* w = wsp<bf16_t>(p, WS_CW1) + (size_t)kv * 256 * 2048 + (size_t)j * 2048;
        float acc = 0.f;
        for (int l = 0; l < 32; ++l)
#pragma unroll
            for (int d8 = 0; d8 < 8; ++d8) { float a[8], b[8]; unpack8(*(const u32x4*)(src + l * 128 + d8 * 8), a); unpack8(*(const u32x4*)(w + l * 64 + d8 * 8), b);
#pragma unroll
                for (int e = 0; e < 8; ++e) acc += a[e] * b[e]; }
        H[idx] = siluf(acc + wsp<float>(p, WS_CB1)[kv * 256 + j]);
    }
}
DI void cmp_out(const Params& p, int gw, int ngw, int lane) {
    const float* H = wsp<float>(p, WS_CMPH);
    for (int u = gw; u < 2 * 2 * 1024; u += ngw) {
        const int r = u & 1023, g = (u >> 10) & 1, kv = u >> 11; const int b = r >> 7, n = r & 127;
        bf16_t* dst = wsp<bf16_t>(p, kv ? WS_VCF : WS_KCF) + (size_t)r * 128 + g * 64 + lane;
        if (n == 127) { *dst = 0; continue; }
        const float* h = H + (size_t)u * 256; const float* w2 = (kv ? p.in[I_CW2V] : p.in[I_CW2K]) + lane;
        float acc = 0.f;
        for (int j = 0; j < 256; ++j) acc += h[j] * w2[j * 64];
        if (kv == 0) {
            const float rstd = rsqrtf(wave_sum(acc * acc) * (1.f / 64.f) + EPS);
            float y = acc * rstd * p.in[I_NKCG][lane];
            const int prow = b * SEQ + 16 * n + 31; const float oth = __shfl_xor(y, 8);
            if (lane < 16) { const float c = ropeCN(p)[(size_t)prow * 8 + (lane & 7)], s = ropeSN(p)[(size_t)prow * 8 + (lane & 7)]; y = (lane < 8) ? y * c - oth * s : y * c + oth * s; }
            acc = y;
        }
        *dst = (bf16_t)f2bf(acc);
    }
}

DI unsigned select_blocks(const float (&imp)[32], int cur) {
    if (cur < 8) return (2u << cur) - 1u;
    unsigned mask = 1u | (1u << cur) | (1u << (cur - 1));
#pragma unroll 1
    for (int it = 0; it < 5; ++it) {
        float best = -1.0f; int bi = 1;
#pragma unroll
        for (int j = 1; j < 32; ++j) { const bool ok = (j <= cur - 2) && !((mask >> j) & 1u); if (ok && imp[j] > best) { best = imp[j]; bi = j; } }
        mask |= 1u << bi;
    }
    return mask;
}

DI float dot64(const float (&q)[64], const bf16_t* k) { float acc = 0.f;
#pragma unroll
    for (int c = 0; c < 8; ++c) { float kf[8]; unpack8(*(const u32x4*)(k + 8 * c), kf);
#pragma unroll
        for (int e = 0; e < 8; ++e) acc += q[8 * c + e] * kf[e]; }
    return acc; }
DI void axpy64(float (&o)[64], float pw, const bf16_t* v) {
#pragma unroll
    for (int c = 0; c < 8; ++c) { float vf[8]; unpack8(*(const u32x4*)(v + 8 * c), vf);
#pragma unroll
        for (int e = 0; e < 8; ++e) o[8 * c + e] += pw * vf[e]; } }
DI void nsa_naive(const Params& p, int bid, int nb, float* lds) {
    float* impL = lds + threadIdx.x * 33;
    const bf16_t* QN = wsp<bf16_t>(p, WS_QN); const bf16_t* KCF = wsp<bf16_t>(p, WS_KCF); const bf16_t* VCF = wsp<bf16_t>(p, WS_VCF);
    const bf16_t* KS = wsp<bf16_t>(p, WS_KS); const bf16_t* VS = wsp<bf16_t>(p, WS_VS); const bf16_t* KW = wsp<bf16_t>(p, WS_KW); const bf16_t* VW = wsp<bf16_t>(p, WS_VW);
    const bf16_t* GN = wsp<bf16_t>(p, WS_GN); bf16_t* OC = wsp<bf16_t>(p, WS_R1);
    for (int idx = bid * blockDim.x + threadIdx.x; idx < MT * 2; idx += nb * blockDim.x) {
        const int t = idx & (SEQ - 1), g = (idx >> 11) & 1, b = idx >> 12; const int row = b * SEQ + t, cur = t >> 6;
        const int nvalid = (t >= 31) ? ((t - 31) >> 4) + 1 : 0;
        for (int j = 0; j < 32; ++j) impL[j] = 0.f;
        float q[64];
        for (int r = 0; r < 4; ++r) {
#pragma unroll
            for (int c = 0; c < 8; ++c) { float f[8]; unpack8(*(const u32x4*)(QN + (size_t)row * 512 + (g * 4 + r) * 64 + 8 * c), f);
#pragma unroll
                for (int e = 0; e < 8; ++e) q[8 * c + e] = f[e]; }
            float m = -INFINITY;
            for (int n = 0; n < nvalid; ++n) m = fmaxf(m, dot64(q, KCF + (size_t)(b * 128 + n) * 128 + g * 64));
            float l = 0.f;
            for (int n = 0; n < nvalid; ++n) l += __builtin_amdgcn_exp2f(dot64(q, KCF + (size_t)(b * 128 + n) * 128 + g * 64) - m);
            const float rl = (nvalid > 0) ? 1.f / l : 0.f;
            for (int n = 0; n < nvalid; ++n) { const float pw = __builtin_amdgcn_exp2f(dot64(q, KCF + (size_t)(b * 128 + n) * 128 + g * 64) - m) * rl;
                impL[n >> 2] += pw; if ((n & 3) == 3 && (n >> 2) + 1 < 32) impL[(n >> 2) + 1] += pw; }
        }
        float imp[32];
#pragma unroll
        for (int j = 0; j < 32; ++j) imp[j] = impL[j];
        const unsigned mask = select_blocks(imp, cur);
        for (int r = 0; r < 4; ++r) {
            const int hh = g * 4 + r;
#pragma unroll
            for (int c = 0; c < 8; ++c) { float f[8]; unpack8(*(const u32x4*)(QN + (size_t)row * 512 + hh * 64 + 8 * c), f);
#pragma unroll
                for (int e = 0; e < 8; ++e) q[8 * c + e] = f[e]; }
            float ot[64];
#pragma unroll
            for (int d = 0; d < 64; ++d) ot[d] = 0.f;
            const float g0 = bf2f(GN[(size_t)row * 32 + hh * 3 + 0]), g1 = bf2f(GN[(size_t)row * 32 + hh * 3 + 1]), g2 = bf2f(GN[(size_t)row * 32 + hh * 3 + 2]);
            for (int br = 0; br < 3; ++br) {
                float o[64];
#pragma unroll
                for (int d = 0; d < 64; ++d) o[d] = 0.f;
                float m = -INFINITY, l = 0.f;
                if (br == 0) {
                    for (int n = 0; n < nvalid; ++n) { const float s = dot64(q, KCF + (size_t)(b * 128 + n) * 128 + g * 64);
                        if (s > m) { const float f = __builtin_amdgcn_exp2f(m - s); l *= f;
#pragma unroll
                            for (int d = 0; d < 64; ++d) o[d] *= f;
                            m = s; }
                        const float pw = __builtin_amdgcn_exp2f(s - m); l += pw; axpy64(o, pw, VCF + (size_t)(b * 128 + n) * 128 + g * 64); }
                } else {
                    const int k0 = (br == 1) ? 0 : ((t - 255 > 0) ? t - 255 : 0);
                    for (int k = k0; k <= t; ++k) {
                        if (br == 1 && !((mask >> (k >> 6)) & 1u)) { k |= 63; continue; }
                        const size_t kr = (size_t)(b * SEQ + k) * 128 + g * 64;
                        const float s = dot64(q, (br == 1 ? KS : KW) + kr);
                        if (s > m) { const float f = __builtin_amdgcn_exp2f(m - s); l *= f;
#pragma unroll
                            for (int d = 0; d < 64; ++d) o[d] *= f;
                            m = s; }
                        const float pw = __builtin_amdgcn_exp2f(s - m); l += pw; axpy64(o, pw, (br == 1 ? VS : VW) + kr); }
                }
                const float gg = (br == 0 ? g0 : br == 1 ? g1 : g2) * ((l > 0.f) ? 1.f / l : 0.f);
#pragma unroll
                for (int d = 0; d < 64; ++d) ot[d] += gg * o[d];
            }
#pragma unroll
            for (int c = 0; c < 8; ++c) { float f[8];
#pragma unroll
                for (int e = 0; e < 8; ++e) f[e] = ot[8 * c + e];
                *(u32x4*)(OC + (size_t)row * 1024 + 512 + hh * 64 + 8 * c) = pack8(f); }
        }
    }
}

DI void mla_qprep(const Params& p, int row, int h, float (&q)[96]) {
    const bf16_t* src = wsp<bf16_t>(p, WS_R0) + (size_t)row * 768 + h * 96; float ss = 0.f;
#pragma unroll
    for (int c = 0; c < 12; ++c) { float f[8]; unpack8(*(const u32x4*)(src + 8 * c), f);
#pragma unroll
        for (int e = 0; e < 8; ++e) { q[8 * c + e] = f[e]; ss += f[e] * f[e]; } }
    const float rstd = rsqrtf(ss * (1.f / 96.f) + EPS); const float* qg = p.in[I_MQG]; const float* kg = p.in[I_MKG];
#pragma unroll
    for (int d = 0; d < 96; ++d) q[d] *= rstd * qg[d];
    const float* cs = ropeCM(p) + (size_t)row * 16; const float* sn = ropeSM(p) + (size_t)row * 16;
#pragma unroll
    for (int i = 0; i < 16; ++i) { const float x1 = q[64 + i], x2 = q[80 + i]; q[64 + i] = x1 * cs[i] - x2 * sn[i]; q[80 + i] = x2 * cs[i] + x1 * sn[i]; }
#pragma unroll
    for (int d = 0; d < 64; ++d) q[d] *= kg[d] * C2M;
#pragma unroll
    for (int d = 64; d < 96; ++d) q[d] *= C2M;
}
DI void mla_naive(const Params& p, int gtid, int ngt) {
    const bf16_t* KN = wsp<bf16_t>(p, WS_KN); const bf16_t* KPE = wsp<bf16_t>(p, WS_KPE); const bf16_t* VM = wsp<bf16_t>(p, WS_VM);
    const float* sqk = wsp<float>(p, WS_SSQKN); const float* sqp = wsp<float>(p, WS_SSQPE); bf16_t* OC = wsp<bf16_t>(p, WS_R1);
    for (int idx = gtid; idx < MT * 8; idx += ngt) {
        const int t = idx & (SEQ - 1), h = (idx >> 11) & 7, b = idx >> 14; const int row = b * SEQ + t;
        float q[96]; mla_qprep(p, row, h, q);
        float o[64];
#pragma unroll
        for (int d = 0; d < 64; ++d) o[d] = 0.f;
        float m = -INFINITY, l = 0.f;
        for (int k = 0; k <= t; ++k) {
            const int kr = b * SEQ + k; const bf16_t* kn = KN + (size_t)kr * 512 + h * 64; const bf16_t* kp = KPE + (size_t)kr * 32; float acc = 0.f;
#pragma unroll
            for (int c = 0; c < 8; ++c) { float kf[8]; unpack8(*(const u32x4*)(kn + 8 * c), kf);
#pragma unroll
                for (int e = 0; e < 8; ++e) acc += q[8 * c + e] * kf[e]; }
#pragma unroll
            for (int c = 0; c < 4; ++c) { float kf[8]; unpack8(*(const u32x4*)(kp + 8 * c), kf);
#pragma unroll
                for (int e = 0; e < 8; ++e) acc += q[64 + 8 * c + e] * kf[e]; }
            const float s = acc * rsqrtf((sqk[(size_t)kr * 8 + h] + sqp[kr]) * (1.f / 96.f) + EPS);
            if (s > m) { const float f = __builtin_amdgcn_exp2f(m - s); l *= f;
#pragma unroll
                for (int d = 0; d < 64; ++d) o[d] *= f;
                m = s; }
            const float pw = __builtin_amdgcn_exp2f(s - m); l += pw; axpy64(o, pw, VM + (size_t)kr * 512 + h * 64);
        }
        const float rl = 1.f / l;
#pragma unroll
        for (int c = 0; c < 8; ++c) { float f[8];
#pragma unroll
            for (int e = 0; e < 8; ++e) f[e] = o[8 * c + e] * rl;
            *(u32x4*)(OC + (size_t)row * 1024 + h * 64 + 8 * c) = pack8(f); }
    }
}
namespace fa {
typedef short bf16x8 __attribute__((ext_vector_type(8)));
typedef short s16x4 __attribute__((ext_vector_type(4)));
typedef float f32x16 __attribute__((ext_vector_type(16)));
typedef LAS const char* lds_cptr;
typedef LAS char* lds_ptr;
constexpr int KBUF = 12288, VBUF = 8192;
constexpr int L_K = 0, L_V = 2 * KBUF, L_RK = L_V + 2 * VBUF, L_WS = L_RK + 512, L_OST = L_WS + 8 * 256, L_END = L_OST + 8 * 4096;
#define FA_SBAR() __builtin_amdgcn_sched_barrier(0)
DI int crow(int r, int hi) { return (r & 3) + 8 * (r >> 2) + 4 * hi; }
typedef float f32x2_t __attribute__((ext_vector_type(2))); typedef __bf16 bf16x2_t __attribute__((ext_vector_type(2)));
DI unsigned cvtpk(float lo, float hi) { f32x2_t v = {lo, hi}; bf16x2_t b = __builtin_convertvector(v, bf16x2_t); return __builtin_bit_cast(unsigned, b); }

template <int DK> DI void qkt(f32x16& p0, f32x16& p1, lds_cptr kb, const bf16x8* qr) {
    f32x16 z;
#pragma unroll
    for (int i = 0; i < 16; ++i) z[i] = 0.f;
#pragma unroll
    for (int d0 = 0; d0 < DK / 16; ++d0) {
        const bf16x8 b0 = *(const LAS bf16x8*)(kb + d0 * 2048);
        const bf16x8 b1 = *(const LAS bf16x8*)(kb + d0 * 2048 + 512);
        if (d0 == 0) { p0 = __builtin_amdgcn_mfma_f32_32x32x16_bf16(b0, qr[0], z, 0, 0, 0); p1 = __builtin_amdgcn_mfma_f32_32x32x16_bf16(b1, qr[0], z, 0, 0, 0); }
        else { p0 = __builtin_amdgcn_mfma_f32_32x32x16_bf16(b0, qr[d0], p0, 0, 0, 0); p1 = __builtin_amdgcn_mfma_f32_32x32x16_bf16(b1, qr[d0], p1, 0, 0, 0); }
    }
}
DI void pv(f32x16* o, int vb, bf16x8 pa0, bf16x8 pa1, bf16x8 pa2, bf16x8 pa3) {
#pragma unroll
    for (int d0 = 0; d0 < 2; ++d0) { s16x4 lo[4], hi[4];
#pragma unroll
        for (int ks = 0; ks < 4; ++ks) {
            asm volatile("ds_read_b64_tr_b16 %0,%1 offset:%c2" : "=&v"(lo[ks]) : "v"(vb), "i"(d0 * 4096 + ks * 1024) : "memory");
            asm volatile("ds_read_b64_tr_b16 %0,%1 offset:%c2" : "=&v"(hi[ks]) : "v"(vb), "i"(d0 * 4096 + ks * 1024 + 512) : "memory"); }
        asm volatile("s_waitcnt lgkmcnt(0)" ::: "memory"); FA_SBAR();
#define FA_PK(k) (bf16x8){lo[k][0], lo[k][1], lo[k][2], lo[k][3], hi[k][0], hi[k][1], hi[k][2], hi[k][3]}
        o[d0] = __builtin_amdgcn_mfma_f32_32x32x16_bf16(pa0, FA_PK(0), o[d0], 0, 0, 0);
        o[d0] = __builtin_amdgcn_mfma_f32_32x32x16_bf16(pa1, FA_PK(1), o[d0], 0, 0, 0);
        o[d0] = __builtin_amdgcn_mfma_f32_32x32x16_bf16(pa2, FA_PK(2), o[d0], 0, 0, 0);
        o[d0] = __builtin_amdgcn_mfma_f32_32x32x16_bf16(pa3, FA_PK(3), o[d0], 0, 0, 0);
#undef FA_PK
    }
}
DI void pack_p(const f32x16& p0, const f32x16& p1, bf16x8& a0, bf16x8& a1, bf16x8& a2, bf16x8& a3) {
    u32x4 w0, w1, w2, w3;
    w0.x = cvtpk(p0[0], p0[1]); w0.y = cvtpk(p0[2], p0[3]); w0.z = cvtpk(p0[4], p0[5]); w0.w = cvtpk(p0[6], p0[7]);
    w1.x = cvtpk(p0[8], p0[9]); w1.y = cvtpk(p0[10], p0[11]); w1.z = cvtpk(p0[12], p0[13]); w1.w = cvtpk(p0[14], p0[15]);
    w2.x = cvtpk(p1[0], p1[1]); w2.y = cvtpk(p1[2], p1[3]); w2.z = cvtpk(p1[4], p1[5]); w2.w = cvtpk(p1[6], p1[7]);
    w3.x = cvtpk(p1[8], p1[9]); w3.y = cvtpk(p1[10], p1[11]); w3.z = cvtpk(p1[12], p1[13]); w3.w = cvtpk(p1[14], p1[15]);
    a0 = __builtin_bit_cast(bf16x8, w0); a1 = __builtin_bit_cast(bf16x8, w1); a2 = __builtin_bit_cast(bf16x8, w2); a3 = __builtin_bit_cast(bf16x8, w3);
}
DI void mask_range(f32x16& p0, f32x16& p1, int key0, int lo, int hi_, int hf) {
#pragma unroll
    for (int r = 0; r < 16; ++r) { const int k = key0 + crow(r, hf); if (k < lo || k > hi_) p0[r] = -INFINITY; if (k + 32 < lo || k + 32 > hi_) p1[r] = -INFINITY; }
}
DI float rowmax32(const f32x16& p0, const f32x16& p1) {
    float a = fmaxf(p0[0], p1[0]);
#pragma unroll
    for (int r = 1; r < 16; ++r) a = fmaxf(a, fmaxf(p0[r], p1[r]));
    return fmaxf(a, __shfl_xor(a, 32));
}
struct State { float m, l; f32x16 o[2]; };
DI void st_init(State& s) { s.m = -INFINITY; s.l = 0.f;
#pragma unroll
    for (int i = 0; i < 16; ++i) { s.o[0][i] = 0.f; s.o[1][i] = 0.f; } }
DI void softmax_pv(State& st, f32x16& p0, f32x16& p1, int vb, LAS float* wsf, int r32, int hf) {
    const float rm = rowmax32(p0, p1);
    const float mn = fmaxf(st.m, rm), mu = (mn == -INFINITY) ? 0.f : mn;
    const float alpha = __builtin_amdgcn_exp2f(st.m - mu);
    st.m = mn;
    float ls = 0.f;
#pragma unroll
    for (int r = 0; r < 16; ++r) { p0[r] = __builtin_amdgcn_exp2f(p0[r] - mu); p1[r] = __builtin_amdgcn_exp2f(p1[r] - mu); ls += p0[r] + p1[r]; }
    st.l = st.l * alpha + ls;
    if (__any(alpha != 1.0f)) {
        if (hf == 0) wsf[r32] = alpha;
        asm volatile("s_waitcnt lgkmcnt(0)" ::: "memory");
#pragma unroll
        for (int g = 0; g < 4; ++g) { const f32x4 a = *(const LAS f32x4*)(wsf + 8 * g + 4 * hf);
            st.o[0][4 * g] *= a.x; st.o[0][4 * g + 1] *= a.y; st.o[0][4 * g + 2] *= a.z; st.o[0][4 * g + 3] *= a.w;
            st.o[1][4 * g] *= a.x; st.o[1][4 * g + 1] *= a.y; st.o[1][4 * g + 2] *= a.z; st.o[1][4 * g + 3] *= a.w; }
    }
    bf16x8 a0, a1, a2, a3; pack_p(p0, p1, a0, a1, a2, a3);
    pv(st.o, vb, a0, a1, a2, a3);
}
DI void accum_scaled(f32x16* acc, const f32x16* o, float fac_row, LAS float* wsf, int r32, int hf) {
    if (hf == 0) wsf[32 + r32] = fac_row;
    asm volatile("s_waitcnt lgkmcnt(0)" ::: "memory");
#pragma unroll
    for (int g = 0; g < 4; ++g) { const f32x4 a = *(const LAS f32x4*)(wsf + 32 + 8 * g + 4 * hf);
        acc[0][4 * g] += o[0][4 * g] * a.x; acc[0][4 * g + 1] += o[0][4 * g + 1] * a.y; acc[0][4 * g + 2] += o[0][4 * g + 2] * a.z; acc[0][4 * g + 3] += o[0][4 * g + 3] * a.w;
        acc[1][4 * g] += o[1][4 * g] * a.x; acc[1][4 * g + 1] += o[1][4 * g + 1] * a.y; acc[1][4 * g + 2] += o[1][4 * g + 2] * a.z; acc[1][4 * g + 3] += o[1][4 * g + 3] * a.w; }
}
DI void stage_rows(const f32x16* acc, LAS bf16_t* stg, int r32, int hf) {
#pragma unroll
    for (int r = 0; r < 16; ++r) { const int orow = crow(r, hf);
        stg[orow * 64 + r32] = (bf16_t)f2bf(acc[0][r]); stg[orow * 64 + 32 + r32] = (bf16_t)f2bf(acc[1][r]); }
    asm volatile("s_waitcnt lgkmcnt(0)" ::: "memory");
}

DI void mla_unit(const Params& p, LAS unsigned char* lds, int b, int h, int qb) {
    const int tid = threadIdx.x, lane = tid & 63, r32 = lane & 31, hf = lane >> 5; const int wv = __builtin_amdgcn_readfirstlane(tid >> 6);
    const bf16_t* KN = wsp<bf16_t>(p, WS_KN); const bf16_t* KPE = wsp<bf16_t>(p, WS_KPE); const bf16_t* VM = wsp<bf16_t>(p, WS_VM);
    const float* sqk = wsp<float>(p, WS_SSQKN); const float* sqp = wsp<float>(p, WS_SSQPE); bf16_t* OC = wsp<bf16_t>(p, WS_R1);
    const int rowbase = b * SEQ, q0 = qb * 256, tq = q0 + wv * 32 + r32, row = rowbase + tq;
    LAS float* wsf = (LAS float*)(lds + L_WS) + wv * 64;
    bf16x8 qr[6];
    {
        const bf16_t* src = wsp<bf16_t>(p, WS_R0) + (size_t)row * 768 + h * 96 + 8 * hf; float q[6][8]; float ss = 0.f;
#pragma unroll
        for (int d0 = 0; d0 < 6; ++d0) { unpack8(*(const u32x4*)(src + 16 * d0), q[d0]);
#pragma unroll
            for (int e = 0; e < 8; ++e) ss += q[d0][e] * q[d0][e]; }
        ss += __shfl_xor(ss, 32);
        const float rstd = rsqrtf(ss * (1.f / 96.f) + EPS); const float* qg = p.in[I_MQG] + 8 * hf; const float* kg = p.in[I_MKG] + 8 * hf;
#pragma unroll
        for (int d0 = 0; d0 < 6; ++d0)
#pragma unroll
            for (int e = 0; e < 8; ++e) q[d0][e] *= rstd * qg[16 * d0 + e];
        const float* cs = ropeCM(p) + (size_t)row * 16 + 8 * hf; const float* sn = ropeSM(p) + (size_t)row * 16 + 8 * hf;
#pragma unroll
        for (int e = 0; e < 8; ++e) { const float x1 = q[4][e], x2 = q[5][e]; q[4][e] = x1 * cs[e] - x2 * sn[e]; q[5][e] = x2 * cs[e] + x1 * sn[e]; }
#pragma unroll
        for (int d0 = 0; d0 < 6; ++d0) { float f[8];
#pragma unroll
            for (int e = 0; e < 8; ++e) f[e] = q[d0][e] * ((d0 < 4) ? kg[16 * d0 + e] * C2M : C2M);
            qr[d0] = __builtin_bit_cast(bf16x8, pack8(f)); }
    }
    State st; st_init(st);
    const int NT = 4 * (qb + 1);
    u32x4 ka, kb2, vv; float rk = 0.f;
    const bf16_t* kasrc = KN + (size_t)(rowbase + lane) * 512 + h * 64 + wv * 8;
    const bf16_t* kbsrc = KPE + (size_t)(rowbase + lane) * 32 + (wv & 3) * 8;
    const bf16_t* vsrc = VM + (size_t)(rowbase + 16 * (wv & 3) + (lane >> 2)) * 512 + h * 64 + (wv >> 2) * 32 + (lane & 3) * 8;
#define MLA_LOAD(t) do { ka = *(const u32x4*)(kasrc + (size_t)(t) * 64 * 512); if (wv < 4) kb2 = *(const u32x4*)(kbsrc + (size_t)(t) * 64 * 32); vv = *(const u32x4*)(vsrc + (size_t)(t) * 64 * 512); \
        if (tid < 64) { const int kr_ = rowbase + (t) * 64 + tid; rk = rsqrtf((sqk[(size_t)kr_ * 8 + h] + sqp[kr_]) * (1.f / 96.f) + EPS); } } while (0)
#define MLA_STORE(bf) do { *(LAS u32x4*)(lds + L_K + (bf) * KBUF + wv * 1024 + lane * 16) = ka; if (wv < 4) *(LAS u32x4*)(lds + L_K + (bf) * KBUF + (8 + wv) * 1024 + lane * 16) = kb2; \
        *(LAS u32x4*)(lds + L_V + (bf) * VBUF + wv * 1024 + lane * 16) = vv; if (tid < 64) *(LAS float*)(lds + L_RK + (bf) * 256 + tid * 4) = rk; } while (0)
    __syncthreads();
    MLA_LOAD(0); MLA_STORE(0); if (NT > 1) MLA_LOAD(1);
    const int vboff = ((lane >> 4) & 1) * 32 + (lane & 3) * 8 + (4 * hf + ((lane & 15) >> 2)) * 64;
    const int qlo = q0 + wv * 32;
    for (int i = 0; i < NT; ++i) {
        __syncthreads();
        if (i + 1 < NT) { MLA_STORE((i + 1) & 1); if (i + 2 < NT) MLA_LOAD(i + 2); }
        const int key0 = i * 64, bf = i & 1;
        if (key0 <= qlo + 31) {
            f32x16 p0, p1; qkt<96>(p0, p1, (lds_cptr)(lds + L_K + bf * KBUF) + hf * 1024 + r32 * 16, qr);
            const LAS float* rkp = (const LAS float*)(lds + L_RK + bf * 256);
#pragma unroll
            for (int g = 0; g < 4; ++g) { const f32x4 a = *(const LAS f32x4*)(rkp + 8 * g + 4 * hf), c = *(const LAS f32x4*)(rkp + 32 + 8 * g + 4 * hf);
                p0[4 * g] *= a.x; p0[4 * g + 1] *= a.y; p0[4 * g + 2] *= a.z; p0[4 * g + 3] *= a.w; p1[4 * g] *= c.x; p1[4 * g + 1] *= c.y; p1[4 * g + 2] *= c.z; p1[4 * g + 3] *= c.w; }
            if (key0 + 63 > qlo) mask_range(p0, p1, key0, 0, tq, hf);
            softmax_pv(st, p0, p1, (int)(uintptr_t)(lds + L_V + bf * VBUF) + vboff, wsf, r32, hf);
        }
    }
#undef MLA_LOAD
#undef MLA_STORE
    const float lt = st.l + __shfl_xor(st.l, 32);
    f32x16 acc[2];
#pragma unroll
    for (int i = 0; i < 16; ++i) { acc[0][i] = 0.f; acc[1][i] = 0.f; }
    accum_scaled(acc, st.o, 1.0f / lt, wsf, r32, hf);
    LAS bf16_t* stg = (LAS bf16_t*)(lds + L_OST) + wv * 2048;
    stage_rows(acc, stg, r32, hf);
#pragma unroll
    for (int i = 0; i < 4; ++i) { const int rr = i * 8 + (lane >> 3), ch = lane & 7; const u32x4 v = *(const LAS u32x4*)(stg + rr * 64 + ch * 8);
        *(u32x4*)(OC + (size_t)(rowbase + q0 + wv * 32 + rr) * 1024 + h * 64 + ch * 8) = v; }
}

DI void nsa_unit(const Params& p, LAS unsigned char* lds, int b, int g, int c) {
    const int tid = threadIdx.x, lane = tid & 63, r32 = lane & 31, hf = lane >> 5; const int wv = __builtin_amdgcn_readfirstlane(tid >> 6);
    const bf16_t* QN = wsp<bf16_t>(p, WS_QN); const bf16_t* KCF = wsp<bf16_t>(p, WS_KCF); const bf16_t* VCF = wsp<bf16_t>(p, WS_VCF);
    const bf16_t* KS = wsp<bf16_t>(p, WS_KS); const bf16_t* VS = wsp<bf16_t>(p, WS_VS); const bf16_t* KW = wsp<bf16_t>(p, WS_KW); const bf16_t* VW = wsp<bf16_t>(p, WS_VW);
    const bf16_t* GN = wsp<bf16_t>(p, WS_GN); bf16_t* OC = wsp<bf16_t>(p, WS_R1);
    const int rowbase = b * SEQ, tt = 8 * wv + (r32 >> 2), hd = g * 4 + (r32 & 3), tq = 64 * c + tt, row = rowbase + tq;
    LAS float* wsf = (LAS float*)(lds + L_WS) + wv * 64;
    bf16x8 qr[4];
#pragma unroll
    for (int d0 = 0; d0 < 4; ++d0) qr[d0] = *(const bf16x8*)(QN + (size_t)row * 512 + hd * 64 + 16 * d0 + 8 * hf);
    const float g0 = bf2f(GN[(size_t)row * 32 + hd * 3 + 0]), g1 = bf2f(GN[(size_t)row * 32 + hd * 3 + 1]), g2 = bf2f(GN[(size_t)row * 32 + hd * 3 + 2]);
    f32x16 ot[2];
#pragma unroll
    for (int i = 0; i < 16; ++i) { ot[0][i] = 0.f; ot[1][i] = 0.f; }
    const int vboff = ((lane >> 4) & 1) * 32 + (lane & 3) * 8 + (4 * hf + ((lane & 15) >> 2)) * 64;
    u32x4 ka, vv;
#define NSA_LOAD(KB, VB, krow0) do { ka = *(const u32x4*)((KB) + (size_t)((krow0) + lane) * 128 + g * 64 + wv * 8); \
        vv = *(const u32x4*)((VB) + (size_t)((krow0) + 16 * (wv & 3) + (lane >> 2)) * 128 + g * 64 + (wv >> 2) * 32 + (lane & 3) * 8); } while (0)
#define NSA_STORE(koff, voff) do { *(LAS u32x4*)(lds + (koff) + wv * 1024 + lane * 16) = ka; *(LAS u32x4*)(lds + (voff) + wv * 1024 + lane * 16) = vv; } while (0)
    unsigned selmask;
    {
        const int ntile = (4 * c + 3 > 64) ? 2 : 1;
        const int nmax = (tq >= 31) ? ((tq - 31) >> 4) : -1;
        __syncthreads();
        NSA_LOAD(KCF, VCF, b * 128); NSA_STORE(L_K, L_V);
        if (ntile == 2) { NSA_LOAD(KCF, VCF, b * 128 + 64); NSA_STORE(L_K + 8192, L_V + 8192); }
        __syncthreads();
        f32x16 pa0, pa1, pb0, pb1;
        qkt<64>(pa0, pa1, (lds_cptr)(lds + L_K) + hf * 1024 + r32 * 16, qr); mask_range(pa0, pa1, 0, 0, nmax, hf);
        float m = rowmax32(pa0, pa1);
        if (ntile == 2) { qkt<64>(pb0, pb1, (lds_cptr)(lds + L_K + 8192) + hf * 1024 + r32 * 16, qr); mask_range(pb0, pb1, 64, 0, nmax, hf); m = fmaxf(m, rowmax32(pb0, pb1)); }
        else {
#pragma unroll
            for (int i = 0; i < 16; ++i) { pb0[i] = -INFINITY; pb1[i] = -INFINITY; } }
        const float mu = (m == -INFINITY) ? 0.f : m;
        float ls = 0.f;
#pragma unroll
        for (int r = 0; r < 16; ++r) { pa0[r] = __builtin_amdgcn_exp2f(pa0[r] - mu); pa1[r] = __builtin_amdgcn_exp2f(pa1[r] - mu); pb0[r] = __builtin_amdgcn_exp2f(pb0[r] - mu); pb1[r] = __builtin_amdgcn_exp2f(pb1[r] - mu);
            ls += (pa0[r] + pa1[r]) + (pb0[r] + pb1[r]); }
        ls += __shfl_xor(ls, 32);
        const float rl = (ls > 0.f) ? 1.0f / ls : 0.f;
#pragma unroll
        for (int r = 0; r < 16; ++r) { pa0[r] *= rl; pa1[r] *= rl; pb0[r] *= rl; pb1[r] *= rl; }
        float own[16], ee[16];
#pragma unroll
        for (int q = 0; q < 4; ++q) {
            own[q] = (pa0[4 * q] + pa0[4 * q + 1]) + (pa0[4 * q + 2] + pa0[4 * q + 3]); ee[q] = pa0[4 * q + 3];
            own[4 + q] = (pa1[4 * q] + pa1[4 * q + 1]) + (pa1[4 * q + 2] + pa1[4 * q + 3]); ee[4 + q] = pa1[4 * q + 3];
            own[8 + q] = (pb0[4 * q] + pb0[4 * q + 1]) + (pb0[4 * q + 2] + pb0[4 * q + 3]); ee[8 + q] = pb0[4 * q + 3];
            own[12 + q] = (pb1[4 * q] + pb1[4 * q + 1]) + (pb1[4 * q + 2] + pb1[4 * q + 3]); ee[12 + q] = pb1[4 * q + 3]; }
        float eo[16];
#pragma unroll
        for (int k = 0; k < 16; ++k) eo[k] = __shfl_xor(ee[k], 32);
#pragma unroll
        for (int k = 0; k < 16; ++k) { const float add = hf ? eo[k] : ((k > 0) ? eo[k - 1] : 0.f); own[k] += add; }
#pragma unroll
        for (int k = 0; k < 16; ++k) { own[k] += __shfl_xor(own[k], 1); own[k] += __shfl_xor(own[k], 2); }
        float imp[32];
#pragma unroll
        for (int k = 0; k < 16; ++k) { const float oth = __shfl_xor(own[k], 32); imp[2 * k] = hf ? oth : own[k]; imp[2 * k + 1] = hf ? own[k] : oth; }
        selmask = select_blocks(imp, c);
        State sc; st_init(sc);
        { bf16x8 a0, a1, a2, a3; pack_p(pa0, pa1, a0, a1, a2, a3); pv(sc.o, (int)(uintptr_t)(lds + L_V) + vboff, a0, a1, a2, a3); }
        if (ntile == 2) { bf16x8 a0, a1, a2, a3; pack_p(pb0, pb1, a0, a1, a2, a3); pv(sc.o, (int)(uintptr_t)(lds + L_V + 8192) + vboff, a0, a1, a2, a3); }
        accum_scaled(ot, sc.o, g0, wsf, r32, hf);
    }
#pragma unroll 1
    for (int br = 1; br < 3; ++br) {
        const bf16_t* KB = (br == 1) ? KS : KW; const bf16_t* VB = (br == 1) ? VS : VW;
        const int NT = (br == 1) ? (c + 1) : ((c + 1 < 5) ? c + 1 : 5);
        const int lo = (br == 1) ? 0 : tq - 255;
        State st; st_init(st);
        __syncthreads();
        NSA_LOAD(KB, VB, rowbase + c * 64); NSA_STORE(L_K, L_V); if (NT > 1) NSA_LOAD(KB, VB, rowbase + (c - 1) * 64);
        for (int i = 0; i < NT; ++i) {
            __syncthreads();
            if (i + 1 < NT) { NSA_STORE(L_K + ((i + 1) & 1) * KBUF, L_V + ((i + 1) & 1) * VBUF); if (i + 2 < NT) NSA_LOAD(KB, VB, rowbase + (c - i - 2) * 64); }
            const int j = c - i, key0 = j * 64, bf = i & 1;
            const bool sel = (br == 2) || ((selmask >> j) & 1u);
            if (__any(sel)) {
                f32x16 p0, p1; qkt<64>(p0, p1, (lds_cptr)(lds + L_K + bf * KBUF) + hf * 1024 + r32 * 16, qr);
                if (br == 1) { if (i == 0) mask_range(p0, p1, key0, 0, tq, hf);
                    if (!sel) {
#pragma unroll
                        for (int r = 0; r < 16; ++r) { p0[r] = -INFINITY; p1[r] = -INFINITY; } } }
                else { if (i == 0 || i == 4) mask_range(p0, p1, key0, lo, tq, hf); }
                softmax_pv(st, p0, p1, (int)(uintptr_t)(lds + L_V + bf * VBUF) + vboff, wsf, r32, hf);
            }
        }
        const float lt = st.l + __shfl_xor(st.l, 32);
        accum_scaled(ot, st.o, ((br == 1) ? g1 : g2) / lt, wsf, r32, hf);
    }
#undef NSA_LOAD
#undef NSA_STORE
    LAS bf16_t* stg = (LAS bf16_t*)(lds + L_OST) + wv * 2048;
    stage_rows(ot, stg, r32, hf);
#pragma unroll
    for (int i = 0; i < 4; ++i) { const int rr = i * 8 + (lane >> 3), ch = lane & 7; const u32x4 v = *(const LAS u32x4*)(stg + rr * 64 + ch * 8);
        *(u32x4*)(OC + (size_t)(rowbase + 64 * c + 8 * wv + (rr >> 2)) * 1024 + 512 + (g * 4 + (rr & 3)) * 64 + ch * 8) = v; }
}
#undef FA_SBAR
}

DI void stage_attn_fast(const Params& p, LAS unsigned char* lds, int bid, int nb, bool do_mla, bool do_nsa) {
    if (do_mla) for (int u = bid; u < 256; u += nb) { const int bh = u >> 2, s = u & 3; fa::mla_unit(p, lds, bh >> 3, bh & 7, 7 - s); fa::mla_unit(p, lds, bh >> 3, bh & 7, s); }
    if (do_nsa) for (int u = bid; u < 256; u += nb) { const int bg = u >> 4, s = u & 15; fa::nsa_unit(p, lds, bg >> 1, bg & 1, 31 - s); fa::nsa_unit(p, lds, bg >> 1, bg & 1, s); }
    __syncthreads();
}
enum { ST_P0 = 0, ST_NORM1, ST_GEMM_Z, ST_GEMM_Q, ST_GEMM_KV, ST_CMP_H, ST_CMP_O, ST_MLA, ST_NSA, ST_GEMM_MERGE, ST_GEMM_OUT, ST_NORM2, ST_GEMM_GU, ST_GEMM_DOWN };
constexpr int LDS_BYTES = 147456;

template <int ST> __global__ void __launch_bounds__(256) stage_kernel(Params p) {
    __shared__ __attribute__((aligned(16))) float lds[256 * 34];
    const int tid = threadIdx.x, lane = tid & 63, wave = tid >> 6, nwv = blockDim.x >> 6;
    const int gw = blockIdx.x * nwv + wave, ngw = gridDim.x * nwv, gtid = blockIdx.x * blockDim.x + tid, ngt = gridDim.x * blockDim.x;
    if constexpr (ST == ST_P0) { stage_weights(p, gw, ngw, lds + wave * (64 * 33), lane); __syncthreads(); stage_mod(p, blockIdx.x, gridDim.x, lds); stage_rope(p, gtid, ngt); }
    if constexpr (ST == ST_NORM1) stage_normmod(p.in[I_X], p.in[I_N1G], wsp<float>(p, WS_MOD), 0, 1, wsp<bf16_t>(p, WS_R0), gw, ngw, lane);
    if constexpr (ST == ST_CMP_H) cmp_hidden_naive(p, gtid, ngt);
    if constexpr (ST == ST_CMP_O) cmp_out(p, gw, ngw, lane);
    if constexpr (ST == ST_MLA) mla_naive(p, gtid, ngt);
    if constexpr (ST == ST_NSA) nsa_naive(p, blockIdx.x, gridDim.x, lds);
    if constexpr (ST == ST_NORM2) stage_normmod(wsp<float>(p, WS_R2), p.in[I_N2G], wsp<float>(p, WS_MOD), 3, 4, wsp<bf16_t>(p, WS_R1), gw, ngw, lane);
}
template <int ST> __global__ void __launch_bounds__(512, 2) gemm_kernel(Params p) {
    extern __shared__ __attribute__((aligned(16))) unsigned char dlds[];
    PG8_LAS unsigned char* lds = (PG8_LAS unsigned char*)dlds; const int G = gridDim.x, c = blockIdx.x;
    if constexpr (ST == ST_GEMM_Z) { EpiZ E{p}; gemm_fast(lds, wsp<bf16_t>(p, WS_R0), 1024, wsp<bf16_t>(p, WS_WIN), MT, ZN, 1024, E, G, c); }
    if constexpr (ST == ST_GEMM_Q) { EpiQ E{p}; gemm_fast(lds, wsp<bf16_t>(p, WS_R1), 1024, wsp<bf16_t>(p, WS_WQB), MT, 768, 768, E, G, c); }
    if constexpr (ST == ST_GEMM_KV) { EpiKV E{p}; gemm_fast(lds, wsp<bf16_t>(p, WS_R1) + 768, 1024, wsp<bf16_t>(p, WS_WKVB), MT, 1024, 256, E, G, c); }
    if constexpr (ST == ST_GEMM_MERGE) { EpiMerge E{p}; gemm_fast(lds, wsp<bf16_t>(p, WS_R1), 1024, wsp<bf16_t>(p, WS_WO), MT, 1024, 1024, E, G, c); }
    if constexpr (ST == ST_GEMM_OUT) { EpiOut E{p}; gemm_fast(lds, wsp<bf16_t>(p, WS_R0), 1024, wsp<bf16_t>(p, WS_WOUT), MT, 1024, 1024, E, G, c); }
    if constexpr (ST == ST_GEMM_GU) { EpiGU E{p}; gemm_fast(lds, wsp<bf16_t>(p, WS_R1), 1024, wsp<bf16_t>(p, WS_WGU), MT, 5632, 1024, E, G, c); }
    if constexpr (ST == ST_GEMM_DOWN) { EpiDown E{p}; gemm_fast(lds, wsp<bf16_t>(p, WS_HID), DFF, wsp<bf16_t>(p, WS_WD), MT, 1024, DFF, E, G, c); }
}

#ifndef FAST_MLA
#define FAST_MLA 1
#endif
#ifndef FAST_NSA
#define FAST_NSA 1
#endif
template <int WHICH> __global__ void __launch_bounds__(512, 2) attn_kernel(Params p) {
    extern __shared__ __attribute__((aligned(16))) unsigned char dlds[];
    stage_attn_fast(p, (LAS unsigned char*)dlds, blockIdx.x, gridDim.x, WHICH == 0, WHICH == 1);
}
extern "C" void kernel_launch(void* const* d_in, const int* in_sizes, int n_in, void* d_out, int out_size, void* d_ws, size_t ws_size, hipStream_t stream) {
    if (n_in != 30 || out_size != MT * DM || ws_size < WS_END) { fprintf(stderr, "kernel_launch: unexpected shapes (n_in %d out %d ws %zu)\n", n_in, out_size, ws_size); return; }
    Params p{};
    for (int i = 0; i < 30; ++i) p.in[i] = (const float*)d_in[i];
    p.out = (float*)d_out; p.ws = (unsigned char*)d_ws;
    static bool attr_done = false;
#define GATTR(ST) hipFuncSetAttribute((const void*)gemm_kernel<ST>, hipFuncAttributeMaxDynamicSharedMemorySize, LDS_BYTES)
    if (!attr_done) { GATTR(ST_GEMM_Z); GATTR(ST_GEMM_Q); GATTR(ST_GEMM_KV); GATTR(ST_GEMM_MERGE); GATTR(ST_GEMM_OUT); GATTR(ST_GEMM_GU); GATTR(ST_GEMM_DOWN);
        hipFuncSetAttribute((const void*)attn_kernel<0>, hipFuncAttributeMaxDynamicSharedMemorySize, LDS_BYTES); hipFuncSetAttribute((const void*)attn_kernel<1>, hipFuncAttributeMaxDynamicSharedMemorySize, LDS_BYTES); attr_done = true; }
    const int G = 2048;
#define LAUNCH(ST) hipLaunchKernelGGL(stage_kernel<ST>, dim3(G), dim3(256), 0, stream, p)
#define GLAUNCH(ST) hipLaunchKernelGGL(gemm_kernel<ST>, dim3(256), dim3(512), LDS_BYTES, stream, p)
    LAUNCH(ST_P0); LAUNCH(ST_NORM1); GLAUNCH(ST_GEMM_Z); GLAUNCH(ST_GEMM_Q); GLAUNCH(ST_GEMM_KV); LAUNCH(ST_CMP_H); LAUNCH(ST_CMP_O);
    if (FAST_MLA) hipLaunchKernelGGL(attn_kernel<0>, dim3(256), dim3(512), LDS_BYTES, stream, p); else LAUNCH(ST_MLA);
    if (FAST_NSA) hipLaunchKernelGGL(attn_kernel<1>, dim3(256), dim3(512), LDS_BYTES, stream, p); else LAUNCH(ST_NSA);
    GLAUNCH(ST_GEMM_MERGE); GLAUNCH(ST_GEMM_OUT); LAUNCH(ST_NORM2); GLAUNCH(ST_GEMM_GU); GLAUNCH(ST_GEMM_DOWN);
#undef LAUNCH
}
```

```cpp
#include <hip/hip_runtime.h>
#include <hip/hip_cooperative_groups.h>
#include <cstdint>
#include <cstdio>
namespace cg = cooperative_groups;

typedef unsigned short bf16_t;
typedef unsigned u32x4 __attribute__((ext_vector_type(4)));
typedef unsigned u32x2 __attribute__((ext_vector_type(2)));
typedef float f32x4 __attribute__((ext_vector_type(4)));
typedef float f32x2 __attribute__((ext_vector_type(2)));
#define DI __device__ __forceinline__

constexpr int NB = 8, SEQ = 2048, DM = 1024, MT = NB * SEQ;
constexpr int DFF = 2816, NMOD = 6;
constexpr int ZN = 4608;
constexpr float EPS = 1e-6f;
constexpr float LOG2E = 1.4426950408889634f;
constexpr float C2N = 0.125f * LOG2E;
constexpr float C2M = 0.10206207261596575f * LOG2E;
constexpr int NTHR = 512, NWAVE = 8;
constexpr int O_CQ = 0, O_CKV = 768, O_KPE = 1024, O_QN = 1056, O_KC = 1568, O_VC = 1696, O_KS = 1824, O_VS = 1952, O_KW = 2080, O_VW = 2208,
              O_GN = 2336, O_GM = 2360, O_GNM = 3384, D_IN = 4408;

constexpr size_t MiB = 1u << 20;
constexpr size_t WS_CTL = 0;
constexpr size_t WS_MOD = 1 * MiB;
constexpr size_t WS_CB1 = 1 * MiB + 256 * 1024;
constexpr size_t WS_SSQPE = 1 * MiB + 320 * 1024;
constexpr size_t WS_SSQKN = 1 * MiB + 512 * 1024;
constexpr size_t WS_SSQA = 2 * MiB;
constexpr size_t WS_KCF = 3 * MiB;
constexpr size_t WS_VCF = 3 * MiB + 256 * 1024;
constexpr size_t WS_CW2 = 3 * MiB + 512 * 1024;
constexpr size_t WS_WIN = 4 * MiB;
constexpr size_t WS_WQB = 13 * MiB;
constexpr size_t WS_WKVB = 15 * MiB;
constexpr size_t WS_WO = 16 * MiB;
constexpr size_t WS_WOUT = 18 * MiB;
constexpr size_t WS_WGU = 20 * MiB;
constexpr size_t WS_WD = 31 * MiB;
constexpr size_t WS_CW1 = 37 * MiB;
constexpr size_t WS_R0 = 40 * MiB;
constexpr size_t WS_R1 = 72 * MiB;
constexpr size_t WS_R2 = 104 * MiB;
constexpr size_t WS_QN = 168 * MiB;
constexpr size_t WS_KC = 184 * MiB, WS_VC = 188 * MiB, WS_KS = 192 * MiB, WS_VS = 196 * MiB, WS_KW = 200 * MiB, WS_VW = 204 * MiB;
constexpr size_t WS_KPE = 208 * MiB;
constexpr size_t WS_GN = 209 * MiB;
constexpr size_t WS_KN = 210 * MiB;
constexpr size_t WS_VM = 226 * MiB;
constexpr size_t WS_CMPH = 64 * MiB;
constexpr size_t WS_ROPE = 248 * MiB;
constexpr size_t WS_HID = 168 * MiB;
constexpr size_t WS_END = 256 * MiB;

struct Params {
    const float* in[30];
    float* out;
    unsigned char* ws;
};
enum { I_X = 0, I_C, I_POS, I_ADAW, I_ADAB, I_N1G, I_WIN, I_QAG, I_WQB, I_KVAG, I_WKVB, I_MQG, I_MKG, I_NQG, I_NKCG, I_NKSG, I_NKWG,
       I_CPK, I_CW1K, I_CW2K, I_CPV, I_CW1V, I_CW2V, I_WOM, I_WON, I_WOUT, I_N2G, I_WG, I_WU, I_WDN };

template <class T> DI T* wsp(const Params& p, size_t off) { return (T*)(p.ws + off); }

DI int lane_id() { return (int)__builtin_amdgcn_mbcnt_hi(~0u, __builtin_amdgcn_mbcnt_lo(~0u, 0u)); }
DI int opaque_tid(int wid0) { int l = lane_id(); asm volatile("" : "+v"(l)); return (wid0 << 6) | l; }
DI unsigned f2bf(float f) { unsigned u = __float_as_uint(f); return (u + 0x7fffu + ((u >> 16) & 1u)) >> 16; }
DI unsigned pk2(float lo, float hi) { return f2bf(lo) | (f2bf(hi) << 16); }
DI float bf2f(unsigned short b) { return __uint_as_float(((unsigned)b) << 16); }
DI float bflo(unsigned w) { return __uint_as_float(w << 16); }
DI float bfhi(unsigned w) { return __uint_as_float(w & 0xffff0000u); }
DI void unpack8(const u32x4 w, float (&f)[8]) { f[0] = bflo(w.x); f[1] = bfhi(w.x); f[2] = bflo(w.y); f[3] = bfhi(w.y); f[4] = bflo(w.z); f[5] = bfhi(w.z); f[6] = bflo(w.w); f[7] = bfhi(w.w); }
DI u32x4 pack8(const float (&f)[8]) { u32x4 w; w.x = pk2(f[0], f[1]); w.y = pk2(f[2], f[3]); w.z = pk2(f[4], f[5]); w.w = pk2(f[6], f[7]); return w; }
DI float sigmoidf(float x) { return 1.0f / (1.0f + __expf(-x)); }
DI float siluf(float x) { return x / (1.0f + __expf(-x)); }
template <int X> DI float xorl(float v) { return __int_as_float(__builtin_amdgcn_ds_swizzle(__float_as_int(v), (X << 10) | 0x1f)); }
DI void halves(float v, float& lo, float& hi) { auto rr = __builtin_amdgcn_permlane32_swap(__float_as_uint(v), __float_as_uint(v), false, false); lo = __uint_as_float(rr[0]); hi = __uint_as_float(rr[1]); }
DI float xor32(float v, int hf) { float lo, hi; halves(v, lo, hi); return hf ? lo : hi; }
DI float sum32(float v) { float lo, hi; halves(v, lo, hi); return lo + hi; }
DI float max32(float v) { float lo, hi; halves(v, lo, hi); return fmaxf(lo, hi); }
DI float wave_sum(float v) { v += xorl<1>(v); v += xorl<2>(v); v += xorl<4>(v); v += xorl<8>(v); v += xorl<16>(v); return sum32(v); }
DI void sincos_rad(float ang, float& c, float& s) {
    double rev = (double)ang * 0.15915494309189535; rev -= __builtin_rint(rev);
    const float fr = (float)rev; s = __builtin_amdgcn_sinf(fr); c = __builtin_amdgcn_cosf(fr);
}
#define LAS __attribute__((address_space(3)))
DI void transpose_item(const float* W, int ldw, int c0, int ncols, const float* rs, bf16_t* dst, int ldd, int n0, int k0, float* scr, int lane) {
    if (c0 >= 0) {
#pragma unroll 8
        for (int i = 0; i < 32; ++i) { const int kk = 2 * i + (lane >> 5), cc = lane & 31;
            float v = (cc < ncols) ? W[(size_t)(k0 + kk) * ldw + c0 + cc] : 0.f; if (rs) v *= rs[k0 + kk]; scr[kk * 33 + cc] = v; }
    } else {
#pragma unroll 8
        for (int i = 0; i < 32; ++i) { const int kk = 2 * i + (lane >> 5), cc = lane & 31; scr[kk * 33 + cc] = 0.f; }
    }
    __builtin_amdgcn_s_waitcnt(0xc07f);
    asm volatile("" ::: "memory");
    const int c = lane & 7;
#pragma unroll
    for (int j = 0; j < 4; ++j) { const int n = (lane >> 3) + 8 * j; const float* s = scr + (8 * c) * 33 + n;
        u32x4 o; o.x = pk2(s[0 * 33], s[1 * 33]); o.y = pk2(s[2 * 33], s[3 * 33]); o.z = pk2(s[4 * 33], s[5 * 33]); o.w = pk2(s[6 * 33], s[7 * 33]);
        *(u32x4*)(dst + (size_t)(n0 + n) * ldd + k0 + 8 * c) = o; }
    __builtin_amdgcn_s_waitcnt(0xc07f);
    asm volatile("" ::: "memory");
}
DI int zsrc(int s, int L0, int& ncols) {
    ncols = 32;
    if (s < 16) return 64 * s + L0;
    if (s == 16) { if (L0 == 0) return O_KPE; ncols = 24; return O_GN; }
    if (s < 25) return O_QN + 64 * (s - 17) + L0;
    if (s < 27) return O_KC + 64 * (s - 25) + L0;
    if (s < 29) return O_VC + 64 * (s - 27) + L0;
    if (s < 31) return O_KS + 64 * (s - 29) + L0;
    if (s < 33) return O_VS + 64 * (s - 31) + L0;
    if (s < 35) return O_KW + 64 * (s - 33) + L0;
    if (s < 37) return O_VW + 64 * (s - 35) + L0;
    if (s < 40) return -1;
    if (s < 56) return O_GM + 64 * (s - 40) + L0;
    return O_GNM + 64 * (s - 56) + L0;
}
DI void stage_weights(const Params& p, int gw, int ngw, float* scr, int lane) {
    constexpr int I_IN = (ZN / 32) * (DM / 64);
    constexpr int I_QB = (768 / 32) * (768 / 64);
    constexpr int I_KVB = (1024 / 32) * (256 / 64);
    constexpr int I_O = (1024 / 32) * (1024 / 64);
    constexpr int I_OUT = I_O;
    constexpr int I_GU = (5632 / 32) * (1024 / 64);
    constexpr int I_D = (1024 / 32) * (DFF / 64);
    constexpr int I_C1 = 2 * (256 / 32) * (2048 / 64);
    constexpr int NITEMS = I_IN + I_QB + I_KVB + I_O + I_OUT + I_GU + I_D + I_C1;
    for (int it = gw; it < NITEMS; it += ngw) {
        int r = it;
        if (r < I_IN) { const int nb = r / 16, kb = r % 16; const int pn = nb >> 3, bj = (nb >> 2) & 1, wc = nb & 3; int nc; const int c0 = zsrc(4 * pn + wc, 32 * bj, nc);
            transpose_item(p.in[I_WIN], D_IN, c0, nc, nullptr, wsp<bf16_t>(p, WS_WIN), DM, nb * 32, kb * 64, scr, lane); continue; } r -= I_IN;
        if (r < I_QB) { const int nb = r / 12, kb = r % 12; transpose_item(p.in[I_WQB], 768, nb * 32, 32, p.in[I_QAG], wsp<bf16_t>(p, WS_WQB), 768, nb * 32, kb * 64, scr, lane); continue; } r -= I_QB;
        if (r < I_KVB) { const int nb = r / 4, kb = r % 4; const int pn = nb >> 3, bj = (nb >> 2) & 1, wc = nb & 3, s = 4 * pn + wc;
            const int c0 = (s < 8) ? (128 * s + 32 * bj) : (128 * (s - 8) + 64 + 32 * bj);
            transpose_item(p.in[I_WKVB], 1024, c0, 32, p.in[I_KVAG], wsp<bf16_t>(p, WS_WKVB), 256, nb * 32, kb * 64, scr, lane); continue; } r -= I_KVB;
        if (r < I_O) { const int nb = r / 16, kb = r % 16;
            if (kb < 8) transpose_item(p.in[I_WOM], 1024, nb * 32, 32, nullptr, wsp<bf16_t>(p, WS_WO), 1024, nb * 32, kb * 64, scr, lane);
            else transpose_item(p.in[I_WON] - (size_t)512 * 1024, 1024, nb * 32, 32, nullptr, wsp<bf16_t>(p, WS_WO), 1024, nb * 32, kb * 64, scr, lane);
            continue; } r -= I_O;
        if (r < I_OUT) { const int nb = r / 16, kb = r % 16; transpose_item(p.in[I_WOUT], 1024, nb * 32, 32, nullptr, wsp<bf16_t>(p, WS_WOUT), 1024, nb * 32, kb * 64, scr, lane); continue; } r -= I_OUT;
        if (r < I_GU) { const int nb = r / 16, kb = r % 16; const int pn = nb >> 3, bj = (nb >> 2) & 1, wc = nb & 3, s = 4 * pn + wc;
            transpose_item(bj ? p.in[I_WU] : p.in[I_WG], DFF, 32 * s, 32, nullptr, wsp<bf16_t>(p, WS_WGU), 1024, nb * 32, kb * 64, scr, lane); continue; } r -= I_GU;
        if (r < I_D) { const int nb = r / 44, kb = r % 44; transpose_item(p.in[I_WDN], 1024, nb * 32, 32, nullptr, wsp<bf16_t>(p, WS_WD), DFF, nb * 32, kb * 64, scr, lane); continue; } r -= I_D;
        { const int kv = r / 256, rr = r % 256, nb = rr / 32, kb = rr % 32;
          transpose_item(kv ? p.in[I_CW1V] : p.in[I_CW1K], 256, nb * 32, 32, nullptr, wsp<bf16_t>(p, WS_CW1) + (size_t)kv * 256 * 2048, 2048, nb * 32, kb * 64, scr, lane); }
    }
}
DI void stage_mod(const Params& p, int bid, int nb, float* lds, int wid0) {
    const int tid = opaque_tid(wid0), wave = tid >> 6, lane = tid & 63, nwv = blockDim.x >> 6;
    for (int u = bid; u < 104; u += nb) {
        float acc[8];
#pragma unroll
        for (int b = 0; b < 8; ++b) acc[b] = 0.f;
        if (u < 96) {
            const int n = u * 64 + lane; const float* W = p.in[I_ADAW]; const float* c = p.in[I_C];
            for (int k = wave * (1024 / nwv); k < (wave + 1) * (1024 / nwv); ++k) { const float w = W[(size_t)k * 6144 + n];
#pragma unroll
                for (int b = 0; b < 8; ++b) acc[b] += siluf(c[b * 1024 + k]) * w; }
        } else {
            const int kv = (u - 96) >> 2, n = ((u - 96) & 3) * 64 + lane; const float* W = kv ? p.in[I_CW1V] : p.in[I_CW1K]; const float* pos = kv ? p.in[I_CPV] : p.in[I_CPK];
            for (int k = wave * (2048 / nwv); k < (wave + 1) * (2048 / nwv); ++k) acc[0] += pos[k] * W[(size_t)k * 256 + n];
        }
        __syncthreads();
#pragma unroll
        for (int b = 0; b < 8; ++b) lds[(wave * 8 + b) * 64 + lane] = acc[b];
        __syncthreads();
        if (wave == 0) {
#pragma unroll
            for (int b = 0; b < 8; ++b) { float s = 0.f;
                for (int w = 0; w < nwv; ++w) s += lds[(w * 8 + b) * 64 + lane];
                if (u < 96) wsp<float>(p, WS_MOD)[b * 6144 + u * 64 + lane] = s + p.in[I_ADAB][u * 64 + lane];
                else if (b == 0) wsp<float>(p, WS_CB1)[(u - 96) * 64 + lane] = s; }
        }
    }
    __syncthreads();
}
DI void stage_rope(const Params& p, int gtid, int ngt) {
    float* T = wsp<float>(p, WS_ROPE); const int* pos = (const int*)p.in[I_POS];
    for (int i = gtid; i < MT * 24; i += ngt) {
        const int row = i / 24, j = i % 24; const float ps = (float)pos[row]; float inv, c, s;
        if (j < 16) inv = (float)pow(500000.0, -(double)j / 16.0); else inv = (float)pow(500000.0, -(double)(j - 16) / 8.0);
        sincos_rad(ps * inv, c, s);
        if (j < 16) { T[(size_t)row * 16 + j] = c; T[(size_t)MT * 16 + (size_t)row * 16 + j] = s; }
        else { T[(size_t)MT * 32 + (size_t)row * 8 + (j - 16)] = c; T[(size_t)MT * 40 + (size_t)row * 8 + (j - 16)] = s; }
    }
}
DI const float* ropeCM(const Params& p) { return wsp<float>(p, WS_ROPE); }
DI const float* ropeSM(const Params& p) { return wsp<float>(p, WS_ROPE) + (size_t)MT * 16; }
DI const float* ropeCN(const Params& p) { return wsp<float>(p, WS_ROPE) + (size_t)MT * 32; }
DI const float* ropeSN(const Params& p) { return wsp<float>(p, WS_ROPE) + (size_t)MT * 40; }

DI void stage_normmod(const float* X, const float* gain, const float* mod, int sh_idx, int sc_idx, bf16_t* Hout, int gw, int ngw, int lane) {
    for (int m = gw; m < MT; m += ngw) {
        const int b = m / SEQ; const f32x4* xr = (const f32x4*)(X + (size_t)m * DM) + lane;
        f32x4 v[4]; float s = 0.f;
#pragma unroll
        for (int j = 0; j < 4; ++j) { v[j] = xr[64 * j]; s += (v[j].x * v[j].x + v[j].y * v[j].y) + (v[j].z * v[j].z + v[j].w * v[j].w); }
        const float rstd = rsqrtf(wave_sum(s) * (1.f / DM) + EPS);
        const f32x4* g4 = (const f32x4*)gain + lane; const f32x4* sc4 = (const f32x4*)(mod + b * 6144 + sc_idx * 1024) + lane; const f32x4* sh4 = (const f32x4*)(mod + b * 6144 + sh_idx * 1024) + lane;
        u32x2* o8 = (u32x2*)(Hout + (size_t)m * DM) + lane;
#pragma unroll
        for (int j = 0; j < 4; ++j) { const f32x4 g = g4[64 * j], sc = sc4[64 * j], sh = sh4[64 * j];
            const f32x4 y = v[j] * rstd * g * (1.0f + sc) + sh; u32x2 w; w.x = pk2(y.x, y.y); w.y = pk2(y.z, y.w); o8[64 * j] = w; }
    }
}
DI void store8bf(bf16_t* dst, const float (&f)[8]) { *(u32x4*)dst = pack8(f); }
DI float ssq16(const float (&v)[2][8]) { float q = 0.f;
#pragma unroll
    for (int b = 0; b < 2; ++b)
#pragma unroll
        for (int j = 0; j < 8; ++j) q += v[b][j] * v[b][j];
    q += xorl<16>(q); return sum32(q); }

struct EpiZ {
    static constexpr bool HAS_MID = false; static constexpr int NTYPES = 7;
    Params p;
    DI void mid(int, int, int, int, float (&)[2][8]) const {}
    DI int type(int pn, int wc) const { const int s = 4 * pn + wc;
        if (s < 16) return 0; if (s == 16) return 1; if (s < 25) return 2; if (s < 37) { const int t = (s - 25) >> 1; return (t == 2 || t == 4) ? 3 : 4; } if (s < 40) return 5; return 6; }
    DI void normrope(int row, int fq, float (&v)[2][8], const float* gain, float post, bf16_t* dst) const {
        const float rstd = rsqrtf(ssq16(v) * (1.f / 64.f) + EPS);
#pragma unroll
        for (int b = 0; b < 2; ++b) { const f32x4 g0 = *(const f32x4*)(gain + 32 * b + 8 * fq), g1 = *(const f32x4*)(gain + 32 * b + 8 * fq + 4);
            v[b][0] *= rstd * g0.x; v[b][1] *= rstd * g0.y; v[b][2] *= rstd * g0.z; v[b][3] *= rstd * g0.w; v[b][4] *= rstd * g1.x; v[b][5] *= rstd * g1.y; v[b][6] *= rstd * g1.z; v[b][7] *= rstd * g1.w; }
        const float* cs = ropeCN(p) + (size_t)row * 8; const float* sn = ropeSN(p) + (size_t)row * 8;
#pragma unroll
        for (int j = 0; j < 8; ++j) { const float own = v[0][j], oth = xorl<16>(own); const float c = cs[j], s = sn[j];
            if (fq == 0) v[0][j] = own * c - oth * s; else if (fq == 1) v[0][j] = own * c + oth * s; }
#pragma unroll
        for (int b = 0; b < 2; ++b) {
#pragma unroll
            for (int j = 0; j < 8; ++j) v[b][j] *= post;
            store8bf(dst + 32 * b + 8 * fq, v[b]); }
    }
    template <int T> DI void apply(int row, int pn, int wc, int fq, float (&v)[2][8]) const {
        const int s = 4 * pn + wc;
        if constexpr (T == 0) {
            bf16_t* d = wsp<bf16_t>(p, WS_R1) + (size_t)row * 1024 + 64 * s + 8 * fq;
            const float q = ssq16(v); store8bf(d, v[0]); store8bf(d + 32, v[1]);
            if (fq == 0) wsp<float>(p, WS_SSQA)[(size_t)row * 16 + s] = q;
        } else if constexpr (T == 1) {
            float q = 0.f;
#pragma unroll
            for (int j = 0; j < 8; ++j) q += v[0][j] * v[0][j];
            q += xorl<16>(q); q = sum32(q);
            if (fq == 0) wsp<float>(p, WS_SSQPE)[row] = q;
            const float* kg = p.in[I_MKG] + 64 + 8 * fq; const int i0 = 8 * (fq & 1);
            const float* cs = ropeCM(p) + (size_t)row * 16 + i0; const float* sn = ropeSM(p) + (size_t)row * 16 + i0;
            float o[8];
#pragma unroll
            for (int j = 0; j < 8; ++j) { const float own = v[0][j] * kg[j], oth = xor32(own, fq >> 1); o[j] = (fq < 2) ? own * cs[j] - oth * sn[j] : own * cs[j] + oth * sn[j]; }
            store8bf(wsp<bf16_t>(p, WS_KPE) + (size_t)row * 32 + 8 * fq, o);
#pragma unroll
            for (int j = 0; j < 8; ++j) o[j] = sigmoidf(v[1][j]);
            store8bf(wsp<bf16_t>(p, WS_GN) + (size_t)row * 32 + 8 * fq, o);
        } else if constexpr (T == 2) {
            normrope(row, fq, v, p.in[I_NQG], C2N, wsp<bf16_t>(p, WS_QN) + (size_t)row * 512 + 64 * (s - 17));
        } else if constexpr (T == 3 || T == 4) {
            const int t = (s - 25) >> 1, g = (s - 25) & 1;
            bf16_t* d = wsp<bf16_t>(p, WS_KC + (size_t)t * 4 * MiB) + (size_t)row * 128 + 64 * g;
            if constexpr (T == 3) normrope(row, fq, v, (t == 2) ? p.in[I_NKSG] : p.in[I_NKWG], 1.0f, d);
            else { store8bf(d + 8 * fq, v[0]); store8bf(d + 32 + 8 * fq, v[1]); }
        } else if constexpr (T == 5) {
        } else {
            bf16_t* d = wsp<bf16_t>(p, WS_R2) + (size_t)row * 2048 + 64 * (s - 40) + 8 * fq;
#pragma unroll
            for (int b = 0; b < 2; ++b) { float o[8];
#pragma unroll
                for (int j = 0; j < 8; ++j) o[j] = sigmoidf(v[b][j]);
                store8bf(d + 32 * b, o); }
        }
    }
};
struct EpiQ {
    static constexpr bool HAS_MID = false; static constexpr int NTYPES = 1;
    Params p;
    DI int type(int, int) const { return 0; }
    DI void mid(int, int, int, int, float (&)[2][8]) const {}
    template <int T> DI void apply(int row, int pn, int wc, int fq, float (&v)[2][8]) const {
        const float* sq = wsp<float>(p, WS_SSQA) + (size_t)row * 16; float s = 0.f;
#pragma unroll
        for (int i = 0; i < 12; ++i) s += sq[i];
        const float rstd = rsqrtf(s * (1.f / 768.f) + EPS);
        bf16_t* d = wsp<bf16_t>(p, WS_R0) + (size_t)row * 768 + 256 * pn + 32 * wc + 8 * fq;
#pragma unroll
        for (int b = 0; b < 2; ++b) { float o[8];
#pragma unroll
            for (int j = 0; j < 8; ++j) o[j] = v[b][j] * rstd;
            store8bf(d + 128 * b, o); }
    }
};
struct EpiKV {
    static constexpr bool HAS_MID = false; static constexpr int NTYPES = 1;
    Params p;
    DI int type(int, int) const { return 0; }
    DI void mid(int, int, int, int, float (&)[2][8]) const {}
    template <int T> DI void apply(int row, int pn, int wc, int fq, float (&v)[2][8]) const {
        const int s = 4 * pn + wc;
        const float* sq = wsp<float>(p, WS_SSQA) + (size_t)row * 16 + 12;
        const float rstd = rsqrtf(((sq[0] + sq[1]) + (sq[2] + sq[3])) * (1.f / 256.f) + EPS);
#pragma unroll
        for (int b = 0; b < 2; ++b)
#pragma unroll
            for (int j = 0; j < 8; ++j) v[b][j] *= rstd;
        if (s < 8) { const float q = ssq16(v); if (fq == 0) wsp<float>(p, WS_SSQKN)[(size_t)row * 8 + s] = q;
            bf16_t* d = wsp<bf16_t>(p, WS_KN) + (size_t)row * 512 + 64 * s + 8 * fq; store8bf(d, v[0]); store8bf(d + 32, v[1]); }
        else { bf16_t* d = wsp<bf16_t>(p, WS_VM) + (size_t)row * 512 + 64 * (s - 8) + 8 * fq; store8bf(d, v[0]); store8bf(d + 32, v[1]); }
    }
};
struct EpiMerge {
    static constexpr bool HAS_MID = true; static constexpr int NTYPES = 1;
    Params p;
    DI int type(int, int) const { return 0; }
    DI void mid(int row, int pn, int wc, int fq, float (&v)[2][8]) const {
        const bf16_t* g = wsp<bf16_t>(p, WS_R2) + (size_t)row * 2048 + 256 * pn + 32 * wc + 8 * fq;
#pragma unroll
        for (int b = 0; b < 2; ++b) { float s1[8], s2[8]; unpack8(*(const u32x4*)(g + 128 * b), s1); unpack8(*(const u32x4*)(g + 1024 + 128 * b), s2);
#pragma unroll
            for (int j = 0; j < 8; ++j) v[b][j] *= s1[j] * __builtin_amdgcn_rcpf(s2[j]); }
    }
    template <int T> DI void apply(int row, int pn, int wc, int fq, float (&v)[2][8]) const {
        const bf16_t* g = wsp<bf16_t>(p, WS_R2) + (size_t)row * 2048 + 1024 + 256 * pn + 32 * wc + 8 * fq;
        bf16_t* d = wsp<bf16_t>(p, WS_R0) + (size_t)row * 1024 + 256 * pn + 32 * wc + 8 * fq;
#pragma unroll
        for (int b = 0; b < 2; ++b) { float s2[8], o[8]; unpack8(*(const u32x4*)(g + 128 * b), s2);
#pragma unroll
            for (int j = 0; j < 8; ++j) o[j] = v[b][j] * s2[j];
            store8bf(d + 128 * b, o); }
    }
};
struct EpiOut {
    static constexpr bool HAS_MID = false; static constexpr int NTYPES = 1;
    Params p;
    DI int type(int, int) const { return 0; }
    DI void mid(int, int, int, int, float (&)[2][8]) const {}
    template <int T> DI void apply(int row, int pn, int wc, int fq, float (&v)[2][8]) const {
        const int b_ = row / SEQ, col = 256 * pn + 32 * wc + 8 * fq;
        const float* gt = wsp<float>(p, WS_MOD) + b_ * 6144 + 2 * 1024 + col; const float* x = p.in[I_X] + (size_t)row * DM + col; float* d = wsp<float>(p, WS_R2) + (size_t)row * DM + col;
#pragma unroll
        for (int b = 0; b < 2; ++b)
#pragma unroll
            for (int h = 0; h < 2; ++h) { const f32x4 g = *(const f32x4*)(gt + 128 * b + 4 * h), xv = *(const f32x4*)(x + 128 * b + 4 * h);
                f32x4 o; o.x = xv.x + g.x * v[b][4 * h]; o.y = xv.y + g.y * v[b][4 * h + 1]; o.z = xv.z + g.z * v[b][4 * h + 2]; o.w = xv.w + g.w * v[b][4 * h + 3]; *(f32x4*)(d + 128 * b + 4 * h) = o; }
    }
};
struct EpiGU {
    static constexpr bool HAS_MID = false; static constexpr int NTYPES = 1;
    Params p;
    DI int type(int, int) const { return 0; }
    DI void mid(int, int, int, int, float (&)[2][8]) const {}
    template <int T> DI void apply(int row, int pn, int wc, int fq, float (&v)[2][8]) const {
        const int s = 4 * pn + wc; float o[8];
#pragma unroll
        for (int j = 0; j < 8; ++j) o[j] = siluf(v[0][j]) * v[1][j];
        store8bf(wsp<bf16_t>(p, WS_HID) + (size_t)row * DFF + 32 * s + 8 * fq, o);
    }
};
struct EpiDown {
    static constexpr bool HAS_MID = false; static constexpr int NTYPES = 1;
    Params p;
    DI int type(int, int) const { return 0; }
    DI void mid(int, int, int, int, float (&)[2][8]) const {}
    template <int T> DI void apply(int row, int pn, int wc, int fq, float (&v)[2][8]) const {
        const int b_ = row / SEQ, col = 256 * pn + 32 * wc + 8 * fq;
        const float* gt = wsp<float>(p, WS_MOD) + b_ * 6144 + 5 * 1024 + col; const float* x = wsp<float>(p, WS_R2) + (size_t)row * DM + col; float* d = p.out + (size_t)row * DM + col;
#pragma unroll
        for (int b = 0; b < 2; ++b)
#pragma unroll
            for (int h = 0; h < 2; ++h) { const f32x4 g = *(const f32x4*)(gt + 128 * b + 4 * h), xv = *(const f32x4*)(x + 128 * b + 4 * h);
                f32x4 o; o.x = xv.x + g.x * v[b][4 * h]; o.y = xv.y + g.y * v[b][4 * h + 1]; o.z = xv.z + g.z * v[b][4 * h + 2]; o.w = xv.w + g.w * v[b][4 * h + 3]; *(f32x4*)(d + 128 * b + 4 * h) = o; }
    }
};

template <class Epi, int T> DI void apply_dispatch(const Epi& E, int ty, int row, int pn, int wc, int fq, float (&v)[2][8]) {
    if constexpr (T < Epi::NTYPES) { if (ty == T) E.template apply<T>(row, pn, wc, fq, v); else apply_dispatch<Epi, T + 1>(E, ty, row, pn, wc, fq, v); }
}
template <class Epi>
DI void gemm_naive(const bf16_t* A, int lda, const bf16_t* Bt, int ldb, int M, int N, int K, int kmid, const Epi& E, int gw, int ngw) {
    const int lane = threadIdx.x & 63, fr = lane & 15, fq = lane >> 4;
    const int nslots = N / 64; const long total = (long)(M / 16) * nslots;
    for (long u = gw; u < total; u += ngw) {
        const int rg = (int)(u / nslots), s = (int)(u % nslots), pn = s >> 2, wc = s & 3, row = rg * 16 + fr;
        float v[2][8];
#pragma unroll
        for (int b = 0; b < 2; ++b)
#pragma unroll
            for (int j = 0; j < 8; ++j) v[b][j] = 0.f;
        const bf16_t* a = A + (size_t)row * lda; const bf16_t* bb = Bt + (size_t)(256 * pn + 32 * wc + 8 * fq) * ldb;
        for (int k = 0; k < K; k += 8) {
            if (Epi::HAS_MID && k == kmid) E.mid(row, pn, wc, fq, v);
            float af[8]; unpack8(*(const u32x4*)(a + k), af);
#pragma unroll
            for (int b = 0; b < 2; ++b)
#pragma unroll
                for (int j = 0; j < 8; ++j) { float bf[8]; unpack8(*(const u32x4*)(bb + (size_t)(128 * b + j) * ldb + k), bf); float d = 0.f;
#pragma unroll
                    for (int e = 0; e < 8; ++e) d += af[e] * bf[e];
                    v[b][j] += d; }
        }
        apply_dispatch<Epi, 0>(E, E.type(pn, wc), row, pn, wc, fq, v);
    }
}
namespace pg8 {
#define PG8_LAS __attribute__((address_space(3)))
typedef short bf16x8 __attribute__((ext_vector_type(8)));
constexpr int BM = 256, BK = 64, HALF = 128, HTB = HALF * BK * 2  , STAGE_BYTES = 8 * HTB, NXCD = 8, WGM = 8;

__host__ __device__ __forceinline__ int lds_byte(int r, int c) { const int st = (r >> 4) * 2 + (c >> 5), rr = r & 15, cc = c & 31, ob = rr * 64 + cc * 2; return st * 1024 + (ob ^ (((ob >> 9) & 1) << 5)); }
__host__ __device__ __forceinline__ void stage_rc(int b, int& R, int& C) { const int st = b / 1024, sb = b % 1024, swz = sb ^ (((sb >> 9) & 1) << 5); R = (st >> 1) * 16 + swz / 64; C = (st & 1) * 32 + (swz % 64) / 2; }
__host__ __device__ __forceinline__ int perm32(int rho) { const int n = rho >> 4, i = rho & 15; return 8 * (i >> 2) + 4 * n + (i & 3); }

struct Unit { int pm, pn; };
struct Gemm { const bf16_t* A; const bf16_t* Bt; int M, N, K, lda, ldb, kstepA; };

struct StaticOrder {
    int nM, nN, nwg, G, c;
    __host__ __device__ void init(int M, int N, int G_, int c_) { nM = M / BM; nN = N / BM; nwg = nM * nN; G = G_; c = c_; }
    __host__ __device__ bool next(int i, Unit& u) const {
        const long L = (long)i * G + c; if (L >= nwg) return false;
        int wgid = (int)L; { const int q = nwg / NXCD, r = nwg % NXCD, xcd = wgid % NXCD, off = wgid / NXCD; wgid = (xcd < r ? xcd * (q + 1) : r * (q + 1) + (xcd - r) * q) + off; }
        const int nig = WGM * nN, gid = wgid / nig, fm = gid * WGM, gsz = (nM - fm) < WGM ? (nM - fm) : WGM;
        u.pm = fm + ((wgid % nig) % gsz); u.pn = (wgid % nig) / gsz; return true;
    }
    __device__ __forceinline__ void a_ready(const Unit&) const {}
    __device__ __forceinline__ void done(const Unit&) const {}
};

template <class Epi, class Sched, bool ALIGN_EPI = false, bool SP2 = false>
__device__ __forceinline__ void gemm_phase(PG8_LAS unsigned char* lds, const Gemm g, const Sched& S, const Epi& E, int wid0) {
    const int tid = opaque_tid(wid0), wid = __builtin_amdgcn_readfirstlane(tid >> 6), lane = tid & 63, wr = wid >> 2, wc = wid & 3, fr = lane & 15, fq = lane >> 4;
    const int K = g.K; int nt = K / BK; asm volatile("" : "+s"(nt));
    unsigned voffA[2], voffB[2];
#pragma unroll
    for (int i = 0; i < 2; ++i) { int R, C; stage_rc(tid * 16 + i * 8192, R, C); const int Rb = Epi::PERM ? ((R & ~31) + perm32(R & 31)) : R;
        voffA[i] = (unsigned)(R * g.lda + C) * 2u; voffB[i] = (unsigned)(Rb * g.ldb + C) * 2u; }
    const size_t kstep = (size_t)(BK * 2), kstepA = (size_t)g.kstepA;
    const size_t hstepB = (size_t)HALF * g.ldb * 2, hstepA = (size_t)HALF * g.lda * 2;
    const size_t tstepB = 2 * hstepB, tstepA = 2 * hstepA;
    const unsigned ldsw = (unsigned)wid * 1024u;
    const int aoff = lds_byte(wr * 64 + fr, fq * 8), boff = lds_byte(wc * 32 + fr, fq * 8);
#define PG8_SA(b, h) (((b) * 2 + (h)) * HTB)
#define PG8_SB(b, h) ((4 + (b) * 2 + (h)) * HTB)
#define PG8_STAGE(bufoff, gbase, voff) do { _Pragma("unroll") for (int _i = 0; _i < 2; ++_i) \
        __builtin_amdgcn_global_load_lds((const unsigned*)((const char*)(gbase) + (voff)[_i]), (PG8_LAS unsigned*)(lds + (bufoff) + ldsw + _i * 8192), 16, 0, 0); } while (0)
#define PG8_LDA(dst, b, h) do { _Pragma("unroll") for (int m = 0; m < 4; ++m) _Pragma("unroll") for (int k = 0; k < 2; ++k) dst[m][k] = *(const PG8_LAS bf16x8*)(lds + PG8_SA(b, h) + aoff + m * 2048 + k * 1024); } while (0)
#define PG8_LDB(dst, b, h) do { _Pragma("unroll") for (int n = 0; n < 2; ++n) _Pragma("unroll") for (int k = 0; k < 2; ++k) dst[n][k] = *(const PG8_LAS bf16x8*)(lds + PG8_SB(b, h) + boff + n * 2048 + k * 1024); } while (0)
#define PG8_MMA(ai, bj, At, Bt) do { __builtin_amdgcn_s_setprio(1); _Pragma("unroll") for (int m = 0; m < 4; ++m) _Pragma("unroll") for (int n = 0; n < 2; ++n) _Pragma("unroll") for (int k = 0; k < 2; ++k) \
        acc[ai][bj][m][n] = __builtin_amdgcn_mfma_f32_16x16x32_bf16(Bt[n][k], At[m][k], acc[ai][bj][m][n], 0, 0, 0); __builtin_amdgcn_s_setprio(0); } while (0)
#define PG8_WAIT_V(n) asm volatile("s_waitcnt vmcnt(" #n ")" ::: "memory")
#define PG8_WAIT_L(n) asm volatile("s_waitcnt lgkmcnt(" #n ")" ::: "memory")
#define PG8_BAR __builtin_amdgcn_s_barrier()
#define PG8_SCHED __builtin_amdgcn_sched_barrier(0)
    Unit cur, nxt; int ui = 0;
    if (!S.next(0, cur)) return;
    f32x4 acc[2][2][4][2];
#pragma unroll
    for (int a = 0; a < 2; ++a)
#pragma unroll
        for (int b = 0; b < 2; ++b)
#pragma unroll
            for (int m = 0; m < 4; ++m)
#pragma unroll
                for (int n = 0; n < 2; ++n) acc[a][b][m][n] = (f32x4){0.f, 0.f, 0.f, 0.f};
    bf16x8 At[4][2], B0[2][2], B1[2][2];
    const char* cA = (const char*)g.A + (size_t)cur.pm * tstepA; const char* cB = (const char*)g.Bt + (size_t)cur.pn * tstepB;
    S.a_ready(cur);
    if constexpr (SP2) {
        PG8_STAGE(PG8_SB(0, 0), cB, voffB); PG8_STAGE(PG8_SB(0, 1), cB + hstepB, voffB); PG8_STAGE(PG8_SA(0, 0), cA, voffA); PG8_STAGE(PG8_SA(0, 1), cA + hstepA, voffA);
        if (wr == 1) PG8_BAR;
        PG8_WAIT_V(2); PG8_BAR;
        PG8_STAGE(PG8_SB(1, 0), cB + kstep, voffB); PG8_STAGE(PG8_SA(1, 0), cA + kstepA, voffA); PG8_STAGE(PG8_SB(1, 1), cB + hstepB + kstep, voffB);
        PG8_WAIT_V(6); PG8_BAR;
    } else {
        PG8_STAGE(PG8_SB(0, 0), cB, voffB); PG8_STAGE(PG8_SA(0, 0), cA, voffA); PG8_STAGE(PG8_SB(0, 1), cB + hstepB, voffB); PG8_STAGE(PG8_SA(0, 1), cA + hstepA, voffA);
        if (wr == 1) PG8_BAR;
        PG8_WAIT_V(4); PG8_BAR;
        PG8_STAGE(PG8_SB(1, 0), cB + kstep, voffB); PG8_STAGE(PG8_SA(1, 0), cA + kstepA, voffA); PG8_STAGE(PG8_SB(1, 1), cB + hstepB + kstep, voffB);
        PG8_WAIT_V(6); PG8_BAR;
    }
    for (;;) {
        const bool has_next = S.next(ui + 1, nxt);
        const char* nA = has_next ? (const char*)g.A + (size_t)nxt.pm * tstepA : cA; const char* nB = has_next ? (const char*)g.Bt + (size_t)nxt.pn * tstepB : cB;
        for (int hh_ = 0; hh_ < (Epi::HAS_MID ? 2 : 1); ++hh_) {
        if constexpr (Epi::HAS_MID) { if (hh_ == 1) E.mid(acc, cur, wr, wc, fr, fq); }
        const int t0_ = Epi::HAS_MID ? hh_ * (nt >> 1) : 0, t1_ = Epi::HAS_MID ? (hh_ + 1) * (nt >> 1) : nt;
        for (int t = t0_; t < t1_; t += 2) {
            const bool last = (t == nt - 2);
            const char* a1 = cA + (size_t)(t + 1) * kstepA;
            const char* a2 = last ? nA : cA + (size_t)(t + 2) * kstepA; const char* b2 = last ? nB : cB + (size_t)(t + 2) * kstep;
            const char* a3 = a2 + kstepA; const char* b3 = b2 + kstep;
            if (last && has_next) S.a_ready(nxt);
            if constexpr (SP2) {
            PG8_LDB(B0, 0, 0); PG8_LDB(B1, 0, 1); PG8_SCHED; PG8_LDA(At, 0, 0); PG8_STAGE(PG8_SA(1, 1), a1 + hstepA, voffA);
            PG8_WAIT_V(8); PG8_WAIT_L(0); PG8_BAR; PG8_MMA(0, 0, At, B0); PG8_MMA(0, 1, At, B1); PG8_BAR; PG8_SCHED;
            PG8_LDA(At, 0, 1); PG8_STAGE(PG8_SB(0, 0), b2, voffB); PG8_STAGE(PG8_SB(0, 1), b2 + hstepB, voffB); PG8_STAGE(PG8_SA(0, 0), a2, voffA);
            PG8_WAIT_V(8); PG8_WAIT_L(0); PG8_BAR; PG8_MMA(1, 0, At, B0); PG8_MMA(1, 1, At, B1); PG8_BAR; PG8_SCHED;
            PG8_LDB(B0, 1, 0); PG8_LDB(B1, 1, 1); PG8_SCHED; PG8_LDA(At, 1, 0); PG8_STAGE(PG8_SA(0, 1), a2 + hstepA, voffA);
            PG8_WAIT_V(8); PG8_WAIT_L(0); PG8_BAR; PG8_MMA(0, 0, At, B0); PG8_MMA(0, 1, At, B1); PG8_BAR; PG8_SCHED;
            PG8_LDA(At, 1, 1); PG8_STAGE(PG8_SB(1, 0), b3, voffB); PG8_STAGE(PG8_SB(1, 1), b3 + hstepB, voffB); PG8_STAGE(PG8_SA(1, 0), a3, voffA);
            PG8_WAIT_V(8); PG8_WAIT_L(0); PG8_BAR; PG8_MMA(1, 0, At, B0); PG8_MMA(1, 1, At, B1); PG8_BAR; PG8_SCHED;
            } else {
            PG8_LDB(B0, 0, 0); PG8_SCHED; PG8_LDA(At, 0, 0); PG8_STAGE(PG8_SA(1, 1), a1 + hstepA, voffA);
            PG8_WAIT_L(8); PG8_BAR; PG8_WAIT_L(0); PG8_MMA(0, 0, At, B0); PG8_BAR; PG8_SCHED;
            PG8_LDB(B1, 0, 1); PG8_STAGE(PG8_SB(0, 0), b2, voffB);
            PG8_BAR; PG8_WAIT_L(0); PG8_MMA(0, 1, At, B1); PG8_BAR;
            PG8_LDA(At, 0, 1); PG8_STAGE(PG8_SA(0, 0), a2, voffA);
            PG8_BAR; PG8_WAIT_L(0); PG8_MMA(1, 0, At, B0); PG8_BAR; PG8_SCHED;
            PG8_STAGE(PG8_SB(0, 1), b2 + hstepB, voffB);
            PG8_WAIT_V(6); PG8_BAR; PG8_MMA(1, 1, At, B1); PG8_BAR;
            PG8_LDB(B0, 1, 0); PG8_SCHED; PG8_LDA(At, 1, 0); PG8_STAGE(PG8_SA(0, 1), a2 + hstepA, voffA);
            PG8_WAIT_L(8); PG8_BAR; PG8_WAIT_L(0); PG8_MMA(0, 0, At, B0); PG8_BAR; PG8_SCHED;
            PG8_LDB(B1, 1, 1); PG8_STAGE(PG8_SB(1, 0), b3, voffB);
            PG8_BAR; PG8_WAIT_L(0); PG8_MMA(0, 1, At, B1); PG8_BAR;
            PG8_LDA(At, 1, 1); PG8_STAGE(PG8_SA(1, 0), a3, voffA);
            PG8_BAR; PG8_WAIT_L(0); PG8_MMA(1, 0, At, B0); PG8_BAR; PG8_SCHED;
            PG8_STAGE(PG8_SB(1, 1), b3 + hstepB, voffB);
            PG8_WAIT_V(6); PG8_BAR; PG8_MMA(1, 1, At, B1); PG8_BAR;
            }
        }
        }
        if constexpr (ALIGN_EPI) { if (wr == 0) PG8_BAR; }
        if constexpr (!Epi::AFTER_DRAIN) { E(acc, cur, wr, wc, fr, fq); S.done(cur); }
        if (!has_next) break;
#pragma unroll
        for (int a = 0; a < 2; ++a)
#pragma unroll
            for (int b = 0; b < 2; ++b)
#pragma unroll
                for (int m = 0; m < 4; ++m)
#pragma unroll
                    for (int n = 0; n < 2; ++n) acc[a][b][m][n] = (f32x4){0.f, 0.f, 0.f, 0.f};
        cur = nxt; cA = nA; cB = nB; ++ui;
        if constexpr (ALIGN_EPI) { if (wr == 1) PG8_BAR; }
    }
    PG8_WAIT_V(0);
    if constexpr (!ALIGN_EPI) { if (wr == 0) PG8_BAR; }
    PG8_BAR;
    if constexpr (Epi::AFTER_DRAIN) { E.fused(acc, cur, wr, wc, fr, fq, lds, wid, lane); S.done(cur); }
#undef PG8_SA
#undef PG8_SB
#undef PG8_STAGE
#undef PG8_LDA
#undef PG8_LDB
#undef PG8_MMA
#undef PG8_WAIT_V
#undef PG8_WAIT_L
#undef PG8_BAR
#undef PG8_SCHED
}
}

template <class SE> struct EpiAdapt {
    static constexpr bool PERM = true, AFTER_DRAIN = false, HAS_MID = SE::HAS_MID;
    SE se;
    template <int T> DI void run(f32x4 (&acc)[2][2][4][2], const pg8::Unit& u, int wr, int wc, int fr, int fq) const {
#pragma unroll
        for (int ai = 0; ai < 2; ++ai)
#pragma unroll
            for (int m = 0; m < 4; ++m) {
                int row = fr; asm volatile("" : "+v"(row)); row += u.pm * 256 + ai * 128 + wr * 64 + m * 16; float v[2][8];
#pragma unroll
                for (int bj = 0; bj < 2; ++bj)
#pragma unroll
                    for (int n = 0; n < 2; ++n) { v[bj][4 * n] = acc[ai][bj][m][n][0]; v[bj][4 * n + 1] = acc[ai][bj][m][n][1]; v[bj][4 * n + 2] = acc[ai][bj][m][n][2]; v[bj][4 * n + 3] = acc[ai][bj][m][n][3]; }
                se.template apply<T>(row, u.pn, wc, fq, v);
                asm volatile("" ::: "memory");
            }
    }
    template <int T> DI void disp(int ty, f32x4 (&acc)[2][2][4][2], const pg8::Unit& u, int wr, int wc, int fr, int fq) const {
        if constexpr (T < SE::NTYPES) { if (ty == T) run<T>(acc, u, wr, wc, fr, fq); else disp<T + 1>(ty, acc, u, wr, wc, fr, fq); }
    }
    DI void operator()(f32x4 (&acc)[2][2][4][2], const pg8::Unit& u, int wr, int wc, int fr, int fq) const { disp<0>(se.type(u.pn, wc), acc, u, wr, wc, fr, fq); }
    DI void mid(f32x4 (&acc)[2][2][4][2], const pg8::Unit& u, int wr, int wc, int fr, int fq) const {
#pragma unroll
        for (int ai = 0; ai < 2; ++ai)
#pragma unroll
            for (int m = 0; m < 4; ++m) {
                int row = fr; asm volatile("" : "+v"(row)); row += u.pm * 256 + ai * 128 + wr * 64 + m * 16; float v[2][8];
#pragma unroll
                for (int bj = 0; bj < 2; ++bj)
#pragma unroll
                    for (int n = 0; n < 2; ++n) { v[bj][4 * n] = acc[ai][bj][m][n][0]; v[bj][4 * n + 1] = acc[ai][bj][m][n][1]; v[bj][4 * n + 2] = acc[ai][bj][m][n][2]; v[bj][4 * n + 3] = acc[ai][bj][m][n][3]; }
                se.mid(row, u.pn, wc, fq, v);
                asm volatile("" ::: "memory");
#pragma unroll
                for (int bj = 0; bj < 2; ++bj)
#pragma unroll
                    for (int n = 0; n < 2; ++n) { acc[ai][bj][m][n][0] = v[bj][4 * n]; acc[ai][bj][m][n][1] = v[bj][4 * n + 1]; acc[ai][bj][m][n][2] = v[bj][4 * n + 2]; acc[ai][bj][m][n][3] = v[bj][4 * n + 3]; }
            }
    }
};
template <class SE> DI void gemm_fast(PG8_LAS unsigned char* lds, const bf16_t* A, int lda, const bf16_t* Bt, int M, int N, int K, const SE& se, int G, int c, int wid0) {
    pg8::Gemm g{A, Bt, M, N, K, lda, K, 128}; pg8::StaticOrder S; S.init(M, N, G, c);
    EpiAdapt<SE> E{se};
    pg8::gemm_phase<EpiAdapt<SE>, pg8::StaticOrder, true, true>(lds, g, S, E, wid0);
}
struct RangeOrder {
    int base, cnt, nN;
    DI bool next(int i, pg8::Unit& u) const { if (i >= cnt) return false; const int L = base + i; u.pm = L / nN; u.pn = L % nN; return true; }
    DI void a_ready(const pg8::Unit&) const {}
    DI void done(const pg8::Unit&) const {}
};
template <class SE> DI void gemm_fast_range(PG8_LAS unsigned char* lds, const bf16_t* A, int lda, const bf16_t* Bt, int M, int N, int K, const SE& se, int base, int cnt, int wid0) {
    pg8::Gemm g{A, Bt, M, N, K, lda, K, 128}; RangeOrder S{base, cnt, N / 256};
    EpiAdapt<SE> E{se};
    pg8::gemm_phase<EpiAdapt<SE>, RangeOrder, true, true>(lds, g, S, E, wid0);
}
struct OneUnit {
    int pm, pn;
    DI bool next(int i, pg8::Unit& u) const { if (i > 0) return false; u.pm = pm; u.pn = pn; return true; }
    DI void a_ready(const pg8::Unit&) const {}
    DI void done(const pg8::Unit&) const {}
};
struct EpiCmpH {
    static constexpr bool HAS_MID = false; static constexpr int NTYPES = 1;
    float* H;
    DI int type(int, int) const { return 0; }
    DI void mid(int, int, int, int, float (&)[2][8]) const {}
    template <int T> DI void apply(int row, int pn, int wc, int fq, float (&v)[2][8]) const {
        float* d = H + (size_t)row * 256 + 32 * wc + 8 * fq;
#pragma unroll
        for (int b = 0; b < 2; ++b) { *(f32x4*)(d + 128 * b) = (f32x4){v[b][0], v[b][1], v[b][2], v[b][3]}; *(f32x4*)(d + 128 * b + 4) = (f32x4){v[b][4], v[b][5], v[b][6], v[b][7]}; }
    }
};
DI void cmp_hidden_fast(const Params& p, PG8_LAS unsigned char* lds, int cu, int wid0) {
    const int kv = cu >> 4, g = (cu >> 3) & 1, pm = (cu >> 1) & 3, sp = cu & 1;
    const bf16_t* A = wsp<bf16_t>(p, kv ? WS_VC : WS_KC) + g * 64 + (size_t)(16 * sp) * 128;
    const bf16_t* Bt = wsp<bf16_t>(p, WS_CW1) + (size_t)kv * 256 * 2048 + 1024 * sp;
    pg8::Gemm gm{A, Bt, 1024, 256, 1024, 2048, 2048, 256}; OneUnit S{pm, 0};
    EpiCmpH se{wsp<float>(p, WS_CMPH) + (size_t)((kv * 2 + g) * 2 + sp) * 1024 * 256};
    EpiAdapt<EpiCmpH> E{se};
    pg8::gemm_phase<EpiAdapt<EpiCmpH>, OneUnit, true, true>(lds, gm, S, E, wid0);
}
template <bool SPLIT> DI void cmp_out(const Params& p, int gw, int ngw, int lane) {
    const float* H = wsp<float>(p, WS_CMPH);
    for (int u = gw; u < 2 * 2 * 1024; u += ngw) {
        const int r = u & 1023, g = (u >> 10) & 1, kv = u >> 11; const int b = r >> 7, n = r & 127;
        bf16_t* dst = wsp<bf16_t>(p, kv ? WS_VCF : WS_KCF) + (size_t)r * 128 + g * 64 + lane;
        if (n == 127) { *dst = 0; continue; }
        const float* w2 = (kv ? p.in[I_CW2V] : p.in[I_CW2K]) + lane;
        float acc = 0.f;
        if constexpr (SPLIT) {
            const float* h = H + ((size_t)((kv * 2 + g) * 2) * 1024 + r) * 256; const float* cb = wsp<float>(p, WS_CB1) + kv * 256;
            float hv[4];
#pragma unroll
            for (int q = 0; q < 4; ++q) { const int j = 64 * q + lane; hv[q] = siluf((h[j] + h[(size_t)1024 * 256 + j]) + cb[j]); }
#pragma unroll
            for (int q = 0; q < 4; ++q)
#pragma unroll
                for (int jj = 0; jj < 64; ++jj) acc += __int_as_float(__builtin_amdgcn_readlane(__float_as_int(hv[q]), jj)) * w2[(64 * q + jj) * 64];
        } else {
            const float* h = H + (size_t)u * 256;
            for (int j = 0; j < 256; ++j) acc += h[j] * w2[j * 64];
        }
        if (kv == 0) {
            const float rstd = rsqrtf(wave_sum(acc * acc) * (1.f / 64.f) + EPS);
            float y = acc * rstd * p.in[I_NKCG][lane];
            const int prow = b * SEQ + 16 * n + 31; const float oth = xorl<8>(y);
            if (lane < 16) { const float c = ropeCN(p)[(size_t)prow * 8 + (lane & 7)], s = ropeSN(p)[(size_t)prow * 8 + (lane & 7)]; y = (lane < 8) ? y * c - oth * s : y * c + oth * s; }
            acc = y;
        }
        *dst = (bf16_t)f2bf(acc);
    }
}

DI unsigned select_blocks(const float (&imp)[32], int cur) {
    if (cur < 8) return (2u << cur) - 1u;
    unsigned mask = 1u | (1u << cur) | (1u << (cur - 1));
#pragma unroll 1
    for (int it = 0; it < 5; ++it) {
        float best = -1.0f; int bi = 1;
#pragma unroll
        for (int j = 1; j < 32; ++j) { const bool ok = (j <= cur - 2) && !((mask >> j) & 1u); if (ok && imp[j] > best) { best = imp[j]; bi = j; } }
        mask |= 1u << bi;
    }
    return mask;
}

namespace fa {
typedef short bf16x8 __attribute__((ext_vector_type(8)));
typedef short s16x4 __attribute__((ext_vector_type(4)));
typedef float f32x16 __attribute__((ext_vector_type(16)));
typedef LAS const char* lds_cptr;
typedef LAS char* lds_ptr;
constexpr int KBUF = 12288, VBUF = 8192;
constexpr int L_K = 0, L_V = 2 * KBUF, L_RK = L_V + 2 * VBUF, L_WS = L_RK + 512, L_OST = L_WS + 8 * 256, L_END = L_OST + 8 * 4096;
#define FA_SBAR() __builtin_amdgcn_sched_barrier(0)
DI int crow(int r, int hi) { return (r & 3) + 8 * (r >> 2) + 4 * hi; }
typedef float f32x2_t __attribute__((ext_vector_type(2))); typedef __bf16 bf16x2_t __attribute__((ext_vector_type(2)));
DI unsigned cvtpk(float lo, float hi) { f32x2_t v = {lo, hi}; bf16x2_t b = __builtin_convertvector(v, bf16x2_t); return __builtin_bit_cast(unsigned, b); }

template <int DK> DI void qkt(f32x16& p0, f32x16& p1, lds_cptr kb, const bf16x8* qr) {
    f32x16 z;
#pragma unroll
    for (int i = 0; i < 16; ++i) z[i] = 0.f;
#pragma unroll
    for (int d0 = 0; d0 < DK / 16; ++d0) {
        const bf16x8 b0 = *(const LAS bf16x8*)(kb + d0 * 2048);
        const bf16x8 b1 = *(const LAS bf16x8*)(kb + d0 * 2048 + 512);
        if (d0 == 0) { p0 = __builtin_amdgcn_mfma_f32_32x32x16_bf16(b0, qr[0], z, 0, 0, 0); p1 = __builtin_amdgcn_mfma_f32_32x32x16_bf16(b1, qr[0], z, 0, 0, 0); }
        else { p0 = __builtin_amdgcn_mfma_f32_32x32x16_bf16(b0, qr[d0], p0, 0, 0, 0); p1 = __builtin_amdgcn_mfma_f32_32x32x16_bf16(b1, qr[d0], p1, 0, 0, 0); }
    }
}
DI void pv(f32x16* o, int vb, bf16x8 pa0, bf16x8 pa1, bf16x8 pa2, bf16x8 pa3) {
#pragma unroll
    for (int d0 = 0; d0 < 2; ++d0) { s16x4 lo[4], hi[4];
#pragma unroll
        for (int ks = 0; ks < 4; ++ks) {
            asm volatile("ds_read_b64_tr_b16 %0,%1 offset:%c2" : "=&v"(lo[ks]) : "v"(vb), "i"(d0 * 4096 + ks * 1024) : "memory");
            asm volatile("ds_read_b64_tr_b16 %0,%1 offset:%c2" : "=&v"(hi[ks]) : "v"(vb), "i"(d0 * 4096 + ks * 1024 + 512) : "memory"); }
        asm volatile("s_waitcnt lgkmcnt(0)" ::: "memory"); FA_SBAR();
#define FA_PK(k) (bf16x8){lo[k][0], lo[k][1], lo[k][2], lo[k][3], hi[k][0], hi[k][1], hi[k][2], hi[k][3]}
        o[d0] = __builtin_amdgcn_mfma_f32_32x32x16_bf16(pa0, FA_PK(0), o[d0], 0, 0, 0);
        o[d0] = __builtin_amdgcn_mfma_f32_32x32x16_bf16(pa1, FA_PK(1), o[d0], 0, 0, 0);
        o[d0] = __builtin_amdgcn_mfma_f32_32x32x16_bf16(pa2, FA_PK(2), o[d0], 0, 0, 0);
        o[d0] = __builtin_amdgcn_mfma_f32_32x32x16_bf16(pa3, FA_PK(3), o[d0], 0, 0, 0);
#undef FA_PK
    }
}
DI void pack_p(const f32x16& p0, const f32x16& p1, bf16x8& a0, bf16x8& a1, bf16x8& a2, bf16x8& a3) {
    u32x4 w0, w1, w2, w3;
    w0.x = cvtpk(p0[0], p0[1]); w0.y = cvtpk(p0[2], p0[3]); w0.z = cvtpk(p0[4], p0[5]); w0.w = cvtpk(p0[6], p0[7]);
    w1.x = cvtpk(p0[8], p0[9]); w1.y = cvtpk(p0[10], p0[11]); w1.z = cvtpk(p0[12], p0[13]); w1.w = cvtpk(p0[14], p0[15]);
    w2.x = cvtpk(p1[0], p1[1]); w2.y = cvtpk(p1[2], p1[3]); w2.z = cvtpk(p1[4], p1[5]); w2.w = cvtpk(p1[6], p1[7]);
    w3.x = cvtpk(p1[8], p1[9]); w3.y = cvtpk(p1[10], p1[11]); w3.z = cvtpk(p1[12], p1[13]); w3.w = cvtpk(p1[14], p1[15]);
    a0 = __builtin_bit_cast(bf16x8, w0); a1 = __builtin_bit_cast(bf16x8, w1); a2 = __builtin_bit_cast(bf16x8, w2); a3 = __builtin_bit_cast(bf16x8, w3);
}
DI void mask_range(f32x16& p0, f32x16& p1, int key0, int lo, int hi_, int hf) {
#pragma unroll
    for (int r = 0; r < 16; ++r) { const int k = key0 + crow(r, hf); if (k < lo || k > hi_) p0[r] = -INFINITY; if (k + 32 < lo || k + 32 > hi_) p1[r] = -INFINITY; }
}
DI float rowmax32(const f32x16& p0, const f32x16& p1) {
    float a = fmaxf(p0[0], p1[0]);
#pragma unroll
    for (int r = 1; r < 16; ++r) a = fmaxf(a, fmaxf(p0[r], p1[r]));
    return max32(a);
}
struct State { float m, l; f32x16 o[2]; };
DI void st_init(State& s) { s.m = -INFINITY; s.l = 0.f;
#pragma unroll
    for (int i = 0; i < 16; ++i) { s.o[0][i] = 0.f; s.o[1][i] = 0.f; } }
DI void softmax_pv(State& st, f32x16& p0, f32x16& p1, int vb, LAS float* wsf, int r32, int hf) {
    const float rm = rowmax32(p0, p1);
    const float mn = fmaxf(st.m, rm), mu = (mn == -INFINITY) ? 0.f : mn;
    const float alpha = __builtin_amdgcn_exp2f(st.m - mu);
    st.m = mn;
    float ls = 0.f;
#pragma unroll
    for (int r = 0; r < 16; ++r) { p0[r] = __builtin_amdgcn_exp2f(p0[r] - mu); p1[r] = __builtin_amdgcn_exp2f(p1[r] - mu); ls += p0[r] + p1[r]; }
    st.l = st.l * alpha + ls;
    if (__any(alpha != 1.0f)) {
        if (hf == 0) wsf[r32] = alpha;
        asm volatile("s_waitcnt lgkmcnt(0)" ::: "memory");
#pragma unroll
        for (int g = 0; g < 4; ++g) { const f32x4 a = *(const LAS f32x4*)(wsf + 8 * g + 4 * hf);
            st.o[0][4 * g] *= a.x; st.o[0][4 * g + 1] *= a.y; st.o[0][4 * g + 2] *= a.z; st.o[0][4 * g + 3] *= a.w;
            st.o[1][4 * g] *= a.x; st.o[1][4 * g + 1] *= a.y; st.o[1][4 * g + 2] *= a.z; st.o[1][4 * g + 3] *= a.w; }
    }
    bf16x8 a0, a1, a2, a3; pack_p(p0, p1, a0, a1, a2, a3);
    pv(st.o, vb, a0, a1, a2, a3);
}
DI void accum_scaled(f32x16* acc, const f32x16* o, float fac_row, LAS float* wsf, int r32, int hf) {
    if (hf == 0) wsf[32 + r32] = fac_row;
    asm volatile("s_waitcnt lgkmcnt(0)" ::: "memory");
#pragma unroll
    for (int g = 0; g < 4; ++g) { const f32x4 a = *(const LAS f32x4*)(wsf + 32 + 8 * g + 4 * hf);
        acc[0][4 * g] += o[0][4 * g] * a.x; acc[0][4 * g + 1] += o[0][4 * g + 1] * a.y; acc[0][4 * g + 2] += o[0][4 * g + 2] * a.z; acc[0][4 * g + 3] += o[0][4 * g + 3] * a.w;
        acc[1][4 * g] += o[1][4 * g] * a.x; acc[1][4 * g + 1] += o[1][4 * g + 1] * a.y; acc[1][4 * g + 2] += o[1][4 * g + 2] * a.z; acc[1][4 * g + 3] += o[1][4 * g + 3] * a.w; }
}
DI void stage_rows(const f32x16* acc, LAS bf16_t* stg, int r32, int hf) {
#pragma unroll
    for (int r = 0; r < 16; ++r) { const int orow = crow(r, hf);
        stg[orow * 64 + r32] = (bf16_t)f2bf(acc[0][r]); stg[orow * 64 + 32 + r32] = (bf16_t)f2bf(acc[1][r]); }
    asm volatile("s_waitcnt lgkmcnt(0)" ::: "memory");
}

DI void mla_unit(const Params& p, LAS unsigned char* lds, int b, int h, int qb, int wid0) {
    const int tid = opaque_tid(wid0), lane = tid & 63, r32 = lane & 31, hf = lane >> 5; const int wv = __builtin_amdgcn_readfirstlane(tid >> 6);
    const bf16_t* KN = wsp<bf16_t>(p, WS_KN); const bf16_t* KPE = wsp<bf16_t>(p, WS_KPE); const bf16_t* VM = wsp<bf16_t>(p, WS_VM);
    const float* sqk = wsp<float>(p, WS_SSQKN); const float* sqp = wsp<float>(p, WS_SSQPE); bf16_t* OC = wsp<bf16_t>(p, WS_R1);
    const int rowbase = b * SEQ, q0 = qb * 256, tq = q0 + wv * 32 + r32, row = rowbase + tq;
    LAS float* wsf = (LAS float*)(lds + L_WS) + wv * 64;
    bf16x8 qr[6];
    {
        const bf16_t* src = wsp<bf16_t>(p, WS_R0) + (size_t)row * 768 + h * 96 + 8 * hf; float q[6][8]; float ss = 0.f;
#pragma unroll
        for (int d0 = 0; d0 < 6; ++d0) { unpack8(*(const u32x4*)(src + 16 * d0), q[d0]);
#pragma unroll
            for (int e = 0; e < 8; ++e) ss += q[d0][e] * q[d0][e]; }
        ss = sum32(ss);
        const float rstd = rsqrtf(ss * (1.f / 96.f) + EPS); const float* qg = p.in[I_MQG] + 8 * hf; const float* kg = p.in[I_MKG] + 8 * hf;
#pragma unroll
        for (int d0 = 0; d0 < 6; ++d0)
#pragma unroll
            for (int e = 0; e < 8; ++e) q[d0][e] *= rstd * qg[16 * d0 + e];
        const float* cs = ropeCM(p) + (size_t)row * 16 + 8 * hf; const float* sn = ropeSM(p) + (size_t)row * 16 + 8 * hf;
#pragma unroll
        for (int e = 0; e < 8; ++e) { const float x1 = q[4][e], x2 = q[5][e]; q[4][e] = x1 * cs[e] - x2 * sn[e]; q[5][e] = x2 * cs[e] + x1 * sn[e]; }
#pragma unroll
        for (int d0 = 0; d0 < 6; ++d0) { float f[8];
#pragma unroll
            for (int e = 0; e < 8; ++e) f[e] = q[d0][e] * ((d0 < 4) ? kg[16 * d0 + e] * C2M : C2M);
            qr[d0] = __builtin_bit_cast(bf16x8, pack8(f)); }
    }
    State st; st_init(st);
    const int NT = 4 * (qb + 1);
    u32x4 ka, kb2, vv; float rk = 0.f;
    const bf16_t* kasrc = KN + (size_t)(rowbase + lane) * 512 + h * 64 + wv * 8;
    const bf16_t* kbsrc = KPE + (size_t)(rowbase + lane) * 32 + (wv & 3) * 8;
    const bf16_t* vsrc = VM + (size_t)(rowbase + 16 * (wv & 3) + (lane >> 2)) * 512 + h * 64 + (wv >> 2) * 32 + (lane & 3) * 8;
#define MLA_LOAD(t) do { ka = *(const u32x4*)(kasrc + (size_t)(t) * 64 * 512); if (wv < 4) kb2 = *(const u32x4*)(kbsrc + (size_t)(t) * 64 * 32); vv = *(const u32x4*)(vsrc + (size_t)(t) * 64 * 512); \
        if (tid < 64) { const int kr_ = rowbase + (t) * 64 + tid; rk = rsqrtf((sqk[(size_t)kr_ * 8 + h] + sqp[kr_]) * (1.f / 96.f) + EPS); } } while (0)
#define MLA_STORE(bf) do { *(LAS u32x4*)(lds + L_K + (bf) * KBUF + wv * 1024 + lane * 16) = ka; if (wv < 4) *(LAS u32x4*)(lds + L_K + (bf) * KBUF + (8 + wv) * 1024 + lane * 16) = kb2; \
        *(LAS u32x4*)(lds + L_V + (bf) * VBUF + wv * 1024 + lane * 16) = vv; if (tid < 64) *(LAS float*)(lds + L_RK + (bf) * 256 + tid * 4) = rk; } while (0)
    __syncthreads();
    MLA_LOAD(0); MLA_STORE(0); if (NT > 1) MLA_LOAD(1);
    const int vboff = ((lane >> 4) & 1) * 32 + (lane & 3) * 8 + (4 * hf + ((lane & 15) >> 2)) * 64;
    const int qlo = q0 + wv * 32;
    for (int i = 0; i < NT; ++i) {
        __syncthreads();
        if (i + 1 < NT) { MLA_STORE((i + 1) & 1); if (i + 2 < NT) MLA_LOAD(i + 2); }
        const int key0 = i * 64, bf = i & 1;
        if (key0 <= qlo + 31) {
            f32x16 p0, p1; qkt<96>(p0, p1, (lds_cptr)(lds + L_K + bf * KBUF) + hf * 1024 + r32 * 16, qr);
            const LAS float* rkp = (const LAS float*)(lds + L_RK + bf * 256);
#pragma unroll
            for (int g = 0; g < 4; ++g) { const f32x4 a = *(const LAS f32x4*)(rkp + 8 * g + 4 * hf), c = *(const LAS f32x4*)(rkp + 32 + 8 * g + 4 * hf);
                p0[4 * g] *= a.x; p0[4 * g + 1] *= a.y; p0[4 * g + 2] *= a.z; p0[4 * g + 3] *= a.w; p1[4 * g] *= c.x; p1[4 * g + 1] *= c.y; p1[4 * g + 2] *= c.z; p1[4 * g + 3] *= c.w; }
            if (key0 + 63 > qlo) mask_range(p0, p1, key0, 0, tq, hf);
            softmax_pv(st, p0, p1, (int)(uintptr_t)(lds + L_V + bf * VBUF) + vboff, wsf, r32, hf);
        }
    }
#undef MLA_LOAD
#undef MLA_STORE
    const float lt = sum32(st.l);
    f32x16 acc[2];
#pragma unroll
    for (int i = 0; i < 16; ++i) { acc[0][i] = 0.f; acc[1][i] = 0.f; }
    accum_scaled(acc, st.o, 1.0f / lt, wsf, r32, hf);
    LAS bf16_t* stg = (LAS bf16_t*)(lds + L_OST) + wv * 2048;
    stage_rows(acc, stg, r32, hf);
#pragma unroll
    for (int i = 0; i < 4; ++i) { const int rr = i * 8 + (lane >> 3), ch = lane & 7; const u32x4 v = *(const LAS u32x4*)(stg + rr * 64 + ch * 8);
        *(u32x4*)(OC + (size_t)(rowbase + q0 + wv * 32 + rr) * 1024 + h * 64 + ch * 8) = v; }
}

DI void nsa_unit(const Params& p, LAS unsigned char* lds, int b, int g, int c, int wid0) {
    const int tid = opaque_tid(wid0), lane = tid & 63, r32 = lane & 31, hf = lane >> 5; const int wv = __builtin_amdgcn_readfirstlane(tid >> 6);
    const bf16_t* QN = wsp<bf16_t>(p, WS_QN); const bf16_t* KCF = wsp<bf16_t>(p, WS_KCF); const bf16_t* VCF = wsp<bf16_t>(p, WS_VCF);
    const bf16_t* KS = wsp<bf16_t>(p, WS_KS); const bf16_t* VS = wsp<bf16_t>(p, WS_VS); const bf16_t* KW = wsp<bf16_t>(p, WS_KW); const bf16_t* VW = wsp<bf16_t>(p, WS_VW);
    const bf16_t* GN = wsp<bf16_t>(p, WS_GN); bf16_t* OC = wsp<bf16_t>(p, WS_R1);
    const int rowbase = b * SEQ, tt = 8 * wv + (r32 >> 2), hd = g * 4 + (r32 & 3), tq = 64 * c + tt, row = rowbase + tq;
    LAS float* wsf = (LAS float*)(lds + L_WS) + wv * 64;
    bf16x8 qr[4];
#pragma unroll
    for (int d0 = 0; d0 < 4; ++d0) qr[d0] = *(const bf16x8*)(QN + (size_t)row * 512 + hd * 64 + 16 * d0 + 8 * hf);
    const float g0 = bf2f(GN[(size_t)row * 32 + hd * 3 + 0]), g1 = bf2f(GN[(size_t)row * 32 + hd * 3 + 1]), g2 = bf2f(GN[(size_t)row * 32 + hd * 3 + 2]);
    f32x16 ot[2];
#pragma unroll
    for (int i = 0; i < 16; ++i) { ot[0][i] = 0.f; ot[1][i] = 0.f; }
    const int vboff = ((lane >> 4) & 1) * 32 + (lane & 3) * 8 + (4 * hf + ((lane & 15) >> 2)) * 64;
    u32x4 ka, vv;
#define NSA_LOAD(KB, VB, krow0) do { ka = *(const u32x4*)((KB) + (size_t)((krow0) + lane) * 128 + g * 64 + wv * 8); \
        vv = *(const u32x4*)((VB) + (size_t)((krow0) + 16 * (wv & 3) + (lane >> 2)) * 128 + g * 64 + (wv >> 2) * 32 + (lane & 3) * 8); } while (0)
#define NSA_STORE(koff, voff) do { *(LAS u32x4*)(lds + (koff) + wv * 1024 + lane * 16) = ka; *(LAS u32x4*)(lds + (voff) + wv * 1024 + lane * 16) = vv; } while (0)
    unsigned selmask;
    {
        const int ntile = (4 * c + 3 > 64) ? 2 : 1;
        const int nmax = (tq >= 31) ? ((tq - 31) >> 4) : -1;
        __syncthreads();
        NSA_LOAD(KCF, VCF, b * 128); NSA_STORE(L_K, L_V);
        if (ntile == 2) { NSA_LOAD(KCF, VCF, b * 128 + 64); NSA_STORE(L_K + 8192, L_V + 8192); }
        __syncthreads();
        f32x16 pa0, pa1, pb0, pb1;
        qkt<64>(pa0, pa1, (lds_cptr)(lds + L_K) + hf * 1024 + r32 * 16, qr); mask_range(pa0, pa1, 0, 0, nmax, hf);
        float m = rowmax32(pa0, pa1);
        if (ntile == 2) { qkt<64>(pb0, pb1, (lds_cptr)(lds + L_K + 8192) + hf * 1024 + r32 * 16, qr); mask_range(pb0, pb1, 64, 0, nmax, hf); m = fmaxf(m, rowmax32(pb0, pb1)); }
        else {
#pragma unroll
            for (int i = 0; i < 16; ++i) { pb0[i] = -INFINITY; pb1[i] = -INFINITY; } }
        const float mu = (m == -INFINITY) ? 0.f : m;
        float ls = 0.f;
#pragma unroll
        for (int r = 0; r < 16; ++r) { pa0[r] = __builtin_amdgcn_exp2f(pa0[r] - mu); pa1[r] = __builtin_amdgcn_exp2f(pa1[r] - mu); pb0[r] = __builtin_amdgcn_exp2f(pb0[r] - mu); pb1[r] = __builtin_amdgcn_exp2f(pb1[r] - mu);
            ls += (pa0[r] + pa1[r]) + (pb0[r] + pb1[r]); }
        ls = sum32(ls);
        const float rl = (ls > 0.f) ? 1.0f / ls : 0.f;
#pragma unroll
        for (int r = 0; r < 16; ++r) { pa0[r] *= rl; pa1[r] *= rl; pb0[r] *= rl; pb1[r] *= rl; }
        float own[16], ee[16];
#pragma unroll
        for (int q = 0; q < 4; ++q) {
            own[q] = (pa0[4 * q] + pa0[4 * q + 1]) + (pa0[4 * q + 2] + pa0[4 * q + 3]); ee[q] = pa0[4 * q + 3];
            own[4 + q] = (pa1[4 * q] + pa1[4 * q + 1]) + (pa1[4 * q + 2] + pa1[4 * q + 3]); ee[4 + q] = pa1[4 * q + 3];
            own[8 + q] = (pb0[4 * q] + pb0[4 * q + 1]) + (pb0[4 * q + 2] + pb0[4 * q + 3]); ee[8 + q] = pb0[4 * q + 3];
            own[12 + q] = (pb1[4 * q] + pb1[4 * q + 1]) + (pb1[4 * q + 2] + pb1[4 * q + 3]); ee[12 + q] = pb1[4 * q + 3]; }
        float eo[16];
#pragma unroll
        for (int k = 0; k < 16; ++k) eo[k] = xor32(ee[k], hf);
#pragma unroll
        for (int k = 0; k < 16; ++k) { const float add = hf ? eo[k] : ((k > 0) ? eo[k - 1] : 0.f); own[k] += add; }
#pragma unroll
        for (int k = 0; k < 16; ++k) { own[k] += xorl<1>(own[k]); own[k] += xorl<2>(own[k]); }
        float imp[32];
#pragma unroll
        for (int k = 0; k < 16; ++k) { const float oth = xor32(own[k], hf); imp[2 * k] = hf ? oth : own[k]; imp[2 * k + 1] = hf ? own[k] : oth; }
        selmask = select_blocks(imp, c);
        State sc; st_init(sc);
        { bf16x8 a0, a1, a2, a3; pack_p(pa0, pa1, a0, a1, a2, a3); pv(sc.o, (int)(uintptr_t)(lds + L_V) + vboff, a0, a1, a2, a3); }
        if (ntile == 2) { bf16x8 a0, a1, a2, a3; pack_p(pb0, pb1, a0, a1, a2, a3); pv(sc.o, (int)(uintptr_t)(lds + L_V + 8192) + vboff, a0, a1, a2, a3); }
        accum_scaled(ot, sc.o, g0, wsf, r32, hf);
    }
#pragma unroll 1
    for (int br = 1; br < 3; ++br) {
        const bf16_t* KB = (br == 1) ? KS : KW; const bf16_t* VB = (br == 1) ? VS : VW;
        const int NT = (br == 1) ? (c + 1) : ((c + 1 < 5) ? c + 1 : 5);
        const int lo = (br == 1) ? 0 : tq - 255;
        State st; st_init(st);
        __syncthreads();
        NSA_LOAD(KB, VB, rowbase + c * 64); NSA_STORE(L_K, L_V); if (NT > 1) NSA_LOAD(KB, VB, rowbase + (c - 1) * 64);
        for (int i = 0; i < NT; ++i) {
            __syncthreads();
            if (i + 1 < NT) { NSA_STORE(L_K + ((i + 1) & 1) * KBUF, L_V + ((i + 1) & 1) * VBUF); if (i + 2 < NT) NSA_LOAD(KB, VB, rowbase + (c - i - 2) * 64); }
            const int j = c - i, key0 = j * 64, bf = i & 1;
            const bool sel = (br == 2) || ((selmask >> j) & 1u);
            if (__any(sel)) {
                f32x16 p0, p1; qkt<64>(p0, p1, (lds_cptr)(lds + L_K + bf * KBUF) + hf * 1024 + r32 * 16, qr);
                if (br == 1) { if (i == 0) mask_range(p0, p1, key0, 0, tq, hf);
                    if (!sel) {
#pragma unroll
                        for (int r = 0; r < 16; ++r) { p0[r] = -INFINITY; p1[r] = -INFINITY; } } }
                else { if (i == 0 || i == 4) mask_range(p0, p1, key0, lo, tq, hf); }
                softmax_pv(st, p0, p1, (int)(uintptr_t)(lds + L_V + bf * VBUF) + vboff, wsf, r32, hf);
            }
        }
        const float lt = sum32(st.l);
        accum_scaled(ot, st.o, ((br == 1) ? g1 : g2) / lt, wsf, r32, hf);
    }
#undef NSA_LOAD
#undef NSA_STORE
    LAS bf16_t* stg = (LAS bf16_t*)(lds + L_OST) + wv * 2048;
    stage_rows(ot, stg, r32, hf);
#pragma unroll
    for (int i = 0; i < 4; ++i) { const int rr = i * 8 + (lane >> 3), ch = lane & 7; const u32x4 v = *(const LAS u32x4*)(stg + rr * 64 + ch * 8);
        *(u32x4*)(OC + (size_t)(rowbase + 64 * c + 8 * wv + (rr >> 2)) * 1024 + 512 + (g * 4 + (rr & 3)) * 64 + ch * 8) = v; }
}
#undef FA_SBAR
}

DI void stage_attn_fast(const Params& p, LAS unsigned char* lds, int bid, int nb, bool do_mla, bool do_nsa, int wid0) {
    if (do_mla) for (int u = bid; u < 256; u += nb) { const int bh = u >> 2, s = u & 3; fa::mla_unit(p, lds, bh >> 3, bh & 7, 7 - s, wid0); fa::mla_unit(p, lds, bh >> 3, bh & 7, s, wid0); }
    if (do_nsa) for (int u = bid; u < 256; u += nb) { const int bg = u >> 4, s = u & 15; fa::nsa_unit(p, lds, bg >> 1, bg & 1, 31 - s, wid0); fa::nsa_unit(p, lds, bg >> 1, bg & 1, s, wid0); }
    __syncthreads();
}
constexpr int LDS_BYTES = 147456;
#ifndef USE_CG_SYNC
#define USE_CG_SYNC 1
#endif

typedef const Params __attribute__((address_space(4)))* KParamsPtr;
#if defined(__HIP_DEVICE_COMPILE__)
DI KParamsPtr kparams() { KParamsPtr k = (KParamsPtr)__builtin_amdgcn_kernarg_segment_ptr(); asm volatile("" : "+s"(k)); return k; }
#endif
#if defined(__HIP_DEVICE_COMPILE__)
#define PHASE_PARAMS() const Params p = *kparams()
#else
#define PHASE_PARAMS() const Params p = p_arg
#endif
__global__ void __launch_bounds__(512, 2) fwd_megakernel(Params p_arg) {
    extern __shared__ __attribute__((aligned(16))) unsigned char dlds[];
    LAS unsigned char* lds = (LAS unsigned char*)dlds;
    cg::grid_group grid = cg::this_grid();
    const int G = gridDim.x, c = blockIdx.x, ngw = G * NWAVE, ngt = G * NTHR;
    const int wid0 = __builtin_amdgcn_readfirstlane(threadIdx.x >> 6);
#define TIDS() const int tid = opaque_tid(wid0), lane = tid & 63, wave = tid >> 6, gw = c * NWAVE + wave, gtid = c * NTHR + tid; (void)lane; (void)gw; (void)gtid
#define GRID_SYNC() grid.sync()
    { PHASE_PARAMS();
    { TIDS(); stage_weights(p, gw, ngw, (float*)dlds + wave * (64 * 33), lane); }
    __syncthreads();
    stage_mod(p, c, G, (float*)dlds, wid0);
    { TIDS(); stage_rope(p, gtid, ngt); } }
    GRID_SYNC();
    { PHASE_PARAMS(); TIDS(); stage_normmod(p.in[I_X], p.in[I_N1G], wsp<float>(p, WS_MOD), 0, 1, wsp<bf16_t>(p, WS_R0), gw, ngw, lane); }
    GRID_SYNC();
    { PHASE_PARAMS(); EpiZ E{p}; gemm_fast(lds, wsp<bf16_t>(p, WS_R0), 1024, wsp<bf16_t>(p, WS_WIN), MT, ZN, 1024, E, G, c, wid0); }
    GRID_SYNC();
    { PHASE_PARAMS();
      int qb, qc, kb, kc;
      if (G == 256) { qb = c; qc = (c < 192) ? 1 : 0; kb = (c < 192) ? c : (c >= 224 ? 192 + 2 * (c - 224) : 0); kc = (c < 192) ? 1 : (c >= 224 ? 2 : 0); }
      else { const int pq = (192 + G - 1) / G, pk = (256 + G - 1) / G; qb = c * pq; qc = (192 - qb < pq) ? ((192 - qb > 0) ? 192 - qb : 0) : pq; kb = c * pk; kc = (256 - kb < pk) ? ((256 - kb > 0) ? 256 - kb : 0) : pk; }
      { EpiQ E{p}; gemm_fast_range(lds, wsp<bf16_t>(p, WS_R1), 1024, wsp<bf16_t>(p, WS_WQB), MT, 768, 768, E, qb, qc, wid0); }
      for (int cu = (c + 64) % G; cu < 32; cu += G) cmp_hidden_fast(p, lds, cu, wid0);
      { EpiKV E{p}; gemm_fast_range(lds, wsp<bf16_t>(p, WS_R1) + 768, 1024, wsp<bf16_t>(p, WS_WKVB), MT, 1024, 256, E, kb, kc, wid0); }
    }
    GRID_SYNC();
    { PHASE_PARAMS(); TIDS(); cmp_out<true>(p, gw, ngw, lane); }
    { PHASE_PARAMS(); stage_attn_fast(p, lds, c, G, true, false, wid0); }
    GRID_SYNC();
    { PHASE_PARAMS(); stage_attn_fast(p, lds, c, G, false, true, wid0); }
    GRID_SYNC();
    { PHASE_PARAMS(); EpiMerge E{p}; gemm_fast(lds, wsp<bf16_t>(p, WS_R1), 1024, wsp<bf16_t>(p, WS_WO), MT, 1024, 1024, E, G, c, wid0); }
    GRID_SYNC();
    { PHASE_PARAMS(); EpiOut E{p}; gemm_fast(lds, wsp<bf16_t>(p, WS_R0), 1024, wsp<bf16_t>(p, WS_WOUT), MT, 1024, 1024, E, G, c, wid0); }
    GRID_SYNC();
    { PHASE_PARAMS(); TIDS(); stage_normmod(wsp<float>(p, WS_R2), p.in[I_N2G], wsp<float>(p, WS_MOD), 3, 4, wsp<bf16_t>(p, WS_R1), gw, ngw, lane); }
    GRID_SYNC();
    { PHASE_PARAMS(); EpiGU E{p}; gemm_fast(lds, wsp<bf16_t>(p, WS_R1), 1024, wsp<bf16_t>(p, WS_WGU), MT, 5632, 1024, E, G, c, wid0); }
    GRID_SYNC();
    { PHASE_PARAMS(); EpiDown E{p}; gemm_fast(lds, wsp<bf16_t>(p, WS_HID), DFF, wsp<bf16_t>(p, WS_WD), MT, 1024, DFF, E, G, c, wid0); }
}

extern "C" void kernel_launch(void* const* d_in, const int* in_sizes, int n_in, void* d_out, int out_size, void* d_ws, size_t ws_size, hipStream_t stream) {
    if (n_in != 30 || out_size != MT * DM || ws_size < WS_END) { fprintf(stderr, "kernel_launch: unexpected shapes (n_in %d out %d ws %zu)\n", n_in, out_size, ws_size); return; }
    static int grid = 0;
    if (grid == 0) {
        int dev = 0, cus = 0, per_cu = 0;
        hipGetDevice(&dev); hipDeviceGetAttribute(&cus, hipDeviceAttributeMultiprocessorCount, dev);
        hipFuncSetAttribute((const void*)fwd_megakernel, hipFuncAttributeMaxDynamicSharedMemorySize, LDS_BYTES);
        hipOccupancyMaxActiveBlocksPerMultiprocessor(&per_cu, (const void*)fwd_megakernel, NTHR, LDS_BYTES);
        if (per_cu < 1) { fprintf(stderr, "kernel_launch: occupancy query says %d blocks per CU\n", per_cu); per_cu = 1; }
        grid = cus;
        (void)hipGetLastError();
    }
    Params p{};
    for (int i = 0; i < 30; ++i) p.in[i] = (const float*)d_in[i];
    p.out = (float*)d_out; p.ws = (unsigned char*)d_ws;
    void* args[] = {&p};
    hipError_t e = hipLaunchCooperativeKernel((const void*)fwd_megakernel, dim3(grid), dim3(NTHR), args, LDS_BYTES, stream);
    if (e != hipSuccess) fprintf(stderr, "kernel_launch: cooperative launch failed: %s (grid %d)\n", hipGetErrorString(e), grid);
}
```

```cpp
#include <hip/hip_runtime.h>
#include <hip/hip_cooperative_groups.h>
#include <cstdint>
#include <cstdio>
namespace cg = cooperative_groups;

typedef unsigned short bf16_t;
typedef unsigned u32x4 __attribute__((ext_vector_type(4)));
typedef unsigned u32x2 __attribute__((ext_vector_type(2)));
typedef float f32x4 __attribute__((ext_vector_type(4)));
typedef float f32x2 __attribute__((ext_vector_type(2)));
#define DI __device__ __forceinline__

constexpr int NB = 8, SEQ = 2048, DM = 1024, MT = NB * SEQ;
constexpr int DFF = 2816, NMOD = 6;
constexpr int ZN = 4608;
constexpr float EPS = 1e-6f;
constexpr float LOG2E = 1.4426950408889634f;
constexpr float C2N = 0.125f * LOG2E;
constexpr float C2M = 0.10206207261596575f * LOG2E;
constexpr int NTHR = 512, NWAVE = 8;
constexpr int O_CQ = 0, O_CKV = 768, O_KPE = 1024, O_QN = 1056, O_KC = 1568, O_VC = 1696, O_KS = 1824, O_VS = 1952, O_KW = 2080, O_VW = 2208,
              O_GN = 2336, O_GM = 2360, O_GNM = 3384, D_IN = 4408;

constexpr size_t MiB = 1u << 20;
constexpr size_t WS_CTL = 0;
constexpr size_t WS_MOD = 1 * MiB;
constexpr size_t WS_CB1 = 1 * MiB + 256 * 1024;
constexpr size_t WS_SSQPE = 1 * MiB + 320 * 1024;
constexpr size_t WS_SSQKN = 1 * MiB + 512 * 1024;
constexpr size_t WS_SSQA = 2 * MiB;
constexpr size_t WS_KCF = 3 * MiB;
constexpr size_t WS_VCF = 3 * MiB + 256 * 1024;
constexpr size_t WS_CW2 = 3 * MiB + 512 * 1024;
constexpr size_t WS_WIN = 4 * MiB;
constexpr size_t WS_WQB = 13 * MiB;
constexpr size_t WS_WKVB = 15 * MiB;
constexpr size_t WS_WO = 16 * MiB;
constexpr size_t WS_WOUT = 18 * MiB;
constexpr size_t WS_WGU = 20 * MiB;
constexpr size_t WS_WD = 31 * MiB;
constexpr size_t WS_CW1 = 37 * MiB;
constexpr size_t WS_R0 = 40 * MiB;
constexpr size_t WS_R1 = 72 * MiB;
constexpr size_t WS_R2 = 104 * MiB;
constexpr size_t WS_QN = 168 * MiB;
constexpr size_t WS_KC = 184 * MiB, WS_VC = 188 * MiB, WS_KS = 192 * MiB, WS_VS = 196 * MiB, WS_KW = 200 * MiB, WS_VW = 204 * MiB;
constexpr size_t WS_KPE = 208 * MiB;
constexpr size_t WS_GN = 209 * MiB;
constexpr size_t WS_KN = 210 * MiB;
constexpr size_t WS_VM = 226 * MiB;
constexpr size_t WS_CMPH = 64 * MiB;
constexpr size_t WS_ROPE = 248 * MiB;
constexpr size_t WS_HID = 168 * MiB;
constexpr size_t WS_END = 256 * MiB;

struct Params {
    const float* in[30];
    float* out;
    unsigned char* ws;
};
enum { I_X = 0, I_C, I_POS, I_ADAW, I_ADAB, I_N1G, I_WIN, I_QAG, I_WQB, I_KVAG, I_WKVB, I_MQG, I_MKG, I_NQG, I_NKCG, I_NKSG, I_NKWG,
       I_CPK, I_CW1K, I_CW2K, I_CPV, I_CW1V, I_CW2V, I_WOM, I_WON, I_WOUT, I_N2G, I_WG, I_WU, I_WDN };

template <class T> DI T* wsp(const Params& p, size_t off) { return (T*)(p.ws + off); }

DI int lane_id() { return (int)__builtin_amdgcn_mbcnt_hi(~0u, __builtin_amdgcn_mbcnt_lo(~0u, 0u)); }
DI int opaque_tid(int wid0) { int l = lane_id(); asm volatile("" : "+v"(l)); return (wid0 << 6) | l; }
DI unsigned f2bf(float f) { unsigned u = __float_as_uint(f); return (u + 0x7fffu + ((u >> 16) & 1u)) >> 16; }
DI unsigned pk2(float lo, float hi) { return f2bf(lo) | (f2bf(hi) << 16); }
DI float bf2f(unsigned short b) { return __uint_as_float(((unsigned)b) << 16); }
DI float bflo(unsigned w) { return __uint_as_float(w << 16); }
DI float bfhi(unsigned w) { return __uint_as_float(w & 0xffff0000u); }
DI void unpack8(const u32x4 w, float (&f)[8]) { f[0] = bflo(w.x); f[1] = bfhi(w.x); f[2] = bflo(w.y); f[3] = bfhi(w.y); f[4] = bflo(w.z); f[5] = bfhi(w.z); f[6] = bflo(w.w); f[7] = bfhi(w.w); }
DI u32x4 pack8(const float (&f)[8]) { u32x4 w; w.x = pk2(f[0], f[1]); w.y = pk2(f[2], f[3]); w.z = pk2(f[4], f[5]); w.w = pk2(f[6], f[7]); return w; }
DI float sigmoidf(float x) { return 1.0f / (1.0f + __expf(-x)); }
DI float siluf(float x) { return x / (1.0f + __expf(-x)); }
template <int X> DI float xorl(float v) { return __int_as_float(__builtin_amdgcn_ds_swizzle(__float_as_int(v), (X << 10) | 0x1f)); }
DI void halves(float v, float& lo, float& hi) { auto rr = __builtin_amdgcn_permlane32_swap(__float_as_uint(v), __float_as_uint(v), false, false); lo = __uint_as_float(rr[0]); hi = __uint_as_float(rr[1]); }
DI float xor32(float v, int hf) { float lo, hi; halves(v, lo, hi); return hf ? lo : hi; }
DI float sum32(float v) { float lo, hi; halves(v, lo, hi); return lo + hi; }
DI float max32(float v) { float lo, hi; halves(v, lo, hi); return fmaxf(lo, hi); }
DI float wave_sum(float v) { v += xorl<1>(v); v += xorl<2>(v); v += xorl<4>(v); v += xorl<8>(v); v += xorl<16>(v); return sum32(v); }
DI void sincos_rad(float ang, float& c, float& s) {
    double rev = (double)ang * 0.15915494309189535; rev -= __builtin_rint(rev);
    const float fr = (float)rev; s = __builtin_amdgcn_sinf(fr); c = __builtin_amdgcn_cosf(fr);
}
#define LAS __attribute__((address_space(3)))
DI void transpose_item(const float* W, int ldw, int c0, int ncols, const float* rs, bf16_t* dst, int ldd, int n0, int k0, float* scr, int lane) {
    if (c0 >= 0) {
#pragma unroll 8
        for (int i = 0; i < 32; ++i) { const int kk = 2 * i + (lane >> 5), cc = lane & 31;
            float v = (cc < ncols) ? W[(size_t)(k0 + kk) * ldw + c0 + cc] : 0.f; if (rs) v *= rs[k0 + kk]; scr[kk * 33 + cc] = v; }
    } else {
#pragma unroll 8
        for (int i = 0; i < 32; ++i) { const int kk = 2 * i + (lane >> 5), cc = lane & 31; scr[kk * 33 + cc] = 0.f; }
    }
    __builtin_amdgcn_s_waitcnt(0xc07f);
    asm volatile("" ::: "memory");
    const int c = lane & 7;
#pragma unroll
    for (int j = 0; j < 4; ++j) { const int n = (lane >> 3) + 8 * j; const float* s = scr + (8 * c) * 33 + n;
        u32x4 o; o.x = pk2(s[0 * 33], s[1 * 33]); o.y = pk2(s[2 * 33], s[3 * 33]); o.z = pk2(s[4 * 33], s[5 * 33]); o.w = pk2(s[6 * 33], s[7 * 33]);
        *(u32x4*)(dst + (size_t)(n0 + n) * ldd + k0 + 8 * c) = o; }
    __builtin_amdgcn_s_waitcnt(0xc07f);
    asm volatile("" ::: "memory");
}
DI int zsrc(int s, int L0, int& ncols) {
    ncols = 32;
    if (s < 16) return 64 * s + L0;
    if (s == 16) { if (L0 == 0) return O_KPE; ncols = 24; return O_GN; }
    if (s < 25) return O_QN + 64 * (s - 17) + L0;
    if (s < 27) return O_KC + 64 * (s - 25) + L0;
    if (s < 29) return O_VC + 64 * (s - 27) + L0;
    if (s < 31) return O_KS + 64 * (s - 29) + L0;
    if (s < 33) return O_VS + 64 * (s - 31) + L0;
    if (s < 35) return O_KW + 64 * (s - 33) + L0;
    if (s < 37) return O_VW + 64 * (s - 35) + L0;
    if (s < 40) return -1;
    if (s < 56) return O_GM + 64 * (s - 40) + L0;
    return O_GNM + 64 * (s - 56) + L0;
}
DI void stage_weights(const Params& p, int gw, int ngw, float* scr, int lane) {
    constexpr int I_IN = (ZN / 32) * (DM / 64);
    constexpr int I_QB = (768 / 32) * (768 / 64);
    constexpr int I_KVB = (1024 / 32) * (256 / 64);
    constexpr int I_O = (1024 / 32) * (1024 / 64);
    constexpr int I_OUT = I_O;
    constexpr int I_GU = (5632 / 32) * (1024 / 64);
    constexpr int I_D = (1024 / 32) * (DFF / 64);
    constexpr int I_C1 = 2 * (256 / 32) * (2048 / 64);
    constexpr int NITEMS = I_IN + I_QB + I_KVB + I_O + I_OUT + I_GU + I_D + I_C1;
    for (int it = gw; it < NITEMS; it += ngw) {
        int r = it;
        if (r < I_IN) { const int nb = r / 16, kb = r % 16; const int pn = nb >> 3, bj = (nb >> 2) & 1, wc = nb & 3; int nc; const int c0 = zsrc(4 * pn + wc, 32 * bj, nc);
            transpose_item(p.in[I_WIN], D_IN, c0, nc, nullptr, wsp<bf16_t>(p, WS_WIN), DM, nb * 32, kb * 64, scr, lane); continue; } r -= I_IN;
        if (r < I_QB) { const int nb = r / 12, kb = r % 12; transpose_item(p.in[I_WQB], 768, nb * 32, 32, p.in[I_QAG], wsp<bf16_t>(p, WS_WQB), 768, nb * 32, kb * 64, scr, lane); continue; } r -= I_QB;
        if (r < I_KVB) { const int nb = r / 4, kb = r % 4; const int pn = nb >> 3, bj = (nb >> 2) & 1, wc = nb & 3, s = 4 * pn + wc;
            const int c0 = (s < 8) ? (128 * s + 32 * bj) : (128 * (s - 8) + 64 + 32 * bj);
            transpose_item(p.in[I_WKVB], 1024, c0, 32, p.in[I_KVAG], wsp<bf16_t>(p, WS_WKVB), 256, nb * 32, kb * 64, scr, lane); continue; } r -= I_KVB;
        if (r < I_O) { const int nb = r / 16, kb = r % 16;
            if (kb < 8) transpose_item(p.in[I_WOM], 1024, nb * 32, 32, nullptr, wsp<bf16_t>(p, WS_WO), 1024, nb * 32, kb * 64, scr, lane);
            else transpose_item(p.in[I_WON] - (size_t)512 * 1024, 1024, nb * 32, 32, nullptr, wsp<bf16_t>(p, WS_WO), 1024, nb * 32, kb * 64, scr, lane);
            continue; } r -= I_O;
        if (r < I_OUT) { const int nb = r / 16, kb = r % 16; transpose_item(p.in[I_WOUT], 1024, nb * 32, 32, nullptr, wsp<bf16_t>(p, WS_WOUT), 1024, nb * 32, kb * 64, scr, lane); continue; } r -= I_OUT;
        if (r < I_GU) { const int nb = r / 16, kb = r % 16; const int pn = nb >> 3, bj = (nb >> 2) & 1, wc = nb & 3, s = 4 * pn + wc;
            transpose_item(bj ? p.in[I_WU] : p.in[I_WG], DFF, 32 * s, 32, nullptr, wsp<bf16_t>(p, WS_WGU), 1024, nb * 32, kb * 64, scr, lane); continue; } r -= I_GU;
        if (r < I_D) { const int nb = r / 44, kb = r % 44; transpose_item(p.in[I_WDN], 1024, nb * 32, 32, nullptr, wsp<bf16_t>(p, WS_WD), DFF, nb * 32, kb * 64, scr, lane); continue; } r -= I_D;
        { const int kv = r / 256, rr = r % 256, nb = rr / 32, kb = rr % 32;
          transpose_item(kv ? p.in[I_CW1V] : p.in[I_CW1K], 256, nb * 32, 32, nullptr, wsp<bf16_t>(p, WS_CW1) + (size_t)kv * 256 * 2048, 2048, nb * 32, kb * 64, scr, lane); }
    }
}
DI void stage_mod(const Params& p, int bid, int nb, float* lds, int wid0) {
    const int tid = opaque_tid(wid0), wave = tid >> 6, lane = tid & 63, nwv = blockDim.x >> 6;
    for (int u = bid; u < 104; u += nb) {
        float acc[8];
#pragma unroll
        for (int b = 0; b < 8; ++b) acc[b] = 0.f;
        if (u < 96) {
            const int n = u * 64 + lane; const float* W = p.in[I_ADAW]; const float* c = p.in[I_C];
            for (int k = wave * (1024 / nwv); k < (wave + 1) * (1024 / nwv); ++k) { const float w = W[(size_t)k * 6144 + n];
#pragma unroll
                for (int b = 0; b < 8; ++b) acc[b] += siluf(c[b * 1024 + k]) * w; }
        } else {
            const int kv = (u - 96) >> 2, n = ((u - 96) & 3) * 64 + lane; const float* W = kv ? p.in[I_CW1V] : p.in[I_CW1K]; const float* pos = kv ? p.in[I_CPV] : p.in[I_CPK];
            for (int k = wave * (2048 / nwv); k < (wave + 1) * (2048 / nwv); ++k) acc[0] += pos[k] * W[(size_t)k * 256 + n];
        }
        __syncthreads();
#pragma unroll
        for (int b = 0; b < 8; ++b) lds[(wave * 8 + b) * 64 + lane] = acc[b];
        __syncthreads();
        if (wave == 0) {
#pragma unroll
            for (int b = 0; b < 8; ++b) { float s = 0.f;
                for (int w = 0; w < nwv; ++w) s += lds[(w * 8 + b) * 64 + lane];
                if (u < 96) wsp<float>(p, WS_MOD)[b * 6144 + u * 64 + lane] = s + p.in[I_ADAB][u * 64 + lane];
                else if (b == 0) wsp<float>(p, WS_CB1)[(u - 96) * 64 + lane] = s; }
        }
    }
    __syncthreads();
}
DI void stage_rope(const Params& p, int gtid, int ngt) {
    float* T = wsp<float>(p, WS_ROPE); const int* pos = (const int*)p.in[I_POS];
    for (int i = gtid; i < MT * 24; i += ngt) {
        const int row = i / 24, j = i % 24; const float ps = (float)pos[row]; float inv, c, s;
        if (j < 16) inv = (float)pow(500000.0, -(double)j / 16.0); else inv = (float)pow(500000.0, -(double)(j - 16) / 8.0);
        sincos_rad(ps * inv, c, s);
        if (j < 16) { T[(size_t)row * 16 + j] = c; T[(size_t)MT * 16 + (size_t)row * 16 + j] = s; }
        else { T[(size_t)MT * 32 + (size_t)row * 8 + (j - 16)] = c; T[(size_t)MT * 40 + (size_t)row * 8 + (j - 16)] = s; }
    }
}
DI const float* ropeCM(const Params& p) { return wsp<float>(p, WS_ROPE); }
DI const float* ropeSM(const Params& p) { return wsp<float>(p, WS_ROPE) + (size_t)MT * 16; }
DI const float* ropeCN(const Params& p) { return wsp<float>(p, WS_ROPE) + (size_t)MT * 32; }
DI const float* ropeSN(const Params& p) { return wsp<float>(p, WS_ROPE) + (size_t)MT * 40; }

DI void stage_normmod(const float* X, const float* gain, const float* mod, int sh_idx, int sc_idx, bf16_t* Hout, int gw, int ngw, int lane) {
    for (int m = gw; m < MT; m += ngw) {
        const int b = m / SEQ; const f32x4* xr = (const f32x4*)(X + (size_t)m * DM) + lane;
        f32x4 v[4]; float s = 0.f;
#pragma unroll
        for (int j = 0; j < 4; ++j) { v[j] = xr[64 * j]; s += (v[j].x * v[j].x + v[j].y * v[j].y) + (v[j].z * v[j].z + v[j].w * v[j].w); }
        const float rstd = rsqrtf(wave_sum(s) * (1.f / DM) + EPS);
        const f32x4* g4 = (const f32x4*)gain + lane; const f32x4* sc4 = (const f32x4*)(mod + b * 6144 + sc_idx * 1024) + lane; const f32x4* sh4 = (const f32x4*)(mod + b * 6144 + sh_idx * 1024) + lane;
        u32x2* o8 = (u32x2*)(Hout + (size_t)m * DM) + lane;
#pragma unroll
        for (int j = 0; j < 4; ++j) { const f32x4 g = g4[64 * j], sc = sc4[64 * j], sh = sh4[64 * j];
            const f32x4 y = v[j] * rstd * g * (1.0f + sc) + sh; u32x2 w; w.x = pk2(y.x, y.y); w.y = pk2(y.z, y.w); o8[64 * j] = w; }
    }
}
DI void store8bf(bf16_t* dst, const float (&f)[8]) { *(u32x4*)dst = pack8(f); }
DI float ssq16(const float (&v)[2][8]) { float q = 0.f;
#pragma unroll
    for (int b = 0; b < 2; ++b)
#pragma unroll
        for (int j = 0; j < 8; ++j) q += v[b][j] * v[b][j];
    q += xorl<16>(q); return sum32(q); }

struct EpiZ {
    static constexpr bool HAS_MID = false; static constexpr int NTYPES = 7;
    Params p;
    DI void mid(int, int, int, int, float (&)[2][8]) const {}
    DI int type(int pn, int wc) const { const int s = 4 * pn + wc;
        if (s < 16) return 0; if (s == 16) return 1; if (s < 25) return 2; if (s < 37) { const int t = (s - 25) >> 1; return (t == 2 || t == 4) ? 3 : 4; } if (s < 40) return 5; return 6; }
    DI void normrope(int row, int fq, float (&v)[2][8], const float* gain, float post, bf16_t* dst) const {
        const float rstd = rsqrtf(ssq16(v) * (1.f / 64.f) + EPS);
#pragma unroll
        for (int b = 0; b < 2; ++b) { const f32x4 g0 = *(const f32x4*)(gain + 32 * b + 8 * fq), g1 = *(const f32x4*)(gain + 32 * b + 8 * fq + 4);
            v[b][0] *= rstd * g0.x; v[b][1] *= rstd * g0.y; v[b][2] *= rstd * g0.z; v[b][3] *= rstd * g0.w; v[b][4] *= rstd * g1.x; v[b][5] *= rstd * g1.y; v[b][6] *= rstd * g1.z; v[b][7] *= rstd * g1.w; }
        const float* cs = ropeCN(p) + (size_t)row * 8; const float* sn = ropeSN(p) + (size_t)row * 8;
#pragma unroll
        for (int j = 0; j < 8; ++j) { const float own = v[0][j], oth = xorl<16>(own); const float c = cs[j], s = sn[j];
            if (fq == 0) v[0][j] = own * c - oth * s; else if (fq == 1) v[0][j] = own * c + oth * s; }
#pragma unroll
        for (int b = 0; b < 2; ++b) {
#pragma unroll
            for (int j = 0; j < 8; ++j) v[b][j] *= post;
            store8bf(dst + 32 * b + 8 * fq, v[b]); }
    }
    template <int T> DI void apply(int row, int pn, int wc, int fq, float (&v)[2][8]) const {
        const int s = 4 * pn + wc;
        if constexpr (T == 0) {
            bf16_t* d = wsp<bf16_t>(p, WS_R1) + (size_t)row * 1024 + 64 * s + 8 * fq;
            const float q = ssq16(v); store8bf(d, v[0]); store8bf(d + 32, v[1]);
            if (fq == 0) wsp<float>(p, WS_SSQA)[(size_t)row * 16 + s] = q;
        } else if constexpr (T == 1) {
            float q = 0.f;
#pragma unroll
            for (int j = 0; j < 8; ++j) q += v[0][j] * v[0][j];
            q += xorl<16>(q); q = sum32(q);
            if (fq == 0) wsp<float>(p, WS_SSQPE)[row] = q;
            const float* kg = p.in[I_MKG] + 64 + 8 * fq; const int i0 = 8 * (fq & 1);
            const float* cs = ropeCM(p) + (size_t)row * 16 + i0; const float* sn = ropeSM(p) + (size_t)row * 16 + i0;
            float o[8];
#pragma unroll
            for (int j = 0; j < 8; ++j) { const float own = v[0][j] * kg[j], oth = xor32(own, fq >> 1); o[j] = (fq < 2) ? own * cs[j] - oth * sn[j] : own * cs[j] + oth * sn[j]; }
            store8bf(wsp<bf16_t>(p, WS_KPE) + (size_t)row * 32 + 8 * fq, o);
#pragma unroll
            for (int j = 0; j < 8; ++j) o[j] = sigmoidf(v[1][j]);
            store8bf(wsp<bf16_t>(p, WS_GN) + (size_t)row * 32 + 8 * fq, o);
        } else if constexpr (T == 2) {
            normrope(row, fq, v, p.in[I_NQG], C2N, wsp<bf16_t>(p, WS_QN) + (size_t)row * 512 + 64 * (s - 17));
        } else if constexpr (T == 3 || T == 4) {
            const int t = (s - 25) >> 1, g = (s - 25) & 1;
            bf16_t* d = wsp<bf16_t>(p, WS_KC + (size_t)t * 4 * MiB) + (size_t)row * 128 + 64 * g;
            if constexpr (T == 3) normrope(row, fq, v, (t == 2) ? p.in[I_NKSG] : p.in[I_NKWG], 1.0f, d);
            else { store8bf(d + 8 * fq, v[0]); store8bf(d + 32 + 8 * fq, v[1]); }
        } else if constexpr (T == 5) {
        } else {
            bf16_t* d = wsp<bf16_t>(p, WS_R2) + (size_t)row * 2048 + 64 * (s - 40) + 8 * fq;
#pragma unroll
            for (int b = 0; b < 2; ++b) { float o[8];
#pragma unroll
                for (int j = 0; j < 8; ++j) o[j] = sigmoidf(v[b][j]);
                store8bf(d + 32 * b, o); }
        }
    }
};
struct EpiQ {
    static constexpr bool HAS_MID = false; static constexpr int NTYPES = 1;
    Params p;
    DI int type(int, int) const { return 0; }
    DI void mid(int, int, int, int, float (&)[2][8]) const {}
    template <int T> DI void apply(int row, int pn, int wc, int fq, float (&v)[2][8]) const {
        const float* sq = wsp<float>(p, WS_SSQA) + (size_t)row * 16; float s = 0.f;
#pragma unroll
        for (int i = 0; i < 12; ++i) s += sq[i];
        const float rstd = rsqrtf(s * (1.f / 768.f) + EPS);
        bf16_t* d = wsp<bf16_t>(p, WS_R0) + (size_t)row * 768 + 256 * pn + 32 * wc + 8 * fq;
#pragma unroll
        for (int b = 0; b < 2; ++b) { float o[8];
#pragma unroll
            for (int j = 0; j < 8; ++j) o[j] = v[b][j] * rstd;
            store8bf(d + 128 * b, o); }
    }
};
struct EpiKV {
    static constexpr bool HAS_MID = false; static constexpr int NTYPES = 1;
    Params p;
    DI int type(int, int) const { return 0; }
    DI void mid(int, int, int, int, float (&)[2][8]) const {}
    template <int T> DI void apply(int row, int pn, int wc, int fq, float (&v)[2][8]) const {
        const int s = 4 * pn + wc;
        const float* sq = wsp<float>(p, WS_SSQA) + (size_t)row * 16 + 12;
        const float rstd = rsqrtf(((sq[0] + sq[1]) + (sq[2] + sq[3])) * (1.f / 256.f) + EPS);
#pragma unroll
        for (int b = 0; b < 2; ++b)
#pragma unroll
            for (int j = 0; j < 8; ++j) v[b][j] *= rstd;
        if (s < 8) { const float q = ssq16(v); if (fq == 0) wsp<float>(p, WS_SSQKN)[(size_t)row * 8 + s] = q;
            bf16_t* d = wsp<bf16_t>(p, WS_KN) + (size_t)row * 512 + 64 * s + 8 * fq; store8bf(d, v[0]); store8bf(d + 32, v[1]); }
        else { bf16_t* d = wsp<bf16_t>(p, WS_VM) + (size_t)row * 512 + 64 * (s - 8) + 8 * fq; store8bf(d, v[0]); store8bf(d + 32, v[1]); }
    }
};
struct EpiMerge {
    static constexpr bool HAS_MID = true; static constexpr int NTYPES = 1;
    Params p;
    DI int type(int, int) const { return 0; }
    DI void mid(int row, int pn, int wc, int fq, float (&v)[2][8]) const {
        const bf16_t* g = wsp<bf16_t>(p, WS_R2) + (size_t)row * 2048 + 256 * pn + 32 * wc + 8 * fq;
#pragma unroll
        for (int b = 0; b < 2; ++b) { float s1[8], s2[8]; unpack8(*(const u32x4*)(g + 128 * b), s1); unpack8(*(const u32x4*)(g + 1024 + 128 * b), s2);
#pragma unroll
            for (int j = 0; j < 8; ++j) v[b][j] *= s1[j] * __builtin_amdgcn_rcpf(s2[j]); }
    }
    template <int T> DI void apply(int row, int pn, int wc, int fq, float (&v)[2][8]) const {
        const bf16_t* g = wsp<bf16_t>(p, WS_R2) + (size_t)row * 2048 + 1024 + 256 * pn + 32 * wc + 8 * fq;
        bf16_t* d = wsp<bf16_t>(p, WS_R0) + (size_t)row * 1024 + 256 * pn + 32 * wc + 8 * fq;
#pragma unroll
        for (int b = 0; b < 2; ++b) { float s2[8], o[8]; unpack8(*(const u32x4*)(g + 128 * b), s2);
#pragma unroll
            for (int j = 0; j < 8; ++j) o[j] = v[b][j] * s2[j];
            store8bf(d + 128 * b, o); }
    }
};
struct EpiOut {
    static constexpr bool HAS_MID = false; static constexpr int NTYPES = 1;
    Params p;
    DI int type(int, int) const { return 0; }
    DI void mid(int, int, int, int, float (&)[2][8]) const {}
    template <int T> DI void apply(int row, int pn, int wc, int fq, float (&v)[2][8]) const {
        const int b_ = row / SEQ, col = 256 * pn + 32 * wc + 8 * fq;
        const float* gt = wsp<float>(p, WS_MOD) + b_ * 6144 + 2 * 1024 + col; const float* x = p.in[I_X] + (size_t)row * DM + col; float* d = wsp<float>(p, WS_R2) + (size_t)row * DM + col;
#pragma unroll
        for (int b = 0; b < 2; ++b)
#pragma unroll
            for (int h = 0; h < 2; ++h) { const f32x4 g = *(const f32x4*)(gt + 128 * b + 4 * h), xv = *(const f32x4*)(x + 128 * b + 4 * h);
                f32x4 o; o.x = xv.x + g.x * v[b][4 * h]; o.y = xv.y + g.y * v[b][4 * h + 1]; o.z = xv.z + g.z * v[b][4 * h + 2]; o.w = xv.w + g.w * v[b][4 * h + 3]; *(f32x4*)(d + 128 * b + 4 * h) = o; }
    }
};
struct EpiGU {
    static constexpr bool HAS_MID = false; static constexpr int NTYPES = 1;
    Params p;
    DI int type(int, int) const { return 0; }
    DI void mid(int, int, int, int, float (&)[2][8]) const {}
    template <int T> DI void apply(int row, int pn, int wc, int fq, float (&v)[2][8]) const {
        const int s = 4 * pn + wc; float o[8];
#pragma unroll
        for (int j = 0; j < 8; ++j) o[j] = siluf(v[0][j]) * v[1][j];
        store8bf(wsp<bf16_t>(p, WS_HID) + (size_t)row * DFF + 32 * s + 8 * fq, o);
    }
};
struct EpiDown {
    static constexpr bool HAS_MID = false; static constexpr int NTYPES = 1;
    Params p;
    DI int type(int, int) const { return 0; }
    DI void mid(int, int, int, int, float (&)[2][8]) const {}
    template <int T> DI void apply(int row, int pn, int wc, int fq, float (&v)[2][8]) const {
        const int b_ = row / SEQ, col = 256 * pn + 32 * wc + 8 * fq;
        const float* gt = wsp<float>(p, WS_MOD) + b_ * 6144 + 5 * 1024 + col; const float* x = wsp<float>(p, WS_R2) + (size_t)row * DM + col; float* d = p.out + (size_t)row * DM + col;
#pragma unroll
        for (int b = 0; b < 2; ++b)
#pragma unroll
            for (int h = 0; h < 2; ++h) { const f32x4 g = *(const f32x4*)(gt + 128 * b + 4 * h), xv = *(const f32x4*)(x + 128 * b + 4 * h);
                f32x4 o; o.x = xv.x + g.x * v[b][4 * h]; o.y = xv.y + g.y * v[b][4 * h + 1]; o.z = xv.z + g.z * v[b][4 * h + 2]; o.w = xv.w + g.w * v[b][4 * h + 3]; *(f32x4*)(d + 128 * b + 4 * h) = o; }
    }
};

template <class Epi, int T> DI void apply_dispatch(const Epi& E, int ty, int row, int pn, int wc, int fq, float (&v)[2][8]) {
    if constexpr (T < Epi::NTYPES) { if (ty == T) E.template apply<T>(row, pn, wc, fq, v); else apply_dispatch<Epi, T + 1>(E, ty, row, pn, wc, fq, v); }
}
template <class Epi>
DI void gemm_naive(const bf16_t* A, int lda, const bf16_t* Bt, int ldb, int M, int N, int K, int kmid, const Epi& E, int gw, int ngw) {
    const int lane = threadIdx.x & 63, fr = lane & 15, fq = lane >> 4;
    const int nslots = N / 64; const long total = (long)(M / 16) * nslots;
    for (long u = gw; u < total; u += ngw) {
        const int rg = (int)(u / nslots), s = (int)(u % nslots), pn = s >> 2, wc = s & 3, row = rg * 16 + fr;
        float v[2][8];
#pragma unroll
        for (int b = 0; b < 2; ++b)
#pragma unroll
            for (int j = 0; j < 8; ++j) v[b][j] = 0.f;
        const bf16_t* a = A + (size_t)row * lda; const bf16_t* bb = Bt + (size_t)(256 * pn + 32 * wc + 8 * fq) * ldb;
        for (int k = 0; k < K; k += 8) {
            if (Epi::HAS_MID && k == kmid) E.mid(row, pn, wc, fq, v);
            float af[8]; unpack8(*(const u32x4*)(a + k), af);
#pragma unroll
            for (int b = 0; b < 2; ++b)
#pragma unroll
                for (int j = 0; j < 8; ++j) { float bf[8]; unpack8(*(const u32x4*)(bb + (size_t)(128 * b + j) * ldb + k), bf); float d = 0.f;
#pragma unroll
                    for (int e = 0; e < 8; ++e) d += af[e] * bf[e];
                    v[b][j] += d; }
        }
        apply_dispatch<Epi, 0>(E, E.type(pn, wc), row, pn, wc, fq, v);
    }
}
namespace pg8 {
#define PG8_LAS __attribute__((address_space(3)))
typedef short bf16x8 __attribute__((ext_vector_type(8)));
constexpr int BM = 256, BK = 64, HALF = 128, HTB = HALF * BK * 2  , STAGE_BYTES = 8 * HTB, NXCD = 8, WGM = 8;

__host__ __device__ __forceinline__ int lds_byte(int r, int c) { const int st = (r >> 4) * 2 + (c >> 5), rr = r & 15, cc = c & 31, ob = rr * 64 + cc * 2; return st * 1024 + (ob ^ (((ob >> 9) & 1) << 5)); }
__host__ __device__ __forceinline__ void stage_rc(int b, int& R, int& C) { const int st = b / 1024, sb = b % 1024, swz = sb ^ (((sb >> 9) & 1) << 5); R = (st >> 1) * 16 + swz / 64; C = (st & 1) * 32 + (swz % 64) / 2; }
__host__ __device__ __forceinline__ int perm32(int rho) { const int n = rho >> 4, i = rho & 15; return 8 * (i >> 2) + 4 * n + (i & 3); }

struct Unit { int pm, pn; };
struct Gemm { const bf16_t* A; const bf16_t* Bt; int M, N, K, lda, ldb, kstepA; };

struct StaticOrder {
    int nM, nN, nwg, G, c;
    __host__ __device__ void init(int M, int N, int G_, int c_) { nM = M / BM; nN = N / BM; nwg = nM * nN; G = G_; c = c_; }
    __host__ __device__ bool next(int i, Unit& u) const {
        const long L = (long)i * G + c; if (L >= nwg) return false;
        int wgid = (int)L; { const int q = nwg / NXCD, r = nwg % NXCD, xcd = wgid % NXCD, off = wgid / NXCD; wgid = (xcd < r ? xcd * (q + 1) : r * (q + 1) + (xcd - r) * q) + off; }
        const int nig = WGM * nN, gid = wgid / nig, fm = gid * WGM, gsz = (nM - fm) < WGM ? (nM - fm) : WGM;
        u.pm = fm + ((wgid % nig) % gsz); u.pn = (wgid % nig) / gsz; return true;
    }
    __device__ __forceinline__ void a_ready(const Unit&) const {}
    __device__ __forceinline__ void done(const Unit&) const {}
};

template <class Epi, class Sched, bool ALIGN_EPI = false, bool SP2 = false>
__device__ __forceinline__ void gemm_phase(PG8_LAS unsigned char* lds, const Gemm g, const Sched& S, const Epi& E, int wid0) {
    const int tid = opaque_tid(wid0), wid = __builtin_amdgcn_readfirstlane(tid >> 6), lane = tid & 63, wr = wid >> 2, wc = wid & 3, fr = lane & 15, fq = lane >> 4;
    const int K = g.K; int nt = K / BK; asm volatile("" : "+s"(nt));
    unsigned voffA[2], voffB[2];
#pragma unroll
    for (int i = 0; i < 2; ++i) { int R, C; stage_rc(tid * 16 + i * 8192, R, C); const int Rb = Epi::PERM ? ((R & ~31) + perm32(R & 31)) : R;
        voffA[i] = (unsigned)(R * g.lda + C) * 2u; voffB[i] = (unsigned)(Rb * g.ldb + C) * 2u; }
    const size_t kstep = (size_t)(BK * 2), kstepA = (size_t)g.kstepA;
    const size_t hstepB = (size_t)HALF * g.ldb * 2, hstepA = (size_t)HALF * g.lda * 2;
    const size_t tstepB = 2 * hstepB, tstepA = 2 * hstepA;
    const unsigned ldsw = (unsigned)wid * 1024u;
    const int aoff = lds_byte(wr * 64 + fr, fq * 8), boff = lds_byte(wc * 32 + fr, fq * 8);
#define PG8_SA(b, h) (((b) * 2 + (h)) * HTB)
#define PG8_SB(b, h) ((4 + (b) * 2 + (h)) * HTB)
#define PG8_STAGE(bufoff, gbase, voff) do { _Pragma("unroll") for (int _i = 0; _i < 2; ++_i) \
        __builtin_amdgcn_global_load_lds((const unsigned*)((const char*)(gbase) + (voff)[_i]), (PG8_LAS unsigned*)(lds + (bufoff) + ldsw + _i * 8192), 16, 0, 0); } while (0)
#define PG8_LDA(dst, b, h) do { _Pragma("unroll") for (int m = 0; m < 4; ++m) _Pragma("unroll") for (int k = 0; k < 2; ++k) dst[m][k] = *(const PG8_LAS bf16x8*)(lds + PG8_SA(b, h) + aoff + m * 2048 + k * 1024); } while (0)
#define PG8_LDB(dst, b, h) do { _Pragma("unroll") for (int n = 0; n < 2; ++n) _Pragma("unroll") for (int k = 0; k < 2; ++k) dst[n][k] = *(const PG8_LAS bf16x8*)(lds + PG8_SB(b, h) + boff + n * 2048 + k * 1024); } while (0)
#define PG8_MMA(ai, bj, At, Bt) do { __builtin_amdgcn_s_setprio(1); _Pragma("unroll") for (int m = 0; m < 4; ++m) _Pragma("unroll") for (int n = 0; n < 2; ++n) _Pragma("unroll") for (int k = 0; k < 2; ++k) \
        acc[ai][bj][m][n] = __builtin_amdgcn_mfma_f32_16x16x32_bf16(Bt[n][k], At[m][k], acc[ai][bj][m][n], 0, 0, 0); __builtin_amdgcn_s_setprio(0); } while (0)
#define PG8_WAIT_V(n) asm volatile("s_waitcnt vmcnt(" #n ")" ::: "memory")
#define PG8_WAIT_L(n) asm volatile("s_waitcnt lgkmcnt(" #n ")" ::: "memory")
#define PG8_BAR __builtin_amdgcn_s_barrier()
#define PG8_SCHED __builtin_amdgcn_sched_barrier(0)
    Unit cur, nxt; int ui = 0;
    if (!S.next(0, cur)) return;
    f32x4 acc[2][2][4][2];
#pragma unroll
    for (int a = 0; a < 2; ++a)
#pragma unroll
        for (int b = 0; b < 2; ++b)
#pragma unroll
            for (int m = 0; m < 4; ++m)
#pragma unroll
                for (int n = 0; n < 2; ++n) acc[a][b][m][n] = (f32x4){0.f, 0.f, 0.f, 0.f};
    bf16x8 At[4][2], B0[2][2], B1[2][2];
    const char* cA = (const char*)g.A + (size_t)cur.pm * tstepA; const char* cB = (const char*)g.Bt + (size_t)cur.pn * tstepB;
    S.a_ready(cur);
    if constexpr (SP2) {
        PG8_STAGE(PG8_SB(0, 0), cB, voffB); PG8_STAGE(PG8_SB(0, 1), cB + hstepB, voffB); PG8_STAGE(PG8_SA(0, 0), cA, voffA); PG8_STAGE(PG8_SA(0, 1), cA + hstepA, voffA);
        if (wr == 1) PG8_BAR;
        PG8_WAIT_V(2); PG8_BAR;
        PG8_STAGE(PG8_SB(1, 0), cB + kstep, voffB); PG8_STAGE(PG8_SA(1, 0), cA + kstepA, voffA); PG8_STAGE(PG8_SB(1, 1), cB + hstepB + kstep, voffB);
        PG8_WAIT_V(6); PG8_BAR;
    } else {
        PG8_STAGE(PG8_SB(0, 0), cB, voffB); PG8_STAGE(PG8_SA(0, 0), cA, voffA); PG8_STAGE(PG8_SB(0, 1), cB + hstepB, voffB); PG8_STAGE(PG8_SA(0, 1), cA + hstepA, voffA);
        if (wr == 1) PG8_BAR;
        PG8_WAIT_V(4); PG8_BAR;
        PG8_STAGE(PG8_SB(1, 0), cB + kstep, voffB); PG8_STAGE(PG8_SA(1, 0), cA + kstepA, voffA); PG8_STAGE(PG8_SB(1, 1), cB + hstepB + kstep, voffB);
        PG8_WAIT_V(6); PG8_BAR;
    }
    for (;;) {
        const bool has_next = S.next(ui + 1, nxt);
        const char* nA = has_next ? (const char*)g.A + (size_t)nxt.pm * tstepA : cA; const char* nB = has_next ? (const char*)g.Bt + (size_t)nxt.pn * tstepB : cB;
        for (int hh_ = 0; hh_ < (Epi::HAS_MID ? 2 : 1); ++hh_) {
        if constexpr (Epi::HAS_MID) { if (hh_ == 1) E.mid(acc, cur, wr, wc, fr, fq); }
        const int t0_ = Epi::HAS_MID ? hh_ * (nt >> 1) : 0, t1_ = Epi::HAS_MID ? (hh_ + 1) * (nt >> 1) : nt;
        for (int t = t0_; t < t1_; t += 2) {
            const bool last = (t == nt - 2);
            const char* a1 = cA + (size_t)(t + 1) * kstepA;
            const char* a2 = last ? nA : cA + (size_t)(t + 2) * kstepA; const char* b2 = last ? nB : cB + (size_t)(t + 2) * kstep;
            const char* a3 = a2 + kstepA; const char* b3 = b2 + kstep;
            if (last && has_next) S.a_ready(nxt);
            if constexpr (SP2) {
            PG8_LDB(B0, 0, 0); PG8_LDB(B1, 0, 1); PG8_SCHED; PG8_LDA(At, 0, 0); PG8_STAGE(PG8_SA(1, 1), a1 + hstepA, voffA);
            PG8_WAIT_V(8); PG8_WAIT_L(0); PG8_BAR; PG8_MMA(0, 0, At, B0); PG8_MMA(0, 1, At, B1); PG8_BAR; PG8_SCHED;
            PG8_LDA(At, 0, 1); PG8_STAGE(PG8_SB(0, 0), b2, voffB); PG8_STAGE(PG8_SB(0, 1), b2 + hstepB, voffB); PG8_STAGE(PG8_SA(0, 0), a2, voffA);
            PG8_WAIT_V(8); PG8_WAIT_L(0); PG8_BAR; PG8_MMA(1, 0, At, B0); PG8_MMA(1, 1, At, B1); PG8_BAR; PG8_SCHED;
            PG8_LDB(B0, 1, 0); PG8_LDB(B1, 1, 1); PG8_SCHED; PG8_LDA(At, 1, 0); PG8_STAGE(PG8_SA(0, 1), a2 + hstepA, voffA);
            PG8_WAIT_V(8); PG8_WAIT_L(0); PG8_BAR; PG8_MMA(0, 0, At, B0); PG8_MMA(0, 1, At, B1); PG8_BAR; PG8_SCHED;
            PG8_LDA(At, 1, 1); PG8_STAGE(PG8_SB(1, 0), b3, voffB); PG8_STAGE(PG8_SB(1, 1), b3 + hstepB, voffB); PG8_STAGE(PG8_SA(1, 0), a3, voffA);
            PG8_WAIT_V(8); PG8_WAIT_L(0); PG8_BAR; PG8_MMA(1, 0, At, B0); PG8_MMA(1, 1, At, B1); PG8_BAR; PG8_SCHED;
            } else {
            PG8_LDB(B0, 0, 0); PG8_SCHED; PG8_LDA(At, 0, 0); PG8_STAGE(PG8_SA(1, 1), a1 + hstepA, voffA);
            PG8_WAIT_L(8); PG8_BAR; PG8_WAIT_L(0); PG8_MMA(0, 0, At, B0); PG8_BAR; PG8_SCHED;
            PG8_LDB(B1, 0, 1); PG8_STAGE(PG8_SB(0, 0), b2, voffB);
            PG8_BAR; PG8_WAIT_L(0); PG8_MMA(0, 1, At, B1); PG8_BAR;
            PG8_LDA(At, 0, 1); PG8_STAGE(PG8_SA(0, 0), a2, voffA);
            PG8_BAR; PG8_WAIT_L(0); PG8_MMA(1, 0, At, B0); PG8_BAR; PG8_SCHED;
            PG8_STAGE(PG8_SB(0, 1), b2 + hstepB, voffB);
            PG8_WAIT_V(6); PG8_BAR; PG8_MMA(1, 1, At, B1); PG8_BAR;
            PG8_LDB(B0, 1, 0); PG8_SCHED; PG8_LDA(At, 1, 0); PG8_STAGE(PG8_SA(0, 1), a2 + hstepA, voffA);
            PG8_WAIT_L(8); PG8_BAR; PG8_WAIT_L(0); PG8_MMA(0, 0, At, B0); PG8_BAR; PG8_SCHED;
            PG8_LDB(B1, 1, 1); PG8_STAGE(PG8_SB(1, 0), b3, voffB);
            PG8_BAR; PG8_WAIT_L(0); PG8_MMA(0, 1, At, B1); PG8_BAR;
            PG8_LDA(At, 1, 1); PG8_STAGE(PG8_SA(1, 0), a3, voffA);
            PG8_BAR; PG8_WAIT_L(0); PG8_MMA(1, 0, At, B0); PG8_BAR; PG8_SCHED;
            PG8_STAGE(PG8_SB(1, 1), b3 + hstepB, voffB);
            PG8_WAIT_V(6); PG8_BAR; PG8_MMA(1, 1, At, B1); PG8_BAR;
            }
        }
        }
        if constexpr (ALIGN_EPI) { if (wr == 0) PG8_BAR; }
        if constexpr (!Epi::AFTER_DRAIN) { E(acc, cur, wr, wc, fr, fq); S.done(cur); }
        if (!has_next) break;
#pragma unroll
        for (int a = 0; a < 2; ++a)
#pragma unroll
            for (int b = 0; b < 2; ++b)
#pragma unroll
                for (int m = 0; m < 4; ++m)
#pragma unroll
                    for (int n = 0; n < 2; ++n) acc[a][b][m][n] = (f32x4){0.f, 0.f, 0.f, 0.f};
        cur = nxt; cA = nA; cB = nB; ++ui;
        if constexpr (ALIGN_EPI) { if (wr == 1) PG8_BAR; }
    }
    PG8_WAIT_V(0);
    if constexpr (!ALIGN_EPI) { if (wr == 0) PG8_BAR; }
    PG8_BAR;
    if constexpr (Epi::AFTER_DRAIN) { E.fused(acc, cur, wr, wc, fr, fq, lds, wid, lane); S.done(cur); }
#undef PG8_SA
#undef PG8_SB
#undef PG8_STAGE
#undef PG8_LDA
#undef PG8_LDB
#undef PG8_MMA
#undef PG8_WAIT_V
#undef PG8_WAIT_L
#undef PG8_BAR
#undef PG8_SCHED
}
}

template <class SE> struct EpiAdapt {
    static constexpr bool PERM = true, AFTER_DRAIN = false, HAS_MID = SE::HAS_MID;
    SE se;
    template <int T> DI void run(f32x4 (&acc)[2][2][4][2], const pg8::Unit& u, int wr, int wc, int fr, int fq) const {
#pragma unroll
        for (int ai = 0; ai < 2; ++ai)
#pragma unroll
            for (int m = 0; m < 4; ++m) {
                int row = fr; asm volatile("" : "+v"(row)); row += u.pm * 256 + ai * 128 + wr * 64 + m * 16; float v[2][8];
#pragma unroll
                for (int bj = 0; bj < 2; ++bj)
#pragma unroll
                    for (int n = 0; n < 2; ++n) { v[bj][4 * n] = acc[ai][bj][m][n][0]; v[bj][4 * n + 1] = acc[ai][bj][m][n][1]; v[bj][4 * n + 2] = acc[ai][bj][m][n][2]; v[bj][4 * n + 3] = acc[ai][bj][m][n][3]; }
                se.template apply<T>(row, u.pn, wc, fq, v);
                asm volatile("" ::: "memory");
            }
    }
    template <int T> DI void disp(int ty, f32x4 (&acc)[2][2][4][2], const pg8::Unit& u, int wr, int wc, int fr, int fq) const {
        if constexpr (T < SE::NTYPES) { if (ty == T) run<T>(acc, u, wr, wc, fr, fq); else disp<T + 1>(ty, acc, u, wr, wc, fr, fq); }
    }
    DI void operator()(f32x4 (&acc)[2][2][4][2], const pg8::Unit& u, int wr, int wc, int fr, int fq) const { disp<0>(se.type(u.pn, wc), acc, u, wr, wc, fr, fq); }
    DI void mid(f32x4 (&acc)[2][2][4][2], const pg8::Unit& u, int wr, int wc, int fr, int fq) const {
#pragma unroll
        for (int ai = 0; ai < 2; ++ai)
#pragma unroll
            for (int m = 0; m < 4; ++m) {
                int row = fr; asm volatile("" : "+v"(row)); row += u.pm * 256 + ai * 128 + wr * 64 + m * 16; float v[2][8];
#pragma unroll
                for (int bj = 0; bj < 2; ++bj)
#pragma unroll
                    for (int n = 0; n < 2; ++n) { v[bj][4 * n] = acc[ai][bj][m][n][0]; v[bj][4 * n + 1] = acc[ai][bj][m][n][1]; v[bj][4 * n + 2] = acc[ai][bj][m][n][2]; v[bj][4 * n + 3] = acc[ai][bj][m][n][3]; }
                se.mid(row, u.pn, wc, fq, v);
                asm volatile("" ::: "memory");
#pragma unroll
                for (int bj = 0; bj < 2; ++bj)
#pragma unroll
                    for (int n = 0; n < 2; ++n) { acc[ai][bj][m][n][0] = v[bj][4 * n]; acc[ai][bj][m][n][1] = v[bj][4 * n + 1]; acc[ai][bj][m][n][2] = v[bj][4 * n + 2]; acc[ai][bj][m][n][3] = v[bj][4 * n + 3]; }
            }
    }
};
template <class SE> DI void gemm_fast(PG8_LAS unsigned char* lds, const bf16_t* A, int lda, const bf16_t* Bt, int M, int N, int K, const SE& se, int G, int c, int wid0) {
    pg8::Gemm g{A, Bt, M, N, K, lda, K, 128}; pg8::StaticOrder S; S.init(M, N, G, c);
    EpiAdapt<SE> E{se};
    pg8::gemm_phase<EpiAdapt<SE>, pg8::StaticOrder, true, true>(lds, g, S, E, wid0);
}
struct RangeOrder {
    int base, cnt, nN;
    DI bool next(int i, pg8::Unit& u) const { if (i >= cnt) return false; const int L = base + i; u.pm = L / nN; u.pn = L % nN; return true; }
    DI void a_ready(const pg8::Unit&) const {}
    DI void done(const pg8::Unit&) const {}
};
template <class SE> DI void gemm_fast_range(PG8_LAS unsigned char* lds, const bf16_t* A, int lda, const bf16_t* Bt, int M, int N, int K, const SE& se, int base, int cnt, int wid0) {
    pg8::Gemm g{A, Bt, M, N, K, lda, K, 128}; RangeOrder S{base, cnt, N / 256};
    EpiAdapt<SE> E{se};
    pg8::gemm_phase<EpiAdapt<SE>, RangeOrder, true, true>(lds, g, S, E, wid0);
}
struct OneUnit {
    int pm, pn;
    DI bool next(int i, pg8::Unit& u) const { if (i > 0) return false; u.pm = pm; u.pn = pn; return true; }
    DI void a_ready(const pg8::Unit&) const {}
    DI void done(const pg8::Unit&) const {}
};
struct EpiCmpH {
    static constexpr bool HAS_MID = false; static constexpr int NTYPES = 1;
    float* H;
    DI int type(int, int) const { return 0; }
    DI void mid(int, int, int, int, float (&)[2][8]) const {}
    template <int T> DI void apply(int row, int pn, int wc, int fq, float (&v)[2][8]) const {
        float* d = H + (size_t)row * 256 + 32 * wc + 8 * fq;
#pragma unroll
        for (int b = 0; b < 2; ++b) { *(f32x4*)(d + 128 * b) = (f32x4){v[b][0], v[b][1], v[b][2], v[b][3]}; *(f32x4*)(d + 128 * b + 4) = (f32x4){v[b][4], v[b][5], v[b][6], v[b][7]}; }
    }
};
DI void cmp_hidden_fast(const Params& p, PG8_LAS unsigned char* lds, int cu, int wid0) {
    const int kv = cu >> 4, g = (cu >> 3) & 1, pm = (cu >> 1) & 3, sp = cu & 1;
    const bf16_t* A = wsp<bf16_t>(p, kv ? WS_VC : WS_KC) + g * 64 + (size_t)(16 * sp) * 128;
    const bf16_t* Bt = wsp<bf16_t>(p, WS_CW1) + (size_t)kv * 256 * 2048 + 1024 * sp;
    pg8::Gemm gm{A, Bt, 1024, 256, 1024, 2048, 2048, 256}; OneUnit S{pm, 0};
    EpiCmpH se{wsp<float>(p, WS_CMPH) + (size_t)((kv * 2 + g) * 2 + sp) * 1024 * 256};
    EpiAdapt<EpiCmpH> E{se};
    pg8::gemm_phase<EpiAdapt<EpiCmpH>, OneUnit, true, true>(lds, gm, S, E, wid0);
}
template <bool SPLIT> DI void cmp_out(const Params& p, int gw, int ngw, int lane) {
    const float* H = wsp<float>(p, WS_CMPH);
    for (int u = gw; u < 2 * 2 * 1024; u += ngw) {
        const int r = u & 1023, g = (u >> 10) & 1, kv = u >> 11; const int b = r >> 7, n = r & 127;
        bf16_t* dst = wsp<bf16_t>(p, kv ? WS_VCF : WS_KCF) + (size_t)r * 128 + g * 64 + lane;
        if (n == 127) { *dst = 0; continue; }
        const float* w2 = (kv ? p.in[I_CW2V] : p.in[I_CW2K]) + lane;
        float acc = 0.f;
        if constexpr (SPLIT) {
            const float* h = H + ((size_t)((kv * 2 + g) * 2) * 1024 + r) * 256; const float* cb = wsp<float>(p, WS_CB1) + kv * 256;
            float hv[4];
#pragma unroll
            for (int q = 0; q < 4; ++q) { const int j = 64 * q + lane; hv[q] = siluf((h[j] + h[(size_t)1024 * 256 + j]) + cb[j]); }
#pragma unroll
            for (int q = 0; q < 4; ++q)
#pragma unroll
                for (int jj = 0; jj < 64; ++jj) acc += __int_as_float(__builtin_amdgcn_readlane(__float_as_int(hv[q]), jj)) * w2[(64 * q + jj) * 64];
        } else {
            const float* h = H + (size_t)u * 256;
            for (int j = 0; j < 256; ++j) acc += h[j] * w2[j * 64];
        }
        if (kv == 0) {
            const float rstd = rsqrtf(wave_sum(acc * acc) * (1.f / 64.f) + EPS);
            float y = acc * rstd * p.in[I_NKCG][lane];
            const int prow = b * SEQ + 16 * n + 31; const float oth = xorl<8>(y);
            if (lane < 16) { const float c = ropeCN(p)[(size_t)prow * 8 + (lane & 7)], s = ropeSN(p)[(size_t)prow * 8 + (lane & 7)]; y = (lane < 8) ? y * c - oth * s : y * c + oth * s; }
            acc = y;
        }
        *dst = (bf16_t)f2bf(acc);
    }
}

DI unsigned select_blocks(const float (&imp)[32], int cur) {
    if (cur < 8) return (2u << cur) - 1u;
    unsigned mask = 1u | (1u << cur) | (1u << (cur - 1));
#pragma unroll 1
    for (int it = 0; it < 5; ++it) {
        float best = -1.0f; int bi = 1;
#pragma unroll
        for (int j = 1; j < 32; ++j) { const bool ok = (j <= cur - 2) && !((mask >> j) & 1u); if (ok && imp[j] > best) { best = imp[j]; bi = j; } }
        mask |= 1u << bi;
    }
    return mask;
}

namespace fa {
typedef short bf16x8 __attribute__((ext_vector_type(8)));
typedef short s16x4 __attribute__((ext_vector_type(4)));
typedef float f32x16 __attribute__((ext_vector_type(16)));
typedef LAS const char* lds_cptr;
typedef LAS char* lds_ptr;
constexpr int KBUF = 12288, VBUF = 8192;
constexpr int L_K = 0, L_V = 2 * KBUF, L_RK = L_V + 2 * VBUF, L_WS = L_RK + 512, L_OST = L_WS + 8 * 256, L_END = L_OST + 8 * 4096;
#define FA_SBAR() __builtin_amdgcn_sched_barrier(0)
DI int crow(int r, int hi) { return (r & 3) + 8 * (r >> 2) + 4 * hi; }
typedef float f32x2_t __attribute__((ext_vector_type(2))); typedef __bf16 bf16x2_t __attribute__((ext_vector_type(2)));
DI unsigned cvtpk(float lo, float hi) { f32x2_t v = {lo, hi}; bf16x2_t b = __builtin_convertvector(v, bf16x2_t); return __builtin_bit_cast(unsigned, b); }

template <int DK> DI void qkt(f32x16& p0, f32x16& p1, lds_cptr kb, const bf16x8* qr) {
    f32x16 z;
#pragma unroll
    for (int i = 0; i < 16; ++i) z[i] = 0.f;
#pragma unroll
    for (int d0 = 0; d0 < DK / 16; ++d0) {
        const bf16x8 b0 = *(const LAS bf16x8*)(kb + d0 * 2048);
        const bf16x8 b1 = *(const LAS bf16x8*)(kb + d0 * 2048 + 512);
        if (d0 == 0) { p0 = __builtin_amdgcn_mfma_f32_32x32x16_bf16(b0, qr[0], z, 0, 0, 0); p1 = __builtin_amdgcn_mfma_f32_32x32x16_bf16(b1, qr[0], z, 0, 0, 0); }
        else { p0 = __builtin_amdgcn_mfma_f32_32x32x16_bf16(b0, qr[d0], p0, 0, 0, 0); p1 = __builtin_amdgcn_mfma_f32_32x32x16_bf16(b1, qr[d0], p1, 0, 0, 0); }
    }
}
DI void pv(f32x16* o, int vb, bf16x8 pa0, bf16x8 pa1, bf16x8 pa2, bf16x8 pa3) {
#pragma unroll
    for (int d0 = 0; d0 < 2; ++d0) { s16x4 lo[4], hi[4];
#pragma unroll
        for (int ks = 0; ks < 4; ++ks) {
            asm volatile("ds_read_b64_tr_b16 %0,%1 offset:%c2" : "=&v"(lo[ks]) : "v"(vb), "i"(d0 * 4096 + ks * 1024) : "memory");
            asm volatile("ds_read_b64_tr_b16 %0,%1 offset:%c2" : "=&v"(hi[ks]) : "v"(vb), "i"(d0 * 4096 + ks * 1024 + 512) : "memory"); }
        asm volatile("s_waitcnt lgkmcnt(0)" ::: "memory"); FA_SBAR();
#define FA_PK(k) (bf16x8){lo[k][0], lo[k][1], lo[k][2], lo[k][3], hi[k][0], hi[k][1], hi[k][2], hi[k][3]}
        o[d0] = __builtin_amdgcn_mfma_f32_32x32x16_bf16(pa0, FA_PK(0), o[d0], 0, 0, 0);
        o[d0] = __builtin_amdgcn_mfma_f32_32x32x16_bf16(pa1, FA_PK(1), o[d0], 0, 0, 0);
        o[d0] = __builtin_amdgcn_mfma_f32_32x32x16_bf16(pa2, FA_PK(2), o[d0], 0, 0, 0);
        o[d0] = __builtin_amdgcn_mfma_f32_32x32x16_bf16(pa3, FA_PK(3), o[d0], 0, 0, 0);
#undef FA_PK
    }
}
DI void pack_p(const f32x16& p0, const f32x16& p1, bf16x8& a0, bf16x8& a1, bf16x8& a2, bf16x8& a3) {
    u32x4 w0, w1, w2, w3;
    w0.x = cvtpk(p0[0], p0[1]); w0.y = cvtpk(p0[2], p0[3]); w0.z = cvtpk(p0[4], p0[5]); w0.w = cvtpk(p0[6], p0[7]);
    w1.x = cvtpk(p0[8], p0[9]); w1.y = cvtpk(p0[10], p0[11]); w1.z = cvtpk(p0[12], p0[13]); w1.w = cvtpk(p0[14], p0[15]);
    w2.x = cvtpk(p1[0], p1[1]); w2.y = cvtpk(p1[2], p1[3]); w2.z = cvtpk(p1[4], p1[5]); w2.w = cvtpk(p1[6], p1[7]);
    w3.x = cvtpk(p1[8], p1[9]); w3.y = cvtpk(p1[10], p1[11]); w3.z = cvtpk(p1[12], p1[13]); w3.w = cvtpk(p1[14], p1[15]);
    a0 = __builtin_bit_cast(bf16x8, w0); a1 = __builtin_bit_cast(bf16x8, w1); a2 = __builtin_bit_cast(bf16x8, w2); a3 = __builtin_bit_cast(bf16x8, w3);
}
DI void mask_range(f32x16& p0, f32x16& p1, int key0, int lo, int hi_, int hf) {
#pragma unroll
    for (int r = 0; r < 16; ++r) { const int k = key0 + crow(r, hf); if (k < lo || k > hi_) p0[r] = -INFINITY; if (k + 32 < lo || k + 32 > hi_) p1[r] = -INFINITY; }
}
DI float rowmax32(const f32x16& p0, const f32x16& p1) {
    float a = fmaxf(p0[0], p1[0]);
#pragma unroll
    for (int r = 1; r < 16; ++r) a = fmaxf(a, fmaxf(p0[r], p1[r]));
    return max32(a);
}
struct State { float m, l; f32x16 o[2]; };
DI void st_init(State& s) { s.m = -INFINITY; s.l = 0.f;
#pragma unroll
    for (int i = 0; i < 16; ++i) { s.o[0][i] = 0.f; s.o[1][i] = 0.f; } }
DI void softmax_pv(State& st, f32x16& p0, f32x16& p1, int vb, LAS float* wsf, int r32, int hf) {
    const float rm = rowmax32(p0, p1);
    const float mn = fmaxf(st.m, rm), mu = (mn == -INFINITY) ? 0.f : mn;
    const float alpha = __builtin_amdgcn_exp2f(st.m - mu);
    st.m = mn;
    float ls = 0.f;
#pragma unroll
    for (int r = 0; r < 16; ++r) { p0[r] = __builtin_amdgcn_exp2f(p0[r] - mu); p1[r] = __builtin_amdgcn_exp2f(p1[r] - mu); ls += p0[r] + p1[r]; }
    st.l = st.l * alpha + ls;
    if (__any(alpha != 1.0f)) {
        if (hf == 0) wsf[r32] = alpha;
        asm volatile("s_waitcnt lgkmcnt(0)" ::: "memory");
#pragma unroll
        for (int g = 0; g < 4; ++g) { const f32x4 a = *(const LAS f32x4*)(wsf + 8 * g + 4 * hf);
            st.o[0][4 * g] *= a.x; st.o[0][4 * g + 1] *= a.y; st.o[0][4 * g + 2] *= a.z; st.o[0][4 * g + 3] *= a.w;
            st.o[1][4 * g] *= a.x; st.o[1][4 * g + 1] *= a.y; st.o[1][4 * g + 2] *= a.z; st.o[1][4 * g + 3] *= a.w; }
    }
    bf16x8 a0, a1, a2, a3; pack_p(p0, p1, a0, a1, a2, a3);
    pv(st.o, vb, a0, a1, a2, a3);
}
DI void accum_scaled(f32x16* acc, const f32x16* o, float fac_row, LAS float* wsf, int r32, int hf) {
    if (hf == 0) wsf[32 + r32] = fac_row;
    asm volatile("s_waitcnt lgkmcnt(0)" ::: "memory");
#pragma unroll
    for (int g = 0; g < 4; ++g) { const f32x4 a = *(const LAS f32x4*)(wsf + 32 + 8 * g + 4 * hf);
        acc[0][4 * g] += o[0][4 * g] * a.x; acc[0][4 * g + 1] += o[0][4 * g + 1] * a.y; acc[0][4 * g + 2] += o[0][4 * g + 2] * a.z; acc[0][4 * g + 3] += o[0][4 * g + 3] * a.w;
        acc[1][4 * g] += o[1][4 * g] * a.x; acc[1][4 * g + 1] += o[1][4 * g + 1] * a.y; acc[1][4 * g + 2] += o[1][4 * g + 2] * a.z; acc[1][4 * g + 3] += o[1][4 * g + 3] * a.w; }
}
DI void stage_rows(const f32x16* acc, LAS bf16_t* stg, int r32, int hf) {
#pragma unroll
    for (int r = 0; r < 16; ++r) { const int orow = crow(r, hf);
        stg[orow * 64 + r32] = (bf16_t)f2bf(acc[0][r]); stg[orow * 64 + 32 + r32] = (bf16_t)f2bf(acc[1][r]); }
    asm volatile("s_waitcnt lgkmcnt(0)" ::: "memory");
}

DI void mla_unit(const Params& p, LAS unsigned char* lds, int b, int h, int qb, int wid0) {
    const int tid = opaque_tid(wid0), lane = tid & 63, r32 = lane & 31, hf = lane >> 5; const int wv = __builtin_amdgcn_readfirstlane(tid >> 6);
    const bf16_t* KN = wsp<bf16_t>(p, WS_KN); const bf16_t* KPE = wsp<bf16_t>(p, WS_KPE); const bf16_t* VM = wsp<bf16_t>(p, WS_VM);
    const float* sqk = wsp<float>(p, WS_SSQKN); const float* sqp = wsp<float>(p, WS_SSQPE); bf16_t* OC = wsp<bf16_t>(p, WS_R1);
    const int rowbase = b * SEQ, q0 = qb * 256, tq = q0 + wv * 32 + r32, row = rowbase + tq;
    LAS float* wsf = (LAS float*)(lds + L_WS) + wv * 64;
    bf16x8 qr[6];
    {
        const bf16_t* src = wsp<bf16_t>(p, WS_R0) + (size_t)row * 768 + h * 96 + 8 * hf; float q[6][8]; float ss = 0.f;
#pragma unroll
        for (int d0 = 0; d0 < 6; ++d0) { unpack8(*(const u32x4*)(src + 16 * d0), q[d0]);
#pragma unroll
            for (int e = 0; e < 8; ++e) ss += q[d0][e] * q[d0][e]; }
        ss = sum32(ss);
        const float rstd = rsqrtf(ss * (1.f / 96.f) + EPS); const float* qg = p.in[I_MQG] + 8 * hf; const float* kg = p.in[I_MKG] + 8 * hf;
#pragma unroll
        for (int d0 = 0; d0 < 6; ++d0)
#pragma unroll
            for (int e = 0; e < 8; ++e) q[d0][e] *= rstd * qg[16 * d0 + e];
        const float* cs = ropeCM(p) + (size_t)row * 16 + 8 * hf; const float* sn = ropeSM(p) + (size_t)row * 16 + 8 * hf;
#pragma unroll
        for (int e = 0; e < 8; ++e) { const float x1 = q[4][e], x2 = q[5][e]; q[4][e] = x1 * cs[e] - x2 * sn[e]; q[5][e] = x2 * cs[e] + x1 * sn[e]; }
#pragma unroll
        for (int d0 = 0; d0 < 6; ++d0) { float f[8];
#pragma unroll
            for (int e = 0; e < 8; ++e) f[e] = q[d0][e] * ((d0 < 4) ? kg[16 * d0 + e] * C2M : C2M);
            qr[d0] = __builtin_bit_cast(bf16x8, pack8(f)); }
    }
    State st; st_init(st);
    const int NT = 4 * (qb + 1);
    u32x4 ka, kb2, vv; float rk = 0.f;
    const bf16_t* kasrc = KN + (size_t)(rowbase + lane) * 512 + h * 64 + wv * 8;
    const bf16_t* kbsrc = KPE + (size_t)(rowbase + lane) * 32 + (wv & 3) * 8;
    const bf16_t* vsrc = VM + (size_t)(rowbase + 16 * (wv & 3) + (lane >> 2)) * 512 + h * 64 + (wv >> 2) * 32 + (lane & 3) * 8;
#define MLA_LOAD(t) do { ka = *(const u32x4*)(kasrc + (size_t)(t) * 64 * 512); if (wv < 4) kb2 = *(const u32x4*)(kbsrc + (size_t)(t) * 64 * 32); vv = *(const u32x4*)(vsrc + (size_t)(t) * 64 * 512); \
        if (tid < 64) { const int kr_ = rowbase + (t) * 64 + tid; rk = rsqrtf((sqk[(size_t)kr_ * 8 + h] + sqp[kr_]) * (1.f / 96.f) + EPS); } } while (0)
#define MLA_STORE(bf) do { *(LAS u32x4*)(lds + L_K + (bf) * KBUF + wv * 1024 + lane * 16) = ka; if (wv < 4) *(LAS u32x4*)(lds + L_K + (bf) * KBUF + (8 + wv) * 1024 + lane * 16) = kb2; \
        *(LAS u32x4*)(lds + L_V + (bf) * VBUF + wv * 1024 + lane * 16) = vv; if (tid < 64) *(LAS float*)(lds + L_RK + (bf) * 256 + tid * 4) = rk; } while (0)
    __syncthreads();
    MLA_LOAD(0); MLA_STORE(0); if (NT > 1) MLA_LOAD(1);
    const int vboff = ((lane >> 4) & 1) * 32 + (lane & 3) * 8 + (4 * hf + ((lane & 15) >> 2)) * 64;
    const int qlo = q0 + wv * 32;
    for (int i = 0; i < NT; ++i) {
        __syncthreads();
        if (i + 1 < NT) { MLA_STORE((i + 1) & 1); if (i + 2 < NT) MLA_LOAD(i + 2); }
        const int key0 = i * 64, bf = i & 1;
        if (key0 <= qlo + 31) {
            f32x16 p0, p1; qkt<96>(p0, p1, (lds_cptr)(lds + L_K + bf * KBUF) + hf * 1024 + r32 * 16, qr);
            const LAS float* rkp = (const LAS float*)(lds + L_RK + bf * 256);
#pragma unroll
            for (int g = 0; g < 4; ++g) { const f32x4 a = *(const LAS f32x4*)(rkp + 8 * g + 4 * hf), c = *(const LAS f32x4*)(rkp + 32 + 8 * g + 4 * hf);
                p0[4 * g] *= a.x; p0[4 * g + 1] *= a.y; p0[4 * g + 2] *= a.z; p0[4 * g + 3] *= a.w; p1[4 * g] *= c.x; p1[4 * g + 1] *= c.y; p1[4 * g + 2] *= c.z; p1[4 * g + 3] *= c.w; }
            if (key0 + 63 > qlo) mask_range(p0, p1, key0, 0, tq, hf);
            softmax_pv(st, p0, p1, (int)(uintptr_t)(lds + L_V + bf * VBUF) + vboff, wsf, r32, hf);
        }
    }
#undef MLA_LOAD
#undef MLA_STORE
    const float lt = sum32(st.l);
    f32x16 acc[2];
#pragma unroll
    for (int i = 0; i < 16; ++i) { acc[0][i] = 0.f; acc[1][i] = 0.f; }
    accum_scaled(acc, st.o, 1.0f / lt, wsf, r32, hf);
    LAS bf16_t* stg = (LAS bf16_t*)(lds + L_OST) + wv * 2048;
    stage_rows(acc, stg, r32, hf);
#pragma unroll
    for (int i = 0; i < 4; ++i) { const int rr = i * 8 + (lane >> 3), ch = lane & 7; const u32x4 v = *(const LAS u32x4*)(stg + rr * 64 + ch * 8);
        *(u32x4*)(OC + (size_t)(rowbase + q0 + wv * 32 + rr) * 1024 + h * 64 + ch * 8) = v; }
}

DI void nsa_unit(const Params& p, LAS unsigned char* lds, int b, int g, int c, int wid0) {
    const int tid = opaque_tid(wid0), lane = tid & 63, r32 = lane & 31, hf = lane >> 5; const int wv = __builtin_amdgcn_readfirstlane(tid >> 6);
    const bf16_t* QN = wsp<bf16_t>(p, WS_QN); const bf16_t* KCF = wsp<bf16_t>(p, WS_KCF); const bf16_t* VCF = wsp<bf16_t>(p, WS_VCF);
    const bf16_t* KS = wsp<bf16_t>(p, WS_KS); const bf16_t* VS = wsp<bf16_t>(p, WS_VS); const bf16_t* KW = wsp<bf16_t>(p, WS_KW); const bf16_t* VW = wsp<bf16_t>(p, WS_VW);
    const bf16_t* GN = wsp<bf16_t>(p, WS_GN); bf16_t* OC = wsp<bf16_t>(p, WS_R1);
    const int rowbase = b * SEQ, tt = 8 * wv + (r32 >> 2), hd = g * 4 + (r32 & 3), tq = 64 * c + tt, row = rowbase + tq;
    LAS float* wsf = (LAS float*)(lds + L_WS) + wv * 64;
    bf16x8 qr[4];
#pragma unroll
    for (int d0 = 0; d0 < 4; ++d0) qr[d0] = *(const bf16x8*)(QN + (size_t)row * 512 + hd * 64 + 16 * d0 + 8 * hf);
    const float g0 = bf2f(GN[(size_t)row * 32 + hd * 3 + 0]), g1 = bf2f(GN[(size_t)row * 32 + hd * 3 + 1]), g2 = bf2f(GN[(size_t)row * 32 + hd * 3 + 2]);
    f32x16 ot[2];
#pragma unroll
    for (int i = 0; i < 16; ++i) { ot[0][i] = 0.f; ot[1][i] = 0.f; }
    const int vboff = ((lane >> 4) & 1) * 32 + (lane & 3) * 8 + (4 * hf + ((lane & 15) >> 2)) * 64;
    u32x4 ka, vv;
#define NSA_LOAD(KB, VB, krow0) do { ka = *(const u32x4*)((KB) + (size_t)((krow0) + lane) * 128 + g * 64 + wv * 8); \
        vv = *(const u32x4*)((VB) + (size_t)((krow0) + 16 * (wv & 3) + (lane >> 2)) * 128 + g * 64 + (wv >> 2) * 32 + (lane & 3) * 8); } while (0)
#define NSA_STORE(koff, voff) do { *(LAS u32x4*)(lds + (koff) + wv * 1024 + lane * 16) = ka; *(LAS u32x4*)(lds + (voff) + wv * 1024 + lane * 16) = vv; } while (0)
    unsigned selmask;
    {
        const int ntile = (4 * c + 3 > 64) ? 2 : 1;
        const int nmax = (tq >= 31) ? ((tq - 31) >> 4) : -1;
        __syncthreads();
        NSA_LOAD(KCF, VCF, b * 128); NSA_STORE(L_K, L_V);
        if (ntile == 2) { NSA_LOAD(KCF, VCF, b * 128 + 64); NSA_STORE(L_K + 8192, L_V + 8192); }
        __syncthreads();
        f32x16 pa0, pa1, pb0, pb1;
        qkt<64>(pa0, pa1, (lds_cptr)(lds + L_K) + hf * 1024 + r32 * 16, qr); mask_range(pa0, pa1, 0, 0, nmax, hf);
        float m = rowmax32(pa0, pa1);
        if (ntile == 2) { qkt<64>(pb0, pb1, (lds_cptr)(lds + L_K + 8192) + hf * 1024 + r32 * 16, qr); mask_range(pb0, pb1, 64, 0, nmax, hf); m = fmaxf(m, rowmax32(pb0, pb1)); }
        else {
#pragma unroll
            for (int i = 0; i < 16; ++i) { pb0[i] = -INFINITY; pb1[i] = -INFINITY; } }
        const float mu = (m == -INFINITY) ? 0.f : m;
        float ls = 0.f;
#pragma unroll
        for (int r = 0; r < 16; ++r) { pa0[r] = __builtin_amdgcn_exp2f(pa0[r] - mu); pa1[r] = __builtin_amdgcn_exp2f(pa1[r] - mu); pb0[r] = __builtin_amdgcn_exp2f(pb0[r] - mu); pb1[r] = __builtin_amdgcn_exp2f(pb1[r] - mu);
            ls += (pa0[r] + pa1[r]) + (pb0[r] + pb1[r]); }
        ls = sum32(ls);
        const float rl = (ls > 0.f) ? 1.0f / ls : 0.f;
#pragma unroll
        for (int r = 0; r < 16; ++r) { pa0[r] *= rl; pa1[r] *= rl; pb0[r] *= rl; pb1[r] *= rl; }
        float own[16], ee[16];
#pragma unroll
        for (int q = 0; q < 4; ++q) {
            own[q] = (pa0[4 * q] + pa0[4 * q + 1]) + (pa0[4 * q + 2] + pa0[4 * q + 3]); ee[q] = pa0[4 * q + 3];
            own[4 + q] = (pa1[4 * q] + pa1[4 * q + 1]) + (pa1[4 * q + 2] + pa1[4 * q + 3]); ee[4 + q] = pa1[4 * q + 3];
            own[8 + q] = (pb0[4 * q] + pb0[4 * q + 1]) + (pb0[4 * q + 2] + pb0[4 * q + 3]); ee[8 + q] = pb0[4 * q + 3];
            own[12 + q] = (pb1[4 * q] + pb1[4 * q + 1]) + (pb1[4 * q + 2] + pb1[4 * q + 3]); ee[12 + q] = pb1[4 * q + 3]; }
        float eo[16];
#pragma unroll
        for (int k = 0; k < 16; ++k) eo[k] = xor32(ee[k], hf);
#pragma unroll
        for (int k = 0; k < 16; ++k) { const float add = hf ? eo[k] : ((k > 0) ? eo[k - 1] : 0.f); own[k] += add; }
#pragma unroll
        for (int k = 0; k < 16; ++k) { own[k] += xorl<1>(own[k]); own[k] += xorl<2>(own[k]); }
        float imp[32];
#pragma unroll
        for (int k = 0; k < 16; ++k) { const float oth = xor32(own[k], hf); imp[2 * k] = hf ? oth : own[k]; imp[2 * k + 1] = hf ? own[k] : oth; }
        selmask = select_blocks(imp, c);
        State sc; st_init(sc);
        { bf16x8 a0, a1, a2, a3; pack_p(pa0, pa1, a0, a1, a2, a3); pv(sc.o, (int)(uintptr_t)(lds + L_V) + vboff, a0, a1, a2, a3); }
        if (ntile == 2) { bf16x8 a0, a1, a2, a3; pack_p(pb0, pb1, a0, a1, a2, a3); pv(sc.o, (int)(uintptr_t)(lds + L_V + 8192) + vboff, a0, a1, a2, a3); }
        accum_scaled(ot, sc.o, g0, wsf, r32, hf);
    }
#pragma unroll 1
    for (int br = 1; br < 3; ++br) {
        const bf16_t* KB = (br == 1) ? KS : KW; const bf16_t* VB = (br == 1) ? VS : VW;
        const int NT = (br == 1) ? (c + 1) : ((c + 1 < 5) ? c + 1 : 5);
        const int lo = (br == 1) ? 0 : tq - 255;
        State st; st_init(st);
        __syncthreads();
        NSA_LOAD(KB, VB, rowbase + c * 64); NSA_STORE(L_K, L_V); if (NT > 1) NSA_LOAD(KB, VB, rowbase + (c - 1) * 64);
        for (int i = 0; i < NT; ++i) {
            __syncthreads();
            if (i + 1 < NT) { NSA_STORE(L_K + ((i + 1) & 1) * KBUF, L_V + ((i + 1) & 1) * VBUF); if (i + 2 < NT) NSA_LOAD(KB, VB, rowbase + (c - i - 2) * 64); }
            const int j = c - i, key0 = j * 64, bf = i & 1;
            const bool sel = (br == 2) || ((selmask >> j) & 1u);
            if (__any(sel)) {
                f32x16 p0, p1; qkt<64>(p0, p1, (lds_cptr)(lds + L_K + bf * KBUF) + hf * 1024 + r32 * 16, qr);
                if (br == 1) { if (i == 0) mask_range(p0, p1, key0, 0, tq, hf);
                    if (!sel) {
#pragma unroll
                        for (int r = 0; r < 16; ++r) { p0[r] = -INFINITY; p1[r] = -INFINITY; } } }
                else { if (i == 0 || i == 4) mask_range(p0, p1, key0, lo, tq, hf); }
                softmax_pv(st, p0, p1, (int)(uintptr_t)(lds + L_V + bf * VBUF) + vboff, wsf, r32, hf);
            }
        }
        const float lt = sum32(st.l);
        accum_scaled(ot, st.o, ((br == 1) ? g1 : g2) / lt, wsf, r32, hf);
    }
#undef NSA_LOAD
#undef NSA_STORE
    LAS bf16_t* stg = (LAS bf16_t*)(lds + L_OST) + wv * 2048;
    stage_rows(ot, stg, r32, hf);
#pragma unroll
    for (int i = 0; i < 4; ++i) { const int rr = i * 8 + (lane >> 3), ch = lane & 7; const u32x4 v = *(const LAS u32x4*)(stg + rr * 64 + ch * 8);
        *(u32x4*)(OC + (size_t)(rowbase + 64 * c + 8 * wv + (rr >> 2)) * 1024 + 512 + (g * 4 + (rr & 3)) * 64 + ch * 8) = v; }
}
#undef FA_SBAR
}

DI void stage_attn_fast(const Params& p, LAS unsigned char* lds, int bid, int nb, bool do_mla, bool do_nsa, int wid0) {
    if (do_mla) for (int u = bid; u < 256; u += nb) { const int bh = u >> 2, s = u & 3; fa::mla_unit(p, lds, bh >> 3, bh & 7, 7 - s, wid0); fa::mla_unit(p, lds, bh >> 3, bh & 7, s, wid0); }
    if (do_nsa) for (int u = bid; u < 256; u += nb) { const int bg = u >> 4, s = u & 15; fa::nsa_unit(p, lds, bg >> 1, bg & 1, 31 - s, wid0); fa::nsa_unit(p, lds, bg >> 1, bg & 1, s, wid0); }
    __syncthreads();
}
#define XB_TMO      128
#define XB_XCNT(j)  (256  + 64 * (j))
#define XB_XSUB(j)  (1280 + 64 * (j))
#define XB_XGEN(j)  (2304 + 64 * (j))
#define XB_TOP      3328
#define XB_TOPGEN   3392
#define XCD_BAR_WORDS 3456
#define XB_SPIN_CAP (1u << 18)

__device__ __forceinline__ unsigned xb_ld(unsigned* p)              { return __hip_atomic_load(p, __ATOMIC_RELAXED, __HIP_MEMORY_SCOPE_AGENT); }
__device__ __forceinline__ unsigned xb_add(unsigned* p, unsigned v) { return __hip_atomic_fetch_add(p, v, __ATOMIC_RELAXED, __HIP_MEMORY_SCOPE_AGENT); }
__device__ __forceinline__ unsigned xb_xcc_id() { return (unsigned)__builtin_amdgcn_s_getreg((3 << 11) | 20) & 0xFu; }
#define XB_SPIN(cond, bar) do { unsigned _sp = 0; while (cond) { __builtin_amdgcn_s_sleep(1); \
    if ((++_sp & 255u) == 0u) { if (xb_ld(&(bar)[XB_TMO])) break; if (_sp > XB_SPIN_CAP) { atomicAdd(&(bar)[XB_TMO], 1u); break; } } } } while (0)

struct XcdBarrier {
    unsigned* bar; unsigned x;
    volatile LAS unsigned* st;
};

__device__ __forceinline__ XcdBarrier xcd_barrier_post(unsigned* bar, volatile LAS unsigned* st, bool t0) {
    XcdBarrier b; b.bar = bar; b.x = xb_xcc_id(); b.st = st;
    if (t0) (void)xb_add(&bar[XB_XCNT(b.x)], 1u);
    return b;
}
__device__ __forceinline__ void xcd_barrier_complete(unsigned* bar, unsigned x, unsigned& nloc, unsigned& nx) {
    const unsigned G = gridDim.x * gridDim.y * gridDim.z;
    unsigned sum, cnt, mine, sp = 0u;
    for (;;) {
        sum = 0u; cnt = 0u; mine = 0u;
#pragma unroll
        for (unsigned j = 0; j < 16; ++j) { const unsigned c = xb_ld(&bar[XB_XCNT(j)]); sum += c; cnt += (c > 0u) ? 1u : 0u; mine = (j == x) ? c : mine; }
        if (sum == G) break;
        __builtin_amdgcn_s_sleep(1);
        if ((++sp & 255u) == 0u) { if (xb_ld(&bar[XB_TMO])) break; if (sp > XB_SPIN_CAP) { atomicAdd(&bar[XB_TMO], 1u); break; } }
    }
    nloc = mine > 0u ? mine : 1u; nx = cnt > 0u ? cnt : 1u;
}

__device__ __forceinline__ void xcd_barrier(const XcdBarrier& b, bool t0) {
    asm volatile("s_waitcnt vmcnt(0)" ::: "memory");
    __syncthreads();
    if (t0) {
        unsigned* bar = b.bar;
        __builtin_amdgcn_s_waitcnt(0);
        unsigned nloc = b.st[0], nx = b.st[1];
        if (nloc == 0u) { xcd_barrier_complete(bar, b.x, nloc, nx); b.st[0] = nloc; b.st[1] = nx; }
        const unsigned old = xb_add(&bar[XB_XSUB(b.x)], 1u);
        const unsigned gen = old / nloc;
        if (old + 1u == (gen + 1u) * nloc) {
            __builtin_amdgcn_fence(__ATOMIC_RELEASE, "agent");
            asm volatile("s_waitcnt vmcnt(0)" ::: "memory");
            const unsigned og = xb_add(&bar[XB_TOP], 1u);
            const unsigned tg = og / nx;
            if (og + 1u == (tg + 1u) * nx) xb_add(&bar[XB_TOPGEN], 1u);
            else XB_SPIN(xb_ld(&bar[XB_TOPGEN]) == tg, bar);
            __builtin_amdgcn_fence(__ATOMIC_ACQUIRE, "agent");
            xb_add(&bar[XB_XGEN(b.x)], 1u);
            asm volatile("s_waitcnt vmcnt(0)" ::: "memory");
        } else {
            XB_SPIN(xb_ld(&bar[XB_XGEN(b.x)]) == gen, bar);
            __builtin_amdgcn_fence(__ATOMIC_ACQUIRE, "agent");
            asm volatile("s_waitcnt vmcnt(0)" ::: "memory");
        }
    }
    __syncthreads();
}
constexpr int LDS_BYTES = 147456;
#ifndef USE_CG_SYNC
#define USE_CG_SYNC 0
#endif

typedef const Params __attribute__((address_space(4)))* KParamsPtr;
#if defined(__HIP_DEVICE_COMPILE__)
DI KParamsPtr kparams() { KParamsPtr k = (KParamsPtr)__builtin_amdgcn_kernarg_segment_ptr(); asm volatile("" : "+s"(k)); return k; }
#endif
#if defined(__HIP_DEVICE_COMPILE__)
#define PHASE_PARAMS() const Params p = *kparams()
#else
#define PHASE_PARAMS() const Params p = p_arg
#endif
__global__ void __launch_bounds__(512, 2) fwd_megakernel(Params p_arg) {
    extern __shared__ __attribute__((aligned(16))) unsigned char dlds[];
    LAS unsigned char* lds = (LAS unsigned char*)dlds;
#if USE_CG_SYNC
    cg::grid_group grid = cg::this_grid();
#endif
    const int G = gridDim.x, c = blockIdx.x, ngw = G * NWAVE, ngt = G * NTHR;
    const int wid0 = __builtin_amdgcn_readfirstlane(threadIdx.x >> 6);
#define TIDS() const int tid = opaque_tid(wid0), lane = tid & 63, wave = tid >> 6, gw = c * NWAVE + wave, gtid = c * NTHR + tid; (void)lane; (void)gw; (void)gtid
#if USE_CG_SYNC
#define GRID_SYNC() grid.sync()
#else
    volatile LAS unsigned* MISC = (volatile LAS unsigned*)(lds + 131072 + 320);
    { TIDS(); if (tid < 32) MISC[tid] = 0u; }
    __syncthreads();
    XcdBarrier bar;
    { PHASE_PARAMS(); TIDS(); bar = xcd_barrier_post((unsigned*)(p.ws + WS_CTL) + 4096, MISC + 8, tid == 0); }
#define GRID_SYNC() do { TIDS(); xcd_barrier(bar, tid == 0); } while (0)
#endif
    { PHASE_PARAMS();
    { TIDS(); stage_weights(p, gw, ngw, (float*)dlds + wave * (64 * 33), lane); }
    __syncthreads();
    stage_mod(p, c, G, (float*)dlds, wid0);
    { TIDS(); stage_rope(p, gtid, ngt); } }
    GRID_SYNC();
    { PHASE_PARAMS(); TIDS(); stage_normmod(p.in[I_X], p.in[I_N1G], wsp<float>(p, WS_MOD), 0, 1, wsp<bf16_t>(p, WS_R0), gw, ngw, lane); }
    GRID_SYNC();
    { PHASE_PARAMS(); EpiZ E{p}; gemm_fast(lds, wsp<bf16_t>(p, WS_R0), 1024, wsp<bf16_t>(p, WS_WIN), MT, ZN, 1024, E, G, c, wid0); }
    GRID_SYNC();
    { PHASE_PARAMS();
      int qb, qc, kb, kc;
      if (G == 256) { qb = c; qc = (c < 192) ? 1 : 0; kb = (c < 192) ? c : (c >= 224 ? 192 + 2 * (c - 224) : 0); kc = (c < 192) ? 1 : (c >= 224 ? 2 : 0); }
      else { const int pq = (192 + G - 1) / G, pk = (256 + G - 1) / G; qb = c * pq; qc = (192 - qb < pq) ? ((192 - qb > 0) ? 192 - qb : 0) : pq; kb = c * pk; kc = (256 - kb < pk) ? ((256 - kb > 0) ? 256 - kb : 0) : pk; }
      { EpiQ E{p}; gemm_fast_range(lds, wsp<bf16_t>(p, WS_R1), 1024, wsp<bf16_t>(p, WS_WQB), MT, 768, 768, E, qb, qc, wid0); }
      for (int cu = (c + 64) % G; cu < 32; cu += G) cmp_hidden_fast(p, lds, cu, wid0);
      { EpiKV E{p}; gemm_fast_range(lds, wsp<bf16_t>(p, WS_R1) + 768, 1024, wsp<bf16_t>(p, WS_WKVB), MT, 1024, 256, E, kb, kc, wid0); }
    }
    GRID_SYNC();
    { PHASE_PARAMS(); TIDS(); cmp_out<true>(p, gw, ngw, lane); }
    { PHASE_PARAMS(); stage_attn_fast(p, lds, c, G, true, false, wid0); }
    GRID_SYNC();
    { PHASE_PARAMS(); stage_attn_fast(p, lds, c, G, false, true, wid0); }
    GRID_SYNC();
    { PHASE_PARAMS(); EpiMerge E{p}; gemm_fast(lds, wsp<bf16_t>(p, WS_R1), 1024, wsp<bf16_t>(p, WS_WO), MT, 1024, 1024, E, G, c, wid0); }
    GRID_SYNC();
    { PHASE_PARAMS(); EpiOut E{p}; gemm_fast(lds, wsp<bf16_t>(p, WS_R0), 1024, wsp<bf16_t>(p, WS_WOUT), MT, 1024, 1024, E, G, c, wid0); }
    GRID_SYNC();
    { PHASE_PARAMS(); TIDS(); stage_normmod(wsp<float>(p, WS_R2), p.in[I_N2G], wsp<float>(p, WS_MOD), 3, 4, wsp<bf16_t>(p, WS_R1), gw, ngw, lane); }
    GRID_SYNC();
    { PHASE_PARAMS(); EpiGU E{p}; gemm_fast(lds, wsp<bf16_t>(p, WS_R1), 1024, wsp<bf16_t>(p, WS_WGU), MT, 5632, 1024, E, G, c, wid0); }
    GRID_SYNC();
    { PHASE_PARAMS(); EpiDown E{p}; gemm_fast(lds, wsp<bf16_t>(p, WS_HID), DFF, wsp<bf16_t>(p, WS_WD), MT, 1024, DFF, E, G, c, wid0); }
}

extern "C" void kernel_launch(void* const* d_in, const int* in_sizes, int n_in, void* d_out, int out_size, void* d_ws, size_t ws_size, hipStream_t stream) {
    if (n_in != 30 || out_size != MT * DM || ws_size < WS_END) { fprintf(stderr, "kernel_launch: unexpected shapes (n_in %d out %d ws %zu)\n", n_in, out_size, ws_size); return; }
    static int grid = 0;
    if (grid == 0) {
        int dev = 0, cus = 0, per_cu = 0;
        hipGetDevice(&dev); hipDeviceGetAttribute(&cus, hipDeviceAttributeMultiprocessorCount, dev);
        hipFuncSetAttribute((const void*)fwd_megakernel, hipFuncAttributeMaxDynamicSharedMemorySize, LDS_BYTES);
        hipOccupancyMaxActiveBlocksPerMultiprocessor(&per_cu, (const void*)fwd_megakernel, NTHR, LDS_BYTES);
        if (per_cu < 1) { fprintf(stderr, "kernel_launch: occupancy query says %d blocks per CU\n", per_cu); per_cu = 1; }
        grid = cus;
        (void)hipGetLastError();
    }
    Params p{};
    for (int i = 0; i < 30; ++i) p.in[i] = (const float*)d_in[i];
    p.out = (float*)d_out; p.ws = (unsigned char*)d_ws;
    if (!USE_CG_SYNC) (void)hipMemsetAsync((char*)d_ws + WS_CTL, 0, 65536, stream);
    void* args[] = {&p};
    hipError_t e = hipLaunchCooperativeKernel((const void*)fwd_megakernel, dim3(grid), dim3(NTHR), args, LDS_BYTES, stream);
    if (e != hipSuccess) fprintf(stderr, "kernel_launch: cooperative launch failed: %s (grid %d)\n", hipGetErrorString(e), grid);
}
```

```cpp
#include <hip/hip_runtime.h>
#include <hip/hip_cooperative_groups.h>
#include <cstdint>
#include <cstdio>
namespace cg = cooperative_groups;

typedef unsigned short bf16_t;
typedef unsigned u32x4 __attribute__((ext_vector_type(4)));
typedef unsigned u32x2 __attribute__((ext_vector_type(2)));
typedef float f32x4 __attribute__((ext_vector_type(4)));
typedef float f32x2 __attribute__((ext_vector_type(2)));
#define DI __device__ __forceinline__

constexpr int NB = 8, SEQ = 2048, DM = 1024, MT = NB * SEQ;
constexpr int DFF = 2816, NMOD = 6;
constexpr int ZN = 4608;
constexpr float EPS = 1e-6f;
constexpr float LOG2E = 1.4426950408889634f;
constexpr float C2N = 0.125f * LOG2E;
constexpr float C2M = 0.10206207261596575f * LOG2E;
constexpr int NTHR = 512, NWAVE = 8;
constexpr int O_CQ = 0, O_CKV = 768, O_KPE = 1024, O_QN = 1056, O_KC = 1568, O_VC = 1696, O_KS = 1824, O_VS = 1952, O_KW = 2080, O_VW = 2208,
              O_GN = 2336, O_GM = 2360, O_GNM = 3384, D_IN = 4408;

constexpr size_t MiB = 1u << 20;
constexpr size_t WS_CTL = 0;
constexpr size_t WS_MOD = 1 * MiB;
constexpr size_t WS_CB1 = 1 * MiB + 256 * 1024;
constexpr size_t WS_SSQPE = 1 * MiB + 320 * 1024;
constexpr size_t WS_SSQKN = 1 * MiB + 512 * 1024;
constexpr size_t WS_SSQA = 2 * MiB;
constexpr size_t WS_KCF = 3 * MiB;
constexpr size_t WS_VCF = 3 * MiB + 256 * 1024;
constexpr size_t WS_CW2 = 3 * MiB + 512 * 1024;
constexpr size_t WS_WIN = 4 * MiB;
constexpr size_t WS_WQB = 13 * MiB;
constexpr size_t WS_WKVB = 15 * MiB;
constexpr size_t WS_WO = 16 * MiB;
constexpr size_t WS_WOUT = 18 * MiB;
constexpr size_t WS_WGU = 20 * MiB;
constexpr size_t WS_WD = 31 * MiB;
constexpr size_t WS_CW1 = 37 * MiB;
constexpr size_t WS_R0 = 40 * MiB;
constexpr size_t WS_R1 = 72 * MiB;
constexpr size_t WS_R2 = 104 * MiB;
constexpr size_t WS_QN = 168 * MiB;
constexpr size_t WS_KC = 184 * MiB, WS_VC = 188 * MiB, WS_KS = 192 * MiB, WS_VS = 196 * MiB, WS_KW = 200 * MiB, WS_VW = 204 * MiB;
constexpr size_t WS_KPE = 208 * MiB;
constexpr size_t WS_GN = 209 * MiB;
constexpr size_t WS_KN = 210 * MiB;
constexpr size_t WS_VM = 226 * MiB;
constexpr size_t WS_CMPH = 64 * MiB;
constexpr size_t WS_ROPE = 248 * MiB;
constexpr size_t WS_HID = 168 * MiB;
constexpr size_t WS_END = 256 * MiB;

struct Params {
    const float* in[30];
    float* out;
    unsigned char* ws;
};
enum { I_X = 0, I_C, I_POS, I_ADAW, I_ADAB, I_N1G, I_WIN, I_QAG, I_WQB, I_KVAG, I_WKVB, I_MQG, I_MKG, I_NQG, I_NKCG, I_NKSG, I_NKWG,
       I_CPK, I_CW1K, I_CW2K, I_CPV, I_CW1V, I_CW2V, I_WOM, I_WON, I_WOUT, I_N2G, I_WG, I_WU, I_WDN };

template <class T> DI T* wsp(const Params& p, size_t off) { return (T*)(p.ws + off); }

DI int lane_id() { return (int)__builtin_amdgcn_mbcnt_hi(~0u, __builtin_amdgcn_mbcnt_lo(~0u, 0u)); }
DI int opaque_tid(int wid0) { int l = lane_id(); asm volatile("" : "+v"(l)); return (wid0 << 6) | l; }
DI unsigned f2bf(float f) { unsigned u = __float_as_uint(f); return (u + 0x7fffu + ((u >> 16) & 1u)) >> 16; }
DI unsigned pk2(float lo, float hi) { return f2bf(lo) | (f2bf(hi) << 16); }
DI float bf2f(unsigned short b) { return __uint_as_float(((unsigned)b) << 16); }
DI float bflo(unsigned w) { return __uint_as_float(w << 16); }
DI float bfhi(unsigned w) { return __uint_as_float(w & 0xffff0000u); }
DI void unpack8(const u32x4 w, float (&f)[8]) { f[0] = bflo(w.x); f[1] = bfhi(w.x); f[2] = bflo(w.y); f[3] = bfhi(w.y); f[4] = bflo(w.z); f[5] = bfhi(w.z); f[6] = bflo(w.w); f[7] = bfhi(w.w); }
DI u32x4 pack8(const float (&f)[8]) { u32x4 w; w.x = pk2(f[0], f[1]); w.y = pk2(f[2], f[3]); w.z = pk2(f[4], f[5]); w.w = pk2(f[6], f[7]); return w; }
DI float sigmoidf(float x) { return __builtin_amdgcn_rcpf(1.0f + __expf(-x)); }
DI float siluf(float x) { return x * __builtin_amdgcn_rcpf(1.0f + __expf(-x)); }
template <int X> DI float xorl(float v) { return __int_as_float(__builtin_amdgcn_ds_swizzle(__float_as_int(v), (X << 10) | 0x1f)); }
DI void halves(float v, float& lo, float& hi) { auto rr = __builtin_amdgcn_permlane32_swap(__float_as_uint(v), __float_as_uint(v), false, false); lo = __uint_as_float(rr[0]); hi = __uint_as_float(rr[1]); }
DI float xor32(float v, int hf) { float lo, hi; halves(v, lo, hi); return hf ? lo : hi; }
DI float sum32(float v) { float lo, hi; halves(v, lo, hi); return lo + hi; }
DI float max32(float v) { float lo, hi; halves(v, lo, hi); return fmaxf(lo, hi); }
DI float wave_sum(float v) { v += xorl<1>(v); v += xorl<2>(v); v += xorl<4>(v); v += xorl<8>(v); v += xorl<16>(v); return sum32(v); }
DI void sincos_rad(float ang, float& c, float& s) {
    double rev = (double)ang * 0.15915494309189535; rev -= __builtin_rint(rev);
    const float fr = (float)rev; s = __builtin_amdgcn_sinf(fr); c = __builtin_amdgcn_cosf(fr);
}
#define LAS __attribute__((address_space(3)))
DI void transpose_item(const float* W, int ldw, int c0, int ncols, const float* rs, bf16_t* dst, int ldd, int n0, int k0, float* scr, int lane) {
    const int cc = lane & 31, kh = lane >> 5;
    float v[32];
    if (c0 >= 0) {
        const float* src = W + (size_t)(k0 + kh) * ldw + c0 + cc;
        if (cc < ncols) {
#pragma unroll
            for (int i = 0; i < 32; ++i) v[i] = src[(size_t)(2 * i) * ldw];
        } else {
#pragma unroll
            for (int i = 0; i < 32; ++i) v[i] = 0.f;
        }
        if (rs) {
#pragma unroll
            for (int i = 0; i < 32; ++i) v[i] *= rs[k0 + 2 * i + kh];
        }
    } else {
#pragma unroll
        for (int i = 0; i < 32; ++i) v[i] = 0.f;
    }
#pragma unroll
    for (int i = 0; i < 32; ++i) scr[(2 * i + kh) * 33 + cc] = v[i];
    __builtin_amdgcn_s_waitcnt(0xc07f);
    asm volatile("" ::: "memory");
    const int c = lane & 7;
#pragma unroll
    for (int j = 0; j < 4; ++j) { const int n = (lane >> 3) + 8 * j; const float* s = scr + (8 * c) * 33 + n;
        u32x4 o; o.x = pk2(s[0 * 33], s[1 * 33]); o.y = pk2(s[2 * 33], s[3 * 33]); o.z = pk2(s[4 * 33], s[5 * 33]); o.w = pk2(s[6 * 33], s[7 * 33]);
        *(u32x4*)(dst + (size_t)(n0 + n) * ldd + k0 + 8 * c) = o; }
    __builtin_amdgcn_s_waitcnt(0xc07f);
    asm volatile("" ::: "memory");
}
DI int zsrc(int s, int L0, int& ncols) {
    ncols = 32;
    if (s < 16) return 64 * s + L0;
    if (s == 16) { if (L0 == 0) return O_KPE; ncols = 24; return O_GN; }
    if (s < 25) return O_QN + 64 * (s - 17) + L0;
    if (s < 27) return O_KC + 64 * (s - 25) + L0;
    if (s < 29) return O_VC + 64 * (s - 27) + L0;
    if (s < 31) return O_KS + 64 * (s - 29) + L0;
    if (s < 33) return O_VS + 64 * (s - 31) + L0;
    if (s < 35) return O_KW + 64 * (s - 33) + L0;
    if (s < 37) return O_VW + 64 * (s - 35) + L0;
    if (s < 40) return -1;
    if (s < 56) return O_GM + 64 * (s - 40) + L0;
    return O_GNM + 64 * (s - 56) + L0;
}
DI void stage_weights(const Params& p, int gw, int ngw, float* scr, int lane) {
    constexpr int I_IN = (ZN / 32) * (DM / 64);
    constexpr int I_QB = (768 / 32) * (768 / 64);
    constexpr int I_KVB = (1024 / 32) * (256 / 64);
    constexpr int I_O = (1024 / 32) * (1024 / 64);
    constexpr int I_OUT = I_O;
    constexpr int I_GU = (5632 / 32) * (1024 / 64);
    constexpr int I_D = (1024 / 32) * (DFF / 64);
    constexpr int I_C1 = 2 * (256 / 32) * (2048 / 64);
    constexpr int NITEMS = I_IN + I_QB + I_KVB + I_O + I_OUT + I_GU + I_D + I_C1;
    for (int it = gw; it < NITEMS; it += ngw) {
        int r = it;
        if (r < I_IN) { const int nb = r / 16, kb = r % 16; const int pn = nb >> 3, bj = (nb >> 2) & 1, wc = nb & 3; int nc; const int c0 = zsrc(4 * pn + wc, 32 * bj, nc);
            transpose_item(p.in[I_WIN], D_IN, c0, nc, nullptr, wsp<bf16_t>(p, WS_WIN), DM, nb * 32, kb * 64, scr, lane); continue; } r -= I_IN;
        if (r < I_QB) { const int nb = r / 12, kb = r % 12; transpose_item(p.in[I_WQB], 768, nb * 32, 32, p.in[I_QAG], wsp<bf16_t>(p, WS_WQB), 768, nb * 32, kb * 64, scr, lane); continue; } r -= I_QB;
        if (r < I_KVB) { const int nb = r / 4, kb = r % 4; const int pn = nb >> 3, bj = (nb >> 2) & 1, wc = nb & 3, s = 4 * pn + wc;
            const int c0 = (s < 8) ? (128 * s + 32 * bj) : (128 * (s - 8) + 64 + 32 * bj);
            transpose_item(p.in[I_WKVB], 1024, c0, 32, p.in[I_KVAG], wsp<bf16_t>(p, WS_WKVB), 256, nb * 32, kb * 64, scr, lane); continue; } r -= I_KVB;
        if (r < I_O) { const int nb = r / 16, kb = r % 16;
            if (kb < 8) transpose_item(p.in[I_WOM], 1024, nb * 32, 32, nullptr, wsp<bf16_t>(p, WS_WO), 1024, nb * 32, kb * 64, scr, lane);
            else transpose_item(p.in[I_WON] - (size_t)512 * 1024, 1024, nb * 32, 32, nullptr, wsp<bf16_t>(p, WS_WO), 1024, nb * 32, kb * 64, scr, lane);
            continue; } r -= I_O;
        if (r < I_OUT) { const int nb = r / 16, kb = r % 16; transpose_item(p.in[I_WOUT], 1024, nb * 32, 32, nullptr, wsp<bf16_t>(p, WS_WOUT), 1024, nb * 32, kb * 64, scr, lane); continue; } r -= I_OUT;
        if (r < I_GU) { const int nb = r / 16, kb = r % 16; const int pn = nb >> 3, bj = (nb >> 2) & 1, wc = nb & 3, s = 4 * pn + wc;
            transpose_item(bj ? p.in[I_WU] : p.in[I_WG], DFF, 32 * s, 32, nullptr, wsp<bf16_t>(p, WS_WGU), 1024, nb * 32, kb * 64, scr, lane); continue; } r -= I_GU;
        if (r < I_D) { const int nb = r / 44, kb = r % 44; transpose_item(p.in[I_WDN], 1024, nb * 32, 32, nullptr, wsp<bf16_t>(p, WS_WD), DFF, nb * 32, kb * 64, scr, lane); continue; } r -= I_D;
        { const int kv = r / 256, rr = r % 256, nb = rr / 32, kb = rr % 32;
          transpose_item(kv ? p.in[I_CW1V] : p.in[I_CW1K], 256, nb * 32, 32, nullptr, wsp<bf16_t>(p, WS_CW1) + (size_t)kv * 256 * 2048, 2048, nb * 32, kb * 64, scr, lane); }
    }
}
DI void stage_mod(const Params& p, int bid, int nb, float* lds, int wid0) {
    const int tid = opaque_tid(wid0), wave = tid >> 6, lane = tid & 63, nwv = blockDim.x >> 6;
    if (bid >= 104) return;
    float* sl = lds; float* red = lds + 8192;
    for (int i = tid; i < 8192; i += blockDim.x) sl[i] = siluf(p.in[I_C][i]);
    __syncthreads();
    for (int u = bid; u < 104; u += nb) {
        float acc[8];
#pragma unroll
        for (int b = 0; b < 8; ++b) acc[b] = 0.f;
        if (u < 96) {
            const float* W = p.in[I_ADAW] + u * 64 + lane; const int kn = 1024 / nwv;
            for (int k = wave * kn; k < (wave + 1) * kn; k += 8) { float w[8];
#pragma unroll
                for (int e = 0; e < 8; ++e) w[e] = W[(size_t)(k + e) * 6144];
#pragma unroll
                for (int e = 0; e < 8; ++e)
#pragma unroll
                    for (int b = 0; b < 8; ++b) acc[b] += sl[b * 1024 + k + e] * w[e]; }
        } else {
            const int kv = (u - 96) >> 2; const float* W = (kv ? p.in[I_CW1V] : p.in[I_CW1K]) + ((u - 96) & 3) * 64 + lane; const float* pos = kv ? p.in[I_CPV] : p.in[I_CPK]; const int kn = 2048 / nwv;
            for (int k = wave * kn; k < (wave + 1) * kn; k += 8) { float w[8];
#pragma unroll
                for (int e = 0; e < 8; ++e) w[e] = W[(size_t)(k + e) * 256];
#pragma unroll
                for (int e = 0; e < 8; ++e) acc[0] += pos[k + e] * w[e]; }
        }
        __syncthreads();
#pragma unroll
        for (int b = 0; b < 8; ++b) red[(wave * 8 + b) * 64 + lane] = acc[b];
        __syncthreads();
        if (wave == 0) {
#pragma unroll
            for (int b = 0; b < 8; ++b) { float s = 0.f;
                for (int w = 0; w < nwv; ++w) s += red[(w * 8 + b) * 64 + lane];
                if (u < 96) wsp<float>(p, WS_MOD)[b * 6144 + u * 64 + lane] = s + p.in[I_ADAB][u * 64 + lane];
                else if (b == 0) wsp<float>(p, WS_CB1)[(u - 96) * 64 + lane] = s; }
        }
    }
}
DI void stage_rope(const Params& p, int tid, int gtid, int ngt, float* invt) {
    if (tid < 24) invt[tid] = (tid < 16) ? (float)pow(500000.0, -(double)tid / 16.0) : (float)pow(500000.0, -(double)(tid - 16) / 8.0);
    __syncthreads();
    float* T = wsp<float>(p, WS_ROPE); const int* pos = (const int*)p.in[I_POS];
    for (int i = gtid; i < MT * 24; i += ngt) {
        const int row = i / 24, j = i % 24; const float ps = (float)pos[row]; float c, s;
        sincos_rad(ps * invt[j], c, s);
        if (j < 16) { T[(size_t)row * 16 + j] = c; T[(size_t)MT * 16 + (size_t)row * 16 + j] = s; }
        else { T[(size_t)MT * 32 + (size_t)row * 8 + (j - 16)] = c; T[(size_t)MT * 40 + (size_t)row * 8 + (j - 16)] = s; }
    }
}
DI const float* ropeCM(const Params& p) { return wsp<float>(p, WS_ROPE); }
DI const float* ropeSM(const Params& p) { return wsp<float>(p, WS_ROPE) + (size_t)MT * 16; }
DI const float* ropeCN(const Params& p) { return wsp<float>(p, WS_ROPE) + (size_t)MT * 32; }
DI const float* ropeSN(const Params& p) { return wsp<float>(p, WS_ROPE) + (size_t)MT * 40; }

DI void stage_normmod(const float* X, const float* gain, const float* mod, int sh_idx, int sc_idx, bf16_t* Hout, int gw, int ngw, int lane) {
    for (int m = gw; m < MT; m += ngw) {
        const int b = m / SEQ; const f32x4* xr = (const f32x4*)(X + (size_t)m * DM) + lane;
        f32x4 v[4]; float s = 0.f;
#pragma unroll
        for (int j = 0; j < 4; ++j) { v[j] = xr[64 * j]; s += (v[j].x * v[j].x + v[j].y * v[j].y) + (v[j].z * v[j].z + v[j].w * v[j].w); }
        const float rstd = rsqrtf(wave_sum(s) * (1.f / DM) + EPS);
        const f32x4* g4 = (const f32x4*)gain + lane; const f32x4* sc4 = (const f32x4*)(mod + b * 6144 + sc_idx * 1024) + lane; const f32x4* sh4 = (const f32x4*)(mod + b * 6144 + sh_idx * 1024) + lane;
        u32x2* o8 = (u32x2*)(Hout + (size_t)m * DM) + lane;
#pragma unroll
        for (int j = 0; j < 4; ++j) { const f32x4 g = g4[64 * j], sc = sc4[64 * j], sh = sh4[64 * j];
            const f32x4 y = v[j] * rstd * g * (1.0f + sc) + sh; u32x2 w; w.x = pk2(y.x, y.y); w.y = pk2(y.z, y.w); o8[64 * j] = w; }
    }
}
DI void store8bf(bf16_t* dst, const float (&f)[8]) { *(u32x4*)dst = pack8(f); }
DI float ssq16(const float (&v)[2][8]) { float q = 0.f;
#pragma unroll
    for (int b = 0; b < 2; ++b)
#pragma unroll
        for (int j = 0; j < 8; ++j) q += v[b][j] * v[b][j];
    q += xorl<16>(q); return sum32(q); }

struct EpiZ {
    static constexpr bool HAS_MID = false; static constexpr int NTYPES = 7;
    Params p;
    DI void mid(int, int, int, int, float (&)[2][8]) const {}
    DI int type(int pn, int wc) const { const int s = 4 * pn + wc;
        if (s < 16) return 0; if (s == 16) return 1; if (s < 25) return 2; if (s < 37) { const int t = (s - 25) >> 1; return (t == 2 || t == 4) ? 3 : 4; } if (s < 40) return 5; return 6; }
    DI void normrope(int row, int fq, float (&v)[2][8], const float* gain, float post, bf16_t* dst) const {
        const float rstd = rsqrtf(ssq16(v) * (1.f / 64.f) + EPS);
#pragma unroll
        for (int b = 0; b < 2; ++b) { const f32x4 g0 = *(const f32x4*)(gain + 32 * b + 8 * fq), g1 = *(const f32x4*)(gain + 32 * b + 8 * fq + 4);
            v[b][0] *= rstd * g0.x; v[b][1] *= rstd * g0.y; v[b][2] *= rstd * g0.z; v[b][3] *= rstd * g0.w; v[b][4] *= rstd * g1.x; v[b][5] *= rstd * g1.y; v[b][6] *= rstd * g1.z; v[b][7] *= rstd * g1.w; }
        const float* cs = ropeCN(p) + (size_t)row * 8; const float* sn = ropeSN(p) + (size_t)row * 8;
#pragma unroll
        for (int j = 0; j < 8; ++j) { const float own = v[0][j], oth = xorl<16>(own); const float c = cs[j], s = sn[j];
            if (fq == 0) v[0][j] = own * c - oth * s; else if (fq == 1) v[0][j] = own * c + oth * s; }
#pragma unroll
        for (int b = 0; b < 2; ++b) {
#pragma unroll
            for (int j = 0; j < 8; ++j) v[b][j] *= post;
            store8bf(dst + 32 * b + 8 * fq, v[b]); }
    }
    template <int T> DI void apply(int row, int pn, int wc, int fq, float (&v)[2][8]) const {
        const int s = 4 * pn + wc;
        if constexpr (T == 0) {
            bf16_t* d = wsp<bf16_t>(p, WS_R1) + (size_t)row * 1024 + 64 * s + 8 * fq;
            const float q = ssq16(v); store8bf(d, v[0]); store8bf(d + 32, v[1]);
            if (fq == 0) wsp<float>(p, WS_SSQA)[(size_t)row * 16 + s] = q;
        } else if constexpr (T == 1) {
            float q = 0.f;
#pragma unroll
            for (int j = 0; j < 8; ++j) q += v[0][j] * v[0][j];
            q += xorl<16>(q); q = sum32(q);
            if (fq == 0) wsp<float>(p, WS_SSQPE)[row] = q;
            const float* kg = p.in[I_MKG] + 64 + 8 * fq; const int i0 = 8 * (fq & 1);
            const float* cs = ropeCM(p) + (size_t)row * 16 + i0; const float* sn = ropeSM(p) + (size_t)row * 16 + i0;
            float o[8];
#pragma unroll
            for (int j = 0; j < 8; ++j) { const float own = v[0][j] * kg[j], oth = xor32(own, fq >> 1); o[j] = (fq < 2) ? own * cs[j] - oth * sn[j] : own * cs[j] + oth * sn[j]; }
            store8bf(wsp<bf16_t>(p, WS_KPE) + (size_t)row * 32 + 8 * fq, o);
#pragma unroll
            for (int j = 0; j < 8; ++j) o[j] = sigmoidf(v[1][j]);
            store8bf(wsp<bf16_t>(p, WS_GN) + (size_t)row * 32 + 8 * fq, o);
        } else if constexpr (T == 2) {
            normrope(row, fq, v, p.in[I_NQG], C2N, wsp<bf16_t>(p, WS_QN) + (size_t)row * 512 + 64 * (s - 17));
        } else if constexpr (T == 3 || T == 4) {
            const int t = (s - 25) >> 1, g = (s - 25) & 1;
            bf16_t* d = wsp<bf16_t>(p, WS_KC + (size_t)t * 4 * MiB) + (size_t)row * 128 + 64 * g;
            if constexpr (T == 3) normrope(row, fq, v, (t == 2) ? p.in[I_NKSG] : p.in[I_NKWG], 1.0f, d);
            else { store8bf(d + 8 * fq, v[0]); store8bf(d + 32 + 8 * fq, v[1]); }
        } else if constexpr (T == 5) {
        } else {
            bf16_t* d = wsp<bf16_t>(p, WS_R2) + (size_t)row * 2048 + 64 * (s - 40) + 8 * fq;
#pragma unroll
            for (int b = 0; b < 2; ++b) { float o[8];
#pragma unroll
                for (int j = 0; j < 8; ++j) o[j] = sigmoidf(v[b][j]);
                store8bf(d + 32 * b, o); }
        }
    }
};
struct EpiQ {
    static constexpr bool HAS_MID = false; static constexpr int NTYPES = 1;
    Params p;
    DI int type(int, int) const { return 0; }
    DI void mid(int, int, int, int, float (&)[2][8]) const {}
    template <int T> DI void apply(int row, int pn, int wc, int fq, float (&v)[2][8]) const {
        const float* sq = wsp<float>(p, WS_SSQA) + (size_t)row * 16; float s = 0.f;
#pragma unroll
        for (int i = 0; i < 12; ++i) s += sq[i];
        const float rstd = rsqrtf(s * (1.f / 768.f) + EPS);
        bf16_t* d = wsp<bf16_t>(p, WS_R0) + (size_t)row * 768 + 256 * pn + 32 * wc + 8 * fq;
#pragma unroll
        for (int b = 0; b < 2; ++b) { float o[8];
#pragma unroll
            for (int j = 0; j < 8; ++j) o[j] = v[b][j] * rstd;
            store8bf(d + 128 * b, o); }
    }
};
struct EpiKV {
    static constexpr bool HAS_MID = false; static constexpr int NTYPES = 1;
    Params p;
    DI int type(int, int) const { return 0; }
    DI void mid(int, int, int, int, float (&)[2][8]) const {}
    template <int T> DI void apply(int row, int pn, int wc, int fq, float (&v)[2][8]) const {
        const int s = 4 * pn + wc;
        const float* sq = wsp<float>(p, WS_SSQA) + (size_t)row * 16 + 12;
        const float rstd = rsqrtf(((sq[0] + sq[1]) + (sq[2] + sq[3])) * (1.f / 256.f) + EPS);
#pragma unroll
        for (int b = 0; b < 2; ++b)
#pragma unroll
            for (int j = 0; j < 8; ++j) v[b][j] *= rstd;
        if (s < 8) { const float q = ssq16(v); if (fq == 0) wsp<float>(p, WS_SSQKN)[(size_t)row * 8 + s] = q;
            bf16_t* d = wsp<bf16_t>(p, WS_KN) + (size_t)row * 512 + 64 * s + 8 * fq; store8bf(d, v[0]); store8bf(d + 32, v[1]); }
        else { bf16_t* d = wsp<bf16_t>(p, WS_VM) + (size_t)row * 512 + 64 * (s - 8) + 8 * fq; store8bf(d, v[0]); store8bf(d + 32, v[1]); }
    }
};
struct EpiMerge {
    static constexpr bool HAS_MID = true; static constexpr int NTYPES = 1;
    Params p;
    DI int type(int, int) const { return 0; }
    DI void mid(int row, int pn, int wc, int fq, float (&v)[2][8]) const {
        const bf16_t* g = wsp<bf16_t>(p, WS_R2) + (size_t)row * 2048 + 256 * pn + 32 * wc + 8 * fq;
#pragma unroll
        for (int b = 0; b < 2; ++b) { float s1[8], s2[8]; unpack8(*(const u32x4*)(g + 128 * b), s1); unpack8(*(const u32x4*)(g + 1024 + 128 * b), s2);
#pragma unroll
            for (int j = 0; j < 8; ++j) v[b][j] *= s1[j] * __builtin_amdgcn_rcpf(s2[j]); }
    }
    template <int T> DI void apply(int row, int pn, int wc, int fq, float (&v)[2][8]) const {
        const bf16_t* g = wsp<bf16_t>(p, WS_R2) + (size_t)row * 2048 + 1024 + 256 * pn + 32 * wc + 8 * fq;
        bf16_t* d = wsp<bf16_t>(p, WS_R0) + (size_t)row * 1024 + 256 * pn + 32 * wc + 8 * fq;
#pragma unroll
        for (int b = 0; b < 2; ++b) { float s2[8], o[8]; unpack8(*(const u32x4*)(g + 128 * b), s2);
#pragma unroll
            for (int j = 0; j < 8; ++j) o[j] = v[b][j] * s2[j];
            store8bf(d + 128 * b, o); }
    }
};
struct EpiOut {
    static constexpr bool HAS_MID = false; static constexpr int NTYPES = 1;
    Params p;
    DI int type(int, int) const { return 0; }
    DI void mid(int, int, int, int, float (&)[2][8]) const {}
    template <int T> DI void apply(int row, int pn, int wc, int fq, float (&v)[2][8]) const {
        const int b_ = row / SEQ, col = 256 * pn + 32 * wc + 8 * fq;
        const float* gt = wsp<float>(p, WS_MOD) + b_ * 6144 + 2 * 1024 + col; const float* x = p.in[I_X] + (size_t)row * DM + col; float* d = wsp<float>(p, WS_R2) + (size_t)row * DM + col;
#pragma unroll
        for (int b = 0; b < 2; ++b)
#pragma unroll
            for (int h = 0; h < 2; ++h) { const f32x4 g = *(const f32x4*)(gt + 128 * b + 4 * h), xv = *(const f32x4*)(x + 128 * b + 4 * h);
                f32x4 o; o.x = xv.x + g.x * v[b][4 * h]; o.y = xv.y + g.y * v[b][4 * h + 1]; o.z = xv.z + g.z * v[b][4 * h + 2]; o.w = xv.w + g.w * v[b][4 * h + 3]; *(f32x4*)(d + 128 * b + 4 * h) = o; }
    }
};
struct EpiGU {
    static constexpr bool HAS_MID = false; static constexpr int NTYPES = 1;
    Params p;
    DI int type(int, int) const { return 0; }
    DI void mid(int, int, int, int, float (&)[2][8]) const {}
    template <int T> DI void apply(int row, int pn, int wc, int fq, float (&v)[2][8]) const {
        const int s = 4 * pn + wc; float o[8];
#pragma unroll
        for (int j = 0; j < 8; ++j) o[j] = siluf(v[0][j]) * v[1][j];
        store8bf(wsp<bf16_t>(p, WS_HID) + (size_t)row * DFF + 32 * s + 8 * fq, o);
    }
};
struct EpiDown {
    static constexpr bool HAS_MID = false; static constexpr int NTYPES = 1;
    Params p;
    DI int type(int, int) const { return 0; }
    DI void mid(int, int, int, int, float (&)[2][8]) const {}
    template <int T> DI void apply(int row, int pn, int wc, int fq, float (&v)[2][8]) const {
        const int b_ = row / SEQ, col = 256 * pn + 32 * wc + 8 * fq;
        const float* gt = wsp<float>(p, WS_MOD) + b_ * 6144 + 5 * 1024 + col; const float* x = wsp<float>(p, WS_R2) + (size_t)row * DM + col; float* d = p.out + (size_t)row * DM + col;
#pragma unroll
        for (int b = 0; b < 2; ++b)
#pragma unroll
            for (int h = 0; h < 2; ++h) { const f32x4 g = *(const f32x4*)(gt + 128 * b + 4 * h), xv = *(const f32x4*)(x + 128 * b + 4 * h);
                f32x4 o; o.x = xv.x + g.x * v[b][4 * h]; o.y = xv.y + g.y * v[b][4 * h + 1]; o.z = xv.z + g.z * v[b][4 * h + 2]; o.w = xv.w + g.w * v[b][4 * h + 3]; *(f32x4*)(d + 128 * b + 4 * h) = o; }
    }
};

template <class Epi, int T> DI void apply_dispatch(const Epi& E, int ty, int row, int pn, int wc, int fq, float (&v)[2][8]) {
    if constexpr (T < Epi::NTYPES) { if (ty == T) E.template apply<T>(row, pn, wc, fq, v); else apply_dispatch<Epi, T + 1>(E, ty, row, pn, wc, fq, v); }
}
template <class Epi>
DI void gemm_naive(const bf16_t* A, int lda, const bf16_t* Bt, int ldb, int M, int N, int K, int kmid, const Epi& E, int gw, int ngw) {
    const int lane = threadIdx.x & 63, fr = lane & 15, fq = lane >> 4;
    const int nslots = N / 64; const long total = (long)(M / 16) * nslots;
    for (long u = gw; u < total; u += ngw) {
        const int rg = (int)(u / nslots), s = (int)(u % nslots), pn = s >> 2, wc = s & 3, row = rg * 16 + fr;
        float v[2][8];
#pragma unroll
        for (int b = 0; b < 2; ++b)
#pragma unroll
            for (int j = 0; j < 8; ++j) v[b][j] = 0.f;
        const bf16_t* a = A + (size_t)row * lda; const bf16_t* bb = Bt + (size_t)(256 * pn + 32 * wc + 8 * fq) * ldb;
        for (int k = 0; k < K; k += 8) {
            if (Epi::HAS_MID && k == kmid) E.mid(row, pn, wc, fq, v);
            float af[8]; unpack8(*(const u32x4*)(a + k), af);
#pragma unroll
            for (int b = 0; b < 2; ++b)
#pragma unroll
                for (int j = 0; j < 8; ++j) { float bf[8]; unpack8(*(const u32x4*)(bb + (size_t)(128 * b + j) * ldb + k), bf); float d = 0.f;
#pragma unroll
                    for (int e = 0; e < 8; ++e) d += af[e] * bf[e];
                    v[b][j] += d; }
        }
        apply_dispatch<Epi, 0>(E, E.type(pn, wc), row, pn, wc, fq, v);
    }
}
namespace pg8 {
#define PG8_LAS __attribute__((address_space(3)))
typedef short bf16x8 __attribute__((ext_vector_type(8)));
constexpr int BM = 256, BK = 64, HALF = 128, HTB = HALF * BK * 2  , STAGE_BYTES = 8 * HTB, NXCD = 8, WGM = 8;

__host__ __device__ __forceinline__ int lds_byte(int r, int c) { const int st = (r >> 4) * 2 + (c >> 5), rr = r & 15, cc = c & 31, ob = rr * 64 + cc * 2; return st * 1024 + (ob ^ (((ob >> 9) & 1) << 5)); }
__host__ __device__ __forceinline__ void stage_rc(int b, int& R, int& C) { const int st = b / 1024, sb = b % 1024, swz = sb ^ (((sb >> 9) & 1) << 5); R = (st >> 1) * 16 + swz / 64; C = (st & 1) * 32 + (swz % 64) / 2; }
__host__ __device__ __forceinline__ int perm32(int rho) { const int n = rho >> 4, i = rho & 15; return 8 * (i >> 2) + 4 * n + (i & 3); }

struct Unit { int pm, pn; };
struct Gemm { const bf16_t* A; const bf16_t* Bt; int M, N, K, lda, ldb, kstepA; };

struct StaticOrder {
    int nM, nN, nwg, G, c;
    __host__ __device__ void init(int M, int N, int G_, int c_) { nM = M / BM; nN = N / BM; nwg = nM * nN; G = G_; c = c_; }
    __host__ __device__ bool next(int i, Unit& u) const {
        const long L = (long)i * G + c; if (L >= nwg) return false;
        int wgid = (int)L; { const int q = nwg / NXCD, r = nwg % NXCD, xcd = wgid % NXCD, off = wgid / NXCD; wgid = (xcd < r ? xcd * (q + 1) : r * (q + 1) + (xcd - r) * q) + off; }
        const int nig = WGM * nN, gid = wgid / nig, fm = gid * WGM, gsz = (nM - fm) < WGM ? (nM - fm) : WGM;
        u.pm = fm + ((wgid % nig) % gsz); u.pn = (wgid % nig) / gsz; return true;
    }
    __device__ __forceinline__ void a_ready(const Unit&) const {}
    __device__ __forceinline__ void done(const Unit&) const {}
};

template <class Epi, class Sched, bool ALIGN_EPI = false, bool SP2 = false>
__device__ __forceinline__ void gemm_phase(PG8_LAS unsigned char* lds, const Gemm g, const Sched& S, const Epi& E, int wid0) {
    const int tid = opaque_tid(wid0), wid = __builtin_amdgcn_readfirstlane(tid >> 6), lane = tid & 63, wr = wid >> 2, wc = wid & 3, fr = lane & 15, fq = lane >> 4;
    const int K = g.K; int nt = K / BK; asm volatile("" : "+s"(nt));
    unsigned voffA[2], voffB[2];
#pragma unroll
    for (int i = 0; i < 2; ++i) { int R, C; stage_rc(tid * 16 + i * 8192, R, C); const int Rb = Epi::PERM ? ((R & ~31) + perm32(R & 31)) : R;
        voffA[i] = (unsigned)(R * g.lda + C) * 2u; voffB[i] = (unsigned)(Rb * g.ldb + C) * 2u; }
    const size_t kstep = (size_t)(BK * 2), kstepA = (size_t)g.kstepA;
    const size_t hstepB = (size_t)HALF * g.ldb * 2, hstepA = (size_t)HALF * g.lda * 2;
    const size_t tstepB = 2 * hstepB, tstepA = 2 * hstepA;
    const unsigned ldsw = (unsigned)wid * 1024u;
    const int aoff = lds_byte(wr * 64 + fr, fq * 8), boff = lds_byte(wc * 32 + fr, fq * 8);
#define PG8_SA(b, h) (((b) * 2 + (h)) * HTB)
#define PG8_SB(b, h) ((4 + (b) * 2 + (h)) * HTB)
#define PG8_STAGE(bufoff, gbase, voff) do { _Pragma("unroll") for (int _i = 0; _i < 2; ++_i) \
        __builtin_amdgcn_global_load_lds((const unsigned*)((const char*)(gbase) + (voff)[_i]), (PG8_LAS unsigned*)(lds + (bufoff) + ldsw + _i * 8192), 16, 0, 0); } while (0)
#define PG8_LDA(dst, b, h) do { _Pragma("unroll") for (int m = 0; m < 4; ++m) _Pragma("unroll") for (int k = 0; k < 2; ++k) dst[m][k] = *(const PG8_LAS bf16x8*)(lds + PG8_SA(b, h) + aoff + m * 2048 + k * 1024); } while (0)
#define PG8_LDB(dst, b, h) do { _Pragma("unroll") for (int n = 0; n < 2; ++n) _Pragma("unroll") for (int k = 0; k < 2; ++k) dst[n][k] = *(const PG8_LAS bf16x8*)(lds + PG8_SB(b, h) + boff + n * 2048 + k * 1024); } while (0)
#define PG8_MMA(ai, bj, At, Bt) do { __builtin_amdgcn_s_setprio(1); _Pragma("unroll") for (int m = 0; m < 4; ++m) _Pragma("unroll") for (int n = 0; n < 2; ++n) _Pragma("unroll") for (int k = 0; k < 2; ++k) \
        acc[ai][bj][m][n] = __builtin_amdgcn_mfma_f32_16x16x32_bf16(Bt[n][k], At[m][k], acc[ai][bj][m][n], 0, 0, 0); __builtin_amdgcn_s_setprio(0); } while (0)
#define PG8_WAIT_V(n) asm volatile("s_waitcnt vmcnt(" #n ")" ::: "memory")
#define PG8_WAIT_L(n) asm volatile("s_waitcnt lgkmcnt(" #n ")" ::: "memory")
#define PG8_BAR __builtin_amdgcn_s_barrier()
#define PG8_SCHED __builtin_amdgcn_sched_barrier(0)
    Unit cur, nxt; int ui = 0;
    if (!S.next(0, cur)) return;
    f32x4 acc[2][2][4][2];
#pragma unroll
    for (int a = 0; a < 2; ++a)
#pragma unroll
        for (int b = 0; b < 2; ++b)
#pragma unroll
            for (int m = 0; m < 4; ++m)
#pragma unroll
                for (int n = 0; n < 2; ++n) acc[a][b][m][n] = (f32x4){0.f, 0.f, 0.f, 0.f};
    bf16x8 At[4][2], B0[2][2], B1[2][2];
    const char* cA = (const char*)g.A + (size_t)cur.pm * tstepA; const char* cB = (const char*)g.Bt + (size_t)cur.pn * tstepB;
    S.a_ready(cur);
    if constexpr (SP2) {
        PG8_STAGE(PG8_SB(0, 0), cB, voffB); PG8_STAGE(PG8_SB(0, 1), cB + hstepB, voffB); PG8_STAGE(PG8_SA(0, 0), cA, voffA); PG8_STAGE(PG8_SA(0, 1), cA + hstepA, voffA);
        if (wr == 1) PG8_BAR;
        PG8_WAIT_V(2); PG8_BAR;
        PG8_STAGE(PG8_SB(1, 0), cB + kstep, voffB); PG8_STAGE(PG8_SA(1, 0), cA + kstepA, voffA); PG8_STAGE(PG8_SB(1, 1), cB + hstepB + kstep, voffB);
        PG8_WAIT_V(6); PG8_BAR;
    } else {
        PG8_STAGE(PG8_SB(0, 0), cB, voffB); PG8_STAGE(PG8_SA(0, 0), cA, voffA); PG8_STAGE(PG8_SB(0, 1), cB + hstepB, voffB); PG8_STAGE(PG8_SA(0, 1), cA + hstepA, voffA);
        if (wr == 1) PG8_BAR;
        PG8_WAIT_V(4); PG8_BAR;
        PG8_STAGE(PG8_SB(1, 0), cB + kstep, voffB); PG8_STAGE(PG8_SA(1, 0), cA + kstepA, voffA); PG8_STAGE(PG8_SB(1, 1), cB + hstepB + kstep, voffB);
        PG8_WAIT_V(6); PG8_BAR;
    }
    for (;;) {
        const bool has_next = S.next(ui + 1, nxt);
        const char* nA = has_next ? (const char*)g.A + (size_t)nxt.pm * tstepA : cA; const char* nB = has_next ? (const char*)g.Bt + (size_t)nxt.pn * tstepB : cB;
        for (int hh_ = 0; hh_ < (Epi::HAS_MID ? 2 : 1); ++hh_) {
        if constexpr (Epi::HAS_MID) { if (hh_ == 1) E.mid(acc, cur, wr, wc, fr, fq); }
        const int t0_ = Epi::HAS_MID ? hh_ * (nt >> 1) : 0, t1_ = Epi::HAS_MID ? (hh_ + 1) * (nt >> 1) : nt;
        for (int t = t0_; t < t1_; t += 2) {
            const bool last = (t == nt - 2);
            const char* a1 = cA + (size_t)(t + 1) * kstepA;
            const char* a2 = last ? nA : cA + (size_t)(t + 2) * kstepA; const char* b2 = last ? nB : cB + (size_t)(t + 2) * kstep;
            const char* a3 = a2 + kstepA; const char* b3 = b2 + kstep;
            if (last && has_next) S.a_ready(nxt);
            if constexpr (SP2) {
            PG8_LDB(B0, 0, 0); PG8_LDB(B1, 0, 1); PG8_SCHED; PG8_LDA(At, 0, 0); PG8_STAGE(PG8_SA(1, 1), a1 + hstepA, voffA);
            PG8_WAIT_V(8); PG8_WAIT_L(0); PG8_BAR; PG8_MMA(0, 0, At, B0); PG8_MMA(0, 1, At, B1); PG8_BAR; PG8_SCHED;
            PG8_LDA(At, 0, 1); PG8_STAGE(PG8_SB(0, 0), b2, voffB); PG8_STAGE(PG8_SB(0, 1), b2 + hstepB, voffB); PG8_STAGE(PG8_SA(0, 0), a2, voffA);
            PG8_WAIT_V(8); PG8_WAIT_L(0); PG8_BAR; PG8_MMA(1, 0, At, B0); PG8_MMA(1, 1, At, B1); PG8_BAR; PG8_SCHED;
            PG8_LDB(B0, 1, 0); PG8_LDB(B1, 1, 1); PG8_SCHED; PG8_LDA(At, 1, 0); PG8_STAGE(PG8_SA(0, 1), a2 + hstepA, voffA);
            PG8_WAIT_V(8); PG8_WAIT_L(0); PG8_BAR; PG8_MMA(0, 0, At, B0); PG8_MMA(0, 1, At, B1); PG8_BAR; PG8_SCHED;
            PG8_LDA(At, 1, 1); PG8_STAGE(PG8_SB(1, 0), b3, voffB); PG8_STAGE(PG8_SB(1, 1), b3 + hstepB, voffB); PG8_STAGE(PG8_SA(1, 0), a3, voffA);
            PG8_WAIT_V(8); PG8_WAIT_L(0); PG8_BAR; PG8_MMA(1, 0, At, B0); PG8_MMA(1, 1, At, B1); PG8_BAR; PG8_SCHED;
            } else {
            PG8_LDB(B0, 0, 0); PG8_SCHED; PG8_LDA(At, 0, 0); PG8_STAGE(PG8_SA(1, 1), a1 + hstepA, voffA);
            PG8_WAIT_L(8); PG8_BAR; PG8_WAIT_L(0); PG8_MMA(0, 0, At, B0); PG8_BAR; PG8_SCHED;
            PG8_LDB(B1, 0, 1); PG8_STAGE(PG8_SB(0, 0), b2, voffB);
            PG8_BAR; PG8_WAIT_L(0); PG8_MMA(0, 1, At, B1); PG8_BAR;
            PG8_LDA(At, 0, 1); PG8_STAGE(PG8_SA(0, 0), a2, voffA);
            PG8_BAR; PG8_WAIT_L(0); PG8_MMA(1, 0, At, B0); PG8_BAR; PG8_SCHED;
            PG8_STAGE(PG8_SB(0, 1), b2 + hstepB, voffB);
            PG8_WAIT_V(6); PG8_BAR; PG8_MMA(1, 1, At, B1); PG8_BAR;
            PG8_LDB(B0, 1, 0); PG8_SCHED; PG8_LDA(At, 1, 0); PG8_STAGE(PG8_SA(0, 1), a2 + hstepA, voffA);
            PG8_WAIT_L(8); PG8_BAR; PG8_WAIT_L(0); PG8_MMA(0, 0, At, B0); PG8_BAR; PG8_SCHED;
            PG8_LDB(B1, 1, 1); PG8_STAGE(PG8_SB(1, 0), b3, voffB);
            PG8_BAR; PG8_WAIT_L(0); PG8_MMA(0, 1, At, B1); PG8_BAR;
            PG8_LDA(At, 1, 1); PG8_STAGE(PG8_SA(1, 0), a3, voffA);
            PG8_BAR; PG8_WAIT_L(0); PG8_MMA(1, 0, At, B0); PG8_BAR; PG8_SCHED;
            PG8_STAGE(PG8_SB(1, 1), b3 + hstepB, voffB);
            PG8_WAIT_V(6); PG8_BAR; PG8_MMA(1, 1, At, B1); PG8_BAR;
            }
        }
        }
        if constexpr (ALIGN_EPI) { if (wr == 0) PG8_BAR; }
        if constexpr (!Epi::AFTER_DRAIN) { E(acc, cur, wr, wc, fr, fq); S.done(cur); }
        if (!has_next) break;
#pragma unroll
        for (int a = 0; a < 2; ++a)
#pragma unroll
            for (int b = 0; b < 2; ++b)
#pragma unroll
                for (int m = 0; m < 4; ++m)
#pragma unroll
                    for (int n = 0; n < 2; ++n) acc[a][b][m][n] = (f32x4){0.f, 0.f, 0.f, 0.f};
        cur = nxt; cA = nA; cB = nB; ++ui;
        if constexpr (ALIGN_EPI) { if (wr == 1) PG8_BAR; }
    }
    PG8_WAIT_V(0);
    if constexpr (!ALIGN_EPI) { if (wr == 0) PG8_BAR; }
    PG8_BAR;
    if constexpr (Epi::AFTER_DRAIN) { E.fused(acc, cur, wr, wc, fr, fq, lds, wid, lane); S.done(cur); }
#undef PG8_SA
#undef PG8_SB
#undef PG8_STAGE
#undef PG8_LDA
#undef PG8_LDB
#undef PG8_MMA
#undef PG8_WAIT_V
#undef PG8_WAIT_L
#undef PG8_BAR
#undef PG8_SCHED
}
}

template <class SE> struct EpiAdapt {
    static constexpr bool PERM = true, AFTER_DRAIN = false, HAS_MID = SE::HAS_MID;
    SE se;
    template <int T> DI void run(f32x4 (&acc)[2][2][4][2], const pg8::Unit& u, int wr, int wc, int fr, int fq) const {
#pragma unroll
        for (int ai = 0; ai < 2; ++ai)
#pragma unroll
            for (int m = 0; m < 4; ++m) {
                int row = fr; asm volatile("" : "+v"(row)); row += u.pm * 256 + ai * 128 + wr * 64 + m * 16; float v[2][8];
#pragma unroll
                for (int bj = 0; bj < 2; ++bj)
#pragma unroll
                    for (int n = 0; n < 2; ++n) { v[bj][4 * n] = acc[ai][bj][m][n][0]; v[bj][4 * n + 1] = acc[ai][bj][m][n][1]; v[bj][4 * n + 2] = acc[ai][bj][m][n][2]; v[bj][4 * n + 3] = acc[ai][bj][m][n][3]; }
                se.template apply<T>(row, u.pn, wc, fq, v);
                asm volatile("" ::: "memory");
            }
    }
    template <int T> DI void disp(int ty, f32x4 (&acc)[2][2][4][2], const pg8::Unit& u, int wr, int wc, int fr, int fq) const {
        if constexpr (T < SE::NTYPES) { if (ty == T) run<T>(acc, u, wr, wc, fr, fq); else disp<T + 1>(ty, acc, u, wr, wc, fr, fq); }
    }
    DI void operator()(f32x4 (&acc)[2][2][4][2], const pg8::Unit& u, int wr, int wc, int fr, int fq) const { disp<0>(se.type(u.pn, wc), acc, u, wr, wc, fr, fq); }
    DI void mid(f32x4 (&acc)[2][2][4][2], const pg8::Unit& u, int wr, int wc, int fr, int fq) const {
#pragma unroll
        for (int ai = 0; ai < 2; ++ai)
#pragma unroll
            for (int m = 0; m < 4; ++m) {
                int row = fr; asm volatile("" : "+v"(row)); row += u.pm * 256 + ai * 128 + wr * 64 + m * 16; float v[2][8];
#pragma unroll
                for (int bj = 0; bj < 2; ++bj)
#pragma unroll
                    for (int n = 0; n < 2; ++n) { v[bj][4 * n] = acc[ai][bj][m][n][0]; v[bj][4 * n + 1] = acc[ai][bj][m][n][1]; v[bj][4 * n + 2] = acc[ai][bj][m][n][2]; v[bj][4 * n + 3] = acc[ai][bj][m][n][3]; }
                se.mid(row, u.pn, wc, fq, v);
                asm volatile("" ::: "memory");
#pragma unroll
                for (int bj = 0; bj < 2; ++bj)
#pragma unroll
                    for (int n = 0; n < 2; ++n) { acc[ai][bj][m][n][0] = v[bj][4 * n]; acc[ai][bj][m][n][1] = v[bj][4 * n + 1]; acc[ai][bj][m][n][2] = v[bj][4 * n + 2]; acc[ai][bj][m][n][3] = v[bj][4 * n + 3]; }
            }
    }
};
template <class SE> DI void gemm_fast(PG8_LAS unsigned char* lds, const bf16_t* A, int lda, const bf16_t* Bt, int M, int N, int K, const SE& se, int G, int c, int wid0) {
    pg8::Gemm g{A, Bt, M, N, K, lda, K, 128}; pg8::StaticOrder S; S.init(M, N, G, c);
    EpiAdapt<SE> E{se};
    pg8::gemm_phase<EpiAdapt<SE>, pg8::StaticOrder, true, true>(lds, g, S, E, wid0);
}
struct RangeOrder {
    int base, cnt, nN;
    DI bool next(int i, pg8::Unit& u) const { if (i >= cnt) return false; const int L = base + i; u.pm = L / nN; u.pn = L % nN; return true; }
    DI void a_ready(const pg8::Unit&) const {}
    DI void done(const pg8::Unit&) const {}
};
template <class SE> DI void gemm_fast_range(PG8_LAS unsigned char* lds, const bf16_t* A, int lda, const bf16_t* Bt, int M, int N, int K, const SE& se, int base, int cnt, int wid0) {
    pg8::Gemm g{A, Bt, M, N, K, lda, K, 128}; RangeOrder S{base, cnt, N / 256};
    EpiAdapt<SE> E{se};
    pg8::gemm_phase<EpiAdapt<SE>, RangeOrder, true, true>(lds, g, S, E, wid0);
}
struct OneUnit {
    int pm, pn;
    DI bool next(int i, pg8::Unit& u) const { if (i > 0) return false; u.pm = pm; u.pn = pn; return true; }
    DI void a_ready(const pg8::Unit&) const {}
    DI void done(const pg8::Unit&) const {}
};
struct EpiCmpH {
    static constexpr bool HAS_MID = false; static constexpr int NTYPES = 1;
    float* H;
    DI int type(int, int) const { return 0; }
    DI void mid(int, int, int, int, float (&)[2][8]) const {}
    template <int T> DI void apply(int row, int pn, int wc, int fq, float (&v)[2][8]) const {
        float* d = H + (size_t)row * 256 + 32 * wc + 8 * fq;
#pragma unroll
        for (int b = 0; b < 2; ++b) { *(f32x4*)(d + 128 * b) = (f32x4){v[b][0], v[b][1], v[b][2], v[b][3]}; *(f32x4*)(d + 128 * b + 4) = (f32x4){v[b][4], v[b][5], v[b][6], v[b][7]}; }
    }
};
DI void cmp_hidden_fast(const Params& p, PG8_LAS unsigned char* lds, int cu, int wid0) {
    const int kv = cu >> 4, g = (cu >> 3) & 1, pm = (cu >> 1) & 3, sp = cu & 1;
    const bf16_t* A = wsp<bf16_t>(p, kv ? WS_VC : WS_KC) + g * 64 + (size_t)(16 * sp) * 128;
    const bf16_t* Bt = wsp<bf16_t>(p, WS_CW1) + (size_t)kv * 256 * 2048 + 1024 * sp;
    pg8::Gemm gm{A, Bt, 1024, 256, 1024, 2048, 2048, 256}; OneUnit S{pm, 0};
    EpiCmpH se{wsp<float>(p, WS_CMPH) + (size_t)((kv * 2 + g) * 2 + sp) * 1024 * 256};
    EpiAdapt<EpiCmpH> E{se};
    pg8::gemm_phase<EpiAdapt<EpiCmpH>, OneUnit, true, true>(lds, gm, S, E, wid0);
}
template <bool SPLIT> DI void cmp_out(const Params& p, int gw, int ngw, int lane) {
    const float* H = wsp<float>(p, WS_CMPH);
    for (int u = gw; u < 2 * 2 * 1024; u += ngw) {
        const int r = u & 1023, g = (u >> 10) & 1, kv = u >> 11; const int b = r >> 7, n = r & 127;
        bf16_t* dst = wsp<bf16_t>(p, kv ? WS_VCF : WS_KCF) + (size_t)r * 128 + g * 64 + lane;
        if (n == 127) { *dst = 0; continue; }
        const float* w2 = (kv ? p.in[I_CW2V] : p.in[I_CW2K]) + lane;
        float acc = 0.f;
        if constexpr (SPLIT) {
            const float* h = H + ((size_t)((kv * 2 + g) * 2) * 1024 + r) * 256; const float* cb = wsp<float>(p, WS_CB1) + kv * 256;
            float hv[4];
#pragma unroll
            for (int q = 0; q < 4; ++q) { const int j = 64 * q + lane; hv[q] = siluf((h[j] + h[(size_t)1024 * 256 + j]) + cb[j]); }
#pragma unroll
            for (int q = 0; q < 4; ++q)
#pragma unroll
                for (int jj = 0; jj < 64; ++jj) acc += __int_as_float(__builtin_amdgcn_readlane(__float_as_int(hv[q]), jj)) * w2[(64 * q + jj) * 64];
        } else {
            const float* h = H + (size_t)u * 256;
            for (int j = 0; j < 256; ++j) acc += h[j] * w2[j * 64];
        }
        if (kv == 0) {
            const float rstd = rsqrtf(wave_sum(acc * acc) * (1.f / 64.f) + EPS);
            float y = acc * rstd * p.in[I_NKCG][lane];
            const int prow = b * SEQ + 16 * n + 31; const float oth = xorl<8>(y);
            if (lane < 16) { const float c = ropeCN(p)[(size_t)prow * 8 + (lane & 7)], s = ropeSN(p)[(size_t)prow * 8 + (lane & 7)]; y = (lane < 8) ? y * c - oth * s : y * c + oth * s; }
            acc = y;
        }
        *dst = (bf16_t)f2bf(acc);
    }
}

DI unsigned select_blocks(const float (&imp)[32], int cur) {
    if (cur < 8) return (2u << cur) - 1u;
    unsigned mask = 1u | (1u << cur) | (1u << (cur - 1));
#pragma unroll 1
    for (int it = 0; it < 5; ++it) {
        float best = -1.0f; int bi = 1;
#pragma unroll
        for (int j = 1; j < 32; ++j) { const bool ok = (j <= cur - 2) && !((mask >> j) & 1u); if (ok && imp[j] > best) { best = imp[j]; bi = j; } }
        mask |= 1u << bi;
    }
    return mask;
}

namespace fa {
typedef short bf16x8 __attribute__((ext_vector_type(8)));
typedef short s16x4 __attribute__((ext_vector_type(4)));
typedef float f32x16 __attribute__((ext_vector_type(16)));
typedef LAS const char* lds_cptr;
typedef LAS char* lds_ptr;
constexpr int KBUF = 12288, VBUF = 8192;
constexpr int L_K = 0, L_V = 2 * KBUF, L_RK = L_V + 2 * VBUF, L_WS = L_RK + 512, L_OST = L_WS + 8 * 256, L_END = L_OST + 8 * 4096;
#define FA_SBAR() __builtin_amdgcn_sched_barrier(0)
DI int crow(int r, int hi) { return (r & 3) + 8 * (r >> 2) + 4 * hi; }
typedef float f32x2_t __attribute__((ext_vector_type(2))); typedef __bf16 bf16x2_t __attribute__((ext_vector_type(2)));
DI unsigned cvtpk(float lo, float hi) { f32x2_t v = {lo, hi}; bf16x2_t b = __builtin_convertvector(v, bf16x2_t); return __builtin_bit_cast(unsigned, b); }

template <int DK> DI void qkt(f32x16& p0, f32x16& p1, lds_cptr kb, const bf16x8* qr) {
    f32x16 z;
#pragma unroll
    for (int i = 0; i < 16; ++i) z[i] = 0.f;
#pragma unroll
    for (int d0 = 0; d0 < DK / 16; ++d0) {
        const bf16x8 b0 = *(const LAS bf16x8*)(kb + d0 * 2048);
        const bf16x8 b1 = *(const LAS bf16x8*)(kb + d0 * 2048 + 512);
        if (d0 == 0) { p0 = __builtin_amdgcn_mfma_f32_32x32x16_bf16(b0, qr[0], z, 0, 0, 0); p1 = __builtin_amdgcn_mfma_f32_32x32x16_bf16(b1, qr[0], z, 0, 0, 0); }
        else { p0 = __builtin_amdgcn_mfma_f32_32x32x16_bf16(b0, qr[d0], p0, 0, 0, 0); p1 = __builtin_amdgcn_mfma_f32_32x32x16_bf16(b1, qr[d0], p1, 0, 0, 0); }
    }
}
DI void pv(f32x16* o, int vb, bf16x8 pa0, bf16x8 pa1, bf16x8 pa2, bf16x8 pa3) {
#pragma unroll
    for (int d0 = 0; d0 < 2; ++d0) { s16x4 lo[4], hi[4];
#pragma unroll
        for (int ks = 0; ks < 4; ++ks) {
            asm volatile("ds_read_b64_tr_b16 %0,%1 offset:%c2" : "=&v"(lo[ks]) : "v"(vb), "i"(d0 * 4096 + ks * 1024) : "memory");
            asm volatile("ds_read_b64_tr_b16 %0,%1 offset:%c2" : "=&v"(hi[ks]) : "v"(vb), "i"(d0 * 4096 + ks * 1024 + 512) : "memory"); }
        asm volatile("s_waitcnt lgkmcnt(0)" ::: "memory"); FA_SBAR();
#define FA_PK(k) (bf16x8){lo[k][0], lo[k][1], lo[k][2], lo[k][3], hi[k][0], hi[k][1], hi[k][2], hi[k][3]}
        o[d0] = __builtin_amdgcn_mfma_f32_32x32x16_bf16(pa0, FA_PK(0), o[d0], 0, 0, 0);
        o[d0] = __builtin_amdgcn_mfma_f32_32x32x16_bf16(pa1, FA_PK(1), o[d0], 0, 0, 0);
        o[d0] = __builtin_amdgcn_mfma_f32_32x32x16_bf16(pa2, FA_PK(2), o[d0], 0, 0, 0);
        o[d0] = __builtin_amdgcn_mfma_f32_32x32x16_bf16(pa3, FA_PK(3), o[d0], 0, 0, 0);
#undef FA_PK
    }
}
DI void pack_p(const f32x16& p0, const f32x16& p1, bf16x8& a0, bf16x8& a1, bf16x8& a2, bf16x8& a3) {
    u32x4 w0, w1, w2, w3;
    w0.x = cvtpk(p0[0], p0[1]); w0.y = cvtpk(p0[2], p0[3]); w0.z = cvtpk(p0[4], p0[5]); w0.w = cvtpk(p0[6], p0[7]);
    w1.x = cvtpk(p0[8], p0[9]); w1.y = cvtpk(p0[10], p0[11]); w1.z = cvtpk(p0[12], p0[13]); w1.w = cvtpk(p0[14], p0[15]);
    w2.x = cvtpk(p1[0], p1[1]); w2.y = cvtpk(p1[2], p1[3]); w2.z = cvtpk(p1[4], p1[5]); w2.w = cvtpk(p1[6], p1[7]);
    w3.x = cvtpk(p1[8], p1[9]); w3.y = cvtpk(p1[10], p1[11]); w3.z = cvtpk(p1[12], p1[13]); w3.w = cvtpk(p1[14], p1[15]);
    a0 = __builtin_bit_cast(bf16x8, w0); a1 = __builtin_bit_cast(bf16x8, w1); a2 = __builtin_bit_cast(bf16x8, w2); a3 = __builtin_bit_cast(bf16x8, w3);
}
DI void mask_range(f32x16& p0, f32x16& p1, int key0, int lo, int hi_, int hf) {
#pragma unroll
    for (int r = 0; r < 16; ++r) { const int k = key0 + crow(r, hf); if (k < lo || k > hi_) p0[r] = -INFINITY; if (k + 32 < lo || k + 32 > hi_) p1[r] = -INFINITY; }
}
DI float rowmax32(const f32x16& p0, const f32x16& p1) {
    float a = fmaxf(p0[0], p1[0]);
#pragma unroll
    for (int r = 1; r < 16; ++r) a = fmaxf(a, fmaxf(p0[r], p1[r]));
    return max32(a);
}
struct State { float m, l; f32x16 o[2]; };
DI void st_init(State& s) { s.m = -INFINITY; s.l = 0.f;
#pragma unroll
    for (int i = 0; i < 16; ++i) { s.o[0][i] = 0.f; s.o[1][i] = 0.f; } }
DI void softmax_pv(State& st, f32x16& p0, f32x16& p1, int vb, LAS float* wsf, int r32, int hf) {
    const float rm = rowmax32(p0, p1);
    const float mn = fmaxf(st.m, rm), mu = (mn == -INFINITY) ? 0.f : mn;
    const float alpha = __builtin_amdgcn_exp2f(st.m - mu);
    st.m = mn;
    float ls = 0.f;
#pragma unroll
    for (int r = 0; r < 16; ++r) { p0[r] = __builtin_amdgcn_exp2f(p0[r] - mu); p1[r] = __builtin_amdgcn_exp2f(p1[r] - mu); ls += p0[r] + p1[r]; }
    st.l = st.l * alpha + ls;
    if (__any(alpha != 1.0f)) {
        if (hf == 0) wsf[r32] = alpha;
        asm volatile("s_waitcnt lgkmcnt(0)" ::: "memory");
#pragma unroll
        for (int g = 0; g < 4; ++g) { const f32x4 a = *(const LAS f32x4*)(wsf + 8 * g + 4 * hf);
            st.o[0][4 * g] *= a.x; st.o[0][4 * g + 1] *= a.y; st.o[0][4 * g + 2] *= a.z; st.o[0][4 * g + 3] *= a.w;
            st.o[1][4 * g] *= a.x; st.o[1][4 * g + 1] *= a.y; st.o[1][4 * g + 2] *= a.z; st.o[1][4 * g + 3] *= a.w; }
    }
    bf16x8 a0, a1, a2, a3; pack_p(p0, p1, a0, a1, a2, a3);
    pv(st.o, vb, a0, a1, a2, a3);
}
DI void accum_scaled(f32x16* acc, const f32x16* o, float fac_row, LAS float* wsf, int r32, int hf) {
    if (hf == 0) wsf[32 + r32] = fac_row;
    asm volatile("s_waitcnt lgkmcnt(0)" ::: "memory");
#pragma unroll
    for (int g = 0; g < 4; ++g) { const f32x4 a = *(const LAS f32x4*)(wsf + 32 + 8 * g + 4 * hf);
        acc[0][4 * g] += o[0][4 * g] * a.x; acc[0][4 * g + 1] += o[0][4 * g + 1] * a.y; acc[0][4 * g + 2] += o[0][4 * g + 2] * a.z; acc[0][4 * g + 3] += o[0][4 * g + 3] * a.w;
        acc[1][4 * g] += o[1][4 * g] * a.x; acc[1][4 * g + 1] += o[1][4 * g + 1] * a.y; acc[1][4 * g + 2] += o[1][4 * g + 2] * a.z; acc[1][4 * g + 3] += o[1][4 * g + 3] * a.w; }
}
DI void stage_rows(const f32x16* acc, LAS bf16_t* stg, int r32, int hf) {
#pragma unroll
    for (int r = 0; r < 16; ++r) { const int orow = crow(r, hf);
        stg[orow * 64 + r32] = (bf16_t)f2bf(acc[0][r]); stg[orow * 64 + 32 + r32] = (bf16_t)f2bf(acc[1][r]); }
    asm volatile("s_waitcnt lgkmcnt(0)" ::: "memory");
}

DI void mla_unit(const Params& p, LAS unsigned char* lds, int b, int h, int qb, int wid0) {
    const int tid = opaque_tid(wid0), lane = tid & 63, r32 = lane & 31, hf = lane >> 5; const int wv = __builtin_amdgcn_readfirstlane(tid >> 6);
    const bf16_t* KN = wsp<bf16_t>(p, WS_KN); const bf16_t* KPE = wsp<bf16_t>(p, WS_KPE); const bf16_t* VM = wsp<bf16_t>(p, WS_VM);
    const float* sqk = wsp<float>(p, WS_SSQKN); const float* sqp = wsp<float>(p, WS_SSQPE); bf16_t* OC = wsp<bf16_t>(p, WS_R1);
    const int rowbase = b * SEQ, q0 = qb * 256, tq = q0 + wv * 32 + r32, row = rowbase + tq;
    LAS float* wsf = (LAS float*)(lds + L_WS) + wv * 64;
    bf16x8 qr[6];
    {
        const bf16_t* src = wsp<bf16_t>(p, WS_R0) + (size_t)row * 768 + h * 96 + 8 * hf; float q[6][8]; float ss = 0.f;
#pragma unroll
        for (int d0 = 0; d0 < 6; ++d0) { unpack8(*(const u32x4*)(src + 16 * d0), q[d0]);
#pragma unroll
            for (int e = 0; e < 8; ++e) ss += q[d0][e] * q[d0][e]; }
        ss = sum32(ss);
        const float rstd = rsqrtf(ss * (1.f / 96.f) + EPS); const float* qg = p.in[I_MQG] + 8 * hf; const float* kg = p.in[I_MKG] + 8 * hf;
#pragma unroll
        for (int d0 = 0; d0 < 6; ++d0)
#pragma unroll
            for (int e = 0; e < 8; ++e) q[d0][e] *= rstd * qg[16 * d0 + e];
        const float* cs = ropeCM(p) + (size_t)row * 16 + 8 * hf; const float* sn = ropeSM(p) + (size_t)row * 16 + 8 * hf;
#pragma unroll
        for (int e = 0; e < 8; ++e) { const float x1 = q[4][e], x2 = q[5][e]; q[4][e] = x1 * cs[e] - x2 * sn[e]; q[5][e] = x2 * cs[e] + x1 * sn[e]; }
#pragma unroll
        for (int d0 = 0; d0 < 6; ++d0) { float f[8];
#pragma unroll
            for (int e = 0; e < 8; ++e) f[e] = q[d0][e] * ((d0 < 4) ? kg[16 * d0 + e] * C2M : C2M);
            qr[d0] = __builtin_bit_cast(bf16x8, pack8(f)); }
    }
    State st; st_init(st);
    const int NT = 4 * (qb + 1);
    u32x4 ka, kb2, vv; float rk = 0.f;
    const bf16_t* kasrc = KN + (size_t)(rowbase + lane) * 512 + h * 64 + wv * 8;
    const bf16_t* kbsrc = KPE + (size_t)(rowbase + lane) * 32 + (wv & 3) * 8;
    const bf16_t* vsrc = VM + (size_t)(rowbase + 16 * (wv & 3) + (lane >> 2)) * 512 + h * 64 + (wv >> 2) * 32 + (lane & 3) * 8;
#define MLA_LOAD(t) do { ka = *(const u32x4*)(kasrc + (size_t)(t) * 64 * 512); if (wv < 4) kb2 = *(const u32x4*)(kbsrc + (size_t)(t) * 64 * 32); vv = *(const u32x4*)(vsrc + (size_t)(t) * 64 * 512); \
        if (tid < 64) { const int kr_ = rowbase + (t) * 64 + tid; rk = rsqrtf((sqk[(size_t)kr_ * 8 + h] + sqp[kr_]) * (1.f / 96.f) + EPS); } } while (0)
#define MLA_STORE(bf) do { *(LAS u32x4*)(lds + L_K + (bf) * KBUF + wv * 1024 + lane * 16) = ka; if (wv < 4) *(LAS u32x4*)(lds + L_K + (bf) * KBUF + (8 + wv) * 1024 + lane * 16) = kb2; \
        *(LAS u32x4*)(lds + L_V + (bf) * VBUF + wv * 1024 + lane * 16) = vv; if (tid < 64) *(LAS float*)(lds + L_RK + (bf) * 256 + tid * 4) = rk; } while (0)
    __syncthreads();
    MLA_LOAD(0); MLA_STORE(0); if (NT > 1) MLA_LOAD(1);
    const int vboff = ((lane >> 4) & 1) * 32 + (lane & 3) * 8 + (4 * hf + ((lane & 15) >> 2)) * 64;
    const int qlo = q0 + wv * 32;
    for (int i = 0; i < NT; ++i) {
        __syncthreads();
        if (i + 1 < NT) { MLA_STORE((i + 1) & 1); if (i + 2 < NT) MLA_LOAD(i + 2); }
        const int key0 = i * 64, bf = i & 1;
        if (key0 <= qlo + 31) {
            f32x16 p0, p1; qkt<96>(p0, p1, (lds_cptr)(lds + L_K + bf * KBUF) + hf * 1024 + r32 * 16, qr);
            const LAS float* rkp = (const LAS float*)(lds + L_RK + bf * 256);
#pragma unroll
            for (int g = 0; g < 4; ++g) { const f32x4 a = *(const LAS f32x4*)(rkp + 8 * g + 4 * hf), c = *(const LAS f32x4*)(rkp + 32 + 8 * g + 4 * hf);
                p0[4 * g] *= a.x; p0[4 * g + 1] *= a.y; p0[4 * g + 2] *= a.z; p0[4 * g + 3] *= a.w; p1[4 * g] *= c.x; p1[4 * g + 1] *= c.y; p1[4 * g + 2] *= c.z; p1[4 * g + 3] *= c.w; }
            if (key0 + 63 > qlo) mask_range(p0, p1, key0, 0, tq, hf);
            softmax_pv(st, p0, p1, (int)(uintptr_t)(lds + L_V + bf * VBUF) + vboff, wsf, r32, hf);
        }
    }
#undef MLA_LOAD
#undef MLA_STORE
    const float lt = sum32(st.l);
    f32x16 acc[2];
#pragma unroll
    for (int i = 0; i < 16; ++i) { acc[0][i] = 0.f; acc[1][i] = 0.f; }
    accum_scaled(acc, st.o, 1.0f / lt, wsf, r32, hf);
    LAS bf16_t* stg = (LAS bf16_t*)(lds + L_OST) + wv * 2048;
    stage_rows(acc, stg, r32, hf);
#pragma unroll
    for (int i = 0; i < 4; ++i) { const int rr = i * 8 + (lane >> 3), ch = lane & 7; const u32x4 v = *(const LAS u32x4*)(stg + rr * 64 + ch * 8);
        *(u32x4*)(OC + (size_t)(rowbase + q0 + wv * 32 + rr) * 1024 + h * 64 + ch * 8) = v; }
}

DI void nsa_unit(const Params& p, LAS unsigned char* lds, int b, int g, int c, int wid0) {
    const int tid = opaque_tid(wid0), lane = tid & 63, r32 = lane & 31, hf = lane >> 5; const int wv = __builtin_amdgcn_readfirstlane(tid >> 6);
    const bf16_t* QN = wsp<bf16_t>(p, WS_QN); const bf16_t* KCF = wsp<bf16_t>(p, WS_KCF); const bf16_t* VCF = wsp<bf16_t>(p, WS_VCF);
    const bf16_t* KS = wsp<bf16_t>(p, WS_KS); const bf16_t* VS = wsp<bf16_t>(p, WS_VS); const bf16_t* KW = wsp<bf16_t>(p, WS_KW); const bf16_t* VW = wsp<bf16_t>(p, WS_VW);
    const bf16_t* GN = wsp<bf16_t>(p, WS_GN); bf16_t* OC = wsp<bf16_t>(p, WS_R1);
    const int rowbase = b * SEQ, tt = 8 * wv + (r32 >> 2), hd = g * 4 + (r32 & 3), tq = 64 * c + tt, row = rowbase + tq;
    LAS float* wsf = (LAS float*)(lds + L_WS) + wv * 64;
    bf16x8 qr[4];
#pragma unroll
    for (int d0 = 0; d0 < 4; ++d0) qr[d0] = *(const bf16x8*)(QN + (size_t)row * 512 + hd * 64 + 16 * d0 + 8 * hf);
    const float g0 = bf2f(GN[(size_t)row * 32 + hd * 3 + 0]), g1 = bf2f(GN[(size_t)row * 32 + hd * 3 + 1]), g2 = bf2f(GN[(size_t)row * 32 + hd * 3 + 2]);
    f32x16 ot[2];
#pragma unroll
    for (int i = 0; i < 16; ++i) { ot[0][i] = 0.f; ot[1][i] = 0.f; }
    const int vboff = ((lane >> 4) & 1) * 32 + (lane & 3) * 8 + (4 * hf + ((lane & 15) >> 2)) * 64;
    u32x4 ka, vv;
#define NSA_LOAD(KB, VB, krow0) do { ka = *(const u32x4*)((KB) + (size_t)((krow0) + lane) * 128 + g * 64 + wv * 8); \
        vv = *(const u32x4*)((VB) + (size_t)((krow0) + 16 * (wv & 3) + (lane >> 2)) * 128 + g * 64 + (wv >> 2) * 32 + (lane & 3) * 8); } while (0)
#define NSA_STORE(koff, voff) do { *(LAS u32x4*)(lds + (koff) + wv * 1024 + lane * 16) = ka; *(LAS u32x4*)(lds + (voff) + wv * 1024 + lane * 16) = vv; } while (0)
    unsigned selmask;
    {
        const int ntile = (4 * c + 3 > 64) ? 2 : 1;
        const int nmax = (tq >= 31) ? ((tq - 31) >> 4) : -1;
        __syncthreads();
        NSA_LOAD(KCF, VCF, b * 128); NSA_STORE(L_K, L_V);
        if (ntile == 2) { NSA_LOAD(KCF, VCF, b * 128 + 64); NSA_STORE(L_K + 8192, L_V + 8192); }
        __syncthreads();
        f32x16 pa0, pa1, pb0, pb1;
        qkt<64>(pa0, pa1, (lds_cptr)(lds + L_K) + hf * 1024 + r32 * 16, qr); mask_range(pa0, pa1, 0, 0, nmax, hf);
        float m = rowmax32(pa0, pa1);
        if (ntile == 2) { qkt<64>(pb0, pb1, (lds_cptr)(lds + L_K + 8192) + hf * 1024 + r32 * 16, qr); mask_range(pb0, pb1, 64, 0, nmax, hf); m = fmaxf(m, rowmax32(pb0, pb1)); }
        else {
#pragma unroll
            for (int i = 0; i < 16; ++i) { pb0[i] = -INFINITY; pb1[i] = -INFINITY; } }
        const float mu = (m == -INFINITY) ? 0.f : m;
        float ls = 0.f;
#pragma unroll
        for (int r = 0; r < 16; ++r) { pa0[r] = __builtin_amdgcn_exp2f(pa0[r] - mu); pa1[r] = __builtin_amdgcn_exp2f(pa1[r] - mu); pb0[r] = __builtin_amdgcn_exp2f(pb0[r] - mu); pb1[r] = __builtin_amdgcn_exp2f(pb1[r] - mu);
            ls += (pa0[r] + pa1[r]) + (pb0[r] + pb1[r]); }
        ls = sum32(ls);
        const float rl = (ls > 0.f) ? 1.0f / ls : 0.f;
#pragma unroll
        for (int r = 0; r < 16; ++r) { pa0[r] *= rl; pa1[r] *= rl; pb0[r] *= rl; pb1[r] *= rl; }
        float own[16], ee[16];
#pragma unroll
        for (int q = 0; q < 4; ++q) {
            own[q] = (pa0[4 * q] + pa0[4 * q + 1]) + (pa0[4 * q + 2] + pa0[4 * q + 3]); ee[q] = pa0[4 * q + 3];
            own[4 + q] = (pa1[4 * q] + pa1[4 * q + 1]) + (pa1[4 * q + 2] + pa1[4 * q + 3]); ee[4 + q] = pa1[4 * q + 3];
            own[8 + q] = (pb0[4 * q] + pb0[4 * q + 1]) + (pb0[4 * q + 2] + pb0[4 * q + 3]); ee[8 + q] = pb0[4 * q + 3];
            own[12 + q] = (pb1[4 * q] + pb1[4 * q + 1]) + (pb1[4 * q + 2] + pb1[4 * q + 3]); ee[12 + q] = pb1[4 * q + 3]; }
        float eo[16];
#pragma unroll
        for (int k = 0; k < 16; ++k) eo[k] = xor32(ee[k], hf);
#pragma unroll
        for (int k = 0; k < 16; ++k) { const float add = hf ? eo[k] : ((k > 0) ? eo[k - 1] : 0.f); own[k] += add; }
#pragma unroll
        for (int k = 0; k < 16; ++k) { own[k] += xorl<1>(own[k]); own[k] += xorl<2>(own[k]); }
        float imp[32];
#pragma unroll
        for (int k = 0; k < 16; ++k) { const float oth = xor32(own[k], hf); imp[2 * k] = hf ? oth : own[k]; imp[2 * k + 1] = hf ? own[k] : oth; }
        selmask = select_blocks(imp, c);
        State sc; st_init(sc);
        { bf16x8 a0, a1, a2, a3; pack_p(pa0, pa1, a0, a1, a2, a3); pv(sc.o, (int)(uintptr_t)(lds + L_V) + vboff, a0, a1, a2, a3); }
        if (ntile == 2) { bf16x8 a0, a1, a2, a3; pack_p(pb0, pb1, a0, a1, a2, a3); pv(sc.o, (int)(uintptr_t)(lds + L_V + 8192) + vboff, a0, a1, a2, a3); }
        accum_scaled(ot, sc.o, g0, wsf, r32, hf);
    }
#pragma unroll 1
    for (int br = 1; br < 3; ++br) {
        const bf16_t* KB = (br == 1) ? KS : KW; const bf16_t* VB = (br == 1) ? VS : VW;
        const int NT = (br == 1) ? (c + 1) : ((c + 1 < 5) ? c + 1 : 5);
        const int lo = (br == 1) ? 0 : tq - 255;
        State st; st_init(st);
        __syncthreads();
        NSA_LOAD(KB, VB, rowbase + c * 64); NSA_STORE(L_K, L_V); if (NT > 1) NSA_LOAD(KB, VB, rowbase + (c - 1) * 64);
        for (int i = 0; i < NT; ++i) {
            __syncthreads();
            if (i + 1 < NT) { NSA_STORE(L_K + ((i + 1) & 1) * KBUF, L_V + ((i + 1) & 1) * VBUF); if (i + 2 < NT) NSA_LOAD(KB, VB, rowbase + (c - i - 2) * 64); }
            const int j = c - i, key0 = j * 64, bf = i & 1;
            const bool sel = (br == 2) || ((selmask >> j) & 1u);
            if (__any(sel)) {
                f32x16 p0, p1; qkt<64>(p0, p1, (lds_cptr)(lds + L_K + bf * KBUF) + hf * 1024 + r32 * 16, qr);
                if (br == 1) { if (i == 0) mask_range(p0, p1, key0, 0, tq, hf);
                    if (!sel) {
#pragma unroll
                        for (int r = 0; r < 16; ++r) { p0[r] = -INFINITY; p1[r] = -INFINITY; } } }
                else { if (i == 0 || i == 4) mask_range(p0, p1, key0, lo, tq, hf); }
                softmax_pv(st, p0, p1, (int)(uintptr_t)(lds + L_V + bf * VBUF) + vboff, wsf, r32, hf);
            }
        }
        const float lt = sum32(st.l);
        accum_scaled(ot, st.o, ((br == 1) ? g1 : g2) / lt, wsf, r32, hf);
    }
#undef NSA_LOAD
#undef NSA_STORE
    LAS bf16_t* stg = (LAS bf16_t*)(lds + L_OST) + wv * 2048;
    stage_rows(ot, stg, r32, hf);
#pragma unroll
    for (int i = 0; i < 4; ++i) { const int rr = i * 8 + (lane >> 3), ch = lane & 7; const u32x4 v = *(const LAS u32x4*)(stg + rr * 64 + ch * 8);
        *(u32x4*)(OC + (size_t)(rowbase + 64 * c + 8 * wv + (rr >> 2)) * 1024 + 512 + (g * 4 + (rr & 3)) * 64 + ch * 8) = v; }
}
#undef FA_SBAR
}

DI void stage_attn_fast(const Params& p, LAS unsigned char* lds, int bid, int nb, bool do_mla, bool do_nsa, int wid0) {
    if (do_mla) for (int u = bid; u < 256; u += nb) { const int bh = u >> 2, s = u & 3; fa::mla_unit(p, lds, bh >> 3, bh & 7, 7 - s, wid0); fa::mla_unit(p, lds, bh >> 3, bh & 7, s, wid0); }
    if (do_nsa) for (int u = bid; u < 256; u += nb) { const int bg = u >> 4, s = u & 15; fa::nsa_unit(p, lds, bg >> 1, bg & 1, 31 - s, wid0); fa::nsa_unit(p, lds, bg >> 1, bg & 1, s, wid0); }
    __syncthreads();
}
#define XB_TMO      128
#define XB_XCNT(j)  (256  + 64 * (j))
#define XB_XSUB(j)  (1280 + 64 * (j))
#define XB_XGEN(j)  (2304 + 64 * (j))
#define XB_TOP      3328
#define XB_TOPGEN   3392
#define XCD_BAR_WORDS 3456
#define XB_SPIN_CAP (1u << 18)

__device__ __forceinline__ unsigned xb_ld(unsigned* p)              { return __hip_atomic_load(p, __ATOMIC_RELAXED, __HIP_MEMORY_SCOPE_AGENT); }
__device__ __forceinline__ unsigned xb_add(unsigned* p, unsigned v) { return __hip_atomic_fetch_add(p, v, __ATOMIC_RELAXED, __HIP_MEMORY_SCOPE_AGENT); }
__device__ __forceinline__ unsigned xb_xcc_id() { return (unsigned)__builtin_amdgcn_s_getreg((3 << 11) | 20) & 0xFu; }
#define XB_SPIN(cond, bar) do { unsigned _sp = 0; while (cond) { __builtin_amdgcn_s_sleep(1); \
    if ((++_sp & 255u) == 0u) { if (xb_ld(&(bar)[XB_TMO])) break; if (_sp > XB_SPIN_CAP) { atomicAdd(&(bar)[XB_TMO], 1u); break; } } } } while (0)

struct XcdBarrier {
    unsigned* bar; unsigned x;
    volatile LAS unsigned* st;
};

__device__ __forceinline__ XcdBarrier xcd_barrier_post(unsigned* bar, volatile LAS unsigned* st, bool t0) {
    XcdBarrier b; b.bar = bar; b.x = xb_xcc_id(); b.st = st;
    if (t0) (void)xb_add(&bar[XB_XCNT(b.x)], 1u);
    return b;
}
__device__ __forceinline__ void xcd_barrier_complete(unsigned* bar, unsigned x, unsigned& nloc, unsigned& nx) {
    const unsigned G = gridDim.x * gridDim.y * gridDim.z;
    unsigned sum, cnt, mine, sp = 0u;
    for (;;) {
        sum = 0u; cnt = 0u; mine = 0u;
#pragma unroll
        for (unsigned j = 0; j < 16; ++j) { const unsigned c = xb_ld(&bar[XB_XCNT(j)]); sum += c; cnt += (c > 0u) ? 1u : 0u; mine = (j == x) ? c : mine; }
        if (sum == G) break;
        __builtin_amdgcn_s_sleep(1);
        if ((++sp & 255u) == 0u) { if (xb_ld(&bar[XB_TMO])) break; if (sp > XB_SPIN_CAP) { atomicAdd(&bar[XB_TMO], 1u); break; } }
    }
    nloc = mine > 0u ? mine : 1u; nx = cnt > 0u ? cnt : 1u;
}

__device__ __forceinline__ void xcd_barrier(const XcdBarrier& b, bool t0) {
    asm volatile("s_waitcnt vmcnt(0)" ::: "memory");
    __syncthreads();
    if (t0) {
        unsigned* bar = b.bar;
        __builtin_amdgcn_s_waitcnt(0);
        unsigned nloc = b.st[0], nx = b.st[1];
        if (nloc == 0u) { xcd_barrier_complete(bar, b.x, nloc, nx); b.st[0] = nloc; b.st[1] = nx; }
        const unsigned old = xb_add(&bar[XB_XSUB(b.x)], 1u);
        const unsigned gen = old / nloc;
        if (old + 1u == (gen + 1u) * nloc) {
            __builtin_amdgcn_fence(__ATOMIC_RELEASE, "agent");
            asm volatile("s_waitcnt vmcnt(0)" ::: "memory");
            const unsigned og = xb_add(&bar[XB_TOP], 1u);
            const unsigned tg = og / nx;
            if (og + 1u == (tg + 1u) * nx) xb_add(&bar[XB_TOPGEN], 1u);
            else XB_SPIN(xb_ld(&bar[XB_TOPGEN]) == tg, bar);
            __builtin_amdgcn_fence(__ATOMIC_ACQUIRE, "agent");
            xb_add(&bar[XB_XGEN(b.x)], 1u);
            asm volatile("s_waitcnt vmcnt(0)" ::: "memory");
        } else {
            XB_SPIN(xb_ld(&bar[XB_XGEN(b.x)]) == gen, bar);
            __builtin_amdgcn_fence(__ATOMIC_ACQUIRE, "agent");
            asm volatile("s_waitcnt vmcnt(0)" ::: "memory");
        }
    }
    __syncthreads();
}
constexpr int LDS_BYTES = 147456;
#ifndef REPEAT_PHASE
#define REPEAT_PHASE -1
#endif
#define REP(k) for (int rep_ = 0; rep_ < ((REPEAT_PHASE == (k)) ? 2 : 1); ++rep_)
#ifndef USE_CG_SYNC
#define USE_CG_SYNC 0
#endif

typedef const Params __attribute__((address_space(4)))* KParamsPtr;
#if defined(__HIP_DEVICE_COMPILE__)
DI KParamsPtr kparams() { KParamsPtr k = (KParamsPtr)__builtin_amdgcn_kernarg_segment_ptr(); asm volatile("" : "+s"(k)); return k; }
#endif
#if defined(__HIP_DEVICE_COMPILE__)
#define PHASE_PARAMS() const Params p = *kparams()
#else
#define PHASE_PARAMS() const Params p = p_arg
#endif
__global__ void __launch_bounds__(512, 2) fwd_megakernel(Params p_arg) {
    extern __shared__ __attribute__((aligned(16))) unsigned char dlds[];
    LAS unsigned char* lds = (LAS unsigned char*)dlds;
#if USE_CG_SYNC
    cg::grid_group grid = cg::this_grid();
#endif
    const int G = gridDim.x, c = blockIdx.x, ngw = G * NWAVE, ngt = G * NTHR;
    const int wid0 = __builtin_amdgcn_readfirstlane(threadIdx.x >> 6);
#define TIDS() const int tid = opaque_tid(wid0), lane = tid & 63, wave = tid >> 6, gw = c * NWAVE + wave, gtid = c * NTHR + tid; (void)lane; (void)gw; (void)gtid
#if USE_CG_SYNC
#define GRID_SYNC() grid.sync()
#else
    volatile LAS unsigned* MISC = (volatile LAS unsigned*)(lds + 131072 + 320);
    { TIDS(); if (tid < 32) MISC[tid] = 0u; }
    __syncthreads();
    XcdBarrier bar;
    { PHASE_PARAMS(); TIDS(); bar = xcd_barrier_post((unsigned*)(p.ws + WS_CTL) + 4096, MISC + 8, tid == 0); }
#define GRID_SYNC() do { TIDS(); xcd_barrier(bar, tid == 0); } while (0)
#endif
    REP(0) { PHASE_PARAMS();
    { TIDS(); stage_weights(p, gw, ngw, (float*)dlds + wave * (64 * 33), lane); }
    __syncthreads();
    stage_mod(p, c, G, (float*)dlds, wid0);
    __syncthreads();
    { TIDS(); stage_rope(p, tid, gtid, ngt, (float*)dlds + 16384); } }
    GRID_SYNC();
    REP(1) { PHASE_PARAMS(); TIDS(); stage_normmod(p.in[I_X], p.in[I_N1G], wsp<float>(p, WS_MOD), 0, 1, wsp<bf16_t>(p, WS_R0), gw, ngw, lane); }
    GRID_SYNC();
    REP(2) { PHASE_PARAMS(); EpiZ E{p}; gemm_fast(lds, wsp<bf16_t>(p, WS_R0), 1024, wsp<bf16_t>(p, WS_WIN), MT, ZN, 1024, E, G, c, wid0); }
    GRID_SYNC();
    REP(3) { PHASE_PARAMS();
      int qb, qc, kb, kc;
      if (G == 256) { qb = c; qc = (c < 192) ? 1 : 0; kb = (c < 192) ? c : (c >= 224 ? 192 + 2 * (c - 224) : 0); kc = (c < 192) ? 1 : (c >= 224 ? 2 : 0); }
      else { const int pq = (192 + G - 1) / G, pk = (256 + G - 1) / G; qb = c * pq; qc = (192 - qb < pq) ? ((192 - qb > 0) ? 192 - qb : 0) : pq; kb = c * pk; kc = (256 - kb < pk) ? ((256 - kb > 0) ? 256 - kb : 0) : pk; }
      { EpiQ E{p}; gemm_fast_range(lds, wsp<bf16_t>(p, WS_R1), 1024, wsp<bf16_t>(p, WS_WQB), MT, 768, 768, E, qb, qc, wid0); }
      for (int cu = (c + 64) % G; cu < 32; cu += G) cmp_hidden_fast(p, lds, cu, wid0);
      { EpiKV E{p}; gemm_fast_range(lds, wsp<bf16_t>(p, WS_R1) + 768, 1024, wsp<bf16_t>(p, WS_WKVB), MT, 1024, 256, E, kb, kc, wid0); }
    }
    GRID_SYNC();
    { PHASE_PARAMS(); TIDS(); cmp_out<true>(p, gw, ngw, lane); }
    REP(4) { PHASE_PARAMS(); stage_attn_fast(p, lds, c, G, true, false, wid0); }
    GRID_SYNC();
    REP(5) { PHASE_PARAMS(); stage_attn_fast(p, lds, c, G, false, true, wid0); }
    GRID_SYNC();
    REP(6) { PHASE_PARAMS(); EpiMerge E{p}; gemm_fast(lds, wsp<bf16_t>(p, WS_R1), 1024, wsp<bf16_t>(p, WS_WO), MT, 1024, 1024, E, G, c, wid0); }
    GRID_SYNC();
    REP(7) { PHASE_PARAMS(); EpiOut E{p}; gemm_fast(lds, wsp<bf16_t>(p, WS_R0), 1024, wsp<bf16_t>(p, WS_WOUT), MT, 1024, 1024, E, G, c, wid0); }
    GRID_SYNC();
    REP(8) { PHASE_PARAMS(); TIDS(); stage_normmod(wsp<float>(p, WS_R2), p.in[I_N2G], wsp<float>(p, WS_MOD), 3, 4, wsp<bf16_t>(p, WS_R1), gw, ngw, lane); }
    GRID_SYNC();
    REP(9) { PHASE_PARAMS(); EpiGU E{p}; gemm_fast(lds, wsp<bf16_t>(p, WS_R1), 1024, wsp<bf16_t>(p, WS_WGU), MT, 5632, 1024, E, G, c, wid0); }
    GRID_SYNC();
    REP(10) { PHASE_PARAMS(); EpiDown E{p}; gemm_fast(lds, wsp<bf16_t>(p, WS_HID), DFF, wsp<bf16_t>(p, WS_WD), MT, 1024, DFF, E, G, c, wid0); }
}

extern "C" void kernel_launch(void* const* d_in, const int* in_sizes, int n_in, void* d_out, int out_size, void* d_ws, size_t ws_size, hipStream_t stream) {
    if (n_in != 30 || out_size != MT * DM || ws_size < WS_END) { fprintf(stderr, "kernel_launch: unexpected shapes (n_in %d out %d ws %zu)\n", n_in, out_size, ws_size); return; }
    static int grid = 0;
    if (grid == 0) {
        int dev = 0, cus = 0, per_cu = 0;
        hipGetDevice(&dev); hipDeviceGetAttribute(&cus, hipDeviceAttributeMultiprocessorCount, dev);
        hipFuncSetAttribute((const void*)fwd_megakernel, hipFuncAttributeMaxDynamicSharedMemorySize, LDS_BYTES);
        hipOccupancyMaxActiveBlocksPerMultiprocessor(&per_cu, (const void*)fwd_megakernel, NTHR, LDS_BYTES);
        if (per_cu < 1) { fprintf(stderr, "kernel_launch: occupancy query says %d blocks per CU\n", per_cu); per_cu = 1; }
        grid = cus;
        (void)hipGetLastError();
    }
    Params p{};
    for (int i = 0; i < 30; ++i) p.in[i] = (const float*)d_in[i];
    p.out = (float*)d_out; p.ws = (unsigned char*)d_ws;
    if (!USE_CG_SYNC) (void)hipMemsetAsync((char*)d_ws + WS_CTL, 0, 65536, stream);
    void* args[] = {&p};
    hipError_t e = hipLaunchCooperativeKernel((const void*)fwd_megakernel, dim3(grid), dim3(NTHR), args, LDS_BYTES, stream);
    if (e != hipSuccess) fprintf(stderr, "kernel_launch: cooperative launch failed: %s (grid %d)\n", hipGetErrorString(e), grid);
}
```

```cpp
#include <hip/hip_runtime.h>
#include <hip/hip_cooperative_groups.h>
#include <cstdint>
#include <cstdio>
namespace cg = cooperative_groups;

typedef unsigned short bf16_t;
typedef unsigned u32x4 __attribute__((ext_vector_type(4)));
typedef unsigned u32x2 __attribute__((ext_vector_type(2)));
typedef float f32x4 __attribute__((ext_vector_type(4)));
typedef float f32x2 __attribute__((ext_vector_type(2)));
#define DI __device__ __forceinline__

constexpr int NB = 8, SEQ = 2048, DM = 1024, MT = NB * SEQ;
constexpr int DFF = 2816, NMOD = 6;
constexpr int ZN = 4608;
constexpr float EPS = 1e-6f;
constexpr float LOG2E = 1.4426950408889634f;
constexpr float C2N = 0.125f * LOG2E;
constexpr float C2M = 0.10206207261596575f * LOG2E;
constexpr int NTHR = 512, NWAVE = 8;
constexpr int O_CQ = 0, O_CKV = 768, O_KPE = 1024, O_QN = 1056, O_KC = 1568, O_VC = 1696, O_KS = 1824, O_VS = 1952, O_KW = 2080, O_VW = 2208,
              O_GN = 2336, O_GM = 2360, O_GNM = 3384, D_IN = 4408;

constexpr size_t MiB = 1u << 20;
constexpr size_t WS_CTL = 0;
constexpr size_t WS_MOD = 1 * MiB;
constexpr size_t WS_CB1 = 1 * MiB + 256 * 1024;
constexpr size_t WS_SSQPE = 1 * MiB + 320 * 1024;
constexpr size_t WS_SSQKN = 1 * MiB + 512 * 1024;
constexpr size_t WS_SSQA = 2 * MiB;
constexpr size_t WS_KCF = 3 * MiB;
constexpr size_t WS_VCF = 3 * MiB + 256 * 1024;
constexpr size_t WS_SHW = 3 * MiB + 512 * 1024;
constexpr size_t WS_WIN = 4 * MiB;
constexpr size_t WS_WQB = 13 * MiB;
constexpr size_t WS_WKVB = 15 * MiB;
constexpr size_t WS_WO = 16 * MiB;
constexpr size_t WS_WOUT = 18 * MiB;
constexpr size_t WS_WGU = 20 * MiB;
constexpr size_t WS_WD = 31 * MiB;
constexpr size_t WS_CW1 = 37 * MiB;
constexpr size_t WS_R0 = 40 * MiB;
constexpr size_t WS_R1 = 72 * MiB;
constexpr size_t WS_R2 = 104 * MiB;
constexpr size_t WS_QN = 168 * MiB;
constexpr size_t WS_KC = 184 * MiB, WS_VC = 188 * MiB, WS_KS = 192 * MiB, WS_VS = 196 * MiB, WS_KW = 200 * MiB, WS_VW = 204 * MiB;
constexpr size_t WS_KPE = 208 * MiB;
constexpr size_t WS_GN = 209 * MiB;
constexpr size_t WS_KN = 210 * MiB;
constexpr size_t WS_VM = 226 * MiB;
constexpr size_t WS_CMPH = 64 * MiB;
constexpr size_t WS_ROPE = 248 * MiB;
constexpr size_t WS_HID = 168 * MiB;
constexpr size_t WS_END = 256 * MiB;

struct Params {
    const float* in[30];
    float* out;
    unsigned char* ws;
};
enum { I_X = 0, I_C, I_POS, I_ADAW, I_ADAB, I_N1G, I_WIN, I_QAG, I_WQB, I_KVAG, I_WKVB, I_MQG, I_MKG, I_NQG, I_NKCG, I_NKSG, I_NKWG,
       I_CPK, I_CW1K, I_CW2K, I_CPV, I_CW1V, I_CW2V, I_WOM, I_WON, I_WOUT, I_N2G, I_WG, I_WU, I_WDN };

template <class T> DI T* wsp(const Params& p, size_t off) { return (T*)(p.ws + off); }

DI int lane_id() { return (int)__builtin_amdgcn_mbcnt_hi(~0u, __builtin_amdgcn_mbcnt_lo(~0u, 0u)); }
DI int opaque_tid(int wid0) { int l = lane_id(); asm volatile("" : "+v"(l)); return (wid0 << 6) | l; }
DI unsigned f2bf(float f) { unsigned u = __float_as_uint(f); return (u + 0x7fffu + ((u >> 16) & 1u)) >> 16; }
DI unsigned pk2(float lo, float hi) { return f2bf(lo) | (f2bf(hi) << 16); }
DI float bf2f(unsigned short b) { return __uint_as_float(((unsigned)b) << 16); }
DI float bflo(unsigned w) { return __uint_as_float(w << 16); }
DI float bfhi(unsigned w) { return __uint_as_float(w & 0xffff0000u); }
DI void unpack8(const u32x4 w, float (&f)[8]) { f[0] = bflo(w.x); f[1] = bfhi(w.x); f[2] = bflo(w.y); f[3] = bfhi(w.y); f[4] = bflo(w.z); f[5] = bfhi(w.z); f[6] = bflo(w.w); f[7] = bfhi(w.w); }
DI u32x4 pack8(const float (&f)[8]) { u32x4 w; w.x = pk2(f[0], f[1]); w.y = pk2(f[2], f[3]); w.z = pk2(f[4], f[5]); w.w = pk2(f[6], f[7]); return w; }
DI float sigmoidf(float x) { return __builtin_amdgcn_rcpf(1.0f + __expf(-x)); }
DI float siluf(float x) { return x * __builtin_amdgcn_rcpf(1.0f + __expf(-x)); }
template <int X> DI float xorl(float v) { return __int_as_float(__builtin_amdgcn_ds_swizzle(__float_as_int(v), (X << 10) | 0x1f)); }
DI void halves(float v, float& lo, float& hi) { auto rr = __builtin_amdgcn_permlane32_swap(__float_as_uint(v), __float_as_uint(v), false, false); lo = __uint_as_float(rr[0]); hi = __uint_as_float(rr[1]); }
DI float xor32(float v, int hf) { float lo, hi; halves(v, lo, hi); return hf ? lo : hi; }
DI float sum32(float v) { float lo, hi; halves(v, lo, hi); return lo + hi; }
DI float max32(float v) { float lo, hi; halves(v, lo, hi); return fmaxf(lo, hi); }
DI float wave_sum(float v) { v += xorl<1>(v); v += xorl<2>(v); v += xorl<4>(v); v += xorl<8>(v); v += xorl<16>(v); return sum32(v); }
DI void sincos_rad(float ang, float& c, float& s) {
    double rev = (double)ang * 0.15915494309189535; rev -= __builtin_rint(rev);
    const float fr = (float)rev; s = __builtin_amdgcn_sinf(fr); c = __builtin_amdgcn_cosf(fr);
}
#define LAS __attribute__((address_space(3)))
DI void transpose_item(const float* W, int ldw, int c0, int ncols, const float* rs, bf16_t* dst, int ldd, int n0, int k0, float* scr, int lane) {
    const int cc = lane & 31, kh = lane >> 5;
    float v[32];
    if (c0 >= 0) {
        const float* src = W + (size_t)(k0 + kh) * ldw + c0 + cc;
        if (cc < ncols) {
#pragma unroll
            for (int i = 0; i < 32; ++i) v[i] = src[(size_t)(2 * i) * ldw];
        } else {
#pragma unroll
            for (int i = 0; i < 32; ++i) v[i] = 0.f;
        }
        if (rs) {
#pragma unroll
            for (int i = 0; i < 32; ++i) v[i] *= rs[k0 + 2 * i + kh];
        }
    } else {
#pragma unroll
        for (int i = 0; i < 32; ++i) v[i] = 0.f;
    }
#pragma unroll
    for (int i = 0; i < 32; ++i) scr[(2 * i + kh) * 33 + cc] = v[i];
    __builtin_amdgcn_s_waitcnt(0xc07f);
    asm volatile("" ::: "memory");
    const int c = lane & 7;
#pragma unroll
    for (int j = 0; j < 4; ++j) { const int n = (lane >> 3) + 8 * j; const float* s = scr + (8 * c) * 33 + n;
        u32x4 o; o.x = pk2(s[0 * 33], s[1 * 33]); o.y = pk2(s[2 * 33], s[3 * 33]); o.z = pk2(s[4 * 33], s[5 * 33]); o.w = pk2(s[6 * 33], s[7 * 33]);
        *(u32x4*)(dst + (size_t)(n0 + n) * ldd + k0 + 8 * c) = o; }
    __builtin_amdgcn_s_waitcnt(0xc07f);
    asm volatile("" ::: "memory");
}
DI int zsrc(int s, int L0, int& ncols) {
    ncols = 32;
    if (s < 16) return 64 * s + L0;
    if (s == 16) { if (L0 == 0) return O_KPE; ncols = 24; return O_GN; }
    if (s < 25) return O_QN + 64 * (s - 17) + L0;
    if (s < 27) return O_KC + 64 * (s - 25) + L0;
    if (s < 29) return O_VC + 64 * (s - 27) + L0;
    if (s < 31) return O_KS + 64 * (s - 29) + L0;
    if (s < 33) return O_VS + 64 * (s - 31) + L0;
    if (s < 35) return O_KW + 64 * (s - 33) + L0;
    if (s < 37) return O_VW + 64 * (s - 35) + L0;
    if (s < 40) return -1;
    if (s < 56) return O_GM + 64 * (s - 40) + L0;
    return O_GNM + 64 * (s - 56) + L0;
}
DI void stage_weights(const Params& p, int gw, int ngw, float* scr, int lane) {
    constexpr int I_IN = (ZN / 32) * (DM / 64);
    constexpr int I_QB = (768 / 32) * (768 / 64);
    constexpr int I_KVB = (1024 / 32) * (256 / 64);
    constexpr int I_O = (1024 / 32) * (1024 / 64);
    constexpr int I_OUT = I_O;
    constexpr int I_GU = (5632 / 32) * (1024 / 64);
    constexpr int I_D = (1024 / 32) * (DFF / 64);
    constexpr int I_C1 = 2 * (256 / 32) * (2048 / 64);
    constexpr int NITEMS = I_IN + I_QB + I_KVB + I_O + I_OUT + I_GU + I_D + I_C1;
    for (int it = gw; it < NITEMS; it += ngw) {
        int r = it;
        if (r < I_IN) { const int nb = r / 16, kb = r % 16; const int pn = nb >> 3, bj = (nb >> 2) & 1, wc = nb & 3; int nc; const int c0 = zsrc(4 * pn + wc, 32 * bj, nc);
            transpose_item(p.in[I_WIN], D_IN, c0, nc, nullptr, wsp<bf16_t>(p, WS_WIN), DM, nb * 32, kb * 64, scr, lane); continue; } r -= I_IN;
        if (r < I_QB) { const int nb = r / 12, kb = r % 12; transpose_item(p.in[I_WQB], 768, nb * 32, 32, p.in[I_QAG], wsp<bf16_t>(p, WS_WQB), 768, nb * 32, kb * 64, scr, lane); continue; } r -= I_QB;
        if (r < I_KVB) { const int nb = r / 4, kb = r % 4; const int pn = nb >> 3, bj = (nb >> 2) & 1, wc = nb & 3, s = 4 * pn + wc;
            const int c0 = (s < 8) ? (128 * s + 32 * bj) : (128 * (s - 8) + 64 + 32 * bj);
            transpose_item(p.in[I_WKVB], 1024, c0, 32, p.in[I_KVAG], wsp<bf16_t>(p, WS_WKVB), 256, nb * 32, kb * 64, scr, lane); continue; } r -= I_KVB;
        if (r < I_O) { const int nb = r / 16, kb = r % 16;
            if (kb < 8) transpose_item(p.in[I_WOM], 1024, nb * 32, 32, nullptr, wsp<bf16_t>(p, WS_WO), 1024, nb * 32, kb * 64, scr, lane);
            else transpose_item(p.in[I_WON] - (size_t)512 * 1024, 1024, nb * 32, 32, nullptr, wsp<bf16_t>(p, WS_WO), 1024, nb * 32, kb * 64, scr, lane);
            continue; } r -= I_O;
        if (r < I_OUT) { const int nb = r / 16, kb = r % 16; transpose_item(p.in[I_WOUT], 1024, nb * 32, 32, nullptr, wsp<bf16_t>(p, WS_WOUT), 1024, nb * 32, kb * 64, scr, lane); continue; } r -= I_OUT;
        if (r < I_GU) { const int nb = r / 16, kb = r % 16; const int pn = nb >> 3, bj = (nb >> 2) & 1, wc = nb & 3, s = 4 * pn + wc;
            transpose_item(bj ? p.in[I_WU] : p.in[I_WG], DFF, 32 * s, 32, nullptr, wsp<bf16_t>(p, WS_WGU), 1024, nb * 32, kb * 64, scr, lane); continue; } r -= I_GU;
        if (r < I_D) { const int nb = r / 44, kb = r % 44; transpose_item(p.in[I_WDN], 1024, nb * 32, 32, nullptr, wsp<bf16_t>(p, WS_WD), DFF, nb * 32, kb * 64, scr, lane); continue; } r -= I_D;
        { const int kv = r / 256, rr = r % 256, nb = rr / 32, kb = rr % 32;
          transpose_item(kv ? p.in[I_CW1V] : p.in[I_CW1K], 256, nb * 32, 32, nullptr, wsp<bf16_t>(p, WS_CW1) + (size_t)kv * 256 * 2048, 2048, nb * 32, kb * 64, scr, lane); }
    }
}
DI void stage_mod(const Params& p, int bid, int nb, float* lds, int wid0) {
    const int tid = opaque_tid(wid0), wave = tid >> 6, lane = tid & 63, nwv = blockDim.x >> 6;
    if (bid >= 104) return;
    float* sl = lds; float* red = lds + 8192;
    for (int i = tid; i < 8192; i += blockDim.x) sl[i] = siluf(p.in[I_C][i]);
    __syncthreads();
    for (int u = bid; u < 104; u += nb) {
        float acc[8];
#pragma unroll
        for (int b = 0; b < 8; ++b) acc[b] = 0.f;
        if (u < 96) {
            const float* W = p.in[I_ADAW] + u * 64 + lane; const int kn = 1024 / nwv;
            for (int k = wave * kn; k < (wave + 1) * kn; k += 8) { float w[8];
#pragma unroll
                for (int e = 0; e < 8; ++e) w[e] = W[(size_t)(k + e) * 6144];
#pragma unroll
                for (int e = 0; e < 8; ++e)
#pragma unroll
                    for (int b = 0; b < 8; ++b) acc[b] += sl[b * 1024 + k + e] * w[e]; }
        } else {
            const int kv = (u - 96) >> 2; const float* W = (kv ? p.in[I_CW1V] : p.in[I_CW1K]) + ((u - 96) & 3) * 64 + lane; const float* pos = kv ? p.in[I_CPV] : p.in[I_CPK]; const int kn = 2048 / nwv;
            for (int k = wave * kn; k < (wave + 1) * kn; k += 8) { float w[8];
#pragma unroll
                for (int e = 0; e < 8; ++e) w[e] = W[(size_t)(k + e) * 256];
#pragma unroll
                for (int e = 0; e < 8; ++e) acc[0] += pos[k + e] * w[e]; }
        }
        __syncthreads();
#pragma unroll
        for (int b = 0; b < 8; ++b) red[(wave * 8 + b) * 64 + lane] = acc[b];
        __syncthreads();
        if (wave == 0) {
#pragma unroll
            for (int b = 0; b < 8; ++b) { float s = 0.f;
                for (int w = 0; w < nwv; ++w) s += red[(w * 8 + b) * 64 + lane];
                if (u < 96) wsp<float>(p, WS_MOD)[b * 6144 + u * 64 + lane] = s + p.in[I_ADAB][u * 64 + lane];
                else if (b == 0) wsp<float>(p, WS_CB1)[(u - 96) * 64 + lane] = s; }
        }
    }
}
DI void stage_rope(const Params& p, int tid, int gtid, int ngt, float* invt) {
    if (tid < 24) invt[tid] = (tid < 16) ? (float)pow(500000.0, -(double)tid / 16.0) : (float)pow(500000.0, -(double)(tid - 16) / 8.0);
    __syncthreads();
    float* T = wsp<float>(p, WS_ROPE); const int* pos = (const int*)p.in[I_POS];
    for (int i = gtid; i < MT * 24; i += ngt) {
        const int row = i / 24, j = i % 24; const float ps = (float)pos[row]; float c, s;
        sincos_rad(ps * invt[j], c, s);
        if (j < 16) { T[(size_t)row * 16 + j] = c; T[(size_t)MT * 16 + (size_t)row * 16 + j] = s; }
        else { T[(size_t)MT * 32 + (size_t)row * 8 + (j - 16)] = c; T[(size_t)MT * 40 + (size_t)row * 8 + (j - 16)] = s; }
    }
}
DI const float* ropeCM(const Params& p) { return wsp<float>(p, WS_ROPE); }
DI const float* ropeSM(const Params& p) { return wsp<float>(p, WS_ROPE) + (size_t)MT * 16; }
DI const float* ropeCN(const Params& p) { return wsp<float>(p, WS_ROPE) + (size_t)MT * 32; }
DI const float* ropeSN(const Params& p) { return wsp<float>(p, WS_ROPE) + (size_t)MT * 40; }

DI void stage_normmod(const float* X, const float* gain, const float* mod, int sh_idx, int sc_idx, bf16_t* Hout, int gw, int ngw, int lane) {
    for (int m = gw; m < MT; m += ngw) {
        const int b = m / SEQ; const f32x4* xr = (const f32x4*)(X + (size_t)m * DM) + lane;
        f32x4 v[4]; float s = 0.f;
#pragma unroll
        for (int j = 0; j < 4; ++j) { v[j] = xr[64 * j]; s += (v[j].x * v[j].x + v[j].y * v[j].y) + (v[j].z * v[j].z + v[j].w * v[j].w); }
        const float rstd = rsqrtf(wave_sum(s) * (1.f / DM) + EPS);
        const f32x4* g4 = (const f32x4*)gain + lane; const f32x4* sc4 = (const f32x4*)(mod + b * 6144 + sc_idx * 1024) + lane; const f32x4* sh4 = (const f32x4*)(mod + b * 6144 + sh_idx * 1024) + lane;
        u32x2* o8 = (u32x2*)(Hout + (size_t)m * DM) + lane;
#pragma unroll
        for (int j = 0; j < 4; ++j) { const f32x4 g = g4[64 * j], sc = sc4[64 * j], sh = sh4[64 * j];
            const f32x4 y = v[j] * rstd * g * (1.0f + sc) + sh; u32x2 w; w.x = pk2(y.x, y.y); w.y = pk2(y.z, y.w); o8[64 * j] = w; }
    }
}

DI void stage_shw(const Params& p, int gw, int ngw, int lane) {
    const bf16_t* W = wsp<bf16_t>(p, WS_WGU); const float* md = wsp<float>(p, WS_MOD) + 3 * 1024 + 16 * lane; float* out = wsp<float>(p, WS_SHW);
    for (int n = gw; n < 5632; n += ngw) {
        float w[16]; { float t[8]; unpack8(*(const u32x4*)(W + (size_t)n * 1024 + 16 * lane), t);
#pragma unroll
            for (int e = 0; e < 8; ++e) w[e] = t[e];
            unpack8(*(const u32x4*)(W + (size_t)n * 1024 + 16 * lane + 8), t);
#pragma unroll
            for (int e = 0; e < 8; ++e) w[8 + e] = t[e]; }
#pragma unroll
        for (int b = 0; b < 8; ++b) { float acc = 0.f;
#pragma unroll
            for (int q = 0; q < 4; ++q) { const f32x4 sv = *(const f32x4*)(md + b * 6144 + 4 * q); acc += (sv.x * w[4 * q] + sv.y * w[4 * q + 1]) + (sv.z * w[4 * q + 2] + sv.w * w[4 * q + 3]); }
            acc = wave_sum(acc);
            if (lane == 0) out[b * 5632 + n] = acc; }
    }
}
struct ColPre { f32x4 c[8]; };
struct RowPre { f32x4 a[4]; };
DI void store8bf(bf16_t* dst, const float (&f)[8]) { *(u32x4*)dst = pack8(f); }
DI float ssq16(const float (&v)[2][8]) { float q = 0.f;
#pragma unroll
    for (int b = 0; b < 2; ++b)
#pragma unroll
        for (int j = 0; j < 8; ++j) q += v[b][j] * v[b][j];
    q += xorl<16>(q); return sum32(q); }
DI f32x4 ld4(const float* p) { return *(const f32x4*)p; }
DI f32x4 ld4u(const bf16_t* p) { return __builtin_bit_cast(f32x4, *(const u32x4*)p); }
DI void un8(const f32x4 raw, float (&f)[8]) { unpack8(__builtin_bit_cast(u32x4, raw), f); }

struct EpiZ {
    static constexpr bool HAS_MID = false; static constexpr int NTYPES = 7;
    Params p;
    DI void midpre(RowPre&, int, int, int, int) const {}
    DI void mid(const RowPre&, int, int, int, int, float (&)[2][8]) const {}
    DI int type(int pn, int wc) const { const int s = 4 * pn + wc;
        if (s < 16) return 0; if (s == 16) return 1; if (s < 25) return 2; if (s < 37) { const int t = (s - 25) >> 1; return (t == 2 || t == 4) ? 3 : 4; } if (s < 40) return 5; return 6; }
    template <int T> DI void ubegin(ColPre& U, int, int pn, int wc, int fq) const {
        const int s = 4 * pn + wc; (void)s;
        if constexpr (T == 1) { U.c[0] = ld4(p.in[I_MKG] + 64 + 8 * fq); U.c[1] = ld4(p.in[I_MKG] + 68 + 8 * fq); }
        if constexpr (T == 2 || T == 3) { const float* gain = (T == 2) ? p.in[I_NQG] : ((((s - 25) >> 1) == 2) ? p.in[I_NKSG] : p.in[I_NKWG]);
            U.c[0] = ld4(gain + 8 * fq); U.c[1] = ld4(gain + 8 * fq + 4); U.c[2] = ld4(gain + 32 + 8 * fq); U.c[3] = ld4(gain + 36 + 8 * fq); }
    }
    template <int T> DI void pre(RowPre& R, int row, int, int, int fq) const {
        if constexpr (T == 1) { const int i0 = 8 * (fq & 1); const float* cs = ropeCM(p) + (size_t)row * 16 + i0; const float* sn = ropeSM(p) + (size_t)row * 16 + i0;
            R.a[0] = ld4(cs); R.a[1] = ld4(cs + 4); R.a[2] = ld4(sn); R.a[3] = ld4(sn + 4); }
        if constexpr (T == 2 || T == 3) { const float* cs = ropeCN(p) + (size_t)row * 8; const float* sn = ropeSN(p) + (size_t)row * 8;
            R.a[0] = ld4(cs); R.a[1] = ld4(cs + 4); R.a[2] = ld4(sn); R.a[3] = ld4(sn + 4); }
    }
    DI void normrope(const ColPre& U, const RowPre& R, int fq, float (&v)[2][8], float post, bf16_t* dst) const {
        const float rstd = rsqrtf(ssq16(v) * (1.f / 64.f) + EPS);
#pragma unroll
        for (int b = 0; b < 2; ++b)
#pragma unroll
            for (int j = 0; j < 8; ++j) v[b][j] *= rstd * U.c[2 * b + (j >> 2)][j & 3];
#pragma unroll
        for (int j = 0; j < 8; ++j) { const float own = v[0][j], oth = xorl<16>(own); const float c = R.a[j >> 2][j & 3], s = R.a[2 + (j >> 2)][j & 3];
            if (fq == 0) v[0][j] = own * c - oth * s; else if (fq == 1) v[0][j] = own * c + oth * s; }
#pragma unroll
        for (int b = 0; b < 2; ++b) {
#pragma unroll
            for (int j = 0; j < 8; ++j) v[b][j] *= post;
            store8bf(dst + 32 * b + 8 * fq, v[b]); }
    }
    template <int T> DI void apply(const ColPre& U, const RowPre& R, int row, int pn, int wc, int fq, float (&v)[2][8]) const {
        const int s = 4 * pn + wc; (void)s;
        if constexpr (T == 0) {
            bf16_t* d = wsp<bf16_t>(p, WS_R1) + (size_t)row * 1024 + 64 * s + 8 * fq;
            const float q = ssq16(v); store8bf(d, v[0]); store8bf(d + 32, v[1]);
            if (fq == 0) wsp<float>(p, WS_SSQA)[(size_t)row * 16 + s] = q;
        } else if constexpr (T == 1) {
            float q = 0.f;
#pragma unroll
            for (int j = 0; j < 8; ++j) q += v[0][j] * v[0][j];
            q += xorl<16>(q); q = sum32(q);
            if (fq == 0) wsp<float>(p, WS_SSQPE)[row] = q;
            float o[8];
#pragma unroll
            for (int j = 0; j < 8; ++j) { const float own = v[0][j] * U.c[j >> 2][j & 3], oth = xor32(own, fq >> 1); const float c = R.a[j >> 2][j & 3], sn = R.a[2 + (j >> 2)][j & 3];
                o[j] = (fq < 2) ? own * c - oth * sn : own * c + oth * sn; }
            store8bf(wsp<bf16_t>(p, WS_KPE) + (size_t)row * 32 + 8 * fq, o);
#pragma unroll
            for (int j = 0; j < 8; ++j) o[j] = sigmoidf(v[1][j]);
            store8bf(wsp<bf16_t>(p, WS_GN) + (size_t)row * 32 + 8 * fq, o);
        } else if constexpr (T == 2) {
            normrope(U, R, fq, v, C2N, wsp<bf16_t>(p, WS_QN) + (size_t)row * 512 + 64 * (s - 17));
        } else if constexpr (T == 3 || T == 4) {
            const int t = (s - 25) >> 1, g = (s - 25) & 1;
            bf16_t* d = wsp<bf16_t>(p, WS_KC + (size_t)t * 4 * MiB) + (size_t)row * 128 + 64 * g;
            if constexpr (T == 3) normrope(U, R, fq, v, 1.0f, d);
            else { store8bf(d + 8 * fq, v[0]); store8bf(d + 32 + 8 * fq, v[1]); }
        } else if constexpr (T == 5) {
        } else {
            bf16_t* d = wsp<bf16_t>(p, WS_R2) + (size_t)row * 2048 + 64 * (s - 40) + 8 * fq;
#pragma unroll
            for (int b = 0; b < 2; ++b) { float o[8];
#pragma unroll
                for (int j = 0; j < 8; ++j) o[j] = sigmoidf(v[b][j]);
                store8bf(d + 32 * b, o); }
        }
    }
};
struct EpiQ {
    static constexpr bool HAS_MID = false; static constexpr int NTYPES = 1;
    Params p;
    DI int type(int, int) const { return 0; }
    DI void midpre(RowPre&, int, int, int, int) const {}
    DI void mid(const RowPre&, int, int, int, int, float (&)[2][8]) const {}
    template <int T> DI void ubegin(ColPre&, int, int, int, int) const {}
    template <int T> DI void pre(RowPre& R, int row, int, int, int) const { const float* sq = wsp<float>(p, WS_SSQA) + (size_t)row * 16; R.a[0] = ld4(sq); R.a[1] = ld4(sq + 4); R.a[2] = ld4(sq + 8); }
    template <int T> DI void apply(const ColPre&, const RowPre& R, int row, int pn, int wc, int fq, float (&v)[2][8]) const {
        const float s = ((R.a[0].x + R.a[0].y) + (R.a[0].z + R.a[0].w)) + ((R.a[1].x + R.a[1].y) + (R.a[1].z + R.a[1].w)) + ((R.a[2].x + R.a[2].y) + (R.a[2].z + R.a[2].w));
        const float rstd = rsqrtf(s * (1.f / 768.f) + EPS);
        bf16_t* d = wsp<bf16_t>(p, WS_R0) + (size_t)row * 768 + 256 * pn + 32 * wc + 8 * fq;
#pragma unroll
        for (int b = 0; b < 2; ++b) { float o[8];
#pragma unroll
            for (int j = 0; j < 8; ++j) o[j] = v[b][j] * rstd;
            store8bf(d + 128 * b, o); }
    }
};
struct EpiKV {
    static constexpr bool HAS_MID = false; static constexpr int NTYPES = 1;
    Params p;
    DI int type(int, int) const { return 0; }
    DI void midpre(RowPre&, int, int, int, int) const {}
    DI void mid(const RowPre&, int, int, int, int, float (&)[2][8]) const {}
    template <int T> DI void ubegin(ColPre&, int, int, int, int) const {}
    template <int T> DI void pre(RowPre& R, int row, int, int, int) const { R.a[0] = ld4(wsp<float>(p, WS_SSQA) + (size_t)row * 16 + 12); }
    template <int T> DI void apply(const ColPre&, const RowPre& R, int row, int pn, int wc, int fq, float (&v)[2][8]) const {
        const int s = 4 * pn + wc;
        const float rstd = rsqrtf(((R.a[0].x + R.a[0].y) + (R.a[0].z + R.a[0].w)) * (1.f / 256.f) + EPS);
#pragma unroll
        for (int b = 0; b < 2; ++b)
#pragma unroll
            for (int j = 0; j < 8; ++j) v[b][j] *= rstd;
        if (s < 8) { const float q = ssq16(v); if (fq == 0) wsp<float>(p, WS_SSQKN)[(size_t)row * 8 + s] = q;
            bf16_t* d = wsp<bf16_t>(p, WS_KN) + (size_t)row * 512 + 64 * s + 8 * fq; store8bf(d, v[0]); store8bf(d + 32, v[1]); }
        else { bf16_t* d = wsp<bf16_t>(p, WS_VM) + (size_t)row * 512 + 64 * (s - 8) + 8 * fq; store8bf(d, v[0]); store8bf(d + 32, v[1]); }
    }
};
struct EpiMerge {
    static constexpr bool HAS_MID = true; static constexpr int NTYPES = 1;
    Params p;
    DI int type(int, int) const { return 0; }
    DI void midpre(RowPre& R, int row, int pn, int wc, int fq) const {
        const bf16_t* g = wsp<bf16_t>(p, WS_R2) + (size_t)row * 2048 + 256 * pn + 32 * wc + 8 * fq;
        R.a[0] = ld4u(g); R.a[1] = ld4u(g + 128); R.a[2] = ld4u(g + 1024); R.a[3] = ld4u(g + 1024 + 128); }
    DI void mid(const RowPre& R, int, int, int, int, float (&v)[2][8]) const {
#pragma unroll
        for (int b = 0; b < 2; ++b) { float s1[8], s2[8]; un8(R.a[b], s1); un8(R.a[2 + b], s2);
#pragma unroll
            for (int j = 0; j < 8; ++j) v[b][j] *= s1[j] * __builtin_amdgcn_rcpf(s2[j]); }
    }
    template <int T> DI void ubegin(ColPre&, int, int, int, int) const {}
    template <int T> DI void pre(RowPre& R, int row, int pn, int wc, int fq) const {
        const bf16_t* g = wsp<bf16_t>(p, WS_R2) + (size_t)row * 2048 + 1024 + 256 * pn + 32 * wc + 8 * fq; R.a[0] = ld4u(g); R.a[1] = ld4u(g + 128); }
    template <int T> DI void apply(const ColPre&, const RowPre& R, int row, int pn, int wc, int fq, float (&v)[2][8]) const {
        bf16_t* d = wsp<bf16_t>(p, WS_R0) + (size_t)row * 1024 + 256 * pn + 32 * wc + 8 * fq;
#pragma unroll
        for (int b = 0; b < 2; ++b) { float s2[8], o[8]; un8(R.a[b], s2);
#pragma unroll
            for (int j = 0; j < 8; ++j) o[j] = v[b][j] * s2[j];
            store8bf(d + 128 * b, o); }
    }
};
struct EpiOut {
    static constexpr bool HAS_MID = false; static constexpr int NTYPES = 1;
    Params p;
    DI int type(int, int) const { return 0; }
    DI void midpre(RowPre&, int, int, int, int) const {}
    DI void mid(const RowPre&, int, int, int, int, float (&)[2][8]) const {}
    template <int T> DI void ubegin(ColPre& U, int row0, int pn, int wc, int fq) const {
        const int b_ = row0 / SEQ, col = 256 * pn + 32 * wc + 8 * fq; const float* md = wsp<float>(p, WS_MOD) + b_ * 6144 + col; const float* g2 = p.in[I_N2G] + col;
#pragma unroll
        for (int i = 0; i < 4; ++i) { const int o = 128 * (i >> 1) + 4 * (i & 1); U.c[i] = ld4(md + 2 * 1024 + o); const f32x4 sc = ld4(md + 4 * 1024 + o), gg = ld4(g2 + o); U.c[4 + i] = gg * (1.0f + sc); }
    }
    template <int T> DI void pre(RowPre& R, int row, int pn, int wc, int fq) const { const float* x = p.in[I_X] + (size_t)row * DM + 256 * pn + 32 * wc + 8 * fq;
        R.a[0] = ld4(x); R.a[1] = ld4(x + 4); R.a[2] = ld4(x + 128); R.a[3] = ld4(x + 132); }
    template <int T> DI void apply(const ColPre& U, const RowPre& R, int row, int pn, int wc, int fq, float (&v)[2][8]) const {
        const int col = 256 * pn + 32 * wc + 8 * fq; float* d = wsp<float>(p, WS_R2) + (size_t)row * DM + col; bf16_t* a2 = wsp<bf16_t>(p, WS_R1) + (size_t)row * DM + col;
        float q = 0.f;
#pragma unroll
        for (int b = 0; b < 2; ++b) { float o8[8];
#pragma unroll
            for (int h = 0; h < 2; ++h) { const f32x4 g = U.c[2 * b + h], xv = R.a[2 * b + h], gs = U.c[4 + 2 * b + h];
                f32x4 o; o.x = xv.x + g.x * v[b][4 * h]; o.y = xv.y + g.y * v[b][4 * h + 1]; o.z = xv.z + g.z * v[b][4 * h + 2]; o.w = xv.w + g.w * v[b][4 * h + 3]; *(f32x4*)(d + 128 * b + 4 * h) = o;
                q += (o.x * o.x + o.y * o.y) + (o.z * o.z + o.w * o.w);
                o8[4 * h] = o.x * gs.x; o8[4 * h + 1] = o.y * gs.y; o8[4 * h + 2] = o.z * gs.z; o8[4 * h + 3] = o.w * gs.w; }
            store8bf(a2 + 128 * b, o8); }
        q += xorl<16>(q); q = sum32(q);
        if (fq == 0) wsp<float>(p, WS_SSQA)[(size_t)row * 16 + 4 * pn + wc] = q;
    }
};
struct EpiGU {
    static constexpr bool HAS_MID = false; static constexpr int NTYPES = 1;
    Params p;
    DI int type(int, int) const { return 0; }
    DI void midpre(RowPre&, int, int, int, int) const {}
    DI void mid(const RowPre&, int, int, int, int, float (&)[2][8]) const {}
    template <int T> DI void ubegin(ColPre& U, int row0, int pn, int wc, int fq) const { const float* sh = wsp<float>(p, WS_SHW) + (row0 / SEQ) * 5632 + 256 * pn + 32 * wc + 8 * fq;
        U.c[0] = ld4(sh); U.c[1] = ld4(sh + 4); U.c[2] = ld4(sh + 128); U.c[3] = ld4(sh + 132); }
    template <int T> DI void pre(RowPre& R, int row, int, int, int) const { const float* sq = wsp<float>(p, WS_SSQA) + (size_t)row * 16; R.a[0] = ld4(sq); R.a[1] = ld4(sq + 4); R.a[2] = ld4(sq + 8); R.a[3] = ld4(sq + 12); }
    template <int T> DI void apply(const ColPre& U, const RowPre& R, int row, int pn, int wc, int fq, float (&v)[2][8]) const {
        const int s = 4 * pn + wc; float o[8];
        const float tot = (((R.a[0].x + R.a[0].y) + (R.a[0].z + R.a[0].w)) + ((R.a[1].x + R.a[1].y) + (R.a[1].z + R.a[1].w))) + (((R.a[2].x + R.a[2].y) + (R.a[2].z + R.a[2].w)) + ((R.a[3].x + R.a[3].y) + (R.a[3].z + R.a[3].w)));
        const float rstd = rsqrtf(tot * (1.f / DM) + EPS);
#pragma unroll
        for (int j = 0; j < 8; ++j) o[j] = siluf(rstd * v[0][j] + U.c[j >> 2][j & 3]) * (rstd * v[1][j] + U.c[2 + (j >> 2)][j & 3]);
        store8bf(wsp<bf16_t>(p, WS_HID) + (size_t)row * DFF + 32 * s + 8 * fq, o);
    }
};
struct EpiDown {
    static constexpr bool HAS_MID = false; static constexpr int NTYPES = 1;
    Params p;
    DI int type(int, int) const { return 0; }
    DI void midpre(RowPre&, int, int, int, int) const {}
    DI void mid(const RowPre&, int, int, int, int, float (&)[2][8]) const {}
    template <int T> DI void ubegin(ColPre& U, int row0, int pn, int wc, int fq) const { const float* gt = wsp<float>(p, WS_MOD) + (row0 / SEQ) * 6144 + 5 * 1024 + 256 * pn + 32 * wc + 8 * fq;
        U.c[0] = ld4(gt); U.c[1] = ld4(gt + 4); U.c[2] = ld4(gt + 128); U.c[3] = ld4(gt + 132); }
    template <int T> DI void pre(RowPre& R, int row, int pn, int wc, int fq) const { const float* x = wsp<float>(p, WS_R2) + (size_t)row * DM + 256 * pn + 32 * wc + 8 * fq;
        R.a[0] = ld4(x); R.a[1] = ld4(x + 4); R.a[2] = ld4(x + 128); R.a[3] = ld4(x + 132); }
    template <int T> DI void apply(const ColPre& U, const RowPre& R, int row, int pn, int wc, int fq, float (&v)[2][8]) const {
        float* d = p.out + (size_t)row * DM + 256 * pn + 32 * wc + 8 * fq;
#pragma unroll
        for (int b = 0; b < 2; ++b)
#pragma unroll
            for (int h = 0; h < 2; ++h) { const f32x4 g = U.c[2 * b + h], xv = R.a[2 * b + h];
                f32x4 o; o.x = xv.x + g.x * v[b][4 * h]; o.y = xv.y + g.y * v[b][4 * h + 1]; o.z = xv.z + g.z * v[b][4 * h + 2]; o.w = xv.w + g.w * v[b][4 * h + 3]; *(f32x4*)(d + 128 * b + 4 * h) = o; }
    }
};
namespace pg8 {
#define PG8_LAS __attribute__((address_space(3)))
typedef short bf16x8 __attribute__((ext_vector_type(8)));
constexpr int BM = 256, BK = 64, HALF = 128, HTB = HALF * BK * 2  , STAGE_BYTES = 8 * HTB, NXCD = 8, WGM = 8;

__host__ __device__ __forceinline__ int lds_byte(int r, int c) { const int st = (r >> 4) * 2 + (c >> 5), rr = r & 15, cc = c & 31, ob = rr * 64 + cc * 2; return st * 1024 + (ob ^ (((ob >> 9) & 1) << 5)); }
__host__ __device__ __forceinline__ void stage_rc(int b, int& R, int& C) { const int st = b / 1024, sb = b % 1024, swz = sb ^ (((sb >> 9) & 1) << 5); R = (st >> 1) * 16 + swz / 64; C = (st & 1) * 32 + (swz % 64) / 2; }
__host__ __device__ __forceinline__ int perm32(int rho) { const int n = rho >> 4, i = rho & 15; return 8 * (i >> 2) + 4 * n + (i & 3); }

struct Unit { int pm, pn; };
struct Gemm { const bf16_t* A; const bf16_t* Bt; int M, N, K, lda, ldb, kstepA; };

struct StaticOrder {
    int nM, nN, nwg, G, c;
    __host__ __device__ void init(int M, int N, int G_, int c_) { nM = M / BM; nN = N / BM; nwg = nM * nN; G = G_; c = c_; }
    __host__ __device__ bool next(int i, Unit& u) const {
        const long L = (long)i * G + c; if (L >= nwg) return false;
        int wgid = (int)L; { const int q = nwg / NXCD, r = nwg % NXCD, xcd = wgid % NXCD, off = wgid / NXCD; wgid = (xcd < r ? xcd * (q + 1) : r * (q + 1) + (xcd - r) * q) + off; }
        const int nig = WGM * nN, gid = wgid / nig, fm = gid * WGM, gsz = (nM - fm) < WGM ? (nM - fm) : WGM;
        u.pm = fm + ((wgid % nig) % gsz); u.pn = (wgid % nig) / gsz; return true;
    }
    __device__ __forceinline__ void a_ready(const Unit&) const {}
    __device__ __forceinline__ void done(const Unit&) const {}
};

template <class Epi, class Sched, bool ALIGN_EPI = false, bool SP2 = false>
__device__ __forceinline__ void gemm_phase(PG8_LAS unsigned char* lds, const Gemm g, const Sched& S, const Epi& E, int wid0) {
    const int tid = opaque_tid(wid0), wid = __builtin_amdgcn_readfirstlane(tid >> 6), lane = tid & 63, wr = wid >> 2, wc = wid & 3, fr = lane & 15, fq = lane >> 4;
    const int K = g.K; int nt = K / BK; asm volatile("" : "+s"(nt));
    unsigned voffA[2], voffB[2];
#pragma unroll
    for (int i = 0; i < 2; ++i) { int R, C; stage_rc(tid * 16 + i * 8192, R, C); const int Rb = Epi::PERM ? ((R & ~31) + perm32(R & 31)) : R;
        voffA[i] = (unsigned)(R * g.lda + C) * 2u; voffB[i] = (unsigned)(Rb * g.ldb + C) * 2u; }
    const size_t kstep = (size_t)(BK * 2), kstepA = (size_t)g.kstepA;
    const size_t hstepB = (size_t)HALF * g.ldb * 2, hstepA = (size_t)HALF * g.lda * 2;
    const size_t tstepB = 2 * hstepB, tstepA = 2 * hstepA;
    const unsigned ldsw = (unsigned)wid * 1024u;
    const int aoff = lds_byte(wr * 64 + fr, fq * 8), boff = lds_byte(wc * 32 + fr, fq * 8);
#define PG8_SA(b, h) (((b) * 2 + (h)) * HTB)
#define PG8_SB(b, h) ((4 + (b) * 2 + (h)) * HTB)
#define PG8_STAGE(bufoff, gbase, voff) do { _Pragma("unroll") for (int _i = 0; _i < 2; ++_i) \
        __builtin_amdgcn_global_load_lds((const unsigned*)((const char*)(gbase) + (voff)[_i]), (PG8_LAS unsigned*)(lds + (bufoff) + ldsw + _i * 8192), 16, 0, 0); } while (0)
#define PG8_LDA(dst, b, h) do { _Pragma("unroll") for (int m = 0; m < 4; ++m) _Pragma("unroll") for (int k = 0; k < 2; ++k) dst[m][k] = *(const PG8_LAS bf16x8*)(lds + PG8_SA(b, h) + aoff + m * 2048 + k * 1024); } while (0)
#define PG8_LDB(dst, b, h) do { _Pragma("unroll") for (int n = 0; n < 2; ++n) _Pragma("unroll") for (int k = 0; k < 2; ++k) dst[n][k] = *(const PG8_LAS bf16x8*)(lds + PG8_SB(b, h) + boff + n * 2048 + k * 1024); } while (0)
#define PG8_MMA(ai, bj, At, Bt) do { __builtin_amdgcn_s_setprio(1); _Pragma("unroll") for (int m = 0; m < 4; ++m) _Pragma("unroll") for (int n = 0; n < 2; ++n) _Pragma("unroll") for (int k = 0; k < 2; ++k) \
        acc[ai][bj][m][n] = __builtin_amdgcn_mfma_f32_16x16x32_bf16(Bt[n][k], At[m][k], acc[ai][bj][m][n], 0, 0, 0); __builtin_amdgcn_s_setprio(0); } while (0)
#define PG8_WAIT_V(n) asm volatile("s_waitcnt vmcnt(" #n ")" ::: "memory")
#define PG8_WAIT_L(n) asm volatile("s_waitcnt lgkmcnt(" #n ")" ::: "memory")
#define PG8_BAR __builtin_amdgcn_s_barrier()
#define PG8_SCHED __builtin_amdgcn_sched_barrier(0)
    Unit cur, nxt; int ui = 0;
    if (!S.next(0, cur)) return;
    f32x4 acc[2][2][4][2];
#pragma unroll
    for (int a = 0; a < 2; ++a)
#pragma unroll
        for (int b = 0; b < 2; ++b)
#pragma unroll
            for (int m = 0; m < 4; ++m)
#pragma unroll
                for (int n = 0; n < 2; ++n) acc[a][b][m][n] = (f32x4){0.f, 0.f, 0.f, 0.f};
    bf16x8 At[4][2], B0[2][2], B1[2][2];
    const char* cA = (const char*)g.A + (size_t)cur.pm * tstepA; const char* cB = (const char*)g.Bt + (size_t)cur.pn * tstepB;
    S.a_ready(cur);
    if constexpr (SP2) {
        PG8_STAGE(PG8_SB(0, 0), cB, voffB); PG8_STAGE(PG8_SB(0, 1), cB + hstepB, voffB); PG8_STAGE(PG8_SA(0, 0), cA, voffA); PG8_STAGE(PG8_SA(0, 1), cA + hstepA, voffA);
        if (wr == 1) PG8_BAR;
        PG8_WAIT_V(2); PG8_BAR;
        PG8_STAGE(PG8_SB(1, 0), cB + kstep, voffB); PG8_STAGE(PG8_SA(1, 0), cA + kstepA, voffA); PG8_STAGE(PG8_SB(1, 1), cB + hstepB + kstep, voffB);
        PG8_WAIT_V(6); PG8_BAR;
    } else {
        PG8_STAGE(PG8_SB(0, 0), cB, voffB); PG8_STAGE(PG8_SA(0, 0), cA, voffA); PG8_STAGE(PG8_SB(0, 1), cB + hstepB, voffB); PG8_STAGE(PG8_SA(0, 1), cA + hstepA, voffA);
        if (wr == 1) PG8_BAR;
        PG8_WAIT_V(4); PG8_BAR;
        PG8_STAGE(PG8_SB(1, 0), cB + kstep, voffB); PG8_STAGE(PG8_SA(1, 0), cA + kstepA, voffA); PG8_STAGE(PG8_SB(1, 1), cB + hstepB + kstep, voffB);
        PG8_WAIT_V(6); PG8_BAR;
    }
    for (;;) {
        const bool has_next = S.next(ui + 1, nxt);
        const char* nA = has_next ? (const char*)g.A + (size_t)nxt.pm * tstepA : cA; const char* nB = has_next ? (const char*)g.Bt + (size_t)nxt.pn * tstepB : cB;
        for (int hh_ = 0; hh_ < (Epi::HAS_MID ? 2 : 1); ++hh_) {
        if constexpr (Epi::HAS_MID) { if (hh_ == 1) E.mid(acc, cur, wr, wc, fr, fq); }
        const int t0_ = Epi::HAS_MID ? hh_ * (nt >> 1) : 0, t1_ = Epi::HAS_MID ? (hh_ + 1) * (nt >> 1) : nt;
        for (int t = t0_; t < t1_; t += 2) {
            const bool last = (t == nt - 2);
            const char* a1 = cA + (size_t)(t + 1) * kstepA;
            const char* a2 = last ? nA : cA + (size_t)(t + 2) * kstepA; const char* b2 = last ? nB : cB + (size_t)(t + 2) * kstep;
            const char* a3 = a2 + kstepA; const char* b3 = b2 + kstep;
            if (last && has_next) S.a_ready(nxt);
            if constexpr (SP2) {
            PG8_LDB(B0, 0, 0); PG8_LDB(B1, 0, 1); PG8_SCHED; PG8_LDA(At, 0, 0); PG8_STAGE(PG8_SA(1, 1), a1 + hstepA, voffA);
            PG8_WAIT_V(8); PG8_WAIT_L(0); PG8_BAR; PG8_MMA(0, 0, At, B0); PG8_MMA(0, 1, At, B1); PG8_BAR; PG8_SCHED;
            PG8_LDA(At, 0, 1); PG8_STAGE(PG8_SB(0, 0), b2, voffB); PG8_STAGE(PG8_SB(0, 1), b2 + hstepB, voffB); PG8_STAGE(PG8_SA(0, 0), a2, voffA);
            PG8_WAIT_V(8); PG8_WAIT_L(0); PG8_BAR; PG8_MMA(1, 0, At, B0); PG8_MMA(1, 1, At, B1); PG8_BAR; PG8_SCHED;
            PG8_LDB(B0, 1, 0); PG8_LDB(B1, 1, 1); PG8_SCHED; PG8_LDA(At, 1, 0); PG8_STAGE(PG8_SA(0, 1), a2 + hstepA, voffA);
            PG8_WAIT_V(8); PG8_WAIT_L(0); PG8_BAR; PG8_MMA(0, 0, At, B0); PG8_MMA(0, 1, At, B1); PG8_BAR; PG8_SCHED;
            PG8_LDA(At, 1, 1); PG8_STAGE(PG8_SB(1, 0), b3, voffB); PG8_STAGE(PG8_SB(1, 1), b3 + hstepB, voffB); PG8_STAGE(PG8_SA(1, 0), a3, voffA);
            PG8_WAIT_V(8); PG8_WAIT_L(0); PG8_BAR; PG8_MMA(1, 0, At, B0); PG8_MMA(1, 1, At, B1); PG8_BAR; PG8_SCHED;
            } else {
            PG8_LDB(B0, 0, 0); PG8_SCHED; PG8_LDA(At, 0, 0); PG8_STAGE(PG8_SA(1, 1), a1 + hstepA, voffA);
            PG8_WAIT_L(8); PG8_BAR; PG8_WAIT_L(0); PG8_MMA(0, 0, At, B0); PG8_BAR; PG8_SCHED;
            PG8_LDB(B1, 0, 1); PG8_STAGE(PG8_SB(0, 0), b2, voffB);
            PG8_BAR; PG8_WAIT_L(0); PG8_MMA(0, 1, At, B1); PG8_BAR;
            PG8_LDA(At, 0, 1); PG8_STAGE(PG8_SA(0, 0), a2, voffA);
            PG8_BAR; PG8_WAIT_L(0); PG8_MMA(1, 0, At, B0); PG8_BAR; PG8_SCHED;
            PG8_STAGE(PG8_SB(0, 1), b2 + hstepB, voffB);
            PG8_WAIT_V(6); PG8_BAR; PG8_MMA(1, 1, At, B1); PG8_BAR;
            PG8_LDB(B0, 1, 0); PG8_SCHED; PG8_LDA(At, 1, 0); PG8_STAGE(PG8_SA(0, 1), a2 + hstepA, voffA);
            PG8_WAIT_L(8); PG8_BAR; PG8_WAIT_L(0); PG8_MMA(0, 0, At, B0); PG8_BAR; PG8_SCHED;
            PG8_LDB(B1, 1, 1); PG8_STAGE(PG8_SB(1, 0), b3, voffB);
            PG8_BAR; PG8_WAIT_L(0); PG8_MMA(0, 1, At, B1); PG8_BAR;
            PG8_LDA(At, 1, 1); PG8_STAGE(PG8_SA(1, 0), a3, voffA);
            PG8_BAR; PG8_WAIT_L(0); PG8_MMA(1, 0, At, B0); PG8_BAR; PG8_SCHED;
            PG8_STAGE(PG8_SB(1, 1), b3 + hstepB, voffB);
            PG8_WAIT_V(6); PG8_BAR; PG8_MMA(1, 1, At, B1); PG8_BAR;
            }
        }
        }
        if constexpr (ALIGN_EPI) { if (wr == 0) PG8_BAR; }
        if constexpr (!Epi::AFTER_DRAIN) { E(acc, cur, wr, wc, fr, fq); S.done(cur); }
        if (!has_next) break;
#pragma unroll
        for (int a = 0; a < 2; ++a)
#pragma unroll
            for (int b = 0; b < 2; ++b)
#pragma unroll
                for (int m = 0; m < 4; ++m)
#pragma unroll
                    for (int n = 0; n < 2; ++n) acc[a][b][m][n] = (f32x4){0.f, 0.f, 0.f, 0.f};
        cur = nxt; cA = nA; cB = nB; ++ui;
        if constexpr (ALIGN_EPI) { if (wr == 1) PG8_BAR; }
    }
    PG8_WAIT_V(0);
    if constexpr (!ALIGN_EPI) { if (wr == 0) PG8_BAR; }
    PG8_BAR;
    if constexpr (Epi::AFTER_DRAIN) { E.fused(acc, cur, wr, wc, fr, fq, lds, wid, lane); S.done(cur); }
#undef PG8_SA
#undef PG8_SB
#undef PG8_STAGE
#undef PG8_LDA
#undef PG8_LDB
#undef PG8_MMA
#undef PG8_WAIT_V
#undef PG8_WAIT_L
#undef PG8_BAR
#undef PG8_SCHED
}
}

template <class SE> struct EpiAdapt {
    static constexpr bool PERM = true, AFTER_DRAIN = false, HAS_MID = SE::HAS_MID;
    SE se;
    template <int T> DI void run(f32x4 (&acc)[2][2][4][2], const pg8::Unit& u, int wr, int wc, int fr, int fq) const {
        int frr = fr; asm volatile("" : "+v"(frr));
        const int rbase = u.pm * 256 + wr * 64;
        ColPre U; se.template ubegin<T>(U, rbase, u.pn, wc, fq);
        RowPre R[2]; se.template pre<T>(R[0], rbase + frr, u.pn, wc, fq);
#pragma unroll
        for (int it = 0; it < 8; ++it) {
            const int ai = it >> 2, m = it & 3; const int row = rbase + ai * 128 + m * 16 + frr;
            if (it < 7) se.template pre<T>(R[(it + 1) & 1], rbase + ((it + 1) >> 2) * 128 + ((it + 1) & 3) * 16 + frr, u.pn, wc, fq);
            float v[2][8];
#pragma unroll
            for (int bj = 0; bj < 2; ++bj)
#pragma unroll
                for (int n = 0; n < 2; ++n) { v[bj][4 * n] = acc[ai][bj][m][n][0]; v[bj][4 * n + 1] = acc[ai][bj][m][n][1]; v[bj][4 * n + 2] = acc[ai][bj][m][n][2]; v[bj][4 * n + 3] = acc[ai][bj][m][n][3]; }
            se.template apply<T>(U, R[it & 1], row, u.pn, wc, fq, v);
        }
    }
    template <int T> DI void disp(int ty, f32x4 (&acc)[2][2][4][2], const pg8::Unit& u, int wr, int wc, int fr, int fq) const {
        if constexpr (T < SE::NTYPES) { if (ty == T) run<T>(acc, u, wr, wc, fr, fq); else disp<T + 1>(ty, acc, u, wr, wc, fr, fq); }
    }
    DI void operator()(f32x4 (&acc)[2][2][4][2], const pg8::Unit& u, int wr, int wc, int fr, int fq) const { disp<0>(se.type(u.pn, wc), acc, u, wr, wc, fr, fq); }
    DI void mid(f32x4 (&acc)[2][2][4][2], const pg8::Unit& u, int wr, int wc, int fr, int fq) const {
        int frr = fr; asm volatile("" : "+v"(frr));
        const int rbase = u.pm * 256 + wr * 64;
        RowPre R[2]; se.midpre(R[0], rbase + frr, u.pn, wc, fq);
#pragma unroll
        for (int it = 0; it < 8; ++it) {
            const int ai = it >> 2, m = it & 3; const int row = rbase + ai * 128 + m * 16 + frr;
            if (it < 7) se.midpre(R[(it + 1) & 1], rbase + ((it + 1) >> 2) * 128 + ((it + 1) & 3) * 16 + frr, u.pn, wc, fq);
            float v[2][8];
#pragma unroll
            for (int bj = 0; bj < 2; ++bj)
#pragma unroll
                for (int n = 0; n < 2; ++n) { v[bj][4 * n] = acc[ai][bj][m][n][0]; v[bj][4 * n + 1] = acc[ai][bj][m][n][1]; v[bj][4 * n + 2] = acc[ai][bj][m][n][2]; v[bj][4 * n + 3] = acc[ai][bj][m][n][3]; }
            se.mid(R[it & 1], row, u.pn, wc, fq, v);
#pragma unroll
            for (int bj = 0; bj < 2; ++bj)
#pragma unroll
                for (int n = 0; n < 2; ++n) { acc[ai][bj][m][n][0] = v[bj][4 * n]; acc[ai][bj][m][n][1] = v[bj][4 * n + 1]; acc[ai][bj][m][n][2] = v[bj][4 * n + 2]; acc[ai][bj][m][n][3] = v[bj][4 * n + 3]; }
        }
    }
};
template <class SE> DI void gemm_fast(PG8_LAS unsigned char* lds, const bf16_t* A, int lda, const bf16_t* Bt, int M, int N, int K, const SE& se, int G, int c, int wid0) {
    pg8::Gemm g{A, Bt, M, N, K, lda, K, 128}; pg8::StaticOrder S; S.init(M, N, G, c);
    EpiAdapt<SE> E{se};
    pg8::gemm_phase<EpiAdapt<SE>, pg8::StaticOrder, true, true>(lds, g, S, E, wid0);
}
struct RangeOrder {
    int base, cnt, nN;
    DI bool next(int i, pg8::Unit& u) const { if (i >= cnt) return false; const int L = base + i; u.pm = L / nN; u.pn = L % nN; return true; }
    DI void a_ready(const pg8::Unit&) const {}
    DI void done(const pg8::Unit&) const {}
};
template <class SE> DI void gemm_fast_range(PG8_LAS unsigned char* lds, const bf16_t* A, int lda, const bf16_t* Bt, int M, int N, int K, const SE& se, int base, int cnt, int wid0) {
    pg8::Gemm g{A, Bt, M, N, K, lda, K, 128}; RangeOrder S{base, cnt, N / 256};
    EpiAdapt<SE> E{se};
    pg8::gemm_phase<EpiAdapt<SE>, RangeOrder, true, true>(lds, g, S, E, wid0);
}
struct OneUnit {
    int pm, pn;
    DI bool next(int i, pg8::Unit& u) const { if (i > 0) return false; u.pm = pm; u.pn = pn; return true; }
    DI void a_ready(const pg8::Unit&) const {}
    DI void done(const pg8::Unit&) const {}
};
struct EpiCmpH {
    static constexpr bool HAS_MID = false; static constexpr int NTYPES = 1;
    float* H;
    DI int type(int, int) const { return 0; }
    DI void midpre(RowPre&, int, int, int, int) const {}
    DI void mid(const RowPre&, int, int, int, int, float (&)[2][8]) const {}
    template <int T> DI void ubegin(ColPre&, int, int, int, int) const {}
    template <int T> DI void pre(RowPre&, int, int, int, int) const {}
    template <int T> DI void apply(const ColPre&, const RowPre&, int row, int pn, int wc, int fq, float (&v)[2][8]) const {
        float* d = H + (size_t)row * 256 + 32 * wc + 8 * fq;
#pragma unroll
        for (int b = 0; b < 2; ++b) { *(f32x4*)(d + 128 * b) = (f32x4){v[b][0], v[b][1], v[b][2], v[b][3]}; *(f32x4*)(d + 128 * b + 4) = (f32x4){v[b][4], v[b][5], v[b][6], v[b][7]}; }
    }
};
DI void cmp_hidden_fast(const Params& p, PG8_LAS unsigned char* lds, int cu, int wid0) {
    const int kv = cu >> 4, g = (cu >> 3) & 1, pm = (cu >> 1) & 3, sp = cu & 1;
    const bf16_t* A = wsp<bf16_t>(p, kv ? WS_VC : WS_KC) + g * 64 + (size_t)(16 * sp) * 128;
    const bf16_t* Bt = wsp<bf16_t>(p, WS_CW1) + (size_t)kv * 256 * 2048 + 1024 * sp;
    pg8::Gemm gm{A, Bt, 1024, 256, 1024, 2048, 2048, 256}; OneUnit S{pm, 0};
    EpiCmpH se{wsp<float>(p, WS_CMPH) + (size_t)((kv * 2 + g) * 2 + sp) * 1024 * 256};
    EpiAdapt<EpiCmpH> E{se};
    pg8::gemm_phase<EpiAdapt<EpiCmpH>, OneUnit, true, true>(lds, gm, S, E, wid0);
}
template <bool SPLIT> DI void cmp_out(const Params& p, int gw, int ngw, int lane) {
    const float* H = wsp<float>(p, WS_CMPH);
    for (int u = gw; u < 2 * 2 * 1024; u += ngw) {
        const int r = u & 1023, g = (u >> 10) & 1, kv = u >> 11; const int b = r >> 7, n = r & 127;
        bf16_t* dst = wsp<bf16_t>(p, kv ? WS_VCF : WS_KCF) + (size_t)r * 128 + g * 64 + lane;
        if (n == 127) { *dst = 0; continue; }
        const float* w2 = (kv ? p.in[I_CW2V] : p.in[I_CW2K]) + lane;
        float acc = 0.f;
        if constexpr (SPLIT) {
            const float* h = H + ((size_t)((kv * 2 + g) * 2) * 1024 + r) * 256; const float* cb = wsp<float>(p, WS_CB1) + kv * 256;
            float hv[4];
#pragma unroll
            for (int q = 0; q < 4; ++q) { const int j = 64 * q + lane; hv[q] = siluf((h[j] + h[(size_t)1024 * 256 + j]) + cb[j]); }
#pragma unroll
            for (int q = 0; q < 4; ++q)
#pragma unroll
                for (int jj = 0; jj < 64; ++jj) acc += __int_as_float(__builtin_amdgcn_readlane(__float_as_int(hv[q]), jj)) * w2[(64 * q + jj) * 64];
        } else {
            const float* h = H + (size_t)u * 256;
            for (int j = 0; j < 256; ++j) acc += h[j] * w2[j * 64];
        }
        if (kv == 0) {
            const float rstd = rsqrtf(wave_sum(acc * acc) * (1.f / 64.f) + EPS);
            float y = acc * rstd * p.in[I_NKCG][lane];
            const int prow = b * SEQ + 16 * n + 31; const float oth = xorl<8>(y);
            if (lane < 16) { const float c = ropeCN(p)[(size_t)prow * 8 + (lane & 7)], s = ropeSN(p)[(size_t)prow * 8 + (lane & 7)]; y = (lane < 8) ? y * c - oth * s : y * c + oth * s; }
            acc = y;
        }
        *dst = (bf16_t)f2bf(acc);
    }
}

DI unsigned select_blocks(const float (&imp)[32], int cur) {
    if (cur < 8) return (2u << cur) - 1u;
    unsigned mask = 1u | (1u << cur) | (1u << (cur - 1));
#pragma unroll 1
    for (int it = 0; it < 5; ++it) {
        float best = -1.0f; int bi = 1;
#pragma unroll
        for (int j = 1; j < 32; ++j) { const bool ok = (j <= cur - 2) && !((mask >> j) & 1u); if (ok && imp[j] > best) { best = imp[j]; bi = j; } }
        mask |= 1u << bi;
    }
    return mask;
}

namespace fa {
typedef short bf16x8 __attribute__((ext_vector_type(8)));
typedef short s16x4 __attribute__((ext_vector_type(4)));
typedef float f32x16 __attribute__((ext_vector_type(16)));
typedef LAS const char* lds_cptr;
typedef LAS char* lds_ptr;
constexpr int KBUF = 12288, VBUF = 8192;
constexpr int L_K = 0, L_V = 2 * KBUF, L_RK = L_V + 2 * VBUF, L_WS = L_RK + 512, L_OST = L_WS + 8 * 256, L_END = L_OST + 8 * 4096;
#define FA_SBAR() __builtin_amdgcn_sched_barrier(0)
DI int crow(int r, int hi) { return (r & 3) + 8 * (r >> 2) + 4 * hi; }
typedef float f32x2_t __attribute__((ext_vector_type(2))); typedef __bf16 bf16x2_t __attribute__((ext_vector_type(2)));
DI unsigned cvtpk(float lo, float hi) { f32x2_t v = {lo, hi}; bf16x2_t b = __builtin_convertvector(v, bf16x2_t); return __builtin_bit_cast(unsigned, b); }

template <int DK> DI void qkt(f32x16& p0, f32x16& p1, lds_cptr kb, const bf16x8* qr) {
    f32x16 z;
#pragma unroll
    for (int i = 0; i < 16; ++i) z[i] = 0.f;
#pragma unroll
    for (int d0 = 0; d0 < DK / 16; ++d0) {
        const bf16x8 b0 = *(const LAS bf16x8*)(kb + d0 * 2048);
        const bf16x8 b1 = *(const LAS bf16x8*)(kb + d0 * 2048 + 512);
        if (d0 == 0) { p0 = __builtin_amdgcn_mfma_f32_32x32x16_bf16(b0, qr[0], z, 0, 0, 0); p1 = __builtin_amdgcn_mfma_f32_32x32x16_bf16(b1, qr[0], z, 0, 0, 0); }
        else { p0 = __builtin_amdgcn_mfma_f32_32x32x16_bf16(b0, qr[d0], p0, 0, 0, 0); p1 = __builtin_amdgcn_mfma_f32_32x32x16_bf16(b1, qr[d0], p1, 0, 0, 0); }
    }
}
DI void pv(f32x16* o, int vb, bf16x8 pa0, bf16x8 pa1, bf16x8 pa2, bf16x8 pa3) {
#pragma unroll
    for (int d0 = 0; d0 < 2; ++d0) { s16x4 lo[4], hi[4];
#pragma unroll
        for (int ks = 0; ks < 4; ++ks) {
            asm volatile("ds_read_b64_tr_b16 %0,%1 offset:%c2" : "=&v"(lo[ks]) : "v"(vb), "i"(d0 * 4096 + ks * 1024) : "memory");
            asm volatile("ds_read_b64_tr_b16 %0,%1 offset:%c2" : "=&v"(hi[ks]) : "v"(vb), "i"(d0 * 4096 + ks * 1024 + 512) : "memory"); }
        asm volatile("s_waitcnt lgkmcnt(0)" ::: "memory"); FA_SBAR();
#define FA_PK(k) (bf16x8){lo[k][0], lo[k][1], lo[k][2], lo[k][3], hi[k][0], hi[k][1], hi[k][2], hi[k][3]}
        o[d0] = __builtin_amdgcn_mfma_f32_32x32x16_bf16(pa0, FA_PK(0), o[d0], 0, 0, 0);
        o[d0] = __builtin_amdgcn_mfma_f32_32x32x16_bf16(pa1, FA_PK(1), o[d0], 0, 0, 0);
        o[d0] = __builtin_amdgcn_mfma_f32_32x32x16_bf16(pa2, FA_PK(2), o[d0], 0, 0, 0);
        o[d0] = __builtin_amdgcn_mfma_f32_32x32x16_bf16(pa3, FA_PK(3), o[d0], 0, 0, 0);
#undef FA_PK
    }
}
DI void pack_p(const f32x16& p0, const f32x16& p1, bf16x8& a0, bf16x8& a1, bf16x8& a2, bf16x8& a3) {
    u32x4 w0, w1, w2, w3;
    w0.x = cvtpk(p0[0], p0[1]); w0.y = cvtpk(p0[2], p0[3]); w0.z = cvtpk(p0[4], p0[5]); w0.w = cvtpk(p0[6], p0[7]);
    w1.x = cvtpk(p0[8], p0[9]); w1.y = cvtpk(p0[10], p0[11]); w1.z = cvtpk(p0[12], p0[13]); w1.w = cvtpk(p0[14], p0[15]);
    w2.x = cvtpk(p1[0], p1[1]); w2.y = cvtpk(p1[2], p1[3]); w2.z = cvtpk(p1[4], p1[5]); w2.w = cvtpk(p1[6], p1[7]);
    w3.x = cvtpk(p1[8], p1[9]); w3.y = cvtpk(p1[10], p1[11]); w3.z = cvtpk(p1[12], p1[13]); w3.w = cvtpk(p1[14], p1[15]);
    a0 = __builtin_bit_cast(bf16x8, w0); a1 = __builtin_bit_cast(bf16x8, w1); a2 = __builtin_bit_cast(bf16x8, w2); a3 = __builtin_bit_cast(bf16x8, w3);
}
DI void mask_range(f32x16& p0, f32x16& p1, int key0, int lo, int hi_, int hf) {
#pragma unroll
    for (int r = 0; r < 16; ++r) { const int k = key0 + crow(r, hf); if (k < lo || k > hi_) p0[r] = -INFINITY; if (k + 32 < lo || k + 32 > hi_) p1[r] = -INFINITY; }
}
DI float rowmax32(const f32x16& p0, const f32x16& p1) {
    float a = fmaxf(p0[0], p1[0]);
#pragma unroll
    for (int r = 1; r < 16; ++r) a = fmaxf(a, fmaxf(p0[r], p1[r]));
    return max32(a);
}
struct State { float m, l; f32x16 o[2]; };
DI void st_init(State& s) { s.m = -INFINITY; s.l = 0.f;
#pragma unroll
    for (int i = 0; i < 16; ++i) { s.o[0][i] = 0.f; s.o[1][i] = 0.f; } }
DI void softmax_pv(State& st, f32x16& p0, f32x16& p1, int vb, LAS float* wsf, int r32, int hf) {
    const float rm = rowmax32(p0, p1);
    const float mn = fmaxf(st.m, rm), mu = (mn == -INFINITY) ? 0.f : mn;
    const float alpha = __builtin_amdgcn_exp2f(st.m - mu);
    st.m = mn;
    float ls = 0.f;
#pragma unroll
    for (int r = 0; r < 16; ++r) { p0[r] = __builtin_amdgcn_exp2f(p0[r] - mu); p1[r] = __builtin_amdgcn_exp2f(p1[r] - mu); ls += p0[r] + p1[r]; }
    st.l = st.l * alpha + ls;
    if (__any(alpha != 1.0f)) {
        if (hf == 0) wsf[r32] = alpha;
        asm volatile("s_waitcnt lgkmcnt(0)" ::: "memory");
#pragma unroll
        for (int g = 0; g < 4; ++g) { const f32x4 a = *(const LAS f32x4*)(wsf + 8 * g + 4 * hf);
            st.o[0][4 * g] *= a.x; st.o[0][4 * g + 1] *= a.y; st.o[0][4 * g + 2] *= a.z; st.o[0][4 * g + 3] *= a.w;
            st.o[1][4 * g] *= a.x; st.o[1][4 * g + 1] *= a.y; st.o[1][4 * g + 2] *= a.z; st.o[1][4 * g + 3] *= a.w; }
    }
    bf16x8 a0, a1, a2, a3; pack_p(p0, p1, a0, a1, a2, a3);
    pv(st.o, vb, a0, a1, a2, a3);
}
DI void accum_scaled(f32x16* acc, const f32x16* o, float fac_row, LAS float* wsf, int r32, int hf) {
    if (hf == 0) wsf[32 + r32] = fac_row;
    asm volatile("s_waitcnt lgkmcnt(0)" ::: "memory");
#pragma unroll
    for (int g = 0; g < 4; ++g) { const f32x4 a = *(const LAS f32x4*)(wsf + 32 + 8 * g + 4 * hf);
        acc[0][4 * g] += o[0][4 * g] * a.x; acc[0][4 * g + 1] += o[0][4 * g + 1] * a.y; acc[0][4 * g + 2] += o[0][4 * g + 2] * a.z; acc[0][4 * g + 3] += o[0][4 * g + 3] * a.w;
        acc[1][4 * g] += o[1][4 * g] * a.x; acc[1][4 * g + 1] += o[1][4 * g + 1] * a.y; acc[1][4 * g + 2] += o[1][4 * g + 2] * a.z; acc[1][4 * g + 3] += o[1][4 * g + 3] * a.w; }
}
DI void stage_rows(const f32x16* acc, LAS bf16_t* stg, int r32, int hf) {
#pragma unroll
    for (int r = 0; r < 16; ++r) { const int orow = crow(r, hf);
        stg[orow * 64 + r32] = (bf16_t)f2bf(acc[0][r]); stg[orow * 64 + 32 + r32] = (bf16_t)f2bf(acc[1][r]); }
    asm volatile("s_waitcnt lgkmcnt(0)" ::: "memory");
}

DI void mla_unit(const Params& p, LAS unsigned char* lds, int b, int h, int qb, int wid0) {
    const int tid = opaque_tid(wid0), lane = tid & 63, r32 = lane & 31, hf = lane >> 5; const int wv = __builtin_amdgcn_readfirstlane(tid >> 6);
    const bf16_t* KN = wsp<bf16_t>(p, WS_KN); const bf16_t* KPE = wsp<bf16_t>(p, WS_KPE); const bf16_t* VM = wsp<bf16_t>(p, WS_VM);
    const float* sqk = wsp<float>(p, WS_SSQKN); const float* sqp = wsp<float>(p, WS_SSQPE); bf16_t* OC = wsp<bf16_t>(p, WS_R1);
    const int rowbase = b * SEQ, q0 = qb * 256, tq = q0 + wv * 32 + r32, row = rowbase + tq;
    LAS float* wsf = (LAS float*)(lds + L_WS) + wv * 64;
    bf16x8 qr[6];
    {
        const bf16_t* src = wsp<bf16_t>(p, WS_R0) + (size_t)row * 768 + h * 96 + 8 * hf; float q[6][8]; float ss = 0.f;
#pragma unroll
        for (int d0 = 0; d0 < 6; ++d0) { unpack8(*(const u32x4*)(src + 16 * d0), q[d0]);
#pragma unroll
            for (int e = 0; e < 8; ++e) ss += q[d0][e] * q[d0][e]; }
        ss = sum32(ss);
        const float rstd = rsqrtf(ss * (1.f / 96.f) + EPS); const float* qg = p.in[I_MQG] + 8 * hf; const float* kg = p.in[I_MKG] + 8 * hf;
#pragma unroll
        for (int d0 = 0; d0 < 6; ++d0)
#pragma unroll
            for (int e = 0; e < 8; ++e) q[d0][e] *= rstd * qg[16 * d0 + e];
        const float* cs = ropeCM(p) + (size_t)row * 16 + 8 * hf; const float* sn = ropeSM(p) + (size_t)row * 16 + 8 * hf;
#pragma unroll
        for (int e = 0; e < 8; ++e) { const float x1 = q[4][e], x2 = q[5][e]; q[4][e] = x1 * cs[e] - x2 * sn[e]; q[5][e] = x2 * cs[e] + x1 * sn[e]; }
#pragma unroll
        for (int d0 = 0; d0 < 6; ++d0) { float f[8];
#pragma unroll
            for (int e = 0; e < 8; ++e) f[e] = q[d0][e] * ((d0 < 4) ? kg[16 * d0 + e] * C2M : C2M);
            qr[d0] = __builtin_bit_cast(bf16x8, pack8(f)); }
    }
    State st; st_init(st);
    const int NT = 4 * (qb + 1);
    u32x4 ka, kb2, vv; float rk = 0.f;
    const bf16_t* kasrc = KN + (size_t)(rowbase + lane) * 512 + h * 64 + wv * 8;
    const bf16_t* kbsrc = KPE + (size_t)(rowbase + lane) * 32 + (wv & 3) * 8;
    const bf16_t* vsrc = VM + (size_t)(rowbase + 16 * (wv & 3) + (lane >> 2)) * 512 + h * 64 + (wv >> 2) * 32 + (lane & 3) * 8;
#define MLA_LOAD(t) do { ka = *(const u32x4*)(kasrc + (size_t)(t) * 64 * 512); if (wv < 4) kb2 = *(const u32x4*)(kbsrc + (size_t)(t) * 64 * 32); vv = *(const u32x4*)(vsrc + (size_t)(t) * 64 * 512); \
        if (tid < 64) { const int kr_ = rowbase + (t) * 64 + tid; rk = rsqrtf((sqk[(size_t)kr_ * 8 + h] + sqp[kr_]) * (1.f / 96.f) + EPS); } } while (0)
#define MLA_STORE(bf) do { *(LAS u32x4*)(lds + L_K + (bf) * KBUF + wv * 1024 + lane * 16) = ka; if (wv < 4) *(LAS u32x4*)(lds + L_K + (bf) * KBUF + (8 + wv) * 1024 + lane * 16) = kb2; \
        *(LAS u32x4*)(lds + L_V + (bf) * VBUF + wv * 1024 + lane * 16) = vv; if (tid < 64) *(LAS float*)(lds + L_RK + (bf) * 256 + tid * 4) = rk; } while (0)
    __syncthreads();
    MLA_LOAD(0); MLA_STORE(0); if (NT > 1) MLA_LOAD(1);
    const int vboff = ((lane >> 4) & 1) * 32 + (lane & 3) * 8 + (4 * hf + ((lane & 15) >> 2)) * 64;
    const int qlo = q0 + wv * 32;
    for (int i = 0; i < NT; ++i) {
        __syncthreads();
        if (i + 1 < NT) { MLA_STORE((i + 1) & 1); if (i + 2 < NT) MLA_LOAD(i + 2); }
        const int key0 = i * 64, bf = i & 1;
        if (key0 <= qlo + 31) {
            f32x16 p0, p1; qkt<96>(p0, p1, (lds_cptr)(lds + L_K + bf * KBUF) + hf * 1024 + r32 * 16, qr);
            const LAS float* rkp = (const LAS float*)(lds + L_RK + bf * 256);
#pragma unroll
            for (int g = 0; g < 4; ++g) { const f32x4 a = *(const LAS f32x4*)(rkp + 8 * g + 4 * hf), c = *(const LAS f32x4*)(rkp + 32 + 8 * g + 4 * hf);
                p0[4 * g] *= a.x; p0[4 * g + 1] *= a.y; p0[4 * g + 2] *= a.z; p0[4 * g + 3] *= a.w; p1[4 * g] *= c.x; p1[4 * g + 1] *= c.y; p1[4 * g + 2] *= c.z; p1[4 * g + 3] *= c.w; }
            if (key0 + 63 > qlo) mask_range(p0, p1, key0, 0, tq, hf);
            softmax_pv(st, p0, p1, (int)(uintptr_t)(lds + L_V + bf * VBUF) + vboff, wsf, r32, hf);
        }
    }
#undef MLA_LOAD
#undef MLA_STORE
    const float lt = sum32(st.l);
    f32x16 acc[2];
#pragma unroll
    for (int i = 0; i < 16; ++i) { acc[0][i] = 0.f; acc[1][i] = 0.f; }
    accum_scaled(acc, st.o, 1.0f / lt, wsf, r32, hf);
    LAS bf16_t* stg = (LAS bf16_t*)(lds + L_OST) + wv * 2048;
    stage_rows(acc, stg, r32, hf);
#pragma unroll
    for (int i = 0; i < 4; ++i) { const int rr = i * 8 + (lane >> 3), ch = lane & 7; const u32x4 v = *(const LAS u32x4*)(stg + rr * 64 + ch * 8);
        *(u32x4*)(OC + (size_t)(rowbase + q0 + wv * 32 + rr) * 1024 + h * 64 + ch * 8) = v; }
}

DI void nsa_unit(const Params& p, LAS unsigned char* lds, int b, int g, int c, int wid0) {
    const int tid = opaque_tid(wid0), lane = tid & 63, r32 = lane & 31, hf = lane >> 5; const int wv = __builtin_amdgcn_readfirstlane(tid >> 6);
    const bf16_t* QN = wsp<bf16_t>(p, WS_QN); const bf16_t* KCF = wsp<bf16_t>(p, WS_KCF); const bf16_t* VCF = wsp<bf16_t>(p, WS_VCF);
    const bf16_t* KS = wsp<bf16_t>(p, WS_KS); const bf16_t* VS = wsp<bf16_t>(p, WS_VS); const bf16_t* KW = wsp<bf16_t>(p, WS_KW); const bf16_t* VW = wsp<bf16_t>(p, WS_VW);
    const bf16_t* GN = wsp<bf16_t>(p, WS_GN); bf16_t* OC = wsp<bf16_t>(p, WS_R1);
    const int rowbase = b * SEQ, tt = 8 * wv + (r32 >> 2), hd = g * 4 + (r32 & 3), tq = 64 * c + tt, row = rowbase + tq;
    LAS float* wsf = (LAS float*)(lds + L_WS) + wv * 64;
    bf16x8 qr[4];
#pragma unroll
    for (int d0 = 0; d0 < 4; ++d0) qr[d0] = *(const bf16x8*)(QN + (size_t)row * 512 + hd * 64 + 16 * d0 + 8 * hf);
    const float g0 = bf2f(GN[(size_t)row * 32 + hd * 3 + 0]), g1 = bf2f(GN[(size_t)row * 32 + hd * 3 + 1]), g2 = bf2f(GN[(size_t)row * 32 + hd * 3 + 2]);
    f32x16 ot[2];
#pragma unroll
    for (int i = 0; i < 16; ++i) { ot[0][i] = 0.f; ot[1][i] = 0.f; }
    const int vboff = ((lane >> 4) & 1) * 32 + (lane & 3) * 8 + (4 * hf + ((lane & 15) >> 2)) * 64;
    u32x4 ka, vv;
#define NSA_LOAD(KB, VB, krow0) do { ka = *(const u32x4*)((KB) + (size_t)((krow0) + lane) * 128 + g * 64 + wv * 8); \
        vv = *(const u32x4*)((VB) + (size_t)((krow0) + 16 * (wv & 3) + (lane >> 2)) * 128 + g * 64 + (wv >> 2) * 32 + (lane & 3) * 8); } while (0)
#define NSA_STORE(koff, voff) do { *(LAS u32x4*)(lds + (koff) + wv * 1024 + lane * 16) = ka; *(LAS u32x4*)(lds + (voff) + wv * 1024 + lane * 16) = vv; } while (0)
    unsigned selmask;
    {
        const int ntile = (4 * c + 3 > 64) ? 2 : 1;
        const int nmax = (tq >= 31) ? ((tq - 31) >> 4) : -1;
        __syncthreads();
        NSA_LOAD(KCF, VCF, b * 128); NSA_STORE(L_K, L_V);
        if (ntile == 2) { NSA_LOAD(KCF, VCF, b * 128 + 64); NSA_STORE(L_K + 8192, L_V + 8192); }
        __syncthreads();
        f32x16 pa0, pa1, pb0, pb1;
        qkt<64>(pa0, pa1, (lds_cptr)(lds + L_K) + hf * 1024 + r32 * 16, qr); mask_range(pa0, pa1, 0, 0, nmax, hf);
        float m = rowmax32(pa0, pa1);
        if (ntile == 2) { qkt<64>(pb0, pb1, (lds_cptr)(lds + L_K + 8192) + hf * 1024 + r32 * 16, qr); mask_range(pb0, pb1, 64, 0, nmax, hf); m = fmaxf(m, rowmax32(pb0, pb1)); }
        else {
#pragma unroll
            for (int i = 0; i < 16; ++i) { pb0[i] = -INFINITY; pb1[i] = -INFINITY; } }
        const float mu = (m == -INFINITY) ? 0.f : m;
        float ls = 0.f;
#pragma unroll
        for (int r = 0; r < 16; ++r) { pa0[r] = __builtin_amdgcn_exp2f(pa0[r] - mu); pa1[r] = __builtin_amdgcn_exp2f(pa1[r] - mu); pb0[r] = __builtin_amdgcn_exp2f(pb0[r] - mu); pb1[r] = __builtin_amdgcn_exp2f(pb1[r] - mu);
            ls += (pa0[r] + pa1[r]) + (pb0[r] + pb1[r]); }
        ls = sum32(ls);
        const float rl = (ls > 0.f) ? 1.0f / ls : 0.f;
#pragma unroll
        for (int r = 0; r < 16; ++r) { pa0[r] *= rl; pa1[r] *= rl; pb0[r] *= rl; pb1[r] *= rl; }
        float own[16], ee[16];
#pragma unroll
        for (int q = 0; q < 4; ++q) {
            own[q] = (pa0[4 * q] + pa0[4 * q + 1]) + (pa0[4 * q + 2] + pa0[4 * q + 3]); ee[q] = pa0[4 * q + 3];
            own[4 + q] = (pa1[4 * q] + pa1[4 * q + 1]) + (pa1[4 * q + 2] + pa1[4 * q + 3]); ee[4 + q] = pa1[4 * q + 3];
            own[8 + q] = (pb0[4 * q] + pb0[4 * q + 1]) + (pb0[4 * q + 2] + pb0[4 * q + 3]); ee[8 + q] = pb0[4 * q + 3];
            own[12 + q] = (pb1[4 * q] + pb1[4 * q + 1]) + (pb1[4 * q + 2] + pb1[4 * q + 3]); ee[12 + q] = pb1[4 * q + 3]; }
        float eo[16];
#pragma unroll
        for (int k = 0; k < 16; ++k) eo[k] = xor32(ee[k], hf);
#pragma unroll
        for (int k = 0; k < 16; ++k) { const float add = hf ? eo[k] : ((k > 0) ? eo[k - 1] : 0.f); own[k] += add; }
#pragma unroll
        for (int k = 0; k < 16; ++k) { own[k] += xorl<1>(own[k]); own[k] += xorl<2>(own[k]); }
        float imp[32];
#pragma unroll
        for (int k = 0; k < 16; ++k) { const float oth = xor32(own[k], hf); imp[2 * k] = hf ? oth : own[k]; imp[2 * k + 1] = hf ? own[k] : oth; }
        selmask = select_blocks(imp, c);
        State sc; st_init(sc);
        { bf16x8 a0, a1, a2, a3; pack_p(pa0, pa1, a0, a1, a2, a3); pv(sc.o, (int)(uintptr_t)(lds + L_V) + vboff, a0, a1, a2, a3); }
        if (ntile == 2) { bf16x8 a0, a1, a2, a3; pack_p(pb0, pb1, a0, a1, a2, a3); pv(sc.o, (int)(uintptr_t)(lds + L_V + 8192) + vboff, a0, a1, a2, a3); }
        accum_scaled(ot, sc.o, g0, wsf, r32, hf);
    }
#pragma unroll 1
    for (int br = 1; br < 3; ++br) {
        const bf16_t* KB = (br == 1) ? KS : KW; const bf16_t* VB = (br == 1) ? VS : VW;
        const int NT = (br == 1) ? (c + 1) : ((c + 1 < 5) ? c + 1 : 5);
        const int lo = (br == 1) ? 0 : tq - 255;
        State st; st_init(st);
        __syncthreads();
        NSA_LOAD(KB, VB, rowbase + c * 64); NSA_STORE(L_K, L_V); if (NT > 1) NSA_LOAD(KB, VB, rowbase + (c - 1) * 64);
        for (int i = 0; i < NT; ++i) {
            __syncthreads();
            if (i + 1 < NT) { NSA_STORE(L_K + ((i + 1) & 1) * KBUF, L_V + ((i + 1) & 1) * VBUF); if (i + 2 < NT) NSA_LOAD(KB, VB, rowbase + (c - i - 2) * 64); }
            const int j = c - i, key0 = j * 64, bf = i & 1;
            const bool sel = (br == 2) || ((selmask >> j) & 1u);
            if (__any(sel)) {
                f32x16 p0, p1; qkt<64>(p0, p1, (lds_cptr)(lds + L_K + bf * KBUF) + hf * 1024 + r32 * 16, qr);
                if (br == 1) { if (i == 0) mask_range(p0, p1, key0, 0, tq, hf);
                    if (!sel) {
#pragma unroll
                        for (int r = 0; r < 16; ++r) { p0[r] = -INFINITY; p1[r] = -INFINITY; } } }
                else { if (i == 0 || i == 4) mask_range(p0, p1, key0, lo, tq, hf); }
                softmax_pv(st, p0, p1, (int)(uintptr_t)(lds + L_V + bf * VBUF) + vboff, wsf, r32, hf);
            }
        }
        const float lt = sum32(st.l);
        accum_scaled(ot, st.o, ((br == 1) ? g1 : g2) / lt, wsf, r32, hf);
    }
#undef NSA_LOAD
#undef NSA_STORE
    LAS bf16_t* stg = (LAS bf16_t*)(lds + L_OST) + wv * 2048;
    stage_rows(ot, stg, r32, hf);
#pragma unroll
    for (int i = 0; i < 4; ++i) { const int rr = i * 8 + (lane >> 3), ch = lane & 7; const u32x4 v = *(const LAS u32x4*)(stg + rr * 64 + ch * 8);
        *(u32x4*)(OC + (size_t)(rowbase + 64 * c + 8 * wv + (rr >> 2)) * 1024 + 512 + (g * 4 + (rr & 3)) * 64 + ch * 8) = v; }
}
#undef FA_SBAR
}

DI void stage_attn_fast(const Params& p, LAS unsigned char* lds, int bid, int nb, bool do_mla, bool do_nsa, int wid0) {
    if (do_mla) for (int u = bid; u < 256; u += nb) { const int bh = u >> 2, s = u & 3; fa::mla_unit(p, lds, bh >> 3, bh & 7, 7 - s, wid0); fa::mla_unit(p, lds, bh >> 3, bh & 7, s, wid0); }
    if (do_nsa) for (int u = bid; u < 256; u += nb) { const int bg = u >> 4, s = u & 15; fa::nsa_unit(p, lds, bg >> 1, bg & 1, 31 - s, wid0); fa::nsa_unit(p, lds, bg >> 1, bg & 1, s, wid0); }
    __syncthreads();
}
#define XB_TMO      128
#define XB_XCNT(j)  (256  + 64 * (j))
#define XB_XSUB(j)  (1280 + 64 * (j))
#define XB_XGEN(j)  (2304 + 64 * (j))
#define XB_TOP      3328
#define XB_TOPGEN   3392
#define XCD_BAR_WORDS 3456
#define XB_SPIN_CAP (1u << 18)

__device__ __forceinline__ unsigned xb_ld(unsigned* p)              { return __hip_atomic_load(p, __ATOMIC_RELAXED, __HIP_MEMORY_SCOPE_AGENT); }
__device__ __forceinline__ unsigned xb_add(unsigned* p, unsigned v) { return __hip_atomic_fetch_add(p, v, __ATOMIC_RELAXED, __HIP_MEMORY_SCOPE_AGENT); }
__device__ __forceinline__ unsigned xb_xcc_id() { return (unsigned)__builtin_amdgcn_s_getreg((3 << 11) | 20) & 0xFu; }
#define XB_SPIN(cond, bar) do { unsigned _sp = 0; while (cond) { __builtin_amdgcn_s_sleep(1); \
    if ((++_sp & 255u) == 0u) { if (xb_ld(&(bar)[XB_TMO])) break; if (_sp > XB_SPIN_CAP) { atomicAdd(&(bar)[XB_TMO], 1u); break; } } } } while (0)

struct XcdBarrier {
    unsigned* bar; unsigned x;
    volatile LAS unsigned* st;
};

__device__ __forceinline__ XcdBarrier xcd_barrier_post(unsigned* bar, volatile LAS unsigned* st, bool t0) {
    XcdBarrier b; b.bar = bar; b.x = xb_xcc_id(); b.st = st;
    if (t0) (void)xb_add(&bar[XB_XCNT(b.x)], 1u);
    return b;
}
__device__ __forceinline__ void xcd_barrier_complete(unsigned* bar, unsigned x, unsigned& nloc, unsigned& nx) {
    const unsigned G = gridDim.x * gridDim.y * gridDim.z;
    unsigned sum, cnt, mine, sp = 0u;
    for (;;) {
        sum = 0u; cnt = 0u; mine = 0u;
#pragma unroll
        for (unsigned j = 0; j < 16; ++j) { const unsigned c = xb_ld(&bar[XB_XCNT(j)]); sum += c; cnt += (c > 0u) ? 1u : 0u; mine = (j == x) ? c : mine; }
        if (sum == G) break;
        __builtin_amdgcn_s_sleep(1);
        if ((++sp & 255u) == 0u) { if (xb_ld(&bar[XB_TMO])) break; if (sp > XB_SPIN_CAP) { atomicAdd(&bar[XB_TMO], 1u); break; } }
    }
    nloc = mine > 0u ? mine : 1u; nx = cnt > 0u ? cnt : 1u;
}

__device__ __forceinline__ void xcd_barrier(const XcdBarrier& b, bool t0) {
    asm volatile("s_waitcnt vmcnt(0)" ::: "memory");
    __syncthreads();
    if (t0) {
        unsigned* bar = b.bar;
        __builtin_amdgcn_s_waitcnt(0);
        unsigned nloc = b.st[0], nx = b.st[1];
        if (nloc == 0u) { xcd_barrier_complete(bar, b.x, nloc, nx); b.st[0] = nloc; b.st[1] = nx; }
        const unsigned old = xb_add(&bar[XB_XSUB(b.x)], 1u);
        const unsigned gen = old / nloc;
        if (old + 1u == (gen + 1u) * nloc) {
            __builtin_amdgcn_fence(__ATOMIC_RELEASE, "agent");
            asm volatile("s_waitcnt vmcnt(0)" ::: "memory");
            const unsigned og = xb_add(&bar[XB_TOP], 1u);
            const unsigned tg = og / nx;
            if (og + 1u == (tg + 1u) * nx) xb_add(&bar[XB_TOPGEN], 1u);
            else XB_SPIN(xb_ld(&bar[XB_TOPGEN]) == tg, bar);
            __builtin_amdgcn_fence(__ATOMIC_ACQUIRE, "agent");
            xb_add(&bar[XB_XGEN(b.x)], 1u);
            asm volatile("s_waitcnt vmcnt(0)" ::: "memory");
        } else {
            XB_SPIN(xb_ld(&bar[XB_XGEN(b.x)]) == gen, bar);
            __builtin_amdgcn_fence(__ATOMIC_ACQUIRE, "agent");
            asm volatile("s_waitcnt vmcnt(0)" ::: "memory");
        }
    }
    __syncthreads();
}
constexpr int LDS_BYTES = 147456;
#ifndef REPEAT_PHASE
#define REPEAT_PHASE -1
#endif
#define REP(k) for (int rep_ = 0; rep_ < ((REPEAT_PHASE == (k)) ? 2 : 1); ++rep_)
#ifndef USE_CG_SYNC
#define USE_CG_SYNC 0
#endif

typedef const Params __attribute__((address_space(4)))* KParamsPtr;
#if defined(__HIP_DEVICE_COMPILE__)
DI KParamsPtr kparams() { KParamsPtr k = (KParamsPtr)__builtin_amdgcn_kernarg_segment_ptr(); asm volatile("" : "+s"(k)); return k; }
#endif
#if defined(__HIP_DEVICE_COMPILE__)
#define PHASE_PARAMS() const Params p = *kparams()
#else
#define PHASE_PARAMS() const Params p = p_arg
#endif
__global__ void __launch_bounds__(512, 2) fwd_megakernel(Params p_arg) {
    extern __shared__ __attribute__((aligned(16))) unsigned char dlds[];
    LAS unsigned char* lds = (LAS unsigned char*)dlds;
#if USE_CG_SYNC
    cg::grid_group grid = cg::this_grid();
#endif
    const int G = gridDim.x, c = blockIdx.x, ngw = G * NWAVE, ngt = G * NTHR;
    const int wid0 = __builtin_amdgcn_readfirstlane(threadIdx.x >> 6);
#define TIDS() const int tid = opaque_tid(wid0), lane = tid & 63, wave = tid >> 6, gw = c * NWAVE + wave, gtid = c * NTHR + tid; (void)lane; (void)gw; (void)gtid
#if USE_CG_SYNC
#define GRID_SYNC() grid.sync()
#else
    volatile LAS unsigned* MISC = (volatile LAS unsigned*)(lds + 131072 + 320);
    { TIDS(); if (tid < 32) MISC[tid] = 0u; }
    __syncthreads();
    XcdBarrier bar;
    { PHASE_PARAMS(); TIDS(); bar = xcd_barrier_post((unsigned*)(p.ws + WS_CTL) + 4096, MISC + 8, tid == 0); }
#ifdef DOUBLE_BAR
#define GRID_SYNC() do { TIDS(); xcd_barrier(bar, tid == 0); xcd_barrier(bar, tid == 0); } while (0)
#else
#define GRID_SYNC() do { TIDS(); xcd_barrier(bar, tid == 0); } while (0)
#endif
#endif
    REP(0) { PHASE_PARAMS();
    { TIDS(); stage_weights(p, gw, ngw, (float*)dlds + wave * (64 * 33), lane); }
    __syncthreads();
    stage_mod(p, c, G, (float*)dlds, wid0);
    __syncthreads();
    { TIDS(); stage_rope(p, tid, gtid, ngt, (float*)dlds + 16384); } }
    GRID_SYNC();
    REP(1) { PHASE_PARAMS(); TIDS(); stage_normmod(p.in[I_X], p.in[I_N1G], wsp<float>(p, WS_MOD), 0, 1, wsp<bf16_t>(p, WS_R0), gw, ngw, lane); stage_shw(p, gw, ngw, lane); }
    GRID_SYNC();
    REP(2) { PHASE_PARAMS(); EpiZ E{p}; gemm_fast(lds, wsp<bf16_t>(p, WS_R0), 1024, wsp<bf16_t>(p, WS_WIN), MT, ZN, 1024, E, G, c, wid0); }
    GRID_SYNC();
    REP(3) { PHASE_PARAMS();
      int qb, qc, kb, kc;
      if (G == 256) { qb = c; qc = (c < 192) ? 1 : 0; kb = (c < 192) ? c : (c >= 224 ? 192 + 2 * (c - 224) : 0); kc = (c < 192) ? 1 : (c >= 224 ? 2 : 0); }
      else { const int pq = (192 + G - 1) / G, pk = (256 + G - 1) / G; qb = c * pq; qc = (192 - qb < pq) ? ((192 - qb > 0) ? 192 - qb : 0) : pq; kb = c * pk; kc = (256 - kb < pk) ? ((256 - kb > 0) ? 256 - kb : 0) : pk; }
      { EpiQ E{p}; gemm_fast_range(lds, wsp<bf16_t>(p, WS_R1), 1024, wsp<bf16_t>(p, WS_WQB), MT, 768, 768, E, qb, qc, wid0); }
      for (int cu = (c + 64) % G; cu < 32; cu += G) cmp_hidden_fast(p, lds, cu, wid0);
      { EpiKV E{p}; gemm_fast_range(lds, wsp<bf16_t>(p, WS_R1) + 768, 1024, wsp<bf16_t>(p, WS_WKVB), MT, 1024, 256, E, kb, kc, wid0); }
    }
    GRID_SYNC();
    { PHASE_PARAMS(); TIDS(); cmp_out<true>(p, gw, ngw, lane); }
    REP(4) { PHASE_PARAMS(); stage_attn_fast(p, lds, c, G, true, false, wid0); }
    GRID_SYNC();
    REP(5) { PHASE_PARAMS(); stage_attn_fast(p, lds, c, G, false, true, wid0); }
    GRID_SYNC();
    REP(6) { PHASE_PARAMS(); EpiMerge E{p}; gemm_fast(lds, wsp<bf16_t>(p, WS_R1), 1024, wsp<bf16_t>(p, WS_WO), MT, 1024, 1024, E, G, c, wid0); }
    GRID_SYNC();
    REP(7) { PHASE_PARAMS(); EpiOut E{p}; gemm_fast(lds, wsp<bf16_t>(p, WS_R0), 1024, wsp<bf16_t>(p, WS_WOUT), MT, 1024, 1024, E, G, c, wid0); }
    GRID_SYNC();
    REP(9) { PHASE_PARAMS(); EpiGU E{p}; gemm_fast(lds, wsp<bf16_t>(p, WS_R1), 1024, wsp<bf16_t>(p, WS_WGU), MT, 5632, 1024, E, G, c, wid0); }
    GRID_SYNC();
    REP(10) { PHASE_PARAMS(); EpiDown E{p}; gemm_fast(lds, wsp<bf16_t>(p, WS_HID), DFF, wsp<bf16_t>(p, WS_WD), MT, 1024, DFF, E, G, c, wid0); }
}

extern "C" void kernel_launch(void* const* d_in, const int* in_sizes, int n_in, void* d_out, int out_size, void* d_ws, size_t ws_size, hipStream_t stream) {
    if (n_in != 30 || out_size != MT * DM || ws_size < WS_END) { fprintf(stderr, "kernel_launch: unexpected shapes (n_in %d out %d ws %zu)\n", n_in, out_size, ws_size); return; }
    static int grid = 0;
    if (grid == 0) {
        int dev = 0, cus = 0, per_cu = 0;
        hipGetDevice(&dev); hipDeviceGetAttribute(&cus, hipDeviceAttributeMultiprocessorCount, dev);
        hipFuncSetAttribute((const void*)fwd_megakernel, hipFuncAttributeMaxDynamicSharedMemorySize, LDS_BYTES);
        hipOccupancyMaxActiveBlocksPerMultiprocessor(&per_cu, (const void*)fwd_megakernel, NTHR, LDS_BYTES);
        if (per_cu < 1) { fprintf(stderr, "kernel_launch: occupancy query says %d blocks per CU\n", per_cu); per_cu = 1; }
        grid = cus;
        (void)hipGetLastError();
    }
    Params p{};
    for (int i = 0; i < 30; ++i) p.in[i] = (const float*)d_in[i];
    p.out = (float*)d_out; p.ws = (unsigned char*)d_ws;
    if (!USE_CG_SYNC) (void)hipMemsetAsync((char*)d_ws + WS_CTL, 0, 65536, stream);
    void* args[] = {&p};
#ifndef USE_COOP
#define USE_COOP 1
#endif
    hipError_t e;
    if (USE_COOP) e = hipLaunchCooperativeKernel((const void*)fwd_megakernel, dim3(grid), dim3(NTHR), args, LDS_BYTES, stream);
    else { hipLaunchKernelGGL(fwd_megakernel, dim3(grid), dim3(NTHR), LDS_BYTES, stream, p); e = hipPeekAtLastError(); }
    if (e != hipSuccess) fprintf(stderr, "kernel_launch: cooperative launch failed: %s (grid %d)\n", hipGetErrorString(e), grid);
}
```

```cpp
#include <hip/hip_runtime.h>
#include <hip/hip_cooperative_groups.h>
#include <cstdint>
#include <cstdio>
namespace cg = cooperative_groups;

typedef unsigned short bf16_t;
typedef unsigned u32x4 __attribute__((ext_vector_type(4)));
typedef unsigned u32x2 __attribute__((ext_vector_type(2)));
typedef float f32x4 __attribute__((ext_vector_type(4)));
typedef float f32x2 __attribute__((ext_vector_type(2)));
#define DI __device__ __forceinline__

constexpr int NB = 8, SEQ = 2048, DM = 1024, MT = NB * SEQ;
constexpr int DFF = 2816, NMOD = 6;
constexpr int ZN = 4608;
constexpr float EPS = 1e-6f;
constexpr float LOG2E = 1.4426950408889634f;
constexpr float C2N = 0.125f * LOG2E;
constexpr float C2M = 0.10206207261596575f * LOG2E;
constexpr int NTHR = 512, NWAVE = 8;
constexpr int O_CQ = 0, O_CKV = 768, O_KPE = 1024, O_QN = 1056, O_KC = 1568, O_VC = 1696, O_KS = 1824, O_VS = 1952, O_KW = 2080, O_VW = 2208,
              O_GN = 2336, O_GM = 2360, O_GNM = 3384, D_IN = 4408;

constexpr size_t MiB = 1u << 20;
constexpr size_t WS_CTL = 0;
constexpr size_t WS_MOD = 1 * MiB;
constexpr size_t WS_CB1 = 1 * MiB + 256 * 1024;
constexpr size_t WS_SSQPE = 1 * MiB + 320 * 1024;
constexpr size_t WS_SSQKN = 1 * MiB + 512 * 1024;
constexpr size_t WS_SSQA = 2 * MiB;
constexpr size_t WS_KCF = 3 * MiB;
constexpr size_t WS_VCF = 3 * MiB + 256 * 1024;
constexpr size_t WS_SHW = 3 * MiB + 512 * 1024;
constexpr size_t WS_WIN = 4 * MiB;
constexpr size_t WS_WQB = 13 * MiB;
constexpr size_t WS_WKVB = 15 * MiB;
constexpr size_t WS_WO = 16 * MiB;
constexpr size_t WS_WOUT = 18 * MiB;
constexpr size_t WS_WGU = 20 * MiB;
constexpr size_t WS_WD = 31 * MiB;
constexpr size_t WS_CW1 = 37 * MiB;
constexpr size_t WS_R0 = 40 * MiB;
constexpr size_t WS_R1 = 72 * MiB;
constexpr size_t WS_R2 = 104 * MiB;
constexpr size_t WS_QN = 168 * MiB;
constexpr size_t WS_KC = 184 * MiB, WS_VC = 188 * MiB, WS_KS = 192 * MiB, WS_VS = 196 * MiB, WS_KW = 200 * MiB, WS_VW = 204 * MiB;
constexpr size_t WS_KPE = 208 * MiB;
constexpr size_t WS_GN = 209 * MiB;
constexpr size_t WS_KN = 210 * MiB;
constexpr size_t WS_VM = 234 * MiB;
constexpr size_t WS_CMPH = 64 * MiB;
constexpr size_t WS_ROPE = 250 * MiB;
constexpr size_t WS_HID = 168 * MiB;
constexpr size_t WS_END = 256 * MiB;

struct Params {
    const float* in[30];
    float* out;
    unsigned char* ws;
};
enum { I_X = 0, I_C, I_POS, I_ADAW, I_ADAB, I_N1G, I_WIN, I_QAG, I_WQB, I_KVAG, I_WKVB, I_MQG, I_MKG, I_NQG, I_NKCG, I_NKSG, I_NKWG,
       I_CPK, I_CW1K, I_CW2K, I_CPV, I_CW1V, I_CW2V, I_WOM, I_WON, I_WOUT, I_N2G, I_WG, I_WU, I_WDN };

template <class T> DI T* wsp(const Params& p, size_t off) { return (T*)(p.ws + off); }

DI int lane_id() { return (int)__builtin_amdgcn_mbcnt_hi(~0u, __builtin_amdgcn_mbcnt_lo(~0u, 0u)); }
DI int opaque_tid(int wid0) { int l = lane_id(); asm volatile("" : "+v"(l)); return (wid0 << 6) | l; }
DI unsigned f2bf(float f) { unsigned u = __float_as_uint(f); return (u + 0x7fffu + ((u >> 16) & 1u)) >> 16; }
DI unsigned pk2(float lo, float hi) { return f2bf(lo) | (f2bf(hi) << 16); }
DI float bf2f(unsigned short b) { return __uint_as_float(((unsigned)b) << 16); }
DI float bflo(unsigned w) { return __uint_as_float(w << 16); }
DI float bfhi(unsigned w) { return __uint_as_float(w & 0xffff0000u); }
DI void unpack8(const u32x4 w, float (&f)[8]) { f[0] = bflo(w.x); f[1] = bfhi(w.x); f[2] = bflo(w.y); f[3] = bfhi(w.y); f[4] = bflo(w.z); f[5] = bfhi(w.z); f[6] = bflo(w.w); f[7] = bfhi(w.w); }
DI u32x4 pack8(const float (&f)[8]) { u32x4 w; w.x = pk2(f[0], f[1]); w.y = pk2(f[2], f[3]); w.z = pk2(f[4], f[5]); w.w = pk2(f[6], f[7]); return w; }
DI float sigmoidf(float x) { return __builtin_amdgcn_rcpf(1.0f + __expf(-x)); }
DI float siluf(float x) { return x * __builtin_amdgcn_rcpf(1.0f + __expf(-x)); }
template <int X> DI float xorl(float v) { return __int_as_float(__builtin_amdgcn_ds_swizzle(__float_as_int(v), (X << 10) | 0x1f)); }
DI void halves(float v, float& lo, float& hi) { auto rr = __builtin_amdgcn_permlane32_swap(__float_as_uint(v), __float_as_uint(v), false, false); lo = __uint_as_float(rr[0]); hi = __uint_as_float(rr[1]); }
DI float xor32(float v, int hf) { float lo, hi; halves(v, lo, hi); return hf ? lo : hi; }
DI float sum32(float v) { float lo, hi; halves(v, lo, hi); return lo + hi; }
DI float max32(float v) { float lo, hi; halves(v, lo, hi); return fmaxf(lo, hi); }
DI float wave_sum(float v) { v += xorl<1>(v); v += xorl<2>(v); v += xorl<4>(v); v += xorl<8>(v); v += xorl<16>(v); return sum32(v); }
DI void sincos_rad(float ang, float& c, float& s) {
    double rev = (double)ang * 0.15915494309189535; rev -= __builtin_rint(rev);
    const float fr = (float)rev; s = __builtin_amdgcn_sinf(fr); c = __builtin_amdgcn_cosf(fr);
}
#define LAS __attribute__((address_space(3)))
DI void transpose_item(const float* W, int ldw, int c0, int ncols, const float* rs, bf16_t* dst, int ldd, int n0, int k0, float* scr, int lane) {
    const int cc = lane & 31, kh = lane >> 5;
    float v[32];
    if (c0 >= 0) {
        const float* src = W + (size_t)(k0 + kh) * ldw + c0 + cc;
        if (cc < ncols) {
#pragma unroll
            for (int i = 0; i < 32; ++i) v[i] = src[(size_t)(2 * i) * ldw];
        } else {
#pragma unroll
            for (int i = 0; i < 32; ++i) v[i] = 0.f;
        }
        if (rs) {
#pragma unroll
            for (int i = 0; i < 32; ++i) v[i] *= rs[k0 + 2 * i + kh];
        }
    } else {
#pragma unroll
        for (int i = 0; i < 32; ++i) v[i] = 0.f;
    }
#pragma unroll
    for (int i = 0; i < 32; ++i) scr[(2 * i + kh) * 33 + cc] = v[i];
    __builtin_amdgcn_s_waitcnt(0xc07f);
    asm volatile("" ::: "memory");
    const int c = lane & 7;
#pragma unroll
    for (int j = 0; j < 4; ++j) { const int n = (lane >> 3) + 8 * j; const float* s = scr + (8 * c) * 33 + n;
        u32x4 o; o.x = pk2(s[0 * 33], s[1 * 33]); o.y = pk2(s[2 * 33], s[3 * 33]); o.z = pk2(s[4 * 33], s[5 * 33]); o.w = pk2(s[6 * 33], s[7 * 33]);
        *(u32x4*)(dst + (size_t)(n0 + n) * ldd + k0 + 8 * c) = o; }
    __builtin_amdgcn_s_waitcnt(0xc07f);
    asm volatile("" ::: "memory");
}
DI int zsrc(int s, int L0, int& ncols) {
    ncols = 32;
    if (s < 16) return 64 * s + L0;
    if (s == 16) { if (L0 == 0) return O_KPE; ncols = 24; return O_GN; }
    if (s < 25) return O_QN + 64 * (s - 17) + L0;
    if (s < 27) return O_KC + 64 * (s - 25) + L0;
    if (s < 29) return O_VC + 64 * (s - 27) + L0;
    if (s < 31) return O_KS + 64 * (s - 29) + L0;
    if (s < 33) return O_VS + 64 * (s - 31) + L0;
    if (s < 35) return O_KW + 64 * (s - 33) + L0;
    if (s < 37) return O_VW + 64 * (s - 35) + L0;
    if (s < 40) return -1;
    if (s < 56) return O_GM + 64 * (s - 40) + L0;
    return O_GNM + 64 * (s - 56) + L0;
}
DI void stage_weights(const Params& p, int gw, int ngw, float* scr, int lane) {
    constexpr int I_IN = (ZN / 32) * (DM / 64);
    constexpr int I_QB = (768 / 32) * (768 / 64);
    constexpr int I_KVB = (1024 / 32) * (256 / 64);
    constexpr int I_O = (1024 / 32) * (1024 / 64);
    constexpr int I_OUT = I_O;
    constexpr int I_GU = (5632 / 32) * (1024 / 64);
    constexpr int I_D = (1024 / 32) * (DFF / 64);
    constexpr int I_C1 = 2 * (256 / 32) * (2048 / 64);
    constexpr int NITEMS = I_IN + I_QB + I_KVB + I_O + I_OUT + I_GU + I_D + I_C1;
    for (int it = gw; it < NITEMS; it += ngw) {
        int r = it;
        if (r < I_IN) { const int nb = r / 16, kb = r % 16; const int pn = nb >> 3, bj = (nb >> 2) & 1, wc = nb & 3; int nc; const int c0 = zsrc(4 * pn + wc, 32 * bj, nc);
            transpose_item(p.in[I_WIN], D_IN, c0, nc, nullptr, wsp<bf16_t>(p, WS_WIN), DM, nb * 32, kb * 64, scr, lane); continue; } r -= I_IN;
        if (r < I_QB) { const int nb = r / 12, kb = r % 12; transpose_item(p.in[I_WQB], 768, nb * 32, 32, p.in[I_QAG], wsp<bf16_t>(p, WS_WQB), 768, nb * 32, kb * 64, scr, lane); continue; } r -= I_QB;
        if (r < I_KVB) { const int nb = r / 4, kb = r % 4; const int pn = nb >> 3, bj = (nb >> 2) & 1, wc = nb & 3, s = 4 * pn + wc;
            const int c0 = (s < 8) ? (128 * s + 32 * bj) : (128 * (s - 8) + 64 + 32 * bj);
            transpose_item(p.in[I_WKVB], 1024, c0, 32, p.in[I_KVAG], wsp<bf16_t>(p, WS_WKVB), 256, nb * 32, kb * 64, scr, lane); continue; } r -= I_KVB;
        if (r < I_O) { const int nb = r / 16, kb = r % 16;
            if (kb < 8) transpose_item(p.in[I_WOM], 1024, nb * 32, 32, nullptr, wsp<bf16_t>(p, WS_WO), 1024, nb * 32, kb * 64, scr, lane);
            else transpose_item(p.in[I_WON] - (size_t)512 * 1024, 1024, nb * 32, 32, nullptr, wsp<bf16_t>(p, WS_WO), 1024, nb * 32, kb * 64, scr, lane);
            continue; } r -= I_O;
        if (r < I_OUT) { const int nb = r / 16, kb = r % 16; transpose_item(p.in[I_WOUT], 1024, nb * 32, 32, nullptr, wsp<bf16_t>(p, WS_WOUT), 1024, nb * 32, kb * 64, scr, lane); continue; } r -= I_OUT;
        if (r < I_GU) { const int nb = r / 16, kb = r % 16; const int pn = nb >> 3, bj = (nb >> 2) & 1, wc = nb & 3, s = 4 * pn + wc;
            transpose_item(bj ? p.in[I_WU] : p.in[I_WG], DFF, 32 * s, 32, nullptr, wsp<bf16_t>(p, WS_WGU), 1024, nb * 32, kb * 64, scr, lane); continue; } r -= I_GU;
        if (r < I_D) { const int nb = r / 44, kb = r % 44; transpose_item(p.in[I_WDN], 1024, nb * 32, 32, nullptr, wsp<bf16_t>(p, WS_WD), DFF, nb * 32, kb * 64, scr, lane); continue; } r -= I_D;
        { const int kv = r / 256, rr = r % 256, nb = rr / 32, kb = rr % 32;
          transpose_item(kv ? p.in[I_CW1V] : p.in[I_CW1K], 256, nb * 32, 32, nullptr, wsp<bf16_t>(p, WS_CW1) + (size_t)kv * 256 * 2048, 2048, nb * 32, kb * 64, scr, lane); }
    }
}
DI void stage_mod(const Params& p, int bid, int nb, float* lds, int wid0) {
    const int tid = opaque_tid(wid0), wave = tid >> 6, lane = tid & 63, nwv = blockDim.x >> 6;
    if (bid >= 104) return;
    float* sl = lds; float* red = lds + 8192;
    for (int i = tid; i < 8192; i += blockDim.x) sl[i] = siluf(p.in[I_C][i]);
    __syncthreads();
    for (int u = bid; u < 104; u += nb) {
        float acc[8];
#pragma unroll
        for (int b = 0; b < 8; ++b) acc[b] = 0.f;
        if (u < 96) {
            const float* W = p.in[I_ADAW] + u * 64 + lane; const int kn = 1024 / nwv;
            for (int k = wave * kn; k < (wave + 1) * kn; k += 8) { float w[8];
#pragma unroll
                for (int e = 0; e < 8; ++e) w[e] = W[(size_t)(k + e) * 6144];
#pragma unroll
                for (int e = 0; e < 8; ++e)
#pragma unroll
                    for (int b = 0; b < 8; ++b) acc[b] += sl[b * 1024 + k + e] * w[e]; }
        } else {
            const int kv = (u - 96) >> 2; const float* W = (kv ? p.in[I_CW1V] : p.in[I_CW1K]) + ((u - 96) & 3) * 64 + lane; const float* pos = kv ? p.in[I_CPV] : p.in[I_CPK]; const int kn = 2048 / nwv;
            for (int k = wave * kn; k < (wave + 1) * kn; k += 8) { float w[8];
#pragma unroll
                for (int e = 0; e < 8; ++e) w[e] = W[(size_t)(k + e) * 256];
#pragma unroll
                for (int e = 0; e < 8; ++e) acc[0] += pos[k + e] * w[e]; }
        }
        __syncthreads();
#pragma unroll
        for (int b = 0; b < 8; ++b) red[(wave * 8 + b) * 64 + lane] = acc[b];
        __syncthreads();
        if (wave == 0) {
#pragma unroll
            for (int b = 0; b < 8; ++b) { float s = 0.f;
                for (int w = 0; w < nwv; ++w) s += red[(w * 8 + b) * 64 + lane];
                if (u < 96) wsp<float>(p, WS_MOD)[b * 6144 + u * 64 + lane] = s + p.in[I_ADAB][u * 64 + lane];
                else if (b == 0) wsp<float>(p, WS_CB1)[(u - 96) * 64 + lane] = s; }
        }
    }
}
DI void stage_rope(const Params& p, int tid, int gtid, int ngt, float* invt) {
    if (tid < 24) invt[tid] = (tid < 16) ? (float)pow(500000.0, -(double)tid / 16.0) : (float)pow(500000.0, -(double)(tid - 16) / 8.0);
    __syncthreads();
    float* T = wsp<float>(p, WS_ROPE); const int* pos = (const int*)p.in[I_POS];
    for (int i = gtid; i < MT * 24; i += ngt) {
        const int row = i / 24, j = i % 24; const float ps = (float)pos[row]; float c, s;
        sincos_rad(ps * invt[j], c, s);
        if (j < 16) { T[(size_t)row * 16 + j] = c; T[(size_t)MT * 16 + (size_t)row * 16 + j] = s; }
        else { T[(size_t)MT * 32 + (size_t)row * 8 + (j - 16)] = c; T[(size_t)MT * 40 + (size_t)row * 8 + (j - 16)] = s; }
    }
}
DI const float* ropeCM(const Params& p) { return wsp<float>(p, WS_ROPE); }
DI const float* ropeSM(const Params& p) { return wsp<float>(p, WS_ROPE) + (size_t)MT * 16; }
DI const float* ropeCN(const Params& p) { return wsp<float>(p, WS_ROPE) + (size_t)MT * 32; }
DI const float* ropeSN(const Params& p) { return wsp<float>(p, WS_ROPE) + (size_t)MT * 40; }

DI void stage_normmod(const float* X, const float* gain, const float* mod, int sh_idx, int sc_idx, bf16_t* Hout, int gw, int ngw, int lane) {
    for (int m = gw; m < MT; m += ngw) {
        const int b = m / SEQ; const f32x4* xr = (const f32x4*)(X + (size_t)m * DM) + lane;
        f32x4 v[4]; float s = 0.f;
#pragma unroll
        for (int j = 0; j < 4; ++j) { v[j] = xr[64 * j]; s += (v[j].x * v[j].x + v[j].y * v[j].y) + (v[j].z * v[j].z + v[j].w * v[j].w); }
        const float rstd = rsqrtf(wave_sum(s) * (1.f / DM) + EPS);
        const f32x4* g4 = (const f32x4*)gain + lane; const f32x4* sc4 = (const f32x4*)(mod + b * 6144 + sc_idx * 1024) + lane; const f32x4* sh4 = (const f32x4*)(mod + b * 6144 + sh_idx * 1024) + lane;
        u32x2* o8 = (u32x2*)(Hout + (size_t)m * DM) + lane;
#pragma unroll
        for (int j = 0; j < 4; ++j) { const f32x4 g = g4[64 * j], sc = sc4[64 * j], sh = sh4[64 * j];
            const f32x4 y = v[j] * rstd * g * (1.0f + sc) + sh; u32x2 w; w.x = pk2(y.x, y.y); w.y = pk2(y.z, y.w); o8[64 * j] = w; }
    }
}

DI void stage_shw(const Params& p, int gw, int ngw, int lane) {
    const bf16_t* W = wsp<bf16_t>(p, WS_WGU); const float* md = wsp<float>(p, WS_MOD) + 3 * 1024 + 16 * lane; float* out = wsp<float>(p, WS_SHW);
    for (int n = gw; n < 5632; n += ngw) {
        float w[16]; { float t[8]; unpack8(*(const u32x4*)(W + (size_t)n * 1024 + 16 * lane), t);
#pragma unroll
            for (int e = 0; e < 8; ++e) w[e] = t[e];
            unpack8(*(const u32x4*)(W + (size_t)n * 1024 + 16 * lane + 8), t);
#pragma unroll
            for (int e = 0; e < 8; ++e) w[8 + e] = t[e]; }
#pragma unroll
        for (int b = 0; b < 8; ++b) { float acc = 0.f;
#pragma unroll
            for (int q = 0; q < 4; ++q) { const f32x4 sv = *(const f32x4*)(md + b * 6144 + 4 * q); acc += (sv.x * w[4 * q] + sv.y * w[4 * q + 1]) + (sv.z * w[4 * q + 2] + sv.w * w[4 * q + 3]); }
            acc = wave_sum(acc);
            if (lane == 0) out[b * 5632 + n] = acc; }
    }
}
struct ColPre { f32x4 c[8]; };
struct RowPre { f32x4 a[4]; };
DI void store8bf(bf16_t* dst, const float (&f)[8]) { *(u32x4*)dst = pack8(f); }
DI float ssq16(const float (&v)[2][8]) { float q = 0.f;
#pragma unroll
    for (int b = 0; b < 2; ++b)
#pragma unroll
        for (int j = 0; j < 8; ++j) q += v[b][j] * v[b][j];
    q += xorl<16>(q); return sum32(q); }
DI f32x4 ld4(const float* p) { return *(const f32x4*)p; }
DI f32x4 ld4u(const bf16_t* p) { return __builtin_bit_cast(f32x4, *(const u32x4*)p); }
DI void un8(const f32x4 raw, float (&f)[8]) { unpack8(__builtin_bit_cast(u32x4, raw), f); }

struct EpiZ {
    static constexpr bool HAS_MID = false; static constexpr int NTYPES = 7;
    Params p;
    DI void midpre(RowPre&, int, int, int, int) const {}
    DI void mid(const RowPre&, int, int, int, int, float (&)[2][8]) const {}
    DI int type(int pn, int wc) const { const int s = 4 * pn + wc;
        if (s < 16) return 0; if (s == 16) return 1; if (s < 25) return 2; if (s < 37) { const int t = (s - 25) >> 1; return (t == 2 || t == 4) ? 3 : 4; } if (s < 40) return 5; return 6; }
    template <int T> DI void ubegin(ColPre& U, int, int pn, int wc, int fq) const {
        const int s = 4 * pn + wc; (void)s;
        if constexpr (T == 1) { U.c[0] = ld4(p.in[I_MKG] + 64 + 8 * fq); U.c[1] = ld4(p.in[I_MKG] + 68 + 8 * fq); }
        if constexpr (T == 2 || T == 3) { const float* gain = (T == 2) ? p.in[I_NQG] : ((((s - 25) >> 1) == 2) ? p.in[I_NKSG] : p.in[I_NKWG]);
            U.c[0] = ld4(gain + 8 * fq); U.c[1] = ld4(gain + 8 * fq + 4); U.c[2] = ld4(gain + 32 + 8 * fq); U.c[3] = ld4(gain + 36 + 8 * fq); }
    }
    template <int T> DI void pre(RowPre& R, int row, int, int, int fq) const {
        if constexpr (T == 1) { const int i0 = 8 * (fq & 1); const float* cs = ropeCM(p) + (size_t)row * 16 + i0; const float* sn = ropeSM(p) + (size_t)row * 16 + i0;
            R.a[0] = ld4(cs); R.a[1] = ld4(cs + 4); R.a[2] = ld4(sn); R.a[3] = ld4(sn + 4); }
        if constexpr (T == 2 || T == 3) { const float* cs = ropeCN(p) + (size_t)row * 8; const float* sn = ropeSN(p) + (size_t)row * 8;
            R.a[0] = ld4(cs); R.a[1] = ld4(cs + 4); R.a[2] = ld4(sn); R.a[3] = ld4(sn + 4); }
    }
    DI void normrope(const ColPre& U, const RowPre& R, int fq, float (&v)[2][8], float post, bf16_t* dst) const {
        const float rstd = rsqrtf(ssq16(v) * (1.f / 64.f) + EPS);
#pragma unroll
        for (int b = 0; b < 2; ++b)
#pragma unroll
            for (int j = 0; j < 8; ++j) v[b][j] *= rstd * U.c[2 * b + (j >> 2)][j & 3];
#pragma unroll
        for (int j = 0; j < 8; ++j) { const float own = v[0][j], oth = xorl<16>(own); const float c = R.a[j >> 2][j & 3], s = R.a[2 + (j >> 2)][j & 3];
            if (fq == 0) v[0][j] = own * c - oth * s; else if (fq == 1) v[0][j] = own * c + oth * s; }
#pragma unroll
        for (int b = 0; b < 2; ++b) {
#pragma unroll
            for (int j = 0; j < 8; ++j) v[b][j] *= post;
            store8bf(dst + 32 * b + 8 * fq, v[b]); }
    }
    template <int T> DI void apply(const ColPre& U, const RowPre& R, int row, int pn, int wc, int fq, float (&v)[2][8]) const {
        const int s = 4 * pn + wc; (void)s;
        if constexpr (T == 0) {
            bf16_t* d = wsp<bf16_t>(p, WS_R1) + (size_t)row * 1024 + 64 * s + 8 * fq;
            const float q = ssq16(v); store8bf(d, v[0]); store8bf(d + 32, v[1]);
            if (fq == 0) wsp<float>(p, WS_SSQA)[(size_t)row * 16 + s] = q;
        } else if constexpr (T == 1) {
            float q = 0.f;
#pragma unroll
            for (int j = 0; j < 8; ++j) q += v[0][j] * v[0][j];
            q += xorl<16>(q); q = sum32(q);
            if (fq == 0) wsp<float>(p, WS_SSQPE)[row] = q;
            float o[8];
#pragma unroll
            for (int j = 0; j < 8; ++j) { const float own = v[0][j] * U.c[j >> 2][j & 3], oth = xor32(own, fq >> 1); const float c = R.a[j >> 2][j & 3], sn = R.a[2 + (j >> 2)][j & 3];
                o[j] = (fq < 2) ? own * c - oth * sn : own * c + oth * sn; }
            store8bf(wsp<bf16_t>(p, WS_KPE) + (size_t)row * 32 + 8 * fq, o);
#pragma unroll
            for (int j = 0; j < 8; ++j) o[j] = sigmoidf(v[1][j]);
            store8bf(wsp<bf16_t>(p, WS_GN) + (size_t)row * 32 + 8 * fq, o);
        } else if constexpr (T == 2) {
            normrope(U, R, fq, v, C2N, wsp<bf16_t>(p, WS_QN) + (size_t)row * 512 + 64 * (s - 17));
        } else if constexpr (T == 3 || T == 4) {
            const int t = (s - 25) >> 1, g = (s - 25) & 1;
            bf16_t* d = wsp<bf16_t>(p, WS_KC + (size_t)t * 4 * MiB) + (size_t)row * 128 + 64 * g;
            if constexpr (T == 3) normrope(U, R, fq, v, 1.0f, d);
            else { store8bf(d + 8 * fq, v[0]); store8bf(d + 32 + 8 * fq, v[1]); }
        } else if constexpr (T == 5) {
        } else {
            bf16_t* d = wsp<bf16_t>(p, WS_R2) + (size_t)row * 2048 + 64 * (s - 40) + 8 * fq;
#pragma unroll
            for (int b = 0; b < 2; ++b) { float o[8];
#pragma unroll
                for (int j = 0; j < 8; ++j) o[j] = sigmoidf(v[b][j]);
                store8bf(d + 32 * b, o); }
        }
    }
};
struct EpiQ {
    static constexpr bool HAS_MID = false; static constexpr int NTYPES = 1;
    Params p;
    DI int type(int, int) const { return 0; }
    DI void midpre(RowPre&, int, int, int, int) const {}
    DI void mid(const RowPre&, int, int, int, int, float (&)[2][8]) const {}
    template <int T> DI void ubegin(ColPre&, int, int, int, int) const {}
    template <int T> DI void pre(RowPre& R, int row, int, int, int) const { const float* sq = wsp<float>(p, WS_SSQA) + (size_t)row * 16; R.a[0] = ld4(sq); R.a[1] = ld4(sq + 4); R.a[2] = ld4(sq + 8); }
    template <int T> DI void apply(const ColPre&, const RowPre& R, int row, int pn, int wc, int fq, float (&v)[2][8]) const {
        const float s = ((R.a[0].x + R.a[0].y) + (R.a[0].z + R.a[0].w)) + ((R.a[1].x + R.a[1].y) + (R.a[1].z + R.a[1].w)) + ((R.a[2].x + R.a[2].y) + (R.a[2].z + R.a[2].w));
        const float rstd = rsqrtf(s * (1.f / 768.f) + EPS);
        bf16_t* d = wsp<bf16_t>(p, WS_R0) + (size_t)row * 768 + 256 * pn + 32 * wc + 8 * fq;
#pragma unroll
        for (int b = 0; b < 2; ++b) { float o[8];
#pragma unroll
            for (int j = 0; j < 8; ++j) o[j] = v[b][j] * rstd;
            store8bf(d + 128 * b, o); }
    }
};
struct EpiKV {
    static constexpr bool HAS_MID = false; static constexpr int NTYPES = 1;
    Params p;
    DI int type(int, int) const { return 0; }
    DI void midpre(RowPre&, int, int, int, int) const {}
    DI void mid(const RowPre&, int, int, int, int, float (&)[2][8]) const {}
    template <int T> DI void ubegin(ColPre&, int, int, int, int) const {}
    template <int T> DI void pre(RowPre& R, int row, int pn, int wc, int fq) const { R.a[0] = ld4(wsp<float>(p, WS_SSQA) + (size_t)row * 16 + 12);
        if (4 * pn + wc < 8) { R.a[1].x = wsp<float>(p, WS_SSQPE)[row]; R.a[2] = ld4u(wsp<bf16_t>(p, WS_KPE) + (size_t)row * 32 + 8 * fq); } }
    template <int T> DI void apply(const ColPre&, const RowPre& R, int row, int pn, int wc, int fq, float (&v)[2][8]) const {
        const int s = 4 * pn + wc;
        const float rstd = rsqrtf(((R.a[0].x + R.a[0].y) + (R.a[0].z + R.a[0].w)) * (1.f / 256.f) + EPS);
#pragma unroll
        for (int b = 0; b < 2; ++b)
#pragma unroll
            for (int j = 0; j < 8; ++j) v[b][j] *= rstd;
        if (s < 8) { const float rk = rsqrtf((ssq16(v) + R.a[1].x) * (1.f / 96.f) + EPS);
#pragma unroll
            for (int b = 0; b < 2; ++b)
#pragma unroll
                for (int j = 0; j < 8; ++j) v[b][j] *= rk;
            float pe[8]; un8(R.a[2], pe);
#pragma unroll
            for (int j = 0; j < 8; ++j) pe[j] *= rk;
            bf16_t* d = wsp<bf16_t>(p, WS_KN) + (size_t)row * 768 + 96 * s + 8 * fq; store8bf(d, v[0]); store8bf(d + 32, v[1]); store8bf(d + 64, pe); }
        else { bf16_t* d = wsp<bf16_t>(p, WS_VM) + (size_t)row * 512 + 64 * (s - 8) + 8 * fq; store8bf(d, v[0]); store8bf(d + 32, v[1]); }
    }
};
struct EpiMerge {
    static constexpr bool HAS_MID = true; static constexpr int NTYPES = 1;
    Params p;
    DI int type(int, int) const { return 0; }
    DI void midpre(RowPre& R, int row, int pn, int wc, int fq) const {
        const bf16_t* g = wsp<bf16_t>(p, WS_R2) + (size_t)row * 2048 + 256 * pn + 32 * wc + 8 * fq;
        R.a[0] = ld4u(g); R.a[1] = ld4u(g + 128); R.a[2] = ld4u(g + 1024); R.a[3] = ld4u(g + 1024 + 128); }
    DI void mid(const RowPre& R, int, int, int, int, float (&v)[2][8]) const {
#pragma unroll
        for (int b = 0; b < 2; ++b) { float s1[8], s2[8]; un8(R.a[b], s1); un8(R.a[2 + b], s2);
#pragma unroll
            for (int j = 0; j < 8; ++j) v[b][j] *= s1[j] * __builtin_amdgcn_rcpf(s2[j]); }
    }
    template <int T> DI void ubegin(ColPre&, int, int, int, int) const {}
    template <int T> DI void pre(RowPre& R, int row, int pn, int wc, int fq) const {
        const bf16_t* g = wsp<bf16_t>(p, WS_R2) + (size_t)row * 2048 + 1024 + 256 * pn + 32 * wc + 8 * fq; R.a[0] = ld4u(g); R.a[1] = ld4u(g + 128); }
    template <int T> DI void apply(const ColPre&, const RowPre& R, int row, int pn, int wc, int fq, float (&v)[2][8]) const {
        bf16_t* d = wsp<bf16_t>(p, WS_R0) + (size_t)row * 1024 + 256 * pn + 32 * wc + 8 * fq;
#pragma unroll
        for (int b = 0; b < 2; ++b) { float s2[8], o[8]; un8(R.a[b], s2);
#pragma unroll
            for (int j = 0; j < 8; ++j) o[j] = v[b][j] * s2[j];
            store8bf(d + 128 * b, o); }
    }
};
struct EpiOut {
    static constexpr bool HAS_MID = false; static constexpr int NTYPES = 1;
    Params p;
    DI int type(int, int) const { return 0; }
    DI void midpre(RowPre&, int, int, int, int) const {}
    DI void mid(const RowPre&, int, int, int, int, float (&)[2][8]) const {}
    template <int T> DI void ubegin(ColPre& U, int row0, int pn, int wc, int fq) const {
        const int b_ = row0 / SEQ, col = 256 * pn + 32 * wc + 8 * fq; const float* md = wsp<float>(p, WS_MOD) + b_ * 6144 + col; const float* g2 = p.in[I_N2G] + col;
#pragma unroll
        for (int i = 0; i < 4; ++i) { const int o = 128 * (i >> 1) + 4 * (i & 1); U.c[i] = ld4(md + 2 * 1024 + o); const f32x4 sc = ld4(md + 4 * 1024 + o), gg = ld4(g2 + o); U.c[4 + i] = gg * (1.0f + sc); }
    }
    template <int T> DI void pre(RowPre& R, int row, int pn, int wc, int fq) const { const float* x = p.in[I_X] + (size_t)row * DM + 256 * pn + 32 * wc + 8 * fq;
        R.a[0] = ld4(x); R.a[1] = ld4(x + 4); R.a[2] = ld4(x + 128); R.a[3] = ld4(x + 132); }
    template <int T> DI void apply(const ColPre& U, const RowPre& R, int row, int pn, int wc, int fq, float (&v)[2][8]) const {
        const int col = 256 * pn + 32 * wc + 8 * fq; float* d = wsp<float>(p, WS_R2) + (size_t)row * DM + col; bf16_t* a2 = wsp<bf16_t>(p, WS_R1) + (size_t)row * DM + col;
        float q = 0.f;
#pragma unroll
        for (int b = 0; b < 2; ++b) { float o8[8];
#pragma unroll
            for (int h = 0; h < 2; ++h) { const f32x4 g = U.c[2 * b + h], xv = R.a[2 * b + h], gs = U.c[4 + 2 * b + h];
                f32x4 o; o.x = xv.x + g.x * v[b][4 * h]; o.y = xv.y + g.y * v[b][4 * h + 1]; o.z = xv.z + g.z * v[b][4 * h + 2]; o.w = xv.w + g.w * v[b][4 * h + 3]; *(f32x4*)(d + 128 * b + 4 * h) = o;
                q += (o.x * o.x + o.y * o.y) + (o.z * o.z + o.w * o.w);
                o8[4 * h] = o.x * gs.x; o8[4 * h + 1] = o.y * gs.y; o8[4 * h + 2] = o.z * gs.z; o8[4 * h + 3] = o.w * gs.w; }
            store8bf(a2 + 128 * b, o8); }
        q += xorl<16>(q); q = sum32(q);
        if (fq == 0) wsp<float>(p, WS_SSQA)[(size_t)row * 16 + 4 * pn + wc] = q;
    }
};
struct EpiGU {
    static constexpr bool HAS_MID = false; static constexpr int NTYPES = 1;
    Params p;
    DI int type(int, int) const { return 0; }
    DI void midpre(RowPre&, int, int, int, int) const {}
    DI void mid(const RowPre&, int, int, int, int, float (&)[2][8]) const {}
    template <int T> DI void ubegin(ColPre& U, int row0, int pn, int wc, int fq) const { const float* sh = wsp<float>(p, WS_SHW) + (row0 / SEQ) * 5632 + 256 * pn + 32 * wc + 8 * fq;
        U.c[0] = ld4(sh); U.c[1] = ld4(sh + 4); U.c[2] = ld4(sh + 128); U.c[3] = ld4(sh + 132); }
    template <int T> DI void pre(RowPre& R, int row, int, int, int) const { const float* sq = wsp<float>(p, WS_SSQA) + (size_t)row * 16; R.a[0] = ld4(sq); R.a[1] = ld4(sq + 4); R.a[2] = ld4(sq + 8); R.a[3] = ld4(sq + 12); }
    template <int T> DI void apply(const ColPre& U, const RowPre& R, int row, int pn, int wc, int fq, float (&v)[2][8]) const {
        const int s = 4 * pn + wc; float o[8];
        const float tot = (((R.a[0].x + R.a[0].y) + (R.a[0].z + R.a[0].w)) + ((R.a[1].x + R.a[1].y) + (R.a[1].z + R.a[1].w))) + (((R.a[2].x + R.a[2].y) + (R.a[2].z + R.a[2].w)) + ((R.a[3].x + R.a[3].y) + (R.a[3].z + R.a[3].w)));
        const float rstd = rsqrtf(tot * (1.f / DM) + EPS);
#pragma unroll
        for (int j = 0; j < 8; ++j) o[j] = siluf(rstd * v[0][j] + U.c[j >> 2][j & 3]) * (rstd * v[1][j] + U.c[2 + (j >> 2)][j & 3]);
        store8bf(wsp<bf16_t>(p, WS_HID) + (size_t)row * DFF + 32 * s + 8 * fq, o);
    }
};
struct EpiDown {
    static constexpr bool HAS_MID = false; static constexpr int NTYPES = 1;
    Params p;
    DI int type(int, int) const { return 0; }
    DI void midpre(RowPre&, int, int, int, int) const {}
    DI void mid(const RowPre&, int, int, int, int, float (&)[2][8]) const {}
    template <int T> DI void ubegin(ColPre& U, int row0, int pn, int wc, int fq) const { const float* gt = wsp<float>(p, WS_MOD) + (row0 / SEQ) * 6144 + 5 * 1024 + 256 * pn + 32 * wc + 8 * fq;
        U.c[0] = ld4(gt); U.c[1] = ld4(gt + 4); U.c[2] = ld4(gt + 128); U.c[3] = ld4(gt + 132); }
    template <int T> DI void pre(RowPre& R, int row, int pn, int wc, int fq) const { const float* x = wsp<float>(p, WS_R2) + (size_t)row * DM + 256 * pn + 32 * wc + 8 * fq;
        R.a[0] = ld4(x); R.a[1] = ld4(x + 4); R.a[2] = ld4(x + 128); R.a[3] = ld4(x + 132); }
    template <int T> DI void apply(const ColPre& U, const RowPre& R, int row, int pn, int wc, int fq, float (&v)[2][8]) const {
        float* d = p.out + (size_t)row * DM + 256 * pn + 32 * wc + 8 * fq;
#pragma unroll
        for (int b = 0; b < 2; ++b)
#pragma unroll
            for (int h = 0; h < 2; ++h) { const f32x4 g = U.c[2 * b + h], xv = R.a[2 * b + h];
                f32x4 o; o.x = xv.x + g.x * v[b][4 * h]; o.y = xv.y + g.y * v[b][4 * h + 1]; o.z = xv.z + g.z * v[b][4 * h + 2]; o.w = xv.w + g.w * v[b][4 * h + 3]; *(f32x4*)(d + 128 * b + 4 * h) = o; }
    }
};
namespace pg8 {
#define PG8_LAS __attribute__((address_space(3)))
typedef short bf16x8 __attribute__((ext_vector_type(8)));
constexpr int BM = 256, BK = 64, HALF = 128, HTB = HALF * BK * 2  , STAGE_BYTES = 8 * HTB, NXCD = 8, WGM = 8;

__host__ __device__ __forceinline__ int lds_byte(int r, int c) { const int st = (r >> 4) * 2 + (c >> 5), rr = r & 15, cc = c & 31, ob = rr * 64 + cc * 2; return st * 1024 + (ob ^ (((ob >> 9) & 1) << 5)); }
__host__ __device__ __forceinline__ void stage_rc(int b, int& R, int& C) { const int st = b / 1024, sb = b % 1024, swz = sb ^ (((sb >> 9) & 1) << 5); R = (st >> 1) * 16 + swz / 64; C = (st & 1) * 32 + (swz % 64) / 2; }
__host__ __device__ __forceinline__ int perm32(int rho) { const int n = rho >> 4, i = rho & 15; return 8 * (i >> 2) + 4 * n + (i & 3); }

struct Unit { int pm, pn; };
struct Gemm { const bf16_t* A; const bf16_t* Bt; int M, N, K, lda, ldb, kstepA; };

struct StaticOrder {
    int nM, nN, nwg, G, c;
    __host__ __device__ void init(int M, int N, int G_, int c_) { nM = M / BM; nN = N / BM; nwg = nM * nN; G = G_; c = c_; }
    __host__ __device__ bool next(int i, Unit& u) const {
        const long L = (long)i * G + c; if (L >= nwg) return false;
        int wgid = (int)L; { const int q = nwg / NXCD, r = nwg % NXCD, xcd = wgid % NXCD, off = wgid / NXCD; wgid = (xcd < r ? xcd * (q + 1) : r * (q + 1) + (xcd - r) * q) + off; }
        const int nig = WGM * nN, gid = wgid / nig, fm = gid * WGM, gsz = (nM - fm) < WGM ? (nM - fm) : WGM;
        u.pm = fm + ((wgid % nig) % gsz); u.pn = (wgid % nig) / gsz; return true;
    }
    __device__ __forceinline__ void a_ready(const Unit&) const {}
    __device__ __forceinline__ void done(const Unit&) const {}
};

template <class Epi, class Sched, bool ALIGN_EPI = false, bool SP2 = false>
__device__ __forceinline__ void gemm_phase(PG8_LAS unsigned char* lds, const Gemm g, const Sched& S, const Epi& E, int wid0) {
    const int tid = opaque_tid(wid0), wid = __builtin_amdgcn_readfirstlane(tid >> 6), lane = tid & 63, wr = wid >> 2, wc = wid & 3, fr = lane & 15, fq = lane >> 4;
    const int K = g.K; int nt = K / BK; asm volatile("" : "+s"(nt));
    unsigned voffA[2], voffB[2];
#pragma unroll
    for (int i = 0; i < 2; ++i) { int R, C; stage_rc(tid * 16 + i * 8192, R, C); const int Rb = Epi::PERM ? ((R & ~31) + perm32(R & 31)) : R;
        voffA[i] = (unsigned)(R * g.lda + C) * 2u; voffB[i] = (unsigned)(Rb * g.ldb + C) * 2u; }
    const size_t kstep = (size_t)(BK * 2), kstepA = (size_t)g.kstepA;
    const size_t hstepB = (size_t)HALF * g.ldb * 2, hstepA = (size_t)HALF * g.lda * 2;
    const size_t tstepB = 2 * hstepB, tstepA = 2 * hstepA;
    const unsigned ldsw = (unsigned)wid * 1024u;
    const int aoff = lds_byte(wr * 64 + fr, fq * 8), boff = lds_byte(wc * 32 + fr, fq * 8);
#define PG8_SA(b, h) (((b) * 2 + (h)) * HTB)
#define PG8_SB(b, h) ((4 + (b) * 2 + (h)) * HTB)
#define PG8_STAGE(bufoff, gbase, voff) do { _Pragma("unroll") for (int _i = 0; _i < 2; ++_i) \
        __builtin_amdgcn_global_load_lds((const unsigned*)((const char*)(gbase) + (voff)[_i]), (PG8_LAS unsigned*)(lds + (bufoff) + ldsw + _i * 8192), 16, 0, 0); } while (0)
#define PG8_LDA(dst, b, h) do { _Pragma("unroll") for (int m = 0; m < 4; ++m) _Pragma("unroll") for (int k = 0; k < 2; ++k) dst[m][k] = *(const PG8_LAS bf16x8*)(lds + PG8_SA(b, h) + aoff + m * 2048 + k * 1024); } while (0)
#define PG8_LDB(dst, b, h) do { _Pragma("unroll") for (int n = 0; n < 2; ++n) _Pragma("unroll") for (int k = 0; k < 2; ++k) dst[n][k] = *(const PG8_LAS bf16x8*)(lds + PG8_SB(b, h) + boff + n * 2048 + k * 1024); } while (0)
#define PG8_MMA(ai, bj, At, Bt) do { __builtin_amdgcn_s_setprio(1); _Pragma("unroll") for (int m = 0; m < 4; ++m) _Pragma("unroll") for (int n = 0; n < 2; ++n) _Pragma("unroll") for (int k = 0; k < 2; ++k) \
        acc[ai][bj][m][n] = __builtin_amdgcn_mfma_f32_16x16x32_bf16(Bt[n][k], At[m][k], acc[ai][bj][m][n], 0, 0, 0); __builtin_amdgcn_s_setprio(0); } while (0)
#define PG8_WAIT_V(n) asm volatile("s_waitcnt vmcnt(" #n ")" ::: "memory")
#define PG8_WAIT_L(n) asm volatile("s_waitcnt lgkmcnt(" #n ")" ::: "memory")
#define PG8_BAR __builtin_amdgcn_s_barrier()
#define PG8_SCHED __builtin_amdgcn_sched_barrier(0)
    Unit cur, nxt; int ui = 0;
    if (!S.next(0, cur)) return;
    f32x4 acc[2][2][4][2];
#pragma unroll
    for (int a = 0; a < 2; ++a)
#pragma unroll
        for (int b = 0; b < 2; ++b)
#pragma unroll
            for (int m = 0; m < 4; ++m)
#pragma unroll
                for (int n = 0; n < 2; ++n) acc[a][b][m][n] = (f32x4){0.f, 0.f, 0.f, 0.f};
    bf16x8 At[4][2], B0[2][2], B1[2][2];
    const char* cA = (const char*)g.A + (size_t)cur.pm * tstepA; const char* cB = (const char*)g.Bt + (size_t)cur.pn * tstepB;
    S.a_ready(cur);
    if constexpr (SP2) {
        PG8_STAGE(PG8_SB(0, 0), cB, voffB); PG8_STAGE(PG8_SB(0, 1), cB + hstepB, voffB); PG8_STAGE(PG8_SA(0, 0), cA, voffA); PG8_STAGE(PG8_SA(0, 1), cA + hstepA, voffA);
        if (wr == 1) PG8_BAR;
        PG8_WAIT_V(2); PG8_BAR;
        PG8_STAGE(PG8_SB(1, 0), cB + kstep, voffB); PG8_STAGE(PG8_SA(1, 0), cA + kstepA, voffA); PG8_STAGE(PG8_SB(1, 1), cB + hstepB + kstep, voffB);
        PG8_WAIT_V(6); PG8_BAR;
    } else {
        PG8_STAGE(PG8_SB(0, 0), cB, voffB); PG8_STAGE(PG8_SA(0, 0), cA, voffA); PG8_STAGE(PG8_SB(0, 1), cB + hstepB, voffB); PG8_STAGE(PG8_SA(0, 1), cA + hstepA, voffA);
        if (wr == 1) PG8_BAR;
        PG8_WAIT_V(4); PG8_BAR;
        PG8_STAGE(PG8_SB(1, 0), cB + kstep, voffB); PG8_STAGE(PG8_SA(1, 0), cA + kstepA, voffA); PG8_STAGE(PG8_SB(1, 1), cB + hstepB + kstep, voffB);
        PG8_WAIT_V(6); PG8_BAR;
    }
    for (;;) {
        const bool has_next = S.next(ui + 1, nxt);
        const char* nA = has_next ? (const char*)g.A + (size_t)nxt.pm * tstepA : cA; const char* nB = has_next ? (const char*)g.Bt + (size_t)nxt.pn * tstepB : cB;
        for (int hh_ = 0; hh_ < (Epi::HAS_MID ? 2 : 1); ++hh_) {
        if constexpr (Epi::HAS_MID) { if (hh_ == 1) E.mid(acc, cur, wr, wc, fr, fq); }
        const int t0_ = Epi::HAS_MID ? hh_ * (nt >> 1) : 0, t1_ = Epi::HAS_MID ? (hh_ + 1) * (nt >> 1) : nt;
        for (int t = t0_; t < t1_; t += 2) {
            const bool last = (t == nt - 2);
            const char* a1 = cA + (size_t)(t + 1) * kstepA;
            const char* a2 = last ? nA : cA + (size_t)(t + 2) * kstepA; const char* b2 = last ? nB : cB + (size_t)(t + 2) * kstep;
            const char* a3 = a2 + kstepA; const char* b3 = b2 + kstep;
            if (last && has_next) S.a_ready(nxt);
            if constexpr (SP2) {
            PG8_LDB(B0, 0, 0); PG8_LDB(B1, 0, 1); PG8_SCHED; PG8_LDA(At, 0, 0); PG8_STAGE(PG8_SA(1, 1), a1 + hstepA, voffA);
            PG8_WAIT_V(8); PG8_WAIT_L(0); PG8_BAR; PG8_MMA(0, 0, At, B0); PG8_MMA(0, 1, At, B1); PG8_BAR; PG8_SCHED;
            PG8_LDA(At, 0, 1); PG8_STAGE(PG8_SB(0, 0), b2, voffB); PG8_STAGE(PG8_SB(0, 1), b2 + hstepB, voffB); PG8_STAGE(PG8_SA(0, 0), a2, voffA);
            PG8_WAIT_V(8); PG8_WAIT_L(0); PG8_BAR; PG8_MMA(1, 0, At, B0); PG8_MMA(1, 1, At, B1); PG8_BAR; PG8_SCHED;
            PG8_LDB(B0, 1, 0); PG8_LDB(B1, 1, 1); PG8_SCHED; PG8_LDA(At, 1, 0); PG8_STAGE(PG8_SA(0, 1), a2 + hstepA, voffA);
            PG8_WAIT_V(8); PG8_WAIT_L(0); PG8_BAR; PG8_MMA(0, 0, At, B0); PG8_MMA(0, 1, At, B1); PG8_BAR; PG8_SCHED;
            PG8_LDA(At, 1, 1); PG8_STAGE(PG8_SB(1, 0), b3, voffB); PG8_STAGE(PG8_SB(1, 1), b3 + hstepB, voffB); PG8_STAGE(PG8_SA(1, 0), a3, voffA);
            PG8_WAIT_V(8); PG8_WAIT_L(0); PG8_BAR; PG8_MMA(1, 0, At, B0); PG8_MMA(1, 1, At, B1); PG8_BAR; PG8_SCHED;
            } else {
            PG8_LDB(B0, 0, 0); PG8_SCHED; PG8_LDA(At, 0, 0); PG8_STAGE(PG8_SA(1, 1), a1 + hstepA, voffA);
            PG8_WAIT_L(8); PG8_BAR; PG8_WAIT_L(0); PG8_MMA(0, 0, At, B0); PG8_BAR; PG8_SCHED;
            PG8_LDB(B1, 0, 1); PG8_STAGE(PG8_SB(0, 0), b2, voffB);
            PG8_BAR; PG8_WAIT_L(0); PG8_MMA(0, 1, At, B1); PG8_BAR;
            PG8_LDA(At, 0, 1); PG8_STAGE(PG8_SA(0, 0), a2, voffA);
            PG8_BAR; PG8_WAIT_L(0); PG8_MMA(1, 0, At, B0); PG8_BAR; PG8_SCHED;
            PG8_STAGE(PG8_SB(0, 1), b2 + hstepB, voffB);
            PG8_WAIT_V(6); PG8_BAR; PG8_MMA(1, 1, At, B1); PG8_BAR;
            PG8_LDB(B0, 1, 0); PG8_SCHED; PG8_LDA(At, 1, 0); PG8_STAGE(PG8_SA(0, 1), a2 + hstepA, voffA);
            PG8_WAIT_L(8); PG8_BAR; PG8_WAIT_L(0); PG8_MMA(0, 0, At, B0); PG8_BAR; PG8_SCHED;
            PG8_LDB(B1, 1, 1); PG8_STAGE(PG8_SB(1, 0), b3, voffB);
            PG8_BAR; PG8_WAIT_L(0); PG8_MMA(0, 1, At, B1); PG8_BAR;
            PG8_LDA(At, 1, 1); PG8_STAGE(PG8_SA(1, 0), a3, voffA);
            PG8_BAR; PG8_WAIT_L(0); PG8_MMA(1, 0, At, B0); PG8_BAR; PG8_SCHED;
            PG8_STAGE(PG8_SB(1, 1), b3 + hstepB, voffB);
            PG8_WAIT_V(6); PG8_BAR; PG8_MMA(1, 1, At, B1); PG8_BAR;
            }
        }
        }
        if constexpr (ALIGN_EPI) { if (wr == 0) PG8_BAR; }
        if constexpr (!Epi::AFTER_DRAIN) { E(acc, cur, wr, wc, fr, fq); S.done(cur); }
        if (!has_next) break;
#pragma unroll
        for (int a = 0; a < 2; ++a)
#pragma unroll
            for (int b = 0; b < 2; ++b)
#pragma unroll
                for (int m = 0; m < 4; ++m)
#pragma unroll
                    for (int n = 0; n < 2; ++n) acc[a][b][m][n] = (f32x4){0.f, 0.f, 0.f, 0.f};
        cur = nxt; cA = nA; cB = nB; ++ui;
        if constexpr (ALIGN_EPI) { if (wr == 1) PG8_BAR; }
    }
    PG8_WAIT_V(0);
    if constexpr (!ALIGN_EPI) { if (wr == 0) PG8_BAR; }
    PG8_BAR;
    if constexpr (Epi::AFTER_DRAIN) { E.fused(acc, cur, wr, wc, fr, fq, lds, wid, lane); S.done(cur); }
#undef PG8_SA
#undef PG8_SB
#undef PG8_STAGE
#undef PG8_LDA
#undef PG8_LDB
#undef PG8_MMA
#undef PG8_WAIT_V
#undef PG8_WAIT_L
#undef PG8_BAR
#undef PG8_SCHED
}
}

template <class SE> struct EpiAdapt {
    static constexpr bool PERM = true, AFTER_DRAIN = false, HAS_MID = SE::HAS_MID;
    SE se;
    template <int T> DI void run(f32x4 (&acc)[2][2][4][2], const pg8::Unit& u, int wr, int wc, int fr, int fq) const {
        int frr = fr; asm volatile("" : "+v"(frr));
        const int rbase = u.pm * 256 + wr * 64;
        ColPre U; se.template ubegin<T>(U, rbase, u.pn, wc, fq);
        RowPre R[2]; se.template pre<T>(R[0], rbase + frr, u.pn, wc, fq);
#pragma unroll
        for (int it = 0; it < 8; ++it) {
            const int ai = it >> 2, m = it & 3; const int row = rbase + ai * 128 + m * 16 + frr;
            if (it < 7) se.template pre<T>(R[(it + 1) & 1], rbase + ((it + 1) >> 2) * 128 + ((it + 1) & 3) * 16 + frr, u.pn, wc, fq);
            float v[2][8];
#pragma unroll
            for (int bj = 0; bj < 2; ++bj)
#pragma unroll
                for (int n = 0; n < 2; ++n) { v[bj][4 * n] = acc[ai][bj][m][n][0]; v[bj][4 * n + 1] = acc[ai][bj][m][n][1]; v[bj][4 * n + 2] = acc[ai][bj][m][n][2]; v[bj][4 * n + 3] = acc[ai][bj][m][n][3]; }
            se.template apply<T>(U, R[it & 1], row, u.pn, wc, fq, v);
        }
    }
    template <int T> DI void disp(int ty, f32x4 (&acc)[2][2][4][2], const pg8::Unit& u, int wr, int wc, int fr, int fq) const {
        if constexpr (T < SE::NTYPES) { if (ty == T) run<T>(acc, u, wr, wc, fr, fq); else disp<T + 1>(ty, acc, u, wr, wc, fr, fq); }
    }
    DI void operator()(f32x4 (&acc)[2][2][4][2], const pg8::Unit& u, int wr, int wc, int fr, int fq) const { disp<0>(se.type(u.pn, wc), acc, u, wr, wc, fr, fq); }
    DI void mid(f32x4 (&acc)[2][2][4][2], const pg8::Unit& u, int wr, int wc, int fr, int fq) const {
        int frr = fr; asm volatile("" : "+v"(frr));
        const int rbase = u.pm * 256 + wr * 64;
        RowPre R[2]; se.midpre(R[0], rbase + frr, u.pn, wc, fq);
#pragma unroll
        for (int it = 0; it < 8; ++it) {
            const int ai = it >> 2, m = it & 3; const int row = rbase + ai * 128 + m * 16 + frr;
            if (it < 7) se.midpre(R[(it + 1) & 1], rbase + ((it + 1) >> 2) * 128 + ((it + 1) & 3) * 16 + frr, u.pn, wc, fq);
            float v[2][8];
#pragma unroll
            for (int bj = 0; bj < 2; ++bj)
#pragma unroll
                for (int n = 0; n < 2; ++n) { v[bj][4 * n] = acc[ai][bj][m][n][0]; v[bj][4 * n + 1] = acc[ai][bj][m][n][1]; v[bj][4 * n + 2] = acc[ai][bj][m][n][2]; v[bj][4 * n + 3] = acc[ai][bj][m][n][3]; }
            se.mid(R[it & 1], row, u.pn, wc, fq, v);
#pragma unroll
            for (int bj = 0; bj < 2; ++bj)
#pragma unroll
                for (int n = 0; n < 2; ++n) { acc[ai][bj][m][n][0] = v[bj][4 * n]; acc[ai][bj][m][n][1] = v[bj][4 * n + 1]; acc[ai][bj][m][n][2] = v[bj][4 * n + 2]; acc[ai][bj][m][n][3] = v[bj][4 * n + 3]; }
        }
    }
};
template <class SE> DI void gemm_fast(PG8_LAS unsigned char* lds, const bf16_t* A, int lda, const bf16_t* Bt, int M, int N, int K, const SE& se, int G, int c, int wid0) {
    pg8::Gemm g{A, Bt, M, N, K, lda, K, 128}; pg8::StaticOrder S; S.init(M, N, G, c);
    EpiAdapt<SE> E{se};
    pg8::gemm_phase<EpiAdapt<SE>, pg8::StaticOrder, true, true>(lds, g, S, E, wid0);
}
struct RangeOrder {
    int base, cnt, nN;
    DI bool next(int i, pg8::Unit& u) const { if (i >= cnt) return false; const int L = base + i; u.pm = L / nN; u.pn = L % nN; return true; }
    DI void a_ready(const pg8::Unit&) const {}
    DI void done(const pg8::Unit&) const {}
};
template <class SE> DI void gemm_fast_range(PG8_LAS unsigned char* lds, const bf16_t* A, int lda, const bf16_t* Bt, int M, int N, int K, const SE& se, int base, int cnt, int wid0) {
    pg8::Gemm g{A, Bt, M, N, K, lda, K, 128}; RangeOrder S{base, cnt, N / 256};
    EpiAdapt<SE> E{se};
    pg8::gemm_phase<EpiAdapt<SE>, RangeOrder, true, true>(lds, g, S, E, wid0);
}
struct OneUnit {
    int pm, pn;
    DI bool next(int i, pg8::Unit& u) const { if (i > 0) return false; u.pm = pm; u.pn = pn; return true; }
    DI void a_ready(const pg8::Unit&) const {}
    DI void done(const pg8::Unit&) const {}
};
struct EpiCmpH {
    static constexpr bool HAS_MID = false; static constexpr int NTYPES = 1;
    float* H;
    DI int type(int, int) const { return 0; }
    DI void midpre(RowPre&, int, int, int, int) const {}
    DI void mid(const RowPre&, int, int, int, int, float (&)[2][8]) const {}
    template <int T> DI void ubegin(ColPre&, int, int, int, int) const {}
    template <int T> DI void pre(RowPre&, int, int, int, int) const {}
    template <int T> DI void apply(const ColPre&, const RowPre&, int row, int pn, int wc, int fq, float (&v)[2][8]) const {
        float* d = H + (size_t)row * 256 + 32 * wc + 8 * fq;
#pragma unroll
        for (int b = 0; b < 2; ++b) { *(f32x4*)(d + 128 * b) = (f32x4){v[b][0], v[b][1], v[b][2], v[b][3]}; *(f32x4*)(d + 128 * b + 4) = (f32x4){v[b][4], v[b][5], v[b][6], v[b][7]}; }
    }
};
DI void cmp_hidden_fast(const Params& p, PG8_LAS unsigned char* lds, int cu, int wid0) {
    const int kv = cu >> 4, g = (cu >> 3) & 1, pm = (cu >> 1) & 3, sp = cu & 1;
    const bf16_t* A = wsp<bf16_t>(p, kv ? WS_VC : WS_KC) + g * 64 + (size_t)(16 * sp) * 128;
    const bf16_t* Bt = wsp<bf16_t>(p, WS_CW1) + (size_t)kv * 256 * 2048 + 1024 * sp;
    pg8::Gemm gm{A, Bt, 1024, 256, 1024, 2048, 2048, 256}; OneUnit S{pm, 0};
    EpiCmpH se{wsp<float>(p, WS_CMPH) + (size_t)((kv * 2 + g) * 2 + sp) * 1024 * 256};
    EpiAdapt<EpiCmpH> E{se};
    pg8::gemm_phase<EpiAdapt<EpiCmpH>, OneUnit, true, true>(lds, gm, S, E, wid0);
}
template <bool SPLIT> DI void cmp_out(const Params& p, int gw, int ngw, int lane) {
    const float* H = wsp<float>(p, WS_CMPH);
    for (int u = gw; u < 2 * 2 * 1024; u += ngw) {
        const int r = u & 1023, g = (u >> 10) & 1, kv = u >> 11; const int b = r >> 7, n = r & 127;
        bf16_t* dst = wsp<bf16_t>(p, kv ? WS_VCF : WS_KCF) + (size_t)r * 128 + g * 64 + lane;
        if (n == 127) { *dst = 0; continue; }
        const float* w2 = (kv ? p.in[I_CW2V] : p.in[I_CW2K]) + lane;
        float acc = 0.f;
        if constexpr (SPLIT) {
            const float* h = H + ((size_t)((kv * 2 + g) * 2) * 1024 + r) * 256; const float* cb = wsp<float>(p, WS_CB1) + kv * 256;
            float hv[4];
#pragma unroll
            for (int q = 0; q < 4; ++q) { const int j = 64 * q + lane; hv[q] = siluf((h[j] + h[(size_t)1024 * 256 + j]) + cb[j]); }
#pragma unroll
            for (int q = 0; q < 4; ++q)
#pragma unroll
                for (int jj = 0; jj < 64; ++jj) acc += __int_as_float(__builtin_amdgcn_readlane(__float_as_int(hv[q]), jj)) * w2[(64 * q + jj) * 64];
        } else {
            const float* h = H + (size_t)u * 256;
            for (int j = 0; j < 256; ++j) acc += h[j] * w2[j * 64];
        }
        if (kv == 0) {
            const float rstd = rsqrtf(wave_sum(acc * acc) * (1.f / 64.f) + EPS);
            float y = acc * rstd * p.in[I_NKCG][lane];
            const int prow = b * SEQ + 16 * n + 31; const float oth = xorl<8>(y);
            if (lane < 16) { const float c = ropeCN(p)[(size_t)prow * 8 + (lane & 7)], s = ropeSN(p)[(size_t)prow * 8 + (lane & 7)]; y = (lane < 8) ? y * c - oth * s : y * c + oth * s; }
            acc = y;
        }
        *dst = (bf16_t)f2bf(acc);
    }
}

DI unsigned select_blocks(const float (&imp)[32], int cur) {
    if (cur < 8) return (2u << cur) - 1u;
    unsigned mask = 1u | (1u << cur) | (1u << (cur - 1));
#pragma unroll 1
    for (int it = 0; it < 5; ++it) {
        float best = -1.0f; int bi = 1;
#pragma unroll
        for (int j = 1; j < 32; ++j) { const bool ok = (j <= cur - 2) && !((mask >> j) & 1u); if (ok && imp[j] > best) { best = imp[j]; bi = j; } }
        mask |= 1u << bi;
    }
    return mask;
}

namespace fa {
typedef short bf16x8 __attribute__((ext_vector_type(8)));
typedef short s16x4 __attribute__((ext_vector_type(4)));
typedef float f32x16 __attribute__((ext_vector_type(16)));
typedef LAS const char* lds_cptr;
typedef LAS char* lds_ptr;
constexpr int KBUF = 12288, VBUF = 8192;
constexpr int L_K = 0, L_V = 2 * KBUF, L_RK = L_V + 2 * VBUF, L_WS = L_RK + 512, L_OST = L_WS + 8 * 256, L_END = L_OST + 8 * 4096;
#define FA_SBAR() __builtin_amdgcn_sched_barrier(0)
DI int crow(int r, int hi) { return (r & 3) + 8 * (r >> 2) + 4 * hi; }
typedef float f32x2_t __attribute__((ext_vector_type(2))); typedef __bf16 bf16x2_t __attribute__((ext_vector_type(2)));
DI unsigned cvtpk(float lo, float hi) { f32x2_t v = {lo, hi}; bf16x2_t b = __builtin_convertvector(v, bf16x2_t); return __builtin_bit_cast(unsigned, b); }

template <int DK> DI void qkt(f32x16& p0, f32x16& p1, lds_cptr kb, const bf16x8* qr) {
    f32x16 z;
#pragma unroll
    for (int i = 0; i < 16; ++i) z[i] = 0.f;
#pragma unroll
    for (int d0 = 0; d0 < DK / 16; ++d0) {
        const bf16x8 b0 = *(const LAS bf16x8*)(kb + d0 * 2048);
        const bf16x8 b1 = *(const LAS bf16x8*)(kb + d0 * 2048 + 512);
        if (d0 == 0) { p0 = __builtin_amdgcn_mfma_f32_32x32x16_bf16(b0, qr[0], z, 0, 0, 0); p1 = __builtin_amdgcn_mfma_f32_32x32x16_bf16(b1, qr[0], z, 0, 0, 0); }
        else { p0 = __builtin_amdgcn_mfma_f32_32x32x16_bf16(b0, qr[d0], p0, 0, 0, 0); p1 = __builtin_amdgcn_mfma_f32_32x32x16_bf16(b1, qr[d0], p1, 0, 0, 0); }
    }
}
typedef short v4i16_t __attribute__((ext_vector_type(4)));
DI s16x4 vtr(int addr) { return __builtin_bit_cast(s16x4, __builtin_amdgcn_ds_read_tr16_b64_v4i16((LAS v4i16_t*)(uintptr_t)(unsigned)addr)); }
DI void pv(f32x16* o, int vb, bf16x8 pa0, bf16x8 pa1, bf16x8 pa2, bf16x8 pa3) {
#pragma unroll
    for (int d0 = 0; d0 < 2; ++d0) { s16x4 lo[4], hi[4];
#pragma unroll
        for (int ks = 0; ks < 4; ++ks) { lo[ks] = vtr(vb + d0 * 4096 + ks * 1024); hi[ks] = vtr(vb + d0 * 4096 + ks * 1024 + 512); }
#define FA_PK(k) (bf16x8){lo[k][0], lo[k][1], lo[k][2], lo[k][3], hi[k][0], hi[k][1], hi[k][2], hi[k][3]}
        o[d0] = __builtin_amdgcn_mfma_f32_32x32x16_bf16(pa0, FA_PK(0), o[d0], 0, 0, 0);
        o[d0] = __builtin_amdgcn_mfma_f32_32x32x16_bf16(pa1, FA_PK(1), o[d0], 0, 0, 0);
        o[d0] = __builtin_amdgcn_mfma_f32_32x32x16_bf16(pa2, FA_PK(2), o[d0], 0, 0, 0);
        o[d0] = __builtin_amdgcn_mfma_f32_32x32x16_bf16(pa3, FA_PK(3), o[d0], 0, 0, 0);
#undef FA_PK
    }
}
DI void pack_p(const f32x16& p0, const f32x16& p1, bf16x8& a0, bf16x8& a1, bf16x8& a2, bf16x8& a3) {
    u32x4 w0, w1, w2, w3;
    w0.x = cvtpk(p0[0], p0[1]); w0.y = cvtpk(p0[2], p0[3]); w0.z = cvtpk(p0[4], p0[5]); w0.w = cvtpk(p0[6], p0[7]);
    w1.x = cvtpk(p0[8], p0[9]); w1.y = cvtpk(p0[10], p0[11]); w1.z = cvtpk(p0[12], p0[13]); w1.w = cvtpk(p0[14], p0[15]);
    w2.x = cvtpk(p1[0], p1[1]); w2.y = cvtpk(p1[2], p1[3]); w2.z = cvtpk(p1[4], p1[5]); w2.w = cvtpk(p1[6], p1[7]);
    w3.x = cvtpk(p1[8], p1[9]); w3.y = cvtpk(p1[10], p1[11]); w3.z = cvtpk(p1[12], p1[13]); w3.w = cvtpk(p1[14], p1[15]);
    a0 = __builtin_bit_cast(bf16x8, w0); a1 = __builtin_bit_cast(bf16x8, w1); a2 = __builtin_bit_cast(bf16x8, w2); a3 = __builtin_bit_cast(bf16x8, w3);
}
DI void mask_range(f32x16& p0, f32x16& p1, int key0, int lo, int hi_, int hf) {
#pragma unroll
    for (int r = 0; r < 16; ++r) { const int k = key0 + crow(r, hf); if (k < lo || k > hi_) p0[r] = -INFINITY; if (k + 32 < lo || k + 32 > hi_) p1[r] = -INFINITY; }
}
DI float max3(float a, float b, float c) { return fmaxf(fmaxf(a, b), c); }
DI float rowmax32(const f32x16& p0, const f32x16& p1) {
    float a = max3(p0[0], p0[1], p0[2]), b = max3(p0[3], p0[4], p0[5]), c = max3(p0[6], p0[7], p0[8]), d = max3(p0[9], p0[10], p0[11]);
    a = max3(a, p0[12], p0[13]); b = max3(b, p0[14], p0[15]); c = max3(c, p1[0], p1[1]); d = max3(d, p1[2], p1[3]);
    a = max3(a, p1[4], p1[5]); b = max3(b, p1[6], p1[7]); c = max3(c, p1[8], p1[9]); d = max3(d, p1[10], p1[11]);
    a = max3(a, p1[12], p1[13]); b = max3(b, p1[14], p1[15]);
    return max32(fmaxf(fmaxf(a, b), fmaxf(c, d)));
}
struct State { float m, l; f32x16 o[2]; };
DI void st_init(State& s) { s.m = -INFINITY; s.l = 0.f;
#pragma unroll
    for (int i = 0; i < 16; ++i) { s.o[0][i] = 0.f; s.o[1][i] = 0.f; } }
DI void softmax_pv(State& st, f32x16& p0, f32x16& p1, int vb, LAS float* wsf, int r32, int hf) {
    const float rm = rowmax32(p0, p1);
    const float mn = fmaxf(st.m, rm), mu = (mn == -INFINITY) ? 0.f : mn;
    const float alpha = __builtin_amdgcn_exp2f(st.m - mu);
    st.m = mn;
    float ls0 = 0.f, ls1 = 0.f, ls2 = 0.f, ls3 = 0.f;
#pragma unroll
    for (int r = 0; r < 16; r += 2) { p0[r] = __builtin_amdgcn_exp2f(p0[r] - mu); p1[r] = __builtin_amdgcn_exp2f(p1[r] - mu); p0[r + 1] = __builtin_amdgcn_exp2f(p0[r + 1] - mu); p1[r + 1] = __builtin_amdgcn_exp2f(p1[r + 1] - mu);
        ls0 += p0[r]; ls1 += p1[r]; ls2 += p0[r + 1]; ls3 += p1[r + 1]; }
    st.l = st.l * alpha + ((ls0 + ls1) + (ls2 + ls3));
    if (__any(alpha != 1.0f)) {
        if (hf == 0) wsf[r32] = alpha;
        asm volatile("s_waitcnt lgkmcnt(0)" ::: "memory");
#pragma unroll
        for (int g = 0; g < 4; ++g) { const f32x4 a = *(const LAS f32x4*)(wsf + 8 * g + 4 * hf);
            st.o[0][4 * g] *= a.x; st.o[0][4 * g + 1] *= a.y; st.o[0][4 * g + 2] *= a.z; st.o[0][4 * g + 3] *= a.w;
            st.o[1][4 * g] *= a.x; st.o[1][4 * g + 1] *= a.y; st.o[1][4 * g + 2] *= a.z; st.o[1][4 * g + 3] *= a.w; }
    }
    bf16x8 a0, a1, a2, a3; pack_p(p0, p1, a0, a1, a2, a3);
    pv(st.o, vb, a0, a1, a2, a3);
}
DI void accum_scaled(f32x16* acc, const f32x16* o, float fac_row, LAS float* wsf, int r32, int hf) {
    if (hf == 0) wsf[32 + r32] = fac_row;
    asm volatile("s_waitcnt lgkmcnt(0)" ::: "memory");
#pragma unroll
    for (int g = 0; g < 4; ++g) { const f32x4 a = *(const LAS f32x4*)(wsf + 32 + 8 * g + 4 * hf);
        acc[0][4 * g] += o[0][4 * g] * a.x; acc[0][4 * g + 1] += o[0][4 * g + 1] * a.y; acc[0][4 * g + 2] += o[0][4 * g + 2] * a.z; acc[0][4 * g + 3] += o[0][4 * g + 3] * a.w;
        acc[1][4 * g] += o[1][4 * g] * a.x; acc[1][4 * g + 1] += o[1][4 * g + 1] * a.y; acc[1][4 * g + 2] += o[1][4 * g + 2] * a.z; acc[1][4 * g + 3] += o[1][4 * g + 3] * a.w; }
}
DI void stage_rows(const f32x16* acc, LAS bf16_t* stg, int r32, int hf) {
#pragma unroll
    for (int r = 0; r < 16; ++r) { const int orow = crow(r, hf);
        stg[orow * 64 + r32] = (bf16_t)f2bf(acc[0][r]); stg[orow * 64 + 32 + r32] = (bf16_t)f2bf(acc[1][r]); }
    asm volatile("s_waitcnt lgkmcnt(0)" ::: "memory");
}

DI void mla_unit(const Params& p, LAS unsigned char* lds, int b, int h, int qb, int wid0) {
    const int tid = opaque_tid(wid0), lane = tid & 63, r32 = lane & 31, hf = lane >> 5; const int wv = __builtin_amdgcn_readfirstlane(tid >> 6);
    const bf16_t* KN = wsp<bf16_t>(p, WS_KN); const bf16_t* VM = wsp<bf16_t>(p, WS_VM); bf16_t* OC = wsp<bf16_t>(p, WS_R1);
    const int rowbase = b * SEQ, q0 = qb * 256, tq = q0 + wv * 32 + r32, row = rowbase + tq;
    LAS float* wsf = (LAS float*)(lds + L_WS) + wv * 64;
    bf16x8 qr[6];
    {
        const bf16_t* src = wsp<bf16_t>(p, WS_R0) + (size_t)row * 768 + h * 96 + 8 * hf; float q[6][8]; float ss = 0.f;
#pragma unroll
        for (int d0 = 0; d0 < 6; ++d0) { unpack8(*(const u32x4*)(src + 16 * d0), q[d0]);
#pragma unroll
            for (int e = 0; e < 8; ++e) ss += q[d0][e] * q[d0][e]; }
        ss = sum32(ss);
        const float rstd = rsqrtf(ss * (1.f / 96.f) + EPS); const float* qg = p.in[I_MQG] + 8 * hf; const float* kg = p.in[I_MKG] + 8 * hf;
#pragma unroll
        for (int d0 = 0; d0 < 6; ++d0)
#pragma unroll
            for (int e = 0; e < 8; ++e) q[d0][e] *= rstd * qg[16 * d0 + e];
        const float* cs = ropeCM(p) + (size_t)row * 16 + 8 * hf; const float* sn = ropeSM(p) + (size_t)row * 16 + 8 * hf;
#pragma unroll
        for (int e = 0; e < 8; ++e) { const float x1 = q[4][e], x2 = q[5][e]; q[4][e] = x1 * cs[e] - x2 * sn[e]; q[5][e] = x2 * cs[e] + x1 * sn[e]; }
#pragma unroll
        for (int d0 = 0; d0 < 6; ++d0) { float f[8];
#pragma unroll
            for (int e = 0; e < 8; ++e) f[e] = q[d0][e] * ((d0 < 4) ? kg[16 * d0 + e] * C2M : C2M);
            qr[d0] = __builtin_bit_cast(bf16x8, pack8(f)); }
    }
    State st; st_init(st);
    const int NT = 4 * (qb + 1);
    u32x4 ka, kb2, vv;
    const bf16_t* kasrc = KN + (size_t)(rowbase + lane) * 768 + h * 96 + wv * 8;
    const bf16_t* vsrc = VM + (size_t)(rowbase + 16 * (wv & 3) + (lane >> 2)) * 512 + h * 64 + (wv >> 2) * 32 + (lane & 3) * 8;
#define MLA_LOAD(t) do { ka = *(const u32x4*)(kasrc + (size_t)(t) * 64 * 768); if (wv < 4) kb2 = *(const u32x4*)(kasrc + (size_t)(t) * 64 * 768 + 64); vv = *(const u32x4*)(vsrc + (size_t)(t) * 64 * 512); } while (0)
#define MLA_STORE(bf) do { *(LAS u32x4*)(lds + L_K + (bf) * KBUF + wv * 1024 + lane * 16) = ka; if (wv < 4) *(LAS u32x4*)(lds + L_K + (bf) * KBUF + (8 + wv) * 1024 + lane * 16) = kb2; \
        *(LAS u32x4*)(lds + L_V + (bf) * VBUF + wv * 1024 + lane * 16) = vv; } while (0)
    __syncthreads();
    MLA_LOAD(0); MLA_STORE(0); if (NT > 1) MLA_LOAD(1);
    const int vboff = ((lane >> 4) & 1) * 32 + (lane & 3) * 8 + (4 * hf + ((lane & 15) >> 2)) * 64;
    const int qlo = q0 + wv * 32;
    for (int i = 0; i < NT; ++i) {
        __syncthreads();
        if (i + 1 < NT) { MLA_STORE((i + 1) & 1); if (i + 2 < NT) MLA_LOAD(i + 2); }
        const int key0 = i * 64, bf = i & 1;
        if (key0 <= qlo + 31) {
            f32x16 p0, p1; qkt<96>(p0, p1, (lds_cptr)(lds + L_K + bf * KBUF) + hf * 1024 + r32 * 16, qr);
            if (key0 + 63 > qlo) mask_range(p0, p1, key0, 0, tq, hf);
            softmax_pv(st, p0, p1, (int)(uintptr_t)(lds + L_V + bf * VBUF) + vboff, wsf, r32, hf);
        }
    }
#undef MLA_LOAD
#undef MLA_STORE
    const float lt = sum32(st.l);
    f32x16 acc[2];
#pragma unroll
    for (int i = 0; i < 16; ++i) { acc[0][i] = 0.f; acc[1][i] = 0.f; }
    accum_scaled(acc, st.o, 1.0f / lt, wsf, r32, hf);
    LAS bf16_t* stg = (LAS bf16_t*)(lds + L_OST) + wv * 2048;
    stage_rows(acc, stg, r32, hf);
#pragma unroll
    for (int i = 0; i < 4; ++i) { const int rr = i * 8 + (lane >> 3), ch = lane & 7; const u32x4 v = *(const LAS u32x4*)(stg + rr * 64 + ch * 8);
        *(u32x4*)(OC + (size_t)(rowbase + q0 + wv * 32 + rr) * 1024 + h * 64 + ch * 8) = v; }
}

DI void nsa_unit(const Params& p, LAS unsigned char* lds, int b, int g, int c, int wid0) {
    const int tid = opaque_tid(wid0), lane = tid & 63, r32 = lane & 31, hf = lane >> 5; const int wv = __builtin_amdgcn_readfirstlane(tid >> 6);
    const bf16_t* QN = wsp<bf16_t>(p, WS_QN); const bf16_t* KCF = wsp<bf16_t>(p, WS_KCF); const bf16_t* VCF = wsp<bf16_t>(p, WS_VCF);
    const bf16_t* KS = wsp<bf16_t>(p, WS_KS); const bf16_t* VS = wsp<bf16_t>(p, WS_VS); const bf16_t* KW = wsp<bf16_t>(p, WS_KW); const bf16_t* VW = wsp<bf16_t>(p, WS_VW);
    const bf16_t* GN = wsp<bf16_t>(p, WS_GN); bf16_t* OC = wsp<bf16_t>(p, WS_R1);
    const int rowbase = b * SEQ, tt = 8 * wv + (r32 >> 2), hd = g * 4 + (r32 & 3), tq = 64 * c + tt, row = rowbase + tq;
    LAS float* wsf = (LAS float*)(lds + L_WS) + wv * 64;
    bf16x8 qr[4];
#pragma unroll
    for (int d0 = 0; d0 < 4; ++d0) qr[d0] = *(const bf16x8*)(QN + (size_t)row * 512 + hd * 64 + 16 * d0 + 8 * hf);
    const float g0 = bf2f(GN[(size_t)row * 32 + hd * 3 + 0]), g1 = bf2f(GN[(size_t)row * 32 + hd * 3 + 1]), g2 = bf2f(GN[(size_t)row * 32 + hd * 3 + 2]);
    f32x16 ot[2];
#pragma unroll
    for (int i = 0; i < 16; ++i) { ot[0][i] = 0.f; ot[1][i] = 0.f; }
    const int vboff = ((lane >> 4) & 1) * 32 + (lane & 3) * 8 + (4 * hf + ((lane & 15) >> 2)) * 64;
    u32x4 ka, vv;
#define NSA_LOAD(KB, VB, krow0) do { ka = *(const u32x4*)((KB) + (size_t)((krow0) + lane) * 128 + g * 64 + wv * 8); \
        vv = *(const u32x4*)((VB) + (size_t)((krow0) + 16 * (wv & 3) + (lane >> 2)) * 128 + g * 64 + (wv >> 2) * 32 + (lane & 3) * 8); } while (0)
#define NSA_STORE(koff, voff) do { *(LAS u32x4*)(lds + (koff) + wv * 1024 + lane * 16) = ka; *(LAS u32x4*)(lds + (voff) + wv * 1024 + lane * 16) = vv; } while (0)
    unsigned selmask;
    {
        const int ntile = (4 * c + 3 > 64) ? 2 : 1;
        const int nmax = (tq >= 31) ? ((tq - 31) >> 4) : -1;
        __syncthreads();
        NSA_LOAD(KCF, VCF, b * 128); NSA_STORE(L_K, L_V);
        if (ntile == 2) { NSA_LOAD(KCF, VCF, b * 128 + 64); NSA_STORE(L_K + 8192, L_V + 8192); }
        __syncthreads();
        f32x16 pa0, pa1, pb0, pb1;
        qkt<64>(pa0, pa1, (lds_cptr)(lds + L_K) + hf * 1024 + r32 * 16, qr); mask_range(pa0, pa1, 0, 0, nmax, hf);
        float m = rowmax32(pa0, pa1);
        if (ntile == 2) { qkt<64>(pb0, pb1, (lds_cptr)(lds + L_K + 8192) + hf * 1024 + r32 * 16, qr); mask_range(pb0, pb1, 64, 0, nmax, hf); m = fmaxf(m, rowmax32(pb0, pb1)); }
        else {
#pragma unroll
            for (int i = 0; i < 16; ++i) { pb0[i] = -INFINITY; pb1[i] = -INFINITY; } }
        const float mu = (m == -INFINITY) ? 0.f : m;
        float ls = 0.f;
#pragma unroll
        for (int r = 0; r < 16; ++r) { pa0[r] = __builtin_amdgcn_exp2f(pa0[r] - mu); pa1[r] = __builtin_amdgcn_exp2f(pa1[r] - mu); pb0[r] = __builtin_amdgcn_exp2f(pb0[r] - mu); pb1[r] = __builtin_amdgcn_exp2f(pb1[r] - mu);
            ls += (pa0[r] + pa1[r]) + (pb0[r] + pb1[r]); }
        ls = sum32(ls);
        const float rl = (ls > 0.f) ? 1.0f / ls : 0.f;
#pragma unroll
        for (int r = 0; r < 16; ++r) { pa0[r] *= rl; pa1[r] *= rl; pb0[r] *= rl; pb1[r] *= rl; }
        float own[16], ee[16];
#pragma unroll
        for (int q = 0; q < 4; ++q) {
            own[q] = (pa0[4 * q] + pa0[4 * q + 1]) + (pa0[4 * q + 2] + pa0[4 * q + 3]); ee[q] = pa0[4 * q + 3];
            own[4 + q] = (pa1[4 * q] + pa1[4 * q + 1]) + (pa1[4 * q + 2] + pa1[4 * q + 3]); ee[4 + q] = pa1[4 * q + 3];
            own[8 + q] = (pb0[4 * q] + pb0[4 * q + 1]) + (pb0[4 * q + 2] + pb0[4 * q + 3]); ee[8 + q] = pb0[4 * q + 3];
            own[12 + q] = (pb1[4 * q] + pb1[4 * q + 1]) + (pb1[4 * q + 2] + pb1[4 * q + 3]); ee[12 + q] = pb1[4 * q + 3]; }
        float eo[16];
#pragma unroll
        for (int k = 0; k < 16; ++k) eo[k] = xor32(ee[k], hf);
#pragma unroll
        for (int k = 0; k < 16; ++k) { const float add = hf ? eo[k] : ((k > 0) ? eo[k - 1] : 0.f); own[k] += add; }
#pragma unroll
        for (int k = 0; k < 16; ++k) { own[k] += xorl<1>(own[k]); own[k] += xorl<2>(own[k]); }
        float imp[32];
#pragma unroll
        for (int k = 0; k < 16; ++k) { const float oth = xor32(own[k], hf); imp[2 * k] = hf ? oth : own[k]; imp[2 * k + 1] = hf ? own[k] : oth; }
        selmask = select_blocks(imp, c);
        State sc; st_init(sc);
        { bf16x8 a0, a1, a2, a3; pack_p(pa0, pa1, a0, a1, a2, a3); pv(sc.o, (int)(uintptr_t)(lds + L_V) + vboff, a0, a1, a2, a3); }
        if (ntile == 2) { bf16x8 a0, a1, a2, a3; pack_p(pb0, pb1, a0, a1, a2, a3); pv(sc.o, (int)(uintptr_t)(lds + L_V + 8192) + vboff, a0, a1, a2, a3); }
        accum_scaled(ot, sc.o, g0, wsf, r32, hf);
    }
#pragma unroll 1
    for (int br = 1; br < 3; ++br) {
        const bf16_t* KB = (br == 1) ? KS : KW; const bf16_t* VB = (br == 1) ? VS : VW;
        const int NT = (br == 1) ? (c + 1) : ((c + 1 < 5) ? c + 1 : 5);
        const int lo = (br == 1) ? 0 : tq - 255;
        State st; st_init(st);
        __syncthreads();
        NSA_LOAD(KB, VB, rowbase + c * 64); NSA_STORE(L_K, L_V); if (NT > 1) NSA_LOAD(KB, VB, rowbase + (c - 1) * 64);
        for (int i = 0; i < NT; ++i) {
            __syncthreads();
            if (i + 1 < NT) { NSA_STORE(L_K + ((i + 1) & 1) * KBUF, L_V + ((i + 1) & 1) * VBUF); if (i + 2 < NT) NSA_LOAD(KB, VB, rowbase + (c - i - 2) * 64); }
            const int j = c - i, key0 = j * 64, bf = i & 1;
            const bool sel = (br == 2) || ((selmask >> j) & 1u);
            if (__any(sel)) {
                f32x16 p0, p1; qkt<64>(p0, p1, (lds_cptr)(lds + L_K + bf * KBUF) + hf * 1024 + r32 * 16, qr);
                if (br == 1) { if (i == 0) mask_range(p0, p1, key0, 0, tq, hf);
                    if (!sel) {
#pragma unroll
                        for (int r = 0; r < 16; ++r) { p0[r] = -INFINITY; p1[r] = -INFINITY; } } }
                else { if (i == 0 || i == 4) mask_range(p0, p1, key0, lo, tq, hf); }
                softmax_pv(st, p0, p1, (int)(uintptr_t)(lds + L_V + bf * VBUF) + vboff, wsf, r32, hf);
            }
        }
        const float lt = sum32(st.l);
        accum_scaled(ot, st.o, ((br == 1) ? g1 : g2) / lt, wsf, r32, hf);
    }
#undef NSA_LOAD
#undef NSA_STORE
    LAS bf16_t* stg = (LAS bf16_t*)(lds + L_OST) + wv * 2048;
    stage_rows(ot, stg, r32, hf);
#pragma unroll
    for (int i = 0; i < 4; ++i) { const int rr = i * 8 + (lane >> 3), ch = lane & 7; const u32x4 v = *(const LAS u32x4*)(stg + rr * 64 + ch * 8);
        *(u32x4*)(OC + (size_t)(rowbase + 64 * c + 8 * wv + (rr >> 2)) * 1024 + 512 + (g * 4 + (rr & 3)) * 64 + ch * 8) = v; }
}
#undef FA_SBAR
}

DI void stage_attn_fast(const Params& p, LAS unsigned char* lds, int bid, int nb, bool do_mla, bool do_nsa, int wid0) {
    if (do_mla) for (int u = bid; u < 256; u += nb) { const int bh = u >> 2, s = u & 3; fa::mla_unit(p, lds, bh >> 3, bh & 7, 7 - s, wid0); fa::mla_unit(p, lds, bh >> 3, bh & 7, s, wid0); }
    if (do_nsa) for (int u = bid; u < 256; u += nb) { const int bg = u >> 4, s = u & 15; fa::nsa_unit(p, lds, bg >> 1, bg & 1, 31 - s, wid0); fa::nsa_unit(p, lds, bg >> 1, bg & 1, s, wid0); }
    __syncthreads();
}
#define XB_TMO      128
#define XB_XCNT(j)  (256  + 64 * (j))
#define XB_XSUB(j)  (1280 + 64 * (j))
#define XB_XGEN(j)  (2304 + 64 * (j))
#define XB_TOP      3328
#define XB_TOPGEN   3392
#define XCD_BAR_WORDS 3456
#define XB_SPIN_CAP (1u << 18)

__device__ __forceinline__ unsigned xb_ld(unsigned* p)              { return __hip_atomic_load(p, __ATOMIC_RELAXED, __HIP_MEMORY_SCOPE_AGENT); }
__device__ __forceinline__ unsigned xb_add(unsigned* p, unsigned v) { return __hip_atomic_fetch_add(p, v, __ATOMIC_RELAXED, __HIP_MEMORY_SCOPE_AGENT); }
__device__ __forceinline__ unsigned xb_xcc_id() { return (unsigned)__builtin_amdgcn_s_getreg((3 << 11) | 20) & 0xFu; }
#define XB_SPIN(cond, bar) do { unsigned _sp = 0; while (cond) { __builtin_amdgcn_s_sleep(1); \
    if ((++_sp & 255u) == 0u) { if (xb_ld(&(bar)[XB_TMO])) break; if (_sp > XB_SPIN_CAP) { atomicAdd(&(bar)[XB_TMO], 1u); break; } } } } while (0)

struct XcdBarrier {
    unsigned* bar; unsigned x;
    volatile LAS unsigned* st;
};

__device__ __forceinline__ XcdBarrier xcd_barrier_post(unsigned* bar, volatile LAS unsigned* st, bool t0) {
    XcdBarrier b; b.bar = bar; b.x = xb_xcc_id(); b.st = st;
    if (t0) (void)xb_add(&bar[XB_XCNT(b.x)], 1u);
    return b;
}
__device__ __forceinline__ void xcd_barrier_complete(unsigned* bar, unsigned x, unsigned& nloc, unsigned& nx) {
    const unsigned G = gridDim.x * gridDim.y * gridDim.z;
    unsigned sum, cnt, mine, sp = 0u;
    for (;;) {
        sum = 0u; cnt = 0u; mine = 0u;
#pragma unroll
        for (unsigned j = 0; j < 16; ++j) { const unsigned c = xb_ld(&bar[XB_XCNT(j)]); sum += c; cnt += (c > 0u) ? 1u : 0u; mine = (j == x) ? c : mine; }
        if (sum == G) break;
        __builtin_amdgcn_s_sleep(1);
        if ((++sp & 255u) == 0u) { if (xb_ld(&bar[XB_TMO])) break; if (sp > XB_SPIN_CAP) { atomicAdd(&bar[XB_TMO], 1u); break; } }
    }
    nloc = mine > 0u ? mine : 1u; nx = cnt > 0u ? cnt : 1u;
}

__device__ __forceinline__ void xcd_barrier(const XcdBarrier& b, bool t0) {
    asm volatile("s_waitcnt vmcnt(0)" ::: "memory");
    __syncthreads();
    if (t0) {
        unsigned* bar = b.bar;
        __builtin_amdgcn_s_waitcnt(0);
        unsigned nloc = b.st[0], nx = b.st[1];
        if (nloc == 0u) { xcd_barrier_complete(bar, b.x, nloc, nx); b.st[0] = nloc; b.st[1] = nx; }
        const unsigned old = xb_add(&bar[XB_XSUB(b.x)], 1u);
        const unsigned gen = old / nloc;
        if (old + 1u == (gen + 1u) * nloc) {
            __builtin_amdgcn_fence(__ATOMIC_RELEASE, "agent");
            asm volatile("s_waitcnt vmcnt(0)" ::: "memory");
            const unsigned og = xb_add(&bar[XB_TOP], 1u);
            const unsigned tg = og / nx;
            if (og + 1u == (tg + 1u) * nx) xb_add(&bar[XB_TOPGEN], 1u);
            else XB_SPIN(xb_ld(&bar[XB_TOPGEN]) == tg, bar);
            __builtin_amdgcn_fence(__ATOMIC_ACQUIRE, "agent");
            xb_add(&bar[XB_XGEN(b.x)], 1u);
            asm volatile("s_waitcnt vmcnt(0)" ::: "memory");
        } else {
            XB_SPIN(xb_ld(&bar[XB_XGEN(b.x)]) == gen, bar);
            __builtin_amdgcn_fence(__ATOMIC_ACQUIRE, "agent");
            asm volatile("s_waitcnt vmcnt(0)" ::: "memory");
        }
    }
    __syncthreads();
}
constexpr int LDS_BYTES = 147456;
#ifndef REPEAT_PHASE
#define REPEAT_PHASE -1
#endif
#define REP(k) for (int rep_ = 0; rep_ < ((REPEAT_PHASE == (k)) ? 2 : 1); ++rep_)
#ifndef USE_CG_SYNC
#define USE_CG_SYNC 0
#endif

typedef const Params __attribute__((address_space(4)))* KParamsPtr;
#if defined(__HIP_DEVICE_COMPILE__)
DI KParamsPtr kparams() { KParamsPtr k = (KParamsPtr)__builtin_amdgcn_kernarg_segment_ptr(); asm volatile("" : "+s"(k)); return k; }
#endif
#if defined(__HIP_DEVICE_COMPILE__)
#define PHASE_PARAMS() const Params p = *kparams()
#else
#define PHASE_PARAMS() const Params p = p_arg
#endif
__global__ void __launch_bounds__(512, 2) fwd_megakernel(Params p_arg) {
    extern __shared__ __attribute__((aligned(16))) unsigned char dlds[];
    LAS unsigned char* lds = (LAS unsigned char*)dlds;
#if USE_CG_SYNC
    cg::grid_group grid = cg::this_grid();
#endif
    const int G = gridDim.x, c = blockIdx.x, ngw = G * NWAVE, ngt = G * NTHR;
    const int wid0 = __builtin_amdgcn_readfirstlane(threadIdx.x >> 6);
#define TIDS() const int tid = opaque_tid(wid0), lane = tid & 63, wave = tid >> 6, gw = c * NWAVE + wave, gtid = c * NTHR + tid; (void)lane; (void)gw; (void)gtid
#if USE_CG_SYNC
#define GRID_SYNC() grid.sync()
#else
    volatile LAS unsigned* MISC = (volatile LAS unsigned*)(lds + 131072 + 320);
    { TIDS(); if (tid < 32) MISC[tid] = 0u; }
    __syncthreads();
    XcdBarrier bar;
    { PHASE_PARAMS(); TIDS(); bar = xcd_barrier_post((unsigned*)(p.ws + WS_CTL) + 4096, MISC + 8, tid == 0); }
#ifdef DOUBLE_BAR
#define GRID_SYNC() do { TIDS(); xcd_barrier(bar, tid == 0); xcd_barrier(bar, tid == 0); } while (0)
#else
#define GRID_SYNC() do { TIDS(); xcd_barrier(bar, tid == 0); } while (0)
#endif
#endif
    REP(0) { PHASE_PARAMS();
    { TIDS(); stage_weights(p, gw, ngw, (float*)dlds + wave * (64 * 33), lane); }
    __syncthreads();
    stage_mod(p, c, G, (float*)dlds, wid0);
    __syncthreads();
    { TIDS(); stage_rope(p, tid, gtid, ngt, (float*)dlds + 16384); } }
    GRID_SYNC();
    REP(1) { PHASE_PARAMS(); TIDS(); stage_normmod(p.in[I_X], p.in[I_N1G], wsp<float>(p, WS_MOD), 0, 1, wsp<bf16_t>(p, WS_R0), gw, ngw, lane); stage_shw(p, gw, ngw, lane); }
    GRID_SYNC();
    REP(2) { PHASE_PARAMS(); EpiZ E{p}; gemm_fast(lds, wsp<bf16_t>(p, WS_R0), 1024, wsp<bf16_t>(p, WS_WIN), MT, ZN, 1024, E, G, c, wid0); }
    GRID_SYNC();
    REP(3) { PHASE_PARAMS();
      int qb, qc, kb, kc;
      if (G == 256) { qb = c; qc = (c < 192) ? 1 : 0; kb = (c < 192) ? c : (c >= 224 ? 192 + 2 * (c - 224) : 0); kc = (c < 192) ? 1 : (c >= 224 ? 2 : 0); }
      else { const int pq = (192 + G - 1) / G, pk = (256 + G - 1) / G; qb = c * pq; qc = (192 - qb < pq) ? ((192 - qb > 0) ? 192 - qb : 0) : pq; kb = c * pk; kc = (256 - kb < pk) ? ((256 - kb > 0) ? 256 - kb : 0) : pk; }
      { EpiQ E{p}; gemm_fast_range(lds, wsp<bf16_t>(p, WS_R1), 1024, wsp<bf16_t>(p, WS_WQB), MT, 768, 768, E, qb, qc, wid0); }
      for (int cu = (c + 64) % G; cu < 32; cu += G) cmp_hidden_fast(p, lds, cu, wid0);
      { EpiKV E{p}; gemm_fast_range(lds, wsp<bf16_t>(p, WS_R1) + 768, 1024, wsp<bf16_t>(p, WS_WKVB), MT, 1024, 256, E, kb, kc, wid0); }
    }
    GRID_SYNC();
    { PHASE_PARAMS(); TIDS(); cmp_out<true>(p, gw, ngw, lane); }
    REP(4) { PHASE_PARAMS(); stage_attn_fast(p, lds, c, G, true, false, wid0); }
    GRID_SYNC();
    REP(5) { PHASE_PARAMS(); stage_attn_fast(p, lds, c, G, false, true, wid0); }
    GRID_SYNC();
    REP(6) { PHASE_PARAMS(); EpiMerge E{p}; gemm_fast(lds, wsp<bf16_t>(p, WS_R1), 1024, wsp<bf16_t>(p, WS_WO), MT, 1024, 1024, E, G, c, wid0); }
    GRID_SYNC();
    REP(7) { PHASE_PARAMS(); EpiOut E{p}; gemm_fast(lds, wsp<bf16_t>(p, WS_R0), 1024, wsp<bf16_t>(p, WS_WOUT), MT, 1024, 1024, E, G, c, wid0); }
    GRID_SYNC();
    REP(9) { PHASE_PARAMS(); EpiGU E{p}; gemm_fast(lds, wsp<bf16_t>(p, WS_R1), 1024, wsp<bf16_t>(p, WS_WGU), MT, 5632, 1024, E, G, c, wid0); }
    GRID_SYNC();
    REP(10) { PHASE_PARAMS(); EpiDown E{p}; gemm_fast(lds, wsp<bf16_t>(p, WS_HID), DFF, wsp<bf16_t>(p, WS_WD), MT, 1024, DFF, E, G, c, wid0); }
}

extern "C" void kernel_launch(void* const* d_in, const int* in_sizes, int n_in, void* d_out, int out_size, void* d_ws, size_t ws_size, hipStream_t stream) {
    if (n_in != 30 || out_size != MT * DM || ws_size < WS_END) { fprintf(stderr, "kernel_launch: unexpected shapes (n_in %d out %d ws %zu)\n", n_in, out_size, ws_size); return; }
    static int grid = 0;
    if (grid == 0) {
        int dev = 0, cus = 0, per_cu = 0;
        hipGetDevice(&dev); hipDeviceGetAttribute(&cus, hipDeviceAttributeMultiprocessorCount, dev);
        hipFuncSetAttribute((const void*)fwd_megakernel, hipFuncAttributeMaxDynamicSharedMemorySize, LDS_BYTES);
        hipOccupancyMaxActiveBlocksPerMultiprocessor(&per_cu, (const void*)fwd_megakernel, NTHR, LDS_BYTES);
        if (per_cu < 1) { fprintf(stderr, "kernel_launch: occupancy query says %d blocks per CU\n", per_cu); per_cu = 1; }
        grid = cus;
        (void)hipGetLastError();
    }
    Params p{};
    for (int i = 0; i < 30; ++i) p.in[i] = (const float*)d_in[i];
    p.out = (float*)d_out; p.ws = (unsigned char*)d_ws;
    if (!USE_CG_SYNC) (void)hipMemsetAsync((char*)d_ws + WS_CTL, 0, 65536, stream);
    void* args[] = {&p};
#ifndef USE_COOP
#define USE_COOP 1
#endif
    hipError_t e;
    if (USE_COOP) e = hipLaunchCooperativeKernel((const void*)fwd_megakernel, dim3(grid), dim3(NTHR), args, LDS_BYTES, stream);
    else { hipLaunchKernelGGL(fwd_megakernel, dim3(grid), dim3(NTHR), LDS_BYTES, stream, p); e = hipPeekAtLastError(); }
    if (e != hipSuccess) fprintf(stderr, "kernel_launch: cooperative launch failed: %s (grid %d)\n", hipGetErrorString(e), grid);
}
```

```cpp
#include <hip/hip_runtime.h>
#include <hip/hip_cooperative_groups.h>
#include <cstdint>
#include <cstdio>
namespace cg = cooperative_groups;

typedef unsigned short bf16_t;
typedef unsigned u32x4 __attribute__((ext_vector_type(4)));
typedef unsigned u32x2 __attribute__((ext_vector_type(2)));
typedef float f32x4 __attribute__((ext_vector_type(4)));
typedef float f32x2 __attribute__((ext_vector_type(2)));
#define DI __device__ __forceinline__

constexpr int NB = 8, SEQ = 2048, DM = 1024, MT = NB * SEQ;
constexpr int DFF = 2816, NMOD = 6;
constexpr int ZN = 4608;
constexpr float EPS = 1e-6f;
constexpr float LOG2E = 1.4426950408889634f;
constexpr float C2N = 0.125f * LOG2E;
constexpr float C2M = 0.10206207261596575f * LOG2E;
constexpr int NTHR = 512, NWAVE = 8;
constexpr int O_CQ = 0, O_CKV = 768, O_KPE = 1024, O_QN = 1056, O_KC = 1568, O_VC = 1696, O_KS = 1824, O_VS = 1952, O_KW = 2080, O_VW = 2208,
              O_GN = 2336, O_GM = 2360, O_GNM = 3384, D_IN = 4408;

constexpr size_t MiB = 1u << 20;
constexpr size_t WS_CTL = 0;
constexpr size_t WS_MOD = 1 * MiB;
constexpr size_t WS_CB1 = 1 * MiB + 256 * 1024;
constexpr size_t WS_SSQPE = 1 * MiB + 320 * 1024;
constexpr size_t WS_SSQKN = 1 * MiB + 512 * 1024;
constexpr size_t WS_SSQA = 2 * MiB;
constexpr size_t WS_KCF = 3 * MiB;
constexpr size_t WS_VCF = 3 * MiB + 256 * 1024;
constexpr size_t WS_SHW = 3 * MiB + 512 * 1024;
constexpr size_t WS_WIN = 4 * MiB;
constexpr size_t WS_WQB = 13 * MiB;
constexpr size_t WS_WKVB = 15 * MiB;
constexpr size_t WS_WO = 16 * MiB;
constexpr size_t WS_WOUT = 18 * MiB;
constexpr size_t WS_WGU = 20 * MiB;
constexpr size_t WS_WD = 31 * MiB;
constexpr size_t WS_CW1 = 37 * MiB;
constexpr size_t WS_R0 = 40 * MiB;
constexpr size_t WS_R1 = 72 * MiB;
constexpr size_t WS_R2 = 104 * MiB;
constexpr size_t WS_QN = 168 * MiB;
constexpr size_t WS_KC = 184 * MiB, WS_VC = 188 * MiB, WS_KS = 192 * MiB, WS_VS = 196 * MiB, WS_KW = 200 * MiB, WS_VW = 204 * MiB;
constexpr size_t WS_KPE = 208 * MiB;
constexpr size_t WS_GN = 209 * MiB;
constexpr size_t WS_KN = 210 * MiB;
constexpr size_t WS_VM = 234 * MiB;
constexpr size_t WS_CMPH = 64 * MiB;
constexpr size_t WS_ROPE = 250 * MiB;
constexpr size_t WS_HID = 168 * MiB;
constexpr size_t WS_END = 256 * MiB;

struct Params {
    const float* in[30];
    float* out;
    unsigned char* ws;
};
enum { I_X = 0, I_C, I_POS, I_ADAW, I_ADAB, I_N1G, I_WIN, I_QAG, I_WQB, I_KVAG, I_WKVB, I_MQG, I_MKG, I_NQG, I_NKCG, I_NKSG, I_NKWG,
       I_CPK, I_CW1K, I_CW2K, I_CPV, I_CW1V, I_CW2V, I_WOM, I_WON, I_WOUT, I_N2G, I_WG, I_WU, I_WDN };

template <class T> DI T* wsp(const Params& p, size_t off) { return (T*)(p.ws + off); }

DI int lane_id() { return (int)__builtin_amdgcn_mbcnt_hi(~0u, __builtin_amdgcn_mbcnt_lo(~0u, 0u)); }
DI int opaque_tid(int wid0) { int l; asm volatile("v_mbcnt_lo_u32_b32 %0, -1, 0\n\tv_mbcnt_hi_u32_b32 %0, -1, %0" : "=v"(l)); return (wid0 << 6) | l; }
DI unsigned f2bf(float f) { unsigned u = __float_as_uint(f); return (u + 0x7fffu + ((u >> 16) & 1u)) >> 16; }
DI unsigned pk2(float lo, float hi) { return f2bf(lo) | (f2bf(hi) << 16); }
DI float bf2f(unsigned short b) { return __uint_as_float(((unsigned)b) << 16); }
DI float bflo(unsigned w) { return __uint_as_float(w << 16); }
DI float bfhi(unsigned w) { return __uint_as_float(w & 0xffff0000u); }
DI void unpack8(const u32x4 w, float (&f)[8]) { f[0] = bflo(w.x); f[1] = bfhi(w.x); f[2] = bflo(w.y); f[3] = bfhi(w.y); f[4] = bflo(w.z); f[5] = bfhi(w.z); f[6] = bflo(w.w); f[7] = bfhi(w.w); }
DI u32x4 pack8(const float (&f)[8]) { u32x4 w; w.x = pk2(f[0], f[1]); w.y = pk2(f[2], f[3]); w.z = pk2(f[4], f[5]); w.w = pk2(f[6], f[7]); return w; }
DI float sigmoidf(float x) { return __builtin_amdgcn_rcpf(1.0f + __expf(-x)); }
DI float siluf(float x) { return x * __builtin_amdgcn_rcpf(1.0f + __expf(-x)); }
template <int X> DI float xorl(float v) { return __int_as_float(__builtin_amdgcn_ds_swizzle(__float_as_int(v), (X << 10) | 0x1f)); }
DI void halves(float v, float& lo, float& hi) { auto rr = __builtin_amdgcn_permlane32_swap(__float_as_uint(v), __float_as_uint(v), false, false); lo = __uint_as_float(rr[0]); hi = __uint_as_float(rr[1]); }
DI float xor32(float v, int hf) { float lo, hi; halves(v, lo, hi); return hf ? lo : hi; }
DI float sum32(float v) { float lo, hi; halves(v, lo, hi); return lo + hi; }
DI float max32(float v) { float lo, hi; halves(v, lo, hi); return fmaxf(lo, hi); }
DI float wave_sum(float v) { v += xorl<1>(v); v += xorl<2>(v); v += xorl<4>(v); v += xorl<8>(v); v += xorl<16>(v); return sum32(v); }
DI void sincos_rad(float ang, float& c, float& s) {
    double rev = (double)ang * 0.15915494309189535; rev -= __builtin_rint(rev);
    const float fr = (float)rev; s = __builtin_amdgcn_sinf(fr); c = __builtin_amdgcn_cosf(fr);
}
#define LAS __attribute__((address_space(3)))
DI void transpose_item(const float* W, int ldw, int c0, int ncols, const float* rs, bf16_t* dst, int ldd, int n0, int k0, float* scr, int lane) {
    const int cc = lane & 31, kh = lane >> 5;
    float v[32];
    if (c0 >= 0) {
        const float* src = W + (size_t)(k0 + kh) * ldw + c0 + cc;
        if (cc < ncols) {
#pragma unroll
            for (int i = 0; i < 32; ++i) v[i] = src[(size_t)(2 * i) * ldw];
        } else {
#pragma unroll
            for (int i = 0; i < 32; ++i) v[i] = 0.f;
        }
        if (rs) {
#pragma unroll
            for (int i = 0; i < 32; ++i) v[i] *= rs[k0 + 2 * i + kh];
        }
    } else {
#pragma unroll
        for (int i = 0; i < 32; ++i) v[i] = 0.f;
    }
#pragma unroll
    for (int i = 0; i < 32; ++i) scr[(2 * i + kh) * 33 + cc] = v[i];
    __builtin_amdgcn_s_waitcnt(0xc07f);
    asm volatile("" ::: "memory");
    const int c = lane & 7;
#pragma unroll
    for (int j = 0; j < 4; ++j) { const int n = (lane >> 3) + 8 * j; const float* s = scr + (8 * c) * 33 + n;
        u32x4 o; o.x = pk2(s[0 * 33], s[1 * 33]); o.y = pk2(s[2 * 33], s[3 * 33]); o.z = pk2(s[4 * 33], s[5 * 33]); o.w = pk2(s[6 * 33], s[7 * 33]);
        *(u32x4*)(dst + (size_t)(n0 + n) * ldd + k0 + 8 * c) = o; }
    __builtin_amdgcn_s_waitcnt(0xc07f);
    asm volatile("" ::: "memory");
}
DI int zsrc(int s, int L0, int& ncols) {
    ncols = 32;
    if (s < 16) return 64 * s + L0;
    if (s == 16) { if (L0 == 0) return O_KPE; ncols = 24; return O_GN; }
    if (s < 25) return O_QN + 64 * (s - 17) + L0;
    if (s < 27) return O_KC + 64 * (s - 25) + L0;
    if (s < 29) return O_VC + 64 * (s - 27) + L0;
    if (s < 31) return O_KS + 64 * (s - 29) + L0;
    if (s < 33) return O_VS + 64 * (s - 31) + L0;
    if (s < 35) return O_KW + 64 * (s - 33) + L0;
    if (s < 37) return O_VW + 64 * (s - 35) + L0;
    if (s < 40) return -1;
    if (s < 56) return O_GM + 64 * (s - 40) + L0;
    return O_GNM + 64 * (s - 56) + L0;
}
DI void stage_weights(const Params& p, int gw, int ngw, float* scr, int lane) {
    constexpr int I_IN = (ZN / 32) * (DM / 64);
    constexpr int I_QB = (768 / 32) * (768 / 64);
    constexpr int I_KVB = (1024 / 32) * (256 / 64);
    constexpr int I_O = (1024 / 32) * (1024 / 64);
    constexpr int I_OUT = I_O;
    constexpr int I_GU = (5632 / 32) * (1024 / 64);
    constexpr int I_D = (1024 / 32) * (DFF / 64);
    constexpr int I_C1 = 2 * (256 / 32) * (2048 / 64);
    constexpr int NITEMS = I_IN + I_QB + I_KVB + I_O + I_OUT + I_GU + I_D + I_C1;
    for (int it = gw; it < NITEMS; it += ngw) {
        int r = it;
        if (r < I_IN) { const int nb = r / 16, kb = r % 16; const int pn = nb >> 3, bj = (nb >> 2) & 1, wc = nb & 3; int nc; const int c0 = zsrc(4 * pn + wc, 32 * bj, nc);
            transpose_item(p.in[I_WIN], D_IN, c0, nc, nullptr, wsp<bf16_t>(p, WS_WIN), DM, nb * 32, kb * 64, scr, lane); continue; } r -= I_IN;
        if (r < I_QB) { const int nb = r / 12, kb = r % 12; transpose_item(p.in[I_WQB], 768, nb * 32, 32, p.in[I_QAG], wsp<bf16_t>(p, WS_WQB), 768, nb * 32, kb * 64, scr, lane); continue; } r -= I_QB;
        if (r < I_KVB) { const int nb = r / 4, kb = r % 4; const int pn = nb >> 3, bj = (nb >> 2) & 1, wc = nb & 3, s = 4 * pn + wc;
            const int c0 = (s < 8) ? (128 * s + 32 * bj) : (128 * (s - 8) + 64 + 32 * bj);
            transpose_item(p.in[I_WKVB], 1024, c0, 32, p.in[I_KVAG], wsp<bf16_t>(p, WS_WKVB), 256, nb * 32, kb * 64, scr, lane); continue; } r -= I_KVB;
        if (r < I_O) { const int nb = r / 16, kb = r % 16;
            if (kb < 8) transpose_item(p.in[I_WOM], 1024, nb * 32, 32, nullptr, wsp<bf16_t>(p, WS_WO), 1024, nb * 32, kb * 64, scr, lane);
            else transpose_item(p.in[I_WON] - (size_t)512 * 1024, 1024, nb * 32, 32, nullptr, wsp<bf16_t>(p, WS_WO), 1024, nb * 32, kb * 64, scr, lane);
            continue; } r -= I_O;
        if (r < I_OUT) { const int nb = r / 16, kb = r % 16; transpose_item(p.in[I_WOUT], 1024, nb * 32, 32, nullptr, wsp<bf16_t>(p, WS_WOUT), 1024, nb * 32, kb * 64, scr, lane); continue; } r -= I_OUT;
        if (r < I_GU) { const int nb = r / 16, kb = r % 16; const int pn = nb >> 3, bj = (nb >> 2) & 1, wc = nb & 3, s = 4 * pn + wc;
            transpose_item(bj ? p.in[I_WU] : p.in[I_WG], DFF, 32 * s, 32, nullptr, wsp<bf16_t>(p, WS_WGU), 1024, nb * 32, kb * 64, scr, lane); continue; } r -= I_GU;
        if (r < I_D) { const int nb = r / 44, kb = r % 44; transpose_item(p.in[I_WDN], 1024, nb * 32, 32, nullptr, wsp<bf16_t>(p, WS_WD), DFF, nb * 32, kb * 64, scr, lane); continue; } r -= I_D;
        { const int kv = r / 256, rr = r % 256, nb = rr / 32, kb = rr % 32;
          transpose_item(kv ? p.in[I_CW1V] : p.in[I_CW1K], 256, nb * 32, 32, nullptr, wsp<bf16_t>(p, WS_CW1) + (size_t)kv * 256 * 2048, 2048, nb * 32, kb * 64, scr, lane); }
    }
}
DI void stage_mod(const Params& p, int bid, int nb, float* lds, int wid0) {
    const int tid = opaque_tid(wid0), wave = tid >> 6, lane = tid & 63, nwv = blockDim.x >> 6;
    if (bid >= 104) return;
    float* sl = lds; float* red = lds + 8192;
    for (int i = tid; i < 8192; i += blockDim.x) sl[i] = siluf(p.in[I_C][i]);
    __syncthreads();
    for (int u = bid; u < 104; u += nb) {
        float acc[8];
#pragma unroll
        for (int b = 0; b < 8; ++b) acc[b] = 0.f;
        if (u < 96) {
            const float* W = p.in[I_ADAW] + u * 64 + lane; const int kn = 1024 / nwv;
            for (int k = wave * kn; k < (wave + 1) * kn; k += 8) { float w[8];
#pragma unroll
                for (int e = 0; e < 8; ++e) w[e] = W[(size_t)(k + e) * 6144];
#pragma unroll
                for (int e = 0; e < 8; ++e)
#pragma unroll
                    for (int b = 0; b < 8; ++b) acc[b] += sl[b * 1024 + k + e] * w[e]; }
        } else {
            const int kv = (u - 96) >> 2; const float* W = (kv ? p.in[I_CW1V] : p.in[I_CW1K]) + ((u - 96) & 3) * 64 + lane; const float* pos = kv ? p.in[I_CPV] : p.in[I_CPK]; const int kn = 2048 / nwv;
            for (int k = wave * kn; k < (wave + 1) * kn; k += 8) { float w[8];
#pragma unroll
                for (int e = 0; e < 8; ++e) w[e] = W[(size_t)(k + e) * 256];
#pragma unroll
                for (int e = 0; e < 8; ++e) acc[0] += pos[k + e] * w[e]; }
        }
        __syncthreads();
#pragma unroll
        for (int b = 0; b < 8; ++b) red[(wave * 8 + b) * 64 + lane] = acc[b];
        __syncthreads();
        if (wave == 0) {
#pragma unroll
            for (int b = 0; b < 8; ++b) { float s = 0.f;
                for (int w = 0; w < nwv; ++w) s += red[(w * 8 + b) * 64 + lane];
                if (u < 96) wsp<float>(p, WS_MOD)[b * 6144 + u * 64 + lane] = s + p.in[I_ADAB][u * 64 + lane];
                else if (b == 0) wsp<float>(p, WS_CB1)[(u - 96) * 64 + lane] = s; }
        }
    }
}
DI void stage_rope(const Params& p, int tid, int gtid, int ngt, float* invt) {
    if (tid < 24) invt[tid] = (tid < 16) ? (float)pow(500000.0, -(double)tid / 16.0) : (float)pow(500000.0, -(double)(tid - 16) / 8.0);
    __syncthreads();
    float* T = wsp<float>(p, WS_ROPE); const int* pos = (const int*)p.in[I_POS];
    for (int i = gtid; i < MT * 24; i += ngt) {
        const int row = i / 24, j = i % 24; const float ps = (float)pos[row]; float c, s;
        sincos_rad(ps * invt[j], c, s);
        if (j < 16) { T[(size_t)row * 16 + j] = c; T[(size_t)MT * 16 + (size_t)row * 16 + j] = s; }
        else { T[(size_t)MT * 32 + (size_t)row * 8 + (j - 16)] = c; T[(size_t)MT * 40 + (size_t)row * 8 + (j - 16)] = s; }
    }
}
DI const float* ropeCM(const Params& p) { return wsp<float>(p, WS_ROPE); }
DI const float* ropeSM(const Params& p) { return wsp<float>(p, WS_ROPE) + (size_t)MT * 16; }
DI const float* ropeCN(const Params& p) { return wsp<float>(p, WS_ROPE) + (size_t)MT * 32; }
DI const float* ropeSN(const Params& p) { return wsp<float>(p, WS_ROPE) + (size_t)MT * 40; }

DI void stage_normmod(const float* X, const float* gain, const float* mod, int sh_idx, int sc_idx, bf16_t* Hout, int gw, int ngw, int lane) {
    for (int m = gw; m < MT; m += ngw) {
        const int b = m / SEQ; const f32x4* xr = (const f32x4*)(X + (size_t)m * DM) + lane;
        f32x4 v[4]; float s = 0.f;
#pragma unroll
        for (int j = 0; j < 4; ++j) { v[j] = xr[64 * j]; s += (v[j].x * v[j].x + v[j].y * v[j].y) + (v[j].z * v[j].z + v[j].w * v[j].w); }
        const float rstd = rsqrtf(wave_sum(s) * (1.f / DM) + EPS);
        const f32x4* g4 = (const f32x4*)gain + lane; const f32x4* sc4 = (const f32x4*)(mod + b * 6144 + sc_idx * 1024) + lane; const f32x4* sh4 = (const f32x4*)(mod + b * 6144 + sh_idx * 1024) + lane;
        u32x2* o8 = (u32x2*)(Hout + (size_t)m * DM) + lane;
#pragma unroll
        for (int j = 0; j < 4; ++j) { const f32x4 g = g4[64 * j], sc = sc4[64 * j], sh = sh4[64 * j];
            const f32x4 y = v[j] * rstd * g * (1.0f + sc) + sh; u32x2 w; w.x = pk2(y.x, y.y); w.y = pk2(y.z, y.w); o8[64 * j] = w; }
    }
}

DI void stage_shw(const Params& p, int gw, int ngw, int lane) {
    const bf16_t* W = wsp<bf16_t>(p, WS_WGU); const float* md = wsp<float>(p, WS_MOD) + 3 * 1024 + 16 * lane; float* out = wsp<float>(p, WS_SHW);
    for (int n = gw; n < 5632; n += ngw) {
        float w[16]; { float t[8]; unpack8(*(const u32x4*)(W + (size_t)n * 1024 + 16 * lane), t);
#pragma unroll
            for (int e = 0; e < 8; ++e) w[e] = t[e];
            unpack8(*(const u32x4*)(W + (size_t)n * 1024 + 16 * lane + 8), t);
#pragma unroll
            for (int e = 0; e < 8; ++e) w[8 + e] = t[e]; }
#pragma unroll
        for (int b = 0; b < 8; ++b) { float acc = 0.f;
#pragma unroll
            for (int q = 0; q < 4; ++q) { const f32x4 sv = *(const f32x4*)(md + b * 6144 + 4 * q); acc += (sv.x * w[4 * q] + sv.y * w[4 * q + 1]) + (sv.z * w[4 * q + 2] + sv.w * w[4 * q + 3]); }
            acc = wave_sum(acc);
            if (lane == 0) out[b * 5632 + n] = acc; }
    }
}
struct ColPre { f32x4 c[8]; };
struct RowPre { f32x4 a[4]; };
DI void store8bf(bf16_t* dst, const float (&f)[8]) { *(u32x4*)dst = pack8(f); }
DI float ssq16(const float (&v)[2][8]) { float q = 0.f;
#pragma unroll
    for (int b = 0; b < 2; ++b)
#pragma unroll
        for (int j = 0; j < 8; ++j) q += v[b][j] * v[b][j];
    q += xorl<16>(q); return sum32(q); }
DI f32x4 ld4(const float* p) { return *(const f32x4*)p; }
DI f32x4 ld4u(const bf16_t* p) { return __builtin_bit_cast(f32x4, *(const u32x4*)p); }
DI void un8(const f32x4 raw, float (&f)[8]) { unpack8(__builtin_bit_cast(u32x4, raw), f); }

struct EpiZ {
    static constexpr bool HAS_MID = false; static constexpr int NTYPES = 7;
    Params p;
    DI void midpre(RowPre&, int, int, int, int) const {}
    DI void mid(const RowPre&, int, int, int, int, float (&)[2][8]) const {}
    DI int type(int pn, int wc) const { const int s = 4 * pn + wc;
        if (s < 16) return 0; if (s == 16) return 1; if (s < 25) return 2; if (s < 37) { const int t = (s - 25) >> 1; return (t == 2 || t == 4) ? 3 : 4; } if (s < 40) return 5; return 6; }
    template <int T> DI void ubegin(ColPre& U, int, int pn, int wc, int fq) const {
        const int s = 4 * pn + wc; (void)s;
        if constexpr (T == 1) { U.c[0] = ld4(p.in[I_MKG] + 64 + 8 * fq); U.c[1] = ld4(p.in[I_MKG] + 68 + 8 * fq); }
        if constexpr (T == 2 || T == 3) { const float* gain = (T == 2) ? p.in[I_NQG] : ((((s - 25) >> 1) == 2) ? p.in[I_NKSG] : p.in[I_NKWG]);
            U.c[0] = ld4(gain + 8 * fq); U.c[1] = ld4(gain + 8 * fq + 4); U.c[2] = ld4(gain + 32 + 8 * fq); U.c[3] = ld4(gain + 36 + 8 * fq); }
    }
    template <int T> DI void pre(RowPre& R, int row, int, int, int fq) const {
        if constexpr (T == 1) { const int i0 = 8 * (fq & 1); const float* cs = ropeCM(p) + (size_t)row * 16 + i0; const float* sn = ropeSM(p) + (size_t)row * 16 + i0;
            R.a[0] = ld4(cs); R.a[1] = ld4(cs + 4); R.a[2] = ld4(sn); R.a[3] = ld4(sn + 4); }
        if constexpr (T == 2 || T == 3) { const float* cs = ropeCN(p) + (size_t)row * 8; const float* sn = ropeSN(p) + (size_t)row * 8;
            R.a[0] = ld4(cs); R.a[1] = ld4(cs + 4); R.a[2] = ld4(sn); R.a[3] = ld4(sn + 4); }
    }
    DI void normrope(const ColPre& U, const RowPre& R, int fq, float (&v)[2][8], float post, bf16_t* dst) const {
        const float rstd = rsqrtf(ssq16(v) * (1.f / 64.f) + EPS);
#pragma unroll
        for (int b = 0; b < 2; ++b)
#pragma unroll
            for (int j = 0; j < 8; ++j) v[b][j] *= rstd * U.c[2 * b + (j >> 2)][j & 3];
#pragma unroll
        for (int j = 0; j < 8; ++j) { const float own = v[0][j], oth = xorl<16>(own); const float c = R.a[j >> 2][j & 3], s = R.a[2 + (j >> 2)][j & 3];
            if (fq == 0) v[0][j] = own * c - oth * s; else if (fq == 1) v[0][j] = own * c + oth * s; }
#pragma unroll
        for (int b = 0; b < 2; ++b) {
#pragma unroll
            for (int j = 0; j < 8; ++j) v[b][j] *= post;
            store8bf(dst + 32 * b + 8 * fq, v[b]); }
    }
    template <int T> DI void apply(const ColPre& U, const RowPre& R, int row, int pn, int wc, int fq, float (&v)[2][8]) const {
        const int s = 4 * pn + wc; (void)s;
        if constexpr (T == 0) {
            bf16_t* d = wsp<bf16_t>(p, WS_R1) + (size_t)row * 1024 + 64 * s + 8 * fq;
            const float q = ssq16(v); store8bf(d, v[0]); store8bf(d + 32, v[1]);
            if (fq == 0) wsp<float>(p, WS_SSQA)[(size_t)row * 16 + s] = q;
        } else if constexpr (T == 1) {
            float q = 0.f;
#pragma unroll
            for (int j = 0; j < 8; ++j) q += v[0][j] * v[0][j];
            q += xorl<16>(q); q = sum32(q);
            if (fq == 0) wsp<float>(p, WS_SSQPE)[row] = q;
            float o[8];
#pragma unroll
            for (int j = 0; j < 8; ++j) { const float own = v[0][j] * U.c[j >> 2][j & 3], oth = xor32(own, fq >> 1); const float c = R.a[j >> 2][j & 3], sn = R.a[2 + (j >> 2)][j & 3];
                o[j] = (fq < 2) ? own * c - oth * sn : own * c + oth * sn; }
            store8bf(wsp<bf16_t>(p, WS_KPE) + (size_t)row * 32 + 8 * fq, o);
#pragma unroll
            for (int j = 0; j < 8; ++j) o[j] = sigmoidf(v[1][j]);
            store8bf(wsp<bf16_t>(p, WS_GN) + (size_t)row * 32 + 8 * fq, o);
        } else if constexpr (T == 2) {
            normrope(U, R, fq, v, C2N, wsp<bf16_t>(p, WS_QN) + (size_t)row * 512 + 64 * (s - 17));
        } else if constexpr (T == 3 || T == 4) {
            const int t = (s - 25) >> 1, g = (s - 25) & 1;
            bf16_t* d = wsp<bf16_t>(p, WS_KC + (size_t)t * 4 * MiB) + (size_t)row * 128 + 64 * g;
            if constexpr (T == 3) normrope(U, R, fq, v, 1.0f, d);
            else { store8bf(d + 8 * fq, v[0]); store8bf(d + 32 + 8 * fq, v[1]); }
        } else if constexpr (T == 5) {
        } else {
            bf16_t* d = wsp<bf16_t>(p, WS_R2) + (size_t)row * 2048 + 64 * (s - 40) + 8 * fq;
#pragma unroll
            for (int b = 0; b < 2; ++b) { float o[8];
#pragma unroll
                for (int j = 0; j < 8; ++j) o[j] = sigmoidf(v[b][j]);
                store8bf(d + 32 * b, o); }
        }
    }
};
struct EpiQ {
    static constexpr bool HAS_MID = false; static constexpr int NTYPES = 1;
    Params p;
    DI int type(int, int) const { return 0; }
    DI void midpre(RowPre&, int, int, int, int) const {}
    DI void mid(const RowPre&, int, int, int, int, float (&)[2][8]) const {}
    template <int T> DI void ubegin(ColPre&, int, int, int, int) const {}
    template <int T> DI void pre(RowPre& R, int row, int, int, int) const { const float* sq = wsp<float>(p, WS_SSQA) + (size_t)row * 16; R.a[0] = ld4(sq); R.a[1] = ld4(sq + 4); R.a[2] = ld4(sq + 8); }
    template <int T> DI void apply(const ColPre&, const RowPre& R, int row, int pn, int wc, int fq, float (&v)[2][8]) const {
        const float s = ((R.a[0].x + R.a[0].y) + (R.a[0].z + R.a[0].w)) + ((R.a[1].x + R.a[1].y) + (R.a[1].z + R.a[1].w)) + ((R.a[2].x + R.a[2].y) + (R.a[2].z + R.a[2].w));
        const float rstd = rsqrtf(s * (1.f / 768.f) + EPS);
        bf16_t* d = wsp<bf16_t>(p, WS_R0) + (size_t)row * 768 + 256 * pn + 32 * wc + 8 * fq;
#pragma unroll
        for (int b = 0; b < 2; ++b) { float o[8];
#pragma unroll
            for (int j = 0; j < 8; ++j) o[j] = v[b][j] * rstd;
            store8bf(d + 128 * b, o); }
    }
};
struct EpiKV {
    static constexpr bool HAS_MID = false; static constexpr int NTYPES = 1;
    Params p;
    DI int type(int, int) const { return 0; }
    DI void midpre(RowPre&, int, int, int, int) const {}
    DI void mid(const RowPre&, int, int, int, int, float (&)[2][8]) const {}
    template <int T> DI void ubegin(ColPre&, int, int, int, int) const {}
    template <int T> DI void pre(RowPre& R, int row, int pn, int wc, int fq) const { R.a[0] = ld4(wsp<float>(p, WS_SSQA) + (size_t)row * 16 + 12);
        if (4 * pn + wc < 8) { R.a[1].x = wsp<float>(p, WS_SSQPE)[row]; R.a[2] = ld4u(wsp<bf16_t>(p, WS_KPE) + (size_t)row * 32 + 8 * fq); } }
    template <int T> DI void apply(const ColPre&, const RowPre& R, int row, int pn, int wc, int fq, float (&v)[2][8]) const {
        const int s = 4 * pn + wc;
        const float rstd = rsqrtf(((R.a[0].x + R.a[0].y) + (R.a[0].z + R.a[0].w)) * (1.f / 256.f) + EPS);
#pragma unroll
        for (int b = 0; b < 2; ++b)
#pragma unroll
            for (int j = 0; j < 8; ++j) v[b][j] *= rstd;
        if (s < 8) { const float rk = rsqrtf((ssq16(v) + R.a[1].x) * (1.f / 96.f) + EPS);
#pragma unroll
            for (int b = 0; b < 2; ++b)
#pragma unroll
                for (int j = 0; j < 8; ++j) v[b][j] *= rk;
            float pe[8]; un8(R.a[2], pe);
#pragma unroll
            for (int j = 0; j < 8; ++j) pe[j] *= rk;
            bf16_t* d = wsp<bf16_t>(p, WS_KN) + (size_t)row * 768 + 96 * s + 8 * fq; store8bf(d, v[0]); store8bf(d + 32, v[1]); store8bf(d + 64, pe); }
        else { bf16_t* d = wsp<bf16_t>(p, WS_VM) + (size_t)row * 512 + 64 * (s - 8) + 8 * fq; store8bf(d, v[0]); store8bf(d + 32, v[1]); }
    }
};
struct EpiMerge {
    static constexpr bool HAS_MID = true; static constexpr int NTYPES = 1;
    Params p;
    DI int type(int, int) const { return 0; }
    DI void midpre(RowPre& R, int row, int pn, int wc, int fq) const {
        const bf16_t* g = wsp<bf16_t>(p, WS_R2) + (size_t)row * 2048 + 256 * pn + 32 * wc + 8 * fq;
        R.a[0] = ld4u(g); R.a[1] = ld4u(g + 128); R.a[2] = ld4u(g + 1024); R.a[3] = ld4u(g + 1024 + 128); }
    DI void mid(const RowPre& R, int, int, int, int, float (&v)[2][8]) const {
#pragma unroll
        for (int b = 0; b < 2; ++b) { float s1[8], s2[8]; un8(R.a[b], s1); un8(R.a[2 + b], s2);
#pragma unroll
            for (int j = 0; j < 8; ++j) v[b][j] *= s1[j] * __builtin_amdgcn_rcpf(s2[j]); }
    }
    template <int T> DI void ubegin(ColPre&, int, int, int, int) const {}
    template <int T> DI void pre(RowPre& R, int row, int pn, int wc, int fq) const {
        const bf16_t* g = wsp<bf16_t>(p, WS_R2) + (size_t)row * 2048 + 1024 + 256 * pn + 32 * wc + 8 * fq; R.a[0] = ld4u(g); R.a[1] = ld4u(g + 128); }
    template <int T> DI void apply(const ColPre&, const RowPre& R, int row, int pn, int wc, int fq, float (&v)[2][8]) const {
        bf16_t* d = wsp<bf16_t>(p, WS_R0) + (size_t)row * 1024 + 256 * pn + 32 * wc + 8 * fq;
#pragma unroll
        for (int b = 0; b < 2; ++b) { float s2[8], o[8]; un8(R.a[b], s2);
#pragma unroll
            for (int j = 0; j < 8; ++j) o[j] = v[b][j] * s2[j];
            store8bf(d + 128 * b, o); }
    }
};
struct EpiOut {
    static constexpr bool HAS_MID = false; static constexpr int NTYPES = 1;
    Params p;
    DI int type(int, int) const { return 0; }
    DI void midpre(RowPre&, int, int, int, int) const {}
    DI void mid(const RowPre&, int, int, int, int, float (&)[2][8]) const {}
    template <int T> DI void ubegin(ColPre& U, int row0, int pn, int wc, int fq) const {
        const int b_ = row0 / SEQ, col = 256 * pn + 32 * wc + 8 * fq; const float* md = wsp<float>(p, WS_MOD) + b_ * 6144 + col; const float* g2 = p.in[I_N2G] + col;
#pragma unroll
        for (int i = 0; i < 4; ++i) { const int o = 128 * (i >> 1) + 4 * (i & 1); U.c[i] = ld4(md + 2 * 1024 + o); const f32x4 sc = ld4(md + 4 * 1024 + o), gg = ld4(g2 + o); U.c[4 + i] = gg * (1.0f + sc); }
    }
    template <int T> DI void pre(RowPre& R, int row, int pn, int wc, int fq) const { const float* x = p.in[I_X] + (size_t)row * DM + 256 * pn + 32 * wc + 8 * fq;
        R.a[0] = ld4(x); R.a[1] = ld4(x + 4); R.a[2] = ld4(x + 128); R.a[3] = ld4(x + 132); }
    template <int T> DI void apply(const ColPre& U, const RowPre& R, int row, int pn, int wc, int fq, float (&v)[2][8]) const {
        const int col = 256 * pn + 32 * wc + 8 * fq; float* d = wsp<float>(p, WS_R2) + (size_t)row * DM + col; bf16_t* a2 = wsp<bf16_t>(p, WS_R1) + (size_t)row * DM + col;
        float q = 0.f;
#pragma unroll
        for (int b = 0; b < 2; ++b) { float o8[8];
#pragma unroll
            for (int h = 0; h < 2; ++h) { const f32x4 g = U.c[2 * b + h], xv = R.a[2 * b + h], gs = U.c[4 + 2 * b + h];
                f32x4 o; o.x = xv.x + g.x * v[b][4 * h]; o.y = xv.y + g.y * v[b][4 * h + 1]; o.z = xv.z + g.z * v[b][4 * h + 2]; o.w = xv.w + g.w * v[b][4 * h + 3]; *(f32x4*)(d + 128 * b + 4 * h) = o;
                q += (o.x * o.x + o.y * o.y) + (o.z * o.z + o.w * o.w);
                o8[4 * h] = o.x * gs.x; o8[4 * h + 1] = o.y * gs.y; o8[4 * h + 2] = o.z * gs.z; o8[4 * h + 3] = o.w * gs.w; }
            store8bf(a2 + 128 * b, o8); }
        q += xorl<16>(q); q = sum32(q);
        if (fq == 0) wsp<float>(p, WS_SSQA)[(size_t)row * 16 + 4 * pn + wc] = q;
    }
};
struct EpiGU {
    static constexpr bool HAS_MID = false; static constexpr int NTYPES = 1;
    Params p;
    DI int type(int, int) const { return 0; }
    DI void midpre(RowPre&, int, int, int, int) const {}
    DI void mid(const RowPre&, int, int, int, int, float (&)[2][8]) const {}
    template <int T> DI void ubegin(ColPre& U, int row0, int pn, int wc, int fq) const { const float* sh = wsp<float>(p, WS_SHW) + (row0 / SEQ) * 5632 + 256 * pn + 32 * wc + 8 * fq;
        U.c[0] = ld4(sh); U.c[1] = ld4(sh + 4); U.c[2] = ld4(sh + 128); U.c[3] = ld4(sh + 132); }
    template <int T> DI void pre(RowPre& R, int row, int, int, int) const { const float* sq = wsp<float>(p, WS_SSQA) + (size_t)row * 16; R.a[0] = ld4(sq); R.a[1] = ld4(sq + 4); R.a[2] = ld4(sq + 8); R.a[3] = ld4(sq + 12); }
    template <int T> DI void apply(const ColPre& U, const RowPre& R, int row, int pn, int wc, int fq, float (&v)[2][8]) const {
        const int s = 4 * pn + wc; float o[8];
        const float tot = (((R.a[0].x + R.a[0].y) + (R.a[0].z + R.a[0].w)) + ((R.a[1].x + R.a[1].y) + (R.a[1].z + R.a[1].w))) + (((R.a[2].x + R.a[2].y) + (R.a[2].z + R.a[2].w)) + ((R.a[3].x + R.a[3].y) + (R.a[3].z + R.a[3].w)));
        const float rstd = rsqrtf(tot * (1.f / DM) + EPS);
#pragma unroll
        for (int j = 0; j < 8; ++j) o[j] = siluf(rstd * v[0][j] + U.c[j >> 2][j & 3]) * (rstd * v[1][j] + U.c[2 + (j >> 2)][j & 3]);
        store8bf(wsp<bf16_t>(p, WS_HID) + (size_t)row * DFF + 32 * s + 8 * fq, o);
    }
};
struct EpiDown {
    static constexpr bool HAS_MID = false; static constexpr int NTYPES = 1;
    Params p;
    DI int type(int, int) const { return 0; }
    DI void midpre(RowPre&, int, int, int, int) const {}
    DI void mid(const RowPre&, int, int, int, int, float (&)[2][8]) const {}
    template <int T> DI void ubegin(ColPre& U, int row0, int pn, int wc, int fq) const { const float* gt = wsp<float>(p, WS_MOD) + (row0 / SEQ) * 6144 + 5 * 1024 + 256 * pn + 32 * wc + 8 * fq;
        U.c[0] = ld4(gt); U.c[1] = ld4(gt + 4); U.c[2] = ld4(gt + 128); U.c[3] = ld4(gt + 132); }
    template <int T> DI void pre(RowPre& R, int row, int pn, int wc, int fq) const { const float* x = wsp<float>(p, WS_R2) + (size_t)row * DM + 256 * pn + 32 * wc + 8 * fq;
        R.a[0] = ld4(x); R.a[1] = ld4(x + 4); R.a[2] = ld4(x + 128); R.a[3] = ld4(x + 132); }
    template <int T> DI void apply(const ColPre& U, const RowPre& R, int row, int pn, int wc, int fq, float (&v)[2][8]) const {
        float* d = p.out + (size_t)row * DM + 256 * pn + 32 * wc + 8 * fq;
#pragma unroll
        for (int b = 0; b < 2; ++b)
#pragma unroll
            for (int h = 0; h < 2; ++h) { const f32x4 g = U.c[2 * b + h], xv = R.a[2 * b + h];
                f32x4 o; o.x = xv.x + g.x * v[b][4 * h]; o.y = xv.y + g.y * v[b][4 * h + 1]; o.z = xv.z + g.z * v[b][4 * h + 2]; o.w = xv.w + g.w * v[b][4 * h + 3]; *(f32x4*)(d + 128 * b + 4 * h) = o; }
    }
};
namespace pg8 {
#define PG8_LAS __attribute__((address_space(3)))
typedef short bf16x8 __attribute__((ext_vector_type(8)));
constexpr int BM = 256, BK = 64, HALF = 128, HTB = HALF * BK * 2  , STAGE_BYTES = 8 * HTB, NXCD = 8, WGM = 8;

__host__ __device__ __forceinline__ int lds_byte(int r, int c) { const int st = (r >> 4) * 2 + (c >> 5), rr = r & 15, cc = c & 31, ob = rr * 64 + cc * 2; return st * 1024 + (ob ^ (((ob >> 9) & 1) << 5)); }
__host__ __device__ __forceinline__ void stage_rc(int b, int& R, int& C) { const int st = b / 1024, sb = b % 1024, swz = sb ^ (((sb >> 9) & 1) << 5); R = (st >> 1) * 16 + swz / 64; C = (st & 1) * 32 + (swz % 64) / 2; }
__host__ __device__ __forceinline__ int perm32(int rho) { const int n = rho >> 4, i = rho & 15; return 8 * (i >> 2) + 4 * n + (i & 3); }

struct Unit { int pm, pn; };
struct Gemm { const bf16_t* A; const bf16_t* Bt; int M, N, K, lda, ldb, kstepA; };

struct StaticOrder {
    int nM, nN, nwg, G, c;
    __host__ __device__ void init(int M, int N, int G_, int c_) { nM = M / BM; nN = N / BM; nwg = nM * nN; G = G_; c = c_; }
    __host__ __device__ bool next(int i, Unit& u) const {
        const long L = (long)i * G + c; if (L >= nwg) return false;
        int wgid = (int)L; { const int q = nwg / NXCD, r = nwg % NXCD, xcd = wgid % NXCD, off = wgid / NXCD; wgid = (xcd < r ? xcd * (q + 1) : r * (q + 1) + (xcd - r) * q) + off; }
        const int nig = WGM * nN, gid = wgid / nig, fm = gid * WGM, gsz = (nM - fm) < WGM ? (nM - fm) : WGM;
        u.pm = fm + ((wgid % nig) % gsz); u.pn = (wgid % nig) / gsz; return true;
    }
    __device__ __forceinline__ void a_ready(const Unit&) const {}
    __device__ __forceinline__ void done(const Unit&) const {}
};

template <class Epi, class Sched, bool ALIGN_EPI = false, bool SP2 = false>
__device__ __forceinline__ void gemm_phase(PG8_LAS unsigned char* lds, const Gemm g, const Sched& S, const Epi& E, int wid0) {
    const int tid = opaque_tid(wid0), wid = __builtin_amdgcn_readfirstlane(tid >> 6), lane = tid & 63, wr = wid >> 2, wc = wid & 3, fr = lane & 15, fq = lane >> 4;
    const int K = g.K; int nt = K / BK; asm volatile("" : "+s"(nt));
    unsigned voffA[2], voffB[2];
#pragma unroll
    for (int i = 0; i < 2; ++i) { int R, C; stage_rc(tid * 16 + i * 8192, R, C); const int Rb = Epi::PERM ? ((R & ~31) + perm32(R & 31)) : R;
        voffA[i] = (unsigned)(R * g.lda + C) * 2u; voffB[i] = (unsigned)(Rb * g.ldb + C) * 2u; }
    const size_t kstep = (size_t)(BK * 2), kstepA = (size_t)g.kstepA;
    const size_t hstepB = (size_t)HALF * g.ldb * 2, hstepA = (size_t)HALF * g.lda * 2;
    const size_t tstepB = 2 * hstepB, tstepA = 2 * hstepA;
    const unsigned ldsw = (unsigned)wid * 1024u;
    const int aoff = lds_byte(wr * 64 + fr, fq * 8), boff = lds_byte(wc * 32 + fr, fq * 8);
#define PG8_SA(b, h) (((b) * 2 + (h)) * HTB)
#define PG8_SB(b, h) ((4 + (b) * 2 + (h)) * HTB)
#define PG8_STAGE(bufoff, gbase, voff) do { _Pragma("unroll") for (int _i = 0; _i < 2; ++_i) \
        __builtin_amdgcn_global_load_lds((const unsigned*)((const char*)(gbase) + (voff)[_i]), (PG8_LAS unsigned*)(lds + (bufoff) + ldsw + _i * 8192), 16, 0, 0); } while (0)
#define PG8_LDA(dst, b, h) do { _Pragma("unroll") for (int m = 0; m < 4; ++m) _Pragma("unroll") for (int k = 0; k < 2; ++k) dst[m][k] = *(const PG8_LAS bf16x8*)(lds + PG8_SA(b, h) + aoff + m * 2048 + k * 1024); } while (0)
#define PG8_LDB(dst, b, h) do { _Pragma("unroll") for (int n = 0; n < 2; ++n) _Pragma("unroll") for (int k = 0; k < 2; ++k) dst[n][k] = *(const PG8_LAS bf16x8*)(lds + PG8_SB(b, h) + boff + n * 2048 + k * 1024); } while (0)
#define PG8_MMA(ai, bj, At, Bt) do { __builtin_amdgcn_s_setprio(1); _Pragma("unroll") for (int m = 0; m < 4; ++m) _Pragma("unroll") for (int n = 0; n < 2; ++n) _Pragma("unroll") for (int k = 0; k < 2; ++k) \
        acc[ai][bj][m][n] = __builtin_amdgcn_mfma_f32_16x16x32_bf16(Bt[n][k], At[m][k], acc[ai][bj][m][n], 0, 0, 0); __builtin_amdgcn_s_setprio(0); } while (0)
#define PG8_WAIT_V(n) asm volatile("s_waitcnt vmcnt(" #n ")" ::: "memory")
#define PG8_WAIT_L(n) asm volatile("s_waitcnt lgkmcnt(" #n ")" ::: "memory")
#define PG8_BAR __builtin_amdgcn_s_barrier()
#define PG8_SCHED __builtin_amdgcn_sched_barrier(0)
    Unit cur, nxt; int ui = 0;
    if (!S.next(0, cur)) return;
    f32x4 acc[2][2][4][2];
#pragma unroll
    for (int a = 0; a < 2; ++a)
#pragma unroll
        for (int b = 0; b < 2; ++b)
#pragma unroll
            for (int m = 0; m < 4; ++m)
#pragma unroll
                for (int n = 0; n < 2; ++n) acc[a][b][m][n] = (f32x4){0.f, 0.f, 0.f, 0.f};
    bf16x8 At[4][2], B0[2][2], B1[2][2];
    const char* cA = (const char*)g.A + (size_t)cur.pm * tstepA; const char* cB = (const char*)g.Bt + (size_t)cur.pn * tstepB;
    S.a_ready(cur);
    if constexpr (SP2) {
        PG8_STAGE(PG8_SB(0, 0), cB, voffB); PG8_STAGE(PG8_SB(0, 1), cB + hstepB, voffB); PG8_STAGE(PG8_SA(0, 0), cA, voffA); PG8_STAGE(PG8_SA(0, 1), cA + hstepA, voffA);
        if (wr == 1) PG8_BAR;
        PG8_WAIT_V(2); PG8_BAR;
        PG8_STAGE(PG8_SB(1, 0), cB + kstep, voffB); PG8_STAGE(PG8_SA(1, 0), cA + kstepA, voffA); PG8_STAGE(PG8_SB(1, 1), cB + hstepB + kstep, voffB);
        PG8_WAIT_V(6); PG8_BAR;
    } else {
        PG8_STAGE(PG8_SB(0, 0), cB, voffB); PG8_STAGE(PG8_SA(0, 0), cA, voffA); PG8_STAGE(PG8_SB(0, 1), cB + hstepB, voffB); PG8_STAGE(PG8_SA(0, 1), cA + hstepA, voffA);
        if (wr == 1) PG8_BAR;
        PG8_WAIT_V(4); PG8_BAR;
        PG8_STAGE(PG8_SB(1, 0), cB + kstep, voffB); PG8_STAGE(PG8_SA(1, 0), cA + kstepA, voffA); PG8_STAGE(PG8_SB(1, 1), cB + hstepB + kstep, voffB);
        PG8_WAIT_V(6); PG8_BAR;
    }
    for (;;) {
        const bool has_next = S.next(ui + 1, nxt);
        const char* nA = has_next ? (const char*)g.A + (size_t)nxt.pm * tstepA : cA; const char* nB = has_next ? (const char*)g.Bt + (size_t)nxt.pn * tstepB : cB;
        for (int hh_ = 0; hh_ < (Epi::HAS_MID ? 2 : 1); ++hh_) {
        if constexpr (Epi::HAS_MID) { if (hh_ == 1) E.mid(acc, cur, wr, wc, fr, fq); }
        const int t0_ = Epi::HAS_MID ? hh_ * (nt >> 1) : 0, t1_ = Epi::HAS_MID ? (hh_ + 1) * (nt >> 1) : nt;
        for (int t = t0_; t < t1_; t += 2) {
            const bool last = (t == nt - 2);
            const char* a1 = cA + (size_t)(t + 1) * kstepA;
            const char* a2 = last ? nA : cA + (size_t)(t + 2) * kstepA; const char* b2 = last ? nB : cB + (size_t)(t + 2) * kstep;
            const char* a3 = a2 + kstepA; const char* b3 = b2 + kstep;
            if (last && has_next) S.a_ready(nxt);
            if constexpr (SP2) {
            PG8_LDB(B0, 0, 0); PG8_LDB(B1, 0, 1); PG8_SCHED; PG8_LDA(At, 0, 0); PG8_STAGE(PG8_SA(1, 1), a1 + hstepA, voffA);
            PG8_WAIT_V(8); PG8_WAIT_L(0); PG8_BAR; PG8_MMA(0, 0, At, B0); PG8_MMA(0, 1, At, B1); PG8_BAR; PG8_SCHED;
            PG8_LDA(At, 0, 1); PG8_STAGE(PG8_SB(0, 0), b2, voffB); PG8_STAGE(PG8_SB(0, 1), b2 + hstepB, voffB); PG8_STAGE(PG8_SA(0, 0), a2, voffA);
            PG8_WAIT_V(8); PG8_WAIT_L(0); PG8_BAR; PG8_MMA(1, 0, At, B0); PG8_MMA(1, 1, At, B1); PG8_BAR; PG8_SCHED;
            PG8_LDB(B0, 1, 0); PG8_LDB(B1, 1, 1); PG8_SCHED; PG8_LDA(At, 1, 0); PG8_STAGE(PG8_SA(0, 1), a2 + hstepA, voffA);
            PG8_WAIT_V(8); PG8_WAIT_L(0); PG8_BAR; PG8_MMA(0, 0, At, B0); PG8_MMA(0, 1, At, B1); PG8_BAR; PG8_SCHED;
            PG8_LDA(At, 1, 1); PG8_STAGE(PG8_SB(1, 0), b3, voffB); PG8_STAGE(PG8_SB(1, 1), b3 + hstepB, voffB); PG8_STAGE(PG8_SA(1, 0), a3, voffA);
            PG8_WAIT_V(8); PG8_WAIT_L(0); PG8_BAR; PG8_MMA(1, 0, At, B0); PG8_MMA(1, 1, At, B1); PG8_BAR; PG8_SCHED;
            } else {
            PG8_LDB(B0, 0, 0); PG8_SCHED; PG8_LDA(At, 0, 0); PG8_STAGE(PG8_SA(1, 1), a1 + hstepA, voffA);
            PG8_WAIT_L(8); PG8_BAR; PG8_WAIT_L(0); PG8_MMA(0, 0, At, B0); PG8_BAR; PG8_SCHED;
            PG8_LDB(B1, 0, 1); PG8_STAGE(PG8_SB(0, 0), b2, voffB);
            PG8_BAR; PG8_WAIT_L(0); PG8_MMA(0, 1, At, B1); PG8_BAR;
            PG8_LDA(At, 0, 1); PG8_STAGE(PG8_SA(0, 0), a2, voffA);
            PG8_BAR; PG8_WAIT_L(0); PG8_MMA(1, 0, At, B0); PG8_BAR; PG8_SCHED;
            PG8_STAGE(PG8_SB(0, 1), b2 + hstepB, voffB);
            PG8_WAIT_V(6); PG8_BAR; PG8_MMA(1, 1, At, B1); PG8_BAR;
            PG8_LDB(B0, 1, 0); PG8_SCHED; PG8_LDA(At, 1, 0); PG8_STAGE(PG8_SA(0, 1), a2 + hstepA, voffA);
            PG8_WAIT_L(8); PG8_BAR; PG8_WAIT_L(0); PG8_MMA(0, 0, At, B0); PG8_BAR; PG8_SCHED;
            PG8_LDB(B1, 1, 1); PG8_STAGE(PG8_SB(1, 0), b3, voffB);
            PG8_BAR; PG8_WAIT_L(0); PG8_MMA(0, 1, At, B1); PG8_BAR;
            PG8_LDA(At, 1, 1); PG8_STAGE(PG8_SA(1, 0), a3, voffA);
            PG8_BAR; PG8_WAIT_L(0); PG8_MMA(1, 0, At, B0); PG8_BAR; PG8_SCHED;
            PG8_STAGE(PG8_SB(1, 1), b3 + hstepB, voffB);
            PG8_WAIT_V(6); PG8_BAR; PG8_MMA(1, 1, At, B1); PG8_BAR;
            }
        }
        }
        if constexpr (ALIGN_EPI) { if (wr == 0) PG8_BAR; }
        if constexpr (!Epi::AFTER_DRAIN) { E(acc, cur, wr, wc, fr, fq); S.done(cur); }
        if (!has_next) break;
#pragma unroll
        for (int a = 0; a < 2; ++a)
#pragma unroll
            for (int b = 0; b < 2; ++b)
#pragma unroll
                for (int m = 0; m < 4; ++m)
#pragma unroll
                    for (int n = 0; n < 2; ++n) acc[a][b][m][n] = (f32x4){0.f, 0.f, 0.f, 0.f};
        cur = nxt; cA = nA; cB = nB; ++ui;
        if constexpr (ALIGN_EPI) { if (wr == 1) PG8_BAR; }
    }
    PG8_WAIT_V(0);
    if constexpr (!ALIGN_EPI) { if (wr == 0) PG8_BAR; }
    PG8_BAR;
    if constexpr (Epi::AFTER_DRAIN) { E.fused(acc, cur, wr, wc, fr, fq, lds, wid, lane); S.done(cur); }
#undef PG8_SA
#undef PG8_SB
#undef PG8_STAGE
#undef PG8_LDA
#undef PG8_LDB
#undef PG8_MMA
#undef PG8_WAIT_V
#undef PG8_WAIT_L
#undef PG8_BAR
#undef PG8_SCHED
}
}

template <class SE> struct EpiAdapt {
    static constexpr bool PERM = true, AFTER_DRAIN = false, HAS_MID = SE::HAS_MID;
    SE se;
    template <int T> DI void run(f32x4 (&acc)[2][2][4][2], const pg8::Unit& u, int wr, int wc, int fr, int fq) const {
        int frr = fr; asm volatile("" : "+v"(frr));
        const int rbase = u.pm * 256 + wr * 64;
        ColPre U; se.template ubegin<T>(U, rbase, u.pn, wc, fq);
        RowPre R[2]; se.template pre<T>(R[0], rbase + frr, u.pn, wc, fq);
#pragma unroll
        for (int it = 0; it < 8; ++it) {
            const int ai = it >> 2, m = it & 3; const int row = rbase + ai * 128 + m * 16 + frr;
            if (it < 7) se.template pre<T>(R[(it + 1) & 1], rbase + ((it + 1) >> 2) * 128 + ((it + 1) & 3) * 16 + frr, u.pn, wc, fq);
            float v[2][8];
#pragma unroll
            for (int bj = 0; bj < 2; ++bj)
#pragma unroll
                for (int n = 0; n < 2; ++n) { v[bj][4 * n] = acc[ai][bj][m][n][0]; v[bj][4 * n + 1] = acc[ai][bj][m][n][1]; v[bj][4 * n + 2] = acc[ai][bj][m][n][2]; v[bj][4 * n + 3] = acc[ai][bj][m][n][3]; }
            se.template apply<T>(U, R[it & 1], row, u.pn, wc, fq, v);
        }
    }
    template <int T> DI void disp(int ty, f32x4 (&acc)[2][2][4][2], const pg8::Unit& u, int wr, int wc, int fr, int fq) const {
        if constexpr (T < SE::NTYPES) { if (ty == T) run<T>(acc, u, wr, wc, fr, fq); else disp<T + 1>(ty, acc, u, wr, wc, fr, fq); }
    }
    DI void operator()(f32x4 (&acc)[2][2][4][2], const pg8::Unit& u, int wr, int wc, int fr, int fq) const { disp<0>(se.type(u.pn, wc), acc, u, wr, wc, fr, fq); }
    DI void mid(f32x4 (&acc)[2][2][4][2], const pg8::Unit& u, int wr, int wc, int fr, int fq) const {
        int frr = fr; asm volatile("" : "+v"(frr));
        const int rbase = u.pm * 256 + wr * 64;
        RowPre R[2]; se.midpre(R[0], rbase + frr, u.pn, wc, fq);
#pragma unroll
        for (int it = 0; it < 8; ++it) {
            const int ai = it >> 2, m = it & 3; const int row = rbase + ai * 128 + m * 16 + frr;
            if (it < 7) se.midpre(R[(it + 1) & 1], rbase + ((it + 1) >> 2) * 128 + ((it + 1) & 3) * 16 + frr, u.pn, wc, fq);
            float v[2][8];
#pragma unroll
            for (int bj = 0; bj < 2; ++bj)
#pragma unroll
                for (int n = 0; n < 2; ++n) { v[bj][4 * n] = acc[ai][bj][m][n][0]; v[bj][4 * n + 1] = acc[ai][bj][m][n][1]; v[bj][4 * n + 2] = acc[ai][bj][m][n][2]; v[bj][4 * n + 3] = acc[ai][bj][m][n][3]; }
            se.mid(R[it & 1], row, u.pn, wc, fq, v);
#pragma unroll
            for (int bj = 0; bj < 2; ++bj)
#pragma unroll
                for (int n = 0; n < 2; ++n) { acc[ai][bj][m][n][0] = v[bj][4 * n]; acc[ai][bj][m][n][1] = v[bj][4 * n + 1]; acc[ai][bj][m][n][2] = v[bj][4 * n + 2]; acc[ai][bj][m][n][3] = v[bj][4 * n + 3]; }
        }
    }
};
template <class SE> DI void gemm_fast(PG8_LAS unsigned char* lds, const bf16_t* A, int lda, const bf16_t* Bt, int M, int N, int K, const SE& se, int G, int c, int wid0) {
    pg8::Gemm g{A, Bt, M, N, K, lda, K, 128}; pg8::StaticOrder S; S.init(M, N, G, c);
    EpiAdapt<SE> E{se};
    pg8::gemm_phase<EpiAdapt<SE>, pg8::StaticOrder, true, true>(lds, g, S, E, wid0);
}
struct RangeOrder {
    int base, cnt, nN;
    DI bool next(int i, pg8::Unit& u) const { if (i >= cnt) return false; const int L = base + i; u.pm = L / nN; u.pn = L % nN; return true; }
    DI void a_ready(const pg8::Unit&) const {}
    DI void done(const pg8::Unit&) const {}
};
template <class SE> DI void gemm_fast_range(PG8_LAS unsigned char* lds, const bf16_t* A, int lda, const bf16_t* Bt, int M, int N, int K, const SE& se, int base, int cnt, int wid0) {
    pg8::Gemm g{A, Bt, M, N, K, lda, K, 128}; RangeOrder S{base, cnt, N / 256};
    EpiAdapt<SE> E{se};
    pg8::gemm_phase<EpiAdapt<SE>, RangeOrder, true, true>(lds, g, S, E, wid0);
}
struct OneUnit {
    int pm, pn;
    DI bool next(int i, pg8::Unit& u) const { if (i > 0) return false; u.pm = pm; u.pn = pn; return true; }
    DI void a_ready(const pg8::Unit&) const {}
    DI void done(const pg8::Unit&) const {}
};
struct EpiCmpH {
    static constexpr bool HAS_MID = false; static constexpr int NTYPES = 1;
    float* H;
    DI int type(int, int) const { return 0; }
    DI void midpre(RowPre&, int, int, int, int) const {}
    DI void mid(const RowPre&, int, int, int, int, float (&)[2][8]) const {}
    template <int T> DI void ubegin(ColPre&, int, int, int, int) const {}
    template <int T> DI void pre(RowPre&, int, int, int, int) const {}
    template <int T> DI void apply(const ColPre&, const RowPre&, int row, int pn, int wc, int fq, float (&v)[2][8]) const {
        float* d = H + (size_t)row * 256 + 32 * wc + 8 * fq;
#pragma unroll
        for (int b = 0; b < 2; ++b) { *(f32x4*)(d + 128 * b) = (f32x4){v[b][0], v[b][1], v[b][2], v[b][3]}; *(f32x4*)(d + 128 * b + 4) = (f32x4){v[b][4], v[b][5], v[b][6], v[b][7]}; }
    }
};
DI void cmp_hidden_fast(const Params& p, PG8_LAS unsigned char* lds, int cu, int wid0) {
    const int kv = cu >> 4, g = (cu >> 3) & 1, pm = (cu >> 1) & 3, sp = cu & 1;
    const bf16_t* A = wsp<bf16_t>(p, kv ? WS_VC : WS_KC) + g * 64 + (size_t)(16 * sp) * 128;
    const bf16_t* Bt = wsp<bf16_t>(p, WS_CW1) + (size_t)kv * 256 * 2048 + 1024 * sp;
    pg8::Gemm gm{A, Bt, 1024, 256, 1024, 2048, 2048, 256}; OneUnit S{pm, 0};
    EpiCmpH se{wsp<float>(p, WS_CMPH) + (size_t)((kv * 2 + g) * 2 + sp) * 1024 * 256};
    EpiAdapt<EpiCmpH> E{se};
    pg8::gemm_phase<EpiAdapt<EpiCmpH>, OneUnit, true, true>(lds, gm, S, E, wid0);
}
template <bool SPLIT> DI void cmp_out(const Params& p, int gw, int ngw, int lane) {
    const float* H = wsp<float>(p, WS_CMPH);
    for (int u = gw; u < 2 * 2 * 1024; u += ngw) {
        const int r = u & 1023, g = (u >> 10) & 1, kv = u >> 11; const int b = r >> 7, n = r & 127;
        bf16_t* dst = wsp<bf16_t>(p, kv ? WS_VCF : WS_KCF) + (size_t)r * 128 + g * 64 + lane;
        if (n == 127) { *dst = 0; continue; }
        const float* w2 = (kv ? p.in[I_CW2V] : p.in[I_CW2K]) + lane;
        float acc = 0.f;
        if constexpr (SPLIT) {
            const float* h = H + ((size_t)((kv * 2 + g) * 2) * 1024 + r) * 256; const float* cb = wsp<float>(p, WS_CB1) + kv * 256;
            float hv[4];
#pragma unroll
            for (int q = 0; q < 4; ++q) { const int j = 64 * q + lane; hv[q] = siluf((h[j] + h[(size_t)1024 * 256 + j]) + cb[j]); }
#pragma unroll
            for (int q = 0; q < 4; ++q)
#pragma unroll
                for (int jj = 0; jj < 64; ++jj) acc += __int_as_float(__builtin_amdgcn_readlane(__float_as_int(hv[q]), jj)) * w2[(64 * q + jj) * 64];
        } else {
            const float* h = H + (size_t)u * 256;
            for (int j = 0; j < 256; ++j) acc += h[j] * w2[j * 64];
        }
        if (kv == 0) {
            const float rstd = rsqrtf(wave_sum(acc * acc) * (1.f / 64.f) + EPS);
            float y = acc * rstd * p.in[I_NKCG][lane];
            const int prow = b * SEQ + 16 * n + 31; const float oth = xorl<8>(y);
            if (lane < 16) { const float c = ropeCN(p)[(size_t)prow * 8 + (lane & 7)], s = ropeSN(p)[(size_t)prow * 8 + (lane & 7)]; y = (lane < 8) ? y * c - oth * s : y * c + oth * s; }
            acc = y;
        }
        *dst = (bf16_t)f2bf(acc);
    }
}

DI unsigned select_blocks(const float (&imp)[32], int cur) {
    if (cur < 8) return (2u << cur) - 1u;
    unsigned mask = 1u | (1u << cur) | (1u << (cur - 1));
#pragma unroll 1
    for (int it = 0; it < 5; ++it) {
        float best = -1.0f; int bi = 1;
#pragma unroll
        for (int j = 1; j < 32; ++j) { const bool ok = (j <= cur - 2) && !((mask >> j) & 1u); if (ok && imp[j] > best) { best = imp[j]; bi = j; } }
        mask |= 1u << bi;
    }
    return mask;
}

namespace fa {
typedef short bf16x8 __attribute__((ext_vector_type(8)));
typedef short s16x4 __attribute__((ext_vector_type(4)));
typedef float f32x16 __attribute__((ext_vector_type(16)));
typedef LAS const char* lds_cptr;
typedef LAS char* lds_ptr;
constexpr int KBUF = 12288, VBUF = 8192;
constexpr int L_K = 0, L_V = 2 * KBUF, L_WS = L_V + 2 * VBUF, L_OST = L_WS + 8 * 256, L_END = L_OST + 8 * 8192;
#define FA_SBAR() __builtin_amdgcn_sched_barrier(0)
DI int crow(int r, int hi) { return (r & 3) + 8 * (r >> 2) + 4 * hi; }
typedef float f32x2_t __attribute__((ext_vector_type(2))); typedef __bf16 bf16x2_t __attribute__((ext_vector_type(2)));
DI unsigned cvtpk(float lo, float hi) { f32x2_t v = {lo, hi}; bf16x2_t b = __builtin_convertvector(v, bf16x2_t); return __builtin_bit_cast(unsigned, b); }

template <int DK> DI void qkt(f32x16& p0, f32x16& p1, lds_cptr kb, const bf16x8* qr) {
    f32x16 z;
#pragma unroll
    for (int i = 0; i < 16; ++i) z[i] = 0.f;
#pragma unroll
    for (int d0 = 0; d0 < DK / 16; ++d0) {
        const bf16x8 b0 = *(const LAS bf16x8*)(kb + d0 * 2048);
        const bf16x8 b1 = *(const LAS bf16x8*)(kb + d0 * 2048 + 512);
        if (d0 == 0) { p0 = __builtin_amdgcn_mfma_f32_32x32x16_bf16(b0, qr[0], z, 0, 0, 0); p1 = __builtin_amdgcn_mfma_f32_32x32x16_bf16(b1, qr[0], z, 0, 0, 0); }
        else { p0 = __builtin_amdgcn_mfma_f32_32x32x16_bf16(b0, qr[d0], p0, 0, 0, 0); p1 = __builtin_amdgcn_mfma_f32_32x32x16_bf16(b1, qr[d0], p1, 0, 0, 0); }
    }
}
typedef short v4i16_t __attribute__((ext_vector_type(4)));
DI s16x4 vtr(int addr) { return __builtin_bit_cast(s16x4, __builtin_amdgcn_ds_read_tr16_b64_v4i16((LAS v4i16_t*)(uintptr_t)(unsigned)addr)); }
DI bf16x8 vfrag(int addr) { const s16x4 lo = vtr(addr), hi = vtr(addr + 512); return (bf16x8){lo[0], lo[1], lo[2], lo[3], hi[0], hi[1], hi[2], hi[3]}; }
DI void pv(f32x16* o, int vb, bf16x8 pa0, bf16x8 pa1, bf16x8 pa2, bf16x8 pa3) {
#pragma unroll
    for (int d0 = 0; d0 < 2; ++d0) { s16x4 lo[4], hi[4];
#pragma unroll
        for (int ks = 0; ks < 4; ++ks) { lo[ks] = vtr(vb + d0 * 4096 + ks * 1024); hi[ks] = vtr(vb + d0 * 4096 + ks * 1024 + 512); }
#define FA_PK(k) (bf16x8){lo[k][0], lo[k][1], lo[k][2], lo[k][3], hi[k][0], hi[k][1], hi[k][2], hi[k][3]}
        o[d0] = __builtin_amdgcn_mfma_f32_32x32x16_bf16(pa0, FA_PK(0), o[d0], 0, 0, 0);
        o[d0] = __builtin_amdgcn_mfma_f32_32x32x16_bf16(pa1, FA_PK(1), o[d0], 0, 0, 0);
        o[d0] = __builtin_amdgcn_mfma_f32_32x32x16_bf16(pa2, FA_PK(2), o[d0], 0, 0, 0);
        o[d0] = __builtin_amdgcn_mfma_f32_32x32x16_bf16(pa3, FA_PK(3), o[d0], 0, 0, 0);
#undef FA_PK
    }
}
DI void pack_p(const f32x16& p0, const f32x16& p1, bf16x8& a0, bf16x8& a1, bf16x8& a2, bf16x8& a3) {
    u32x4 w0, w1, w2, w3;
    w0.x = cvtpk(p0[0], p0[1]); w0.y = cvtpk(p0[2], p0[3]); w0.z = cvtpk(p0[4], p0[5]); w0.w = cvtpk(p0[6], p0[7]);
    w1.x = cvtpk(p0[8], p0[9]); w1.y = cvtpk(p0[10], p0[11]); w1.z = cvtpk(p0[12], p0[13]); w1.w = cvtpk(p0[14], p0[15]);
    w2.x = cvtpk(p1[0], p1[1]); w2.y = cvtpk(p1[2], p1[3]); w2.z = cvtpk(p1[4], p1[5]); w2.w = cvtpk(p1[6], p1[7]);
    w3.x = cvtpk(p1[8], p1[9]); w3.y = cvtpk(p1[10], p1[11]); w3.z = cvtpk(p1[12], p1[13]); w3.w = cvtpk(p1[14], p1[15]);
    a0 = __builtin_bit_cast(bf16x8, w0); a1 = __builtin_bit_cast(bf16x8, w1); a2 = __builtin_bit_cast(bf16x8, w2); a3 = __builtin_bit_cast(bf16x8, w3);
}
DI void mask_range(f32x16& p0, f32x16& p1, int key0, int lo, int hi_, int hf) {
#pragma unroll
    for (int r = 0; r < 16; ++r) { const int k = key0 + crow(r, hf); if (k < lo || k > hi_) p0[r] = -INFINITY; if (k + 32 < lo || k + 32 > hi_) p1[r] = -INFINITY; }
}
DI float max3(float a, float b, float c) { return fmaxf(fmaxf(a, b), c); }
DI float rowmax32(const f32x16& p0, const f32x16& p1) {
    float a = max3(p0[0], p0[1], p0[2]), b = max3(p0[3], p0[4], p0[5]), c = max3(p0[6], p0[7], p0[8]), d = max3(p0[9], p0[10], p0[11]);
    a = max3(a, p0[12], p0[13]); b = max3(b, p0[14], p0[15]); c = max3(c, p1[0], p1[1]); d = max3(d, p1[2], p1[3]);
    a = max3(a, p1[4], p1[5]); b = max3(b, p1[6], p1[7]); c = max3(c, p1[8], p1[9]); d = max3(d, p1[10], p1[11]);
    a = max3(a, p1[12], p1[13]); b = max3(b, p1[14], p1[15]);
    return max32(fmaxf(fmaxf(a, b), fmaxf(c, d)));
}
struct State { float m, l; f32x16 o[2]; };
DI void st_init(State& s) { s.m = -INFINITY; s.l = 0.f;
#pragma unroll
    for (int i = 0; i < 16; ++i) { s.o[0][i] = 0.f; s.o[1][i] = 0.f; } }
DI void softmax_pv(State& st, f32x16& p0, f32x16& p1, int vb, LAS float* wsf, int r32, int hf) {
    const float rm = rowmax32(p0, p1);
    const float mn = fmaxf(st.m, rm), mu = (mn == -INFINITY) ? 0.f : mn;
    const float alpha = __builtin_amdgcn_exp2f(st.m - mu);
    st.m = mn;
    float ls0 = 0.f, ls1 = 0.f, ls2 = 0.f, ls3 = 0.f;
#pragma unroll
    for (int r = 0; r < 16; r += 2) { p0[r] = __builtin_amdgcn_exp2f(p0[r] - mu); p1[r] = __builtin_amdgcn_exp2f(p1[r] - mu); p0[r + 1] = __builtin_amdgcn_exp2f(p0[r + 1] - mu); p1[r + 1] = __builtin_amdgcn_exp2f(p1[r + 1] - mu);
        ls0 += p0[r]; ls1 += p1[r]; ls2 += p0[r + 1]; ls3 += p1[r + 1]; }
    st.l = st.l * alpha + ((ls0 + ls1) + (ls2 + ls3));
    if (__any(alpha != 1.0f)) {
        if (hf == 0) wsf[r32] = alpha;
        asm volatile("s_waitcnt lgkmcnt(0)" ::: "memory");
#pragma unroll
        for (int g = 0; g < 4; ++g) { const f32x4 a = *(const LAS f32x4*)(wsf + 8 * g + 4 * hf);
            st.o[0][4 * g] *= a.x; st.o[0][4 * g + 1] *= a.y; st.o[0][4 * g + 2] *= a.z; st.o[0][4 * g + 3] *= a.w;
            st.o[1][4 * g] *= a.x; st.o[1][4 * g + 1] *= a.y; st.o[1][4 * g + 2] *= a.z; st.o[1][4 * g + 3] *= a.w; }
    }
    bf16x8 a0, a1, a2, a3; pack_p(p0, p1, a0, a1, a2, a3);
    pv(st.o, vb, a0, a1, a2, a3);
}
DI void accum_scaled(f32x16* acc, const f32x16* o, float fac_row, LAS float* wsf, int r32, int hf) {
    if (hf == 0) wsf[32 + r32] = fac_row;
    asm volatile("s_waitcnt lgkmcnt(0)" ::: "memory");
#pragma unroll
    for (int g = 0; g < 4; ++g) { const f32x4 a = *(const LAS f32x4*)(wsf + 32 + 8 * g + 4 * hf);
        acc[0][4 * g] += o[0][4 * g] * a.x; acc[0][4 * g + 1] += o[0][4 * g + 1] * a.y; acc[0][4 * g + 2] += o[0][4 * g + 2] * a.z; acc[0][4 * g + 3] += o[0][4 * g + 3] * a.w;
        acc[1][4 * g] += o[1][4 * g] * a.x; acc[1][4 * g + 1] += o[1][4 * g + 1] * a.y; acc[1][4 * g + 2] += o[1][4 * g + 2] * a.z; acc[1][4 * g + 3] += o[1][4 * g + 3] * a.w; }
}
template <bool FIRST> DI void accum_lds(LAS float* accw, const f32x16* o, float fac_row, LAS float* wsf, int r32, int hf) {
    if (hf == 0) wsf[32 + r32] = fac_row;
    asm volatile("s_waitcnt lgkmcnt(0)" ::: "memory");
#pragma unroll
    for (int r = 0; r < 16; ++r) { const int orow = crow(r, hf); const float a = wsf[32 + orow];
        LAS float* d0 = accw + orow * 64 + r32; LAS float* d1 = d0 + 32;
        if (FIRST) { *d0 = o[0][r] * a; *d1 = o[1][r] * a; } else { *d0 += o[0][r] * a; *d1 += o[1][r] * a; } }
}
DI void stage_rows(const f32x16* acc, LAS bf16_t* stg, int r32, int hf) {
#pragma unroll
    for (int r = 0; r < 16; ++r) { const int orow = crow(r, hf);
        stg[orow * 64 + r32] = (bf16_t)f2bf(acc[0][r]); stg[orow * 64 + 32 + r32] = (bf16_t)f2bf(acc[1][r]); }
    asm volatile("s_waitcnt lgkmcnt(0)" ::: "memory");
}

struct TileSrc { const bf16_t* k; const bf16_t* k2; const bf16_t* v; long kstep, vstep; };
#define FA_THRL 8.0f
template <int DK, class MaskF>
DI void pipe_attn(LAS unsigned char* lds, const TileSrc src, int T, const bf16x8 (&qr)[DK / 16], const MaskF& maskf, f32x16 (&o)[2], float& l_out,
                  int wv, int lane, int r32, int hf, LAS float* wsf) {
    constexpr int KB = DK * 128;
    constexpr int PL_V = 3 * KB;
    const LAS unsigned char* kfrag0 = lds + L_K + hf * 1024 + r32 * 16;
    const int vfrag0 = (int)(uintptr_t)(lds + L_K + PL_V) + ((lane >> 4) & 1) * 32 + (lane & 3) * 8 + (4 * hf + ((lane & 15) >> 2)) * 64;
    LAS unsigned char* kst0 = lds + L_K + wv * 1024 + lane * 16; LAS unsigned char* vst0 = lds + L_K + PL_V + wv * 1024 + lane * 16;
    u32x4 kreg, kreg2, vreg;
    const bool k2on = (DK == 96) && (wv < 4);
#define PL_KLOAD(i) do { kreg = *(const u32x4*)(src.k + (long)(i) * src.kstep); if (k2on) kreg2 = *(const u32x4*)(src.k2 + (long)(i) * src.kstep); } while (0)
#define PL_KSTORE(buf) do { *(LAS u32x4*)(kst0 + (buf) * KB) = kreg; if (k2on) *(LAS u32x4*)(kst0 + (buf) * KB + 8192) = kreg2; } while (0)
#define PL_VLOAD(i) (vreg = *(const u32x4*)(src.v + (long)(i) * src.vstep))
    __syncthreads();
    { u32x4 ka_, kb_, kc_, ka2_, kb2_, kc2_; const int t1 = (T > 1) ? 1 : 0, t2 = (T > 2) ? 2 : 0;
      ka_ = *(const u32x4*)(src.k); kb_ = *(const u32x4*)(src.k + (long)t1 * src.kstep); kc_ = *(const u32x4*)(src.k + (long)t2 * src.kstep); PL_VLOAD(0);
      if (k2on) { ka2_ = *(const u32x4*)(src.k2); kb2_ = *(const u32x4*)(src.k2 + (long)t1 * src.kstep); kc2_ = *(const u32x4*)(src.k2 + (long)t2 * src.kstep); }
      *(LAS u32x4*)(kst0) = ka_; *(LAS u32x4*)(kst0 + KB) = kb_; *(LAS u32x4*)(kst0 + 2 * KB) = kc_; *(LAS u32x4*)(vst0) = vreg;
      if (k2on) { *(LAS u32x4*)(kst0 + 8192) = ka2_; *(LAS u32x4*)(kst0 + KB + 8192) = kb2_; *(LAS u32x4*)(kst0 + 2 * KB + 8192) = kc2_; } }
    if (T > 3) PL_KLOAD(3);
    if (T > 1) PL_VLOAD(1);
    __syncthreads();
    float mhat, l_reg = 0.f; f32x16 negm; bool resc = false;
    f32x16 pA0, pA1, pB0, pB1;
#pragma unroll
    for (int i = 0; i < 16; ++i) { o[0][i] = 0.f; o[1][i] = 0.f; }
    qkt<DK>(pA0, pA1, (lds_cptr)kfrag0, qr); maskf(pA0, pA1, 0);
    { const float rm = rowmax32(pA0, pA1); mhat = rm;
#pragma unroll
      for (int r = 0; r < 16; ++r) { pA0[r] = __builtin_amdgcn_exp2f(pA0[r] - rm); pA1[r] = __builtin_amdgcn_exp2f(pA1[r] - rm); negm[r] = -rm; }
      asm volatile("" : "+v"(negm)); }
    __syncthreads();
    u32x4 pw0, pw1, pw2, pw3;
    int kb_cur = 1, kb_st = 0, vb_prev = 0;
#define PL_PIN(x) asm volatile("" : "+v"(x))
#define PL_SB() __builtin_amdgcn_sched_barrier(0)
#define PL_KF(j) (*(const LAS bf16x8*)(kp_ + ((j) >> 1) * 2048 + ((j) & 1) * 512))
#define PL_VF(i) vfrag(vp_ + ((i) >> 2) * 4096 + ((i) & 3) * 1024)
#define PL_PAF(k) __builtin_bit_cast(bf16x8, pw##k)
#define PL_WORK(A0, A1, A2, A3, W0, W1, PW) do { sacc += A0; sacc += A1; sacc += A2; sacc += A3; PL_PIN(sacc); W0; W1; PL_PIN(PW); } while (0)
#define PL_GAPB(MF, X, B) do { MF; X[B] = __builtin_amdgcn_exp2f(X[B]); X[B + 1] = __builtin_amdgcn_exp2f(X[B + 1]); X[B + 2] = __builtin_amdgcn_exp2f(X[B + 2]); X[B + 3] = __builtin_amdgcn_exp2f(X[B + 3]); PL_PIN(X); PL_SB(); } while (0)
#define PL_MF(a, b, c) __builtin_amdgcn_mfma_f32_32x32x16_bf16(a, b, c, 0, 0, 0)
#define PL_STEP(C0, C1, P0, P1, t) do { const int t_ = (t); \
        if (t_ + 2 < T) PL_KSTORE(kb_st); \
        *(LAS u32x4*)(vst0 + (vb_prev ^ 1) * 8192) = vreg; \
        if (t_ + 3 < T) PL_KLOAD(t_ + 3); if (t_ + 1 < T) PL_VLOAD(t_ + 1); \
        PL_SB(); const LAS unsigned char* kp_ = kfrag0 + kb_cur * KB; const int vp_ = vfrag0 + vb_prev * 8192; \
        bf16x8 k0 = PL_KF(0), k1 = PL_KF(1), k2 = PL_KF(2); PL_SB(); float sacc = (P0[0] + P0[1]); \
        C0 = PL_MF(k0, qr[0], negm); k0 = PL_KF(3); PL_WORK(P0[2], P0[3], P0[4], P0[5],     pw0[0] = cvtpk(P0[0], P0[1]),   pw0[1] = cvtpk(P0[2], P0[3]),   pw0); PL_SB(); \
        C1 = PL_MF(k1, qr[0], negm); k1 = PL_KF(4); PL_WORK(P0[6], P0[7], P0[8], P0[9],     pw0[2] = cvtpk(P0[4], P0[5]),   pw0[3] = cvtpk(P0[6], P0[7]),   pw0); PL_SB(); \
        C0 = PL_MF(k2, qr[1], C0);   k2 = PL_KF(5); PL_WORK(P0[10], P0[11], P0[12], P0[13], pw1[0] = cvtpk(P0[8], P0[9]),   pw1[1] = cvtpk(P0[10], P0[11]), pw1); PL_SB(); \
        C1 = PL_MF(k0, qr[1], C1);   k0 = PL_KF(6); PL_WORK(P0[14], P0[15], P1[0], P1[1],   pw1[2] = cvtpk(P0[12], P0[13]), pw1[3] = cvtpk(P0[14], P0[15]), pw1); PL_SB(); \
        C0 = PL_MF(k1, qr[2], C0);   k1 = PL_KF(7); PL_WORK(P1[2], P1[3], P1[4], P1[5],     pw2[0] = cvtpk(P1[0], P1[1]),   pw2[1] = cvtpk(P1[2], P1[3]),   pw2); PL_SB(); \
        C1 = PL_MF(k2, qr[2], C1);   if (DK == 96) k2 = PL_KF(8); PL_WORK(P1[6], P1[7], P1[8], P1[9],     pw2[2] = cvtpk(P1[4], P1[5]),   pw2[3] = cvtpk(P1[6], P1[7]),   pw2); PL_SB(); \
        C0 = PL_MF(k0, qr[3], C0);   if (DK == 96) k0 = PL_KF(9); PL_WORK(P1[10], P1[11], P1[12], P1[13], pw3[0] = cvtpk(P1[8], P1[9]),   pw3[1] = cvtpk(P1[10], P1[11]), pw3); PL_SB(); \
        C1 = PL_MF(k1, qr[3], C1);   if (DK == 96) k1 = PL_KF(10); PL_WORK(P1[14], P1[15], 0.f, 0.f,       pw3[2] = cvtpk(P1[12], P1[13]), pw3[3] = cvtpk(P1[14], P1[15]), pw3); PL_SB(); \
        if (DK == 96) { C0 = PL_MF(k2, qr[DK / 16 - 2], C0); k2 = PL_KF(11); PL_SB(); C1 = PL_MF(k0, qr[DK / 16 - 2], C1); PL_SB(); C0 = PL_MF(k1, qr[DK / 16 - 1], C0); PL_SB(); C1 = PL_MF(k2, qr[DK / 16 - 1], C1); PL_SB(); } \
        l_reg += sacc; \
        bf16x8 v0 = PL_VF(0), v1 = PL_VF(4), v2 = PL_VF(1); \
        maskf(C0, C1, t_); \
        { const float rm = rowmax32(C0, C1); resc = false; \
          if (__builtin_expect(__any(rm > FA_THRL), 0)) { const float dl = fmaxf(rm, 0.f); mhat += dl; \
              _Pragma("unroll") for (int r = 0; r < 16; ++r) { C0[r] -= dl; C1[r] -= dl; } \
              _Pragma("unroll") for (int r = 0; r < 16; ++r) negm[r] = -mhat; \
              asm volatile("" : "+v"(negm)); \
              const float f_ = __builtin_amdgcn_exp2f(-dl); l_reg *= f_; if (hf == 0) wsf[r32] = f_; resc = true; } } \
        PL_SB(); \
        PL_GAPB(o[0] = PL_MF(PL_PAF(0), v0, o[0]); v0 = PL_VF(5), C0, 0); \
        PL_GAPB(o[1] = PL_MF(PL_PAF(0), v1, o[1]); v1 = PL_VF(2), C0, 4); \
        PL_GAPB(o[0] = PL_MF(PL_PAF(1), v2, o[0]); v2 = PL_VF(6), C0, 8); \
        PL_GAPB(o[1] = PL_MF(PL_PAF(1), v0, o[1]); v0 = PL_VF(3), C0, 12); \
        PL_GAPB(o[0] = PL_MF(PL_PAF(2), v1, o[0]); v1 = PL_VF(7), C1, 0); \
        PL_GAPB(o[1] = PL_MF(PL_PAF(2), v2, o[1]), C1, 4); \
        PL_GAPB(o[0] = PL_MF(PL_PAF(3), v0, o[0]), C1, 8); \
        PL_GAPB(o[1] = PL_MF(PL_PAF(3), v1, o[1]), C1, 12); \
        __syncthreads(); \
        if (resc) { \
            _Pragma("unroll") for (int g_ = 0; g_ < 4; ++g_) { const f32x4 a_ = *(const LAS f32x4*)(wsf + 8 * g_ + 4 * hf); \
                o[0][4 * g_] *= a_.x; o[0][4 * g_ + 1] *= a_.y; o[0][4 * g_ + 2] *= a_.z; o[0][4 * g_ + 3] *= a_.w; o[1][4 * g_] *= a_.x; o[1][4 * g_ + 1] *= a_.y; o[1][4 * g_ + 2] *= a_.z; o[1][4 * g_ + 3] *= a_.w; } } \
        kb_cur = (kb_cur == 2) ? 0 : kb_cur + 1; kb_st = (kb_st == 2) ? 0 : kb_st + 1; vb_prev ^= 1; \
    } while (0)
    int t = 1;
    for (; t + 1 < T; t += 2) { PL_STEP(pB0, pB1, pA0, pA1, t); PL_STEP(pA0, pA1, pB0, pB1, t + 1); }
    const bool tail = t < T;
    if (tail) PL_STEP(pB0, pB1, pA0, pA1, t);
#define PL_DRAIN(P0, P1) do { float sacc = 0.f; _Pragma("unroll") for (int r = 0; r < 16; ++r) sacc += P0[r] + P1[r]; l_reg += sacc; \
        bf16x8 a0_, a1_, a2_, a3_; pack_p(P0, P1, a0_, a1_, a2_, a3_); pv(o, vfrag0 + vb_prev * 8192, a0_, a1_, a2_, a3_); } while (0)
    if (tail) PL_DRAIN(pB0, pB1); else PL_DRAIN(pA0, pA1);
    l_out = l_reg;
    __syncthreads();
#undef PL_KLOAD
#undef PL_KSTORE
#undef PL_VLOAD
#undef PL_PIN
#undef PL_SB
#undef PL_KF
#undef PL_VF
#undef PL_PAF
#undef PL_WORK
#undef PL_GAPB
#undef PL_MF
#undef PL_STEP
#undef PL_DRAIN
}

DI void mla_unit(const Params& p, LAS unsigned char* lds, int b, int h, int qb, int wid0) {
    const int tid = opaque_tid(wid0), lane = tid & 63, r32 = lane & 31, hf = lane >> 5; const int wv = __builtin_amdgcn_readfirstlane(tid >> 6);
    const bf16_t* KN = wsp<bf16_t>(p, WS_KN); const bf16_t* VM = wsp<bf16_t>(p, WS_VM); bf16_t* OC = wsp<bf16_t>(p, WS_R1);
    const int rowbase = b * SEQ, q0 = qb * 256, tq = q0 + wv * 32 + r32, row = rowbase + tq;
    LAS float* wsf = (LAS float*)(lds + L_WS) + wv * 64;
    bf16x8 qr[6];
    {
        const bf16_t* src = wsp<bf16_t>(p, WS_R0) + (size_t)row * 768 + h * 96 + 8 * hf; float q[6][8]; float ss = 0.f;
#pragma unroll
        for (int d0 = 0; d0 < 6; ++d0) { unpack8(*(const u32x4*)(src + 16 * d0), q[d0]);
#pragma unroll
            for (int e = 0; e < 8; ++e) ss += q[d0][e] * q[d0][e]; }
        ss = sum32(ss);
        const float rstd = rsqrtf(ss * (1.f / 96.f) + EPS); const float* qg = p.in[I_MQG] + 8 * hf; const float* kg = p.in[I_MKG] + 8 * hf;
#pragma unroll
        for (int d0 = 0; d0 < 6; ++d0)
#pragma unroll
            for (int e = 0; e < 8; ++e) q[d0][e] *= rstd * qg[16 * d0 + e];
        const float* cs = ropeCM(p) + (size_t)row * 16 + 8 * hf; const float* sn = ropeSM(p) + (size_t)row * 16 + 8 * hf;
#pragma unroll
        for (int e = 0; e < 8; ++e) { const float x1 = q[4][e], x2 = q[5][e]; q[4][e] = x1 * cs[e] - x2 * sn[e]; q[5][e] = x2 * cs[e] + x1 * sn[e]; }
#pragma unroll
        for (int d0 = 0; d0 < 6; ++d0) { float f[8];
#pragma unroll
            for (int e = 0; e < 8; ++e) f[e] = q[d0][e] * ((d0 < 4) ? kg[16 * d0 + e] * C2M : C2M);
            qr[d0] = __builtin_bit_cast(bf16x8, pack8(f)); }
    }
    const int NT = 4 * (qb + 1);
    TileSrc src; src.k = KN + (size_t)(rowbase + lane) * 768 + h * 96 + wv * 8; src.k2 = src.k + 64; src.kstep = 64 * 768;
    src.v = VM + (size_t)(rowbase + 16 * (wv & 3) + (lane >> 2)) * 512 + h * 64 + (wv >> 2) * 32 + (lane & 3) * 8; src.vstep = 64 * 512;
    const int qlo = q0 + wv * 32;
    auto mk = [&](f32x16& p0, f32x16& p1, int i) { if (i * 64 + 63 > qlo) mask_range(p0, p1, i * 64, 0, tq, hf); };
    f32x16 ob[2]; float lb;
    pipe_attn<96>(lds, src, NT, qr, mk, ob, lb, wv, lane, r32, hf, wsf);
    const float lt = sum32(lb);
    f32x16 acc[2];
#pragma unroll
    for (int i = 0; i < 16; ++i) { acc[0][i] = 0.f; acc[1][i] = 0.f; }
    accum_scaled(acc, ob, 1.0f / lt, wsf, r32, hf);
    LAS bf16_t* stg = (LAS bf16_t*)(lds + L_OST) + wv * 4096;
    stage_rows(acc, stg, r32, hf);
#pragma unroll
    for (int i = 0; i < 4; ++i) { const int rr = i * 8 + (lane >> 3), ch = lane & 7; const u32x4 v = *(const LAS u32x4*)(stg + rr * 64 + ch * 8);
        *(u32x4*)(OC + (size_t)(rowbase + q0 + wv * 32 + rr) * 1024 + h * 64 + ch * 8) = v; }
}

DI void nsa_unit(const Params& p, LAS unsigned char* lds, int b, int g, int c, int wid0) {
    const int tid = opaque_tid(wid0), lane = tid & 63, r32 = lane & 31, hf = lane >> 5; const int wv = __builtin_amdgcn_readfirstlane(tid >> 6);
    const bf16_t* QN = wsp<bf16_t>(p, WS_QN); const bf16_t* KCF = wsp<bf16_t>(p, WS_KCF); const bf16_t* VCF = wsp<bf16_t>(p, WS_VCF);
    const bf16_t* KS = wsp<bf16_t>(p, WS_KS); const bf16_t* VS = wsp<bf16_t>(p, WS_VS); const bf16_t* KW = wsp<bf16_t>(p, WS_KW); const bf16_t* VW = wsp<bf16_t>(p, WS_VW);
    const bf16_t* GN = wsp<bf16_t>(p, WS_GN); bf16_t* OC = wsp<bf16_t>(p, WS_R1);
    const int rowbase = b * SEQ, tt = 8 * wv + (r32 >> 2), hd = g * 4 + (r32 & 3), tq = 64 * c + tt, row = rowbase + tq;
    LAS float* wsf = (LAS float*)(lds + L_WS) + wv * 64;
    bf16x8 qr[4];
#pragma unroll
    for (int d0 = 0; d0 < 4; ++d0) qr[d0] = *(const bf16x8*)(QN + (size_t)row * 512 + hd * 64 + 16 * d0 + 8 * hf);
    LAS float* accw = (LAS float*)(lds + L_OST) + wv * 2048;
    const int vboff = ((lane >> 4) & 1) * 32 + (lane & 3) * 8 + (4 * hf + ((lane & 15) >> 2)) * 64;
    u32x4 ka, vv;
#define NSA_LOAD(KB, VB, krow0) do { ka = *(const u32x4*)((KB) + (size_t)((krow0) + lane) * 128 + g * 64 + wv * 8); \
        vv = *(const u32x4*)((VB) + (size_t)((krow0) + 16 * (wv & 3) + (lane >> 2)) * 128 + g * 64 + (wv >> 2) * 32 + (lane & 3) * 8); } while (0)
#define NSA_STORE(koff, voff) do { *(LAS u32x4*)(lds + (koff) + wv * 1024 + lane * 16) = ka; *(LAS u32x4*)(lds + (voff) + wv * 1024 + lane * 16) = vv; } while (0)
    unsigned selmask;
    {
        const int ntile = (4 * c + 3 > 64) ? 2 : 1;
        const int nmax = (tq >= 31) ? ((tq - 31) >> 4) : -1;
        __syncthreads();
        { NSA_LOAD(KCF, VCF, b * 128); const u32x4 ka1_ = ka, vv1_ = vv; if (ntile == 2) NSA_LOAD(KCF, VCF, b * 128 + 64);
          *(LAS u32x4*)(lds + L_K + wv * 1024 + lane * 16) = ka1_; *(LAS u32x4*)(lds + L_V + wv * 1024 + lane * 16) = vv1_; if (ntile == 2) NSA_STORE(L_K + 8192, L_V + 8192); }
        __syncthreads();
        f32x16 pa0, pa1, pb0, pb1;
        qkt<64>(pa0, pa1, (lds_cptr)(lds + L_K) + hf * 1024 + r32 * 16, qr); mask_range(pa0, pa1, 0, 0, nmax, hf);
        float m = rowmax32(pa0, pa1);
        if (ntile == 2) { qkt<64>(pb0, pb1, (lds_cptr)(lds + L_K + 8192) + hf * 1024 + r32 * 16, qr); mask_range(pb0, pb1, 64, 0, nmax, hf); m = fmaxf(m, rowmax32(pb0, pb1)); }
        else {
#pragma unroll
            for (int i = 0; i < 16; ++i) { pb0[i] = -INFINITY; pb1[i] = -INFINITY; } }
        const float mu = (m == -INFINITY) ? 0.f : m;
        float ls = 0.f;
#pragma unroll
        for (int r = 0; r < 16; ++r) { pa0[r] = __builtin_amdgcn_exp2f(pa0[r] - mu); pa1[r] = __builtin_amdgcn_exp2f(pa1[r] - mu); pb0[r] = __builtin_amdgcn_exp2f(pb0[r] - mu); pb1[r] = __builtin_amdgcn_exp2f(pb1[r] - mu);
            ls += (pa0[r] + pa1[r]) + (pb0[r] + pb1[r]); }
        ls = sum32(ls);
        const float rl = (ls > 0.f) ? 1.0f / ls : 0.f;
#pragma unroll
        for (int r = 0; r < 16; ++r) { pa0[r] *= rl; pa1[r] *= rl; pb0[r] *= rl; pb1[r] *= rl; }
        float own[16], ee[16];
#pragma unroll
        for (int q = 0; q < 4; ++q) {
            own[q] = (pa0[4 * q] + pa0[4 * q + 1]) + (pa0[4 * q + 2] + pa0[4 * q + 3]); ee[q] = pa0[4 * q + 3];
            own[4 + q] = (pa1[4 * q] + pa1[4 * q + 1]) + (pa1[4 * q + 2] + pa1[4 * q + 3]); ee[4 + q] = pa1[4 * q + 3];
            own[8 + q] = (pb0[4 * q] + pb0[4 * q + 1]) + (pb0[4 * q + 2] + pb0[4 * q + 3]); ee[8 + q] = pb0[4 * q + 3];
            own[12 + q] = (pb1[4 * q] + pb1[4 * q + 1]) + (pb1[4 * q + 2] + pb1[4 * q + 3]); ee[12 + q] = pb1[4 * q + 3]; }
        float eo[16];
#pragma unroll
        for (int k = 0; k < 16; ++k) eo[k] = xor32(ee[k], hf);
#pragma unroll
        for (int k = 0; k < 16; ++k) { const float add = hf ? eo[k] : ((k > 0) ? eo[k - 1] : 0.f); own[k] += add; }
#pragma unroll
        for (int k = 0; k < 16; ++k) { own[k] += xorl<1>(own[k]); own[k] += xorl<2>(own[k]); }
        float imp[32];
#pragma unroll
        for (int k = 0; k < 16; ++k) { const float oth = xor32(own[k], hf); imp[2 * k] = hf ? oth : own[k]; imp[2 * k + 1] = hf ? own[k] : oth; }
        selmask = select_blocks(imp, c);
        State sc; st_init(sc);
        { bf16x8 a0, a1, a2, a3; pack_p(pa0, pa1, a0, a1, a2, a3); pv(sc.o, (int)(uintptr_t)(lds + L_V) + vboff, a0, a1, a2, a3); }
        if (ntile == 2) { bf16x8 a0, a1, a2, a3; pack_p(pb0, pb1, a0, a1, a2, a3); pv(sc.o, (int)(uintptr_t)(lds + L_V + 8192) + vboff, a0, a1, a2, a3); }
        accum_lds<true>(accw, sc.o, bf2f(GN[(size_t)row * 32 + hd * 3]), wsf, r32, hf);
    }
#pragma unroll 1
    for (int br = 1; br < 3; ++br) {
        const bf16_t* KB = (br == 1) ? KS : KW; const bf16_t* VB = (br == 1) ? VS : VW;
        const int NT = (br == 1) ? (c + 1) : ((c + 1 < 5) ? c + 1 : 5);
        TileSrc src; src.k = KB + (size_t)(rowbase + c * 64 + lane) * 128 + g * 64 + wv * 8; src.v = VB + (size_t)(rowbase + c * 64 + 16 * (wv & 3) + (lane >> 2)) * 128 + g * 64 + (wv >> 2) * 32 + (lane & 3) * 8;
        src.k2 = src.k; src.kstep = -64 * 128; src.vstep = -64 * 128;
        f32x16 ob[2]; float lb;
        if (br == 1) {
            auto mk = [&](f32x16& p0, f32x16& p1, int i) { const int j = c - i;
                if (i == 0) mask_range(p0, p1, j * 64, 0, tq, hf);
                if (!((selmask >> j) & 1u)) {
#pragma unroll
                    for (int r = 0; r < 16; ++r) { p0[r] = -INFINITY; p1[r] = -INFINITY; } } };
            pipe_attn<64>(lds, src, NT, qr, mk, ob, lb, wv, lane, r32, hf, wsf);
        } else {
            const int lo = tq - 255;
            auto mk = [&](f32x16& p0, f32x16& p1, int i) { if (i == 0 || i == 4) mask_range(p0, p1, (c - i) * 64, lo, tq, hf); };
            pipe_attn<64>(lds, src, NT, qr, mk, ob, lb, wv, lane, r32, hf, wsf);
        }
        const float lt = sum32(lb);
        accum_lds<false>(accw, ob, bf2f(GN[(size_t)row * 32 + hd * 3 + br]) / lt, wsf, r32, hf);
    }
#undef NSA_LOAD
#undef NSA_STORE
    asm volatile("s_waitcnt lgkmcnt(0)" ::: "memory");
#pragma unroll
    for (int i = 0; i < 4; ++i) { const int rr = i * 8 + (lane >> 3), ch = lane & 7; const f32x4 a = *(const LAS f32x4*)(accw + rr * 64 + ch * 8), b2 = *(const LAS f32x4*)(accw + rr * 64 + ch * 8 + 4);
        u32x4 v; v.x = pk2(a.x, a.y); v.y = pk2(a.z, a.w); v.z = pk2(b2.x, b2.y); v.w = pk2(b2.z, b2.w);
        *(u32x4*)(OC + (size_t)(rowbase + 64 * c + 8 * wv + (rr >> 2)) * 1024 + 512 + (g * 4 + (rr & 3)) * 64 + ch * 8) = v; }
}
#undef FA_SBAR
}

DI void stage_attn_fast(const Params& p, LAS unsigned char* lds, int bid, int nb, bool do_mla, bool do_nsa, int wid0) {
    if (do_mla) for (int u = bid; u < 256; u += nb) { const int bh = u >> 2, s = u & 3; fa::mla_unit(p, lds, bh >> 3, bh & 7, 7 - s, wid0); fa::mla_unit(p, lds, bh >> 3, bh & 7, s, wid0); }
    if (do_nsa) for (int u = bid; u < 256; u += nb) { const int bg = u >> 4, s = u & 15; fa::nsa_unit(p, lds, bg >> 1, bg & 1, 31 - s, wid0); fa::nsa_unit(p, lds, bg >> 1, bg & 1, s, wid0); }
    __syncthreads();
}
#define XB_TMO      128
#define XB_XCNT(j)  (256  + 64 * (j))
#define XB_XSUB(j)  (1280 + 64 * (j))
#define XB_XGEN(j)  (2304 + 64 * (j))
#define XB_TOP      3328
#define XB_TOPGEN   3392
#define XCD_BAR_WORDS 3456
#define XB_SPIN_CAP (1u << 18)

__device__ __forceinline__ unsigned xb_ld(unsigned* p)              { return __hip_atomic_load(p, __ATOMIC_RELAXED, __HIP_MEMORY_SCOPE_AGENT); }
__device__ __forceinline__ unsigned xb_add(unsigned* p, unsigned v) { return __hip_atomic_fetch_add(p, v, __ATOMIC_RELAXED, __HIP_MEMORY_SCOPE_AGENT); }
__device__ __forceinline__ unsigned xb_xcc_id() { return (unsigned)__builtin_amdgcn_s_getreg((3 << 11) | 20) & 0xFu; }
#define XB_SPIN(cond, bar) do { unsigned _sp = 0; while (cond) { __builtin_amdgcn_s_sleep(1); \
    if ((++_sp & 255u) == 0u) { if (xb_ld(&(bar)[XB_TMO])) break; if (_sp > XB_SPIN_CAP) { atomicAdd(&(bar)[XB_TMO], 1u); break; } } } } while (0)

struct XcdBarrier {
    unsigned* bar; unsigned x;
    volatile LAS unsigned* st;
};

__device__ __forceinline__ XcdBarrier xcd_barrier_post(unsigned* bar, volatile LAS unsigned* st, bool t0) {
    XcdBarrier b; b.bar = bar; b.x = xb_xcc_id(); b.st = st;
    if (t0) (void)xb_add(&bar[XB_XCNT(b.x)], 1u);
    return b;
}
__device__ __forceinline__ void xcd_barrier_complete(unsigned* bar, unsigned x, unsigned& nloc, unsigned& nx) {
    const unsigned G = gridDim.x * gridDim.y * gridDim.z;
    unsigned sum, cnt, mine, sp = 0u;
    for (;;) {
        sum = 0u; cnt = 0u; mine = 0u;
#pragma unroll
        for (unsigned j = 0; j < 16; ++j) { const unsigned c = xb_ld(&bar[XB_XCNT(j)]); sum += c; cnt += (c > 0u) ? 1u : 0u; mine = (j == x) ? c : mine; }
        if (sum == G) break;
        __builtin_amdgcn_s_sleep(1);
        if ((++sp & 255u) == 0u) { if (xb_ld(&bar[XB_TMO])) break; if (sp > XB_SPIN_CAP) { atomicAdd(&bar[XB_TMO], 1u); break; } }
    }
    nloc = mine > 0u ? mine : 1u; nx = cnt > 0u ? cnt : 1u;
}

__device__ __forceinline__ void xcd_barrier(const XcdBarrier& b, bool t0) {
    asm volatile("s_waitcnt vmcnt(0)" ::: "memory");
    __syncthreads();
    if (t0) {
        unsigned* bar = b.bar;
        __builtin_amdgcn_s_waitcnt(0);
        unsigned nloc = b.st[0], nx = b.st[1];
        if (nloc == 0u) { xcd_barrier_complete(bar, b.x, nloc, nx); b.st[0] = nloc; b.st[1] = nx; }
        const unsigned old = xb_add(&bar[XB_XSUB(b.x)], 1u);
        const unsigned gen = old / nloc;
        if (old + 1u == (gen + 1u) * nloc) {
            __builtin_amdgcn_fence(__ATOMIC_RELEASE, "agent");
            asm volatile("s_waitcnt vmcnt(0)" ::: "memory");
            const unsigned og = xb_add(&bar[XB_TOP], 1u);
            const unsigned tg = og / nx;
            if (og + 1u == (tg + 1u) * nx) xb_add(&bar[XB_TOPGEN], 1u);
            else XB_SPIN(xb_ld(&bar[XB_TOPGEN]) == tg, bar);
            __builtin_amdgcn_fence(__ATOMIC_ACQUIRE, "agent");
            xb_add(&bar[XB_XGEN(b.x)], 1u);
            asm volatile("s_waitcnt vmcnt(0)" ::: "memory");
        } else {
            XB_SPIN(xb_ld(&bar[XB_XGEN(b.x)]) == gen, bar);
            __builtin_amdgcn_fence(__ATOMIC_ACQUIRE, "agent");
            asm volatile("s_waitcnt vmcnt(0)" ::: "memory");
        }
    }
    __syncthreads();
}
constexpr int LDS_BYTES = 147456;
#ifndef REPEAT_PHASE
#define REPEAT_PHASE -1
#endif
#define REP(k) for (int rep_ = 0; rep_ < ((REPEAT_PHASE == (k)) ? 2 : 1); ++rep_)
#ifndef USE_CG_SYNC
#define USE_CG_SYNC 0
#endif

typedef const Params __attribute__((address_space(4)))* KParamsPtr;
#if defined(__HIP_DEVICE_COMPILE__)
DI KParamsPtr kparams() { KParamsPtr k = (KParamsPtr)__builtin_amdgcn_kernarg_segment_ptr(); asm volatile("" : "+s"(k)); return k; }
#endif
#if defined(__HIP_DEVICE_COMPILE__)
#define PHASE_PARAMS() const Params p = *kparams()
#else
#define PHASE_PARAMS() const Params p = p_arg
#endif
__global__ void __launch_bounds__(512, 2) fwd_megakernel(Params p_arg) {
    extern __shared__ __attribute__((aligned(16))) unsigned char dlds[];
    LAS unsigned char* lds = (LAS unsigned char*)dlds;
#if USE_CG_SYNC
    cg::grid_group grid = cg::this_grid();
#endif
    const int G = gridDim.x, c = blockIdx.x, ngw = G * NWAVE, ngt = G * NTHR;
    const int wid0 = __builtin_amdgcn_readfirstlane(threadIdx.x >> 6);
#define TIDS() const int tid = opaque_tid(wid0), lane = tid & 63, wave = tid >> 6, gw = c * NWAVE + wave, gtid = c * NTHR + tid; (void)lane; (void)gw; (void)gtid
#if USE_CG_SYNC
#define GRID_SYNC() grid.sync()
#else
    volatile LAS unsigned* MISC = (volatile LAS unsigned*)(lds + 131072 + 320);
    { TIDS(); if (tid < 32) MISC[tid] = 0u; }
    __syncthreads();
    XcdBarrier bar;
    { PHASE_PARAMS(); TIDS(); bar = xcd_barrier_post((unsigned*)(p.ws + WS_CTL) + 4096, MISC + 8, tid == 0); }
#ifdef DOUBLE_BAR
#define GRID_SYNC() do { TIDS(); xcd_barrier(bar, tid == 0); xcd_barrier(bar, tid == 0); } while (0)
#else
#define GRID_SYNC() do { TIDS(); xcd_barrier(bar, tid == 0); } while (0)
#endif
#endif
    REP(0) { PHASE_PARAMS();
    { TIDS(); stage_weights(p, gw, ngw, (float*)dlds + wave * (64 * 33), lane); }
    __syncthreads();
    stage_mod(p, c, G, (float*)dlds, wid0);
    __syncthreads();
    { TIDS(); stage_rope(p, tid, gtid, ngt, (float*)dlds + 16384); } }
    GRID_SYNC();
    REP(1) { PHASE_PARAMS(); TIDS(); stage_normmod(p.in[I_X], p.in[I_N1G], wsp<float>(p, WS_MOD), 0, 1, wsp<bf16_t>(p, WS_R0), gw, ngw, lane); stage_shw(p, gw, ngw, lane); }
    GRID_SYNC();
    REP(2) { PHASE_PARAMS(); EpiZ E{p}; gemm_fast(lds, wsp<bf16_t>(p, WS_R0), 1024, wsp<bf16_t>(p, WS_WIN), MT, ZN, 1024, E, G, c, wid0); }
    GRID_SYNC();
    REP(3) { PHASE_PARAMS();
      int qb, qc, kb, kc;
      if (G == 256) { qb = c; qc = (c < 192) ? 1 : 0; kb = (c < 192) ? c : (c >= 224 ? 192 + 2 * (c - 224) : 0); kc = (c < 192) ? 1 : (c >= 224 ? 2 : 0); }
      else { const int pq = (192 + G - 1) / G, pk = (256 + G - 1) / G; qb = c * pq; qc = (192 - qb < pq) ? ((192 - qb > 0) ? 192 - qb : 0) : pq; kb = c * pk; kc = (256 - kb < pk) ? ((256 - kb > 0) ? 256 - kb : 0) : pk; }
      { EpiQ E{p}; gemm_fast_range(lds, wsp<bf16_t>(p, WS_R1), 1024, wsp<bf16_t>(p, WS_WQB), MT, 768, 768, E, qb, qc, wid0); }
      for (int cu = (c + 64) % G; cu < 32; cu += G) cmp_hidden_fast(p, lds, cu, wid0);
      { EpiKV E{p}; gemm_fast_range(lds, wsp<bf16_t>(p, WS_R1) + 768, 1024, wsp<bf16_t>(p, WS_WKVB), MT, 1024, 256, E, kb, kc, wid0); }
    }
    GRID_SYNC();
    { PHASE_PARAMS(); TIDS(); cmp_out<true>(p, gw, ngw, lane); }
    REP(4) { PHASE_PARAMS(); stage_attn_fast(p, lds, c, G, true, false, wid0); }
    GRID_SYNC();
    REP(5) { PHASE_PARAMS(); stage_attn_fast(p, lds, c, G, false, true, wid0); }
    GRID_SYNC();
    REP(6) { PHASE_PARAMS(); EpiMerge E{p}; gemm_fast(lds, wsp<bf16_t>(p, WS_R1), 1024, wsp<bf16_t>(p, WS_WO), MT, 1024, 1024, E, G, c, wid0); }
    GRID_SYNC();
    REP(7) { PHASE_PARAMS(); EpiOut E{p}; gemm_fast(lds, wsp<bf16_t>(p, WS_R0), 1024, wsp<bf16_t>(p, WS_WOUT), MT, 1024, 1024, E, G, c, wid0); }
    GRID_SYNC();
    REP(9) { PHASE_PARAMS(); EpiGU E{p}; gemm_fast(lds, wsp<bf16_t>(p, WS_R1), 1024, wsp<bf16_t>(p, WS_WGU), MT, 5632, 1024, E, G, c, wid0); }
    GRID_SYNC();
    REP(10) { PHASE_PARAMS(); EpiDown E{p}; gemm_fast(lds, wsp<bf16_t>(p, WS_HID), DFF, wsp<bf16_t>(p, WS_WD), MT, 1024, DFF, E, G, c, wid0); }
}

extern "C" void kernel_launch(void* const* d_in, const int* in_sizes, int n_in, void* d_out, int out_size, void* d_ws, size_t ws_size, hipStream_t stream) {
    if (n_in != 30 || out_size != MT * DM || ws_size < WS_END) { fprintf(stderr, "kernel_launch: unexpected shapes (n_in %d out %d ws %zu)\n", n_in, out_size, ws_size); return; }
    static int grid = 0;
    if (grid == 0) {
        int dev = 0, cus = 0, per_cu = 0;
        hipGetDevice(&dev); hipDeviceGetAttribute(&cus, hipDeviceAttributeMultiprocessorCount, dev);
        hipFuncSetAttribute((const void*)fwd_megakernel, hipFuncAttributeMaxDynamicSharedMemorySize, LDS_BYTES);
        hipOccupancyMaxActiveBlocksPerMultiprocessor(&per_cu, (const void*)fwd_megakernel, NTHR, LDS_BYTES);
        if (per_cu < 1) { fprintf(stderr, "kernel_launch: occupancy query says %d blocks per CU\n", per_cu); per_cu = 1; }
        grid = cus;
        (void)hipGetLastError();
    }
    Params p{};
    for (int i = 0; i < 30; ++i) p.in[i] = (const float*)d_in[i];
    p.out = (float*)d_out; p.ws = (unsigned char*)d_ws;
    if (!USE_CG_SYNC) (void)hipMemsetAsync((char*)d_ws + WS_CTL, 0, 65536, stream);
    void* args[] = {&p};
#ifndef USE_COOP
#define USE_COOP 1
#endif
    hipError_t e;
    if (USE_COOP) e = hipLaunchCooperativeKernel((const void*)fwd_megakernel, dim3(grid), dim3(NTHR), args, LDS_BYTES, stream);
    else { hipLaunchKernelGGL(fwd_megakernel, dim3(grid), dim3(NTHR), LDS_BYTES, stream, p); e = hipPeekAtLastError(); }
    if (e != hipSuccess) fprintf(stderr, "kernel_launch: cooperative launch failed: %s (grid %d)\n", hipGetErrorString(e), grid);
}
```

```cpp
#include <hip/hip_runtime.h>
#include <cstdint>
#include <cstdio>

typedef unsigned short bf16_t;
typedef unsigned u32x4 __attribute__((ext_vector_type(4)));
typedef unsigned u32x2 __attribute__((ext_vector_type(2)));
typedef float f32x4 __attribute__((ext_vector_type(4)));
typedef float f32x2 __attribute__((ext_vector_type(2)));
#define DI __device__ __forceinline__

constexpr int NB = 8, SEQ = 2048, DM = 1024, MT = NB * SEQ;
constexpr int DFF = 2816, NMOD = 6;
constexpr int ZN = 4608;
constexpr float EPS = 1e-6f;
constexpr float LOG2E = 1.4426950408889634f;
constexpr float C2N = 0.125f * LOG2E;
constexpr float C2M = 0.10206207261596575f * LOG2E;
constexpr int NTHR = 512, NWAVE = 8;
constexpr int O_CQ = 0, O_CKV = 768, O_KPE = 1024, O_QN = 1056, O_KC = 1568, O_VC = 1696, O_KS = 1824, O_VS = 1952, O_KW = 2080, O_VW = 2208,
              O_GN = 2336, O_GM = 2360, O_GNM = 3384, D_IN = 4408;

constexpr size_t MiB = 1u << 20;
constexpr size_t WS_CTL = 0;
constexpr size_t WS_MOD = 1 * MiB;
constexpr size_t WS_CB1 = 1 * MiB + 256 * 1024;
constexpr size_t WS_SSQPE = 1 * MiB + 320 * 1024;
constexpr size_t WS_SSQKN = 1 * MiB + 512 * 1024;
constexpr size_t WS_SSQA = 2 * MiB;
constexpr size_t WS_KCF = 3 * MiB;
constexpr size_t WS_VCF = 3 * MiB + 256 * 1024;
constexpr size_t WS_SHW = 3 * MiB + 512 * 1024;
constexpr size_t WS_WIN = 4 * MiB;
constexpr size_t WS_WQB = 13 * MiB;
constexpr size_t WS_WKVB = 15 * MiB;
constexpr size_t WS_WO = 16 * MiB;
constexpr size_t WS_WOUT = 18 * MiB;
constexpr size_t WS_WGU = 20 * MiB;
constexpr size_t WS_WD = 31 * MiB;
constexpr size_t WS_CW1 = 37 * MiB;
constexpr size_t WS_R0 = 40 * MiB;
constexpr size_t WS_R1 = 72 * MiB;
constexpr size_t WS_R2 = 104 * MiB;
constexpr size_t WS_QN = 168 * MiB;
constexpr size_t WS_KC = 184 * MiB, WS_VC = 188 * MiB, WS_KS = 192 * MiB, WS_VS = 196 * MiB, WS_KW = 200 * MiB, WS_VW = 204 * MiB;
constexpr size_t WS_KPE = 208 * MiB;
constexpr size_t WS_GN = 209 * MiB;
constexpr size_t WS_KN = 210 * MiB;
constexpr size_t WS_VM = 234 * MiB;
constexpr size_t WS_CMPH = 64 * MiB;
constexpr size_t WS_ROPE = 250 * MiB;
constexpr size_t WS_HID = 168 * MiB;
constexpr size_t WS_END = 256 * MiB;

struct Params {
    const float* in[30];
    float* out;
    unsigned char* ws;
};
enum { I_X = 0, I_C, I_POS, I_ADAW, I_ADAB, I_N1G, I_WIN, I_QAG, I_WQB, I_KVAG, I_WKVB, I_MQG, I_MKG, I_NQG, I_NKCG, I_NKSG, I_NKWG,
       I_CPK, I_CW1K, I_CW2K, I_CPV, I_CW1V, I_CW2V, I_WOM, I_WON, I_WOUT, I_N2G, I_WG, I_WU, I_WDN };

template <class T> DI T* wsp(const Params& p, size_t off) { return (T*)(p.ws + off); }

#ifndef WT_STORES
#define WT_STORES 0
#endif
DI void st16(void* p, u32x4 v) {
#if WT_STORES
    asm volatile("global_store_dwordx4 %0, %1, off sc1\n\ts_nop 1" :: "v"(p), "v"(v) : "memory");
#else
    *(u32x4*)p = v;
#endif
}
DI void st16f(void* p, f32x4 v) { st16(p, __builtin_bit_cast(u32x4, v)); }
DI int lane_id() { return (int)__builtin_amdgcn_mbcnt_hi(~0u, __builtin_amdgcn_mbcnt_lo(~0u, 0u)); }
DI int opaque_lane() { int l; asm volatile("v_mbcnt_lo_u32_b32 %0, -1, 0\n\tv_mbcnt_hi_u32_b32 %0, -1, %0" : "=v"(l)); return l; }
DI int opaque_tid(int wid0) { int l; asm volatile("v_mbcnt_lo_u32_b32 %0, -1, 0\n\tv_mbcnt_hi_u32_b32 %0, -1, %0" : "=v"(l)); return (wid0 << 6) | l; }
DI unsigned f2bf(float f) { unsigned u = __float_as_uint(f); return (u + 0x7fffu + ((u >> 16) & 1u)) >> 16; }
DI unsigned pk2(float lo, float hi) { return f2bf(lo) | (f2bf(hi) << 16); }
DI float bf2f(unsigned short b) { return __uint_as_float(((unsigned)b) << 16); }
DI float bflo(unsigned w) { return __uint_as_float(w << 16); }
DI float bfhi(unsigned w) { return __uint_as_float(w & 0xffff0000u); }
DI void unpack8(const u32x4 w, float (&f)[8]) { f[0] = bflo(w.x); f[1] = bfhi(w.x); f[2] = bflo(w.y); f[3] = bfhi(w.y); f[4] = bflo(w.z); f[5] = bfhi(w.z); f[6] = bflo(w.w); f[7] = bfhi(w.w); }
DI u32x4 pack8(const float (&f)[8]) { u32x4 w; w.x = pk2(f[0], f[1]); w.y = pk2(f[2], f[3]); w.z = pk2(f[4], f[5]); w.w = pk2(f[6], f[7]); return w; }
DI float sigmoidf(float x) { return __builtin_amdgcn_rcpf(1.0f + __expf(-x)); }
DI float siluf(float x) { return x * __builtin_amdgcn_rcpf(1.0f + __expf(-x)); }
template <int X> DI float xorl(float v) { return __int_as_float(__builtin_amdgcn_ds_swizzle(__float_as_int(v), (X << 10) | 0x1f)); }
DI void halves(float v, float& lo, float& hi) { auto rr = __builtin_amdgcn_permlane32_swap(__float_as_uint(v), __float_as_uint(v), false, false); lo = __uint_as_float(rr[0]); hi = __uint_as_float(rr[1]); }
DI float xor32(float v, int hf) { float lo, hi; halves(v, lo, hi); return hf ? lo : hi; }
DI float sum32(float v) { float lo, hi; halves(v, lo, hi); return lo + hi; }
DI float max32(float v) { float lo, hi; halves(v, lo, hi); return fmaxf(lo, hi); }
DI float wave_sum(float v) { v += xorl<1>(v); v += xorl<2>(v); v += xorl<4>(v); v += xorl<8>(v); v += xorl<16>(v); return sum32(v); }
DI void sincos_rad(float ang, float& c, float& s) {
    double rev = (double)ang * 0.15915494309189535; rev -= __builtin_rint(rev);
    const float fr = (float)rev; s = __builtin_amdgcn_sinf(fr); c = __builtin_amdgcn_cosf(fr);
}
#define LAS __attribute__((address_space(3)))
DI void transpose_item(const float* W, int ldw, int c0, int ncols, const float* rs, bf16_t* dst, int ldd, int n0, int k0, float* scr, int lane) {
    const int cc = lane & 31, kh = lane >> 5;
    float v[32];
    if (c0 >= 0) {
        const float* src = W + (size_t)(k0 + kh) * ldw + c0 + cc;
        if (cc < ncols) {
#pragma unroll
            for (int i = 0; i < 32; ++i) v[i] = src[(size_t)(2 * i) * ldw];
        } else {
#pragma unroll
            for (int i = 0; i < 32; ++i) v[i] = 0.f;
        }
        if (rs) {
#pragma unroll
            for (int i = 0; i < 32; ++i) v[i] *= rs[k0 + 2 * i + kh];
        }
    } else {
#pragma unroll
        for (int i = 0; i < 32; ++i) v[i] = 0.f;
    }
#pragma unroll
    for (int i = 0; i < 32; ++i) scr[(2 * i + kh) * 33 + cc] = v[i];
    __builtin_amdgcn_s_waitcnt(0xc07f);
    asm volatile("" ::: "memory");
    const int c = lane & 7;
#pragma unroll
    for (int j = 0; j < 4; ++j) { const int n = (lane >> 3) + 8 * j; const float* s = scr + (8 * c) * 33 + n;
        u32x4 o; o.x = pk2(s[0 * 33], s[1 * 33]); o.y = pk2(s[2 * 33], s[3 * 33]); o.z = pk2(s[4 * 33], s[5 * 33]); o.w = pk2(s[6 * 33], s[7 * 33]);
        st16(dst + (size_t)(n0 + n) * ldd + k0 + 8 * c, o); }
    __builtin_amdgcn_s_waitcnt(0xc07f);
    asm volatile("" ::: "memory");
}
DI int zsrc(int s, int L0, int& ncols) {
    ncols = 32;
    if (s < 16) return 64 * s + L0;
    if (s == 16) { if (L0 == 0) return O_KPE; ncols = 24; return O_GN; }
    if (s < 25) return O_QN + 64 * (s - 17) + L0;
    if (s < 27) return O_KC + 64 * (s - 25) + L0;
    if (s < 29) return O_VC + 64 * (s - 27) + L0;
    if (s < 31) return O_KS + 64 * (s - 29) + L0;
    if (s < 33) return O_VS + 64 * (s - 31) + L0;
    if (s < 35) return O_KW + 64 * (s - 33) + L0;
    if (s < 37) return O_VW + 64 * (s - 35) + L0;
    if (s < 40) return -1;
    if (s < 56) return O_GM + 64 * (s - 40) + L0;
    return O_GNM + 64 * (s - 56) + L0;
}
template <int PART> DI void stage_weights(const Params& p, int gw, int ngw, float* scr, int lane) {
    constexpr int I_IN = (ZN / 32) * (DM / 64);
    constexpr int I_QB = (768 / 32) * (768 / 64);
    constexpr int I_KVB = (1024 / 32) * (256 / 64);
    constexpr int I_O = (1024 / 32) * (1024 / 64);
    constexpr int I_OUT = I_O;
    constexpr int I_GU = (5632 / 32) * (1024 / 64);
    constexpr int I_D = (1024 / 32) * (DFF / 64);
    constexpr int I_C1 = 2 * (256 / 32) * (2048 / 64);
    if constexpr (PART == 1) {
        for (int r = gw; r < I_GU; r += ngw) { const int nb = r / 16, kb = r % 16; const int pn = nb >> 3, bj = (nb >> 2) & 1, wc = nb & 3, s = 4 * pn + wc;
            transpose_item(bj ? p.in[I_WU] : p.in[I_WG], DFF, 32 * s, 32, nullptr, wsp<bf16_t>(p, WS_WGU), 1024, nb * 32, kb * 64, scr, lane); }
        for (int r = gw; r < I_O + I_OUT; r += ngw) {
            if (r < I_O) { const int nb = r / 16, kb = r % 16;
                if (kb < 8) transpose_item(p.in[I_WOM], 1024, nb * 32, 32, nullptr, wsp<bf16_t>(p, WS_WO), 1024, nb * 32, kb * 64, scr, lane);
                else transpose_item(p.in[I_WON] - (size_t)512 * 1024, 1024, nb * 32, 32, nullptr, wsp<bf16_t>(p, WS_WO), 1024, nb * 32, kb * 64, scr, lane); }
            else { const int r2 = r - I_O, nb = r2 / 16, kb = r2 % 16; transpose_item(p.in[I_WOUT], 1024, nb * 32, 32, nullptr, wsp<bf16_t>(p, WS_WOUT), 1024, nb * 32, kb * 64, scr, lane); } }
        return;
    }
    if constexpr (PART == 2) {
        for (int r = gw; r < I_D; r += ngw) { const int nb = r / 44, kb = r % 44; transpose_item(p.in[I_WDN], 1024, nb * 32, 32, nullptr, wsp<bf16_t>(p, WS_WD), DFF, nb * 32, kb * 64, scr, lane); }
        return;
    }
    constexpr int NITEMS = I_IN + I_QB + I_KVB + I_C1;
    for (int it = gw; it < NITEMS; it += ngw) {
        int r = it;
        if (r < I_IN) { const int nb = r / 16, kb = r % 16; const int pn = nb >> 3, bj = (nb >> 2) & 1, wc = nb & 3; int nc; const int c0 = zsrc(4 * pn + wc, 32 * bj, nc);
            transpose_item(p.in[I_WIN], D_IN, c0, nc, nullptr, wsp<bf16_t>(p, WS_WIN), DM, nb * 32, kb * 64, scr, lane); continue; } r -= I_IN;
        if (r < I_QB) { const int nb = r / 12, kb = r % 12; transpose_item(p.in[I_WQB], 768, nb * 32, 32, p.in[I_QAG], wsp<bf16_t>(p, WS_WQB), 768, nb * 32, kb * 64, scr, lane); continue; } r -= I_QB;
        if (r < I_KVB) { const int nb = r / 4, kb = r % 4; const int pn = nb >> 3, bj = (nb >> 2) & 1, wc = nb & 3, s = 4 * pn + wc;
            const int c0 = (s < 8) ? (128 * s + 32 * bj) : (128 * (s - 8) + 64 + 32 * bj);
            transpose_item(p.in[I_WKVB], 1024, c0, 32, p.in[I_KVAG], wsp<bf16_t>(p, WS_WKVB), 256, nb * 32, kb * 64, scr, lane); continue; } r -= I_KVB;
        { const int kv = r / 256, rr = r % 256, nb = rr / 32, kb = rr % 32;
          transpose_item(kv ? p.in[I_CW1V] : p.in[I_CW1K], 256, nb * 32, 32, nullptr, wsp<bf16_t>(p, WS_CW1) + (size_t)kv * 256 * 2048, 2048, nb * 32, kb * 64, scr, lane); }
    }
}
DI void stage_mod(const Params& p, int bid, int nb, float* lds, int wid0) {
    const int tid = opaque_tid(wid0), wave = tid >> 6, lane = tid & 63, nwv = blockDim.x >> 6;
    if (bid >= 104) return;
    float* sl = lds; float* red = lds + 8192;
    for (int i = tid; i < 8192; i += blockDim.x) sl[i] = siluf(p.in[I_C][i]);
    __syncthreads();
    for (int u = bid; u < 104; u += nb) {
        float acc[8];
#pragma unroll
        for (int b = 0; b < 8; ++b) acc[b] = 0.f;
        if (u < 96) {
            const float* W = p.in[I_ADAW] + u * 64 + lane; const int kn = 1024 / nwv;
            for (int k = wave * kn; k < (wave + 1) * kn; k += 8) { float w[8];
#pragma unroll
                for (int e = 0; e < 8; ++e) w[e] = W[(size_t)(k + e) * 6144];
#pragma unroll
                for (int e = 0; e < 8; ++e)
#pragma unroll
                    for (int b = 0; b < 8; ++b) acc[b] += sl[b * 1024 + k + e] * w[e]; }
        } else {
            const int kv = (u - 96) >> 2; const float* W = (kv ? p.in[I_CW1V] : p.in[I_CW1K]) + ((u - 96) & 3) * 64 + lane; const float* pos = kv ? p.in[I_CPV] : p.in[I_CPK]; const int kn = 2048 / nwv;
            for (int k = wave * kn; k < (wave + 1) * kn; k += 8) { float w[8];
#pragma unroll
                for (int e = 0; e < 8; ++e) w[e] = W[(size_t)(k + e) * 256];
#pragma unroll
                for (int e = 0; e < 8; ++e) acc[0] += pos[k + e] * w[e]; }
        }
        __syncthreads();
#pragma unroll
        for (int b = 0; b < 8; ++b) red[(wave * 8 + b) * 64 + lane] = acc[b];
        __syncthreads();
        if (wave == 0) {
#pragma unroll
            for (int b = 0; b < 8; ++b) { float s = 0.f;
                for (int w = 0; w < nwv; ++w) s += red[(w * 8 + b) * 64 + lane];
                if (u < 96) wsp<float>(p, WS_MOD)[b * 6144 + u * 64 + lane] = s + p.in[I_ADAB][u * 64 + lane];
                else if (b == 0) wsp<float>(p, WS_CB1)[(u - 96) * 64 + lane] = s; }
        }
    }
}
DI void stage_rope(const Params& p, int tid, int gtid, int ngt, float* invt) {
    if (tid < 24) invt[tid] = (tid < 16) ? (float)pow(500000.0, -(double)tid / 16.0) : (float)pow(500000.0, -(double)(tid - 16) / 8.0);
    __syncthreads();
    float* T = wsp<float>(p, WS_ROPE); const int* pos = (const int*)p.in[I_POS];
    for (int i = gtid; i < MT * 24; i += ngt) {
        const int row = i / 24, j = i % 24; const float ps = (float)pos[row]; float c, s;
        sincos_rad(ps * invt[j], c, s);
        if (j < 16) { T[(size_t)row * 16 + j] = c; T[(size_t)MT * 16 + (size_t)row * 16 + j] = s; }
        else { T[(size_t)MT * 32 + (size_t)row * 8 + (j - 16)] = c; T[(size_t)MT * 40 + (size_t)row * 8 + (j - 16)] = s; }
    }
}
DI const float* ropeCM(const Params& p) { return wsp<float>(p, WS_ROPE); }
DI const float* ropeSM(const Params& p) { return wsp<float>(p, WS_ROPE) + (size_t)MT * 16; }
DI const float* ropeCN(const Params& p) { return wsp<float>(p, WS_ROPE) + (size_t)MT * 32; }
DI const float* ropeSN(const Params& p) { return wsp<float>(p, WS_ROPE) + (size_t)MT * 40; }

DI void stage_normmod(const float* X, const float* gain, const float* mod, int sh_idx, int sc_idx, bf16_t* Hout, int gw, int ngw, int lane) {
    f32x4 v[4], nx[4];
    if (gw < MT) { const f32x4* xr = (const f32x4*)(X + (size_t)gw * DM) + lane;
#pragma unroll
        for (int j = 0; j < 4; ++j) nx[j] = xr[64 * j]; }
    for (int m = gw; m < MT; m += ngw) {
        const int b = m / SEQ;
#pragma unroll
        for (int j = 0; j < 4; ++j) v[j] = nx[j];
        if (m + ngw < MT) { const f32x4* xr = (const f32x4*)(X + (size_t)(m + ngw) * DM) + lane;
#pragma unroll
            for (int j = 0; j < 4; ++j) nx[j] = xr[64 * j]; }
        float s = 0.f;
#pragma unroll
        for (int j = 0; j < 4; ++j) s += (v[j].x * v[j].x + v[j].y * v[j].y) + (v[j].z * v[j].z + v[j].w * v[j].w);
        const float rstd = rsqrtf(wave_sum(s) * (1.f / DM) + EPS);
        const f32x4* g4 = (const f32x4*)gain + lane; const f32x4* sc4 = (const f32x4*)(mod + b * 6144 + sc_idx * 1024) + lane; const f32x4* sh4 = (const f32x4*)(mod + b * 6144 + sh_idx * 1024) + lane;
        u32x2* o8 = (u32x2*)(Hout + (size_t)m * DM) + lane;
#pragma unroll
        for (int j = 0; j < 4; ++j) { const f32x4 g = g4[64 * j], sc = sc4[64 * j], sh = sh4[64 * j];
            const f32x4 y = v[j] * rstd * g * (1.0f + sc) + sh; u32x2 w; w.x = pk2(y.x, y.y); w.y = pk2(y.z, y.w); o8[64 * j] = w; }
    }
}

DI void stage_shw(const Params& p, int ub, int nbk, float* lds, int wid0) {
    const int tid = opaque_tid(wid0), wave = tid >> 6, lane = tid & 63, nwv = blockDim.x >> 6;
    if (ub >= 88) return;
    float* sl = lds; float* red = lds + 8192;
    for (int i = tid; i < 8192; i += blockDim.x) sl[i] = wsp<float>(p, WS_MOD)[(i >> 10) * 6144 + 3 * 1024 + (i & 1023)];
    __syncthreads();
    for (int u = ub; u < 88; u += nbk) {
        const int mat = u / 44, col = 64 * (u % 44) + lane; const float* W = (mat ? p.in[I_WU] : p.in[I_WG]) + col; const int kn = 1024 / nwv;
        float acc[8];
#pragma unroll
        for (int b = 0; b < 8; ++b) acc[b] = 0.f;
        for (int k = wave * kn; k < (wave + 1) * kn; k += 8) { float w[8];
#pragma unroll
            for (int e = 0; e < 8; ++e) w[e] = W[(size_t)(k + e) * DFF];
#pragma unroll
            for (int e = 0; e < 8; ++e)
#pragma unroll
                for (int b = 0; b < 8; ++b) acc[b] += sl[b * 1024 + k + e] * w[e]; }
        __syncthreads();
#pragma unroll
        for (int b = 0; b < 8; ++b) red[(wave * 8 + b) * 64 + lane] = acc[b];
        __syncthreads();
        if (wave == 0) { const int s = col >> 5, cr = col & 31, phys = 256 * (s >> 2) + 128 * mat + 32 * (s & 3) + cr;
#pragma unroll
            for (int b = 0; b < 8; ++b) { float sum = 0.f;
                for (int w = 0; w < nwv; ++w) sum += red[(w * 8 + b) * 64 + lane];
                wsp<float>(p, WS_SHW)[b * 5632 + phys] = sum; } }
    }
}
struct ColPre { f32x4 c[8]; };
struct RowPre { f32x4 a[4]; };
DI void store8bf(bf16_t* dst, const float (&f)[8]) { st16(dst, pack8(f)); }
DI float ssq16(const float (&v)[2][8]) { float q = 0.f;
#pragma unroll
    for (int b = 0; b < 2; ++b)
#pragma unroll
        for (int j = 0; j < 8; ++j) q += v[b][j] * v[b][j];
    q += xorl<16>(q); return sum32(q); }
DI f32x4 ld4(const float* p) { return *(const f32x4*)p; }
DI f32x4 ld4u(const bf16_t* p) { return __builtin_bit_cast(f32x4, *(const u32x4*)p); }
DI void un8(const f32x4 raw, float (&f)[8]) { unpack8(__builtin_bit_cast(u32x4, raw), f); }

struct EpiZ {
    static constexpr bool HAS_MID = false; static constexpr int NTYPES = 7;
    Params p;
    DI void midpre(RowPre&, int, int, int, int) const {}
    DI void mid(const RowPre&, int, int, int, int, float (&)[2][8]) const {}
    DI int type(int pn, int wc) const { const int s = 4 * pn + wc;
        if (s < 16) return 0; if (s == 16) return 1; if (s < 25) return 2; if (s < 37) { const int t = (s - 25) >> 1; return (t == 2 || t == 4) ? 3 : 4; } if (s < 40) return 5; return 6; }
    template <int T> DI void ubegin(ColPre& U, int, int pn, int wc, int fq) const {
        const int s = 4 * pn + wc; (void)s;
        if constexpr (T == 1) { U.c[0] = ld4(p.in[I_MKG] + 64 + 8 * fq); U.c[1] = ld4(p.in[I_MKG] + 68 + 8 * fq); }
        if constexpr (T == 2 || T == 3) { const float* gain = (T == 2) ? p.in[I_NQG] : ((((s - 25) >> 1) == 2) ? p.in[I_NKSG] : p.in[I_NKWG]);
            U.c[0] = ld4(gain + 8 * fq); U.c[1] = ld4(gain + 8 * fq + 4); U.c[2] = ld4(gain + 32 + 8 * fq); U.c[3] = ld4(gain + 36 + 8 * fq); }
    }
    template <int T> DI void pre(RowPre& R, int row, int, int, int fq) const {
        if constexpr (T == 1) { const int i0 = 8 * (fq & 1); const float* cs = ropeCM(p) + (size_t)row * 16 + i0; const float* sn = ropeSM(p) + (size_t)row * 16 + i0;
            R.a[0] = ld4(cs); R.a[1] = ld4(cs + 4); R.a[2] = ld4(sn); R.a[3] = ld4(sn + 4); }
        if constexpr (T == 2 || T == 3) { const float* cs = ropeCN(p) + (size_t)row * 8; const float* sn = ropeSN(p) + (size_t)row * 8;
            R.a[0] = ld4(cs); R.a[1] = ld4(cs + 4); R.a[2] = ld4(sn); R.a[3] = ld4(sn + 4); }
    }
    DI void normrope(const ColPre& U, const RowPre& R, int fq, float (&v)[2][8], float post, bf16_t* dst) const {
        const float rstd = rsqrtf(ssq16(v) * (1.f / 64.f) + EPS);
#pragma unroll
        for (int b = 0; b < 2; ++b)
#pragma unroll
            for (int j = 0; j < 8; ++j) v[b][j] *= rstd * U.c[2 * b + (j >> 2)][j & 3];
#pragma unroll
        for (int j = 0; j < 8; ++j) { const float own = v[0][j], oth = xorl<16>(own); const float c = R.a[j >> 2][j & 3], s = R.a[2 + (j >> 2)][j & 3];
            if (fq == 0) v[0][j] = own * c - oth * s; else if (fq == 1) v[0][j] = own * c + oth * s; }
#pragma unroll
        for (int b = 0; b < 2; ++b) {
#pragma unroll
            for (int j = 0; j < 8; ++j) v[b][j] *= post;
            store8bf(dst + 32 * b + 8 * fq, v[b]); }
    }
    template <int T> DI void apply(const ColPre& U, const RowPre& R, int row, int pn, int wc, int fq, float (&v)[2][8]) const {
        const int s = 4 * pn + wc; (void)s;
        if constexpr (T == 0) {
            bf16_t* d = wsp<bf16_t>(p, WS_R1) + (size_t)row * 1024 + 64 * s + 8 * fq;
            const float q = ssq16(v); store8bf(d, v[0]); store8bf(d + 32, v[1]);
            if (fq == 0) wsp<float>(p, WS_SSQA)[(size_t)row * 16 + s] = q;
        } else if constexpr (T == 1) {
            float q = 0.f;
#pragma unroll
            for (int j = 0; j < 8; ++j) q += v[0][j] * v[0][j];
            q += xorl<16>(q); q = sum32(q);
            if (fq == 0) wsp<float>(p, WS_SSQPE)[row] = q;
            float o[8];
#pragma unroll
            for (int j = 0; j < 8; ++j) { const float own = v[0][j] * U.c[j >> 2][j & 3], oth = xor32(own, fq >> 1); const float c = R.a[j >> 2][j & 3], sn = R.a[2 + (j >> 2)][j & 3];
                o[j] = (fq < 2) ? own * c - oth * sn : own * c + oth * sn; }
            store8bf(wsp<bf16_t>(p, WS_KPE) + (size_t)row * 32 + 8 * fq, o);
#pragma unroll
            for (int j = 0; j < 8; ++j) o[j] = sigmoidf(v[1][j]);
            store8bf(wsp<bf16_t>(p, WS_GN) + (size_t)row * 32 + 8 * fq, o);
        } else if constexpr (T == 2) {
            normrope(U, R, fq, v, C2N, wsp<bf16_t>(p, WS_QN) + (size_t)row * 512 + 64 * (s - 17));
        } else if constexpr (T == 3 || T == 4) {
            const int t = (s - 25) >> 1, g = (s - 25) & 1;
            bf16_t* d = wsp<bf16_t>(p, WS_KC + (size_t)t * 4 * MiB) + (size_t)row * 128 + 64 * g;
            if constexpr (T == 3) normrope(U, R, fq, v, 1.0f, d);
            else { store8bf(d + 8 * fq, v[0]); store8bf(d + 32 + 8 * fq, v[1]); }
        } else if constexpr (T == 5) {
        } else {
            bf16_t* d = wsp<bf16_t>(p, WS_R2) + (size_t)row * 2048 + 64 * (s - 40) + 8 * fq;
#pragma unroll
            for (int b = 0; b < 2; ++b) { float o[8];
#pragma unroll
                for (int j = 0; j < 8; ++j) o[j] = sigmoidf(v[b][j]);
                store8bf(d + 32 * b, o); }
        }
    }
};
struct EpiQ {
    static constexpr bool HAS_MID = false; static constexpr int NTYPES = 1;
    Params p;
    DI int type(int, int) const { return 0; }
    DI void midpre(RowPre&, int, int, int, int) const {}
    DI void mid(const RowPre&, int, int, int, int, float (&)[2][8]) const {}
    template <int T> DI void ubegin(ColPre&, int, int, int, int) const {}
    template <int T> DI void pre(RowPre& R, int row, int, int, int) const { const float* sq = wsp<float>(p, WS_SSQA) + (size_t)row * 16; R.a[0] = ld4(sq); R.a[1] = ld4(sq + 4); R.a[2] = ld4(sq + 8); }
    template <int T> DI void apply(const ColPre&, const RowPre& R, int row, int pn, int wc, int fq, float (&v)[2][8]) const {
        const float s = ((R.a[0].x + R.a[0].y) + (R.a[0].z + R.a[0].w)) + ((R.a[1].x + R.a[1].y) + (R.a[1].z + R.a[1].w)) + ((R.a[2].x + R.a[2].y) + (R.a[2].z + R.a[2].w));
        const float rstd = rsqrtf(s * (1.f / 768.f) + EPS);
        bf16_t* d = wsp<bf16_t>(p, WS_R0) + (size_t)row * 768 + 256 * pn + 32 * wc + 8 * fq;
#pragma unroll
        for (int b = 0; b < 2; ++b) { float o[8];
#pragma unroll
            for (int j = 0; j < 8; ++j) o[j] = v[b][j] * rstd;
            store8bf(d + 128 * b, o); }
    }
};
struct EpiKV {
    static constexpr bool HAS_MID = false; static constexpr int NTYPES = 1;
    Params p;
    DI int type(int, int) const { return 0; }
    DI void midpre(RowPre&, int, int, int, int) const {}
    DI void mid(const RowPre&, int, int, int, int, float (&)[2][8]) const {}
    template <int T> DI void ubegin(ColPre&, int, int, int, int) const {}
    template <int T> DI void pre(RowPre& R, int row, int pn, int wc, int fq) const { R.a[0] = ld4(wsp<float>(p, WS_SSQA) + (size_t)row * 16 + 12);
        if (4 * pn + wc < 8) { R.a[1].x = wsp<float>(p, WS_SSQPE)[row]; R.a[2] = ld4u(wsp<bf16_t>(p, WS_KPE) + (size_t)row * 32 + 8 * fq); } }
    template <int T> DI void apply(const ColPre&, const RowPre& R, int row, int pn, int wc, int fq, float (&v)[2][8]) const {
        const int s = 4 * pn + wc;
        const float rstd = rsqrtf(((R.a[0].x + R.a[0].y) + (R.a[0].z + R.a[0].w)) * (1.f / 256.f) + EPS);
#pragma unroll
        for (int b = 0; b < 2; ++b)
#pragma unroll
            for (int j = 0; j < 8; ++j) v[b][j] *= rstd;
        if (s < 8) { const float rk = rsqrtf((ssq16(v) + R.a[1].x) * (1.f / 96.f) + EPS);
#pragma unroll
            for (int b = 0; b < 2; ++b)
#pragma unroll
                for (int j = 0; j < 8; ++j) v[b][j] *= rk;
            float pe[8]; un8(R.a[2], pe);
#pragma unroll
            for (int j = 0; j < 8; ++j) pe[j] *= rk;
            bf16_t* d = wsp<bf16_t>(p, WS_KN) + (size_t)row * 768 + 96 * s + 8 * fq; store8bf(d, v[0]); store8bf(d + 32, v[1]); store8bf(d + 64, pe); }
        else { bf16_t* d = wsp<bf16_t>(p, WS_VM) + (size_t)row * 512 + 64 * (s - 8) + 8 * fq; store8bf(d, v[0]); store8bf(d + 32, v[1]); }
    }
};
struct EpiMerge {
    static constexpr bool HAS_MID = true; static constexpr int NTYPES = 1;
    Params p;
    DI int type(int, int) const { return 0; }
    DI void midpre(RowPre& R, int row, int pn, int wc, int fq) const {
        const bf16_t* g = wsp<bf16_t>(p, WS_R2) + (size_t)row * 2048 + 256 * pn + 32 * wc + 8 * fq;
        R.a[0] = ld4u(g); R.a[1] = ld4u(g + 128); R.a[2] = ld4u(g + 1024); R.a[3] = ld4u(g + 1024 + 128); }
    DI void mid(const RowPre& R, int, int, int, int, float (&v)[2][8]) const {
#pragma unroll
        for (int b = 0; b < 2; ++b) { float s1[8], s2[8]; un8(R.a[b], s1); un8(R.a[2 + b], s2);
#pragma unroll
            for (int j = 0; j < 8; ++j) v[b][j] *= s1[j] * __builtin_amdgcn_rcpf(s2[j]); }
    }
    template <int T> DI void ubegin(ColPre&, int, int, int, int) const {}
    template <int T> DI void pre(RowPre& R, int row, int pn, int wc, int fq) const {
        const bf16_t* g = wsp<bf16_t>(p, WS_R2) + (size_t)row * 2048 + 1024 + 256 * pn + 32 * wc + 8 * fq; R.a[0] = ld4u(g); R.a[1] = ld4u(g + 128); }
    template <int T> DI void apply(const ColPre&, const RowPre& R, int row, int pn, int wc, int fq, float (&v)[2][8]) const {
        bf16_t* d = wsp<bf16_t>(p, WS_R0) + (size_t)row * 1024 + 256 * pn + 32 * wc + 8 * fq;
#pragma unroll
        for (int b = 0; b < 2; ++b) { float s2[8], o[8]; un8(R.a[b], s2);
#pragma unroll
            for (int j = 0; j < 8; ++j) o[j] = v[b][j] * s2[j];
            store8bf(d + 128 * b, o); }
    }
};
struct EpiOut {
    static constexpr bool HAS_MID = false; static constexpr int NTYPES = 1;
    Params p;
    DI int type(int, int) const { return 0; }
    DI void midpre(RowPre&, int, int, int, int) const {}
    DI void mid(const RowPre&, int, int, int, int, float (&)[2][8]) const {}
    template <int T> DI void ubegin(ColPre& U, int row0, int pn, int wc, int fq) const {
        const int b_ = row0 / SEQ, col = 256 * pn + 32 * wc + 8 * fq; const float* md = wsp<float>(p, WS_MOD) + b_ * 6144 + col; const float* g2 = p.in[I_N2G] + col;
#pragma unroll
        for (int i = 0; i < 4; ++i) { const int o = 128 * (i >> 1) + 4 * (i & 1); U.c[i] = ld4(md + 2 * 1024 + o); const f32x4 sc = ld4(md + 4 * 1024 + o), gg = ld4(g2 + o); U.c[4 + i] = gg * (1.0f + sc); }
    }
    template <int T> DI void pre(RowPre& R, int row, int pn, int wc, int fq) const { const float* x = p.in[I_X] + (size_t)row * DM + 256 * pn + 32 * wc + 8 * fq;
        R.a[0] = ld4(x); R.a[1] = ld4(x + 4); R.a[2] = ld4(x + 128); R.a[3] = ld4(x + 132); }
    template <int T> DI void apply(const ColPre& U, const RowPre& R, int row, int pn, int wc, int fq, float (&v)[2][8]) const {
        const int col = 256 * pn + 32 * wc + 8 * fq; float* d = wsp<float>(p, WS_R2) + (size_t)row * DM + col; bf16_t* a2 = wsp<bf16_t>(p, WS_R1) + (size_t)row * DM + col;
        float q = 0.f;
#pragma unroll
        for (int b = 0; b < 2; ++b) { float o8[8];
#pragma unroll
            for (int h = 0; h < 2; ++h) { const f32x4 g = U.c[2 * b + h], xv = R.a[2 * b + h], gs = U.c[4 + 2 * b + h];
                f32x4 o; o.x = xv.x + g.x * v[b][4 * h]; o.y = xv.y + g.y * v[b][4 * h + 1]; o.z = xv.z + g.z * v[b][4 * h + 2]; o.w = xv.w + g.w * v[b][4 * h + 3]; st16f(d + 128 * b + 4 * h, o);
                q += (o.x * o.x + o.y * o.y) + (o.z * o.z + o.w * o.w);
                o8[4 * h] = o.x * gs.x; o8[4 * h + 1] = o.y * gs.y; o8[4 * h + 2] = o.z * gs.z; o8[4 * h + 3] = o.w * gs.w; }
            store8bf(a2 + 128 * b, o8); }
        q += xorl<16>(q); q = sum32(q);
        if (fq == 0) wsp<float>(p, WS_SSQA)[(size_t)row * 16 + 4 * pn + wc] = q;
    }
};
struct EpiGU {
    static constexpr bool HAS_MID = false; static constexpr int NTYPES = 1;
    Params p;
    DI int type(int, int) const { return 0; }
    DI void midpre(RowPre&, int, int, int, int) const {}
    DI void mid(const RowPre&, int, int, int, int, float (&)[2][8]) const {}
    template <int T> DI void ubegin(ColPre& U, int row0, int pn, int wc, int fq) const { const float* sh = wsp<float>(p, WS_SHW) + (row0 / SEQ) * 5632 + 256 * pn + 32 * wc + 8 * fq;
        U.c[0] = ld4(sh); U.c[1] = ld4(sh + 4); U.c[2] = ld4(sh + 128); U.c[3] = ld4(sh + 132); }
    template <int T> DI void pre(RowPre& R, int row, int, int, int) const { const float* sq = wsp<float>(p, WS_SSQA) + (size_t)row * 16; R.a[0] = ld4(sq); R.a[1] = ld4(sq + 4); R.a[2] = ld4(sq + 8); R.a[3] = ld4(sq + 12); }
    template <int T> DI void apply(const ColPre& U, const RowPre& R, int row, int pn, int wc, int fq, float (&v)[2][8]) const {
        const int s = 4 * pn + wc; float o[8];
        const float tot = (((R.a[0].x + R.a[0].y) + (R.a[0].z + R.a[0].w)) + ((R.a[1].x + R.a[1].y) + (R.a[1].z + R.a[1].w))) + (((R.a[2].x + R.a[2].y) + (R.a[2].z + R.a[2].w)) + ((R.a[3].x + R.a[3].y) + (R.a[3].z + R.a[3].w)));
        const float rstd = rsqrtf(tot * (1.f / DM) + EPS);
#pragma unroll
        for (int j = 0; j < 8; ++j) o[j] = siluf(rstd * v[0][j] + U.c[j >> 2][j & 3]) * (rstd * v[1][j] + U.c[2 + (j >> 2)][j & 3]);
        store8bf(wsp<bf16_t>(p, WS_HID) + (size_t)row * DFF + 32 * s + 8 * fq, o);
    }
};
struct EpiDown {
    static constexpr bool HAS_MID = false; static constexpr int NTYPES = 1;
    Params p;
    DI int type(int, int) const { return 0; }
    DI void midpre(RowPre&, int, int, int, int) const {}
    DI void mid(const RowPre&, int, int, int, int, float (&)[2][8]) const {}
    template <int T> DI void ubegin(ColPre& U, int row0, int pn, int wc, int fq) const { const float* gt = wsp<float>(p, WS_MOD) + (row0 / SEQ) * 6144 + 5 * 1024 + 256 * pn + 32 * wc + 8 * fq;
        U.c[0] = ld4(gt); U.c[1] = ld4(gt + 4); U.c[2] = ld4(gt + 128); U.c[3] = ld4(gt + 132); }
    template <int T> DI void pre(RowPre& R, int row, int pn, int wc, int fq) const { const float* x = wsp<float>(p, WS_R2) + (size_t)row * DM + 256 * pn + 32 * wc + 8 * fq;
        R.a[0] = ld4(x); R.a[1] = ld4(x + 4); R.a[2] = ld4(x + 128); R.a[3] = ld4(x + 132); }
    template <int T> DI void apply(const ColPre& U, const RowPre& R, int row, int pn, int wc, int fq, float (&v)[2][8]) const {
        float* d = p.out + (size_t)row * DM + 256 * pn + 32 * wc + 8 * fq;
#pragma unroll
        for (int b = 0; b < 2; ++b)
#pragma unroll
            for (int h = 0; h < 2; ++h) { const f32x4 g = U.c[2 * b + h], xv = R.a[2 * b + h];
                f32x4 o; o.x = xv.x + g.x * v[b][4 * h]; o.y = xv.y + g.y * v[b][4 * h + 1]; o.z = xv.z + g.z * v[b][4 * h + 2]; o.w = xv.w + g.w * v[b][4 * h + 3]; *(f32x4*)(d + 128 * b + 4 * h) = o; }
    }
};
namespace pg8 {
#define PG8_LAS __attribute__((address_space(3)))
typedef short bf16x8 __attribute__((ext_vector_type(8)));
constexpr int BM = 256, BK = 64, HALF = 128, HTB = HALF * BK * 2  , STAGE_BYTES = 8 * HTB, NXCD = 8, WGM = 8;

__host__ __device__ __forceinline__ int lds_byte(int r, int c) { const int st = (r >> 4) * 2 + (c >> 5), rr = r & 15, cc = c & 31, ob = rr * 64 + cc * 2; return st * 1024 + (ob ^ (((ob >> 9) & 1) << 5)); }
__host__ __device__ __forceinline__ void stage_rc(int b, int& R, int& C) { const int st = b / 1024, sb = b % 1024, swz = sb ^ (((sb >> 9) & 1) << 5); R = (st >> 1) * 16 + swz / 64; C = (st & 1) * 32 + (swz % 64) / 2; }
__host__ __device__ __forceinline__ int perm32(int rho) { const int n = rho >> 4, i = rho & 15; return 8 * (i >> 2) + 4 * n + (i & 3); }

struct Unit { int pm, pn; };
struct Gemm { const bf16_t* A; const bf16_t* Bt; int M, N, K, lda, ldb, kstepA; };

struct StaticOrder {
    int nM, nN, nwg, G, c;
    __host__ __device__ void init(int M, int N, int G_, int c_) { nM = M / BM; nN = N / BM; nwg = nM * nN; G = G_; c = c_; }
    __host__ __device__ bool next(int i, Unit& u) const {
        const long L = (long)i * G + c; if (L >= nwg) return false;
        int wgid = (int)L; { const int q = nwg / NXCD, r = nwg % NXCD, xcd = wgid % NXCD, off = wgid / NXCD; wgid = (xcd < r ? xcd * (q + 1) : r * (q + 1) + (xcd - r) * q) + off; }
        const int nig = WGM * nN, gid = wgid / nig, fm = gid * WGM, gsz = (nM - fm) < WGM ? (nM - fm) : WGM;
        u.pm = fm + ((wgid % nig) % gsz); u.pn = (wgid % nig) / gsz; return true;
    }
    __device__ __forceinline__ void a_ready(const Unit&) const {}
    __device__ __forceinline__ void done(const Unit&) const {}
};

template <class Epi, class Sched, bool ALIGN_EPI = false, bool SP2 = false>
__device__ __forceinline__ void gemm_phase(PG8_LAS unsigned char* lds, const Gemm g, const Sched& S, const Epi& E, int wid0) {
    const int tid = opaque_tid(wid0), wid = __builtin_amdgcn_readfirstlane(tid >> 6), lane = tid & 63, wr = wid >> 2, wc = wid & 3, fr = lane & 15, fq = lane >> 4;
    const int K = g.K; int nt = K / BK; asm volatile("" : "+s"(nt));
    unsigned voffA[2], voffB[2];
#pragma unroll
    for (int i = 0; i < 2; ++i) { int R, C; stage_rc(tid * 16 + i * 8192, R, C); const int Rb = Epi::PERM ? ((R & ~31) + perm32(R & 31)) : R;
        voffA[i] = (unsigned)(R * g.lda + C) * 2u; voffB[i] = (unsigned)(Rb * g.ldb + C) * 2u; }
    const size_t kstep = (size_t)(BK * 2), kstepA = (size_t)g.kstepA;
    const size_t hstepB = (size_t)HALF * g.ldb * 2, hstepA = (size_t)HALF * g.lda * 2;
    const size_t tstepB = 2 * hstepB, tstepA = 2 * hstepA;
    const unsigned ldsw = (unsigned)wid * 1024u;
    const int aoff = lds_byte(wr * 64 + fr, fq * 8), boff = lds_byte(wc * 32 + fr, fq * 8);
#define PG8_SA(b, h) (((b) * 2 + (h)) * HTB)
#define PG8_SB(b, h) ((4 + (b) * 2 + (h)) * HTB)
#define PG8_STAGE(bufoff, gbase, voff) do { _Pragma("unroll") for (int _i = 0; _i < 2; ++_i) \
        __builtin_amdgcn_global_load_lds((const unsigned*)((const char*)(gbase) + (voff)[_i]), (PG8_LAS unsigned*)(lds + (bufoff) + ldsw + _i * 8192), 16, 0, 0); } while (0)
#define PG8_LDA(dst, b, h) do { _Pragma("unroll") for (int m = 0; m < 4; ++m) _Pragma("unroll") for (int k = 0; k < 2; ++k) dst[m][k] = *(const PG8_LAS bf16x8*)(lds + PG8_SA(b, h) + aoff + m * 2048 + k * 1024); } while (0)
#define PG8_LDB(dst, b, h) do { _Pragma("unroll") for (int n = 0; n < 2; ++n) _Pragma("unroll") for (int k = 0; k < 2; ++k) dst[n][k] = *(const PG8_LAS bf16x8*)(lds + PG8_SB(b, h) + boff + n * 2048 + k * 1024); } while (0)
#define PG8_MMA(ai, bj, At, Bt) do { __builtin_amdgcn_s_setprio(1); _Pragma("unroll") for (int m = 0; m < 4; ++m) _Pragma("unroll") for (int n = 0; n < 2; ++n) _Pragma("unroll") for (int k = 0; k < 2; ++k) \
        acc[ai][bj][m][n] = __builtin_amdgcn_mfma_f32_16x16x32_bf16(Bt[n][k], At[m][k], acc[ai][bj][m][n], 0, 0, 0); __builtin_amdgcn_s_setprio(0); } while (0)
#define PG8_WAIT_V(n) asm volatile("s_waitcnt vmcnt(" #n ")" ::: "memory")
#define PG8_WAIT_L(n) asm volatile("s_waitcnt lgkmcnt(" #n ")" ::: "memory")
#define PG8_BAR __builtin_amdgcn_s_barrier()
#define PG8_SCHED __builtin_amdgcn_sched_barrier(0)
    Unit cur, nxt; int ui = 0;
    if (!S.next(0, cur)) return;
    f32x4 acc[2][2][4][2];
#pragma unroll
    for (int a = 0; a < 2; ++a)
#pragma unroll
        for (int b = 0; b < 2; ++b)
#pragma unroll
            for (int m = 0; m < 4; ++m)
#pragma unroll
                for (int n = 0; n < 2; ++n) acc[a][b][m][n] = (f32x4){0.f, 0.f, 0.f, 0.f};
    bf16x8 At[4][2], B0[2][2], B1[2][2];
    const char* cA = (const char*)g.A + (size_t)cur.pm * tstepA; const char* cB = (const char*)g.Bt + (size_t)cur.pn * tstepB;
    S.a_ready(cur);
    if constexpr (SP2) {
        PG8_STAGE(PG8_SB(0, 0), cB, voffB); PG8_STAGE(PG8_SB(0, 1), cB + hstepB, voffB); PG8_STAGE(PG8_SA(0, 0), cA, voffA); PG8_STAGE(PG8_SA(0, 1), cA + hstepA, voffA);
        if (wr == 1) PG8_BAR;
        PG8_WAIT_V(2); PG8_BAR;
        PG8_STAGE(PG8_SB(1, 0), cB + kstep, voffB); PG8_STAGE(PG8_SA(1, 0), cA + kstepA, voffA); PG8_STAGE(PG8_SB(1, 1), cB + hstepB + kstep, voffB);
        PG8_WAIT_V(6); PG8_BAR;
    } else {
        PG8_STAGE(PG8_SB(0, 0), cB, voffB); PG8_STAGE(PG8_SA(0, 0), cA, voffA); PG8_STAGE(PG8_SB(0, 1), cB + hstepB, voffB); PG8_STAGE(PG8_SA(0, 1), cA + hstepA, voffA);
        if (wr == 1) PG8_BAR;
        PG8_WAIT_V(4); PG8_BAR;
        PG8_STAGE(PG8_SB(1, 0), cB + kstep, voffB); PG8_STAGE(PG8_SA(1, 0), cA + kstepA, voffA); PG8_STAGE(PG8_SB(1, 1), cB + hstepB + kstep, voffB);
        PG8_WAIT_V(6); PG8_BAR;
    }
    for (;;) {
        const bool has_next = S.next(ui + 1, nxt);
        const char* nA = has_next ? (const char*)g.A + (size_t)nxt.pm * tstepA : cA; const char* nB = has_next ? (const char*)g.Bt + (size_t)nxt.pn * tstepB : cB;
        for (int hh_ = 0; hh_ < (Epi::HAS_MID ? 2 : 1); ++hh_) {
        if constexpr (Epi::HAS_MID) { if (hh_ == 1) E.mid(acc, cur, wr, wc, fr, fq); }
        const int t0_ = Epi::HAS_MID ? hh_ * (nt >> 1) : 0, t1_ = Epi::HAS_MID ? (hh_ + 1) * (nt >> 1) : nt;
        for (int t = t0_; t < t1_; t += 2) {
            const bool last = (t == nt - 2);
            const char* a1 = cA + (size_t)(t + 1) * kstepA;
            const char* a2 = last ? nA : cA + (size_t)(t + 2) * kstepA; const char* b2 = last ? nB : cB + (size_t)(t + 2) * kstep;
            const char* a3 = a2 + kstepA; const char* b3 = b2 + kstep;
            if (last && has_next) S.a_ready(nxt);
            if constexpr (SP2) {
            PG8_LDB(B0, 0, 0); PG8_LDB(B1, 0, 1); PG8_SCHED; PG8_LDA(At, 0, 0); PG8_STAGE(PG8_SA(1, 1), a1 + hstepA, voffA);
            PG8_WAIT_V(8); PG8_WAIT_L(0); PG8_BAR; PG8_MMA(0, 0, At, B0); PG8_MMA(0, 1, At, B1); PG8_BAR; PG8_SCHED;
            PG8_LDA(At, 0, 1); PG8_STAGE(PG8_SB(0, 0), b2, voffB); PG8_STAGE(PG8_SB(0, 1), b2 + hstepB, voffB); PG8_STAGE(PG8_SA(0, 0), a2, voffA);
            PG8_WAIT_V(8); PG8_WAIT_L(0); PG8_BAR; PG8_MMA(1, 0, At, B0); PG8_MMA(1, 1, At, B1); PG8_BAR; PG8_SCHED;
            PG8_LDB(B0, 1, 0); PG8_LDB(B1, 1, 1); PG8_SCHED; PG8_LDA(At, 1, 0); PG8_STAGE(PG8_SA(0, 1), a2 + hstepA, voffA);
            PG8_WAIT_V(8); PG8_WAIT_L(0); PG8_BAR; PG8_MMA(0, 0, At, B0); PG8_MMA(0, 1, At, B1); PG8_BAR; PG8_SCHED;
            PG8_LDA(At, 1, 1); PG8_STAGE(PG8_SB(1, 0), b3, voffB); PG8_STAGE(PG8_SB(1, 1), b3 + hstepB, voffB); PG8_STAGE(PG8_SA(1, 0), a3, voffA);
            PG8_WAIT_V(8); PG8_WAIT_L(0); PG8_BAR; PG8_MMA(1, 0, At, B0); PG8_MMA(1, 1, At, B1); PG8_BAR; PG8_SCHED;
            } else {
            PG8_LDB(B0, 0, 0); PG8_SCHED; PG8_LDA(At, 0, 0); PG8_STAGE(PG8_SA(1, 1), a1 + hstepA, voffA);
            PG8_WAIT_L(8); PG8_BAR; PG8_WAIT_L(0); PG8_MMA(0, 0, At, B0); PG8_BAR; PG8_SCHED;
            PG8_LDB(B1, 0, 1); PG8_STAGE(PG8_SB(0, 0), b2, voffB);
            PG8_BAR; PG8_WAIT_L(0); PG8_MMA(0, 1, At, B1); PG8_BAR;
            PG8_LDA(At, 0, 1); PG8_STAGE(PG8_SA(0, 0), a2, voffA);
            PG8_BAR; PG8_WAIT_L(0); PG8_MMA(1, 0, At, B0); PG8_BAR; PG8_SCHED;
            PG8_STAGE(PG8_SB(0, 1), b2 + hstepB, voffB);
            PG8_WAIT_V(6); PG8_BAR; PG8_MMA(1, 1, At, B1); PG8_BAR;
            PG8_LDB(B0, 1, 0); PG8_SCHED; PG8_LDA(At, 1, 0); PG8_STAGE(PG8_SA(0, 1), a2 + hstepA, voffA);
            PG8_WAIT_L(8); PG8_BAR; PG8_WAIT_L(0); PG8_MMA(0, 0, At, B0); PG8_BAR; PG8_SCHED;
            PG8_LDB(B1, 1, 1); PG8_STAGE(PG8_SB(1, 0), b3, voffB);
            PG8_BAR; PG8_WAIT_L(0); PG8_MMA(0, 1, At, B1); PG8_BAR;
            PG8_LDA(At, 1, 1); PG8_STAGE(PG8_SA(1, 0), a3, voffA);
            PG8_BAR; PG8_WAIT_L(0); PG8_MMA(1, 0, At, B0); PG8_BAR; PG8_SCHED;
            PG8_STAGE(PG8_SB(1, 1), b3 + hstepB, voffB);
            PG8_WAIT_V(6); PG8_BAR; PG8_MMA(1, 1, At, B1); PG8_BAR;
            }
        }
        }
        if constexpr (ALIGN_EPI) { if (wr == 0) PG8_BAR; }
        if constexpr (!Epi::AFTER_DRAIN) { E(acc, cur, wr, wc, fr, fq); S.done(cur); }
        if (!has_next) break;
#pragma unroll
        for (int a = 0; a < 2; ++a)
#pragma unroll
            for (int b = 0; b < 2; ++b)
#pragma unroll
                for (int m = 0; m < 4; ++m)
#pragma unroll
                    for (int n = 0; n < 2; ++n) acc[a][b][m][n] = (f32x4){0.f, 0.f, 0.f, 0.f};
        cur = nxt; cA = nA; cB = nB; ++ui;
        if constexpr (ALIGN_EPI) { if (wr == 1) PG8_BAR; }
    }
    PG8_WAIT_V(0);
    if constexpr (!ALIGN_EPI) { if (wr == 0) PG8_BAR; }
    PG8_BAR;
    if constexpr (Epi::AFTER_DRAIN) { E.fused(acc, cur, wr, wc, fr, fq, lds, wid, lane); S.done(cur); }
#undef PG8_SA
#undef PG8_SB
#undef PG8_STAGE
#undef PG8_LDA
#undef PG8_LDB
#undef PG8_MMA
#undef PG8_WAIT_V
#undef PG8_WAIT_L
#undef PG8_BAR
#undef PG8_SCHED
}
}

template <class SE> struct EpiAdapt {
    static constexpr bool PERM = true, AFTER_DRAIN = false, HAS_MID = SE::HAS_MID;
    SE se;
    template <int T> DI void run(f32x4 (&acc)[2][2][4][2], const pg8::Unit& u, int wr, int wc, int fr, int fq) const {
        int frr = fr; asm volatile("" : "+v"(frr));
        const int rbase = u.pm * 256 + wr * 64;
        ColPre U; se.template ubegin<T>(U, rbase, u.pn, wc, fq);
        RowPre R[2]; se.template pre<T>(R[0], rbase + frr, u.pn, wc, fq);
#pragma unroll
        for (int it = 0; it < 8; ++it) {
            const int ai = it >> 2, m = it & 3; const int row = rbase + ai * 128 + m * 16 + frr;
            if (it < 7) se.template pre<T>(R[(it + 1) & 1], rbase + ((it + 1) >> 2) * 128 + ((it + 1) & 3) * 16 + frr, u.pn, wc, fq);
            float v[2][8];
#pragma unroll
            for (int bj = 0; bj < 2; ++bj)
#pragma unroll
                for (int n = 0; n < 2; ++n) { v[bj][4 * n] = acc[ai][bj][m][n][0]; v[bj][4 * n + 1] = acc[ai][bj][m][n][1]; v[bj][4 * n + 2] = acc[ai][bj][m][n][2]; v[bj][4 * n + 3] = acc[ai][bj][m][n][3]; }
            se.template apply<T>(U, R[it & 1], row, u.pn, wc, fq, v);
        }
    }
    template <int T> DI void disp(int ty, f32x4 (&acc)[2][2][4][2], const pg8::Unit& u, int wr, int wc, int fr, int fq) const {
        if constexpr (T < SE::NTYPES) { if (ty == T) run<T>(acc, u, wr, wc, fr, fq); else disp<T + 1>(ty, acc, u, wr, wc, fr, fq); }
    }
    DI void operator()(f32x4 (&acc)[2][2][4][2], const pg8::Unit& u, int wr, int wc, int fr, int fq) const { disp<0>(se.type(u.pn, wc), acc, u, wr, wc, fr, fq); }
    DI void mid(f32x4 (&acc)[2][2][4][2], const pg8::Unit& u, int wr, int wc, int fr, int fq) const {
        int frr = fr; asm volatile("" : "+v"(frr));
        const int rbase = u.pm * 256 + wr * 64;
        RowPre R[2]; se.midpre(R[0], rbase + frr, u.pn, wc, fq);
#pragma unroll
        for (int it = 0; it < 8; ++it) {
            const int ai = it >> 2, m = it & 3; const int row = rbase + ai * 128 + m * 16 + frr;
            if (it < 7) se.midpre(R[(it + 1) & 1], rbase + ((it + 1) >> 2) * 128 + ((it + 1) & 3) * 16 + frr, u.pn, wc, fq);
            float v[2][8];
#pragma unroll
            for (int bj = 0; bj < 2; ++bj)
#pragma unroll
                for (int n = 0; n < 2; ++n) { v[bj][4 * n] = acc[ai][bj][m][n][0]; v[bj][4 * n + 1] = acc[ai][bj][m][n][1]; v[bj][4 * n + 2] = acc[ai][bj][m][n][2]; v[bj][4 * n + 3] = acc[ai][bj][m][n][3]; }
            se.mid(R[it & 1], row, u.pn, wc, fq, v);
#pragma unroll
            for (int bj = 0; bj < 2; ++bj)
#pragma unroll
                for (int n = 0; n < 2; ++n) { acc[ai][bj][m][n][0] = v[bj][4 * n]; acc[ai][bj][m][n][1] = v[bj][4 * n + 1]; acc[ai][bj][m][n][2] = v[bj][4 * n + 2]; acc[ai][bj][m][n][3] = v[bj][4 * n + 3]; }
        }
    }
};
template <class SE, bool ALIGN = true> DI void gemm_fast(PG8_LAS unsigned char* lds, const bf16_t* A, int lda, const bf16_t* Bt, int M, int N, int K, const SE& se, int G, int c, int wid0) {
    pg8::Gemm g{A, Bt, M, N, K, lda, K, 128}; pg8::StaticOrder S; S.init(M, N, G, c);
    EpiAdapt<SE> E{se};
    pg8::gemm_phase<EpiAdapt<SE>, pg8::StaticOrder, ALIGN, true>(lds, g, S, E, wid0);
}
struct RangeOrder {
    int base, cnt, nN;
    DI bool next(int i, pg8::Unit& u) const { if (i >= cnt) return false; const int L = base + i; u.pm = L / nN; u.pn = L % nN; return true; }
    DI void a_ready(const pg8::Unit&) const {}
    DI void done(const pg8::Unit&) const {}
};
template <class SE> DI void gemm_fast_range(PG8_LAS unsigned char* lds, const bf16_t* A, int lda, const bf16_t* Bt, int M, int N, int K, const SE& se, int base, int cnt, int wid0) {
    pg8::Gemm g{A, Bt, M, N, K, lda, K, 128}; RangeOrder S{base, cnt, N / 256};
    EpiAdapt<SE> E{se};
    pg8::gemm_phase<EpiAdapt<SE>, RangeOrder, true, true>(lds, g, S, E, wid0);
}
struct OneUnit {
    int pm, pn;
    DI bool next(int i, pg8::Unit& u) const { if (i > 0) return false; u.pm = pm; u.pn = pn; return true; }
    DI void a_ready(const pg8::Unit&) const {}
    DI void done(const pg8::Unit&) const {}
};
struct EpiCmpH {
    static constexpr bool HAS_MID = false; static constexpr int NTYPES = 1;
    float* H;
    DI int type(int, int) const { return 0; }
    DI void midpre(RowPre&, int, int, int, int) const {}
    DI void mid(const RowPre&, int, int, int, int, float (&)[2][8]) const {}
    template <int T> DI void ubegin(ColPre&, int, int, int, int) const {}
    template <int T> DI void pre(RowPre&, int, int, int, int) const {}
    template <int T> DI void apply(const ColPre&, const RowPre&, int row, int pn, int wc, int fq, float (&v)[2][8]) const {
        float* d = H + (size_t)row * 256 + 32 * wc + 8 * fq;
#pragma unroll
        for (int b = 0; b < 2; ++b) { st16f(d + 128 * b, (f32x4){v[b][0], v[b][1], v[b][2], v[b][3]}); st16f(d + 128 * b + 4, (f32x4){v[b][4], v[b][5], v[b][6], v[b][7]}); }
    }
};
DI void cmp_hidden_fast(const Params& p, PG8_LAS unsigned char* lds, int cu, int wid0) {
    const int kv = cu >> 4, g = (cu >> 3) & 1, pm = (cu >> 1) & 3, sp = cu & 1;
    const bf16_t* A = wsp<bf16_t>(p, kv ? WS_VC : WS_KC) + g * 64 + (size_t)(16 * sp) * 128;
    const bf16_t* Bt = wsp<bf16_t>(p, WS_CW1) + (size_t)kv * 256 * 2048 + 1024 * sp;
    pg8::Gemm gm{A, Bt, 1024, 256, 1024, 2048, 2048, 256}; OneUnit S{pm, 0};
    EpiCmpH se{wsp<float>(p, WS_CMPH) + (size_t)((kv * 2 + g) * 2 + sp) * 1024 * 256};
    EpiAdapt<EpiCmpH> E{se};
    pg8::gemm_phase<EpiAdapt<EpiCmpH>, OneUnit, true, true>(lds, gm, S, E, wid0);
}
template <bool SPLIT> DI void cmp_out(const Params& p, int gw, int ngw, int lane) {
    const float* H = wsp<float>(p, WS_CMPH);
    for (int u = gw; u < 2 * 2 * 1024; u += ngw) {
        const int r = u & 1023, g = (u >> 10) & 1, kv = u >> 11; const int b = r >> 7, n = r & 127;
        bf16_t* dst = wsp<bf16_t>(p, kv ? WS_VCF : WS_KCF) + (size_t)r * 128 + g * 64 + lane;
        if (n == 127) { *dst = 0; continue; }
        const float* w2 = (kv ? p.in[I_CW2V] : p.in[I_CW2K]) + lane;
        float acc = 0.f;
        if constexpr (SPLIT) {
            const float* h = H + ((size_t)((kv * 2 + g) * 2) * 1024 + r) * 256; const float* cb = wsp<float>(p, WS_CB1) + kv * 256;
            float hv[4];
#pragma unroll
            for (int q = 0; q < 4; ++q) { const int j = 64 * q + lane; hv[q] = siluf((h[j] + h[(size_t)1024 * 256 + j]) + cb[j]); }
#pragma unroll
            for (int q = 0; q < 4; ++q)
#pragma unroll
                for (int jj = 0; jj < 64; ++jj) acc += __int_as_float(__builtin_amdgcn_readlane(__float_as_int(hv[q]), jj)) * w2[(64 * q + jj) * 64];
        } else {
            const float* h = H + (size_t)u * 256;
            for (int j = 0; j < 256; ++j) acc += h[j] * w2[j * 64];
        }
        if (kv == 0) {
            const float rstd = rsqrtf(wave_sum(acc * acc) * (1.f / 64.f) + EPS);
            float y = acc * rstd * p.in[I_NKCG][lane];
            const int prow = b * SEQ + 16 * n + 31; const float oth = xorl<8>(y);
            if (lane < 16) { const float c = ropeCN(p)[(size_t)prow * 8 + (lane & 7)], s = ropeSN(p)[(size_t)prow * 8 + (lane & 7)]; y = (lane < 8) ? y * c - oth * s : y * c + oth * s; }
            acc = y;
        }
        *dst = (bf16_t)f2bf(acc);
    }
}

DI unsigned select_blocks(const float (&imp)[32], int cur) {
    if (cur < 8) return (2u << cur) - 1u;
    unsigned mask = 1u | (1u << cur) | (1u << (cur - 1));
#pragma unroll 1
    for (int it = 0; it < 5; ++it) {
        float best = -1.0f; int bi = 1;
#pragma unroll
        for (int j = 1; j < 32; ++j) { const bool ok = (j <= cur - 2) && !((mask >> j) & 1u); if (ok && imp[j] > best) { best = imp[j]; bi = j; } }
        mask |= 1u << bi;
    }
    return mask;
}

namespace fa {
typedef short bf16x8 __attribute__((ext_vector_type(8)));
typedef short s16x4 __attribute__((ext_vector_type(4)));
typedef float f32x16 __attribute__((ext_vector_type(16)));
typedef LAS const char* lds_cptr;
typedef LAS char* lds_ptr;
constexpr int KBUF = 12288, VBUF = 8192;
constexpr int L_K = 0, L_V = 2 * KBUF, L_WS = 3 * 12288 + 2 * 8192, L_OST = L_WS + 8 * 256, L_END = L_OST + 8 * 8192;
static_assert(L_V + 2 * VBUF <= L_WS && L_END <= 131072, "attention LDS map");
#define FA_SBAR() __builtin_amdgcn_sched_barrier(0)
DI int crow(int r, int hi) { return (r & 3) + 8 * (r >> 2) + 4 * hi; }
typedef float f32x2_t __attribute__((ext_vector_type(2))); typedef __bf16 bf16x2_t __attribute__((ext_vector_type(2)));
DI unsigned cvtpk(float lo, float hi) { f32x2_t v = {lo, hi}; bf16x2_t b = __builtin_convertvector(v, bf16x2_t); return __builtin_bit_cast(unsigned, b); }

template <int DK> DI void qkt(f32x16& p0, f32x16& p1, lds_cptr kb, const bf16x8* qr) {
    f32x16 z;
#pragma unroll
    for (int i = 0; i < 16; ++i) z[i] = 0.f;
#pragma unroll
    for (int d0 = 0; d0 < DK / 16; ++d0) {
        const bf16x8 b0 = *(const LAS bf16x8*)(kb + d0 * 2048);
        const bf16x8 b1 = *(const LAS bf16x8*)(kb + d0 * 2048 + 512);
        if (d0 == 0) { p0 = __builtin_amdgcn_mfma_f32_32x32x16_bf16(b0, qr[0], z, 0, 0, 0); p1 = __builtin_amdgcn_mfma_f32_32x32x16_bf16(b1, qr[0], z, 0, 0, 0); }
        else { p0 = __builtin_amdgcn_mfma_f32_32x32x16_bf16(b0, qr[d0], p0, 0, 0, 0); p1 = __builtin_amdgcn_mfma_f32_32x32x16_bf16(b1, qr[d0], p1, 0, 0, 0); }
    }
}
typedef short v4i16_t __attribute__((ext_vector_type(4)));
DI s16x4 vtr(int addr) { return __builtin_bit_cast(s16x4, __builtin_amdgcn_ds_read_tr16_b64_v4i16((LAS v4i16_t*)(uintptr_t)(unsigned)addr)); }
DI bf16x8 vfrag(int addr) { const s16x4 lo = vtr(addr), hi = vtr(addr + 512); return (bf16x8){lo[0], lo[1], lo[2], lo[3], hi[0], hi[1], hi[2], hi[3]}; }
DI void pv(f32x16* o, int vb, bf16x8 pa0, bf16x8 pa1, bf16x8 pa2, bf16x8 pa3) {
#pragma unroll
    for (int d0 = 0; d0 < 2; ++d0) { s16x4 lo[4], hi[4];
#pragma unroll
        for (int ks = 0; ks < 4; ++ks) { lo[ks] = vtr(vb + d0 * 4096 + ks * 1024); hi[ks] = vtr(vb + d0 * 4096 + ks * 1024 + 512); }
#define FA_PK(k) (bf16x8){lo[k][0], lo[k][1], lo[k][2], lo[k][3], hi[k][0], hi[k][1], hi[k][2], hi[k][3]}
        o[d0] = __builtin_amdgcn_mfma_f32_32x32x16_bf16(pa0, FA_PK(0), o[d0], 0, 0, 0);
        o[d0] = __builtin_amdgcn_mfma_f32_32x32x16_bf16(pa1, FA_PK(1), o[d0], 0, 0, 0);
        o[d0] = __builtin_amdgcn_mfma_f32_32x32x16_bf16(pa2, FA_PK(2), o[d0], 0, 0, 0);
        o[d0] = __builtin_amdgcn_mfma_f32_32x32x16_bf16(pa3, FA_PK(3), o[d0], 0, 0, 0);
#undef FA_PK
    }
}
DI void pack_p(const f32x16& p0, const f32x16& p1, bf16x8& a0, bf16x8& a1, bf16x8& a2, bf16x8& a3) {
    u32x4 w0, w1, w2, w3;
    w0.x = cvtpk(p0[0], p0[1]); w0.y = cvtpk(p0[2], p0[3]); w0.z = cvtpk(p0[4], p0[5]); w0.w = cvtpk(p0[6], p0[7]);
    w1.x = cvtpk(p0[8], p0[9]); w1.y = cvtpk(p0[10], p0[11]); w1.z = cvtpk(p0[12], p0[13]); w1.w = cvtpk(p0[14], p0[15]);
    w2.x = cvtpk(p1[0], p1[1]); w2.y = cvtpk(p1[2], p1[3]); w2.z = cvtpk(p1[4], p1[5]); w2.w = cvtpk(p1[6], p1[7]);
    w3.x = cvtpk(p1[8], p1[9]); w3.y = cvtpk(p1[10], p1[11]); w3.z = cvtpk(p1[12], p1[13]); w3.w = cvtpk(p1[14], p1[15]);
    a0 = __builtin_bit_cast(bf16x8, w0); a1 = __builtin_bit_cast(bf16x8, w1); a2 = __builtin_bit_cast(bf16x8, w2); a3 = __builtin_bit_cast(bf16x8, w3);
}
DI void mask_range(f32x16& p0, f32x16& p1, int key0, int lo, int hi_, int hf) {
#pragma unroll
    for (int r = 0; r < 16; ++r) { const int k = key0 + crow(r, hf); if (k < lo || k > hi_) p0[r] = -INFINITY; if (k + 32 < lo || k + 32 > hi_) p1[r] = -INFINITY; }
}
DI float max3(float a, float b, float c) { return fmaxf(fmaxf(a, b), c); }
DI float rowmax32(const f32x16& p0, const f32x16& p1) {
    float a = max3(p0[0], p0[1], p0[2]), b = max3(p0[3], p0[4], p0[5]), c = max3(p0[6], p0[7], p0[8]), d = max3(p0[9], p0[10], p0[11]);
    a = max3(a, p0[12], p0[13]); b = max3(b, p0[14], p0[15]); c = max3(c, p1[0], p1[1]); d = max3(d, p1[2], p1[3]);
    a = max3(a, p1[4], p1[5]); b = max3(b, p1[6], p1[7]); c = max3(c, p1[8], p1[9]); d = max3(d, p1[10], p1[11]);
    a = max3(a, p1[12], p1[13]); b = max3(b, p1[14], p1[15]);
    return max32(fmaxf(fmaxf(a, b), fmaxf(c, d)));
}
struct State { float m, l; f32x16 o[2]; };
DI void st_init(State& s) { s.m = -INFINITY; s.l = 0.f;
#pragma unroll
    for (int i = 0; i < 16; ++i) { s.o[0][i] = 0.f; s.o[1][i] = 0.f; } }
DI void softmax_pv(State& st, f32x16& p0, f32x16& p1, int vb, LAS float* wsf, int r32, int hf) {
    const float rm = rowmax32(p0, p1);
    const float mn = fmaxf(st.m, rm), mu = (mn == -INFINITY) ? 0.f : mn;
    const float alpha = __builtin_amdgcn_exp2f(st.m - mu);
    st.m = mn;
    float ls0 = 0.f, ls1 = 0.f, ls2 = 0.f, ls3 = 0.f;
#pragma unroll
    for (int r = 0; r < 16; r += 2) { p0[r] = __builtin_amdgcn_exp2f(p0[r] - mu); p1[r] = __builtin_amdgcn_exp2f(p1[r] - mu); p0[r + 1] = __builtin_amdgcn_exp2f(p0[r + 1] - mu); p1[r + 1] = __builtin_amdgcn_exp2f(p1[r + 1] - mu);
        ls0 += p0[r]; ls1 += p1[r]; ls2 += p0[r + 1]; ls3 += p1[r + 1]; }
    st.l = st.l * alpha + ((ls0 + ls1) + (ls2 + ls3));
    if (__any(alpha != 1.0f)) {
        if (hf == 0) wsf[r32] = alpha;
        asm volatile("s_waitcnt lgkmcnt(0)" ::: "memory");
#pragma unroll
        for (int g = 0; g < 4; ++g) { const f32x4 a = *(const LAS f32x4*)(wsf + 8 * g + 4 * hf);
            st.o[0][4 * g] *= a.x; st.o[0][4 * g + 1] *= a.y; st.o[0][4 * g + 2] *= a.z; st.o[0][4 * g + 3] *= a.w;
            st.o[1][4 * g] *= a.x; st.o[1][4 * g + 1] *= a.y; st.o[1][4 * g + 2] *= a.z; st.o[1][4 * g + 3] *= a.w; }
    }
    bf16x8 a0, a1, a2, a3; pack_p(p0, p1, a0, a1, a2, a3);
    pv(st.o, vb, a0, a1, a2, a3);
}
DI void accum_scaled(f32x16* acc, const f32x16* o, float fac_row, LAS float* wsf, int r32, int hf) {
    if (hf == 0) wsf[32 + r32] = fac_row;
    asm volatile("s_waitcnt lgkmcnt(0)" ::: "memory");
#pragma unroll
    for (int g = 0; g < 4; ++g) { const f32x4 a = *(const LAS f32x4*)(wsf + 32 + 8 * g + 4 * hf);
        acc[0][4 * g] += o[0][4 * g] * a.x; acc[0][4 * g + 1] += o[0][4 * g + 1] * a.y; acc[0][4 * g + 2] += o[0][4 * g + 2] * a.z; acc[0][4 * g + 3] += o[0][4 * g + 3] * a.w;
        acc[1][4 * g] += o[1][4 * g] * a.x; acc[1][4 * g + 1] += o[1][4 * g + 1] * a.y; acc[1][4 * g + 2] += o[1][4 * g + 2] * a.z; acc[1][4 * g + 3] += o[1][4 * g + 3] * a.w; }
}
template <bool FIRST> DI void accum_lds(LAS float* accw, const f32x16* o, float fac_row, LAS float* wsf, int r32, int hf) {
    if (hf == 0) wsf[32 + r32] = fac_row;
    asm volatile("s_waitcnt lgkmcnt(0)" ::: "memory");
#pragma unroll
    for (int r = 0; r < 16; ++r) { const int orow = crow(r, hf); const float a = wsf[32 + orow];
        LAS float* d0 = accw + orow * 64 + r32; LAS float* d1 = d0 + 32;
        if (FIRST) { *d0 = o[0][r] * a; *d1 = o[1][r] * a; } else { *d0 += o[0][r] * a; *d1 += o[1][r] * a; } }
}
DI void stage_rows(const f32x16* acc, LAS bf16_t* stg, int r32, int hf) {
#pragma unroll
    for (int r = 0; r < 16; ++r) { const int orow = crow(r, hf);
        stg[orow * 64 + r32] = (bf16_t)f2bf(acc[0][r]); stg[orow * 64 + 32 + r32] = (bf16_t)f2bf(acc[1][r]); }
    asm volatile("s_waitcnt lgkmcnt(0)" ::: "memory");
}

struct TileSrc { const bf16_t* k; const bf16_t* k2; const bf16_t* v; long kstep, vstep; };
#ifndef FA_THRL
#define FA_THRL 8.0f
#endif
template <int DK, class MaskF>
DI void pipe_attn(LAS unsigned char* lds, const TileSrc src, int T, const bf16x8 (&qr)[DK / 16], const MaskF& maskf, f32x16 (&o)[2], float& l_out,
                  int wv, int lane, int r32, int hf, LAS float* wsf) {
    constexpr int KB = DK * 128;
    constexpr int PL_V = 3 * KB;
    const LAS unsigned char* kfrag0 = lds + L_K + hf * 1024 + r32 * 16;
    const int vfrag0 = (int)(uintptr_t)(lds + L_K + PL_V) + ((lane >> 4) & 1) * 32 + (lane & 3) * 8 + (4 * hf + ((lane & 15) >> 2)) * 64;
    LAS unsigned char* kst0 = lds + L_K + wv * 1024 + lane * 16; LAS unsigned char* vst0 = lds + L_K + PL_V + wv * 1024 + lane * 16;
    u32x4 kreg, kreg2, vreg;
    const bool k2on = (DK == 96) && (wv < 4);
#define PL_KLOAD(i) do { kreg = *(const u32x4*)(src.k + (long)(i) * src.kstep); if (k2on) kreg2 = *(const u32x4*)(src.k2 + (long)(i) * src.kstep); } while (0)
#define PL_KSTORE(buf) do { *(LAS u32x4*)(kst0 + (buf) * KB) = kreg; if (k2on) *(LAS u32x4*)(kst0 + (buf) * KB + 8192) = kreg2; } while (0)
#define PL_VLOAD(i) (vreg = *(const u32x4*)(src.v + (long)(i) * src.vstep))
    __syncthreads();
    { u32x4 ka_, kb_, kc_, ka2_, kb2_, kc2_; const int t1 = (T > 1) ? 1 : 0, t2 = (T > 2) ? 2 : 0;
      ka_ = *(const u32x4*)(src.k); kb_ = *(const u32x4*)(src.k + (long)t1 * src.kstep); kc_ = *(const u32x4*)(src.k + (long)t2 * src.kstep); PL_VLOAD(0);
      if (k2on) { ka2_ = *(const u32x4*)(src.k2); kb2_ = *(const u32x4*)(src.k2 + (long)t1 * src.kstep); kc2_ = *(const u32x4*)(src.k2 + (long)t2 * src.kstep); }
      *(LAS u32x4*)(kst0) = ka_; *(LAS u32x4*)(kst0 + KB) = kb_; *(LAS u32x4*)(kst0 + 2 * KB) = kc_; *(LAS u32x4*)(vst0) = vreg;
      if (k2on) { *(LAS u32x4*)(kst0 + 8192) = ka2_; *(LAS u32x4*)(kst0 + KB + 8192) = kb2_; *(LAS u32x4*)(kst0 + 2 * KB + 8192) = kc2_; } }
    if (T > 3) PL_KLOAD(3);
    if (T > 1) PL_VLOAD(1);
    __syncthreads();
    float mhat, l_reg = 0.f; f32x16 negm; bool resc = false;
    f32x16 pA0, pA1, pB0, pB1;
#pragma unroll
    for (int i = 0; i < 16; ++i) { o[0][i] = 0.f; o[1][i] = 0.f; }
    qkt<DK>(pA0, pA1, (lds_cptr)kfrag0, qr); maskf(pA0, pA1, 0);
    { const float rm = rowmax32(pA0, pA1); mhat = rm;
#pragma unroll
      for (int r = 0; r < 16; ++r) { pA0[r] = __builtin_amdgcn_exp2f(pA0[r] - rm); pA1[r] = __builtin_amdgcn_exp2f(pA1[r] - rm); negm[r] = -rm; }
      asm volatile("" : "+v"(negm)); }
    __syncthreads();
    u32x4 pw0, pw1, pw2, pw3;
    int kb_cur = 1, kb_st = 0, vb_prev = 0;
#define PL_PIN(x) asm volatile("" : "+v"(x))
#define PL_SB() __builtin_amdgcn_sched_barrier(0)
#define PL_KF(j) (*(const LAS bf16x8*)(kp_ + ((j) >> 1) * 2048 + ((j) & 1) * 512))
#define PL_VF(i) vfrag(vp_ + ((i) >> 2) * 4096 + ((i) & 3) * 1024)
#define PL_PAF(k) __builtin_bit_cast(bf16x8, pw##k)
#define PL_WORK(A0, A1, A2, A3, W0, W1, PW) do { sacc += A0; sacc += A1; sacc += A2; sacc += A3; PL_PIN(sacc); W0; W1; PL_PIN(PW); } while (0)
#define PL_GAPB(MF, X, B) do { MF; X[B] = __builtin_amdgcn_exp2f(X[B]); X[B + 1] = __builtin_amdgcn_exp2f(X[B + 1]); X[B + 2] = __builtin_amdgcn_exp2f(X[B + 2]); X[B + 3] = __builtin_amdgcn_exp2f(X[B + 3]); PL_PIN(X); PL_SB(); } while (0)
#define PL_MF(a, b, c) __builtin_amdgcn_mfma_f32_32x32x16_bf16(a, b, c, 0, 0, 0)
#define PL_STEP(C0, C1, P0, P1, t) do { const int t_ = (t); \
        if (t_ + 2 < T) PL_KSTORE(kb_st); \
        *(LAS u32x4*)(vst0 + (vb_prev ^ 1) * 8192) = vreg; \
        if (t_ + 3 < T) PL_KLOAD(t_ + 3); if (t_ + 1 < T) PL_VLOAD(t_ + 1); \
        PL_SB(); const LAS unsigned char* kp_ = kfrag0 + kb_cur * KB; const int vp_ = vfrag0 + vb_prev * 8192; \
        bf16x8 k0 = PL_KF(0), k1 = PL_KF(1), k2 = PL_KF(2); PL_SB(); float sacc = (P0[0] + P0[1]); \
        C0 = PL_MF(k0, qr[0], negm); k0 = PL_KF(3); PL_WORK(P0[2], P0[3], P0[4], P0[5],     pw0[0] = cvtpk(P0[0], P0[1]),   pw0[1] = cvtpk(P0[2], P0[3]),   pw0); PL_SB(); \
        C1 = PL_MF(k1, qr[0], negm); k1 = PL_KF(4); PL_WORK(P0[6], P0[7], P0[8], P0[9],     pw0[2] = cvtpk(P0[4], P0[5]),   pw0[3] = cvtpk(P0[6], P0[7]),   pw0); PL_SB(); \
        C0 = PL_MF(k2, qr[1], C0);   k2 = PL_KF(5); PL_WORK(P0[10], P0[11], P0[12], P0[13], pw1[0] = cvtpk(P0[8], P0[9]),   pw1[1] = cvtpk(P0[10], P0[11]), pw1); PL_SB(); \
        C1 = PL_MF(k0, qr[1], C1);   k0 = PL_KF(6); PL_WORK(P0[14], P0[15], P1[0], P1[1],   pw1[2] = cvtpk(P0[12], P0[13]), pw1[3] = cvtpk(P0[14], P0[15]), pw1); PL_SB(); \
        C0 = PL_MF(k1, qr[2], C0);   k1 = PL_KF(7); PL_WORK(P1[2], P1[3], P1[4], P1[5],     pw2[0] = cvtpk(P1[0], P1[1]),   pw2[1] = cvtpk(P1[2], P1[3]),   pw2); PL_SB(); \
        C1 = PL_MF(k2, qr[2], C1);   if (DK == 96) k2 = PL_KF(8); PL_WORK(P1[6], P1[7], P1[8], P1[9],     pw2[2] = cvtpk(P1[4], P1[5]),   pw2[3] = cvtpk(P1[6], P1[7]),   pw2); PL_SB(); \
        C0 = PL_MF(k0, qr[3], C0);   if (DK == 96) k0 = PL_KF(9); PL_WORK(P1[10], P1[11], P1[12], P1[13], pw3[0] = cvtpk(P1[8], P1[9]),   pw3[1] = cvtpk(P1[10], P1[11]), pw3); PL_SB(); \
        C1 = PL_MF(k1, qr[3], C1);   if (DK == 96) k1 = PL_KF(10); PL_WORK(P1[14], P1[15], 0.f, 0.f,       pw3[2] = cvtpk(P1[12], P1[13]), pw3[3] = cvtpk(P1[14], P1[15]), pw3); PL_SB(); \
        if (DK == 96) { C0 = PL_MF(k2, qr[DK / 16 - 2], C0); k2 = PL_KF(11); PL_SB(); C1 = PL_MF(k0, qr[DK / 16 - 2], C1); PL_SB(); C0 = PL_MF(k1, qr[DK / 16 - 1], C0); PL_SB(); C1 = PL_MF(k2, qr[DK / 16 - 1], C1); PL_SB(); } \
        l_reg += sacc; \
        bf16x8 v0 = PL_VF(0), v1 = PL_VF(4), v2 = PL_VF(1); \
        maskf(C0, C1, t_); \
        { const float rm = rowmax32(C0, C1); resc = false; \
          if (__builtin_expect(__any(rm > FA_THRL), 0)) { const float dl = fmaxf(rm, 0.f); mhat += dl; \
              _Pragma("unroll") for (int r = 0; r < 16; ++r) { C0[r] -= dl; C1[r] -= dl; } \
              _Pragma("unroll") for (int r = 0; r < 16; ++r) negm[r] = -mhat; \
              asm volatile("" : "+v"(negm)); \
              const float f_ = __builtin_amdgcn_exp2f(-dl); l_reg *= f_; if (hf == 0) wsf[r32] = f_; resc = true; } } \
        PL_SB(); \
        PL_GAPB(o[0] = PL_MF(PL_PAF(0), v0, o[0]); v0 = PL_VF(5), C0, 0); \
        PL_GAPB(o[1] = PL_MF(PL_PAF(0), v1, o[1]); v1 = PL_VF(2), C0, 4); \
        PL_GAPB(o[0] = PL_MF(PL_PAF(1), v2, o[0]); v2 = PL_VF(6), C0, 8); \
        PL_GAPB(o[1] = PL_MF(PL_PAF(1), v0, o[1]); v0 = PL_VF(3), C0, 12); \
        PL_GAPB(o[0] = PL_MF(PL_PAF(2), v1, o[0]); v1 = PL_VF(7), C1, 0); \
        PL_GAPB(o[1] = PL_MF(PL_PAF(2), v2, o[1]), C1, 4); \
        PL_GAPB(o[0] = PL_MF(PL_PAF(3), v0, o[0]), C1, 8); \
        PL_GAPB(o[1] = PL_MF(PL_PAF(3), v1, o[1]), C1, 12); \
        __syncthreads(); \
        if (resc) { \
            _Pragma("unroll") for (int g_ = 0; g_ < 4; ++g_) { const f32x4 a_ = *(const LAS f32x4*)(wsf + 8 * g_ + 4 * hf); \
                o[0][4 * g_] *= a_.x; o[0][4 * g_ + 1] *= a_.y; o[0][4 * g_ + 2] *= a_.z; o[0][4 * g_ + 3] *= a_.w; o[1][4 * g_] *= a_.x; o[1][4 * g_ + 1] *= a_.y; o[1][4 * g_ + 2] *= a_.z; o[1][4 * g_ + 3] *= a_.w; } } \
        kb_cur = (kb_cur == 2) ? 0 : kb_cur + 1; kb_st = (kb_st == 2) ? 0 : kb_st + 1; vb_prev ^= 1; \
    } while (0)
    int t = 1;
    for (; t + 1 < T; t += 2) { PL_STEP(pB0, pB1, pA0, pA1, t); PL_STEP(pA0, pA1, pB0, pB1, t + 1); }
    const bool tail = t < T;
    if (tail) PL_STEP(pB0, pB1, pA0, pA1, t);
#define PL_DRAIN(P0, P1) do { float sacc = 0.f; _Pragma("unroll") for (int r = 0; r < 16; ++r) sacc += P0[r] + P1[r]; l_reg += sacc; \
        bf16x8 a0_, a1_, a2_, a3_; pack_p(P0, P1, a0_, a1_, a2_, a3_); pv(o, vfrag0 + vb_prev * 8192, a0_, a1_, a2_, a3_); } while (0)
    if (tail) PL_DRAIN(pB0, pB1); else PL_DRAIN(pA0, pA1);
    l_out = l_reg;
    __syncthreads();
#undef PL_KLOAD
#undef PL_KSTORE
#undef PL_VLOAD
#undef PL_PIN
#undef PL_SB
#undef PL_KF
#undef PL_VF
#undef PL_PAF
#undef PL_WORK
#undef PL_GAPB
#undef PL_MF
#undef PL_STEP
#undef PL_DRAIN
}

DI void mla_unit(const Params& p, LAS unsigned char* lds, int b, int h, int qb, int wid0) {
    const int tid = opaque_tid(wid0), lane = tid & 63, r32 = lane & 31, hf = lane >> 5; const int wv = __builtin_amdgcn_readfirstlane(tid >> 6);
    const bf16_t* KN = wsp<bf16_t>(p, WS_KN); const bf16_t* VM = wsp<bf16_t>(p, WS_VM); bf16_t* OC = wsp<bf16_t>(p, WS_R1);
    const int rowbase = b * SEQ, q0 = qb * 256, tq = q0 + wv * 32 + r32, row = rowbase + tq;
    LAS float* wsf = (LAS float*)(lds + L_WS) + wv * 64;
    bf16x8 qr[6];
    {
        const bf16_t* src = wsp<bf16_t>(p, WS_R0) + (size_t)row * 768 + h * 96 + 8 * hf; float q[6][8]; float ss = 0.f;
#pragma unroll
        for (int d0 = 0; d0 < 6; ++d0) { unpack8(*(const u32x4*)(src + 16 * d0), q[d0]);
#pragma unroll
            for (int e = 0; e < 8; ++e) ss += q[d0][e] * q[d0][e]; }
        ss = sum32(ss);
        const float rstd = rsqrtf(ss * (1.f / 96.f) + EPS); const float* qg = p.in[I_MQG] + 8 * hf; const float* kg = p.in[I_MKG] + 8 * hf;
#pragma unroll
        for (int d0 = 0; d0 < 6; ++d0)
#pragma unroll
            for (int e = 0; e < 8; ++e) q[d0][e] *= rstd * qg[16 * d0 + e];
        const float* cs = ropeCM(p) + (size_t)row * 16 + 8 * hf; const float* sn = ropeSM(p) + (size_t)row * 16 + 8 * hf;
#pragma unroll
        for (int e = 0; e < 8; ++e) { const float x1 = q[4][e], x2 = q[5][e]; q[4][e] = x1 * cs[e] - x2 * sn[e]; q[5][e] = x2 * cs[e] + x1 * sn[e]; }
#pragma unroll
        for (int d0 = 0; d0 < 6; ++d0) { float f[8];
#pragma unroll
            for (int e = 0; e < 8; ++e) f[e] = q[d0][e] * ((d0 < 4) ? kg[16 * d0 + e] * C2M : C2M);
            qr[d0] = __builtin_bit_cast(bf16x8, pack8(f)); }
    }
    const int NT = 4 * (qb + 1);
    TileSrc src; src.k = KN + (size_t)(rowbase + lane) * 768 + h * 96 + wv * 8; src.k2 = src.k + 64; src.kstep = 64 * 768;
    src.v = VM + (size_t)(rowbase + 16 * (wv & 3) + (lane >> 2)) * 512 + h * 64 + (wv >> 2) * 32 + (lane & 3) * 8; src.vstep = 64 * 512;
    const int qlo = q0 + wv * 32;
    auto mk = [&](f32x16& p0, f32x16& p1, int i) { if (i * 64 + 63 > qlo) mask_range(p0, p1, i * 64, 0, tq, hf); };
    f32x16 ob[2]; float lb;
    pipe_attn<96>(lds, src, NT, qr, mk, ob, lb, wv, lane, r32, hf, wsf);
    const float lt = sum32(lb);
    f32x16 acc[2];
#pragma unroll
    for (int i = 0; i < 16; ++i) { acc[0][i] = 0.f; acc[1][i] = 0.f; }
    accum_scaled(acc, ob, 1.0f / lt, wsf, r32, hf);
    LAS bf16_t* stg = (LAS bf16_t*)(lds + L_OST) + wv * 4096;
    stage_rows(acc, stg, r32, hf);
#pragma unroll
    for (int i = 0; i < 4; ++i) { const int rr = i * 8 + (lane >> 3), ch = lane & 7; const u32x4 v = *(const LAS u32x4*)(stg + rr * 64 + ch * 8);
        st16(OC + (size_t)(rowbase + q0 + wv * 32 + rr) * 1024 + h * 64 + ch * 8, v); }
}

DI void nsa_unit(const Params& p, LAS unsigned char* lds, int b, int g, int c, int wid0) {
    const int tid = opaque_tid(wid0), lane = tid & 63, r32 = lane & 31, hf = lane >> 5; const int wv = __builtin_amdgcn_readfirstlane(tid >> 6);
    const bf16_t* QN = wsp<bf16_t>(p, WS_QN); const bf16_t* KCF = wsp<bf16_t>(p, WS_KCF); const bf16_t* VCF = wsp<bf16_t>(p, WS_VCF);
    const bf16_t* KS = wsp<bf16_t>(p, WS_KS); const bf16_t* VS = wsp<bf16_t>(p, WS_VS); const bf16_t* KW = wsp<bf16_t>(p, WS_KW); const bf16_t* VW = wsp<bf16_t>(p, WS_VW);
    const bf16_t* GN = wsp<bf16_t>(p, WS_GN); bf16_t* OC = wsp<bf16_t>(p, WS_R1);
    const int rowbase = b * SEQ, tt = 8 * wv + (r32 >> 2), hd = g * 4 + (r32 & 3), tq = 64 * c + tt, row = rowbase + tq;
    LAS float* wsf = (LAS float*)(lds + L_WS) + wv * 64;
    bf16x8 qr[4];
#pragma unroll
    for (int d0 = 0; d0 < 4; ++d0) qr[d0] = *(const bf16x8*)(QN + (size_t)row * 512 + hd * 64 + 16 * d0 + 8 * hf);
    LAS float* accw = (LAS float*)(lds + L_OST) + wv * 2048;
    const int vboff = ((lane >> 4) & 1) * 32 + (lane & 3) * 8 + (4 * hf + ((lane & 15) >> 2)) * 64;
    u32x4 ka, vv;
#define NSA_LOAD(KB, VB, krow0) do { ka = *(const u32x4*)((KB) + (size_t)((krow0) + lane) * 128 + g * 64 + wv * 8); \
        vv = *(const u32x4*)((VB) + (size_t)((krow0) + 16 * (wv & 3) + (lane >> 2)) * 128 + g * 64 + (wv >> 2) * 32 + (lane & 3) * 8); } while (0)
#define NSA_STORE(koff, voff) do { *(LAS u32x4*)(lds + (koff) + wv * 1024 + lane * 16) = ka; *(LAS u32x4*)(lds + (voff) + wv * 1024 + lane * 16) = vv; } while (0)
    unsigned selmask;
    {
        const int ntile = (4 * c + 3 > 64) ? 2 : 1;
        const int nmax = (tq >= 31) ? ((tq - 31) >> 4) : -1;
        __syncthreads();
        { NSA_LOAD(KCF, VCF, b * 128); const u32x4 ka1_ = ka, vv1_ = vv; if (ntile == 2) NSA_LOAD(KCF, VCF, b * 128 + 64);
          *(LAS u32x4*)(lds + L_K + wv * 1024 + lane * 16) = ka1_; *(LAS u32x4*)(lds + L_V + wv * 1024 + lane * 16) = vv1_; if (ntile == 2) NSA_STORE(L_K + 8192, L_V + 8192); }
        __syncthreads();
        f32x16 pa0, pa1, pb0, pb1;
        qkt<64>(pa0, pa1, (lds_cptr)(lds + L_K) + hf * 1024 + r32 * 16, qr); mask_range(pa0, pa1, 0, 0, nmax, hf);
        float m = rowmax32(pa0, pa1);
        if (ntile == 2) { qkt<64>(pb0, pb1, (lds_cptr)(lds + L_K + 8192) + hf * 1024 + r32 * 16, qr); mask_range(pb0, pb1, 64, 0, nmax, hf); m = fmaxf(m, rowmax32(pb0, pb1)); }
        else {
#pragma unroll
            for (int i = 0; i < 16; ++i) { pb0[i] = -INFINITY; pb1[i] = -INFINITY; } }
        const float mu = (m == -INFINITY) ? 0.f : m;
        float ls = 0.f;
#pragma unroll
        for (int r = 0; r < 16; ++r) { pa0[r] = __builtin_amdgcn_exp2f(pa0[r] - mu); pa1[r] = __builtin_amdgcn_exp2f(pa1[r] - mu); pb0[r] = __builtin_amdgcn_exp2f(pb0[r] - mu); pb1[r] = __builtin_amdgcn_exp2f(pb1[r] - mu);
            ls += (pa0[r] + pa1[r]) + (pb0[r] + pb1[r]); }
        ls = sum32(ls);
        const float rl = (ls > 0.f) ? 1.0f / ls : 0.f;
#pragma unroll
        for (int r = 0; r < 16; ++r) { pa0[r] *= rl; pa1[r] *= rl; pb0[r] *= rl; pb1[r] *= rl; }
        float own[16], ee[16];
#pragma unroll
        for (int q = 0; q < 4; ++q) {
            own[q] = (pa0[4 * q] + pa0[4 * q + 1]) + (pa0[4 * q + 2] + pa0[4 * q + 3]); ee[q] = pa0[4 * q + 3];
            own[4 + q] = (pa1[4 * q] + pa1[4 * q + 1]) + (pa1[4 * q + 2] + pa1[4 * q + 3]); ee[4 + q] = pa1[4 * q + 3];
            own[8 + q] = (pb0[4 * q] + pb0[4 * q + 1]) + (pb0[4 * q + 2] + pb0[4 * q + 3]); ee[8 + q] = pb0[4 * q + 3];
            own[12 + q] = (pb1[4 * q] + pb1[4 * q + 1]) + (pb1[4 * q + 2] + pb1[4 * q + 3]); ee[12 + q] = pb1[4 * q + 3]; }
        float eo[16];
#pragma unroll
        for (int k = 0; k < 16; ++k) eo[k] = xor32(ee[k], hf);
#pragma unroll
        for (int k = 0; k < 16; ++k) { const float add = hf ? eo[k] : ((k > 0) ? eo[k - 1] : 0.f); own[k] += add; }
#pragma unroll
        for (int k = 0; k < 16; ++k) { own[k] += xorl<1>(own[k]); own[k] += xorl<2>(own[k]); }
        float imp[32];
#pragma unroll
        for (int k = 0; k < 16; ++k) { const float oth = xor32(own[k], hf); imp[2 * k] = hf ? oth : own[k]; imp[2 * k + 1] = hf ? own[k] : oth; }
        selmask = select_blocks(imp, c);
        State sc; st_init(sc);
        { bf16x8 a0, a1, a2, a3; pack_p(pa0, pa1, a0, a1, a2, a3); pv(sc.o, (int)(uintptr_t)(lds + L_V) + vboff, a0, a1, a2, a3); }
        if (ntile == 2) { bf16x8 a0, a1, a2, a3; pack_p(pb0, pb1, a0, a1, a2, a3); pv(sc.o, (int)(uintptr_t)(lds + L_V + 8192) + vboff, a0, a1, a2, a3); }
        accum_lds<true>(accw, sc.o, bf2f(GN[(size_t)row * 32 + hd * 3]), wsf, r32, hf);
    }
#pragma unroll 1
    for (int br = 1; br < 3; ++br) {
        const bf16_t* KB = (br == 1) ? KS : KW; const bf16_t* VB = (br == 1) ? VS : VW;
        const int NT = (br == 1) ? (c + 1) : ((c + 1 < 5) ? c + 1 : 5);
        TileSrc src; src.k = KB + (size_t)(rowbase + c * 64 + lane) * 128 + g * 64 + wv * 8; src.v = VB + (size_t)(rowbase + c * 64 + 16 * (wv & 3) + (lane >> 2)) * 128 + g * 64 + (wv >> 2) * 32 + (lane & 3) * 8;
        src.k2 = src.k; src.kstep = -64 * 128; src.vstep = -64 * 128;
        f32x16 ob[2]; float lb;
        if (br == 1) {
            auto mk = [&](f32x16& p0, f32x16& p1, int i) { const int j = c - i;
                if (i == 0) mask_range(p0, p1, j * 64, 0, tq, hf);
                if (!((selmask >> j) & 1u)) {
#pragma unroll
                    for (int r = 0; r < 16; ++r) { p0[r] = -INFINITY; p1[r] = -INFINITY; } } };
            pipe_attn<64>(lds, src, NT, qr, mk, ob, lb, wv, lane, r32, hf, wsf);
        } else {
            const int lo = tq - 255;
            auto mk = [&](f32x16& p0, f32x16& p1, int i) { if (i == 0 || i == 4) mask_range(p0, p1, (c - i) * 64, lo, tq, hf); };
            pipe_attn<64>(lds, src, NT, qr, mk, ob, lb, wv, lane, r32, hf, wsf);
        }
        const float lt = sum32(lb);
        accum_lds<false>(accw, ob, bf2f(GN[(size_t)row * 32 + hd * 3 + br]) / lt, wsf, r32, hf);
    }
#undef NSA_LOAD
#undef NSA_STORE
    asm volatile("s_waitcnt lgkmcnt(0)" ::: "memory");
#pragma unroll
    for (int i = 0; i < 4; ++i) { const int rr = i * 8 + (lane >> 3), ch = lane & 7; const f32x4 a = *(const LAS f32x4*)(accw + rr * 64 + ch * 8), b2 = *(const LAS f32x4*)(accw + rr * 64 + ch * 8 + 4);
        u32x4 v; v.x = pk2(a.x, a.y); v.y = pk2(a.z, a.w); v.z = pk2(b2.x, b2.y); v.w = pk2(b2.z, b2.w);
        st16(OC + (size_t)(rowbase + 64 * c + 8 * wv + (rr >> 2)) * 1024 + 512 + (g * 4 + (rr & 3)) * 64 + ch * 8, v); }
}
#undef FA_SBAR
}

DI void stage_attn_fast(const Params& p, LAS unsigned char* lds, int bid, int nb, bool do_mla, bool do_nsa, int wid0) {
    if (do_mla) for (int u = bid; u < 256; u += nb) { const int bh = u >> 2, s = u & 3; fa::mla_unit(p, lds, bh >> 3, bh & 7, 7 - s, wid0); fa::mla_unit(p, lds, bh >> 3, bh & 7, s, wid0); }
    if (do_nsa) for (int u = bid; u < 256; u += nb) { const int bg = u >> 4, s = u & 15; fa::nsa_unit(p, lds, bg >> 1, bg & 1, 31 - s, wid0); fa::nsa_unit(p, lds, bg >> 1, bg & 1, s, wid0); }
    __syncthreads();
}
#define XB_TMO      128
#define XB_XCNT(j)  (256  + 64 * (j))
#define XB_XSUB(j)  (1280 + 64 * (j))
#define XB_XGEN(j)  (2304 + 64 * (j))
#define XB_TOP      3328
#define XB_TOPGEN   3392
#define XCD_BAR_WORDS 3456
#define XB_SPIN_CAP (1u << 18)

__device__ __forceinline__ unsigned xb_ld(unsigned* p)              { return __hip_atomic_load(p, __ATOMIC_RELAXED, __HIP_MEMORY_SCOPE_AGENT); }
__device__ __forceinline__ unsigned xb_add(unsigned* p, unsigned v) { return __hip_atomic_fetch_add(p, v, __ATOMIC_RELAXED, __HIP_MEMORY_SCOPE_AGENT); }
__device__ __forceinline__ unsigned xb_xcc_id() { return (unsigned)__builtin_amdgcn_s_getreg((3 << 11) | 20) & 0xFu; }
#define XB_SPIN(cond, bar) do { unsigned _sp = 0; while (cond) { __builtin_amdgcn_s_sleep(1); \
    if ((++_sp & 255u) == 0u) { if (xb_ld(&(bar)[XB_TMO])) break; if (_sp > XB_SPIN_CAP) { atomicAdd(&(bar)[XB_TMO], 1u); break; } } } } while (0)

struct XcdBarrier {
    unsigned* bar; unsigned x;
    volatile LAS unsigned* st;
};

__device__ __forceinline__ XcdBarrier xcd_barrier_post(unsigned* bar, volatile LAS unsigned* st, bool t0) {
    XcdBarrier b; b.bar = bar; b.x = xb_xcc_id(); b.st = st;
    if (t0) (void)xb_add(&bar[XB_XCNT(b.x)], 1u);
    return b;
}
__device__ __forceinline__ void xcd_barrier_complete(unsigned* bar, unsigned x, unsigned& nloc, unsigned& nx) {
    const unsigned G = gridDim.x * gridDim.y * gridDim.z;
    unsigned sum, cnt, mine, sp = 0u;
    for (;;) {
        sum = 0u; cnt = 0u; mine = 0u;
#pragma unroll
        for (unsigned j = 0; j < 16; ++j) { const unsigned c = xb_ld(&bar[XB_XCNT(j)]); sum += c; cnt += (c > 0u) ? 1u : 0u; mine = (j == x) ? c : mine; }
        if (sum == G) break;
        __builtin_amdgcn_s_sleep(1);
        if ((++sp & 255u) == 0u) { if (xb_ld(&bar[XB_TMO])) break; if (sp > XB_SPIN_CAP) { atomicAdd(&bar[XB_TMO], 1u); break; } }
    }
    nloc = mine > 0u ? mine : 1u; nx = cnt > 0u ? cnt : 1u;
}

__device__ __forceinline__ void xcd_barrier(const XcdBarrier& b, bool t0) {
    asm volatile("s_waitcnt vmcnt(0)" ::: "memory");
    __syncthreads();
    if (t0) {
        unsigned* bar = b.bar;
        __builtin_amdgcn_s_waitcnt(0);
        unsigned nloc = b.st[0], nx = b.st[1];
        if (nloc == 0u) { xcd_barrier_complete(bar, b.x, nloc, nx); b.st[0] = nloc; b.st[1] = nx; }
        const unsigned old = xb_add(&bar[XB_XSUB(b.x)], 1u);
        const unsigned gen = old / nloc;
        if (old + 1u == (gen + 1u) * nloc) {
            __builtin_amdgcn_fence(__ATOMIC_RELEASE, "agent");
            asm volatile("s_waitcnt vmcnt(0)" ::: "memory");
            const unsigned og = xb_add(&bar[XB_TOP], 1u);
            const unsigned tg = og / nx;
            if (og + 1u == (tg + 1u) * nx) xb_add(&bar[XB_TOPGEN], 1u);
            else XB_SPIN(xb_ld(&bar[XB_TOPGEN]) == tg, bar);
            __builtin_amdgcn_fence(__ATOMIC_ACQUIRE, "agent");
            xb_add(&bar[XB_XGEN(b.x)], 1u);
            asm volatile("s_waitcnt vmcnt(0)" ::: "memory");
        } else {
            XB_SPIN(xb_ld(&bar[XB_XGEN(b.x)]) == gen, bar);
            __builtin_amdgcn_fence(__ATOMIC_ACQUIRE, "agent");
            asm volatile("s_waitcnt vmcnt(0)" ::: "memory");
        }
    }
    __syncthreads();
}
constexpr int LDS_BYTES = 147456;

typedef const Params __attribute__((address_space(4)))* KParamsPtr;
#if defined(__HIP_DEVICE_COMPILE__)
DI KParamsPtr kparams() { KParamsPtr k = (KParamsPtr)__builtin_amdgcn_kernarg_segment_ptr(); asm volatile("" : "+s"(k)); return k; }
#define PHASE_PARAMS() const Params p = *kparams()
#else
#define PHASE_PARAMS() const Params p = p_arg
#endif
constexpr int CW_BAR = 4096, CW_CMP = 8192;

__global__ void __launch_bounds__(512, 2) fwd_megakernel(Params p_arg) {
    extern __shared__ __attribute__((aligned(16))) unsigned char dlds[];
    LAS unsigned char* lds = (LAS unsigned char*)dlds;
    const int G = gridDim.x, c = blockIdx.x, ngw = G * NWAVE, ngt = G * NTHR;
    const int wid0 = __builtin_amdgcn_readfirstlane(threadIdx.x >> 6);
#define TIDS() const int tid = opaque_tid(wid0), lane = tid & 63, wave = tid >> 6, gw = c * NWAVE + wave, gtid = c * NTHR + tid; (void)lane; (void)gw; (void)gtid
    volatile LAS unsigned* MISC = (volatile LAS unsigned*)(lds + 131072 + 320);
    { TIDS(); if (tid < 32) MISC[tid] = 0u; }
    __syncthreads();
    XcdBarrier bar;
    { PHASE_PARAMS(); TIDS(); bar = xcd_barrier_post((unsigned*)(p.ws + WS_CTL) + CW_BAR, MISC + 8, tid == 0); }
#define GRID_SYNC() do { TIDS(); xcd_barrier(bar, tid == 0); } while (0)

    { PHASE_PARAMS();
      { TIDS(); stage_weights<0>(p, gw, ngw, (float*)dlds + wave * (64 * 33), lane); }
      __syncthreads();
      stage_mod(p, c, G, (float*)dlds, wid0);
      __syncthreads();
      { TIDS(); stage_rope(p, tid, gtid, ngt, (float*)dlds + 16384); } }
    GRID_SYNC();
    { PHASE_PARAMS(); TIDS(); stage_normmod(p.in[I_X], p.in[I_N1G], wsp<float>(p, WS_MOD), 0, 1, wsp<bf16_t>(p, WS_R0), gw, ngw, lane); }
    GRID_SYNC();
    { PHASE_PARAMS(); EpiZ E{p}; gemm_fast(lds, wsp<bf16_t>(p, WS_R0), 1024, wsp<bf16_t>(p, WS_WIN), MT, ZN, 1024, E, G, c, wid0); }
    { PHASE_PARAMS(); const int nz = (MT / 256) * (ZN / 256), first = nz % G;
      if (c >= first) { { TIDS(); stage_weights<1>(p, (c - first) * NWAVE + wave, (G - first) * NWAVE, (float*)dlds + wave * (64 * 33), lane); }
                        __syncthreads(); stage_shw(p, c - first, G - first, (float*)dlds, wid0); } }
    GRID_SYNC();
    { PHASE_PARAMS();
      int qb, qc, kb, kc;
      if (G == 256) { qb = c; qc = (c < 192) ? 1 : 0; kb = (c < 192) ? c : (c >= 224 ? 192 + 2 * (c - 224) : 0); kc = (c < 192) ? 1 : (c >= 224 ? 2 : 0); }
      else { const int pq = (192 + G - 1) / G, pk = (256 + G - 1) / G; qb = c * pq; qc = (192 - qb < pq) ? ((192 - qb > 0) ? 192 - qb : 0) : pq; kb = c * pk; kc = (256 - kb < pk) ? ((256 - kb > 0) ? 256 - kb : 0) : pk; }
      { EpiQ E{p}; gemm_fast_range(lds, wsp<bf16_t>(p, WS_R1), 1024, wsp<bf16_t>(p, WS_WQB), MT, 768, 768, E, qb, qc, wid0); }
      for (int cu = (c + 64) % G; cu < 32; cu += G) cmp_hidden_fast(p, lds, cu, wid0);
      { EpiKV E{p}; gemm_fast_range(lds, wsp<bf16_t>(p, WS_R1) + 768, 1024, wsp<bf16_t>(p, WS_WKVB), MT, 1024, 256, E, kb, kc, wid0); }
    }
    GRID_SYNC();
    { PHASE_PARAMS(); TIDS(); cmp_out<true>(p, gw, ngw, lane);
      asm volatile("s_waitcnt vmcnt(0)" ::: "memory"); __syncthreads();
      if (tid == 0) { __builtin_amdgcn_fence(__ATOMIC_RELEASE, "agent"); asm volatile("s_waitcnt vmcnt(0)" ::: "memory");
          __hip_atomic_fetch_add((unsigned*)(p.ws + WS_CTL) + CW_CMP, 1u, __ATOMIC_RELAXED, __HIP_MEMORY_SCOPE_AGENT); } }
    { PHASE_PARAMS(); stage_attn_fast(p, lds, c, G, true, false, wid0); }
    { PHASE_PARAMS(); TIDS();
      if (tid == 0) { unsigned* cnt = (unsigned*)(p.ws + WS_CTL) + CW_CMP; unsigned sp = 0;
          while (__hip_atomic_load(cnt, __ATOMIC_RELAXED, __HIP_MEMORY_SCOPE_AGENT) < (unsigned)G) { __builtin_amdgcn_s_sleep(2); if (++sp > (1u << 22)) break; }
          __builtin_amdgcn_fence(__ATOMIC_ACQUIRE, "agent"); asm volatile("s_waitcnt vmcnt(0)" ::: "memory"); }
      __syncthreads(); }
    { PHASE_PARAMS(); stage_attn_fast(p, lds, c, G, false, true, wid0); }
    GRID_SYNC();
    { PHASE_PARAMS(); EpiMerge E{p}; gemm_fast(lds, wsp<bf16_t>(p, WS_R1), 1024, wsp<bf16_t>(p, WS_WO), MT, 1024, 1024, E, G, c, wid0); }
    GRID_SYNC();
    { PHASE_PARAMS(); EpiOut E{p}; gemm_fast(lds, wsp<bf16_t>(p, WS_R0), 1024, wsp<bf16_t>(p, WS_WOUT), MT, 1024, 1024, E, G, c, wid0); }
    GRID_SYNC();
    { PHASE_PARAMS(); EpiGU E{p}; gemm_fast(lds, wsp<bf16_t>(p, WS_R1), 1024, wsp<bf16_t>(p, WS_WGU), MT, 5632, 1024, E, G, c, wid0); }
    { PHASE_PARAMS(); const int ng = (MT / 256) * (5632 / 256), first = ng % G;
      if (c >= first) { TIDS(); stage_weights<2>(p, (c - first) * NWAVE + wave, (G - first) * NWAVE, (float*)dlds + wave * (64 * 33), lane); } }
    GRID_SYNC();
    { PHASE_PARAMS(); EpiDown E{p}; gemm_fast(lds, wsp<bf16_t>(p, WS_HID), DFF, wsp<bf16_t>(p, WS_WD), MT, 1024, DFF, E, G, c, wid0); }
}

extern "C" void kernel_launch(void* const* d_in, const int* in_sizes, int n_in, void* d_out, int out_size, void* d_ws, size_t ws_size, hipStream_t stream) {
    if (n_in != 30 || out_size != MT * DM || ws_size < WS_END) { fprintf(stderr, "kernel_launch: unexpected shapes (n_in %d out %d ws %zu)\n", n_in, out_size, ws_size); return; }
    static int grid = 0;
    if (grid == 0) {
        int dev = 0, cus = 0, per_cu = 0;
        (void)hipGetDevice(&dev); (void)hipDeviceGetAttribute(&cus, hipDeviceAttributeMultiprocessorCount, dev);
        (void)hipFuncSetAttribute((const void*)fwd_megakernel, hipFuncAttributeMaxDynamicSharedMemorySize, LDS_BYTES);
        (void)hipOccupancyMaxActiveBlocksPerMultiprocessor(&per_cu, (const void*)fwd_megakernel, NTHR, LDS_BYTES);
        if (per_cu < 1) fprintf(stderr, "kernel_launch: occupancy query says %d blocks per CU\n", per_cu);
        grid = cus;
        (void)hipGetLastError();
    }
    Params p{};
    for (int i = 0; i < 30; ++i) p.in[i] = (const float*)d_in[i];
    p.out = (float*)d_out; p.ws = (unsigned char*)d_ws;
    (void)hipMemsetAsync((char*)d_ws + WS_CTL, 0, 65536, stream);
    void* args[] = {&p};
    hipError_t e = hipLaunchCooperativeKernel((const void*)fwd_megakernel, dim3(grid), dim3(NTHR), args, LDS_BYTES, stream);
    if (e != hipSuccess) fprintf(stderr, "kernel_launch: cooperative launch failed: %s (grid %d)\n", hipGetErrorString(e), grid);
}
```

```cpp
#include <hip/hip_runtime.h>
#include <cstdint>
#include <cstdio>

typedef unsigned short bf16_t;
typedef unsigned u32x4 __attribute__((ext_vector_type(4)));
typedef unsigned u32x2 __attribute__((ext_vector_type(2)));
typedef float f32x4 __attribute__((ext_vector_type(4)));
typedef float f32x2 __attribute__((ext_vector_type(2)));
#define DI __device__ __forceinline__

constexpr int NB = 8, SEQ = 2048, DM = 1024, MT = NB * SEQ;
constexpr int DFF = 2816, NMOD = 6;
constexpr int ZN = 4608;
constexpr float EPS = 1e-6f;
constexpr float LOG2E = 1.4426950408889634f;
constexpr float C2N = 0.125f * LOG2E;
constexpr float C2M = 0.10206207261596575f * LOG2E;
constexpr int NTHR = 512, NWAVE = 8;
constexpr int O_CQ = 0, O_CKV = 768, O_KPE = 1024, O_QN = 1056, O_KC = 1568, O_VC = 1696, O_KS = 1824, O_VS = 1952, O_KW = 2080, O_VW = 2208,
              O_GN = 2336, O_GM = 2360, O_GNM = 3384, D_IN = 4408;

constexpr size_t MiB = 1u << 20;
constexpr size_t WS_CTL = 0;
constexpr size_t WS_MOD = 1 * MiB;
constexpr size_t WS_CB1 = 1 * MiB + 256 * 1024;
constexpr size_t WS_SSQPE = 1 * MiB + 320 * 1024;
constexpr size_t WS_SSQKN = 1 * MiB + 512 * 1024;
constexpr size_t WS_SSQA = 2 * MiB;
constexpr size_t WS_KCF = 3 * MiB;
constexpr size_t WS_VCF = 3 * MiB + 256 * 1024;
constexpr size_t WS_SHW = 3 * MiB + 512 * 1024;
constexpr size_t WS_WIN = 4 * MiB;
constexpr size_t WS_WQB = 13 * MiB;
constexpr size_t WS_WKVB = 15 * MiB;
constexpr size_t WS_WO = 16 * MiB;
constexpr size_t WS_WOUT = 18 * MiB;
constexpr size_t WS_WGU = 20 * MiB;
constexpr size_t WS_WD = 31 * MiB;
constexpr size_t WS_CW1 = 37 * MiB;
constexpr size_t WS_R0 = 40 * MiB;
constexpr size_t WS_R1 = 72 * MiB;
constexpr size_t WS_R2 = 104 * MiB;
constexpr size_t WS_QN = 168 * MiB;
constexpr size_t WS_KC = 184 * MiB, WS_VC = 188 * MiB, WS_KS = 192 * MiB, WS_VS = 196 * MiB, WS_KW = 200 * MiB, WS_VW = 204 * MiB;
constexpr size_t WS_KPE = 208 * MiB;
constexpr size_t WS_GN = 209 * MiB;
constexpr size_t WS_KN = 210 * MiB;
constexpr size_t WS_VM = 234 * MiB;
constexpr size_t WS_CMPH = 64 * MiB;
constexpr size_t WS_ROPE = 250 * MiB;
constexpr size_t WS_HID = 168 * MiB;
constexpr size_t WS_END = 256 * MiB;

struct Params {
    const float* in[30];
    float* out;
    unsigned char* ws;
};
enum { I_X = 0, I_C, I_POS, I_ADAW, I_ADAB, I_N1G, I_WIN, I_QAG, I_WQB, I_KVAG, I_WKVB, I_MQG, I_MKG, I_NQG, I_NKCG, I_NKSG, I_NKWG,
       I_CPK, I_CW1K, I_CW2K, I_CPV, I_CW1V, I_CW2V, I_WOM, I_WON, I_WOUT, I_N2G, I_WG, I_WU, I_WDN };

template <class T> DI T* wsp(const Params& p, size_t off) { return (T*)(p.ws + off); }

#ifndef WT_STORES
#define WT_STORES 0
#endif
DI void st16(void* p, u32x4 v) {
#if WT_STORES
    asm volatile("global_store_dwordx4 %0, %1, off sc1\n\ts_nop 1" :: "v"(p), "v"(v) : "memory");
#else
    *(u32x4*)p = v;
#endif
}
DI void st16f(void* p, f32x4 v) { st16(p, __builtin_bit_cast(u32x4, v)); }
DI int lane_id() { return (int)__builtin_amdgcn_mbcnt_hi(~0u, __builtin_amdgcn_mbcnt_lo(~0u, 0u)); }
DI int opaque_lane() { int l; asm volatile("v_mbcnt_lo_u32_b32 %0, -1, 0\n\tv_mbcnt_hi_u32_b32 %0, -1, %0" : "=v"(l)); return l; }
DI int opaque_tid(int wid0) { int l; asm volatile("v_mbcnt_lo_u32_b32 %0, -1, 0\n\tv_mbcnt_hi_u32_b32 %0, -1, %0" : "=v"(l)); return (wid0 << 6) | l; }
DI unsigned f2bf(float f) { unsigned u = __float_as_uint(f); return (u + 0x7fffu + ((u >> 16) & 1u)) >> 16; }
DI unsigned pk2(float lo, float hi) { return f2bf(lo) | (f2bf(hi) << 16); }
DI float bf2f(unsigned short b) { return __uint_as_float(((unsigned)b) << 16); }
DI float bflo(unsigned w) { return __uint_as_float(w << 16); }
DI float bfhi(unsigned w) { return __uint_as_float(w & 0xffff0000u); }
DI void unpack8(const u32x4 w, float (&f)[8]) { f[0] = bflo(w.x); f[1] = bfhi(w.x); f[2] = bflo(w.y); f[3] = bfhi(w.y); f[4] = bflo(w.z); f[5] = bfhi(w.z); f[6] = bflo(w.w); f[7] = bfhi(w.w); }
DI u32x4 pack8(const float (&f)[8]) { u32x4 w; w.x = pk2(f[0], f[1]); w.y = pk2(f[2], f[3]); w.z = pk2(f[4], f[5]); w.w = pk2(f[6], f[7]); return w; }
DI float sigmoidf(float x) { return __builtin_amdgcn_rcpf(1.0f + __expf(-x)); }
DI float siluf(float x) { return x * __builtin_amdgcn_rcpf(1.0f + __expf(-x)); }
template <int X> DI float xorl(float v) { return __int_as_float(__builtin_amdgcn_ds_swizzle(__float_as_int(v), (X << 10) | 0x1f)); }
DI void halves(float v, float& lo, float& hi) { auto rr = __builtin_amdgcn_permlane32_swap(__float_as_uint(v), __float_as_uint(v), false, false); lo = __uint_as_float(rr[0]); hi = __uint_as_float(rr[1]); }
DI float xor32(float v, int hf) { float lo, hi; halves(v, lo, hi); return hf ? lo : hi; }
DI float sum32(float v) { float lo, hi; halves(v, lo, hi); return lo + hi; }
DI float max32(float v) { float lo, hi; halves(v, lo, hi); return fmaxf(lo, hi); }
DI float wave_sum(float v) { v += xorl<1>(v); v += xorl<2>(v); v += xorl<4>(v); v += xorl<8>(v); v += xorl<16>(v); return sum32(v); }
DI void sincos_rad(float ang, float& c, float& s) {
    double rev = (double)ang * 0.15915494309189535; rev -= __builtin_rint(rev);
    const float fr = (float)rev; s = __builtin_amdgcn_sinf(fr); c = __builtin_amdgcn_cosf(fr);
}
#define LAS __attribute__((address_space(3)))
DI void transpose_item(const float* W, int ldw, int c0, int ncols, const float* rs, bf16_t* dst, int ldd, int n0, int k0, float* scr, int lane) {
    const int cc = lane & 31, kh = lane >> 5;
    float v[32];
    if (c0 >= 0) {
        const float* src = W + (size_t)(k0 + kh) * ldw + c0 + cc;
        if (cc < ncols) {
#pragma unroll
            for (int i = 0; i < 32; ++i) v[i] = src[(size_t)(2 * i) * ldw];
        } else {
#pragma unroll
            for (int i = 0; i < 32; ++i) v[i] = 0.f;
        }
        if (rs) {
#pragma unroll
            for (int i = 0; i < 32; ++i) v[i] *= rs[k0 + 2 * i + kh];
        }
    } else {
#pragma unroll
        for (int i = 0; i < 32; ++i) v[i] = 0.f;
    }
#pragma unroll
    for (int i = 0; i < 32; ++i) scr[(2 * i + kh) * 33 + cc] = v[i];
    __builtin_amdgcn_s_waitcnt(0xc07f);
    asm volatile("" ::: "memory");
    const int c = lane & 7;
#pragma unroll
    for (int j = 0; j < 4; ++j) { const int n = (lane >> 3) + 8 * j; const float* s = scr + (8 * c) * 33 + n;
        u32x4 o; o.x = pk2(s[0 * 33], s[1 * 33]); o.y = pk2(s[2 * 33], s[3 * 33]); o.z = pk2(s[4 * 33], s[5 * 33]); o.w = pk2(s[6 * 33], s[7 * 33]);
        st16(dst + (size_t)(n0 + n) * ldd + k0 + 8 * c, o); }
    __builtin_amdgcn_s_waitcnt(0xc07f);
    asm volatile("" ::: "memory");
}
DI int zsrc(int s, int L0, int& ncols) {
    ncols = 32;
    if (s < 16) return 64 * s + L0;
    if (s == 16) { if (L0 == 0) return O_KPE; ncols = 24; return O_GN; }
    if (s < 25) return O_QN + 64 * (s - 17) + L0;
    if (s < 27) return O_KC + 64 * (s - 25) + L0;
    if (s < 29) return O_VC + 64 * (s - 27) + L0;
    if (s < 31) return O_KS + 64 * (s - 29) + L0;
    if (s < 33) return O_VS + 64 * (s - 31) + L0;
    if (s < 35) return O_KW + 64 * (s - 33) + L0;
    if (s < 37) return O_VW + 64 * (s - 35) + L0;
    if (s < 40) return -1;
    if (s < 56) return O_GM + 64 * (s - 40) + L0;
    return O_GNM + 64 * (s - 56) + L0;
}
template <int PART> DI void stage_weights(const Params& p, int gw, int ngw, float* scr, int lane) {
    constexpr int I_IN = (ZN / 32) * (DM / 64);
    constexpr int I_QB = (768 / 32) * (768 / 64);
    constexpr int I_KVB = (1024 / 32) * (256 / 64);
    constexpr int I_O = (1024 / 32) * (1024 / 64);
    constexpr int I_OUT = I_O;
    constexpr int I_GU = (5632 / 32) * (1024 / 64);
    constexpr int I_D = (1024 / 32) * (DFF / 64);
    constexpr int I_C1 = 2 * (256 / 32) * (2048 / 64);
    if constexpr (PART == 1) {
        for (int r = gw; r < I_GU; r += ngw) { const int nb = r / 16, kb = r % 16; const int pn = nb >> 3, bj = (nb >> 2) & 1, wc = nb & 3, s = 4 * pn + wc;
            transpose_item(bj ? p.in[I_WU] : p.in[I_WG], DFF, 32 * s, 32, nullptr, wsp<bf16_t>(p, WS_WGU), 1024, nb * 32, kb * 64, scr, lane); }
        for (int r = gw; r < I_O + I_OUT; r += ngw) {
            if (r < I_O) { const int nb = r / 16, kb = r % 16;
                if (kb < 8) transpose_item(p.in[I_WOM], 1024, nb * 32, 32, nullptr, wsp<bf16_t>(p, WS_WO), 1024, nb * 32, kb * 64, scr, lane);
                else transpose_item(p.in[I_WON] - (size_t)512 * 1024, 1024, nb * 32, 32, nullptr, wsp<bf16_t>(p, WS_WO), 1024, nb * 32, kb * 64, scr, lane); }
            else { const int r2 = r - I_O, nb = r2 / 16, kb = r2 % 16; transpose_item(p.in[I_WOUT], 1024, nb * 32, 32, nullptr, wsp<bf16_t>(p, WS_WOUT), 1024, nb * 32, kb * 64, scr, lane); } }
        return;
    }
    if constexpr (PART == 2) {
        for (int r = gw; r < I_D; r += ngw) { const int nb = r / 44, kb = r % 44; transpose_item(p.in[I_WDN], 1024, nb * 32, 32, nullptr, wsp<bf16_t>(p, WS_WD), DFF, nb * 32, kb * 64, scr, lane); }
        return;
    }
    constexpr int NITEMS = I_IN + I_QB + I_KVB + I_C1;
    for (int it = gw; it < NITEMS; it += ngw) {
        int r = it;
        if (r < I_IN) { const int nb = r / 16, kb = r % 16; const int pn = nb >> 3, bj = (nb >> 2) & 1, wc = nb & 3; int nc; const int c0 = zsrc(4 * pn + wc, 32 * bj, nc);
            transpose_item(p.in[I_WIN], D_IN, c0, nc, nullptr, wsp<bf16_t>(p, WS_WIN), DM, nb * 32, kb * 64, scr, lane); continue; } r -= I_IN;
        if (r < I_QB) { const int nb = r / 12, kb = r % 12; transpose_item(p.in[I_WQB], 768, nb * 32, 32, p.in[I_QAG], wsp<bf16_t>(p, WS_WQB), 768, nb * 32, kb * 64, scr, lane); continue; } r -= I_QB;
        if (r < I_KVB) { const int nb = r / 4, kb = r % 4; const int pn = nb >> 3, bj = (nb >> 2) & 1, wc = nb & 3, s = 4 * pn + wc;
            const int c0 = (s < 8) ? (128 * s + 32 * bj) : (128 * (s - 8) + 64 + 32 * bj);
            transpose_item(p.in[I_WKVB], 1024, c0, 32, p.in[I_KVAG], wsp<bf16_t>(p, WS_WKVB), 256, nb * 32, kb * 64, scr, lane); continue; } r -= I_KVB;
        { const int kv = r / 256, rr = r % 256, nb = rr / 32, kb = rr % 32;
          transpose_item(kv ? p.in[I_CW1V] : p.in[I_CW1K], 256, nb * 32, 32, nullptr, wsp<bf16_t>(p, WS_CW1) + (size_t)kv * 256 * 2048, 2048, nb * 32, kb * 64, scr, lane); }
    }
}
DI void stage_mod(const Params& p, int bid, int nb, float* lds, int wid0) {
    const int tid = opaque_tid(wid0), wave = tid >> 6, lane = tid & 63, nwv = blockDim.x >> 6;
    if (bid >= 104) return;
    float* sl = lds; float* red = lds + 8192;
    for (int i = tid; i < 8192; i += blockDim.x) sl[i] = siluf(p.in[I_C][i]);
    __syncthreads();
    for (int u = bid; u < 104; u += nb) {
        float acc[8];
#pragma unroll
        for (int b = 0; b < 8; ++b) acc[b] = 0.f;
        if (u < 96) {
            const float* W = p.in[I_ADAW] + u * 64 + lane; const int kn = 1024 / nwv;
            for (int k = wave * kn; k < (wave + 1) * kn; k += 8) { float w[8];
#pragma unroll
                for (int e = 0; e < 8; ++e) w[e] = W[(size_t)(k + e) * 6144];
#pragma unroll
                for (int e = 0; e < 8; ++e)
#pragma unroll
                    for (int b = 0; b < 8; ++b) acc[b] += sl[b * 1024 + k + e] * w[e]; }
        } else {
            const int kv = (u - 96) >> 2; const float* W = (kv ? p.in[I_CW1V] : p.in[I_CW1K]) + ((u - 96) & 3) * 64 + lane; const float* pos = kv ? p.in[I_CPV] : p.in[I_CPK]; const int kn = 2048 / nwv;
            for (int k = wave * kn; k < (wave + 1) * kn; k += 8) { float w[8];
#pragma unroll
                for (int e = 0; e < 8; ++e) w[e] = W[(size_t)(k + e) * 256];
#pragma unroll
                for (int e = 0; e < 8; ++e) acc[0] += pos[k + e] * w[e]; }
        }
        __syncthreads();
#pragma unroll
        for (int b = 0; b < 8; ++b) red[(wave * 8 + b) * 64 + lane] = acc[b];
        __syncthreads();
        if (wave == 0) {
#pragma unroll
            for (int b = 0; b < 8; ++b) { float s = 0.f;
                for (int w = 0; w < nwv; ++w) s += red[(w * 8 + b) * 64 + lane];
                if (u < 96) wsp<float>(p, WS_MOD)[b * 6144 + u * 64 + lane] = s + p.in[I_ADAB][u * 64 + lane];
                else if (b == 0) wsp<float>(p, WS_CB1)[(u - 96) * 64 + lane] = s; }
        }
    }
}
DI void stage_rope(const Params& p, int tid, int gtid, int ngt, float* invt) {
    if (tid < 24) invt[tid] = (tid < 16) ? (float)pow(500000.0, -(double)tid / 16.0) : (float)pow(500000.0, -(double)(tid - 16) / 8.0);
    __syncthreads();
    float* T = wsp<float>(p, WS_ROPE); const int* pos = (const int*)p.in[I_POS];
    for (int i = gtid; i < MT * 24; i += ngt) {
        const int row = i / 24, j = i % 24; const float ps = (float)pos[row]; float c, s;
        sincos_rad(ps * invt[j], c, s);
        if (j < 16) { T[(size_t)row * 16 + j] = c; T[(size_t)MT * 16 + (size_t)row * 16 + j] = s; }
        else { T[(size_t)MT * 32 + (size_t)row * 8 + (j - 16)] = c; T[(size_t)MT * 40 + (size_t)row * 8 + (j - 16)] = s; }
    }
}
DI const float* ropeCM(const Params& p) { return wsp<float>(p, WS_ROPE); }
DI const float* ropeSM(const Params& p) { return wsp<float>(p, WS_ROPE) + (size_t)MT * 16; }
DI const float* ropeCN(const Params& p) { return wsp<float>(p, WS_ROPE) + (size_t)MT * 32; }
DI const float* ropeSN(const Params& p) { return wsp<float>(p, WS_ROPE) + (size_t)MT * 40; }

DI void stage_normmod(const float* X, const float* gain, const float* mod, int sh_idx, int sc_idx, bf16_t* Hout, int gw, int ngw, int lane) {
    f32x4 v[4], nx[4];
    if (gw < MT) { const f32x4* xr = (const f32x4*)(X + (size_t)gw * DM) + lane;
#pragma unroll
        for (int j = 0; j < 4; ++j) nx[j] = xr[64 * j]; }
    for (int m = gw; m < MT; m += ngw) {
        const int b = m / SEQ;
#pragma unroll
        for (int j = 0; j < 4; ++j) v[j] = nx[j];
        if (m + ngw < MT) { const f32x4* xr = (const f32x4*)(X + (size_t)(m + ngw) * DM) + lane;
#pragma unroll
            for (int j = 0; j < 4; ++j) nx[j] = xr[64 * j]; }
        float s = 0.f;
#pragma unroll
        for (int j = 0; j < 4; ++j) s += (v[j].x * v[j].x + v[j].y * v[j].y) + (v[j].z * v[j].z + v[j].w * v[j].w);
        const float rstd = rsqrtf(wave_sum(s) * (1.f / DM) + EPS);
        const f32x4* g4 = (const f32x4*)gain + lane; const f32x4* sc4 = (const f32x4*)(mod + b * 6144 + sc_idx * 1024) + lane; const f32x4* sh4 = (const f32x4*)(mod + b * 6144 + sh_idx * 1024) + lane;
        u32x2* o8 = (u32x2*)(Hout + (size_t)m * DM) + lane;
#pragma unroll
        for (int j = 0; j < 4; ++j) { const f32x4 g = g4[64 * j], sc = sc4[64 * j], sh = sh4[64 * j];
            const f32x4 y = v[j] * rstd * g * (1.0f + sc) + sh; u32x2 w; w.x = pk2(y.x, y.y); w.y = pk2(y.z, y.w); o8[64 * j] = w; }
    }
}

DI void stage_shw(const Params& p, int ub, int nbk, float* lds, int wid0) {
    const int tid = opaque_tid(wid0), wave = tid >> 6, lane = tid & 63, nwv = blockDim.x >> 6;
    if (ub >= 88) return;
    float* sl = lds; float* red = lds + 8192;
    for (int i = tid; i < 8192; i += blockDim.x) sl[i] = wsp<float>(p, WS_MOD)[(i >> 10) * 6144 + 3 * 1024 + (i & 1023)];
    __syncthreads();
    for (int u = ub; u < 88; u += nbk) {
        const int mat = u / 44, col = 64 * (u % 44) + lane; const float* W = (mat ? p.in[I_WU] : p.in[I_WG]) + col; const int kn = 1024 / nwv;
        float acc[8];
#pragma unroll
        for (int b = 0; b < 8; ++b) acc[b] = 0.f;
        for (int k = wave * kn; k < (wave + 1) * kn; k += 8) { float w[8];
#pragma unroll
            for (int e = 0; e < 8; ++e) w[e] = W[(size_t)(k + e) * DFF];
#pragma unroll
            for (int e = 0; e < 8; ++e)
#pragma unroll
                for (int b = 0; b < 8; ++b) acc[b] += sl[b * 1024 + k + e] * w[e]; }
        __syncthreads();
#pragma unroll
        for (int b = 0; b < 8; ++b) red[(wave * 8 + b) * 64 + lane] = acc[b];
        __syncthreads();
        if (wave == 0) { const int s = col >> 5, cr = col & 31, phys = 256 * (s >> 2) + 128 * mat + 32 * (s & 3) + cr;
#pragma unroll
            for (int b = 0; b < 8; ++b) { float sum = 0.f;
                for (int w = 0; w < nwv; ++w) sum += red[(w * 8 + b) * 64 + lane];
                wsp<float>(p, WS_SHW)[b * 5632 + phys] = sum; } }
    }
}
struct ColPre { f32x4 c[8]; };
struct RowPre { f32x4 a[4]; };
DI void store8bf(bf16_t* dst, const float (&f)[8]) { st16(dst, pack8(f)); }
DI float ssq16(const float (&v)[2][8]) { float q = 0.f;
#pragma unroll
    for (int b = 0; b < 2; ++b)
#pragma unroll
        for (int j = 0; j < 8; ++j) q += v[b][j] * v[b][j];
    q += xorl<16>(q); return sum32(q); }
DI f32x4 ld4(const float* p) { return *(const f32x4*)p; }
DI f32x4 ld4u(const bf16_t* p) { return __builtin_bit_cast(f32x4, *(const u32x4*)p); }
DI void un8(const f32x4 raw, float (&f)[8]) { unpack8(__builtin_bit_cast(u32x4, raw), f); }

struct EpiZ {
    static constexpr bool HAS_MID = false; static constexpr int NTYPES = 7;
    Params p;
    DI void midpre(RowPre&, int, int, int, int) const {}
    DI void mid(const RowPre&, int, int, int, int, float (&)[2][8]) const {}
    DI int type(int pn, int wc) const { const int s = 4 * pn + wc;
        if (s < 16) return 0; if (s == 16) return 1; if (s < 25) return 2; if (s < 37) { const int t = (s - 25) >> 1; return (t == 2 || t == 4) ? 3 : 4; } if (s < 40) return 5; return 6; }
    template <int T> DI void ubegin(ColPre& U, int, int pn, int wc, int fq) const {
        const int s = 4 * pn + wc; (void)s;
        if constexpr (T == 1) { U.c[0] = ld4(p.in[I_MKG] + 64 + 8 * fq); U.c[1] = ld4(p.in[I_MKG] + 68 + 8 * fq); }
        if constexpr (T == 2 || T == 3) { const float* gain = (T == 2) ? p.in[I_NQG] : ((((s - 25) >> 1) == 2) ? p.in[I_NKSG] : p.in[I_NKWG]);
            U.c[0] = ld4(gain + 8 * fq); U.c[1] = ld4(gain + 8 * fq + 4); U.c[2] = ld4(gain + 32 + 8 * fq); U.c[3] = ld4(gain + 36 + 8 * fq); }
    }
    template <int T> DI void pre(RowPre& R, int row, int, int, int fq) const {
        if constexpr (T == 1) { const int i0 = 8 * (fq & 1); const float* cs = ropeCM(p) + (size_t)row * 16 + i0; const float* sn = ropeSM(p) + (size_t)row * 16 + i0;
            R.a[0] = ld4(cs); R.a[1] = ld4(cs + 4); R.a[2] = ld4(sn); R.a[3] = ld4(sn + 4); }
        if constexpr (T == 2 || T == 3) { const float* cs = ropeCN(p) + (size_t)row * 8; const float* sn = ropeSN(p) + (size_t)row * 8;
            R.a[0] = ld4(cs); R.a[1] = ld4(cs + 4); R.a[2] = ld4(sn); R.a[3] = ld4(sn + 4); }
    }
    DI void normrope(const ColPre& U, const RowPre& R, int fq, float (&v)[2][8], float post, bf16_t* dst) const {
        const float rstd = rsqrtf(ssq16(v) * (1.f / 64.f) + EPS);
#pragma unroll
        for (int b = 0; b < 2; ++b)
#pragma unroll
            for (int j = 0; j < 8; ++j) v[b][j] *= rstd * U.c[2 * b + (j >> 2)][j & 3];
#pragma unroll
        for (int j = 0; j < 8; ++j) { const float own = v[0][j], oth = xorl<16>(own); const float c = R.a[j >> 2][j & 3], s = R.a[2 + (j >> 2)][j & 3];
            if (fq == 0) v[0][j] = own * c - oth * s; else if (fq == 1) v[0][j] = own * c + oth * s; }
#pragma unroll
        for (int b = 0; b < 2; ++b) {
#pragma unroll
            for (int j = 0; j < 8; ++j) v[b][j] *= post;
            store8bf(dst + 32 * b + 8 * fq, v[b]); }
    }
    template <int T> DI void apply(const ColPre& U, const RowPre& R, int row, int pn, int wc, int fq, float (&v)[2][8]) const {
        const int s = 4 * pn + wc; (void)s;
        if constexpr (T == 0) {
            bf16_t* d = wsp<bf16_t>(p, WS_R1) + (size_t)row * 1024 + 64 * s + 8 * fq;
            const float q = ssq16(v); store8bf(d, v[0]); store8bf(d + 32, v[1]);
            if (fq == 0) wsp<float>(p, WS_SSQA)[(size_t)row * 16 + s] = q;
        } else if constexpr (T == 1) {
            float q = 0.f;
#pragma unroll
            for (int j = 0; j < 8; ++j) q += v[0][j] * v[0][j];
            q += xorl<16>(q); q = sum32(q);
            if (fq == 0) wsp<float>(p, WS_SSQPE)[row] = q;
            float o[8];
#pragma unroll
            for (int j = 0; j < 8; ++j) { const float own = v[0][j] * U.c[j >> 2][j & 3], oth = xor32(own, fq >> 1); const float c = R.a[j >> 2][j & 3], sn = R.a[2 + (j >> 2)][j & 3];
                o[j] = (fq < 2) ? own * c - oth * sn : own * c + oth * sn; }
            store8bf(wsp<bf16_t>(p, WS_KPE) + (size_t)row * 32 + 8 * fq, o);
#pragma unroll
            for (int j = 0; j < 8; ++j) o[j] = sigmoidf(v[1][j]);
            store8bf(wsp<bf16_t>(p, WS_GN) + (size_t)row * 32 + 8 * fq, o);
        } else if constexpr (T == 2) {
            normrope(U, R, fq, v, C2N, wsp<bf16_t>(p, WS_QN) + (size_t)row * 512 + 64 * (s - 17));
        } else if constexpr (T == 3 || T == 4) {
            const int t = (s - 25) >> 1, g = (s - 25) & 1;
            bf16_t* d = wsp<bf16_t>(p, WS_KC + (size_t)t * 4 * MiB) + (size_t)row * 128 + 64 * g;
            if constexpr (T == 3) normrope(U, R, fq, v, 1.0f, d);
            else { store8bf(d + 8 * fq, v[0]); store8bf(d + 32 + 8 * fq, v[1]); }
        } else if constexpr (T == 5) {
        } else {
            bf16_t* d = wsp<bf16_t>(p, WS_R2) + (size_t)row * 2048 + 64 * (s - 40) + 8 * fq;
#pragma unroll
            for (int b = 0; b < 2; ++b) { float o[8];
#pragma unroll
                for (int j = 0; j < 8; ++j) o[j] = sigmoidf(v[b][j]);
                store8bf(d + 32 * b, o); }
        }
    }
};
struct EpiQ {
    static constexpr bool HAS_MID = false; static constexpr int NTYPES = 1;
    Params p;
    DI int type(int, int) const { return 0; }
    DI void midpre(RowPre&, int, int, int, int) const {}
    DI void mid(const RowPre&, int, int, int, int, float (&)[2][8]) const {}
    template <int T> DI void ubegin(ColPre&, int, int, int, int) const {}
    template <int T> DI void pre(RowPre& R, int row, int, int, int) const { const float* sq = wsp<float>(p, WS_SSQA) + (size_t)row * 16; R.a[0] = ld4(sq); R.a[1] = ld4(sq + 4); R.a[2] = ld4(sq + 8); }
    template <int T> DI void apply(const ColPre&, const RowPre& R, int row, int pn, int wc, int fq, float (&v)[2][8]) const {
        const float s = ((R.a[0].x + R.a[0].y) + (R.a[0].z + R.a[0].w)) + ((R.a[1].x + R.a[1].y) + (R.a[1].z + R.a[1].w)) + ((R.a[2].x + R.a[2].y) + (R.a[2].z + R.a[2].w));
        const float rstd = rsqrtf(s * (1.f / 768.f) + EPS);
        bf16_t* d = wsp<bf16_t>(p, WS_R0) + (size_t)row * 768 + 256 * pn + 32 * wc + 8 * fq;
#pragma unroll
        for (int b = 0; b < 2; ++b) { float o[8];
#pragma unroll
            for (int j = 0; j < 8; ++j) o[j] = v[b][j] * rstd;
            store8bf(d + 128 * b, o); }
    }
};
struct EpiKV {
    static constexpr bool HAS_MID = false; static constexpr int NTYPES = 1;
    Params p;
    DI int type(int, int) const { return 0; }
    DI void midpre(RowPre&, int, int, int, int) const {}
    DI void mid(const RowPre&, int, int, int, int, float (&)[2][8]) const {}
    template <int T> DI void ubegin(ColPre&, int, int, int, int) const {}
    template <int T> DI void pre(RowPre& R, int row, int pn, int wc, int fq) const { R.a[0] = ld4(wsp<float>(p, WS_SSQA) + (size_t)row * 16 + 12);
        if (4 * pn + wc < 8) { R.a[1].x = wsp<float>(p, WS_SSQPE)[row]; R.a[2] = ld4u(wsp<bf16_t>(p, WS_KPE) + (size_t)row * 32 + 8 * fq); } }
    template <int T> DI void apply(const ColPre&, const RowPre& R, int row, int pn, int wc, int fq, float (&v)[2][8]) const {
        const int s = 4 * pn + wc;
        const float rstd = rsqrtf(((R.a[0].x + R.a[0].y) + (R.a[0].z + R.a[0].w)) * (1.f / 256.f) + EPS);
#pragma unroll
        for (int b = 0; b < 2; ++b)
#pragma unroll
            for (int j = 0; j < 8; ++j) v[b][j] *= rstd;
        if (s < 8) { const float rk = rsqrtf((ssq16(v) + R.a[1].x) * (1.f / 96.f) + EPS);
#pragma unroll
            for (int b = 0; b < 2; ++b)
#pragma unroll
                for (int j = 0; j < 8; ++j) v[b][j] *= rk;
            float pe[8]; un8(R.a[2], pe);
#pragma unroll
            for (int j = 0; j < 8; ++j) pe[j] *= rk;
            bf16_t* d = wsp<bf16_t>(p, WS_KN) + (size_t)row * 768 + 96 * s + 8 * fq; store8bf(d, v[0]); store8bf(d + 32, v[1]); store8bf(d + 64, pe); }
        else { bf16_t* d = wsp<bf16_t>(p, WS_VM) + (size_t)row * 512 + 64 * (s - 8) + 8 * fq; store8bf(d, v[0]); store8bf(d + 32, v[1]); }
    }
};
struct EpiMerge {
    static constexpr bool HAS_MID = true; static constexpr int NTYPES = 1;
    Params p;
    DI int type(int, int) const { return 0; }
    DI void midpre(RowPre& R, int row, int pn, int wc, int fq) const {
        const bf16_t* g = wsp<bf16_t>(p, WS_R2) + (size_t)row * 2048 + 256 * pn + 32 * wc + 8 * fq;
        R.a[0] = ld4u(g); R.a[1] = ld4u(g + 128); R.a[2] = ld4u(g + 1024); R.a[3] = ld4u(g + 1024 + 128); }
    DI void mid(const RowPre& R, int, int, int, int, float (&v)[2][8]) const {
#pragma unroll
        for (int b = 0; b < 2; ++b) { float s1[8], s2[8]; un8(R.a[b], s1); un8(R.a[2 + b], s2);
#pragma unroll
            for (int j = 0; j < 8; ++j) v[b][j] *= s1[j] * __builtin_amdgcn_rcpf(s2[j]); }
    }
    template <int T> DI void ubegin(ColPre&, int, int, int, int) const {}
    template <int T> DI void pre(RowPre& R, int row, int pn, int wc, int fq) const {
        const bf16_t* g = wsp<bf16_t>(p, WS_R2) + (size_t)row * 2048 + 1024 + 256 * pn + 32 * wc + 8 * fq; R.a[0] = ld4u(g); R.a[1] = ld4u(g + 128); }
    template <int T> DI void apply(const ColPre&, const RowPre& R, int row, int pn, int wc, int fq, float (&v)[2][8]) const {
        bf16_t* d = wsp<bf16_t>(p, WS_R0) + (size_t)row * 1024 + 256 * pn + 32 * wc + 8 * fq;
#pragma unroll
        for (int b = 0; b < 2; ++b) { float s2[8], o[8]; un8(R.a[b], s2);
#pragma unroll
            for (int j = 0; j < 8; ++j) o[j] = v[b][j] * s2[j];
            store8bf(d + 128 * b, o); }
    }
};
struct EpiOut {
    static constexpr bool HAS_MID = false; static constexpr int NTYPES = 1;
    Params p;
    DI int type(int, int) const { return 0; }
    DI void midpre(RowPre&, int, int, int, int) const {}
    DI void mid(const RowPre&, int, int, int, int, float (&)[2][8]) const {}
    template <int T> DI void ubegin(ColPre& U, int row0, int pn, int wc, int fq) const {
        const int b_ = row0 / SEQ, col = 256 * pn + 32 * wc + 8 * fq; const float* md = wsp<float>(p, WS_MOD) + b_ * 6144 + col; const float* g2 = p.in[I_N2G] + col;
#pragma unroll
        for (int i = 0; i < 4; ++i) { const int o = 128 * (i >> 1) + 4 * (i & 1); U.c[i] = ld4(md + 2 * 1024 + o); const f32x4 sc = ld4(md + 4 * 1024 + o), gg = ld4(g2 + o); U.c[4 + i] = gg * (1.0f + sc); }
    }
    template <int T> DI void pre(RowPre& R, int row, int pn, int wc, int fq) const { const float* x = p.in[I_X] + (size_t)row * DM + 256 * pn + 32 * wc + 8 * fq;
        R.a[0] = ld4(x); R.a[1] = ld4(x + 4); R.a[2] = ld4(x + 128); R.a[3] = ld4(x + 132); }
    template <int T> DI void apply(const ColPre& U, const RowPre& R, int row, int pn, int wc, int fq, float (&v)[2][8]) const {
        const int col = 256 * pn + 32 * wc + 8 * fq; float* d = wsp<float>(p, WS_R2) + (size_t)row * DM + col; bf16_t* a2 = wsp<bf16_t>(p, WS_R1) + (size_t)row * DM + col;
        float q = 0.f;
#pragma unroll
        for (int b = 0; b < 2; ++b) { float o8[8];
#pragma unroll
            for (int h = 0; h < 2; ++h) { const f32x4 g = U.c[2 * b + h], xv = R.a[2 * b + h], gs = U.c[4 + 2 * b + h];
                f32x4 o; o.x = xv.x + g.x * v[b][4 * h]; o.y = xv.y + g.y * v[b][4 * h + 1]; o.z = xv.z + g.z * v[b][4 * h + 2]; o.w = xv.w + g.w * v[b][4 * h + 3]; st16f(d + 128 * b + 4 * h, o);
                q += (o.x * o.x + o.y * o.y) + (o.z * o.z + o.w * o.w);
                o8[4 * h] = o.x * gs.x; o8[4 * h + 1] = o.y * gs.y; o8[4 * h + 2] = o.z * gs.z; o8[4 * h + 3] = o.w * gs.w; }
            store8bf(a2 + 128 * b, o8); }
        q += xorl<16>(q); q = sum32(q);
        if (fq == 0) wsp<float>(p, WS_SSQA)[(size_t)row * 16 + 4 * pn + wc] = q;
    }
};
struct EpiGU {
    static constexpr bool HAS_MID = false; static constexpr int NTYPES = 1;
    Params p;
    DI int type(int, int) const { return 0; }
    DI void midpre(RowPre&, int, int, int, int) const {}
    DI void mid(const RowPre&, int, int, int, int, float (&)[2][8]) const {}
    template <int T> DI void ubegin(ColPre& U, int row0, int pn, int wc, int fq) const { const float* sh = wsp<float>(p, WS_SHW) + (row0 / SEQ) * 5632 + 256 * pn + 32 * wc + 8 * fq;
        U.c[0] = ld4(sh); U.c[1] = ld4(sh + 4); U.c[2] = ld4(sh + 128); U.c[3] = ld4(sh + 132); }
    template <int T> DI void pre(RowPre& R, int row, int, int, int) const { const float* sq = wsp<float>(p, WS_SSQA) + (size_t)row * 16; R.a[0] = ld4(sq); R.a[1] = ld4(sq + 4); R.a[2] = ld4(sq + 8); R.a[3] = ld4(sq + 12); }
    template <int T> DI void apply(const ColPre& U, const RowPre& R, int row, int pn, int wc, int fq, float (&v)[2][8]) const {
        const int s = 4 * pn + wc; float o[8];
        const float tot = (((R.a[0].x + R.a[0].y) + (R.a[0].z + R.a[0].w)) + ((R.a[1].x + R.a[1].y) + (R.a[1].z + R.a[1].w))) + (((R.a[2].x + R.a[2].y) + (R.a[2].z + R.a[2].w)) + ((R.a[3].x + R.a[3].y) + (R.a[3].z + R.a[3].w)));
        const float rstd = rsqrtf(tot * (1.f / DM) + EPS);
#pragma unroll
        for (int j = 0; j < 8; ++j) o[j] = siluf(rstd * v[0][j] + U.c[j >> 2][j & 3]) * (rstd * v[1][j] + U.c[2 + (j >> 2)][j & 3]);
        store8bf(wsp<bf16_t>(p, WS_HID) + (size_t)row * DFF + 32 * s + 8 * fq, o);
    }
};
struct EpiDown {
    static constexpr bool HAS_MID = false; static constexpr int NTYPES = 1;
    Params p;
    DI int type(int, int) const { return 0; }
    DI void midpre(RowPre&, int, int, int, int) const {}
    DI void mid(const RowPre&, int, int, int, int, float (&)[2][8]) const {}
    template <int T> DI void ubegin(ColPre& U, int row0, int pn, int wc, int fq) const { const float* gt = wsp<float>(p, WS_MOD) + (row0 / SEQ) * 6144 + 5 * 1024 + 256 * pn + 32 * wc + 8 * fq;
        U.c[0] = ld4(gt); U.c[1] = ld4(gt + 4); U.c[2] = ld4(gt + 128); U.c[3] = ld4(gt + 132); }
    template <int T> DI void pre(RowPre& R, int row, int pn, int wc, int fq) const { const float* x = wsp<float>(p, WS_R2) + (size_t)row * DM + 256 * pn + 32 * wc + 8 * fq;
        R.a[0] = ld4(x); R.a[1] = ld4(x + 4); R.a[2] = ld4(x + 128); R.a[3] = ld4(x + 132); }
    template <int T> DI void apply(const ColPre& U, const RowPre& R, int row, int pn, int wc, int fq, float (&v)[2][8]) const {
        float* d = p.out + (size_t)row * DM + 256 * pn + 32 * wc + 8 * fq;
#pragma unroll
        for (int b = 0; b < 2; ++b)
#pragma unroll
            for (int h = 0; h < 2; ++h) { const f32x4 g = U.c[2 * b + h], xv = R.a[2 * b + h];
                f32x4 o; o.x = xv.x + g.x * v[b][4 * h]; o.y = xv.y + g.y * v[b][4 * h + 1]; o.z = xv.z + g.z * v[b][4 * h + 2]; o.w = xv.w + g.w * v[b][4 * h + 3]; *(f32x4*)(d + 128 * b + 4 * h) = o; }
    }
};
namespace pg8 {
#define PG8_LAS __attribute__((address_space(3)))
typedef short bf16x8 __attribute__((ext_vector_type(8)));
constexpr int BM = 256, BK = 64, HALF = 128, HTB = HALF * BK * 2  , STAGE_BYTES = 8 * HTB, NXCD = 8, WGM = 8;

__host__ __device__ __forceinline__ int lds_byte(int r, int c) { const int st = (r >> 4) * 2 + (c >> 5), rr = r & 15, cc = c & 31, ob = rr * 64 + cc * 2; return st * 1024 + (ob ^ (((ob >> 9) & 1) << 5)); }
__host__ __device__ __forceinline__ void stage_rc(int b, int& R, int& C) { const int st = b / 1024, sb = b % 1024, swz = sb ^ (((sb >> 9) & 1) << 5); R = (st >> 1) * 16 + swz / 64; C = (st & 1) * 32 + (swz % 64) / 2; }
__host__ __device__ __forceinline__ int perm32(int rho) { const int n = rho >> 4, i = rho & 15; return 8 * (i >> 2) + 4 * n + (i & 3); }

struct Unit { int pm, pn; };
struct Gemm { const bf16_t* A; const bf16_t* Bt; int M, N, K, lda, ldb, kstepA; };

struct StaticOrder {
    int nM, nN, nwg, G, c;
    __host__ __device__ void init(int M, int N, int G_, int c_) { nM = M / BM; nN = N / BM; nwg = nM * nN; G = G_; c = c_; }
    __host__ __device__ bool next(int i, Unit& u) const {
        const long L = (long)i * G + c; if (L >= nwg) return false;
        int wgid = (int)L; { const int q = nwg / NXCD, r = nwg % NXCD, xcd = wgid % NXCD, off = wgid / NXCD; wgid = (xcd < r ? xcd * (q + 1) : r * (q + 1) + (xcd - r) * q) + off; }
        const int nig = WGM * nN, gid = wgid / nig, fm = gid * WGM, gsz = (nM - fm) < WGM ? (nM - fm) : WGM;
        u.pm = fm + ((wgid % nig) % gsz); u.pn = (wgid % nig) / gsz; return true;
    }
    __device__ __forceinline__ void a_ready(const Unit&) const {}
    __device__ __forceinline__ void done(const Unit&) const {}
};

template <class Epi, class Sched, bool ALIGN_EPI = false, bool SP2 = false>
__device__ __forceinline__ void gemm_phase(PG8_LAS unsigned char* lds, const Gemm g, const Sched& S, const Epi& E, int wid0) {
    const int tid = opaque_tid(wid0), wid = __builtin_amdgcn_readfirstlane(tid >> 6), lane = tid & 63, wr = wid >> 2, wc = wid & 3, fr = lane & 15, fq = lane >> 4;
    const int K = g.K; int nt = K / BK; asm volatile("" : "+s"(nt));
    unsigned voffA[2], voffB[2];
#pragma unroll
    for (int i = 0; i < 2; ++i) { int R, C; stage_rc(tid * 16 + i * 8192, R, C); const int Rb = Epi::PERM ? ((R & ~31) + perm32(R & 31)) : R;
        voffA[i] = (unsigned)(R * g.lda + C) * 2u; voffB[i] = (unsigned)(Rb * g.ldb + C) * 2u; }
    const size_t kstep = (size_t)(BK * 2), kstepA = (size_t)g.kstepA;
    const size_t hstepB = (size_t)HALF * g.ldb * 2, hstepA = (size_t)HALF * g.lda * 2;
    const size_t tstepB = 2 * hstepB, tstepA = 2 * hstepA;
    const unsigned ldsw = (unsigned)wid * 1024u;
    const int aoff = lds_byte(wr * 64 + fr, fq * 8), boff = lds_byte(wc * 32 + fr, fq * 8);
#define PG8_SA(b, h) (((b) * 2 + (h)) * HTB)
#define PG8_SB(b, h) ((4 + (b) * 2 + (h)) * HTB)
#define PG8_STAGE(bufoff, gbase, voff) do { _Pragma("unroll") for (int _i = 0; _i < 2; ++_i) \
        __builtin_amdgcn_global_load_lds((const unsigned*)((const char*)(gbase) + (voff)[_i]), (PG8_LAS unsigned*)(lds + (bufoff) + ldsw + _i * 8192), 16, 0, 0); } while (0)
#define PG8_LDA(dst, b, h) do { _Pragma("unroll") for (int m = 0; m < 4; ++m) _Pragma("unroll") for (int k = 0; k < 2; ++k) dst[m][k] = *(const PG8_LAS bf16x8*)(lds + PG8_SA(b, h) + aoff + m * 2048 + k * 1024); } while (0)
#define PG8_LDB(dst, b, h) do { _Pragma("unroll") for (int n = 0; n < 2; ++n) _Pragma("unroll") for (int k = 0; k < 2; ++k) dst[n][k] = *(const PG8_LAS bf16x8*)(lds + PG8_SB(b, h) + boff + n * 2048 + k * 1024); } while (0)
#define PG8_MMA(ai, bj, At, Bt) do { __builtin_amdgcn_s_setprio(1); _Pragma("unroll") for (int m = 0; m < 4; ++m) _Pragma("unroll") for (int n = 0; n < 2; ++n) _Pragma("unroll") for (int k = 0; k < 2; ++k) \
        acc[ai][bj][m][n] = __builtin_amdgcn_mfma_f32_16x16x32_bf16(Bt[n][k], At[m][k], acc[ai][bj][m][n], 0, 0, 0); __builtin_amdgcn_s_setprio(0); } while (0)
#define PG8_WAIT_V(n) asm volatile("s_waitcnt vmcnt(" #n ")" ::: "memory")
#define PG8_WAIT_L(n) asm volatile("s_waitcnt lgkmcnt(" #n ")" ::: "memory")
#define PG8_BAR __builtin_amdgcn_s_barrier()
#define PG8_SCHED __builtin_amdgcn_sched_barrier(0)
    Unit cur, nxt; int ui = 0;
    if (!S.next(0, cur)) return;
    f32x4 acc[2][2][4][2];
#pragma unroll
    for (int a = 0; a < 2; ++a)
#pragma unroll
        for (int b = 0; b < 2; ++b)
#pragma unroll
            for (int m = 0; m < 4; ++m)
#pragma unroll
                for (int n = 0; n < 2; ++n) acc[a][b][m][n] = (f32x4){0.f, 0.f, 0.f, 0.f};
    bf16x8 At[4][2], B0[2][2], B1[2][2];
    const char* cA = (const char*)g.A + (size_t)cur.pm * tstepA; const char* cB = (const char*)g.Bt + (size_t)cur.pn * tstepB;
    S.a_ready(cur);
    if constexpr (SP2) {
        PG8_STAGE(PG8_SB(0, 0), cB, voffB); PG8_STAGE(PG8_SB(0, 1), cB + hstepB, voffB); PG8_STAGE(PG8_SA(0, 0), cA, voffA); PG8_STAGE(PG8_SA(0, 1), cA + hstepA, voffA);
        if (wr == 1) PG8_BAR;
        PG8_WAIT_V(2); PG8_BAR;
        PG8_STAGE(PG8_SB(1, 0), cB + kstep, voffB); PG8_STAGE(PG8_SA(1, 0), cA + kstepA, voffA); PG8_STAGE(PG8_SB(1, 1), cB + hstepB + kstep, voffB);
        PG8_WAIT_V(6); PG8_BAR;
    } else {
        PG8_STAGE(PG8_SB(0, 0), cB, voffB); PG8_STAGE(PG8_SA(0, 0), cA, voffA); PG8_STAGE(PG8_SB(0, 1), cB + hstepB, voffB); PG8_STAGE(PG8_SA(0, 1), cA + hstepA, voffA);
        if (wr == 1) PG8_BAR;
        PG8_WAIT_V(4); PG8_BAR;
        PG8_STAGE(PG8_SB(1, 0), cB + kstep, voffB); PG8_STAGE(PG8_SA(1, 0), cA + kstepA, voffA); PG8_STAGE(PG8_SB(1, 1), cB + hstepB + kstep, voffB);
        PG8_WAIT_V(6); PG8_BAR;
    }
    for (;;) {
        const bool has_next = S.next(ui + 1, nxt);
        const char* nA = has_next ? (const char*)g.A + (size_t)nxt.pm * tstepA : cA; const char* nB = has_next ? (const char*)g.Bt + (size_t)nxt.pn * tstepB : cB;
        for (int hh_ = 0; hh_ < (Epi::HAS_MID ? 2 : 1); ++hh_) {
        if constexpr (Epi::HAS_MID) { if (hh_ == 1) E.mid(acc, cur, wr, wc, fr, fq); }
        const int t0_ = Epi::HAS_MID ? hh_ * (nt >> 1) : 0, t1_ = Epi::HAS_MID ? (hh_ + 1) * (nt >> 1) : nt;
        for (int t = t0_; t < t1_; t += 2) {
            const bool last = (t == nt - 2);
            const char* a1 = cA + (size_t)(t + 1) * kstepA;
            const char* a2 = last ? nA : cA + (size_t)(t + 2) * kstepA; const char* b2 = last ? nB : cB + (size_t)(t + 2) * kstep;
            const char* a3 = a2 + kstepA; const char* b3 = b2 + kstep;
            if (last && has_next) S.a_ready(nxt);
            if constexpr (SP2) {
            PG8_LDB(B0, 0, 0); PG8_LDB(B1, 0, 1); PG8_SCHED; PG8_LDA(At, 0, 0); PG8_STAGE(PG8_SA(1, 1), a1 + hstepA, voffA);
            PG8_WAIT_V(8); PG8_WAIT_L(0); PG8_BAR; PG8_MMA(0, 0, At, B0); PG8_MMA(0, 1, At, B1); PG8_BAR; PG8_SCHED;
            PG8_LDA(At, 0, 1); PG8_STAGE(PG8_SB(0, 0), b2, voffB); PG8_STAGE(PG8_SB(0, 1), b2 + hstepB, voffB); PG8_STAGE(PG8_SA(0, 0), a2, voffA);
            PG8_WAIT_V(8); PG8_WAIT_L(0); PG8_BAR; PG8_MMA(1, 0, At, B0); PG8_MMA(1, 1, At, B1); PG8_BAR; PG8_SCHED;
            PG8_LDB(B0, 1, 0); PG8_LDB(B1, 1, 1); PG8_SCHED; PG8_LDA(At, 1, 0); PG8_STAGE(PG8_SA(0, 1), a2 + hstepA, voffA);
            PG8_WAIT_V(8); PG8_WAIT_L(0); PG8_BAR; PG8_MMA(0, 0, At, B0); PG8_MMA(0, 1, At, B1); PG8_BAR; PG8_SCHED;
            PG8_LDA(At, 1, 1); PG8_STAGE(PG8_SB(1, 0), b3, voffB); PG8_STAGE(PG8_SB(1, 1), b3 + hstepB, voffB); PG8_STAGE(PG8_SA(1, 0), a3, voffA);
            PG8_WAIT_V(8); PG8_WAIT_L(0); PG8_BAR; PG8_MMA(1, 0, At, B0); PG8_MMA(1, 1, At, B1); PG8_BAR; PG8_SCHED;
            } else {
            PG8_LDB(B0, 0, 0); PG8_SCHED; PG8_LDA(At, 0, 0); PG8_STAGE(PG8_SA(1, 1), a1 + hstepA, voffA);
            PG8_WAIT_L(8); PG8_BAR; PG8_WAIT_L(0); PG8_MMA(0, 0, At, B0); PG8_BAR; PG8_SCHED;
            PG8_LDB(B1, 0, 1); PG8_STAGE(PG8_SB(0, 0), b2, voffB);
            PG8_BAR; PG8_WAIT_L(0); PG8_MMA(0, 1, At, B1); PG8_BAR;
            PG8_LDA(At, 0, 1); PG8_STAGE(PG8_SA(0, 0), a2, voffA);
            PG8_BAR; PG8_WAIT_L(0); PG8_MMA(1, 0, At, B0); PG8_BAR; PG8_SCHED;
            PG8_STAGE(PG8_SB(0, 1), b2 + hstepB, voffB);
            PG8_WAIT_V(6); PG8_BAR; PG8_MMA(1, 1, At, B1); PG8_BAR;
            PG8_LDB(B0, 1, 0); PG8_SCHED; PG8_LDA(At, 1, 0); PG8_STAGE(PG8_SA(0, 1), a2 + hstepA, voffA);
            PG8_WAIT_L(8); PG8_BAR; PG8_WAIT_L(0); PG8_MMA(0, 0, At, B0); PG8_BAR; PG8_SCHED;
            PG8_LDB(B1, 1, 1); PG8_STAGE(PG8_SB(1, 0), b3, voffB);
            PG8_BAR; PG8_WAIT_L(0); PG8_MMA(0, 1, At, B1); PG8_BAR;
            PG8_LDA(At, 1, 1); PG8_STAGE(PG8_SA(1, 0), a3, voffA);
            PG8_BAR; PG8_WAIT_L(0); PG8_MMA(1, 0, At, B0); PG8_BAR; PG8_SCHED;
            PG8_STAGE(PG8_SB(1, 1), b3 + hstepB, voffB);
            PG8_WAIT_V(6); PG8_BAR; PG8_MMA(1, 1, At, B1); PG8_BAR;
            }
        }
        }
        if constexpr (ALIGN_EPI) { if (wr == 0) PG8_BAR; }
        if constexpr (!Epi::AFTER_DRAIN) { E(acc, cur, wr, wc, fr, fq); S.done(cur); }
        if (!has_next) break;
#pragma unroll
        for (int a = 0; a < 2; ++a)
#pragma unroll
            for (int b = 0; b < 2; ++b)
#pragma unroll
                for (int m = 0; m < 4; ++m)
#pragma unroll
                    for (int n = 0; n < 2; ++n) acc[a][b][m][n] = (f32x4){0.f, 0.f, 0.f, 0.f};
        cur = nxt; cA = nA; cB = nB; ++ui;
        if constexpr (ALIGN_EPI) { if (wr == 1) PG8_BAR; }
    }
    PG8_WAIT_V(0);
    if constexpr (!ALIGN_EPI) { if (wr == 0) PG8_BAR; }
    PG8_BAR;
    if constexpr (Epi::AFTER_DRAIN) { E.fused(acc, cur, wr, wc, fr, fq, lds, wid, lane); S.done(cur); }
#undef PG8_SA
#undef PG8_SB
#undef PG8_STAGE
#undef PG8_LDA
#undef PG8_LDB
#undef PG8_MMA
#undef PG8_WAIT_V
#undef PG8_WAIT_L
#undef PG8_BAR
#undef PG8_SCHED
}
}

template <class SE> struct EpiAdapt {
    static constexpr bool PERM = true, AFTER_DRAIN = false, HAS_MID = SE::HAS_MID;
    SE se;
    template <int T> DI void run(f32x4 (&acc)[2][2][4][2], const pg8::Unit& u, int wr, int wc, int fr, int fq) const {
        int frr = fr; asm volatile("" : "+v"(frr));
        const int rbase = u.pm * 256 + wr * 64;
        ColPre U; se.template ubegin<T>(U, rbase, u.pn, wc, fq);
        RowPre R[2]; se.template pre<T>(R[0], rbase + frr, u.pn, wc, fq);
#pragma unroll
        for (int it = 0; it < 8; ++it) {
            const int ai = it >> 2, m = it & 3; const int row = rbase + ai * 128 + m * 16 + frr;
            if (it < 7) se.template pre<T>(R[(it + 1) & 1], rbase + ((it + 1) >> 2) * 128 + ((it + 1) & 3) * 16 + frr, u.pn, wc, fq);
            float v[2][8];
#pragma unroll
            for (int bj = 0; bj < 2; ++bj)
#pragma unroll
                for (int n = 0; n < 2; ++n) { v[bj][4 * n] = acc[ai][bj][m][n][0]; v[bj][4 * n + 1] = acc[ai][bj][m][n][1]; v[bj][4 * n + 2] = acc[ai][bj][m][n][2]; v[bj][4 * n + 3] = acc[ai][bj][m][n][3]; }
            se.template apply<T>(U, R[it & 1], row, u.pn, wc, fq, v);
        }
    }
    template <int T> DI void disp(int ty, f32x4 (&acc)[2][2][4][2], const pg8::Unit& u, int wr, int wc, int fr, int fq) const {
        if constexpr (T < SE::NTYPES) { if (ty == T) run<T>(acc, u, wr, wc, fr, fq); else disp<T + 1>(ty, acc, u, wr, wc, fr, fq); }
    }
    DI void operator()(f32x4 (&acc)[2][2][4][2], const pg8::Unit& u, int wr, int wc, int fr, int fq) const { disp<0>(se.type(u.pn, wc), acc, u, wr, wc, fr, fq); }
    DI void mid(f32x4 (&acc)[2][2][4][2], const pg8::Unit& u, int wr, int wc, int fr, int fq) const {
        int frr = fr; asm volatile("" : "+v"(frr));
        const int rbase = u.pm * 256 + wr * 64;
        RowPre R[2]; se.midpre(R[0], rbase + frr, u.pn, wc, fq);
#pragma unroll
        for (int it = 0; it < 8; ++it) {
            const int ai = it >> 2, m = it & 3; const int row = rbase + ai * 128 + m * 16 + frr;
            if (it < 7) se.midpre(R[(it + 1) & 1], rbase + ((it + 1) >> 2) * 128 + ((it + 1) & 3) * 16 + frr, u.pn, wc, fq);
            float v[2][8];
#pragma unroll
            for (int bj = 0; bj < 2; ++bj)
#pragma unroll
                for (int n = 0; n < 2; ++n) { v[bj][4 * n] = acc[ai][bj][m][n][0]; v[bj][4 * n + 1] = acc[ai][bj][m][n][1]; v[bj][4 * n + 2] = acc[ai][bj][m][n][2]; v[bj][4 * n + 3] = acc[ai][bj][m][n][3]; }
            se.mid(R[it & 1], row, u.pn, wc, fq, v);
#pragma unroll
            for (int bj = 0; bj < 2; ++bj)
#pragma unroll
                for (int n = 0; n < 2; ++n) { acc[ai][bj][m][n][0] = v[bj][4 * n]; acc[ai][bj][m][n][1] = v[bj][4 * n + 1]; acc[ai][bj][m][n][2] = v[bj][4 * n + 2]; acc[ai][bj][m][n][3] = v[bj][4 * n + 3]; }
        }
    }
};
template <class SE, bool ALIGN = true> DI void gemm_fast(PG8_LAS unsigned char* lds, const bf16_t* A, int lda, const bf16_t* Bt, int M, int N, int K, const SE& se, int G, int c, int wid0) {
    pg8::Gemm g{A, Bt, M, N, K, lda, K, 128}; pg8::StaticOrder S; S.init(M, N, G, c);
    EpiAdapt<SE> E{se};
    pg8::gemm_phase<EpiAdapt<SE>, pg8::StaticOrder, ALIGN, true>(lds, g, S, E, wid0);
}
struct RangeOrder {
    int base, cnt, nN;
    DI bool next(int i, pg8::Unit& u) const { if (i >= cnt) return false; const int L = base + i; u.pm = L / nN; u.pn = L % nN; return true; }
    DI void a_ready(const pg8::Unit&) const {}
    DI void done(const pg8::Unit&) const {}
};
template <class SE> DI void gemm_fast_range(PG8_LAS unsigned char* lds, const bf16_t* A, int lda, const bf16_t* Bt, int M, int N, int K, const SE& se, int base, int cnt, int wid0) {
    pg8::Gemm g{A, Bt, M, N, K, lda, K, 128}; RangeOrder S{base, cnt, N / 256};
    EpiAdapt<SE> E{se};
    pg8::gemm_phase<EpiAdapt<SE>, RangeOrder, true, true>(lds, g, S, E, wid0);
}
struct OneUnit {
    int pm, pn;
    DI bool next(int i, pg8::Unit& u) const { if (i > 0) return false; u.pm = pm; u.pn = pn; return true; }
    DI void a_ready(const pg8::Unit&) const {}
    DI void done(const pg8::Unit&) const {}
};
struct EpiCmpH {
    static constexpr bool HAS_MID = false; static constexpr int NTYPES = 1;
    float* H;
    DI int type(int, int) const { return 0; }
    DI void midpre(RowPre&, int, int, int, int) const {}
    DI void mid(const RowPre&, int, int, int, int, float (&)[2][8]) const {}
    template <int T> DI void ubegin(ColPre&, int, int, int, int) const {}
    template <int T> DI void pre(RowPre&, int, int, int, int) const {}
    template <int T> DI void apply(const ColPre&, const RowPre&, int row, int pn, int wc, int fq, float (&v)[2][8]) const {
        float* d = H + (size_t)row * 256 + 32 * wc + 8 * fq;
#pragma unroll
        for (int b = 0; b < 2; ++b) { st16f(d + 128 * b, (f32x4){v[b][0], v[b][1], v[b][2], v[b][3]}); st16f(d + 128 * b + 4, (f32x4){v[b][4], v[b][5], v[b][6], v[b][7]}); }
    }
};
DI void cmp_hidden_fast(const Params& p, PG8_LAS unsigned char* lds, int cu, int wid0) {
    const int kv = cu >> 4, g = (cu >> 3) & 1, pm = (cu >> 1) & 3, sp = cu & 1;
    const bf16_t* A = wsp<bf16_t>(p, kv ? WS_VC : WS_KC) + g * 64 + (size_t)(16 * sp) * 128;
    const bf16_t* Bt = wsp<bf16_t>(p, WS_CW1) + (size_t)kv * 256 * 2048 + 1024 * sp;
    pg8::Gemm gm{A, Bt, 1024, 256, 1024, 2048, 2048, 256}; OneUnit S{pm, 0};
    EpiCmpH se{wsp<float>(p, WS_CMPH) + (size_t)((kv * 2 + g) * 2 + sp) * 1024 * 256};
    EpiAdapt<EpiCmpH> E{se};
    pg8::gemm_phase<EpiAdapt<EpiCmpH>, OneUnit, true, true>(lds, gm, S, E, wid0);
}
template <bool SPLIT> DI void cmp_out(const Params& p, int gw, int ngw, int lane) {
    const float* H = wsp<float>(p, WS_CMPH);
    for (int u = gw; u < 2 * 2 * 1024; u += ngw) {
        const int r = u & 1023, g = (u >> 10) & 1, kv = u >> 11; const int b = r >> 7, n = r & 127;
        bf16_t* dst = wsp<bf16_t>(p, kv ? WS_VCF : WS_KCF) + (size_t)r * 128 + g * 64 + lane;
        if (n == 127) { *dst = 0; continue; }
        const float* w2 = (kv ? p.in[I_CW2V] : p.in[I_CW2K]) + lane;
        float acc = 0.f;
        if constexpr (SPLIT) {
            const float* h = H + ((size_t)((kv * 2 + g) * 2) * 1024 + r) * 256; const float* cb = wsp<float>(p, WS_CB1) + kv * 256;
            float hv[4];
#pragma unroll
            for (int q = 0; q < 4; ++q) { const int j = 64 * q + lane; hv[q] = siluf((h[j] + h[(size_t)1024 * 256 + j]) + cb[j]); }
#pragma unroll
            for (int q = 0; q < 4; ++q)
#pragma unroll
                for (int jj = 0; jj < 64; ++jj) acc += __int_as_float(__builtin_amdgcn_readlane(__float_as_int(hv[q]), jj)) * w2[(64 * q + jj) * 64];
        } else {
            const float* h = H + (size_t)u * 256;
            for (int j = 0; j < 256; ++j) acc += h[j] * w2[j * 64];
        }
        if (kv == 0) {
            const float rstd = rsqrtf(wave_sum(acc * acc) * (1.f / 64.f) + EPS);
            float y = acc * rstd * p.in[I_NKCG][lane];
            const int prow = b * SEQ + 16 * n + 31; const float oth = xorl<8>(y);
            if (lane < 16) { const float c = ropeCN(p)[(size_t)prow * 8 + (lane & 7)], s = ropeSN(p)[(size_t)prow * 8 + (lane & 7)]; y = (lane < 8) ? y * c - oth * s : y * c + oth * s; }
            acc = y;
        }
        *dst = (bf16_t)f2bf(acc);
    }
}

DI unsigned select_blocks(const float (&imp)[32], int cur) {
    if (cur < 8) return (2u << cur) - 1u;
    unsigned mask = 1u | (1u << cur) | (1u << (cur - 1));
#pragma unroll 1
    for (int it = 0; it < 5; ++it) {
        float best = -1.0f; int bi = 1;
#pragma unroll
        for (int j = 1; j < 32; ++j) { const bool ok = (j <= cur - 2) && !((mask >> j) & 1u); if (ok && imp[j] > best) { best = imp[j]; bi = j; } }
        mask |= 1u << bi;
    }
    return mask;
}

namespace fa {
typedef short bf16x8 __attribute__((ext_vector_type(8)));
typedef short s16x4 __attribute__((ext_vector_type(4)));
typedef float f32x16 __attribute__((ext_vector_type(16)));
typedef LAS const char* lds_cptr;
typedef LAS char* lds_ptr;
constexpr int KBUF = 12288, VBUF = 8192;
constexpr int L_K = 0, L_V = 2 * KBUF, L_WS = 3 * 12288 + 2 * 8192, L_OST = L_WS + 8 * 256, L_END = L_OST + 8 * 8192;
static_assert(L_V + 2 * VBUF <= L_WS && L_END <= 131072, "attention LDS map");
#define FA_SBAR() __builtin_amdgcn_sched_barrier(0)
DI int crow(int r, int hi) { return (r & 3) + 8 * (r >> 2) + 4 * hi; }
typedef float f32x2_t __attribute__((ext_vector_type(2))); typedef __bf16 bf16x2_t __attribute__((ext_vector_type(2)));
DI unsigned cvtpk(float lo, float hi) { f32x2_t v = {lo, hi}; bf16x2_t b = __builtin_convertvector(v, bf16x2_t); return __builtin_bit_cast(unsigned, b); }

template <int DK> DI void qkt(f32x16& p0, f32x16& p1, lds_cptr kb, const bf16x8* qr) {
    f32x16 z;
#pragma unroll
    for (int i = 0; i < 16; ++i) z[i] = 0.f;
#pragma unroll
    for (int d0 = 0; d0 < DK / 16; ++d0) {
        const bf16x8 b0 = *(const LAS bf16x8*)(kb + d0 * 2048);
        const bf16x8 b1 = *(const LAS bf16x8*)(kb + d0 * 2048 + 512);
        if (d0 == 0) { p0 = __builtin_amdgcn_mfma_f32_32x32x16_bf16(b0, qr[0], z, 0, 0, 0); p1 = __builtin_amdgcn_mfma_f32_32x32x16_bf16(b1, qr[0], z, 0, 0, 0); }
        else { p0 = __builtin_amdgcn_mfma_f32_32x32x16_bf16(b0, qr[d0], p0, 0, 0, 0); p1 = __builtin_amdgcn_mfma_f32_32x32x16_bf16(b1, qr[d0], p1, 0, 0, 0); }
    }
}
typedef short v4i16_t __attribute__((ext_vector_type(4)));
DI s16x4 vtr(int addr) { return __builtin_bit_cast(s16x4, __builtin_amdgcn_ds_read_tr16_b64_v4i16((LAS v4i16_t*)(uintptr_t)(unsigned)addr)); }
DI bf16x8 vfrag(int addr) { const s16x4 lo = vtr(addr), hi = vtr(addr + 512); return (bf16x8){lo[0], lo[1], lo[2], lo[3], hi[0], hi[1], hi[2], hi[3]}; }
DI void pv(f32x16* o, int vb, bf16x8 pa0, bf16x8 pa1, bf16x8 pa2, bf16x8 pa3) {
#pragma unroll
    for (int d0 = 0; d0 < 2; ++d0) { s16x4 lo[4], hi[4];
#pragma unroll
        for (int ks = 0; ks < 4; ++ks) { lo[ks] = vtr(vb + d0 * 4096 + ks * 1024); hi[ks] = vtr(vb + d0 * 4096 + ks * 1024 + 512); }
#define FA_PK(k) (bf16x8){lo[k][0], lo[k][1], lo[k][2], lo[k][3], hi[k][0], hi[k][1], hi[k][2], hi[k][3]}
        o[d0] = __builtin_amdgcn_mfma_f32_32x32x16_bf16(pa0, FA_PK(0), o[d0], 0, 0, 0);
        o[d0] = __builtin_amdgcn_mfma_f32_32x32x16_bf16(pa1, FA_PK(1), o[d0], 0, 0, 0);
        o[d0] = __builtin_amdgcn_mfma_f32_32x32x16_bf16(pa2, FA_PK(2), o[d0], 0, 0, 0);
        o[d0] = __builtin_amdgcn_mfma_f32_32x32x16_bf16(pa3, FA_PK(3), o[d0], 0, 0, 0);
#undef FA_PK
    }
}
DI void pack_p(const f32x16& p0, const f32x16& p1, bf16x8& a0, bf16x8& a1, bf16x8& a2, bf16x8& a3) {
    u32x4 w0, w1, w2, w3;
    w0.x = cvtpk(p0[0], p0[1]); w0.y = cvtpk(p0[2], p0[3]); w0.z = cvtpk(p0[4], p0[5]); w0.w = cvtpk(p0[6], p0[7]);
    w1.x = cvtpk(p0[8], p0[9]); w1.y = cvtpk(p0[10], p0[11]); w1.z = cvtpk(p0[12], p0[13]); w1.w = cvtpk(p0[14], p0[15]);
    w2.x = cvtpk(p1[0], p1[1]); w2.y = cvtpk(p1[2], p1[3]); w2.z = cvtpk(p1[4], p1[5]); w2.w = cvtpk(p1[6], p1[7]);
    w3.x = cvtpk(p1[8], p1[9]); w3.y = cvtpk(p1[10], p1[11]); w3.z = cvtpk(p1[12], p1[13]); w3.w = cvtpk(p1[14], p1[15]);
    a0 = __builtin_bit_cast(bf16x8, w0); a1 = __builtin_bit_cast(bf16x8, w1); a2 = __builtin_bit_cast(bf16x8, w2); a3 = __builtin_bit_cast(bf16x8, w3);
}
DI void mask_range(f32x16& p0, f32x16& p1, int key0, int lo, int hi_, int hf) {
#pragma unroll
    for (int r = 0; r < 16; ++r) { const int k = key0 + crow(r, hf); if (k < lo || k > hi_) p0[r] = -INFINITY; if (k + 32 < lo || k + 32 > hi_) p1[r] = -INFINITY; }
}
DI float max3(float a, float b, float c) { return fmaxf(fmaxf(a, b), c); }
DI float rowmax32(const f32x16& p0, const f32x16& p1) {
    float a = max3(p0[0], p0[1], p0[2]), b = max3(p0[3], p0[4], p0[5]), c = max3(p0[6], p0[7], p0[8]), d = max3(p0[9], p0[10], p0[11]);
    a = max3(a, p0[12], p0[13]); b = max3(b, p0[14], p0[15]); c = max3(c, p1[0], p1[1]); d = max3(d, p1[2], p1[3]);
    a = max3(a, p1[4], p1[5]); b = max3(b, p1[6], p1[7]); c = max3(c, p1[8], p1[9]); d = max3(d, p1[10], p1[11]);
    a = max3(a, p1[12], p1[13]); b = max3(b, p1[14], p1[15]);
    return max32(fmaxf(fmaxf(a, b), fmaxf(c, d)));
}
struct State { float m, l; f32x16 o[2]; };
DI void st_init(State& s) { s.m = -INFINITY; s.l = 0.f;
#pragma unroll
    for (int i = 0; i < 16; ++i) { s.o[0][i] = 0.f; s.o[1][i] = 0.f; } }
DI void softmax_pv(State& st, f32x16& p0, f32x16& p1, int vb, LAS float* wsf, int r32, int hf) {
    const float rm = rowmax32(p0, p1);
    const float mn = fmaxf(st.m, rm), mu = (mn == -INFINITY) ? 0.f : mn;
    const float alpha = __builtin_amdgcn_exp2f(st.m - mu);
    st.m = mn;
    float ls0 = 0.f, ls1 = 0.f, ls2 = 0.f, ls3 = 0.f;
#pragma unroll
    for (int r = 0; r < 16; r += 2) { p0[r] = __builtin_amdgcn_exp2f(p0[r] - mu); p1[r] = __builtin_amdgcn_exp2f(p1[r] - mu); p0[r + 1] = __builtin_amdgcn_exp2f(p0[r + 1] - mu); p1[r + 1] = __builtin_amdgcn_exp2f(p1[r + 1] - mu);
        ls0 += p0[r]; ls1 += p1[r]; ls2 += p0[r + 1]; ls3 += p1[r + 1]; }
    st.l = st.l * alpha + ((ls0 + ls1) + (ls2 + ls3));
    if (__any(alpha != 1.0f)) {
        if (hf == 0) wsf[r32] = alpha;
        asm volatile("s_waitcnt lgkmcnt(0)" ::: "memory");
#pragma unroll
        for (int g = 0; g < 4; ++g) { const f32x4 a = *(const LAS f32x4*)(wsf + 8 * g + 4 * hf);
            st.o[0][4 * g] *= a.x; st.o[0][4 * g + 1] *= a.y; st.o[0][4 * g + 2] *= a.z; st.o[0][4 * g + 3] *= a.w;
            st.o[1][4 * g] *= a.x; st.o[1][4 * g + 1] *= a.y; st.o[1][4 * g + 2] *= a.z; st.o[1][4 * g + 3] *= a.w; }
    }
    bf16x8 a0, a1, a2, a3; pack_p(p0, p1, a0, a1, a2, a3);
    pv(st.o, vb, a0, a1, a2, a3);
}
DI void accum_scaled(f32x16* acc, const f32x16* o, float fac_row, LAS float* wsf, int r32, int hf) {
    if (hf == 0) wsf[32 + r32] = fac_row;
    asm volatile("s_waitcnt lgkmcnt(0)" ::: "memory");
#pragma unroll
    for (int g = 0; g < 4; ++g) { const f32x4 a = *(const LAS f32x4*)(wsf + 32 + 8 * g + 4 * hf);
        acc[0][4 * g] += o[0][4 * g] * a.x; acc[0][4 * g + 1] += o[0][4 * g + 1] * a.y; acc[0][4 * g + 2] += o[0][4 * g + 2] * a.z; acc[0][4 * g + 3] += o[0][4 * g + 3] * a.w;
        acc[1][4 * g] += o[1][4 * g] * a.x; acc[1][4 * g + 1] += o[1][4 * g + 1] * a.y; acc[1][4 * g + 2] += o[1][4 * g + 2] * a.z; acc[1][4 * g + 3] += o[1][4 * g + 3] * a.w; }
}
template <bool FIRST> DI void accum_lds(LAS float* accw, const f32x16* o, float fac_row, LAS float* wsf, int r32, int hf) {
    if (hf == 0) wsf[32 + r32] = fac_row;
    asm volatile("s_waitcnt lgkmcnt(0)" ::: "memory");
#pragma unroll
    for (int r = 0; r < 16; ++r) { const int orow = crow(r, hf); const float a = wsf[32 + orow];
        LAS float* d0 = accw + orow * 64 + r32; LAS float* d1 = d0 + 32;
        if (FIRST) { *d0 = o[0][r] * a; *d1 = o[1][r] * a; } else { *d0 += o[0][r] * a; *d1 += o[1][r] * a; } }
}
DI void stage_rows(const f32x16* acc, LAS bf16_t* stg, int r32, int hf) {
#pragma unroll
    for (int r = 0; r < 16; ++r) { const int orow = crow(r, hf);
        stg[orow * 64 + r32] = (bf16_t)f2bf(acc[0][r]); stg[orow * 64 + 32 + r32] = (bf16_t)f2bf(acc[1][r]); }
    asm volatile("s_waitcnt lgkmcnt(0)" ::: "memory");
}

struct TileSrc { const bf16_t* k; const bf16_t* k2; const bf16_t* v; long kstep, vstep; };
#ifndef FA_THRL
#define FA_THRL 8.0f
#endif
template <int DK, class MaskF>
DI void pipe_attn(LAS unsigned char* lds, const TileSrc src, int T, const bf16x8 (&qr)[DK / 16], const MaskF& maskf, f32x16 (&o)[2], float& l_out,
                  int wv, int lane, int r32, int hf, LAS float* wsf) {
    constexpr int KB = DK * 128;
    constexpr int PL_V = 3 * KB;
    const LAS unsigned char* kfrag0 = lds + L_K + hf * 1024 + r32 * 16;
    const int vfrag0 = (int)(uintptr_t)(lds + L_K + PL_V) + ((lane >> 4) & 1) * 32 + (lane & 3) * 8 + (4 * hf + ((lane & 15) >> 2)) * 64;
    LAS unsigned char* kst0 = lds + L_K + wv * 1024 + lane * 16; LAS unsigned char* vst0 = lds + L_K + PL_V + wv * 1024 + lane * 16;
    u32x4 kreg, kreg2, vreg;
    const bool k2on = (DK == 96) && (wv < 4);
#define PL_KLOAD(i) do { kreg = *(const u32x4*)(src.k + (long)(i) * src.kstep); if (k2on) kreg2 = *(const u32x4*)(src.k2 + (long)(i) * src.kstep); } while (0)
#define PL_KSTORE(buf) do { *(LAS u32x4*)(kst0 + (buf) * KB) = kreg; if (k2on) *(LAS u32x4*)(kst0 + (buf) * KB + 8192) = kreg2; } while (0)
#define PL_VLOAD(i) (vreg = *(const u32x4*)(src.v + (long)(i) * src.vstep))
    __syncthreads();
    { u32x4 ka_, kb_, kc_, ka2_, kb2_, kc2_; const int t1 = (T > 1) ? 1 : 0, t2 = (T > 2) ? 2 : 0;
      ka_ = *(const u32x4*)(src.k); kb_ = *(const u32x4*)(src.k + (long)t1 * src.kstep); kc_ = *(const u32x4*)(src.k + (long)t2 * src.kstep); PL_VLOAD(0);
      if (k2on) { ka2_ = *(const u32x4*)(src.k2); kb2_ = *(const u32x4*)(src.k2 + (long)t1 * src.kstep); kc2_ = *(const u32x4*)(src.k2 + (long)t2 * src.kstep); }
      *(LAS u32x4*)(kst0) = ka_; *(LAS u32x4*)(kst0 + KB) = kb_; *(LAS u32x4*)(kst0 + 2 * KB) = kc_; *(LAS u32x4*)(vst0) = vreg;
      if (k2on) { *(LAS u32x4*)(kst0 + 8192) = ka2_; *(LAS u32x4*)(kst0 + KB + 8192) = kb2_; *(LAS u32x4*)(kst0 + 2 * KB + 8192) = kc2_; } }
    if (T > 3) PL_KLOAD(3);
    if (T > 1) PL_VLOAD(1);
    __syncthreads();
    float mhat, l_reg = 0.f; f32x16 negm; bool resc = false;
    f32x16 pA0, pA1, pB0, pB1;
#pragma unroll
    for (int i = 0; i < 16; ++i) { o[0][i] = 0.f; o[1][i] = 0.f; }
    qkt<DK>(pA0, pA1, (lds_cptr)kfrag0, qr); maskf(pA0, pA1, 0);
    { const float rm = rowmax32(pA0, pA1); mhat = rm;
#pragma unroll
      for (int r = 0; r < 16; ++r) { pA0[r] = __builtin_amdgcn_exp2f(pA0[r] - rm); pA1[r] = __builtin_amdgcn_exp2f(pA1[r] - rm); negm[r] = -rm; }
      asm volatile("" : "+v"(negm)); }
    __syncthreads();
    u32x4 pw0, pw1, pw2, pw3;
    int kb_cur = 1, kb_st = 0, vb_prev = 0;
#define PL_PIN(x) asm volatile("" : "+v"(x))
#define PL_SB() __builtin_amdgcn_sched_barrier(0)
#define PL_KF(j) (*(const LAS bf16x8*)(kp_ + ((j) >> 1) * 2048 + ((j) & 1) * 512))
#define PL_VF(i) vfrag(vp_ + ((i) >> 2) * 4096 + ((i) & 3) * 1024)
#define PL_PAF(k) __builtin_bit_cast(bf16x8, pw##k)
#define PL_WORK(A0, A1, A2, A3, W0, W1, PW) do { sacc += A0; sacc += A1; sacc += A2; sacc += A3; PL_PIN(sacc); W0; W1; PL_PIN(PW); } while (0)
#define PL_GAPB(MF, X, B) do { MF; X[B] = __builtin_amdgcn_exp2f(X[B]); X[B + 1] = __builtin_amdgcn_exp2f(X[B + 1]); X[B + 2] = __builtin_amdgcn_exp2f(X[B + 2]); X[B + 3] = __builtin_amdgcn_exp2f(X[B + 3]); PL_PIN(X); PL_SB(); } while (0)
#define PL_MF(a, b, c) __builtin_amdgcn_mfma_f32_32x32x16_bf16(a, b, c, 0, 0, 0)
#define PL_STEP(C0, C1, P0, P1, t) do { const int t_ = (t); \
        if (t_ + 2 < T) PL_KSTORE(kb_st); \
        *(LAS u32x4*)(vst0 + (vb_prev ^ 1) * 8192) = vreg; \
        if (t_ + 3 < T) PL_KLOAD(t_ + 3); if (t_ + 1 < T) PL_VLOAD(t_ + 1); \
        PL_SB(); const LAS unsigned char* kp_ = kfrag0 + kb_cur * KB; const int vp_ = vfrag0 + vb_prev * 8192; \
        bf16x8 k0 = PL_KF(0), k1 = PL_KF(1), k2 = PL_KF(2); PL_SB(); float sacc = (P0[0] + P0[1]); \
        C0 = PL_MF(k0, qr[0], negm); k0 = PL_KF(3); PL_WORK(P0[2], P0[3], P0[4], P0[5],     pw0[0] = cvtpk(P0[0], P0[1]),   pw0[1] = cvtpk(P0[2], P0[3]),   pw0); PL_SB(); \
        C1 = PL_MF(k1, qr[0], negm); k1 = PL_KF(4); PL_WORK(P0[6], P0[7], P0[8], P0[9],     pw0[2] = cvtpk(P0[4], P0[5]),   pw0[3] = cvtpk(P0[6], P0[7]),   pw0); PL_SB(); \
        C0 = PL_MF(k2, qr[1], C0);   k2 = PL_KF(5); PL_WORK(P0[10], P0[11], P0[12], P0[13], pw1[0] = cvtpk(P0[8], P0[9]),   pw1[1] = cvtpk(P0[10], P0[11]), pw1); PL_SB(); \
        C1 = PL_MF(k0, qr[1], C1);   k0 = PL_KF(6); PL_WORK(P0[14], P0[15], P1[0], P1[1],   pw1[2] = cvtpk(P0[12], P0[13]), pw1[3] = cvtpk(P0[14], P0[15]), pw1); PL_SB(); \
        C0 = PL_MF(k1, qr[2], C0);   k1 = PL_KF(7); PL_WORK(P1[2], P1[3], P1[4], P1[5],     pw2[0] = cvtpk(P1[0], P1[1]),   pw2[1] = cvtpk(P1[2], P1[3]),   pw2); PL_SB(); \
        C1 = PL_MF(k2, qr[2], C1);   if (DK == 96) k2 = PL_KF(8); PL_WORK(P1[6], P1[7], P1[8], P1[9],     pw2[2] = cvtpk(P1[4], P1[5]),   pw2[3] = cvtpk(P1[6], P1[7]),   pw2); PL_SB(); \
        C0 = PL_MF(k0, qr[3], C0);   if (DK == 96) k0 = PL_KF(9); PL_WORK(P1[10], P1[11], P1[12], P1[13], pw3[0] = cvtpk(P1[8], P1[9]),   pw3[1] = cvtpk(P1[10], P1[11]), pw3); PL_SB(); \
        C1 = PL_MF(k1, qr[3], C1);   if (DK == 96) k1 = PL_KF(10); PL_WORK(P1[14], P1[15], 0.f, 0.f,       pw3[2] = cvtpk(P1[12], P1[13]), pw3[3] = cvtpk(P1[14], P1[15]), pw3); PL_SB(); \
        if (DK == 96) { C0 = PL_MF(k2, qr[DK / 16 - 2], C0); k2 = PL_KF(11); PL_SB(); C1 = PL_MF(k0, qr[DK / 16 - 2], C1); PL_SB(); C0 = PL_MF(k1, qr[DK / 16 - 1], C0); PL_SB(); C1 = PL_MF(k2, qr[DK / 16 - 1], C1); PL_SB(); } \
        l_reg += sacc; \
        bf16x8 v0 = PL_VF(0), v1 = PL_VF(4), v2 = PL_VF(1); \
        maskf(C0, C1, t_); \
        { const float rm = rowmax32(C0, C1); resc = false; \
          if (__builtin_expect(__any(rm > FA_THRL), 0)) { const float dl = fmaxf(rm, 0.f); mhat += dl; \
              _Pragma("unroll") for (int r = 0; r < 16; ++r) { C0[r] -= dl; C1[r] -= dl; } \
              _Pragma("unroll") for (int r = 0; r < 16; ++r) negm[r] = -mhat; \
              asm volatile("" : "+v"(negm)); \
              const float f_ = __builtin_amdgcn_exp2f(-dl); l_reg *= f_; if (hf == 0) wsf[r32] = f_; resc = true; } } \
        PL_SB(); \
        PL_GAPB(o[0] = PL_MF(PL_PAF(0), v0, o[0]); v0 = PL_VF(5), C0, 0); \
        PL_GAPB(o[1] = PL_MF(PL_PAF(0), v1, o[1]); v1 = PL_VF(2), C0, 4); \
        PL_GAPB(o[0] = PL_MF(PL_PAF(1), v2, o[0]); v2 = PL_VF(6), C0, 8); \
        PL_GAPB(o[1] = PL_MF(PL_PAF(1), v0, o[1]); v0 = PL_VF(3), C0, 12); \
        PL_GAPB(o[0] = PL_MF(PL_PAF(2), v1, o[0]); v1 = PL_VF(7), C1, 0); \
        PL_GAPB(o[1] = PL_MF(PL_PAF(2), v2, o[1]), C1, 4); \
        PL_GAPB(o[0] = PL_MF(PL_PAF(3), v0, o[0]), C1, 8); \
        PL_GAPB(o[1] = PL_MF(PL_PAF(3), v1, o[1]), C1, 12); \
        __syncthreads(); \
        if (resc) { \
            _Pragma("unroll") for (int g_ = 0; g_ < 4; ++g_) { const f32x4 a_ = *(const LAS f32x4*)(wsf + 8 * g_ + 4 * hf); \
                o[0][4 * g_] *= a_.x; o[0][4 * g_ + 1] *= a_.y; o[0][4 * g_ + 2] *= a_.z; o[0][4 * g_ + 3] *= a_.w; o[1][4 * g_] *= a_.x; o[1][4 * g_ + 1] *= a_.y; o[1][4 * g_ + 2] *= a_.z; o[1][4 * g_ + 3] *= a_.w; } } \
        kb_cur = (kb_cur == 2) ? 0 : kb_cur + 1; kb_st = (kb_st == 2) ? 0 : kb_st + 1; vb_prev ^= 1; \
    } while (0)
    int t = 1;
    for (; t + 1 < T; t += 2) { PL_STEP(pB0, pB1, pA0, pA1, t); PL_STEP(pA0, pA1, pB0, pB1, t + 1); }
    const bool tail = t < T;
    if (tail) PL_STEP(pB0, pB1, pA0, pA1, t);
#define PL_DRAIN(P0, P1) do { float sacc = 0.f; _Pragma("unroll") for (int r = 0; r < 16; ++r) sacc += P0[r] + P1[r]; l_reg += sacc; \
        bf16x8 a0_, a1_, a2_, a3_; pack_p(P0, P1, a0_, a1_, a2_, a3_); pv(o, vfrag0 + vb_prev * 8192, a0_, a1_, a2_, a3_); } while (0)
    if (tail) PL_DRAIN(pB0, pB1); else PL_DRAIN(pA0, pA1);
    l_out = l_reg;
    __syncthreads();
#undef PL_KLOAD
#undef PL_KSTORE
#undef PL_VLOAD
#undef PL_PIN
#undef PL_SB
#undef PL_KF
#undef PL_VF
#undef PL_PAF
#undef PL_WORK
#undef PL_GAPB
#undef PL_MF
#undef PL_STEP
#undef PL_DRAIN
}

DI void mla_unit(const Params& p, LAS unsigned char* lds, int b, int h, int qb, int wid0) {
    const int tid = opaque_tid(wid0), lane = tid & 63, r32 = lane & 31, hf = lane >> 5; const int wv = __builtin_amdgcn_readfirstlane(tid >> 6);
    const bf16_t* KN = wsp<bf16_t>(p, WS_KN); const bf16_t* VM = wsp<bf16_t>(p, WS_VM); bf16_t* OC = wsp<bf16_t>(p, WS_R1);
    const int rowbase = b * SEQ, q0 = qb * 256, tq = q0 + wv * 32 + r32, row = rowbase + tq;
    LAS float* wsf = (LAS float*)(lds + L_WS) + wv * 64;
    bf16x8 qr[6];
    {
        const bf16_t* src = wsp<bf16_t>(p, WS_R0) + (size_t)row * 768 + h * 96 + 8 * hf; float q[6][8]; float ss = 0.f;
#pragma unroll
        for (int d0 = 0; d0 < 6; ++d0) { unpack8(*(const u32x4*)(src + 16 * d0), q[d0]);
#pragma unroll
            for (int e = 0; e < 8; ++e) ss += q[d0][e] * q[d0][e]; }
        ss = sum32(ss);
        const float rstd = rsqrtf(ss * (1.f / 96.f) + EPS); const float* qg = p.in[I_MQG] + 8 * hf; const float* kg = p.in[I_MKG] + 8 * hf;
#pragma unroll
        for (int d0 = 0; d0 < 6; ++d0)
#pragma unroll
            for (int e = 0; e < 8; ++e) q[d0][e] *= rstd * qg[16 * d0 + e];
        const float* cs = ropeCM(p) + (size_t)row * 16 + 8 * hf; const float* sn = ropeSM(p) + (size_t)row * 16 + 8 * hf;
#pragma unroll
        for (int e = 0; e < 8; ++e) { const float x1 = q[4][e], x2 = q[5][e]; q[4][e] = x1 * cs[e] - x2 * sn[e]; q[5][e] = x2 * cs[e] + x1 * sn[e]; }
#pragma unroll
        for (int d0 = 0; d0 < 6; ++d0) { float f[8];
#pragma unroll
            for (int e = 0; e < 8; ++e) f[e] = q[d0][e] * ((d0 < 4) ? kg[16 * d0 + e] * C2M : C2M);
            qr[d0] = __builtin_bit_cast(bf16x8, pack8(f)); }
    }
    const int NT = 4 * (qb + 1);
    TileSrc src; src.k = KN + (size_t)(rowbase + lane) * 768 + h * 96 + wv * 8; src.k2 = src.k + 64; src.kstep = 64 * 768;
    src.v = VM + (size_t)(rowbase + 16 * (wv & 3) + (lane >> 2)) * 512 + h * 64 + (wv >> 2) * 32 + (lane & 3) * 8; src.vstep = 64 * 512;
    const int qlo = q0 + wv * 32;
    auto mk = [&](f32x16& p0, f32x16& p1, int i) { if (i * 64 + 63 > qlo) mask_range(p0, p1, i * 64, 0, tq, hf); };
    f32x16 ob[2]; float lb;
    pipe_attn<96>(lds, src, NT, qr, mk, ob, lb, wv, lane, r32, hf, wsf);
    const float lt = sum32(lb);
    f32x16 acc[2];
#pragma unroll
    for (int i = 0; i < 16; ++i) { acc[0][i] = 0.f; acc[1][i] = 0.f; }
    accum_scaled(acc, ob, 1.0f / lt, wsf, r32, hf);
    LAS bf16_t* stg = (LAS bf16_t*)(lds + L_OST) + wv * 4096;
    stage_rows(acc, stg, r32, hf);
#pragma unroll
    for (int i = 0; i < 4; ++i) { const int rr = i * 8 + (lane >> 3), ch = lane & 7; const u32x4 v = *(const LAS u32x4*)(stg + rr * 64 + ch * 8);
        st16(OC + (size_t)(rowbase + q0 + wv * 32 + rr) * 1024 + h * 64 + ch * 8, v); }
}

DI void nsa_unit(const Params& p, LAS unsigned char* lds, int b, int g, int c, int wid0) {
    const int tid = opaque_tid(wid0), lane = tid & 63, r32 = lane & 31, hf = lane >> 5; const int wv = __builtin_amdgcn_readfirstlane(tid >> 6);
    const bf16_t* QN = wsp<bf16_t>(p, WS_QN); const bf16_t* KCF = wsp<bf16_t>(p, WS_KCF); const bf16_t* VCF = wsp<bf16_t>(p, WS_VCF);
    const bf16_t* KS = wsp<bf16_t>(p, WS_KS); const bf16_t* VS = wsp<bf16_t>(p, WS_VS); const bf16_t* KW = wsp<bf16_t>(p, WS_KW); const bf16_t* VW = wsp<bf16_t>(p, WS_VW);
    const bf16_t* GN = wsp<bf16_t>(p, WS_GN); bf16_t* OC = wsp<bf16_t>(p, WS_R1);
    const int rowbase = b * SEQ, tt = 8 * wv + (r32 >> 2), hd = g * 4 + (r32 & 3), tq = 64 * c + tt, row = rowbase + tq;
    LAS float* wsf = (LAS float*)(lds + L_WS) + wv * 64;
    bf16x8 qr[4];
#pragma unroll
    for (int d0 = 0; d0 < 4; ++d0) qr[d0] = *(const bf16x8*)(QN + (size_t)row * 512 + hd * 64 + 16 * d0 + 8 * hf);
    LAS float* accw = (LAS float*)(lds + L_OST) + wv * 2048;
    const int vboff = ((lane >> 4) & 1) * 32 + (lane & 3) * 8 + (4 * hf + ((lane & 15) >> 2)) * 64;
    u32x4 ka, vv;
#define NSA_LOAD(KB, VB, krow0) do { ka = *(const u32x4*)((KB) + (size_t)((krow0) + lane) * 128 + g * 64 + wv * 8); \
        vv = *(const u32x4*)((VB) + (size_t)((krow0) + 16 * (wv & 3) + (lane >> 2)) * 128 + g * 64 + (wv >> 2) * 32 + (lane & 3) * 8); } while (0)
#define NSA_STORE(koff, voff) do { *(LAS u32x4*)(lds + (koff) + wv * 1024 + lane * 16) = ka; *(LAS u32x4*)(lds + (voff) + wv * 1024 + lane * 16) = vv; } while (0)
    unsigned selmask;
    {
        const int ntile = (4 * c + 3 > 64) ? 2 : 1;
        const int nmax = (tq >= 31) ? ((tq - 31) >> 4) : -1;
        __syncthreads();
        { NSA_LOAD(KCF, VCF, b * 128); const u32x4 ka1_ = ka, vv1_ = vv; if (ntile == 2) NSA_LOAD(KCF, VCF, b * 128 + 64);
          *(LAS u32x4*)(lds + L_K + wv * 1024 + lane * 16) = ka1_; *(LAS u32x4*)(lds + L_V + wv * 1024 + lane * 16) = vv1_; if (ntile == 2) NSA_STORE(L_K + 8192, L_V + 8192); }
        __syncthreads();
        f32x16 pa0, pa1, pb0, pb1;
        qkt<64>(pa0, pa1, (lds_cptr)(lds + L_K) + hf * 1024 + r32 * 16, qr); mask_range(pa0, pa1, 0, 0, nmax, hf);
        float m = rowmax32(pa0, pa1);
        if (ntile == 2) { qkt<64>(pb0, pb1, (lds_cptr)(lds + L_K + 8192) + hf * 1024 + r32 * 16, qr); mask_range(pb0, pb1, 64, 0, nmax, hf); m = fmaxf(m, rowmax32(pb0, pb1)); }
        else {
#pragma unroll
            for (int i = 0; i < 16; ++i) { pb0[i] = -INFINITY; pb1[i] = -INFINITY; } }
        const float mu = (m == -INFINITY) ? 0.f : m;
        float ls = 0.f;
#pragma unroll
        for (int r = 0; r < 16; ++r) { pa0[r] = __builtin_amdgcn_exp2f(pa0[r] - mu); pa1[r] = __builtin_amdgcn_exp2f(pa1[r] - mu); pb0[r] = __builtin_amdgcn_exp2f(pb0[r] - mu); pb1[r] = __builtin_amdgcn_exp2f(pb1[r] - mu);
            ls += (pa0[r] + pa1[r]) + (pb0[r] + pb1[r]); }
        ls = sum32(ls);
        const float rl = (ls > 0.f) ? 1.0f / ls : 0.f;
#pragma unroll
        for (int r = 0; r < 16; ++r) { pa0[r] *= rl; pa1[r] *= rl; pb0[r] *= rl; pb1[r] *= rl; }
        float own[16], ee[16];
#pragma unroll
        for (int q = 0; q < 4; ++q) {
            own[q] = (pa0[4 * q] + pa0[4 * q + 1]) + (pa0[4 * q + 2] + pa0[4 * q + 3]); ee[q] = pa0[4 * q + 3];
            own[4 + q] = (pa1[4 * q] + pa1[4 * q + 1]) + (pa1[4 * q + 2] + pa1[4 * q + 3]); ee[4 + q] = pa1[4 * q + 3];
            own[8 + q] = (pb0[4 * q] + pb0[4 * q + 1]) + (pb0[4 * q + 2] + pb0[4 * q + 3]); ee[8 + q] = pb0[4 * q + 3];
            own[12 + q] = (pb1[4 * q] + pb1[4 * q + 1]) + (pb1[4 * q + 2] + pb1[4 * q + 3]); ee[12 + q] = pb1[4 * q + 3]; }
        float eo[16];
#pragma unroll
        for (int k = 0; k < 16; ++k) eo[k] = xor32(ee[k], hf);
#pragma unroll
        for (int k = 0; k < 16; ++k) { const float add = hf ? eo[k] : ((k > 0) ? eo[k - 1] : 0.f); own[k] += add; }
#pragma unroll
        for (int k = 0; k < 16; ++k) { own[k] += xorl<1>(own[k]); own[k] += xorl<2>(own[k]); }
        float imp[32];
#pragma unroll
        for (int k = 0; k < 16; ++k) { const float oth = xor32(own[k], hf); imp[2 * k] = hf ? oth : own[k]; imp[2 * k + 1] = hf ? own[k] : oth; }
        selmask = select_blocks(imp, c);
        State sc; st_init(sc);
        { bf16x8 a0, a1, a2, a3; pack_p(pa0, pa1, a0, a1, a2, a3); pv(sc.o, (int)(uintptr_t)(lds + L_V) + vboff, a0, a1, a2, a3); }
        if (ntile == 2) { bf16x8 a0, a1, a2, a3; pack_p(pb0, pb1, a0, a1, a2, a3); pv(sc.o, (int)(uintptr_t)(lds + L_V + 8192) + vboff, a0, a1, a2, a3); }
        accum_lds<true>(accw, sc.o, bf2f(GN[(size_t)row * 32 + hd * 3]), wsf, r32, hf);
    }
#pragma unroll 1
    for (int br = 1; br < 3; ++br) {
        const bf16_t* KB = (br == 1) ? KS : KW; const bf16_t* VB = (br == 1) ? VS : VW;
        const int NT = (br == 1) ? (c + 1) : ((c + 1 < 5) ? c + 1 : 5);
        TileSrc src; src.k = KB + (size_t)(rowbase + c * 64 + lane) * 128 + g * 64 + wv * 8; src.v = VB + (size_t)(rowbase + c * 64 + 16 * (wv & 3) + (lane >> 2)) * 128 + g * 64 + (wv >> 2) * 32 + (lane & 3) * 8;
        src.k2 = src.k; src.kstep = -64 * 128; src.vstep = -64 * 128;
        f32x16 ob[2]; float lb;
        if (br == 1) {
            auto mk = [&](f32x16& p0, f32x16& p1, int i) { const int j = c - i;
                if (i == 0) mask_range(p0, p1, j * 64, 0, tq, hf);
                if (!((selmask >> j) & 1u)) {
#pragma unroll
                    for (int r = 0; r < 16; ++r) { p0[r] = -INFINITY; p1[r] = -INFINITY; } } };
            pipe_attn<64>(lds, src, NT, qr, mk, ob, lb, wv, lane, r32, hf, wsf);
        } else {
            const int lo = tq - 255;
            auto mk = [&](f32x16& p0, f32x16& p1, int i) { if (i == 0 || i == 4) mask_range(p0, p1, (c - i) * 64, lo, tq, hf); };
            pipe_attn<64>(lds, src, NT, qr, mk, ob, lb, wv, lane, r32, hf, wsf);
        }
        const float lt = sum32(lb);
        accum_lds<false>(accw, ob, bf2f(GN[(size_t)row * 32 + hd * 3 + br]) / lt, wsf, r32, hf);
    }
#undef NSA_LOAD
#undef NSA_STORE
    asm volatile("s_waitcnt lgkmcnt(0)" ::: "memory");
#pragma unroll
    for (int i = 0; i < 4; ++i) { const int rr = i * 8 + (lane >> 3), ch = lane & 7; const f32x4 a = *(const LAS f32x4*)(accw + rr * 64 + ch * 8), b2 = *(const LAS f32x4*)(accw + rr * 64 + ch * 8 + 4);
        u32x4 v; v.x = pk2(a.x, a.y); v.y = pk2(a.z, a.w); v.z = pk2(b2.x, b2.y); v.w = pk2(b2.z, b2.w);
        st16(OC + (size_t)(rowbase + 64 * c + 8 * wv + (rr >> 2)) * 1024 + 512 + (g * 4 + (rr & 3)) * 64 + ch * 8, v); }
}
#undef FA_SBAR
}

DI void stage_attn_fast(const Params& p, LAS unsigned char* lds, int bid, int nb, bool do_mla, bool do_nsa, int wid0) {
    if (do_mla) for (int u = bid; u < 256; u += nb) { const int bh = u >> 2, s = u & 3; fa::mla_unit(p, lds, bh >> 3, bh & 7, 7 - s, wid0); fa::mla_unit(p, lds, bh >> 3, bh & 7, s, wid0); }
    if (do_nsa) for (int u = bid; u < 256; u += nb) { const int bg = u >> 4, s = u & 15; fa::nsa_unit(p, lds, bg >> 1, bg & 1, 31 - s, wid0); fa::nsa_unit(p, lds, bg >> 1, bg & 1, s, wid0); }
    __syncthreads();
}
#define XB_TMO      128
#define XB_XCNT(j)  (256  + 64 * (j))
#define XB_XSUB(j)  (1280 + 64 * (j))
#define XB_XGEN(j)  (2304 + 64 * (j))
#define XB_TOP      3328
#define XB_TOPGEN   3392
#define XCD_BAR_WORDS 3456
#define XB_SPIN_CAP (1u << 18)

__device__ __forceinline__ unsigned xb_ld(unsigned* p)              { return __hip_atomic_load(p, __ATOMIC_RELAXED, __HIP_MEMORY_SCOPE_AGENT); }
__device__ __forceinline__ unsigned xb_add(unsigned* p, unsigned v) { return __hip_atomic_fetch_add(p, v, __ATOMIC_RELAXED, __HIP_MEMORY_SCOPE_AGENT); }
__device__ __forceinline__ unsigned xb_xcc_id() { return (unsigned)__builtin_amdgcn_s_getreg((3 << 11) | 20) & 0xFu; }
#define XB_SPIN(cond, bar) do { unsigned _sp = 0; while (cond) { __builtin_amdgcn_s_sleep(1); \
    if ((++_sp & 255u) == 0u) { if (xb_ld(&(bar)[XB_TMO])) break; if (_sp > XB_SPIN_CAP) { atomicAdd(&(bar)[XB_TMO], 1u); break; } } } } while (0)

struct XcdBarrier {
    unsigned* bar; unsigned x;
    volatile LAS unsigned* st;
};

__device__ __forceinline__ XcdBarrier xcd_barrier_post(unsigned* bar, volatile LAS unsigned* st, bool t0) {
    XcdBarrier b; b.bar = bar; b.x = xb_xcc_id(); b.st = st;
    if (t0) (void)xb_add(&bar[XB_XCNT(b.x)], 1u);
    return b;
}
__device__ __forceinline__ void xcd_barrier_complete(unsigned* bar, unsigned x, unsigned& nloc, unsigned& nx) {
    const unsigned G = gridDim.x * gridDim.y * gridDim.z;
    unsigned sum, cnt, mine, sp = 0u;
    for (;;) {
        sum = 0u; cnt = 0u; mine = 0u;
#pragma unroll
        for (unsigned j = 0; j < 16; ++j) { const unsigned c = xb_ld(&bar[XB_XCNT(j)]); sum += c; cnt += (c > 0u) ? 1u : 0u; mine = (j == x) ? c : mine; }
        if (sum == G) break;
        __builtin_amdgcn_s_sleep(1);
        if ((++sp & 255u) == 0u) { if (xb_ld(&bar[XB_TMO])) break; if (sp > XB_SPIN_CAP) { atomicAdd(&bar[XB_TMO], 1u); break; } }
    }
    nloc = mine > 0u ? mine : 1u; nx = cnt > 0u ? cnt : 1u;
}

__device__ __forceinline__ void xcd_barrier(const XcdBarrier& b, bool t0) {
    asm volatile("s_waitcnt vmcnt(0)" ::: "memory");
    __syncthreads();
    if (t0) {
        unsigned* bar = b.bar;
        __builtin_amdgcn_s_waitcnt(0);
        unsigned nloc = b.st[0], nx = b.st[1];
        if (nloc == 0u) { xcd_barrier_complete(bar, b.x, nloc, nx); b.st[0] = nloc; b.st[1] = nx; }
        const unsigned old = xb_add(&bar[XB_XSUB(b.x)], 1u);
        const unsigned gen = old / nloc;
        if (old + 1u == (gen + 1u) * nloc) {
            __builtin_amdgcn_fence(__ATOMIC_RELEASE, "agent");
            asm volatile("s_waitcnt vmcnt(0)" ::: "memory");
            const unsigned og = xb_add(&bar[XB_TOP], 1u);
            const unsigned tg = og / nx;
            if (og + 1u == (tg + 1u) * nx) xb_add(&bar[XB_TOPGEN], 1u);
            else XB_SPIN(xb_ld(&bar[XB_TOPGEN]) == tg, bar);
            __builtin_amdgcn_fence(__ATOMIC_ACQUIRE, "agent");
            xb_add(&bar[XB_XGEN(b.x)], 1u);
            asm volatile("s_waitcnt vmcnt(0)" ::: "memory");
        } else {
            XB_SPIN(xb_ld(&bar[XB_XGEN(b.x)]) == gen, bar);
            __builtin_amdgcn_fence(__ATOMIC_ACQUIRE, "agent");
            asm volatile("s_waitcnt vmcnt(0)" ::: "memory");
        }
    }
    __syncthreads();
}
constexpr int LDS_BYTES = 147456;

typedef const Params __attribute__((address_space(4)))* KParamsPtr;
#if defined(__HIP_DEVICE_COMPILE__)
DI KParamsPtr kparams() { KParamsPtr k = (KParamsPtr)__builtin_amdgcn_kernarg_segment_ptr(); asm volatile("" : "+s"(k)); return k; }
#define PHASE_PARAMS() const Params p = *kparams()
#else
#define PHASE_PARAMS() const Params p = p_arg
#endif
constexpr int CW_BAR = 4096, CW_CMP = 8192, CW_MOD = 8192 + 64;

__global__ void __launch_bounds__(512, 2) fwd_megakernel(Params p_arg) {
    extern __shared__ __attribute__((aligned(16))) unsigned char dlds[];
    LAS unsigned char* lds = (LAS unsigned char*)dlds;
    const int G = gridDim.x, c = blockIdx.x, ngw = G * NWAVE, ngt = G * NTHR;
    const int wid0 = __builtin_amdgcn_readfirstlane(threadIdx.x >> 6);
#define TIDS() const int tid = opaque_tid(wid0), lane = tid & 63, wave = tid >> 6, gw = c * NWAVE + wave, gtid = c * NTHR + tid; (void)lane; (void)gw; (void)gtid
    volatile LAS unsigned* MISC = (volatile LAS unsigned*)(lds + 131072 + 320);
    { TIDS(); if (tid < 32) MISC[tid] = 0u; }
    __syncthreads();
    XcdBarrier bar;
    { PHASE_PARAMS(); TIDS(); bar = xcd_barrier_post((unsigned*)(p.ws + WS_CTL) + CW_BAR, MISC + 8, tid == 0); }
#define GRID_SYNC() do { TIDS(); xcd_barrier(bar, tid == 0); } while (0)

    { PHASE_PARAMS();
      stage_mod(p, c, G, (float*)dlds, wid0);
      { TIDS(); asm volatile("s_waitcnt vmcnt(0)" ::: "memory"); __syncthreads();
        if (tid == 0) { __builtin_amdgcn_fence(__ATOMIC_RELEASE, "agent"); asm volatile("s_waitcnt vmcnt(0)" ::: "memory");
            __hip_atomic_fetch_add((unsigned*)(p.ws + WS_CTL) + CW_MOD, 1u, __ATOMIC_RELAXED, __HIP_MEMORY_SCOPE_AGENT); } }
      { TIDS(); stage_weights<0>(p, gw, ngw, (float*)dlds + wave * (64 * 33), lane); }
      __syncthreads();
      { TIDS(); stage_rope(p, tid, gtid, ngt, (float*)dlds + 16384); }
      { TIDS();
        if (tid == 0) { unsigned* cnt = (unsigned*)(p.ws + WS_CTL) + CW_MOD; unsigned sp = 0;
            while (__hip_atomic_load(cnt, __ATOMIC_RELAXED, __HIP_MEMORY_SCOPE_AGENT) < (unsigned)G) { __builtin_amdgcn_s_sleep(2); if (++sp > (1u << 22)) break; }
            __builtin_amdgcn_fence(__ATOMIC_ACQUIRE, "agent"); asm volatile("s_waitcnt vmcnt(0)" ::: "memory"); }
        __syncthreads();
        stage_normmod(p.in[I_X], p.in[I_N1G], wsp<float>(p, WS_MOD), 0, 1, wsp<bf16_t>(p, WS_R0), gw, ngw, lane); } }
    GRID_SYNC();
    { PHASE_PARAMS(); EpiZ E{p}; gemm_fast(lds, wsp<bf16_t>(p, WS_R0), 1024, wsp<bf16_t>(p, WS_WIN), MT, ZN, 1024, E, G, c, wid0); }
    { PHASE_PARAMS(); const int nz = (MT / 256) * (ZN / 256), first = nz % G;
      if (c >= first) { { TIDS(); stage_weights<1>(p, (c - first) * NWAVE + wave, (G - first) * NWAVE, (float*)dlds + wave * (64 * 33), lane); }
                        __syncthreads(); stage_shw(p, c - first, G - first, (float*)dlds, wid0); } }
    GRID_SYNC();
    { PHASE_PARAMS();
      int qb, qc, kb, kc;
      if (G == 256) { qb = c; qc = (c < 192) ? 1 : 0; kb = (c < 192) ? c : (c >= 224 ? 192 + 2 * (c - 224) : 0); kc = (c < 192) ? 1 : (c >= 224 ? 2 : 0); }
      else { const int pq = (192 + G - 1) / G, pk = (256 + G - 1) / G; qb = c * pq; qc = (192 - qb < pq) ? ((192 - qb > 0) ? 192 - qb : 0) : pq; kb = c * pk; kc = (256 - kb < pk) ? ((256 - kb > 0) ? 256 - kb : 0) : pk; }
      { EpiQ E{p}; gemm_fast_range(lds, wsp<bf16_t>(p, WS_R1), 1024, wsp<bf16_t>(p, WS_WQB), MT, 768, 768, E, qb, qc, wid0); }
      for (int cu = (c + 64) % G; cu < 32; cu += G) cmp_hidden_fast(p, lds, cu, wid0);
      { EpiKV E{p}; gemm_fast_range(lds, wsp<bf16_t>(p, WS_R1) + 768, 1024, wsp<bf16_t>(p, WS_WKVB), MT, 1024, 256, E, kb, kc, wid0); }
    }
    GRID_SYNC();
    { PHASE_PARAMS(); TIDS(); cmp_out<true>(p, gw, ngw, lane);
      asm volatile("s_waitcnt vmcnt(0)" ::: "memory"); __syncthreads();
      if (tid == 0) { __builtin_amdgcn_fence(__ATOMIC_RELEASE, "agent"); asm volatile("s_waitcnt vmcnt(0)" ::: "memory");
          __hip_atomic_fetch_add((unsigned*)(p.ws + WS_CTL) + CW_CMP, 1u, __ATOMIC_RELAXED, __HIP_MEMORY_SCOPE_AGENT); } }
    { PHASE_PARAMS(); stage_attn_fast(p, lds, c, G, true, false, wid0); }
    { PHASE_PARAMS(); TIDS();
      if (tid == 0) { unsigned* cnt = (unsigned*)(p.ws + WS_CTL) + CW_CMP; unsigned sp = 0;
          while (__hip_atomic_load(cnt, __ATOMIC_RELAXED, __HIP_MEMORY_SCOPE_AGENT) < (unsigned)G) { __builtin_amdgcn_s_sleep(2); if (++sp > (1u << 22)) break; }
          __builtin_amdgcn_fence(__ATOMIC_ACQUIRE, "agent"); asm volatile("s_waitcnt vmcnt(0)" ::: "memory"); }
      __syncthreads(); }
    { PHASE_PARAMS(); stage_attn_fast(p, lds, c, G, false, true, wid0); }
    GRID_SYNC();
    { PHASE_PARAMS(); EpiMerge E{p}; gemm_fast(lds, wsp<bf16_t>(p, WS_R1), 1024, wsp<bf16_t>(p, WS_WO), MT, 1024, 1024, E, G, c, wid0); }
    GRID_SYNC();
    { PHASE_PARAMS(); EpiOut E{p}; gemm_fast(lds, wsp<bf16_t>(p, WS_R0), 1024, wsp<bf16_t>(p, WS_WOUT), MT, 1024, 1024, E, G, c, wid0); }
    GRID_SYNC();
    { PHASE_PARAMS(); EpiGU E{p}; gemm_fast(lds, wsp<bf16_t>(p, WS_R1), 1024, wsp<bf16_t>(p, WS_WGU), MT, 5632, 1024, E, G, c, wid0); }
    { PHASE_PARAMS(); const int ng = (MT / 256) * (5632 / 256), first = ng % G;
      if (c >= first) { TIDS(); stage_weights<2>(p, (c - first) * NWAVE + wave, (G - first) * NWAVE, (float*)dlds + wave * (64 * 33), lane); } }
    GRID_SYNC();
    { PHASE_PARAMS(); EpiDown E{p}; gemm_fast(lds, wsp<bf16_t>(p, WS_HID), DFF, wsp<bf16_t>(p, WS_WD), MT, 1024, DFF, E, G, c, wid0); }
}

extern "C" void kernel_launch(void* const* d_in, const int* in_sizes, int n_in, void* d_out, int out_size, void* d_ws, size_t ws_size, hipStream_t stream) {
    if (n_in != 30 || out_size != MT * DM || ws_size < WS_END) { fprintf(stderr, "kernel_launch: unexpected shapes (n_in %d out %d ws %zu)\n", n_in, out_size, ws_size); return; }
    static int grid = 0;
    if (grid == 0) {
        int dev = 0, cus = 0, per_cu = 0;
        (void)hipGetDevice(&dev); (void)hipDeviceGetAttribute(&cus, hipDeviceAttributeMultiprocessorCount, dev);
        (void)hipFuncSetAttribute((const void*)fwd_megakernel, hipFuncAttributeMaxDynamicSharedMemorySize, LDS_BYTES);
        (void)hipOccupancyMaxActiveBlocksPerMultiprocessor(&per_cu, (const void*)fwd_megakernel, NTHR, LDS_BYTES);
        if (per_cu < 1) fprintf(stderr, "kernel_launch: occupancy query says %d blocks per CU\n", per_cu);
        grid = cus;
        (void)hipGetLastError();
    }
    Params p{};
    for (int i = 0; i < 30; ++i) p.in[i] = (const float*)d_in[i];
    p.out = (float*)d_out; p.ws = (unsigned char*)d_ws;
    (void)hipMemsetAsync((char*)d_ws + WS_CTL, 0, 65536, stream);
    void* args[] = {&p};
    hipError_t e = hipLaunchCooperativeKernel((const void*)fwd_megakernel, dim3(grid), dim3(NTHR), args, LDS_BYTES, stream);
    if (e != hipSuccess) fprintf(stderr, "kernel_launch: cooperative launch failed: %s (grid %d)\n", hipGetErrorString(e), grid);
}
```

```cpp
#include <hip/hip_runtime.h>
#include <cstdint>
#include <cstdio>

typedef unsigned short bf16_t;
typedef unsigned u32x4 __attribute__((ext_vector_type(4)));
typedef unsigned u32x2 __attribute__((ext_vector_type(2)));
typedef float f32x4 __attribute__((ext_vector_type(4)));
typedef float f32x2 __attribute__((ext_vector_type(2)));
#define DI __device__ __forceinline__

constexpr int NB = 8, SEQ = 2048, DM = 1024, MT = NB * SEQ;
constexpr int DFF = 2816, NMOD = 6;
constexpr int ZN = 4608;
constexpr float EPS = 1e-6f;
constexpr float LOG2E = 1.4426950408889634f;
constexpr float C2N = 0.125f * LOG2E;
constexpr float C2M = 0.10206207261596575f * LOG2E;
constexpr int NTHR = 512, NWAVE = 8;
constexpr int O_CQ = 0, O_CKV = 768, O_KPE = 1024, O_QN = 1056, O_KC = 1568, O_VC = 1696, O_KS = 1824, O_VS = 1952, O_KW = 2080, O_VW = 2208,
              O_GN = 2336, O_GM = 2360, O_GNM = 3384, D_IN = 4408;

constexpr size_t MiB = 1u << 20;
constexpr size_t WS_CTL = 0;
constexpr size_t WS_MOD = 1 * MiB;
constexpr size_t WS_CB1 = 1 * MiB + 256 * 1024;
constexpr size_t WS_SSQPE = 1 * MiB + 320 * 1024;
constexpr size_t WS_SSQKN = 1 * MiB + 512 * 1024;
constexpr size_t WS_SSQA = 2 * MiB;
constexpr size_t WS_KCF = 3 * MiB;
constexpr size_t WS_VCF = 3 * MiB + 256 * 1024;
constexpr size_t WS_SHW = 3 * MiB + 512 * 1024;
constexpr size_t WS_WIN = 4 * MiB;
constexpr size_t WS_WQB = 13 * MiB;
constexpr size_t WS_WKVB = 15 * MiB;
constexpr size_t WS_WO = 16 * MiB;
constexpr size_t WS_WOUT = 18 * MiB;
constexpr size_t WS_WGU = 20 * MiB;
constexpr size_t WS_WD = 31 * MiB;
constexpr size_t WS_CW1 = 37 * MiB;
constexpr size_t WS_R0 = 40 * MiB;
constexpr size_t WS_R1 = 72 * MiB;
constexpr size_t WS_R2 = 104 * MiB;
constexpr size_t WS_QN = 168 * MiB;
constexpr size_t WS_KC = 184 * MiB, WS_VC = 188 * MiB, WS_KS = 192 * MiB, WS_VS = 196 * MiB, WS_KW = 200 * MiB, WS_VW = 204 * MiB;
constexpr size_t WS_KPE = 208 * MiB;
constexpr size_t WS_GN = 209 * MiB;
constexpr size_t WS_KN = 210 * MiB;
constexpr size_t WS_VM = 234 * MiB;
constexpr size_t WS_ROPE = 250 * MiB;
constexpr size_t WS_HID = 168 * MiB;
constexpr size_t WS_END = 256 * MiB;

struct Params {
    const float* in[30];
    float* out;
    unsigned char* ws;
};
enum { I_X = 0, I_C, I_POS, I_ADAW, I_ADAB, I_N1G, I_WIN, I_QAG, I_WQB, I_KVAG, I_WKVB, I_MQG, I_MKG, I_NQG, I_NKCG, I_NKSG, I_NKWG,
       I_CPK, I_CW1K, I_CW2K, I_CPV, I_CW1V, I_CW2V, I_WOM, I_WON, I_WOUT, I_N2G, I_WG, I_WU, I_WDN };

template <class T> DI T* wsp(const Params& p, size_t off) { return (T*)(p.ws + off); }
DI bf16_t* qraw(const Params& p) { return (bf16_t*)p.out; }
DI float* cmph(const Params& p) { return p.out + (size_t)6 * 1024 * 1024; }

#ifndef WT_STORES
#define WT_STORES 0
#endif
DI void st16(void* p, u32x4 v) {
#if WT_STORES
    asm volatile("global_store_dwordx4 %0, %1, off sc1\n\ts_nop 1" :: "v"(p), "v"(v) : "memory");
#else
    *(u32x4*)p = v;
#endif
}
DI void st16f(void* p, f32x4 v) { st16(p, __builtin_bit_cast(u32x4, v)); }
DI int lane_id() { return (int)__builtin_amdgcn_mbcnt_hi(~0u, __builtin_amdgcn_mbcnt_lo(~0u, 0u)); }
DI int opaque_lane() { int l; asm volatile("v_mbcnt_lo_u32_b32 %0, -1, 0\n\tv_mbcnt_hi_u32_b32 %0, -1, %0" : "=v"(l)); return l; }
DI int opaque_tid(int wid0) { int l; asm volatile("v_mbcnt_lo_u32_b32 %0, -1, 0\n\tv_mbcnt_hi_u32_b32 %0, -1, %0" : "=v"(l)); return (wid0 << 6) | l; }
DI unsigned f2bf(float f) { unsigned u = __float_as_uint(f); return (u + 0x7fffu + ((u >> 16) & 1u)) >> 16; }
DI unsigned pk2(float lo, float hi) { return f2bf(lo) | (f2bf(hi) << 16); }
DI float bf2f(unsigned short b) { return __uint_as_float(((unsigned)b) << 16); }
DI float bflo(unsigned w) { return __uint_as_float(w << 16); }
DI float bfhi(unsigned w) { return __uint_as_float(w & 0xffff0000u); }
DI void unpack8(const u32x4 w, float (&f)[8]) { f[0] = bflo(w.x); f[1] = bfhi(w.x); f[2] = bflo(w.y); f[3] = bfhi(w.y); f[4] = bflo(w.z); f[5] = bfhi(w.z); f[6] = bflo(w.w); f[7] = bfhi(w.w); }
DI u32x4 pack8(const float (&f)[8]) { u32x4 w; w.x = pk2(f[0], f[1]); w.y = pk2(f[2], f[3]); w.z = pk2(f[4], f[5]); w.w = pk2(f[6], f[7]); return w; }
DI float sigmoidf(float x) { return __builtin_amdgcn_rcpf(1.0f + __expf(-x)); }
DI float siluf(float x) { return x * __builtin_amdgcn_rcpf(1.0f + __expf(-x)); }
template <int X> DI float xorl(float v) { return __int_as_float(__builtin_amdgcn_ds_swizzle(__float_as_int(v), (X << 10) | 0x1f)); }
DI void halves(float v, float& lo, float& hi) { auto rr = __builtin_amdgcn_permlane32_swap(__float_as_uint(v), __float_as_uint(v), false, false); lo = __uint_as_float(rr[0]); hi = __uint_as_float(rr[1]); }
DI float xor32(float v, int hf) { float lo, hi; halves(v, lo, hi); return hf ? lo : hi; }
DI float sum32(float v) { float lo, hi; halves(v, lo, hi); return lo + hi; }
DI float max32(float v) { float lo, hi; halves(v, lo, hi); return fmaxf(lo, hi); }
DI float wave_sum(float v) { v += xorl<1>(v); v += xorl<2>(v); v += xorl<4>(v); v += xorl<8>(v); v += xorl<16>(v); return sum32(v); }
DI void sincos_rad(float ang, float& c, float& s) {
    double rev = (double)ang * 0.15915494309189535; rev -= __builtin_rint(rev);
    const float fr = (float)rev; s = __builtin_amdgcn_sinf(fr); c = __builtin_amdgcn_cosf(fr);
}
#define LAS __attribute__((address_space(3)))
#if defined(__HIP_DEVICE_COMPILE__)
DI const float* karg_in(int i) { typedef const float* KPtr; const KPtr __attribute__((address_space(4)))* k = (const KPtr __attribute__((address_space(4)))*)__builtin_amdgcn_kernarg_segment_ptr(); return k[i]; }
#else
DI const float* karg_in(int) { return nullptr; }
#endif
DI void tr_load(const float* W, int ldw, int c0, int ncols, int k0, float (&v)[32], int lane) {
    const int cc = lane & 31, kh = lane >> 5;
    if (c0 >= 0 && cc < ncols) {
        const float* src = W + (size_t)(k0 + kh) * ldw + c0 + cc;
#pragma unroll
        for (int i = 0; i < 32; ++i) v[i] = src[(size_t)(2 * i) * ldw];
    } else {
#pragma unroll
        for (int i = 0; i < 32; ++i) v[i] = 0.f;
    }
}
DI void tr_finish(const float* rs, bf16_t* dst, int ldd, int n0, int k0, float (&v)[32], float* scr, int lane) {
    const int cc = lane & 31, kh = lane >> 5;
    if (rs) {
#pragma unroll
        for (int i = 0; i < 32; ++i) v[i] *= rs[k0 + 2 * i + kh];
    }
#pragma unroll
    for (int i = 0; i < 32; ++i) scr[(2 * i + kh) * 33 + cc] = v[i];
    __builtin_amdgcn_s_waitcnt(0xc07f);
    asm volatile("" ::: "memory");
    const int c = lane & 7;
#pragma unroll
    for (int j = 0; j < 4; ++j) { const int n = (lane >> 3) + 8 * j; const float* s = scr + (8 * c) * 33 + n;
        u32x4 o; o.x = pk2(s[0 * 33], s[1 * 33]); o.y = pk2(s[2 * 33], s[3 * 33]); o.z = pk2(s[4 * 33], s[5 * 33]); o.w = pk2(s[6 * 33], s[7 * 33]);
        st16(dst + (size_t)(n0 + n) * ldd + k0 + 8 * c, o); }
    __builtin_amdgcn_s_waitcnt(0xc07f);
    asm volatile("" ::: "memory");
}
DI void transpose_item(const float* W, int ldw, int c0, int ncols, const float* rs, bf16_t* dst, int ldd, int n0, int k0, float* scr, int lane) {
    float v[32];
    tr_load(W, ldw, c0, ncols, k0, v, lane); tr_finish(rs, dst, ldd, n0, k0, v, scr, lane);
}
DI int zsrc(int s, int L0, int& ncols) {
    ncols = 32;
    if (s < 16) return 64 * s + L0;
    if (s == 16) { if (L0 == 0) return O_KPE; ncols = 24; return O_GN; }
    if (s < 25) return O_QN + 64 * (s - 17) + L0;
    if (s < 27) return O_KC + 64 * (s - 25) + L0;
    if (s < 29) return O_VC + 64 * (s - 27) + L0;
    if (s < 31) return O_KS + 64 * (s - 29) + L0;
    if (s < 33) return O_VS + 64 * (s - 31) + L0;
    if (s < 35) return O_KW + 64 * (s - 33) + L0;
    if (s < 37) return O_VW + 64 * (s - 35) + L0;
    if (s < 40) return -1;
    if (s < 56) return O_GM + 64 * (s - 40) + L0;
    return O_GNM + 64 * (s - 56) + L0;
}
template <int PART> DI void stage_weights(const Params& p, int gw, int ngw, float* scr, int lane) {
    constexpr int I_IN = (ZN / 32) * (DM / 64);
    constexpr int I_QB = (768 / 32) * (768 / 64);
    constexpr int I_KVB = (1024 / 32) * (256 / 64);
    constexpr int I_O = (1024 / 32) * (1024 / 64);
    constexpr int I_OUT = I_O;
    constexpr int I_GU = (5632 / 32) * (1024 / 64);
    constexpr int I_D = (1024 / 32) * (DFF / 64);
    constexpr int I_C1 = 2 * (256 / 32) * (2048 / 64);
    if constexpr (PART == 1) {
        for (int r = gw; r < I_GU; r += ngw) { const int nb = r / 16, kb = r % 16; const int pn = nb >> 3, bj = (nb >> 2) & 1, wc = nb & 3, s = 4 * pn + wc;
            transpose_item(bj ? p.in[I_WU] : p.in[I_WG], DFF, 32 * s, 32, nullptr, wsp<bf16_t>(p, WS_WGU), 1024, nb * 32, kb * 64, scr, lane); }
        for (int r = gw; r < I_O + I_OUT; r += ngw) {
            if (r < I_O) { const int nb = r / 16, kb = r % 16;
                if (kb < 8) transpose_item(p.in[I_WOM], 1024, nb * 32, 32, nullptr, wsp<bf16_t>(p, WS_WO), 1024, nb * 32, kb * 64, scr, lane);
                else transpose_item(p.in[I_WON] - (size_t)512 * 1024, 1024, nb * 32, 32, nullptr, wsp<bf16_t>(p, WS_WO), 1024, nb * 32, kb * 64, scr, lane); }
            else { const int r2 = r - I_O, nb = r2 / 16, kb = r2 % 16; transpose_item(p.in[I_WOUT], 1024, nb * 32, 32, nullptr, wsp<bf16_t>(p, WS_WOUT), 1024, nb * 32, kb * 64, scr, lane); } }
        return;
    }
    if constexpr (PART == 2) {
        for (int r = gw; r < I_D; r += ngw) { const int nb = r / 44, kb = r % 44; transpose_item(p.in[I_WDN], 1024, nb * 32, 32, nullptr, wsp<bf16_t>(p, WS_WD), DFF, nb * 32, kb * 64, scr, lane); }
        return;
    }
    constexpr int NITEMS = I_IN + I_QB + I_KVB + I_C1;
#define TW_DECODE(it_, wi_, ri_, do_, ldw_, c0_, nc_, ldd_, n0_, k0_) do { int r = (it_); \
        if (r < I_IN) { const int nb = r / 16, kb = r % 16; const int pn = nb >> 3, bj = (nb >> 2) & 1, wc = nb & 3; int ncx; c0_ = zsrc(4 * pn + wc, 32 * bj, ncx); nc_ = ncx; \
            wi_ = I_WIN; ri_ = -1; do_ = WS_WIN; ldw_ = D_IN; ldd_ = DM; n0_ = nb * 32; k0_ = kb * 64; break; } r -= I_IN; \
        if (r < I_QB) { const int nb = r / 12, kb = r % 12; wi_ = I_WQB; ri_ = I_QAG; do_ = WS_WQB; ldw_ = 768; c0_ = nb * 32; nc_ = 32; ldd_ = 768; n0_ = nb * 32; k0_ = kb * 64; break; } r -= I_QB; \
        if (r < I_KVB) { const int nb = r / 4, kb = r % 4; const int pn = nb >> 3, bj = (nb >> 2) & 1, wc = nb & 3, s = 4 * pn + wc; \
            c0_ = (s < 8) ? (128 * s + 32 * bj) : (128 * (s - 8) + 64 + 32 * bj); \
            wi_ = I_WKVB; ri_ = I_KVAG; do_ = WS_WKVB; ldw_ = 1024; nc_ = 32; ldd_ = 256; n0_ = nb * 32; k0_ = kb * 64; break; } r -= I_KVB; \
        { const int kv = r / 256, rr = r % 256, nb = rr / 32, kb = rr % 32; \
          wi_ = kv ? I_CW1V : I_CW1K; ri_ = -1; do_ = WS_CW1 + (size_t)kv * 256 * 2048 * 2; ldw_ = 256; c0_ = nb * 32; nc_ = 32; ldd_ = 2048; n0_ = nb * 32; k0_ = kb * 64; } } while (0)
    int it = gw;
    if (it < NITEMS) {
        int wia, ria, wib = 0, rib = -1; size_t doa, dob = 0; int ldwa, c0a, nca, ldda, n0a, k0a, ldwb = 0, c0b = 0, ncb = 0, lddb = 0, n0b = 0, k0b = 0;
        float va[32], vb[32];
        TW_DECODE(it, wia, ria, doa, ldwa, c0a, nca, ldda, n0a, k0a);
        tr_load(karg_in(wia), ldwa, c0a, nca, k0a, va, lane);
        for (;;) {
            const int nx = it + ngw; const bool hn = nx < NITEMS;
            if (hn) { TW_DECODE(nx, wib, rib, dob, ldwb, c0b, ncb, lddb, n0b, k0b); tr_load(karg_in(wib), ldwb, c0b, ncb, k0b, vb, lane); }
            tr_finish((ria >= 0) ? karg_in(ria) : (const float*)nullptr, (bf16_t*)(p.ws + doa), ldda, n0a, k0a, va, scr, lane);
            if (!hn) break;
            ria = rib; doa = dob; ldda = lddb; n0a = n0b; k0a = k0b; it = nx;
#pragma unroll
            for (int i = 0; i < 32; ++i) va[i] = vb[i];
        }
    }
#undef TW_DECODE
}
DI void stage_mod(const Params& p, int bid, int nb, float* lds, int wid0) {
    const int tid = opaque_tid(wid0), wave = tid >> 6, lane = tid & 63, nwv = blockDim.x >> 6;
    if (bid >= 224) return;
    float* sl = lds; float* red = lds + 8192;
    for (int i = tid; i < 8192; i += blockDim.x) sl[i] = siluf(p.in[I_C][i]);
    __syncthreads();
    for (int u = bid; u < 224; u += nb) {
        float acc[8];
#pragma unroll
        for (int b = 0; b < 8; ++b) acc[b] = 0.f;
        if (u < 192) {
            const int kh = lane >> 5; const float* W = p.in[I_ADAW] + u * 32 + (lane & 31); const int kn = 1024 / nwv;
            for (int k = wave * kn + kh; k < (wave + 1) * kn; k += 64) { float w[32];
#pragma unroll
                for (int e = 0; e < 32; ++e) w[e] = W[(size_t)(k + 2 * e) * 6144];
#pragma unroll
                for (int e = 0; e < 32; ++e)
#pragma unroll
                    for (int b = 0; b < 8; ++b) acc[b] += sl[b * 1024 + k + 2 * e] * w[e]; }
        } else {
            const int kq = (u - 192) >> 3, kv = ((u - 192) >> 2) & 1; const float* W = (kv ? p.in[I_CW1V] : p.in[I_CW1K]) + ((u - 192) & 3) * 64 + lane; const float* pos = kv ? p.in[I_CPV] : p.in[I_CPK]; const int kn = 512 / nwv;
            for (int k = kq * 512 + wave * kn; k < kq * 512 + (wave + 1) * kn; k += 32) { float w[32];
#pragma unroll
                for (int e = 0; e < 32; ++e) w[e] = W[(size_t)(k + e) * 256];
#pragma unroll
                for (int e = 0; e < 32; ++e) acc[0] += pos[k + e] * w[e]; }
        }
        __syncthreads();
#pragma unroll
        for (int b = 0; b < 8; ++b) red[(wave * 8 + b) * 64 + lane] = acc[b];
        __syncthreads();
        if (wave == 0) {
#pragma unroll
            for (int b = 0; b < 8; ++b) { float s = 0.f;
                if (u < 192) { for (int w = 0; w < nwv; ++w) s += red[(w * 8 + b) * 64 + (lane & 31)] + red[(w * 8 + b) * 64 + 32 + (lane & 31)];
                    if (lane < 32) wsp<float>(p, WS_MOD)[b * 6144 + u * 32 + lane] = s + p.in[I_ADAB][u * 32 + lane]; }
                else { for (int w = 0; w < nwv; ++w) s += red[(w * 8 + b) * 64 + lane];
                    if (b == 0) wsp<float>(p, WS_CB1)[((u - 192) >> 3) * 512 + ((u - 192) & 7) * 64 + lane] = s; } }
        }
    }
}
DI void stage_rope(const Params& p, int tid, int gtid, int ngt, float* invt) {
    if (tid < 24) invt[tid] = (tid < 16) ? (float)pow(500000.0, -(double)tid / 16.0) : (float)pow(500000.0, -(double)(tid - 16) / 8.0);
    __syncthreads();
    float* T = wsp<float>(p, WS_ROPE); const int* pos = (const int*)p.in[I_POS];
    for (int i = gtid; i < MT * 24; i += ngt) {
        const int row = i / 24, j = i % 24; const float ps = (float)pos[row]; float c, s;
        sincos_rad(ps * invt[j], c, s);
        if (j < 16) { T[(size_t)row * 16 + j] = c; T[(size_t)MT * 16 + (size_t)row * 16 + j] = s; }
        else { T[(size_t)MT * 32 + (size_t)row * 8 + (j - 16)] = c; T[(size_t)MT * 40 + (size_t)row * 8 + (j - 16)] = s; }
    }
}
DI const float* ropeCM(const Params& p) { return wsp<float>(p, WS_ROPE); }
DI const float* ropeSM(const Params& p) { return wsp<float>(p, WS_ROPE) + (size_t)MT * 16; }
DI const float* ropeCN(const Params& p) { return wsp<float>(p, WS_ROPE) + (size_t)MT * 32; }
DI const float* ropeSN(const Params& p) { return wsp<float>(p, WS_ROPE) + (size_t)MT * 40; }

DI void stage_normmod(const float* X, const float* gain, const float* mod, int sh_idx, int sc_idx, bf16_t* Hout, int m0, int mstep, int cnt, int lane) {
    f32x4 v[4], n1[4], n2[4], gs[4], sh[4];
    int bcur = -1;
#define NM_LOAD(dst, row) do { const f32x4* xr_ = (const f32x4*)(X + (size_t)(row) * DM) + lane; _Pragma("unroll") for (int j = 0; j < 4; ++j) dst[j] = xr_[64 * j]; } while (0)
    if (cnt > 0) NM_LOAD(n1, m0);
    if (cnt > 1) NM_LOAD(n2, m0 + mstep);
    for (int i = 0; i < cnt; ++i) {
        const int m = m0 + i * mstep, b = m / SEQ;
#pragma unroll
        for (int j = 0; j < 4; ++j) { v[j] = n1[j]; n1[j] = n2[j]; }
        if (i + 2 < cnt) NM_LOAD(n2, m + 2 * mstep);
        if (b != bcur) { bcur = b;
            const f32x4* g4 = (const f32x4*)gain + lane; const f32x4* sc4 = (const f32x4*)(mod + b * 6144 + sc_idx * 1024) + lane; const f32x4* sh4 = (const f32x4*)(mod + b * 6144 + sh_idx * 1024) + lane;
#pragma unroll
            for (int j = 0; j < 4; ++j) { gs[j] = g4[64 * j] * (1.0f + sc4[64 * j]); sh[j] = sh4[64 * j]; } }
        float s = 0.f;
#pragma unroll
        for (int j = 0; j < 4; ++j) s += (v[j].x * v[j].x + v[j].y * v[j].y) + (v[j].z * v[j].z + v[j].w * v[j].w);
        const float rstd = rsqrtf(wave_sum(s) * (1.f / DM) + EPS);
        u32x2* o8 = (u32x2*)(Hout + (size_t)m * DM) + lane;
#pragma unroll
        for (int j = 0; j < 4; ++j) { const f32x4 y = v[j] * rstd * gs[j] + sh[j]; u32x2 w; w.x = pk2(y.x, y.y); w.y = pk2(y.z, y.w); o8[64 * j] = w; }
    }
#undef NM_LOAD
}

DI void stage_shw(const Params& p, int ub, int nbk, float* lds, int wid0) {
    const int tid = opaque_tid(wid0), wave = tid >> 6, lane = tid & 63, nwv = blockDim.x >> 6;
    if (ub >= 88) return;
    float* sl = lds; float* red = lds + 8192;
    for (int i = tid; i < 8192; i += blockDim.x) sl[i] = wsp<float>(p, WS_MOD)[(i >> 10) * 6144 + 3 * 1024 + (i & 1023)];
    __syncthreads();
    for (int u = ub; u < 88; u += nbk) {
        const int mat = u / 44, col = 64 * (u % 44) + lane; const float* W = (mat ? p.in[I_WU] : p.in[I_WG]) + col; const int kn = 1024 / nwv;
        float acc[8];
#pragma unroll
        for (int b = 0; b < 8; ++b) acc[b] = 0.f;
        for (int k = wave * kn; k < (wave + 1) * kn; k += 32) { float w[32];
#pragma unroll
            for (int e = 0; e < 32; ++e) w[e] = W[(size_t)(k + e) * DFF];
#pragma unroll
            for (int e = 0; e < 32; ++e)
#pragma unroll
                for (int b = 0; b < 8; ++b) acc[b] += sl[b * 1024 + k + e] * w[e]; }
        __syncthreads();
#pragma unroll
        for (int b = 0; b < 8; ++b) red[(wave * 8 + b) * 64 + lane] = acc[b];
        __syncthreads();
        if (wave == 0) { const int s = col >> 5, cr = col & 31, phys = 256 * (s >> 2) + 128 * mat + 32 * (s & 3) + cr;
#pragma unroll
            for (int b = 0; b < 8; ++b) { float sum = 0.f;
                for (int w = 0; w < nwv; ++w) sum += red[(w * 8 + b) * 64 + lane];
                wsp<float>(p, WS_SHW)[b * 5632 + phys] = sum; } }
    }
}
struct ColPre { f32x4 c[8]; };
struct RowPre { f32x4 a[4]; };
DI void store8bf(bf16_t* dst, const float (&f)[8]) { st16(dst, pack8(f)); }
DI float ssq16(const float (&v)[2][8]) { float q = 0.f;
#pragma unroll
    for (int b = 0; b < 2; ++b)
#pragma unroll
        for (int j = 0; j < 8; ++j) q += v[b][j] * v[b][j];
    q += xorl<16>(q); return sum32(q); }
DI f32x4 ld4(const float* p) { return *(const f32x4*)p; }
DI f32x4 ld4u(const bf16_t* p) { return __builtin_bit_cast(f32x4, *(const u32x4*)p); }
DI void un8(const f32x4 raw, float (&f)[8]) { unpack8(__builtin_bit_cast(u32x4, raw), f); }

struct EpiZ {
    static constexpr bool HAS_MID = false; static constexpr int NTYPES = 7;
    Params p;
    DI void midpre(RowPre&, int, int, int, int) const {}
    DI void mid(const RowPre&, int, int, int, int, float (&)[2][8]) const {}
    DI int type(int pn, int wc) const { const int s = 4 * pn + wc;
        if (s < 16) return 0; if (s == 16) return 1; if (s < 25) return 2; if (s < 37) { const int t = (s - 25) >> 1; return (t == 2 || t == 4) ? 3 : 4; } if (s < 40) return 5; return 6; }
    template <int T> DI void ubegin(ColPre& U, int, int pn, int wc, int fq) const {
        const int s = 4 * pn + wc; (void)s;
        if constexpr (T == 1) { U.c[0] = ld4(p.in[I_MKG] + 64 + 8 * fq); U.c[1] = ld4(p.in[I_MKG] + 68 + 8 * fq); }
        if constexpr (T == 2 || T == 3) { const float* gain = (T == 2) ? p.in[I_NQG] : ((((s - 25) >> 1) == 2) ? p.in[I_NKSG] : p.in[I_NKWG]);
            U.c[0] = ld4(gain + 8 * fq); U.c[1] = ld4(gain + 8 * fq + 4); U.c[2] = ld4(gain + 32 + 8 * fq); U.c[3] = ld4(gain + 36 + 8 * fq); }
    }
    template <int T> DI void pre(RowPre& R, int row, int, int, int fq) const {
        if constexpr (T == 1) { const int i0 = 8 * (fq & 1); const float* cs = ropeCM(p) + (size_t)row * 16 + i0; const float* sn = ropeSM(p) + (size_t)row * 16 + i0;
            R.a[0] = ld4(cs); R.a[1] = ld4(cs + 4); R.a[2] = ld4(sn); R.a[3] = ld4(sn + 4); }
        if constexpr (T == 2 || T == 3) { const float* cs = ropeCN(p) + (size_t)row * 8; const float* sn = ropeSN(p) + (size_t)row * 8;
            R.a[0] = ld4(cs); R.a[1] = ld4(cs + 4); R.a[2] = ld4(sn); R.a[3] = ld4(sn + 4); }
    }
    DI void normrope(const ColPre& U, const RowPre& R, int fq, float (&v)[2][8], float post, bf16_t* dst) const {
        const float rstd = rsqrtf(ssq16(v) * (1.f / 64.f) + EPS);
#pragma unroll
        for (int b = 0; b < 2; ++b)
#pragma unroll
            for (int j = 0; j < 8; ++j) v[b][j] *= rstd * U.c[2 * b + (j >> 2)][j & 3];
#pragma unroll
        for (int j = 0; j < 8; ++j) { const float own = v[0][j], oth = xorl<16>(own); const float c = R.a[j >> 2][j & 3], s = R.a[2 + (j >> 2)][j & 3];
            if (fq == 0) v[0][j] = own * c - oth * s; else if (fq == 1) v[0][j] = own * c + oth * s; }
#pragma unroll
        for (int b = 0; b < 2; ++b) {
#pragma unroll
            for (int j = 0; j < 8; ++j) v[b][j] *= post;
            store8bf(dst + 32 * b + 8 * fq, v[b]); }
    }
    template <int T> DI void apply(const ColPre& U, const RowPre& R, int row, int pn, int wc, int fq, float (&v)[2][8]) const {
        const int s = 4 * pn + wc; (void)s;
        if constexpr (T == 0) {
            bf16_t* d = wsp<bf16_t>(p, WS_R1) + (size_t)row * 1024 + 64 * s + 8 * fq;
            const float q = ssq16(v); store8bf(d, v[0]); store8bf(d + 32, v[1]);
            if (fq == 0) wsp<float>(p, WS_SSQA)[(size_t)row * 16 + s] = q;
        } else if constexpr (T == 1) {
            float q = 0.f;
#pragma unroll
            for (int j = 0; j < 8; ++j) q += v[0][j] * v[0][j];
            q += xorl<16>(q); q = sum32(q);
            if (fq == 0) wsp<float>(p, WS_SSQPE)[row] = q;
            float o[8];
#pragma unroll
            for (int j = 0; j < 8; ++j) { const float own = v[0][j] * U.c[j >> 2][j & 3], oth = xor32(own, fq >> 1); const float c = R.a[j >> 2][j & 3], sn = R.a[2 + (j >> 2)][j & 3];
                o[j] = (fq < 2) ? own * c - oth * sn : own * c + oth * sn; }
            store8bf(wsp<bf16_t>(p, WS_KPE) + (size_t)row * 32 + 8 * fq, o);
#pragma unroll
            for (int j = 0; j < 8; ++j) o[j] = sigmoidf(v[1][j]);
            store8bf(wsp<bf16_t>(p, WS_GN) + (size_t)row * 32 + 8 * fq, o);
        } else if constexpr (T == 2) {
            normrope(U, R, fq, v, C2N, wsp<bf16_t>(p, WS_QN) + (size_t)row * 512 + 64 * (s - 17));
        } else if constexpr (T == 3 || T == 4) {
            const int t = (s - 25) >> 1, g = (s - 25) & 1;
            bf16_t* d = wsp<bf16_t>(p, WS_KC + (size_t)t * 4 * MiB) + (size_t)row * 128 + 64 * g;
            if constexpr (T == 3) normrope(U, R, fq, v, 1.0f, d);
            else { store8bf(d + 8 * fq, v[0]); store8bf(d + 32 + 8 * fq, v[1]); }
        } else if constexpr (T == 5) {
        } else {
            bf16_t* d = wsp<bf16_t>(p, WS_R2) + (size_t)row * 2048 + 64 * (s - 40) + 8 * fq;
#pragma unroll
            for (int b = 0; b < 2; ++b) { float o[8];
#pragma unroll
                for (int j = 0; j < 8; ++j) o[j] = sigmoidf(v[b][j]);
                store8bf(d + 32 * b, o); }
        }
    }
};
struct EpiQ {
    static constexpr bool HAS_MID = false; static constexpr int NTYPES = 1;
    Params p;
    DI int type(int, int) const { return 0; }
    DI void midpre(RowPre&, int, int, int, int) const {}
    DI void mid(const RowPre&, int, int, int, int, float (&)[2][8]) const {}
    template <int T> DI void ubegin(ColPre&, int, int, int, int) const {}
    template <int T> DI void pre(RowPre& R, int row, int, int, int) const { const float* sq = wsp<float>(p, WS_SSQA) + (size_t)row * 16; R.a[0] = ld4(sq); R.a[1] = ld4(sq + 4); R.a[2] = ld4(sq + 8); }
    template <int T> DI void apply(const ColPre&, const RowPre& R, int row, int pn, int wc, int fq, float (&v)[2][8]) const {
        const float s = ((R.a[0].x + R.a[0].y) + (R.a[0].z + R.a[0].w)) + ((R.a[1].x + R.a[1].y) + (R.a[1].z + R.a[1].w)) + ((R.a[2].x + R.a[2].y) + (R.a[2].z + R.a[2].w));
        const float rstd = rsqrtf(s * (1.f / 768.f) + EPS);
        bf16_t* d = qraw(p) + (size_t)row * 768 + 256 * pn + 32 * wc + 8 * fq;
#pragma unroll
        for (int b = 0; b < 2; ++b) { float o[8];
#pragma unroll
            for (int j = 0; j < 8; ++j) o[j] = v[b][j] * rstd;
            store8bf(d + 128 * b, o); }
    }
};
struct EpiKV {
    static constexpr bool HAS_MID = false; static constexpr int NTYPES = 1;
    Params p;
    DI int type(int, int) const { return 0; }
    DI void midpre(RowPre&, int, int, int, int) const {}
    DI void mid(const RowPre&, int, int, int, int, float (&)[2][8]) const {}
    template <int T> DI void ubegin(ColPre&, int, int, int, int) const {}
    template <int T> DI void pre(RowPre& R, int row, int pn, int wc, int fq) const { R.a[0] = ld4(wsp<float>(p, WS_SSQA) + (size_t)row * 16 + 12);
        if (4 * pn + wc < 8) { R.a[1].x = wsp<float>(p, WS_SSQPE)[row]; R.a[2] = ld4u(wsp<bf16_t>(p, WS_KPE) + (size_t)row * 32 + 8 * fq); } }
    template <int T> DI void apply(const ColPre&, const RowPre& R, int row, int pn, int wc, int fq, float (&v)[2][8]) const {
        const int s = 4 * pn + wc;
        const float rstd = rsqrtf(((R.a[0].x + R.a[0].y) + (R.a[0].z + R.a[0].w)) * (1.f / 256.f) + EPS);
#pragma unroll
        for (int b = 0; b < 2; ++b)
#pragma unroll
            for (int j = 0; j < 8; ++j) v[b][j] *= rstd;
        if (s < 8) { const float rk = rsqrtf((ssq16(v) + R.a[1].x) * (1.f / 96.f) + EPS);
#pragma unroll
            for (int b = 0; b < 2; ++b)
#pragma unroll
                for (int j = 0; j < 8; ++j) v[b][j] *= rk;
            float pe[8]; un8(R.a[2], pe);
#pragma unroll
            for (int j = 0; j < 8; ++j) pe[j] *= rk;
            bf16_t* d = wsp<bf16_t>(p, WS_KN) + (size_t)row * 768 + 96 * s + 8 * fq; store8bf(d, v[0]); store8bf(d + 32, v[1]); store8bf(d + 64, pe); }
        else { bf16_t* d = wsp<bf16_t>(p, WS_VM) + (size_t)row * 512 + 64 * (s - 8) + 8 * fq; store8bf(d, v[0]); store8bf(d + 32, v[1]); }
    }
};
struct EpiMerge {
    static constexpr bool HAS_MID = true; static constexpr int NTYPES = 1;
    Params p;
    DI int type(int, int) const { return 0; }
    DI void midpre(RowPre& R, int row, int pn, int wc, int fq) const {
        const bf16_t* g = wsp<bf16_t>(p, WS_R2) + (size_t)row * 2048 + 256 * pn + 32 * wc + 8 * fq;
        R.a[0] = ld4u(g); R.a[1] = ld4u(g + 128); R.a[2] = ld4u(g + 1024); R.a[3] = ld4u(g + 1024 + 128); }
    DI void mid(const RowPre& R, int, int, int, int, float (&v)[2][8]) const {
#pragma unroll
        for (int b = 0; b < 2; ++b) { float s1[8], s2[8]; un8(R.a[b], s1); un8(R.a[2 + b], s2);
#pragma unroll
            for (int j = 0; j < 8; ++j) v[b][j] *= s1[j] * __builtin_amdgcn_rcpf(s2[j]); }
    }
    template <int T> DI void ubegin(ColPre&, int, int, int, int) const {}
    template <int T> DI void pre(RowPre& R, int row, int pn, int wc, int fq) const {
        const bf16_t* g = wsp<bf16_t>(p, WS_R2) + (size_t)row * 2048 + 1024 + 256 * pn + 32 * wc + 8 * fq; R.a[0] = ld4u(g); R.a[1] = ld4u(g + 128); }
    template <int T> DI void apply(const ColPre&, const RowPre& R, int row, int pn, int wc, int fq, float (&v)[2][8]) const {
        bf16_t* d = wsp<bf16_t>(p, WS_R2) + (size_t)row * 2048 + 1024 + 256 * pn + 32 * wc + 8 * fq;
#pragma unroll
        for (int b = 0; b < 2; ++b) { float s2[8], o[8]; un8(R.a[b], s2);
#pragma unroll
            for (int j = 0; j < 8; ++j) o[j] = v[b][j] * s2[j];
            store8bf(d + 128 * b, o); }
    }
};
struct EpiOut {
    static constexpr bool HAS_MID = false; static constexpr int NTYPES = 1;
    Params p;
    DI int type(int, int) const { return 0; }
    DI void midpre(RowPre&, int, int, int, int) const {}
    DI void mid(const RowPre&, int, int, int, int, float (&)[2][8]) const {}
    template <int T> DI void ubegin(ColPre& U, int row0, int pn, int wc, int fq) const {
        const int b_ = row0 / SEQ, col = 256 * pn + 32 * wc + 8 * fq; const float* md = wsp<float>(p, WS_MOD) + b_ * 6144 + col; const float* g2 = p.in[I_N2G] + col;
#pragma unroll
        for (int i = 0; i < 4; ++i) { const int o = 128 * (i >> 1) + 4 * (i & 1); U.c[i] = ld4(md + 2 * 1024 + o); const f32x4 sc = ld4(md + 4 * 1024 + o), gg = ld4(g2 + o); U.c[4 + i] = gg * (1.0f + sc); }
    }
    template <int T> DI void pre(RowPre& R, int row, int pn, int wc, int fq) const { const float* x = p.in[I_X] + (size_t)row * DM + 256 * pn + 32 * wc + 8 * fq;
        R.a[0] = ld4(x); R.a[1] = ld4(x + 4); R.a[2] = ld4(x + 128); R.a[3] = ld4(x + 132); }
    template <int T> DI void apply(const ColPre& U, const RowPre& R, int row, int pn, int wc, int fq, float (&v)[2][8]) const {
        const int col = 256 * pn + 32 * wc + 8 * fq; bf16_t* d = wsp<bf16_t>(p, WS_R2) + (size_t)row * 2048 + col;   bf16_t* a2 = wsp<bf16_t>(p, WS_R1) + (size_t)row * DM + col;
        float q = 0.f;
#pragma unroll
        for (int b = 0; b < 2; ++b) { float o8[8], x8[8];
#pragma unroll
            for (int h = 0; h < 2; ++h) { const f32x4 g = U.c[2 * b + h], xv = R.a[2 * b + h], gs = U.c[4 + 2 * b + h];
                f32x4 o; o.x = xv.x + g.x * v[b][4 * h]; o.y = xv.y + g.y * v[b][4 * h + 1]; o.z = xv.z + g.z * v[b][4 * h + 2]; o.w = xv.w + g.w * v[b][4 * h + 3];
                x8[4 * h] = o.x; x8[4 * h + 1] = o.y; x8[4 * h + 2] = o.z; x8[4 * h + 3] = o.w;
                q += (o.x * o.x + o.y * o.y) + (o.z * o.z + o.w * o.w);
                o8[4 * h] = o.x * gs.x; o8[4 * h + 1] = o.y * gs.y; o8[4 * h + 2] = o.z * gs.z; o8[4 * h + 3] = o.w * gs.w; }
            store8bf(d + 128 * b, x8); store8bf(a2 + 128 * b, o8); }
        q += xorl<16>(q); q = sum32(q);
        if (fq == 0) wsp<float>(p, WS_SSQA)[(size_t)row * 16 + 4 * pn + wc] = q;
    }
};
struct EpiGU {
    static constexpr bool HAS_MID = false; static constexpr int NTYPES = 1;
    Params p;
    DI int type(int, int) const { return 0; }
    DI void midpre(RowPre&, int, int, int, int) const {}
    DI void mid(const RowPre&, int, int, int, int, float (&)[2][8]) const {}
    template <int T> DI void ubegin(ColPre& U, int row0, int pn, int wc, int fq) const { const float* sh = wsp<float>(p, WS_SHW) + (row0 / SEQ) * 5632 + 256 * pn + 32 * wc + 8 * fq;
        U.c[0] = ld4(sh); U.c[1] = ld4(sh + 4); U.c[2] = ld4(sh + 128); U.c[3] = ld4(sh + 132); }
    template <int T> DI void pre(RowPre& R, int row, int, int, int) const { const float* sq = wsp<float>(p, WS_SSQA) + (size_t)row * 16; R.a[0] = ld4(sq); R.a[1] = ld4(sq + 4); R.a[2] = ld4(sq + 8); R.a[3] = ld4(sq + 12); }
    template <int T> DI void apply(const ColPre& U, const RowPre& R, int row, int pn, int wc, int fq, float (&v)[2][8]) const {
        const int s = 4 * pn + wc; float o[8];
        const float tot = (((R.a[0].x + R.a[0].y) + (R.a[0].z + R.a[0].w)) + ((R.a[1].x + R.a[1].y) + (R.a[1].z + R.a[1].w))) + (((R.a[2].x + R.a[2].y) + (R.a[2].z + R.a[2].w)) + ((R.a[3].x + R.a[3].y) + (R.a[3].z + R.a[3].w)));
        const float rstd = rsqrtf(tot * (1.f / DM) + EPS);
#pragma unroll
        for (int j = 0; j < 8; ++j) o[j] = siluf(rstd * v[0][j] + U.c[j >> 2][j & 3]) * (rstd * v[1][j] + U.c[2 + (j >> 2)][j & 3]);
        store8bf(wsp<bf16_t>(p, WS_HID) + (size_t)row * DFF + 32 * s + 8 * fq, o);
    }
};
struct EpiDown {
    static constexpr bool HAS_MID = false; static constexpr int NTYPES = 1;
    Params p;
    DI int type(int, int) const { return 0; }
    DI void midpre(RowPre&, int, int, int, int) const {}
    DI void mid(const RowPre&, int, int, int, int, float (&)[2][8]) const {}
    template <int T> DI void ubegin(ColPre& U, int row0, int pn, int wc, int fq) const { const float* gt = wsp<float>(p, WS_MOD) + (row0 / SEQ) * 6144 + 5 * 1024 + 256 * pn + 32 * wc + 8 * fq;
        U.c[0] = ld4(gt); U.c[1] = ld4(gt + 4); U.c[2] = ld4(gt + 128); U.c[3] = ld4(gt + 132); }
    template <int T> DI void pre(RowPre& R, int row, int pn, int wc, int fq) const { const bf16_t* x = wsp<bf16_t>(p, WS_R2) + (size_t)row * 2048 + 256 * pn + 32 * wc + 8 * fq;
        R.a[0] = ld4u(x); R.a[1] = ld4u(x + 128); }
    template <int T> DI void apply(const ColPre& U, const RowPre& R, int row, int pn, int wc, int fq, float (&v)[2][8]) const {
        float* d = p.out + (size_t)row * DM + 256 * pn + 32 * wc + 8 * fq;
#pragma unroll
        for (int b = 0; b < 2; ++b) { float x8[8]; un8(R.a[b], x8);
#pragma unroll
            for (int h = 0; h < 2; ++h) { const f32x4 g = U.c[2 * b + h];
                f32x4 o; o.x = x8[4 * h] + g.x * v[b][4 * h]; o.y = x8[4 * h + 1] + g.y * v[b][4 * h + 1]; o.z = x8[4 * h + 2] + g.z * v[b][4 * h + 2]; o.w = x8[4 * h + 3] + g.w * v[b][4 * h + 3]; *(f32x4*)(d + 128 * b + 4 * h) = o; } }
    }
};
namespace pg8 {
#define PG8_LAS __attribute__((address_space(3)))
typedef short bf16x8 __attribute__((ext_vector_type(8)));
constexpr int BM = 256, BK = 64, HALF = 128, HTB = HALF * BK * 2  , STAGE_BYTES = 8 * HTB, NXCD = 8;
#ifndef PG8_WGM
#define PG8_WGM 8
#endif
constexpr int WGM = PG8_WGM;

__host__ __device__ __forceinline__ int lds_byte(int r, int c) { const int st = (r >> 4) * 2 + (c >> 5), rr = r & 15, cc = c & 31, ob = rr * 64 + cc * 2; return st * 1024 + (ob ^ (((ob >> 9) & 1) << 5)); }
__host__ __device__ __forceinline__ void stage_rc(int b, int& R, int& C) { const int st = b / 1024, sb = b % 1024, swz = sb ^ (((sb >> 9) & 1) << 5); R = (st >> 1) * 16 + swz / 64; C = (st & 1) * 32 + (swz % 64) / 2; }
__host__ __device__ __forceinline__ int perm32(int rho) { const int n = rho >> 4, i = rho & 15; return 8 * (i >> 2) + 4 * n + (i & 3); }

struct Unit { int pm, pn; };
struct Gemm { const bf16_t* A; const bf16_t* Bt; int M, N, K, lda, ldb, kstepA; };

struct StaticOrder {
    int nM, nN, nwg, G, c;
    __host__ __device__ void init(int M, int N, int G_, int c_) { nM = M / BM; nN = N / BM; nwg = nM * nN; G = G_; c = c_; }
    __host__ __device__ bool next(int i, Unit& u) const {
        const long L = (long)i * G + c; if (L >= nwg) return false;
        int wgid = (int)L; { const int q = nwg / NXCD, r = nwg % NXCD, xcd = wgid % NXCD, off = wgid / NXCD; wgid = (xcd < r ? xcd * (q + 1) : r * (q + 1) + (xcd - r) * q) + off; }
        const int nig = WGM * nN, gid = wgid / nig, fm = gid * WGM, gsz = (nM - fm) < WGM ? (nM - fm) : WGM;
        u.pm = fm + ((wgid % nig) % gsz); u.pn = (wgid % nig) / gsz; return true;
    }
    __device__ __forceinline__ void a_ready(const Unit&) const {}
    __device__ __forceinline__ void done(const Unit&) const {}
};

template <class Epi, class Sched, bool ALIGN_EPI = false, bool SP2 = false>
__device__ __forceinline__ void gemm_phase(PG8_LAS unsigned char* lds, const Gemm g, const Sched& S, const Epi& E, int wid0) {
    const int tid = opaque_tid(wid0), wid = __builtin_amdgcn_readfirstlane(tid >> 6), lane = tid & 63, wr = wid >> 2, wc = wid & 3, fr = lane & 15, fq = lane >> 4;
    const int K = g.K; int nt = K / BK; asm volatile("" : "+s"(nt));
    unsigned voffA[2], voffB[2];
#pragma unroll
    for (int i = 0; i < 2; ++i) { int R, C; stage_rc(tid * 16 + i * 8192, R, C); const int Rb = Epi::PERM ? ((R & ~31) + perm32(R & 31)) : R;
        voffA[i] = (unsigned)(R * g.lda + C) * 2u; voffB[i] = (unsigned)(Rb * g.ldb + C) * 2u; }
    const size_t kstep = (size_t)(BK * 2), kstepA = (size_t)g.kstepA;
    const size_t hstepB = (size_t)HALF * g.ldb * 2, hstepA = (size_t)HALF * g.lda * 2;
    const size_t tstepB = 2 * hstepB, tstepA = 2 * hstepA;
    const unsigned ldsw = (unsigned)wid * 1024u;
    const int aoff = lds_byte(wr * 64 + fr, fq * 8), boff = lds_byte(wc * 32 + fr, fq * 8);
#define PG8_SA(b, h) (((b) * 2 + (h)) * HTB)
#define PG8_SB(b, h) ((4 + (b) * 2 + (h)) * HTB)
#define PG8_STAGE(bufoff, gbase, voff) do { _Pragma("unroll") for (int _i = 0; _i < 2; ++_i) \
        __builtin_amdgcn_global_load_lds((const unsigned*)((const char*)(gbase) + (voff)[_i]), (PG8_LAS unsigned*)(lds + (bufoff) + ldsw + _i * 8192), 16, 0, 0); } while (0)
#define PG8_LDA(dst, b, h) do { _Pragma("unroll") for (int m = 0; m < 4; ++m) _Pragma("unroll") for (int k = 0; k < 2; ++k) dst[m][k] = *(const PG8_LAS bf16x8*)(lds + PG8_SA(b, h) + aoff + m * 2048 + k * 1024); } while (0)
#define PG8_LDB(dst, b, h) do { _Pragma("unroll") for (int n = 0; n < 2; ++n) _Pragma("unroll") for (int k = 0; k < 2; ++k) dst[n][k] = *(const PG8_LAS bf16x8*)(lds + PG8_SB(b, h) + boff + n * 2048 + k * 1024); } while (0)
#define PG8_MMA(ai, bj, At, Bt) do { __builtin_amdgcn_s_setprio(1); _Pragma("unroll") for (int m = 0; m < 4; ++m) _Pragma("unroll") for (int n = 0; n < 2; ++n) _Pragma("unroll") for (int k = 0; k < 2; ++k) \
        acc[ai][bj][m][n] = __builtin_amdgcn_mfma_f32_16x16x32_bf16(Bt[n][k], At[m][k], acc[ai][bj][m][n], 0, 0, 0); __builtin_amdgcn_s_setprio(0); } while (0)
#define PG8_WAIT_V(n) asm volatile("s_waitcnt vmcnt(" #n ")" ::: "memory")
#define PG8_WAIT_L(n) asm volatile("s_waitcnt lgkmcnt(" #n ")" ::: "memory")
#define PG8_BAR __builtin_amdgcn_s_barrier()
#define PG8_SCHED __builtin_amdgcn_sched_barrier(0)
    Unit cur, nxt; int ui = 0;
    if (!S.next(0, cur)) return;
    f32x4 acc[2][2][4][2];
#pragma unroll
    for (int a = 0; a < 2; ++a)
#pragma unroll
        for (int b = 0; b < 2; ++b)
#pragma unroll
            for (int m = 0; m < 4; ++m)
#pragma unroll
                for (int n = 0; n < 2; ++n) acc[a][b][m][n] = (f32x4){0.f, 0.f, 0.f, 0.f};
    bf16x8 At[4][2], B0[2][2], B1[2][2];
    const char* cA = (const char*)g.A + (size_t)cur.pm * tstepA; const char* cB = (const char*)g.Bt + (size_t)cur.pn * tstepB;
    S.a_ready(cur);
    if constexpr (SP2) {
        PG8_STAGE(PG8_SB(0, 0), cB, voffB); PG8_STAGE(PG8_SB(0, 1), cB + hstepB, voffB); PG8_STAGE(PG8_SA(0, 0), cA, voffA); PG8_STAGE(PG8_SA(0, 1), cA + hstepA, voffA);
        if (wr == 1) PG8_BAR;
        PG8_WAIT_V(2); PG8_BAR;
        PG8_STAGE(PG8_SB(1, 0), cB + kstep, voffB); PG8_STAGE(PG8_SA(1, 0), cA + kstepA, voffA); PG8_STAGE(PG8_SB(1, 1), cB + hstepB + kstep, voffB);
        PG8_WAIT_V(6); PG8_BAR;
    } else {
        PG8_STAGE(PG8_SB(0, 0), cB, voffB); PG8_STAGE(PG8_SA(0, 0), cA, voffA); PG8_STAGE(PG8_SB(0, 1), cB + hstepB, voffB); PG8_STAGE(PG8_SA(0, 1), cA + hstepA, voffA);
        if (wr == 1) PG8_BAR;
        PG8_WAIT_V(4); PG8_BAR;
        PG8_STAGE(PG8_SB(1, 0), cB + kstep, voffB); PG8_STAGE(PG8_SA(1, 0), cA + kstepA, voffA); PG8_STAGE(PG8_SB(1, 1), cB + hstepB + kstep, voffB);
        PG8_WAIT_V(6); PG8_BAR;
    }
    for (;;) {
        const bool has_next = S.next(ui + 1, nxt);
        const char* nA = has_next ? (const char*)g.A + (size_t)nxt.pm * tstepA : cA; const char* nB = has_next ? (const char*)g.Bt + (size_t)nxt.pn * tstepB : cB;
        for (int hh_ = 0; hh_ < (Epi::HAS_MID ? 2 : 1); ++hh_) {
        if constexpr (Epi::HAS_MID) { if (hh_ == 1) E.mid(acc, cur, wr, wc, fr, fq); }
        const int t0_ = Epi::HAS_MID ? hh_ * (nt >> 1) : 0, t1_ = Epi::HAS_MID ? (hh_ + 1) * (nt >> 1) : nt;
        for (int t = t0_; t < t1_; t += 2) {
            const bool last = (t == nt - 2);
            const char* a1 = cA + (size_t)(t + 1) * kstepA;
            const char* a2 = last ? nA : cA + (size_t)(t + 2) * kstepA; const char* b2 = last ? nB : cB + (size_t)(t + 2) * kstep;
            const char* a3 = a2 + kstepA; const char* b3 = b2 + kstep;
            if (last && has_next) S.a_ready(nxt);
            if constexpr (SP2) {
            PG8_LDB(B0, 0, 0); PG8_LDB(B1, 0, 1); PG8_SCHED; PG8_LDA(At, 0, 0); PG8_STAGE(PG8_SA(1, 1), a1 + hstepA, voffA);
            PG8_WAIT_V(8); PG8_WAIT_L(0); PG8_BAR; PG8_MMA(0, 0, At, B0); PG8_MMA(0, 1, At, B1); PG8_BAR; PG8_SCHED;
            PG8_LDA(At, 0, 1); PG8_STAGE(PG8_SB(0, 0), b2, voffB); PG8_STAGE(PG8_SB(0, 1), b2 + hstepB, voffB); PG8_STAGE(PG8_SA(0, 0), a2, voffA);
            PG8_WAIT_V(8); PG8_WAIT_L(0); PG8_BAR; PG8_MMA(1, 0, At, B0); PG8_MMA(1, 1, At, B1); PG8_BAR; PG8_SCHED;
            PG8_LDB(B0, 1, 0); PG8_LDB(B1, 1, 1); PG8_SCHED; PG8_LDA(At, 1, 0); PG8_STAGE(PG8_SA(0, 1), a2 + hstepA, voffA);
            PG8_WAIT_V(8); PG8_WAIT_L(0); PG8_BAR; PG8_MMA(0, 0, At, B0); PG8_MMA(0, 1, At, B1); PG8_BAR; PG8_SCHED;
            PG8_LDA(At, 1, 1); PG8_STAGE(PG8_SB(1, 0), b3, voffB); PG8_STAGE(PG8_SB(1, 1), b3 + hstepB, voffB); PG8_STAGE(PG8_SA(1, 0), a3, voffA);
            PG8_WAIT_V(8); PG8_WAIT_L(0); PG8_BAR; PG8_MMA(1, 0, At, B0); PG8_MMA(1, 1, At, B1); PG8_BAR; PG8_SCHED;
            } else {
            PG8_LDB(B0, 0, 0); PG8_SCHED; PG8_LDA(At, 0, 0); PG8_STAGE(PG8_SA(1, 1), a1 + hstepA, voffA);
            PG8_WAIT_L(8); PG8_BAR; PG8_WAIT_L(0); PG8_MMA(0, 0, At, B0); PG8_BAR; PG8_SCHED;
            PG8_LDB(B1, 0, 1); PG8_STAGE(PG8_SB(0, 0), b2, voffB);
            PG8_BAR; PG8_WAIT_L(0); PG8_MMA(0, 1, At, B1); PG8_BAR;
            PG8_LDA(At, 0, 1); PG8_STAGE(PG8_SA(0, 0), a2, voffA);
            PG8_BAR; PG8_WAIT_L(0); PG8_MMA(1, 0, At, B0); PG8_BAR; PG8_SCHED;
            PG8_STAGE(PG8_SB(0, 1), b2 + hstepB, voffB);
            PG8_WAIT_V(6); PG8_BAR; PG8_MMA(1, 1, At, B1); PG8_BAR;
            PG8_LDB(B0, 1, 0); PG8_SCHED; PG8_LDA(At, 1, 0); PG8_STAGE(PG8_SA(0, 1), a2 + hstepA, voffA);
            PG8_WAIT_L(8); PG8_BAR; PG8_WAIT_L(0); PG8_MMA(0, 0, At, B0); PG8_BAR; PG8_SCHED;
            PG8_LDB(B1, 1, 1); PG8_STAGE(PG8_SB(1, 0), b3, voffB);
            PG8_BAR; PG8_WAIT_L(0); PG8_MMA(0, 1, At, B1); PG8_BAR;
            PG8_LDA(At, 1, 1); PG8_STAGE(PG8_SA(1, 0), a3, voffA);
            PG8_BAR; PG8_WAIT_L(0); PG8_MMA(1, 0, At, B0); PG8_BAR; PG8_SCHED;
            PG8_STAGE(PG8_SB(1, 1), b3 + hstepB, voffB);
            PG8_WAIT_V(6); PG8_BAR; PG8_MMA(1, 1, At, B1); PG8_BAR;
            }
        }
        }
        if constexpr (ALIGN_EPI) { if (wr == 0) PG8_BAR; }
        if constexpr (!Epi::AFTER_DRAIN) { E(acc, cur, wr, wc, fr, fq); S.done(cur); }
        if (!has_next) break;
#pragma unroll
        for (int a = 0; a < 2; ++a)
#pragma unroll
            for (int b = 0; b < 2; ++b)
#pragma unroll
                for (int m = 0; m < 4; ++m)
#pragma unroll
                    for (int n = 0; n < 2; ++n) acc[a][b][m][n] = (f32x4){0.f, 0.f, 0.f, 0.f};
        cur = nxt; cA = nA; cB = nB; ++ui;
        if constexpr (ALIGN_EPI) { if (wr == 1) PG8_BAR; }
    }
    PG8_WAIT_V(0);
    if constexpr (!ALIGN_EPI) { if (wr == 0) PG8_BAR; }
    PG8_BAR;
    if constexpr (Epi::AFTER_DRAIN) { E.fused(acc, cur, wr, wc, fr, fq, lds, wid, lane); S.done(cur); }
#undef PG8_SA
#undef PG8_SB
#undef PG8_STAGE
#undef PG8_LDA
#undef PG8_LDB
#undef PG8_MMA
#undef PG8_WAIT_V
#undef PG8_WAIT_L
#undef PG8_BAR
#undef PG8_SCHED
}
}

#ifndef PG8_SP2V
#define PG8_SP2V true
#endif
template <class SE> struct EpiAdapt {
    static constexpr bool PERM = true, AFTER_DRAIN = false, HAS_MID = SE::HAS_MID;
    SE se;
    template <int T> DI void run(f32x4 (&acc)[2][2][4][2], const pg8::Unit& u, int wr, int wc, int fr, int fq) const {
        int frr = fr; asm volatile("" : "+v"(frr));
        const int rbase = u.pm * 256 + wr * 64;
        ColPre U; se.template ubegin<T>(U, rbase, u.pn, wc, fq);
        RowPre R[2]; se.template pre<T>(R[0], rbase + frr, u.pn, wc, fq);
#pragma unroll
        for (int it = 0; it < 8; ++it) {
            const int ai = it >> 2, m = it & 3; const int row = rbase + ai * 128 + m * 16 + frr;
            if (it < 7) se.template pre<T>(R[(it + 1) & 1], rbase + ((it + 1) >> 2) * 128 + ((it + 1) & 3) * 16 + frr, u.pn, wc, fq);
            float v[2][8];
#pragma unroll
            for (int bj = 0; bj < 2; ++bj)
#pragma unroll
                for (int n = 0; n < 2; ++n) { v[bj][4 * n] = acc[ai][bj][m][n][0]; v[bj][4 * n + 1] = acc[ai][bj][m][n][1]; v[bj][4 * n + 2] = acc[ai][bj][m][n][2]; v[bj][4 * n + 3] = acc[ai][bj][m][n][3]; }
            se.template apply<T>(U, R[it & 1], row, u.pn, wc, fq, v);
        }
    }
    template <int T> DI void disp(int ty, f32x4 (&acc)[2][2][4][2], const pg8::Unit& u, int wr, int wc, int fr, int fq) const {
        if constexpr (T < SE::NTYPES) { if (ty == T) run<T>(acc, u, wr, wc, fr, fq); else disp<T + 1>(ty, acc, u, wr, wc, fr, fq); }
    }
    DI void operator()(f32x4 (&acc)[2][2][4][2], const pg8::Unit& u, int wr, int wc, int fr, int fq) const { disp<0>(se.type(u.pn, wc), acc, u, wr, wc, fr, fq); }
    DI void mid(f32x4 (&acc)[2][2][4][2], const pg8::Unit& u, int wr, int wc, int fr, int fq) const {
        int frr = fr; asm volatile("" : "+v"(frr));
        const int rbase = u.pm * 256 + wr * 64;
        RowPre R[2]; se.midpre(R[0], rbase + frr, u.pn, wc, fq);
#pragma unroll
        for (int it = 0; it < 8; ++it) {
            const int ai = it >> 2, m = it & 3; const int row = rbase + ai * 128 + m * 16 + frr;
            if (it < 7) se.midpre(R[(it + 1) & 1], rbase + ((it + 1) >> 2) * 128 + ((it + 1) & 3) * 16 + frr, u.pn, wc, fq);
            float v[2][8];
#pragma unroll
            for (int bj = 0; bj < 2; ++bj)
#pragma unroll
                for (int n = 0; n < 2; ++n) { v[bj][4 * n] = acc[ai][bj][m][n][0]; v[bj][4 * n + 1] = acc[ai][bj][m][n][1]; v[bj][4 * n + 2] = acc[ai][bj][m][n][2]; v[bj][4 * n + 3] = acc[ai][bj][m][n][3]; }
            se.mid(R[it & 1], row, u.pn, wc, fq, v);
#pragma unroll
            for (int bj = 0; bj < 2; ++bj)
#pragma unroll
                for (int n = 0; n < 2; ++n) { acc[ai][bj][m][n][0] = v[bj][4 * n]; acc[ai][bj][m][n][1] = v[bj][4 * n + 1]; acc[ai][bj][m][n][2] = v[bj][4 * n + 2]; acc[ai][bj][m][n][3] = v[bj][4 * n + 3]; }
        }
    }
};
template <class SE, bool ALIGN = true> DI void gemm_fast(PG8_LAS unsigned char* lds, const bf16_t* A, int lda, const bf16_t* Bt, int M, int N, int K, const SE& se, int G, int c, int wid0) {
    pg8::Gemm g{A, Bt, M, N, K, lda, K, 128}; pg8::StaticOrder S; S.init(M, N, G, c);
    EpiAdapt<SE> E{se};
    pg8::gemm_phase<EpiAdapt<SE>, pg8::StaticOrder, ALIGN, PG8_SP2V>(lds, g, S, E, wid0);
}
struct RangeOrder {
    int base, cnt, nN;
    DI bool next(int i, pg8::Unit& u) const { if (i >= cnt) return false; const int L = base + i; u.pm = L / nN; u.pn = L % nN; return true; }
    DI void a_ready(const pg8::Unit&) const {}
    DI void done(const pg8::Unit&) const {}
};
template <class SE> DI void gemm_fast_range(PG8_LAS unsigned char* lds, const bf16_t* A, int lda, const bf16_t* Bt, int M, int N, int K, const SE& se, int base, int cnt, int wid0) {
    pg8::Gemm g{A, Bt, M, N, K, lda, K, 128}; RangeOrder S{base, cnt, N / 256};
    EpiAdapt<SE> E{se};
    pg8::gemm_phase<EpiAdapt<SE>, RangeOrder, true, true>(lds, g, S, E, wid0);
}
struct OneUnit {
    int pm, pn;
    DI bool next(int i, pg8::Unit& u) const { if (i > 0) return false; u.pm = pm; u.pn = pn; return true; }
    DI void a_ready(const pg8::Unit&) const {}
    DI void done(const pg8::Unit&) const {}
};
struct EpiCmpH {
    static constexpr bool HAS_MID = false; static constexpr int NTYPES = 1;
    float* H;
    DI int type(int, int) const { return 0; }
    DI void midpre(RowPre&, int, int, int, int) const {}
    DI void mid(const RowPre&, int, int, int, int, float (&)[2][8]) const {}
    template <int T> DI void ubegin(ColPre&, int, int, int, int) const {}
    template <int T> DI void pre(RowPre&, int, int, int, int) const {}
    template <int T> DI void apply(const ColPre&, const RowPre&, int row, int pn, int wc, int fq, float (&v)[2][8]) const {
        float* d = H + (size_t)row * 256 + 32 * wc + 8 * fq;
#pragma unroll
        for (int b = 0; b < 2; ++b) { st16f(d + 128 * b, (f32x4){v[b][0], v[b][1], v[b][2], v[b][3]}); st16f(d + 128 * b + 4, (f32x4){v[b][4], v[b][5], v[b][6], v[b][7]}); }
    }
};
DI void cmp_hidden_fast(const Params& p, PG8_LAS unsigned char* lds, int cu, int wid0) {
    const int kv = cu >> 4, g = (cu >> 3) & 1, pm = (cu >> 1) & 3, sp = cu & 1;
    const bf16_t* A = wsp<bf16_t>(p, kv ? WS_VC : WS_KC) + g * 64 + (size_t)(16 * sp) * 128;
    const bf16_t* Bt = wsp<bf16_t>(p, WS_CW1) + (size_t)kv * 256 * 2048 + 1024 * sp;
    pg8::Gemm gm{A, Bt, 1024, 256, 1024, 2048, 2048, 256}; OneUnit S{pm, 0};
    EpiCmpH se{cmph(p) + (size_t)((kv * 2 + g) * 2 + sp) * 1024 * 256};
    EpiAdapt<EpiCmpH> E{se};
    pg8::gemm_phase<EpiAdapt<EpiCmpH>, OneUnit, true, true>(lds, gm, S, E, wid0);
}
template <bool SPLIT> DI void cmp_out(const Params& p, int gw, int ngw, int lane, int bfix, LAS float* ldsw, int tid) {
    static_assert(SPLIT, "split-K partials only");
    const float* H = cmph(p);
    if (bfix >= 0) { const float* w2g = ((gw >> 7) ? p.in[I_CW2V] : p.in[I_CW2K]); f32x4 t[8];
#pragma unroll
        for (int it = 0; it < 8; ++it) t[it] = *(const f32x4*)(w2g + 4 * tid + 2048 * it);
#pragma unroll
        for (int it = 0; it < 8; ++it) *(LAS f32x4*)(ldsw + 4 * tid + 2048 * it) = t[it];
        __syncthreads(); }
    for (int i = gw; i < ((bfix < 0) ? 2048 : 256); i += ngw) {
        const int kg = (bfix < 0) ? (i >> 9) : (i >> 6), g = kg & 1, kv = kg >> 1;
        const int r0 = (bfix < 0) ? 2 * (i & 511) : (bfix * 128 + 2 * (i & 63));
        const int b = r0 >> 7, n0 = r0 & 127;
        bf16_t* dst = wsp<bf16_t>(p, kv ? WS_VCF : WS_KCF) + (size_t)r0 * 128 + g * 64 + lane;
        const float* w2 = (kv ? p.in[I_CW2V] : p.in[I_CW2K]) + lane;
        const float* h = H + ((size_t)((kv * 2 + g) * 2) * 1024 + r0) * 256; const float* cb = wsp<float>(p, WS_CB1) + kv * 256;
        float hv[2][4];
#pragma unroll
        for (int q = 0; q < 4; ++q) { const int j = 64 * q + lane; const float cbj = (cb[j] + cb[512 + j]) + (cb[1024 + j] + cb[1536 + j]);
            hv[0][q] = siluf((h[j] + h[(size_t)1024 * 256 + j]) + cbj); hv[1][q] = siluf((h[256 + j] + h[(size_t)1024 * 256 + 256 + j]) + cbj); }
        float acc[2] = {0.f, 0.f};
#pragma unroll
        for (int q = 0; q < 4; ++q)
#pragma unroll 16
            for (int jj = 0; jj < 64; ++jj) { const float w = (bfix >= 0) ? ldsw[(64 * q + jj) * 64 + lane] : w2[(64 * q + jj) * 64];
                acc[0] += __int_as_float(__builtin_amdgcn_readlane(__float_as_int(hv[0][q]), jj)) * w;
                acc[1] += __int_as_float(__builtin_amdgcn_readlane(__float_as_int(hv[1][q]), jj)) * w; }
#pragma unroll
        for (int e = 0; e < 2; ++e) {
            float y = acc[e];
            if (kv == 0) {
                const float rstd = rsqrtf(wave_sum(y * y) * (1.f / 64.f) + EPS);
                y = y * rstd * p.in[I_NKCG][lane];
                const int prow = b * SEQ + 16 * (n0 + e) + 31; const float oth = xorl<8>(y);
                if (lane < 16) { const int pr = (prow < MT) ? prow : MT - 1; const float c = ropeCN(p)[(size_t)pr * 8 + (lane & 7)], s = ropeSN(p)[(size_t)pr * 8 + (lane & 7)]; y = (lane < 8) ? y * c - oth * s : y * c + oth * s; }
            }
            if (n0 + e == 127) y = 0.f;
            dst[e * 128] = (bf16_t)f2bf(y);
        }
    }
}

DI unsigned select_blocks(const float (&imp)[32], int cur) {
    if (cur < 8) return (2u << cur) - 1u;
    unsigned mask = 1u | (1u << cur) | (1u << (cur - 1));
#pragma unroll 1
    for (int it = 0; it < 5; ++it) {
        float best = -1.0f; int bi = 1;
#pragma unroll
        for (int j = 1; j < 32; ++j) { const bool ok = (j <= cur - 2) && !((mask >> j) & 1u); if (ok && imp[j] > best) { best = imp[j]; bi = j; } }
        mask |= 1u << bi;
    }
    return mask;
}

namespace fa {
typedef short bf16x8 __attribute__((ext_vector_type(8)));
typedef short s16x4 __attribute__((ext_vector_type(4)));
typedef float f32x16 __attribute__((ext_vector_type(16)));
typedef LAS const char* lds_cptr;
typedef LAS char* lds_ptr;
constexpr int KBUF = 12288, VBUF = 8192;
constexpr int KCS = 1056;
constexpr int L_K = 0, L_V = 2 * KBUF, L_WS = 3 * 12 * KCS + 2 * 8192, L_OST = L_WS + 8 * 256, L_END = L_OST + 8 * 8192;
static_assert(L_V + 2 * VBUF <= L_WS && L_END <= 131072, "attention LDS map");
#define FA_SBAR() __builtin_amdgcn_sched_barrier(0)
DI int crow(int r, int hi) { return (r & 3) + 8 * (r >> 2) + 4 * hi; }
typedef float f32x2_t __attribute__((ext_vector_type(2))); typedef __bf16 bf16x2_t __attribute__((ext_vector_type(2)));
DI unsigned cvtpk(float lo, float hi) { f32x2_t v = {lo, hi}; bf16x2_t b = __builtin_convertvector(v, bf16x2_t); return __builtin_bit_cast(unsigned, b); }

template <int DK, int CS = 1024> DI void qkt(f32x16& p0, f32x16& p1, lds_cptr kb, const bf16x8* qr) {
    f32x16 z;
#pragma unroll
    for (int i = 0; i < 16; ++i) z[i] = 0.f;
#pragma unroll
    for (int d0 = 0; d0 < DK / 16; ++d0) {
        const bf16x8 b0 = *(const LAS bf16x8*)(kb + d0 * 2 * CS);
        const bf16x8 b1 = *(const LAS bf16x8*)(kb + d0 * 2 * CS + 512);
        if (d0 == 0) { p0 = __builtin_amdgcn_mfma_f32_32x32x16_bf16(b0, qr[0], z, 0, 0, 0); p1 = __builtin_amdgcn_mfma_f32_32x32x16_bf16(b1, qr[0], z, 0, 0, 0); }
        else { p0 = __builtin_amdgcn_mfma_f32_32x32x16_bf16(b0, qr[d0], p0, 0, 0, 0); p1 = __builtin_amdgcn_mfma_f32_32x32x16_bf16(b1, qr[d0], p1, 0, 0, 0); }
    }
}
typedef short v4i16_t __attribute__((ext_vector_type(4)));
DI s16x4 vtr(int addr) { return __builtin_bit_cast(s16x4, __builtin_amdgcn_ds_read_tr16_b64_v4i16((LAS v4i16_t*)(uintptr_t)(unsigned)addr)); }
DI bf16x8 vfrag(int addr) { const s16x4 lo = vtr(addr), hi = vtr(addr + 512); return (bf16x8){lo[0], lo[1], lo[2], lo[3], hi[0], hi[1], hi[2], hi[3]}; }
DI void pv(f32x16* o, int vb, bf16x8 pa0, bf16x8 pa1, bf16x8 pa2, bf16x8 pa3) {
#pragma unroll
    for (int d0 = 0; d0 < 2; ++d0) { s16x4 lo[4], hi[4];
#pragma unroll
        for (int ks = 0; ks < 4; ++ks) { lo[ks] = vtr(vb + d0 * 4096 + ks * 1024); hi[ks] = vtr(vb + d0 * 4096 + ks * 1024 + 512); }
#define FA_PK(k) (bf16x8){lo[k][0], lo[k][1], lo[k][2], lo[k][3], hi[k][0], hi[k][1], hi[k][2], hi[k][3]}
        o[d0] = __builtin_amdgcn_mfma_f32_32x32x16_bf16(pa0, FA_PK(0), o[d0], 0, 0, 0);
        o[d0] = __builtin_amdgcn_mfma_f32_32x32x16_bf16(pa1, FA_PK(1), o[d0], 0, 0, 0);
        o[d0] = __builtin_amdgcn_mfma_f32_32x32x16_bf16(pa2, FA_PK(2), o[d0], 0, 0, 0);
        o[d0] = __builtin_amdgcn_mfma_f32_32x32x16_bf16(pa3, FA_PK(3), o[d0], 0, 0, 0);
#undef FA_PK
    }
}
DI void pack_p(const f32x16& p0, const f32x16& p1, bf16x8& a0, bf16x8& a1, bf16x8& a2, bf16x8& a3) {
    u32x4 w0, w1, w2, w3;
    w0.x = cvtpk(p0[0], p0[1]); w0.y = cvtpk(p0[2], p0[3]); w0.z = cvtpk(p0[4], p0[5]); w0.w = cvtpk(p0[6], p0[7]);
    w1.x = cvtpk(p0[8], p0[9]); w1.y = cvtpk(p0[10], p0[11]); w1.z = cvtpk(p0[12], p0[13]); w1.w = cvtpk(p0[14], p0[15]);
    w2.x = cvtpk(p1[0], p1[1]); w2.y = cvtpk(p1[2], p1[3]); w2.z = cvtpk(p1[4], p1[5]); w2.w = cvtpk(p1[6], p1[7]);
    w3.x = cvtpk(p1[8], p1[9]); w3.y = cvtpk(p1[10], p1[11]); w3.z = cvtpk(p1[12], p1[13]); w3.w = cvtpk(p1[14], p1[15]);
    a0 = __builtin_bit_cast(bf16x8, w0); a1 = __builtin_bit_cast(bf16x8, w1); a2 = __builtin_bit_cast(bf16x8, w2); a3 = __builtin_bit_cast(bf16x8, w3);
}
DI void mask_range(f32x16& p0, f32x16& p1, int key0, int lo, int hi_, int hf) {
#pragma unroll
    for (int r = 0; r < 16; ++r) { const int k = key0 + crow(r, hf); if (k < lo || k > hi_) p0[r] = -INFINITY; if (k + 32 < lo || k + 32 > hi_) p1[r] = -INFINITY; }
}
DI float max3(float a, float b, float c) { return fmaxf(fmaxf(a, b), c); }
DI float rowmax32(const f32x16& p0, const f32x16& p1) {
    float a = max3(p0[0], p0[1], p0[2]), b = max3(p0[3], p0[4], p0[5]), c = max3(p0[6], p0[7], p0[8]), d = max3(p0[9], p0[10], p0[11]);
    a = max3(a, p0[12], p0[13]); b = max3(b, p0[14], p0[15]); c = max3(c, p1[0], p1[1]); d = max3(d, p1[2], p1[3]);
    a = max3(a, p1[4], p1[5]); b = max3(b, p1[6], p1[7]); c = max3(c, p1[8], p1[9]); d = max3(d, p1[10], p1[11]);
    a = max3(a, p1[12], p1[13]); b = max3(b, p1[14], p1[15]);
    return max32(fmaxf(fmaxf(a, b), fmaxf(c, d)));
}
struct State { float m, l; f32x16 o[2]; };
DI void st_init(State& s) { s.m = -INFINITY; s.l = 0.f;
#pragma unroll
    for (int i = 0; i < 16; ++i) { s.o[0][i] = 0.f; s.o[1][i] = 0.f; } }
DI void softmax_pv(State& st, f32x16& p0, f32x16& p1, int vb, LAS float* wsf, int r32, int hf) {
    const float rm = rowmax32(p0, p1);
    const float mn = fmaxf(st.m, rm), mu = (mn == -INFINITY) ? 0.f : mn;
    const float alpha = __builtin_amdgcn_exp2f(st.m - mu);
    st.m = mn;
    float ls0 = 0.f, ls1 = 0.f, ls2 = 0.f, ls3 = 0.f;
#pragma unroll
    for (int r = 0; r < 16; r += 2) { p0[r] = __builtin_amdgcn_exp2f(p0[r] - mu); p1[r] = __builtin_amdgcn_exp2f(p1[r] - mu); p0[r + 1] = __builtin_amdgcn_exp2f(p0[r + 1] - mu); p1[r + 1] = __builtin_amdgcn_exp2f(p1[r + 1] - mu);
        ls0 += p0[r]; ls1 += p1[r]; ls2 += p0[r + 1]; ls3 += p1[r + 1]; }
    st.l = st.l * alpha + ((ls0 + ls1) + (ls2 + ls3));
    if (__any(alpha != 1.0f)) {
        if (hf == 0) wsf[r32] = alpha;
        asm volatile("s_waitcnt lgkmcnt(0)" ::: "memory");
#pragma unroll
        for (int g = 0; g < 4; ++g) { const f32x4 a = *(const LAS f32x4*)(wsf + 8 * g + 4 * hf);
            st.o[0][4 * g] *= a.x; st.o[0][4 * g + 1] *= a.y; st.o[0][4 * g + 2] *= a.z; st.o[0][4 * g + 3] *= a.w;
            st.o[1][4 * g] *= a.x; st.o[1][4 * g + 1] *= a.y; st.o[1][4 * g + 2] *= a.z; st.o[1][4 * g + 3] *= a.w; }
    }
    bf16x8 a0, a1, a2, a3; pack_p(p0, p1, a0, a1, a2, a3);
    pv(st.o, vb, a0, a1, a2, a3);
}
DI void accum_scaled(f32x16* acc, const f32x16* o, float fac_row, LAS float* wsf, int r32, int hf) {
    if (hf == 0) wsf[32 + r32] = fac_row;
    asm volatile("s_waitcnt lgkmcnt(0)" ::: "memory");
#pragma unroll
    for (int g = 0; g < 4; ++g) { const f32x4 a = *(const LAS f32x4*)(wsf + 32 + 8 * g + 4 * hf);
        acc[0][4 * g] += o[0][4 * g] * a.x; acc[0][4 * g + 1] += o[0][4 * g + 1] * a.y; acc[0][4 * g + 2] += o[0][4 * g + 2] * a.z; acc[0][4 * g + 3] += o[0][4 * g + 3] * a.w;
        acc[1][4 * g] += o[1][4 * g] * a.x; acc[1][4 * g + 1] += o[1][4 * g + 1] * a.y; acc[1][4 * g + 2] += o[1][4 * g + 2] * a.z; acc[1][4 * g + 3] += o[1][4 * g + 3] * a.w; }
}
template <bool FIRST> DI void accum_lds(LAS float* accw, const f32x16* o, float fac_row, LAS float* wsf, int r32, int hf) {
    if (hf == 0) wsf[32 + r32] = fac_row;
    asm volatile("s_waitcnt lgkmcnt(0)" ::: "memory");
#pragma unroll
    for (int r = 0; r < 16; ++r) { const int orow = crow(r, hf); const float a = wsf[32 + orow];
        LAS float* d0 = accw + orow * 64 + r32; LAS float* d1 = d0 + 32;
        if (FIRST) { *d0 = o[0][r] * a; *d1 = o[1][r] * a; } else { *d0 += o[0][r] * a; *d1 += o[1][r] * a; } }
}
DI void stage_rows(const f32x16* acc, LAS bf16_t* stg, int r32, int hf) {
#pragma unroll
    for (int r = 0; r < 16; ++r) { const int orow = crow(r, hf);
        stg[orow * 64 + r32] = (bf16_t)f2bf(acc[0][r]); stg[orow * 64 + 32 + r32] = (bf16_t)f2bf(acc[1][r]); }
    asm volatile("s_waitcnt lgkmcnt(0)" ::: "memory");
}

struct TileSrc { const unsigned char* k; const unsigned char* v; unsigned ko, vo; long kstep, vstep; int klds; bool k2on; };
#ifndef FA_THRL
#define FA_THRL 8.0f
#endif
template <int DK, class MaskF>
DI void pipe_attn(LAS unsigned char* lds, const TileSrc src, int T, const bf16x8 (&qr)[DK / 16], const MaskF& maskf, f32x16 (&o)[2], float& l_out,
                  int wv, int lane, int r32, int hf, LAS float* wsf) {
    constexpr int KB = (DK / 8) * KCS;
    constexpr int PL_V = 3 * KB;
    const LAS unsigned char* kfrag0 = lds + L_K + hf * KCS + r32 * 16;
    const int vfrag0 = (int)(uintptr_t)(lds + L_K + PL_V) + ((lane >> 4) & 1) * 32 + (lane & 3) * 8 + (4 * hf + ((lane & 15) >> 2)) * 64;
    LAS unsigned char* kst0 = lds + L_K + src.klds; LAS unsigned char* kst1 = kst0 + 32 * 16; LAS unsigned char* vst0 = lds + L_K + PL_V + wv * 1024 + lane * 16;
    u32x4 kreg, kreg2, vreg;
    const bool k2on = (DK == 96) && src.k2on, kon = (DK == 64) || src.k2on;
#define PL_KADDR(i) (src.k + (long)(i) * src.kstep)
#define PL_KLOAD(i) do { if (kon) kreg = *(const u32x4*)(PL_KADDR(i) + (size_t)src.ko); if (k2on) kreg2 = *(const u32x4*)(PL_KADDR(i) + 32 * 768 * 2 + (size_t)src.ko); } while (0)
#define PL_KSTORE(buf) do { if (kon) *(LAS u32x4*)(kst0 + (buf) * KB) = kreg; if (k2on) *(LAS u32x4*)(kst1 + (buf) * KB) = kreg2; } while (0)
#define PL_VLOAD(i) (vreg = *(const u32x4*)(src.v + (long)(i) * src.vstep + (size_t)src.vo))
    __syncthreads();
    { u32x4 ka_, kb_, kc_, ka2_, kb2_, kc2_; const int t1 = (T > 1) ? 1 : 0, t2 = (T > 2) ? 2 : 0;
      if (kon) { ka_ = *(const u32x4*)(PL_KADDR(0) + (size_t)src.ko); kb_ = *(const u32x4*)(PL_KADDR(t1) + (size_t)src.ko); kc_ = *(const u32x4*)(PL_KADDR(t2) + (size_t)src.ko); } PL_VLOAD(0);
      if (k2on) { ka2_ = *(const u32x4*)(PL_KADDR(0) + 32 * 768 * 2 + (size_t)src.ko); kb2_ = *(const u32x4*)(PL_KADDR(t1) + 32 * 768 * 2 + (size_t)src.ko); kc2_ = *(const u32x4*)(PL_KADDR(t2) + 32 * 768 * 2 + (size_t)src.ko); }
      if (kon) { *(LAS u32x4*)(kst0) = ka_; *(LAS u32x4*)(kst0 + KB) = kb_; *(LAS u32x4*)(kst0 + 2 * KB) = kc_; } *(LAS u32x4*)(vst0) = vreg;
      if (k2on) { *(LAS u32x4*)(kst1) = ka2_; *(LAS u32x4*)(kst1 + KB) = kb2_; *(LAS u32x4*)(kst1 + 2 * KB) = kc2_; } }
    if (T > 3) PL_KLOAD(3);
    if (T > 1) PL_VLOAD(1);
    __syncthreads();
    float mhat, l_reg = 0.f; f32x16 negm; bool resc = false;
    f32x16 pA0, pA1, pB0, pB1;
#pragma unroll
    for (int i = 0; i < 16; ++i) { o[0][i] = 0.f; o[1][i] = 0.f; }
    qkt<DK, KCS>(pA0, pA1, (lds_cptr)kfrag0, qr); maskf(pA0, pA1, 0);
    { const float rm = rowmax32(pA0, pA1); mhat = rm;
#pragma unroll
      for (int r = 0; r < 16; ++r) { pA0[r] = __builtin_amdgcn_exp2f(pA0[r] - rm); pA1[r] = __builtin_amdgcn_exp2f(pA1[r] - rm); negm[r] = -rm; }
      asm volatile("" : "+v"(negm)); }
    __syncthreads();
    u32x4 pw0, pw1, pw2, pw3;
    int kb_cur = 1, kb_st = 0, vb_prev = 0;
#define PL_PIN(x) asm volatile("" : "+v"(x))
#define PL_SB() __builtin_amdgcn_sched_barrier(0)
#define PL_KF(j) (*(const LAS bf16x8*)(kp_ + ((j) >> 1) * 2 * KCS + ((j) & 1) * 512))
#define PL_VF(i) vfrag(vp_ + ((i) >> 2) * 4096 + ((i) & 3) * 1024)
#define PL_PAF(k) __builtin_bit_cast(bf16x8, pw##k)
#define PL_WORK(A0, A1, A2, A3, W0, W1, PW) do { sacc += A0; sacc += A1; sacc += A2; sacc += A3; PL_PIN(sacc); W0; W1; PL_PIN(PW); } while (0)
#define PL_GAPB(MF, X, B) do { MF; X[B] = __builtin_amdgcn_exp2f(X[B]); X[B + 1] = __builtin_amdgcn_exp2f(X[B + 1]); X[B + 2] = __builtin_amdgcn_exp2f(X[B + 2]); X[B + 3] = __builtin_amdgcn_exp2f(X[B + 3]); PL_PIN(X); PL_SB(); } while (0)
#define PL_MF(a, b, c) ({ __builtin_amdgcn_s_setprio(1); __builtin_amdgcn_sched_barrier(0); f32x16 r__ = __builtin_amdgcn_mfma_f32_32x32x16_bf16(a, b, c, 0, 0, 0); __builtin_amdgcn_sched_barrier(0); __builtin_amdgcn_s_setprio(0); r__; })
#define PL_STEP(C0, C1, P0, P1, t) do { const int t_ = (t); \
        if (t_ + 2 < T) PL_KSTORE(kb_st); \
        *(LAS u32x4*)(vst0 + (vb_prev ^ 1) * 8192) = vreg; \
        if (t_ + 3 < T) PL_KLOAD(t_ + 3); if (t_ + 1 < T) PL_VLOAD(t_ + 1); \
        PL_SB(); const LAS unsigned char* kp_ = kfrag0 + kb_cur * KB; const int vp_ = vfrag0 + vb_prev * 8192; \
        bf16x8 k0 = PL_KF(0), k1 = PL_KF(1), k2 = PL_KF(2); PL_SB(); float sacc = (P0[0] + P0[1]); \
        C0 = PL_MF(k0, qr[0], negm); k0 = PL_KF(3); PL_WORK(P0[2], P0[3], P0[4], P0[5],     pw0[0] = cvtpk(P0[0], P0[1]),   pw0[1] = cvtpk(P0[2], P0[3]),   pw0); PL_SB(); \
        C1 = PL_MF(k1, qr[0], negm); k1 = PL_KF(4); PL_WORK(P0[6], P0[7], P0[8], P0[9],     pw0[2] = cvtpk(P0[4], P0[5]),   pw0[3] = cvtpk(P0[6], P0[7]),   pw0); PL_SB(); \
        C0 = PL_MF(k2, qr[1], C0);   k2 = PL_KF(5); PL_WORK(P0[10], P0[11], P0[12], P0[13], pw1[0] = cvtpk(P0[8], P0[9]),   pw1[1] = cvtpk(P0[10], P0[11]), pw1); PL_SB(); \
        C1 = PL_MF(k0, qr[1], C1);   k0 = PL_KF(6); PL_WORK(P0[14], P0[15], P1[0], P1[1],   pw1[2] = cvtpk(P0[12], P0[13]), pw1[3] = cvtpk(P0[14], P0[15]), pw1); PL_SB(); \
        C0 = PL_MF(k1, qr[2], C0);   k1 = PL_KF(7); PL_WORK(P1[2], P1[3], P1[4], P1[5],     pw2[0] = cvtpk(P1[0], P1[1]),   pw2[1] = cvtpk(P1[2], P1[3]),   pw2); PL_SB(); \
        C1 = PL_MF(k2, qr[2], C1);   if (DK == 96) k2 = PL_KF(8); PL_WORK(P1[6], P1[7], P1[8], P1[9],     pw2[2] = cvtpk(P1[4], P1[5]),   pw2[3] = cvtpk(P1[6], P1[7]),   pw2); PL_SB(); \
        C0 = PL_MF(k0, qr[3], C0);   if (DK == 96) k0 = PL_KF(9); PL_WORK(P1[10], P1[11], P1[12], P1[13], pw3[0] = cvtpk(P1[8], P1[9]),   pw3[1] = cvtpk(P1[10], P1[11]), pw3); PL_SB(); \
        C1 = PL_MF(k1, qr[3], C1);   if (DK == 96) k1 = PL_KF(10); PL_WORK(P1[14], P1[15], 0.f, 0.f,       pw3[2] = cvtpk(P1[12], P1[13]), pw3[3] = cvtpk(P1[14], P1[15]), pw3); PL_SB(); \
        if (DK == 96) { C0 = PL_MF(k2, qr[DK / 16 - 2], C0); k2 = PL_KF(11); PL_SB(); C1 = PL_MF(k0, qr[DK / 16 - 2], C1); PL_SB(); C0 = PL_MF(k1, qr[DK / 16 - 1], C0); PL_SB(); C1 = PL_MF(k2, qr[DK / 16 - 1], C1); PL_SB(); } \
        l_reg += sacc; \
        bf16x8 v0 = PL_VF(0), v1 = PL_VF(4), v2 = PL_VF(1); \
        maskf(C0, C1, t_); \
        { const float rm = rowmax32(C0, C1); resc = false; \
          if (__builtin_expect(__any(rm > FA_THRL), 0)) { const float dl = fmaxf(rm, 0.f); mhat += dl; \
              _Pragma("unroll") for (int r = 0; r < 16; ++r) { C0[r] -= dl; C1[r] -= dl; } \
              _Pragma("unroll") for (int r = 0; r < 16; ++r) negm[r] = -mhat; \
              asm volatile("" : "+v"(negm)); \
              const float f_ = __builtin_amdgcn_exp2f(-dl); l_reg *= f_; if (hf == 0) wsf[r32] = f_; resc = true; } } \
        PL_SB(); \
        PL_GAPB(o[0] = PL_MF(PL_PAF(0), v0, o[0]); v0 = PL_VF(5), C0, 0); \
        PL_GAPB(o[1] = PL_MF(PL_PAF(0), v1, o[1]); v1 = PL_VF(2), C0, 4); \
        PL_GAPB(o[0] = PL_MF(PL_PAF(1), v2, o[0]); v2 = PL_VF(6), C0, 8); \
        PL_GAPB(o[1] = PL_MF(PL_PAF(1), v0, o[1]); v0 = PL_VF(3), C0, 12); \
        PL_GAPB(o[0] = PL_MF(PL_PAF(2), v1, o[0]); v1 = PL_VF(7), C1, 0); \
        PL_GAPB(o[1] = PL_MF(PL_PAF(2), v2, o[1]), C1, 4); \
        PL_GAPB(o[0] = PL_MF(PL_PAF(3), v0, o[0]), C1, 8); \
        PL_GAPB(o[1] = PL_MF(PL_PAF(3), v1, o[1]), C1, 12); \
        __syncthreads(); \
        if (resc) { \
            _Pragma("unroll") for (int g_ = 0; g_ < 4; ++g_) { const f32x4 a_ = *(const LAS f32x4*)(wsf + 8 * g_ + 4 * hf); \
                o[0][4 * g_] *= a_.x; o[0][4 * g_ + 1] *= a_.y; o[0][4 * g_ + 2] *= a_.z; o[0][4 * g_ + 3] *= a_.w; o[1][4 * g_] *= a_.x; o[1][4 * g_ + 1] *= a_.y; o[1][4 * g_ + 2] *= a_.z; o[1][4 * g_ + 3] *= a_.w; } } \
        kb_cur = (kb_cur == 2) ? 0 : kb_cur + 1; kb_st = (kb_st == 2) ? 0 : kb_st + 1; vb_prev ^= 1; \
    } while (0)
    int t = 1;
    for (; t + 1 < T; t += 2) { PL_STEP(pB0, pB1, pA0, pA1, t); PL_STEP(pA0, pA1, pB0, pB1, t + 1); }
    const bool tail = t < T;
    if (tail) PL_STEP(pB0, pB1, pA0, pA1, t);
#define PL_DRAIN(P0, P1) do { float sacc = 0.f; _Pragma("unroll") for (int r = 0; r < 16; ++r) sacc += P0[r] + P1[r]; l_reg += sacc; \
        bf16x8 a0_, a1_, a2_, a3_; pack_p(P0, P1, a0_, a1_, a2_, a3_); pv(o, vfrag0 + vb_prev * 8192, a0_, a1_, a2_, a3_); } while (0)
    if (tail) PL_DRAIN(pB0, pB1); else PL_DRAIN(pA0, pA1);
    l_out = l_reg;
    __syncthreads();
#undef PL_KLOAD
#undef PL_KADDR
#undef PL_KSTORE
#undef PL_VLOAD
#undef PL_PIN
#undef PL_SB
#undef PL_KF
#undef PL_VF
#undef PL_PAF
#undef PL_WORK
#undef PL_GAPB
#undef PL_MF
#undef PL_STEP
#undef PL_DRAIN
}

DI void mla_unit(const Params& p, LAS unsigned char* lds, int b, int h, int qb, int wid0) {
    const int tid = opaque_tid(wid0), lane = tid & 63, r32 = lane & 31, hf = lane >> 5; const int wv = __builtin_amdgcn_readfirstlane(tid >> 6);
    const bf16_t* KN = wsp<bf16_t>(p, WS_KN); const bf16_t* VM = wsp<bf16_t>(p, WS_VM); bf16_t* OC = wsp<bf16_t>(p, WS_R1);
    const int rowbase = b * SEQ, q0 = qb * 256, tq = q0 + wv * 32 + r32, row = rowbase + tq;
    LAS float* wsf = (LAS float*)(lds + L_WS) + wv * 64;
    bf16x8 qr[6];
    {
        const bf16_t* src = qraw(p) + (size_t)row * 768 + h * 96 + 8 * hf; float q[6][8]; float ss = 0.f;
#pragma unroll
        for (int d0 = 0; d0 < 6; ++d0) { unpack8(*(const u32x4*)(src + 16 * d0), q[d0]);
#pragma unroll
            for (int e = 0; e < 8; ++e) ss += q[d0][e] * q[d0][e]; }
        ss = sum32(ss);
        const float rstd = rsqrtf(ss * (1.f / 96.f) + EPS); const float* qg = p.in[I_MQG] + 8 * hf; const float* kg = p.in[I_MKG] + 8 * hf;
#pragma unroll
        for (int d0 = 0; d0 < 6; ++d0)
#pragma unroll
            for (int e = 0; e < 8; ++e) q[d0][e] *= rstd * qg[16 * d0 + e];
        const float* cs = ropeCM(p) + (size_t)row * 16 + 8 * hf; const float* sn = ropeSM(p) + (size_t)row * 16 + 8 * hf;
#pragma unroll
        for (int e = 0; e < 8; ++e) { const float x1 = q[4][e], x2 = q[5][e]; q[4][e] = x1 * cs[e] - x2 * sn[e]; q[5][e] = x2 * cs[e] + x1 * sn[e]; }
#pragma unroll
        for (int d0 = 0; d0 < 6; ++d0) { float f[8];
#pragma unroll
            for (int e = 0; e < 8; ++e) f[e] = q[d0][e] * ((d0 < 4) ? kg[16 * d0 + e] * C2M : C2M);
            qr[d0] = __builtin_bit_cast(bf16x8, pack8(f)); }
    }
    const int NT = 4 * (qb + 1);
    TileSrc src; { const int k1 = tid / 12, c1 = tid % 12;
        src.k = (const unsigned char*)(KN + (size_t)rowbase * 768 + h * 96); src.ko = (unsigned)(k1 * 768 + c1 * 8) * 2u; src.klds = c1 * KCS + k1 * 16; src.k2on = wv < 6; }
    src.kstep = 64 * 768 * 2;
    src.v = (const unsigned char*)(VM + (size_t)rowbase * 512 + h * 64); src.vo = (unsigned)((16 * (wv & 3) + (lane >> 2)) * 512 + (wv >> 2) * 32 + (lane & 3) * 8) * 2u; src.vstep = 64 * 512 * 2;
    const int qlo = q0 + wv * 32;
    auto mk = [&](f32x16& p0, f32x16& p1, int i) { if (i * 64 + 63 > qlo) mask_range(p0, p1, i * 64, 0, tq, hf); };
    f32x16 ob[2]; float lb;
    pipe_attn<96>(lds, src, NT, qr, mk, ob, lb, wv, lane, r32, hf, wsf);
    const float lt = sum32(lb);
    f32x16 acc[2];
#pragma unroll
    for (int i = 0; i < 16; ++i) { acc[0][i] = 0.f; acc[1][i] = 0.f; }
    accum_scaled(acc, ob, 1.0f / lt, wsf, r32, hf);
    LAS bf16_t* stg = (LAS bf16_t*)(lds + L_OST) + wv * 4096;
    stage_rows(acc, stg, r32, hf);
#pragma unroll
    for (int i = 0; i < 4; ++i) { const int rr = i * 8 + (lane >> 3), ch = lane & 7; const u32x4 v = *(const LAS u32x4*)(stg + rr * 64 + ch * 8);
        st16(OC + (size_t)(rowbase + q0 + wv * 32 + rr) * 1024 + h * 64 + ch * 8, v); }
}

DI void nsa_unit(const Params& p, LAS unsigned char* lds, int b, int g, int c, int wid0) {
    const int tid = opaque_tid(wid0), lane = tid & 63, r32 = lane & 31, hf = lane >> 5; const int wv = __builtin_amdgcn_readfirstlane(tid >> 6);
    const bf16_t* QN = wsp<bf16_t>(p, WS_QN); const bf16_t* KCF = wsp<bf16_t>(p, WS_KCF); const bf16_t* VCF = wsp<bf16_t>(p, WS_VCF);
    const bf16_t* KS = wsp<bf16_t>(p, WS_KS); const bf16_t* VS = wsp<bf16_t>(p, WS_VS); const bf16_t* KW = wsp<bf16_t>(p, WS_KW); const bf16_t* VW = wsp<bf16_t>(p, WS_VW);
    const bf16_t* GN = wsp<bf16_t>(p, WS_GN); bf16_t* OC = wsp<bf16_t>(p, WS_R1);
    const int rowbase = b * SEQ, tt = 8 * wv + (r32 >> 2), hd = g * 4 + (r32 & 3), tq = 64 * c + tt, row = rowbase + tq;
    LAS float* wsf = (LAS float*)(lds + L_WS) + wv * 64;
    bf16x8 qr[4];
#pragma unroll
    for (int d0 = 0; d0 < 4; ++d0) qr[d0] = *(const bf16x8*)(QN + (size_t)row * 512 + hd * 64 + 16 * d0 + 8 * hf);
    LAS float* accw = (LAS float*)(lds + L_OST) + wv * 2048;
    const int vboff = ((lane >> 4) & 1) * 32 + (lane & 3) * 8 + (4 * hf + ((lane & 15) >> 2)) * 64;
    u32x4 ka, vv;
#define NSA_LOAD(KB, VB, krow0) do { ka = *(const u32x4*)((KB) + (size_t)((krow0) + lane) * 128 + g * 64 + wv * 8); \
        vv = *(const u32x4*)((VB) + (size_t)((krow0) + 16 * (wv & 3) + (lane >> 2)) * 128 + g * 64 + (wv >> 2) * 32 + (lane & 3) * 8); } while (0)
#define NSA_STORE(koff, voff) do { *(LAS u32x4*)(lds + (koff) + wv * 1024 + lane * 16) = ka; *(LAS u32x4*)(lds + (voff) + wv * 1024 + lane * 16) = vv; } while (0)
    unsigned selmask;
    {
        const int ntile = (4 * c + 3 > 64) ? 2 : 1;
        const int nmax = (tq >= 31) ? ((tq - 31) >> 4) : -1;
        __syncthreads();
        { NSA_LOAD(KCF, VCF, b * 128); const u32x4 ka1_ = ka, vv1_ = vv; if (ntile == 2) NSA_LOAD(KCF, VCF, b * 128 + 64);
          *(LAS u32x4*)(lds + L_K + wv * 1024 + lane * 16) = ka1_; *(LAS u32x4*)(lds + L_V + wv * 1024 + lane * 16) = vv1_; if (ntile == 2) NSA_STORE(L_K + 8192, L_V + 8192); }
        __syncthreads();
        f32x16 pa0, pa1, pb0, pb1;
        qkt<64>(pa0, pa1, (lds_cptr)(lds + L_K) + hf * 1024 + r32 * 16, qr); mask_range(pa0, pa1, 0, 0, nmax, hf);
        float m = rowmax32(pa0, pa1);
        if (ntile == 2) { qkt<64>(pb0, pb1, (lds_cptr)(lds + L_K + 8192) + hf * 1024 + r32 * 16, qr); mask_range(pb0, pb1, 64, 0, nmax, hf); m = fmaxf(m, rowmax32(pb0, pb1)); }
        else {
#pragma unroll
            for (int i = 0; i < 16; ++i) { pb0[i] = -INFINITY; pb1[i] = -INFINITY; } }
        const float mu = (m == -INFINITY) ? 0.f : m;
        float ls = 0.f;
#pragma unroll
        for (int r = 0; r < 16; ++r) { pa0[r] = __builtin_amdgcn_exp2f(pa0[r] - mu); pa1[r] = __builtin_amdgcn_exp2f(pa1[r] - mu); pb0[r] = __builtin_amdgcn_exp2f(pb0[r] - mu); pb1[r] = __builtin_amdgcn_exp2f(pb1[r] - mu);
            ls += (pa0[r] + pa1[r]) + (pb0[r] + pb1[r]); }
        ls = sum32(ls);
        const float rl = (ls > 0.f) ? 1.0f / ls : 0.f;
#pragma unroll
        for (int r = 0; r < 16; ++r) { pa0[r] *= rl; pa1[r] *= rl; pb0[r] *= rl; pb1[r] *= rl; }
        float own[16], ee[16];
#pragma unroll
        for (int q = 0; q < 4; ++q) {
            own[q] = (pa0[4 * q] + pa0[4 * q + 1]) + (pa0[4 * q + 2] + pa0[4 * q + 3]); ee[q] = pa0[4 * q + 3];
            own[4 + q] = (pa1[4 * q] + pa1[4 * q + 1]) + (pa1[4 * q + 2] + pa1[4 * q + 3]); ee[4 + q] = pa1[4 * q + 3];
            own[8 + q] = (pb0[4 * q] + pb0[4 * q + 1]) + (pb0[4 * q + 2] + pb0[4 * q + 3]); ee[8 + q] = pb0[4 * q + 3];
            own[12 + q] = (pb1[4 * q] + pb1[4 * q + 1]) + (pb1[4 * q + 2] + pb1[4 * q + 3]); ee[12 + q] = pb1[4 * q + 3]; }
        float eo[16];
#pragma unroll
        for (int k = 0; k < 16; ++k) eo[k] = xor32(ee[k], hf);
#pragma unroll
        for (int k = 0; k < 16; ++k) { const float add = hf ? eo[k] : ((k > 0) ? eo[k - 1] : 0.f); own[k] += add; }
#pragma unroll
        for (int k = 0; k < 16; ++k) { own[k] += xorl<1>(own[k]); own[k] += xorl<2>(own[k]); }
        float imp[32];
#pragma unroll
        for (int k = 0; k < 16; ++k) { const float oth = xor32(own[k], hf); imp[2 * k] = hf ? oth : own[k]; imp[2 * k + 1] = hf ? own[k] : oth; }
        selmask = select_blocks(imp, c);
        State sc; st_init(sc);
        { bf16x8 a0, a1, a2, a3; pack_p(pa0, pa1, a0, a1, a2, a3); pv(sc.o, (int)(uintptr_t)(lds + L_V) + vboff, a0, a1, a2, a3); }
        if (ntile == 2) { bf16x8 a0, a1, a2, a3; pack_p(pb0, pb1, a0, a1, a2, a3); pv(sc.o, (int)(uintptr_t)(lds + L_V + 8192) + vboff, a0, a1, a2, a3); }
        accum_lds<true>(accw, sc.o, bf2f(GN[(size_t)row * 32 + hd * 3]), wsf, r32, hf);
    }
#pragma unroll 1
    for (int br = 1; br < 3; ++br) {
        const bf16_t* KB = (br == 1) ? KS : KW; const bf16_t* VB = (br == 1) ? VS : VW;
        const int NT = (br == 1) ? (c + 1) : ((c + 1 < 5) ? c + 1 : 5);
        TileSrc src; src.k = (const unsigned char*)(KB + (size_t)(rowbase + c * 64) * 128 + g * 64); src.ko = (unsigned)((wv * 8 + (lane >> 3)) * 128 + (lane & 7) * 8) * 2u;
        src.klds = (lane & 7) * KCS + (wv * 8 + (lane >> 3)) * 16; src.k2on = false;
        src.v = (const unsigned char*)(VB + (size_t)(rowbase + c * 64) * 128 + g * 64); src.vo = (unsigned)((16 * (wv & 3) + (lane >> 2)) * 128 + (wv >> 2) * 32 + (lane & 3) * 8) * 2u;
        src.kstep = -64 * 128 * 2; src.vstep = -64 * 128 * 2;
        f32x16 ob[2]; float lb;
        if (br == 1) {
            auto mk = [&](f32x16& p0, f32x16& p1, int i) { const int j = c - i;
                if (i == 0) mask_range(p0, p1, j * 64, 0, tq, hf);
                if (!((selmask >> j) & 1u)) {
#pragma unroll
                    for (int r = 0; r < 16; ++r) { p0[r] = -INFINITY; p1[r] = -INFINITY; } } };
            pipe_attn<64>(lds, src, NT, qr, mk, ob, lb, wv, lane, r32, hf, wsf);
        } else {
            const int lo = tq - 255;
            auto mk = [&](f32x16& p0, f32x16& p1, int i) { if (i == 0 || i == 4) mask_range(p0, p1, (c - i) * 64, lo, tq, hf); };
            pipe_attn<64>(lds, src, NT, qr, mk, ob, lb, wv, lane, r32, hf, wsf);
        }
        const float lt = sum32(lb);
        accum_lds<false>(accw, ob, bf2f(GN[(size_t)row * 32 + hd * 3 + br]) / lt, wsf, r32, hf);
    }
#undef NSA_LOAD
#undef NSA_STORE
    asm volatile("s_waitcnt lgkmcnt(0)" ::: "memory");
#pragma unroll
    for (int i = 0; i < 4; ++i) { const int rr = i * 8 + (lane >> 3), ch = lane & 7; const f32x4 a = *(const LAS f32x4*)(accw + rr * 64 + ch * 8), b2 = *(const LAS f32x4*)(accw + rr * 64 + ch * 8 + 4);
        u32x4 v; v.x = pk2(a.x, a.y); v.y = pk2(a.z, a.w); v.z = pk2(b2.x, b2.y); v.w = pk2(b2.z, b2.w);
        st16(OC + (size_t)(rowbase + 64 * c + 8 * wv + (rr >> 2)) * 1024 + 512 + (g * 4 + (rr & 3)) * 64 + ch * 8, v); }
}
#undef FA_SBAR
}

DI void stage_attn_fast(const Params& p, LAS unsigned char* lds, int bid, int nb, bool do_mla, bool do_nsa, int wid0) {
    const int v0 = (nb % 8 == 0) ? (bid % 8) * (nb / 8) + bid / 8 : bid;
    if (do_mla) for (int u = v0; u < 256; u += nb) { const int bh = u >> 2, s = u & 3; fa::mla_unit(p, lds, bh >> 3, bh & 7, 7 - s, wid0); fa::mla_unit(p, lds, bh >> 3, bh & 7, s, wid0); }
    if (do_nsa) for (int u = v0; u < 256; u += nb) { const int bg = u >> 4, s = u & 15; fa::nsa_unit(p, lds, bg >> 1, bg & 1, 31 - s, wid0); fa::nsa_unit(p, lds, bg >> 1, bg & 1, s, wid0); }
    __syncthreads();
}
#define XB_TMO      128
#define XB_XCNT(j)  (256  + 64 * (j))
#define XB_XSUB(j)  (1280 + 64 * (j))
#define XB_XGEN(j)  (2304 + 64 * (j))
#define XB_TOP      3328
#define XB_TOPGEN   3392
#define XCD_BAR_WORDS 3456
#define XB_SPIN_CAP (1u << 18)

__device__ __forceinline__ unsigned xb_ld(unsigned* p)              { return __hip_atomic_load(p, __ATOMIC_RELAXED, __HIP_MEMORY_SCOPE_AGENT); }
__device__ __forceinline__ unsigned xb_add(unsigned* p, unsigned v) { return __hip_atomic_fetch_add(p, v, __ATOMIC_RELAXED, __HIP_MEMORY_SCOPE_AGENT); }
__device__ __forceinline__ unsigned xb_xcc_id() { return (unsigned)__builtin_amdgcn_s_getreg((3 << 11) | 20) & 0xFu; }
#define XB_SPIN(cond, bar) do { unsigned _sp = 0; while (cond) { __builtin_amdgcn_s_sleep(1); \
    if ((++_sp & 255u) == 0u) { if (xb_ld(&(bar)[XB_TMO])) break; if (_sp > XB_SPIN_CAP) { atomicAdd(&(bar)[XB_TMO], 1u); break; } } } } while (0)

struct XcdBarrier {
    unsigned* bar; unsigned x;
    volatile LAS unsigned* st;
};

__device__ __forceinline__ XcdBarrier xcd_barrier_post(unsigned* bar, volatile LAS unsigned* st, bool t0) {
    XcdBarrier b; b.bar = bar; b.x = xb_xcc_id(); b.st = st;
    if (t0) (void)xb_add(&bar[XB_XCNT(b.x)], 1u);
    return b;
}
__device__ __forceinline__ void xcd_barrier_complete(unsigned* bar, unsigned x, unsigned& nloc, unsigned& nx) {
    const unsigned G = gridDim.x * gridDim.y * gridDim.z;
    unsigned sum, cnt, mine, sp = 0u;
    for (;;) {
        sum = 0u; cnt = 0u; mine = 0u;
#pragma unroll
        for (unsigned j = 0; j < 16; ++j) { const unsigned c = xb_ld(&bar[XB_XCNT(j)]); sum += c; cnt += (c > 0u) ? 1u : 0u; mine = (j == x) ? c : mine; }
        if (sum == G) break;
        __builtin_amdgcn_s_sleep(1);
        if ((++sp & 255u) == 0u) { if (xb_ld(&bar[XB_TMO])) break; if (sp > XB_SPIN_CAP) { atomicAdd(&bar[XB_TMO], 1u); break; } }
    }
    nloc = mine > 0u ? mine : 1u; nx = cnt > 0u ? cnt : 1u;
}

__device__ __forceinline__ void xcd_barrier(const XcdBarrier& b, bool t0) {
    asm volatile("s_waitcnt vmcnt(0)" ::: "memory");
    __syncthreads();
    if (t0) {
        unsigned* bar = b.bar;
        __builtin_amdgcn_s_waitcnt(0);
        unsigned nloc = b.st[0], nx = b.st[1];
        if (nloc == 0u) { xcd_barrier_complete(bar, b.x, nloc, nx); b.st[0] = nloc; b.st[1] = nx; }
        const unsigned old = xb_add(&bar[XB_XSUB(b.x)], 1u);
        const unsigned gen = old / nloc;
        if (old + 1u == (gen + 1u) * nloc) {
            __builtin_amdgcn_fence(__ATOMIC_RELEASE, "agent");
            asm volatile("s_waitcnt vmcnt(0)" ::: "memory");
            const unsigned og = xb_add(&bar[XB_TOP], 1u);
            const unsigned tg = og / nx;
            if (og + 1u == (tg + 1u) * nx) xb_add(&bar[XB_TOPGEN], 1u);
            else XB_SPIN(xb_ld(&bar[XB_TOPGEN]) == tg, bar);
            __builtin_amdgcn_fence(__ATOMIC_ACQUIRE, "agent");
            xb_add(&bar[XB_XGEN(b.x)], 1u);
            asm volatile("s_waitcnt vmcnt(0)" ::: "memory");
        } else {
            XB_SPIN(xb_ld(&bar[XB_XGEN(b.x)]) == gen, bar);
            __builtin_amdgcn_fence(__ATOMIC_ACQUIRE, "agent");
            asm volatile("s_waitcnt vmcnt(0)" ::: "memory");
        }
    }
    __syncthreads();
}

__device__ __forceinline__ void group_barrier(unsigned* cnt, unsigned target, unsigned* rel, unsigned* cnt2, unsigned target2, bool one_xcd, bool t0) {
    asm volatile("s_waitcnt vmcnt(0)" ::: "memory");
    __syncthreads();
    if (t0) {
        __builtin_amdgcn_s_waitcnt(0);
        if (!one_xcd) { __builtin_amdgcn_fence(__ATOMIC_RELEASE, "agent"); asm volatile("s_waitcnt vmcnt(0)" ::: "memory"); }
        const unsigned early2 = target2 ? xb_ld(cnt2) : 0u;
        const unsigned old = xb_add(cnt, 1u);
        if (rel && old + 1u == target) {
            __builtin_amdgcn_fence(__ATOMIC_RELEASE, "agent");
            asm volatile("s_waitcnt vmcnt(0)" ::: "memory");
            (void)xb_add(rel, 1u);
        }
        unsigned sp = 0u;
        while (xb_ld(cnt) < target) { __builtin_amdgcn_s_sleep(1); if (++sp > (1u << 22)) break; }
        if (target2 && early2 < target2) while (xb_ld(cnt2) < target2) { __builtin_amdgcn_s_sleep(1); if (++sp > (1u << 22)) break; }
        __builtin_amdgcn_fence(__ATOMIC_ACQUIRE, "agent");
        asm volatile("s_waitcnt vmcnt(0)" ::: "memory");
    }
    __syncthreads();
}
__device__ __forceinline__ void publish_count(unsigned* cnt, bool t0) {
    asm volatile("s_waitcnt vmcnt(0)" ::: "memory");
    __syncthreads();
    if (t0) { __builtin_amdgcn_s_waitcnt(0); __builtin_amdgcn_fence(__ATOMIC_RELEASE, "agent"); asm volatile("s_waitcnt vmcnt(0)" ::: "memory"); (void)xb_add(cnt, 1u); }
}
constexpr int LDS_BYTES = 147456;

typedef const Params __attribute__((address_space(4)))* KParamsPtr;
#if defined(__HIP_DEVICE_COMPILE__)
DI KParamsPtr kparams() { KParamsPtr k = (KParamsPtr)__builtin_amdgcn_kernarg_segment_ptr(); asm volatile("" : "+s"(k)); return k; }
#define PHASE_PARAMS() const Params p = *kparams()
#else
#define PHASE_PARAMS() const Params p = p_arg
#endif
constexpr int CW_BAR = 4096, CW_CMP = 8192, CW_GXCC = 8704, CW_WD = 9216, CW_P4 = 9280, CW_W1 = 9344, CW_GRP = 9408, CW_REL = 13504;

__global__ void __launch_bounds__(512, 2) fwd_megakernel(Params p_arg) {
    extern __shared__ __attribute__((aligned(16))) unsigned char dlds[];
    LAS unsigned char* lds = (LAS unsigned char*)dlds;
    const int G = gridDim.x, c = blockIdx.x, ngw = G * NWAVE, ngt = G * NTHR;
    const int wid0 = __builtin_amdgcn_readfirstlane(threadIdx.x >> 6);
#define TIDS() const int tid = opaque_tid(wid0), lane = tid & 63, wave = tid >> 6, gw = c * NWAVE + wave, gtid = c * NTHR + tid; (void)lane; (void)gw; (void)gtid
    volatile LAS unsigned* MISC = (volatile LAS unsigned*)(lds + 131072 + 320);
    { TIDS(); if (tid < 32) MISC[tid] = 0u; }
    __syncthreads();
    XcdBarrier bar;
    { PHASE_PARAMS(); TIDS(); bar = xcd_barrier_post((unsigned*)(p.ws + WS_CTL) + CW_BAR, MISC + 8, tid == 0); }
    { PHASE_PARAMS(); TIDS(); if (tid == 0) (void)__hip_atomic_fetch_or((unsigned*)(p.ws + WS_CTL) + CW_GXCC + 64 * (c & 7), 1u << xb_xcc_id(), __ATOMIC_RELAXED, __HIP_MEMORY_SCOPE_AGENT); }
#define GRID_SYNC() do { TIDS(); xcd_barrier(bar, tid == 0); } while (0)
#define GROUP_SYNC_X(k, rel, cnt2, target2, fast) do { PHASE_PARAMS(); TIDS(); if (G == 256) { unsigned* ctl_ = (unsigned*)(p.ws + WS_CTL); \
        group_barrier(ctl_ + CW_GRP + 64 * (8 * (k) + (c & 7)), 32u, (rel) ? ctl_ + CW_REL + 64 * (c & 7) : (unsigned*)nullptr, ctl_ + (cnt2), (target2), tid == 0 && (fast) && MISC[12] != 0u, tid == 0); } else xcd_barrier(bar, tid == 0); } while (0)
#define GROUP_SYNC(k, cnt2, target2) GROUP_SYNC_X(k, false, cnt2, target2, true)

    { PHASE_PARAMS();
      { TIDS(); stage_weights<0>(p, gw, ngw, (float*)dlds + wave * (64 * 33), lane); }
      __syncthreads();
      if (G == 256) { if (c < 224) stage_mod(p, c, G, (float*)dlds, wid0); else { TIDS(); stage_rope(p, tid, (c - 224) * NTHR + tid, (G - 224) * NTHR, (float*)dlds + 16384); } }
      else { stage_mod(p, c, G, (float*)dlds, wid0); __syncthreads(); { TIDS(); stage_rope(p, tid, gtid, ngt, (float*)dlds + 16384); } } }
    GRID_SYNC();
    { PHASE_PARAMS(); TIDS(); if (tid == 0) MISC[12] = (__builtin_popcount(xb_ld((unsigned*)(p.ws + WS_CTL) + CW_GXCC + 64 * (c & 7))) == 1) ? 1u : 0u; }
    { PHASE_PARAMS(); TIDS();
      if (G == 256) stage_normmod(p.in[I_X], p.in[I_N1G], wsp<float>(p, WS_MOD), 0, 1, wsp<bf16_t>(p, WS_R0), SEQ * (c & 7) + 64 * (c >> 3) + wave, NWAVE, 64 / NWAVE, lane);
      else stage_normmod(p.in[I_X], p.in[I_N1G], wsp<float>(p, WS_MOD), 0, 1, wsp<bf16_t>(p, WS_R0), gw, ngw, (gw < MT) ? (MT - gw + ngw - 1) / ngw : 0, lane); }
    GROUP_SYNC(4, CW_WD, 0u);
    { PHASE_PARAMS(); EpiZ E{p}; gemm_fast(lds, wsp<bf16_t>(p, WS_R0), 1024, wsp<bf16_t>(p, WS_WIN), MT, ZN, 1024, E, G, c, wid0); }
    { PHASE_PARAMS(); const int nz = (MT / 256) * (ZN / 256), first = nz % G;
      if (c >= first) { { TIDS(); stage_weights<1>(p, (c - first) * NWAVE + wave, (G - first) * NWAVE, (float*)dlds + wave * (64 * 33), lane); }
                        __syncthreads(); stage_shw(p, c - first, G - first, (float*)dlds, wid0);
                        { TIDS(); publish_count((unsigned*)(p.ws + WS_CTL) + CW_W1, tid == 0); } } }
    GROUP_SYNC_X(5, true, CW_REL + 64 * ((c & 7) ^ 1), (((c >> 3) >= 24 && (c >> 3) < 28) ? 1u : 0u), true);
    { PHASE_PARAMS();
      int qb, qc, kb, kc;
      const int v = c;
      int cu0 = (v + 64) % G;
      if (G == 256) { const int x = c & 7, j = c >> 3;
          qb = 24 * x + j; qc = (j < 24) ? 1 : 0; kb = (j < 24) ? 32 * x + j : (j >= 28 ? 32 * x + 24 + 2 * (j - 28) : 0); kc = (j < 24) ? 1 : (j >= 28 ? 2 : 0);
          cu0 = (j >= 24 && j < 28) ? ((((j - 24) & 1) << 4) | ((((j - 24) >> 1) & 1) << 3) | ((x >> 1) << 1) | (x & 1)) : 32; }
      else { const int pq = (192 + G - 1) / G, pk = (256 + G - 1) / G; qb = v * pq; qc = (192 - qb < pq) ? ((192 - qb > 0) ? 192 - qb : 0) : pq; kb = v * pk; kc = (256 - kb < pk) ? ((256 - kb > 0) ? 256 - kb : 0) : pk; }
      { EpiQ E{p}; gemm_fast_range(lds, wsp<bf16_t>(p, WS_R1), 1024, wsp<bf16_t>(p, WS_WQB), MT, 768, 768, E, qb, qc, wid0); }
      for (int cu = cu0; cu < 32; cu += G) cmp_hidden_fast(p, lds, cu, wid0);
      { EpiKV E{p}; gemm_fast_range(lds, wsp<bf16_t>(p, WS_R1) + 768, 1024, wsp<bf16_t>(p, WS_WKVB), MT, 1024, 256, E, kb, kc, wid0); }
    }
    GROUP_SYNC_X(6, false, CW_GRP + 64 * (8 * 6 + ((c & 7) ^ 1)), 32u, !((c >> 3) >= 24 && (c >> 3) < 28));
    { PHASE_PARAMS(); TIDS(); if (G == 256) cmp_out<true>(p, (c >> 3) * NWAVE + wave, 32 * NWAVE, lane, c & 7, (LAS float*)lds, tid); else cmp_out<true>(p, gw, ngw, lane, -1, (LAS float*)lds, tid);
      asm volatile("s_waitcnt vmcnt(0)" ::: "memory"); __syncthreads();
      if (tid == 0) { if (!(G == 256 && MISC[12] != 0u)) { __builtin_amdgcn_fence(__ATOMIC_RELEASE, "agent"); asm volatile("s_waitcnt vmcnt(0)" ::: "memory"); }
          __hip_atomic_fetch_add((unsigned*)(p.ws + WS_CTL) + CW_CMP + ((G == 256) ? 64 * (c & 7) : 0), 1u, __ATOMIC_RELAXED, __HIP_MEMORY_SCOPE_AGENT); } }
    { PHASE_PARAMS(); stage_attn_fast(p, lds, c, G, true, false, wid0); }
    { PHASE_PARAMS(); TIDS();
      if (tid == 0) { unsigned* cnt = (unsigned*)(p.ws + WS_CTL) + CW_CMP + ((G == 256) ? 64 * (c & 7) : 0); unsigned sp = 0;
          while (__hip_atomic_load(cnt, __ATOMIC_RELAXED, __HIP_MEMORY_SCOPE_AGENT) < (unsigned)((G == 256) ? 32 : G)) { __builtin_amdgcn_s_sleep(2); if (++sp > (1u << 22)) break; }
          __builtin_amdgcn_fence(__ATOMIC_ACQUIRE, "agent"); asm volatile("s_waitcnt vmcnt(0)" ::: "memory"); }
      __syncthreads(); }
    { PHASE_PARAMS(); stage_attn_fast(p, lds, c, G, false, true, wid0); }
    { PHASE_PARAMS(); TIDS(); if (tid == 0) (void)xb_add((unsigned*)(p.ws + WS_CTL) + CW_P4, 1u); }
    { const int nz = (MT / 256) * (ZN / 256), first = nz % G; GROUP_SYNC(3, CW_W1, (unsigned)(G - first)); }
    { PHASE_PARAMS(); EpiMerge E{p}; gemm_fast(lds, wsp<bf16_t>(p, WS_R1), 1024, wsp<bf16_t>(p, WS_WO), MT, 1024, 1024, E, G, c, wid0); }
    GROUP_SYNC(0, CW_WD, 0u);
    { PHASE_PARAMS(); EpiOut E{p}; gemm_fast(lds, wsp<bf16_t>(p, WS_R2) + 1024, 2048, wsp<bf16_t>(p, WS_WOUT), MT, 1024, 1024, E, G, c, wid0); }
    GROUP_SYNC(1, CW_P4, (unsigned)G);
    { PHASE_PARAMS(); EpiGU E{p}; gemm_fast(lds, wsp<bf16_t>(p, WS_R1), 1024, wsp<bf16_t>(p, WS_WGU), MT, 5632, 1024, E, G, c, wid0); }
    { PHASE_PARAMS(); const int ng = (MT / 256) * (5632 / 256), first = ng % G;
      if (c >= first) { TIDS(); stage_weights<2>(p, (c - first) * NWAVE + wave, (G - first) * NWAVE, (float*)dlds + wave * (64 * 33), lane);
                        publish_count((unsigned*)(p.ws + WS_CTL) + CW_WD, tid == 0); } }
    { const int ng = (MT / 256) * (5632 / 256), first = ng % G; GROUP_SYNC(2, CW_WD, (unsigned)(G - first)); }
    { PHASE_PARAMS(); EpiDown E{p}; gemm_fast(lds, wsp<bf16_t>(p, WS_HID), DFF, wsp<bf16_t>(p, WS_WD), MT, 1024, DFF, E, G, c, wid0); }
}

extern "C" void kernel_launch(void* const* d_in, const int* in_sizes, int n_in, void* d_out, int out_size, void* d_ws, size_t ws_size, hipStream_t stream) {
    if (n_in != 30 || out_size != MT * DM || ws_size < WS_END) { fprintf(stderr, "kernel_launch: unexpected shapes (n_in %d out %d ws %zu)\n", n_in, out_size, ws_size); return; }
    static int grid = 0;
    if (grid == 0) {
        int dev = 0, cus = 0, per_cu = 0;
        (void)hipGetDevice(&dev); (void)hipDeviceGetAttribute(&cus, hipDeviceAttributeMultiprocessorCount, dev);
        (void)hipFuncSetAttribute((const void*)fwd_megakernel, hipFuncAttributeMaxDynamicSharedMemorySize, LDS_BYTES);
        (void)hipOccupancyMaxActiveBlocksPerMultiprocessor(&per_cu, (const void*)fwd_megakernel, NTHR, LDS_BYTES);
        if (per_cu < 1) fprintf(stderr, "kernel_launch: occupancy query says %d blocks per CU\n", per_cu);
        grid = cus;
        (void)hipGetLastError();
    }
    Params p{};
    for (int i = 0; i < 30; ++i) p.in[i] = (const float*)d_in[i];
    p.out = (float*)d_out; p.ws = (unsigned char*)d_ws;
    (void)hipMemsetAsync((char*)d_ws + WS_CTL, 0, 65536, stream);
    void* args[] = {&p};
    hipError_t e = hipLaunchCooperativeKernel((const void*)fwd_megakernel, dim3(grid), dim3(NTHR), args, LDS_BYTES, stream);
    if (e != hipSuccess) fprintf(stderr, "kernel_launch: cooperative launch failed: %s (grid %d)\n", hipGetErrorString(e), grid);
}
```

```cpp
#include <hip/hip_runtime.h>
#include <cstdint>
#include <cstdio>

typedef unsigned short bf16_t;
typedef unsigned u32x4 __attribute__((ext_vector_type(4)));
typedef unsigned u32x2 __attribute__((ext_vector_type(2)));
typedef float f32x4 __attribute__((ext_vector_type(4)));
typedef float f32x2 __attribute__((ext_vector_type(2)));
#define DI __device__ __forceinline__

constexpr int NB = 8, SEQ = 2048, DM = 1024, MT = NB * SEQ;
constexpr int DFF = 2816, NMOD = 6;
constexpr int ZN = 4608;
constexpr float EPS = 1e-6f;
constexpr float LOG2E = 1.4426950408889634f;
constexpr float C2N = 0.125f * LOG2E;
constexpr float C2M = 0.10206207261596575f * LOG2E;
constexpr int NTHR = 512, NWAVE = 8;
constexpr int O_CQ = 0, O_CKV = 768, O_KPE = 1024, O_QN = 1056, O_KC = 1568, O_VC = 1696, O_KS = 1824, O_VS = 1952, O_KW = 2080, O_VW = 2208,
              O_GN = 2336, O_GM = 2360, O_GNM = 3384, D_IN = 4408;

constexpr size_t MiB = 1u << 20;
constexpr size_t WS_CTL = 0;
constexpr size_t WS_MOD = 1 * MiB;
constexpr size_t WS_CB1 = 1 * MiB + 256 * 1024;
constexpr size_t WS_SSQPE = 1 * MiB + 320 * 1024;
constexpr size_t WS_SSQKN = 1 * MiB + 512 * 1024;
constexpr size_t WS_SSQA = 2 * MiB;
constexpr size_t WS_KCF = 3 * MiB;
constexpr size_t WS_VCF = 3 * MiB + 256 * 1024;
constexpr size_t WS_SHW = 3 * MiB + 512 * 1024;
constexpr size_t WS_WIN = 4 * MiB;
constexpr size_t WS_WQB = 13 * MiB;
constexpr size_t WS_WKVB = 15 * MiB;
constexpr size_t WS_WO = 16 * MiB;
constexpr size_t WS_WOUT = 18 * MiB;
constexpr size_t WS_WGU = 20 * MiB;
constexpr size_t WS_WD = 31 * MiB;
constexpr size_t WS_CW1 = 37 * MiB;
constexpr size_t WS_R0 = 40 * MiB;
constexpr size_t WS_R1 = 72 * MiB;
constexpr size_t WS_R2 = 104 * MiB;
constexpr size_t WS_QN = 168 * MiB;
constexpr size_t WS_KC = 184 * MiB, WS_VC = 188 * MiB, WS_KS = 192 * MiB, WS_VS = 196 * MiB, WS_KW = 200 * MiB, WS_VW = 204 * MiB;
constexpr size_t WS_KPE = 208 * MiB;
constexpr size_t WS_GN = 209 * MiB;
constexpr size_t WS_KN = 210 * MiB;
constexpr size_t WS_VM = 234 * MiB;
constexpr size_t WS_ROPE = 250 * MiB;
constexpr size_t WS_HID = 168 * MiB;
constexpr size_t WS_END = 256 * MiB;

struct Params {
    const float* in[30];
    float* out;
    unsigned char* ws;
};
enum { I_X = 0, I_C, I_POS, I_ADAW, I_ADAB, I_N1G, I_WIN, I_QAG, I_WQB, I_KVAG, I_WKVB, I_MQG, I_MKG, I_NQG, I_NKCG, I_NKSG, I_NKWG,
       I_CPK, I_CW1K, I_CW2K, I_CPV, I_CW1V, I_CW2V, I_WOM, I_WON, I_WOUT, I_N2G, I_WG, I_WU, I_WDN };

template <class T> DI T* wsp(const Params& p, size_t off) { return (T*)(p.ws + off); }
DI bf16_t* qraw(const Params& p) { return (bf16_t*)p.out; }
DI float* cmph(const Params& p) { return p.out + (size_t)6 * 1024 * 1024; }

#ifndef WT_STORES
#define WT_STORES 0
#endif
DI void st16(void* p, u32x4 v) {
#if WT_STORES
    asm volatile("global_store_dwordx4 %0, %1, off sc1\n\ts_nop 1" :: "v"(p), "v"(v) : "memory");
#else
    *(u32x4*)p = v;
#endif
}
DI void st16f(void* p, f32x4 v) { st16(p, __builtin_bit_cast(u32x4, v)); }
DI int lane_id() { return (int)__builtin_amdgcn_mbcnt_hi(~0u, __builtin_amdgcn_mbcnt_lo(~0u, 0u)); }
DI int opaque_lane() { int l; asm volatile("v_mbcnt_lo_u32_b32 %0, -1, 0\n\tv_mbcnt_hi_u32_b32 %0, -1, %0" : "=v"(l)); return l; }
DI int opaque_tid(int wid0) { int l; asm volatile("v_mbcnt_lo_u32_b32 %0, -1, 0\n\tv_mbcnt_hi_u32_b32 %0, -1, %0" : "=v"(l)); return (wid0 << 6) | l; }
DI unsigned f2bf(float f) { unsigned u = __float_as_uint(f); return (u + 0x7fffu + ((u >> 16) & 1u)) >> 16; }
DI unsigned pk2(float lo, float hi) { return f2bf(lo) | (f2bf(hi) << 16); }
DI float bf2f(unsigned short b) { return __uint_as_float(((unsigned)b) << 16); }
DI float bflo(unsigned w) { return __uint_as_float(w << 16); }
DI float bfhi(unsigned w) { return __uint_as_float(w & 0xffff0000u); }
DI void unpack8(const u32x4 w, float (&f)[8]) { f[0] = bflo(w.x); f[1] = bfhi(w.x); f[2] = bflo(w.y); f[3] = bfhi(w.y); f[4] = bflo(w.z); f[5] = bfhi(w.z); f[6] = bflo(w.w); f[7] = bfhi(w.w); }
DI u32x4 pack8(const float (&f)[8]) { u32x4 w; w.x = pk2(f[0], f[1]); w.y = pk2(f[2], f[3]); w.z = pk2(f[4], f[5]); w.w = pk2(f[6], f[7]); return w; }
DI float sigmoidf(float x) { return __builtin_amdgcn_rcpf(1.0f + __expf(-x)); }
DI float siluf(float x) { return x * __builtin_amdgcn_rcpf(1.0f + __expf(-x)); }
template <int X> DI float xorl(float v) { return __int_as_float(__builtin_amdgcn_ds_swizzle(__float_as_int(v), (X << 10) | 0x1f)); }
DI void halves(float v, float& lo, float& hi) { auto rr = __builtin_amdgcn_permlane32_swap(__float_as_uint(v), __float_as_uint(v), false, false); lo = __uint_as_float(rr[0]); hi = __uint_as_float(rr[1]); }
DI float xor32(float v, int hf) { float lo, hi; halves(v, lo, hi); return hf ? lo : hi; }
DI float sum32(float v) { float lo, hi; halves(v, lo, hi); return lo + hi; }
DI float max32(float v) { float lo, hi; halves(v, lo, hi); return fmaxf(lo, hi); }
DI float wave_sum(float v) { v += xorl<1>(v); v += xorl<2>(v); v += xorl<4>(v); v += xorl<8>(v); v += xorl<16>(v); return sum32(v); }
DI void sincos_rad(float ang, float& c, float& s) {
    double rev = (double)ang * 0.15915494309189535; rev -= __builtin_rint(rev);
    const float fr = (float)rev; s = __builtin_amdgcn_sinf(fr); c = __builtin_amdgcn_cosf(fr);
}
#define LAS __attribute__((address_space(3)))
#if defined(__HIP_DEVICE_COMPILE__)
DI const float* karg_in(int i) { typedef const float* KPtr; const KPtr __attribute__((address_space(4)))* k = (const KPtr __attribute__((address_space(4)))*)__builtin_amdgcn_kernarg_segment_ptr(); return k[i]; }
#else
DI const float* karg_in(int) { return nullptr; }
#endif
DI void tr_load(const float* W, int ldw, int c0, int ncols, int k0, float (&v)[32], int lane) {
    const int cc = lane & 31, kh = lane >> 5;
    if (c0 >= 0 && cc < ncols) {
        const float* src = W + (size_t)(k0 + kh) * ldw + c0 + cc;
#pragma unroll
        for (int i = 0; i < 32; ++i) v[i] = src[(size_t)(2 * i) * ldw];
    } else {
#pragma unroll
        for (int i = 0; i < 32; ++i) v[i] = 0.f;
    }
}
DI void tr_finish(const float* rs, bf16_t* dst, int ldd, int n0, int k0, float (&v)[32], float* scr, int lane) {
    const int cc = lane & 31, kh = lane >> 5;
    if (rs) {
#pragma unroll
        for (int i = 0; i < 32; ++i) v[i] *= rs[k0 + 2 * i + kh];
    }
#pragma unroll
    for (int i = 0; i < 32; ++i) scr[(2 * i + kh) * 33 + cc] = v[i];
    __builtin_amdgcn_s_waitcnt(0xc07f);
    asm volatile("" ::: "memory");
    const int c = lane & 7;
#pragma unroll
    for (int j = 0; j < 4; ++j) { const int n = (lane >> 3) + 8 * j; const float* s = scr + (8 * c) * 33 + n;
        u32x4 o; o.x = pk2(s[0 * 33], s[1 * 33]); o.y = pk2(s[2 * 33], s[3 * 33]); o.z = pk2(s[4 * 33], s[5 * 33]); o.w = pk2(s[6 * 33], s[7 * 33]);
        st16(dst + (size_t)(n0 + n) * ldd + k0 + 8 * c, o); }
    __builtin_amdgcn_s_waitcnt(0xc07f);
    asm volatile("" ::: "memory");
}
DI void transpose_item(const float* W, int ldw, int c0, int ncols, const float* rs, bf16_t* dst, int ldd, int n0, int k0, float* scr, int lane) {
    float v[32];
    tr_load(W, ldw, c0, ncols, k0, v, lane); tr_finish(rs, dst, ldd, n0, k0, v, scr, lane);
}
DI int zsrc(int s, int L0, int& ncols) {
    ncols = 32;
    if (s < 16) return 64 * s + L0;
    if (s == 16) { if (L0 == 0) return O_KPE; ncols = 24; return O_GN; }
    if (s < 25) return O_QN + 64 * (s - 17) + L0;
    if (s < 27) return O_KC + 64 * (s - 25) + L0;
    if (s < 29) return O_VC + 64 * (s - 27) + L0;
    if (s < 31) return O_KS + 64 * (s - 29) + L0;
    if (s < 33) return O_VS + 64 * (s - 31) + L0;
    if (s < 35) return O_KW + 64 * (s - 33) + L0;
    if (s < 37) return O_VW + 64 * (s - 35) + L0;
    if (s < 40) return -1;
    if (s < 56) return O_GM + 64 * (s - 40) + L0;
    return O_GNM + 64 * (s - 56) + L0;
}
template <int PART> DI void stage_weights(const Params& p, int gw, int ngw, float* scr, int lane) {
    constexpr int I_IN = (ZN / 32) * (DM / 64);
    constexpr int I_QB = (768 / 32) * (768 / 64);
    constexpr int I_KVB = (1024 / 32) * (256 / 64);
    constexpr int I_O = (1024 / 32) * (1024 / 64);
    constexpr int I_OUT = I_O;
    constexpr int I_GU = (5632 / 32) * (1024 / 64);
    constexpr int I_D = (1024 / 32) * (DFF / 64);
    constexpr int I_C1 = 2 * (256 / 32) * (2048 / 64);
    if constexpr (PART == 1) {
        for (int r = gw; r < I_GU; r += ngw) { const int nb = r / 16, kb = r % 16; const int pn = nb >> 3, bj = (nb >> 2) & 1, wc = nb & 3, s = 4 * pn + wc;
            transpose_item(bj ? p.in[I_WU] : p.in[I_WG], DFF, 32 * s, 32, nullptr, wsp<bf16_t>(p, WS_WGU), 1024, nb * 32, kb * 64, scr, lane); }
        for (int r = gw; r < I_O + I_OUT; r += ngw) {
            if (r < I_O) { const int nb = r / 16, kb = r % 16;
                if (kb < 8) transpose_item(p.in[I_WOM], 1024, nb * 32, 32, nullptr, wsp<bf16_t>(p, WS_WO), 1024, nb * 32, kb * 64, scr, lane);
                else transpose_item(p.in[I_WON] - (size_t)512 * 1024, 1024, nb * 32, 32, nullptr, wsp<bf16_t>(p, WS_WO), 1024, nb * 32, kb * 64, scr, lane); }
            else { const int r2 = r - I_O, nb = r2 / 16, kb = r2 % 16; transpose_item(p.in[I_WOUT], 1024, nb * 32, 32, nullptr, wsp<bf16_t>(p, WS_WOUT), 1024, nb * 32, kb * 64, scr, lane); } }
        return;
    }
    if constexpr (PART == 2) {
        for (int r = gw; r < I_D; r += ngw) { const int nb = r / 44, kb = r % 44; transpose_item(p.in[I_WDN], 1024, nb * 32, 32, nullptr, wsp<bf16_t>(p, WS_WD), DFF, nb * 32, kb * 64, scr, lane); }
        return;
    }
    constexpr int NITEMS = I_IN + I_QB + I_KVB + I_C1;
#define TW_DECODE(it_, wi_, ri_, do_, ldw_, c0_, nc_, ldd_, n0_, k0_) do { int r = (it_); \
        if (r < I_IN) { const int nb = r / 16, kb = r % 16; const int pn = nb >> 3, bj = (nb >> 2) & 1, wc = nb & 3; int ncx; c0_ = zsrc(4 * pn + wc, 32 * bj, ncx); nc_ = ncx; \
            wi_ = I_WIN; ri_ = -1; do_ = WS_WIN; ldw_ = D_IN; ldd_ = DM; n0_ = nb * 32; k0_ = kb * 64; break; } r -= I_IN; \
        if (r < I_QB) { const int nb = r / 12, kb = r % 12; wi_ = I_WQB; ri_ = I_QAG; do_ = WS_WQB; ldw_ = 768; c0_ = nb * 32; nc_ = 32; ldd_ = 768; n0_ = nb * 32; k0_ = kb * 64; break; } r -= I_QB; \
        if (r < I_KVB) { const int nb = r / 4, kb = r % 4; const int pn = nb >> 3, bj = (nb >> 2) & 1, wc = nb & 3, s = 4 * pn + wc; \
            c0_ = (s < 8) ? (128 * s + 32 * bj) : (128 * (s - 8) + 64 + 32 * bj); \
            wi_ = I_WKVB; ri_ = I_KVAG; do_ = WS_WKVB; ldw_ = 1024; nc_ = 32; ldd_ = 256; n0_ = nb * 32; k0_ = kb * 64; break; } r -= I_KVB; \
        { const int kv = r / 256, rr = r % 256, nb = rr / 32, kb = rr % 32; \
          wi_ = kv ? I_CW1V : I_CW1K; ri_ = -1; do_ = WS_CW1 + (size_t)kv * 256 * 2048 * 2; ldw_ = 256; c0_ = nb * 32; nc_ = 32; ldd_ = 2048; n0_ = nb * 32; k0_ = kb * 64; } } while (0)
    int it = gw;
    if (it < NITEMS) {
        int wia, ria, wib = 0, rib = -1; size_t doa, dob = 0; int ldwa, c0a, nca, ldda, n0a, k0a, ldwb = 0, c0b = 0, ncb = 0, lddb = 0, n0b = 0, k0b = 0;
        float va[32], vb[32];
        TW_DECODE(it, wia, ria, doa, ldwa, c0a, nca, ldda, n0a, k0a);
        tr_load(karg_in(wia), ldwa, c0a, nca, k0a, va, lane);
        for (;;) {
            const int nx = it + ngw; const bool hn = nx < NITEMS;
            if (hn) { TW_DECODE(nx, wib, rib, dob, ldwb, c0b, ncb, lddb, n0b, k0b); tr_load(karg_in(wib), ldwb, c0b, ncb, k0b, vb, lane); }
            tr_finish((ria >= 0) ? karg_in(ria) : (const float*)nullptr, (bf16_t*)(p.ws + doa), ldda, n0a, k0a, va, scr, lane);
            if (!hn) break;
            ria = rib; doa = dob; ldda = lddb; n0a = n0b; k0a = k0b; it = nx;
#pragma unroll
            for (int i = 0; i < 32; ++i) va[i] = vb[i];
        }
    }
#undef TW_DECODE
}
DI void stage_mod(const Params& p, int bid, int nb, float* lds, int wid0) {
    const int tid = opaque_tid(wid0), wave = tid >> 6, lane = tid & 63, nwv = blockDim.x >> 6;
    if (bid >= 224) return;
    float* sl = lds; float* red = lds + 8192;
    for (int i = tid; i < 8192; i += blockDim.x) sl[i] = siluf(p.in[I_C][i]);
    __syncthreads();
    for (int u = bid; u < 224; u += nb) {
        float acc[8];
#pragma unroll
        for (int b = 0; b < 8; ++b) acc[b] = 0.f;
        if (u < 192) {
            const int kh = lane >> 5; const float* W = p.in[I_ADAW] + u * 32 + (lane & 31); const int kn = 1024 / nwv;
            for (int k = wave * kn + kh; k < (wave + 1) * kn; k += 64) { float w[32];
#pragma unroll
                for (int e = 0; e < 32; ++e) w[e] = W[(size_t)(k + 2 * e) * 6144];
#pragma unroll
                for (int e = 0; e < 32; ++e)
#pragma unroll
                    for (int b = 0; b < 8; ++b) acc[b] += sl[b * 1024 + k + 2 * e] * w[e]; }
        } else {
            const int kq = (u - 192) >> 3, kv = ((u - 192) >> 2) & 1; const float* W = (kv ? p.in[I_CW1V] : p.in[I_CW1K]) + ((u - 192) & 3) * 64 + lane; const float* pos = kv ? p.in[I_CPV] : p.in[I_CPK]; const int kn = 512 / nwv;
            for (int k = kq * 512 + wave * kn; k < kq * 512 + (wave + 1) * kn; k += 32) { float w[32];
#pragma unroll
                for (int e = 0; e < 32; ++e) w[e] = W[(size_t)(k + e) * 256];
#pragma unroll
                for (int e = 0; e < 32; ++e) acc[0] += pos[k + e] * w[e]; }
        }
        __syncthreads();
#pragma unroll
        for (int b = 0; b < 8; ++b) red[(wave * 8 + b) * 64 + lane] = acc[b];
        __syncthreads();
        if (wave == 0) {
#pragma unroll
            for (int b = 0; b < 8; ++b) { float s = 0.f;
                if (u < 192) { for (int w = 0; w < nwv; ++w) s += red[(w * 8 + b) * 64 + (lane & 31)] + red[(w * 8 + b) * 64 + 32 + (lane & 31)];
                    if (lane < 32) wsp<float>(p, WS_MOD)[b * 6144 + u * 32 + lane] = s + p.in[I_ADAB][u * 32 + lane]; }
                else { for (int w = 0; w < nwv; ++w) s += red[(w * 8 + b) * 64 + lane];
                    if (b == 0) wsp<float>(p, WS_CB1)[((u - 192) >> 3) * 512 + ((u - 192) & 7) * 64 + lane] = s; } }
        }
    }
}
DI void stage_rope(const Params& p, int tid, int gtid, int ngt, float* invt) {
    if (tid < 24) invt[tid] = (tid < 16) ? (float)pow(500000.0, -(double)tid / 16.0) : (float)pow(500000.0, -(double)(tid - 16) / 8.0);
    __syncthreads();
    float* T = wsp<float>(p, WS_ROPE); const int* pos = (const int*)p.in[I_POS];
    for (int i = gtid; i < MT * 24; i += ngt) {
        const int row = i / 24, j = i % 24; const float ps = (float)pos[row]; float c, s;
        sincos_rad(ps * invt[j], c, s);
        if (j < 16) { T[(size_t)row * 16 + j] = c; T[(size_t)MT * 16 + (size_t)row * 16 + j] = s; }
        else { T[(size_t)MT * 32 + (size_t)row * 8 + (j - 16)] = c; T[(size_t)MT * 40 + (size_t)row * 8 + (j - 16)] = s; }
    }
}
DI const float* ropeCM(const Params& p) { return wsp<float>(p, WS_ROPE); }
DI const float* ropeSM(const Params& p) { return wsp<float>(p, WS_ROPE) + (size_t)MT * 16; }
DI const float* ropeCN(const Params& p) { return wsp<float>(p, WS_ROPE) + (size_t)MT * 32; }
DI const float* ropeSN(const Params& p) { return wsp<float>(p, WS_ROPE) + (size_t)MT * 40; }

DI void stage_normmod(const float* X, const float* gain, const float* mod, int sh_idx, int sc_idx, bf16_t* Hout, int m0, int mstep, int cnt, int lane) {
    f32x4 v[4], n1[4], n2[4], gs[4], sh[4];
    int bcur = -1;
#define NM_LOAD(dst, row) do { const f32x4* xr_ = (const f32x4*)(X + (size_t)(row) * DM) + lane; _Pragma("unroll") for (int j = 0; j < 4; ++j) dst[j] = xr_[64 * j]; } while (0)
    if (cnt > 0) NM_LOAD(n1, m0);
    if (cnt > 1) NM_LOAD(n2, m0 + mstep);
    for (int i = 0; i < cnt; ++i) {
        const int m = m0 + i * mstep, b = m / SEQ;
#pragma unroll
        for (int j = 0; j < 4; ++j) { v[j] = n1[j]; n1[j] = n2[j]; }
        if (i + 2 < cnt) NM_LOAD(n2, m + 2 * mstep);
        if (b != bcur) { bcur = b;
            const f32x4* g4 = (const f32x4*)gain + lane; const f32x4* sc4 = (const f32x4*)(mod + b * 6144 + sc_idx * 1024) + lane; const f32x4* sh4 = (const f32x4*)(mod + b * 6144 + sh_idx * 1024) + lane;
#pragma unroll
            for (int j = 0; j < 4; ++j) { gs[j] = g4[64 * j] * (1.0f + sc4[64 * j]); sh[j] = sh4[64 * j]; } }
        float s = 0.f;
#pragma unroll
        for (int j = 0; j < 4; ++j) s += (v[j].x * v[j].x + v[j].y * v[j].y) + (v[j].z * v[j].z + v[j].w * v[j].w);
        const float rstd = rsqrtf(wave_sum(s) * (1.f / DM) + EPS);
        u32x2* o8 = (u32x2*)(Hout + (size_t)m * DM) + lane;
#pragma unroll
        for (int j = 0; j < 4; ++j) { const f32x4 y = v[j] * rstd * gs[j] + sh[j]; u32x2 w; w.x = pk2(y.x, y.y); w.y = pk2(y.z, y.w); o8[64 * j] = w; }
    }
#undef NM_LOAD
}

DI void stage_shw(const Params& p, int ub, int nbk, float* lds, int wid0) {
    const int tid = opaque_tid(wid0), wave = tid >> 6, lane = tid & 63, nwv = blockDim.x >> 6;
    if (ub >= 88) return;
    float* sl = lds; float* red = lds + 8192;
    for (int i = tid; i < 8192; i += blockDim.x) sl[i] = wsp<float>(p, WS_MOD)[(i >> 10) * 6144 + 3 * 1024 + (i & 1023)];
    __syncthreads();
    for (int u = ub; u < 88; u += nbk) {
        const int mat = u / 44, col = 64 * (u % 44) + lane; const float* W = (mat ? p.in[I_WU] : p.in[I_WG]) + col; const int kn = 1024 / nwv;
        float acc[8];
#pragma unroll
        for (int b = 0; b < 8; ++b) acc[b] = 0.f;
        for (int k = wave * kn; k < (wave + 1) * kn; k += 8) { float w[8];
#pragma unroll
            for (int e = 0; e < 8; ++e) w[e] = W[(size_t)(k + e) * DFF];
#pragma unroll
            for (int e = 0; e < 8; ++e)
#pragma unroll
                for (int b = 0; b < 8; ++b) acc[b] += sl[b * 1024 + k + e] * w[e]; }
        __syncthreads();
#pragma unroll
        for (int b = 0; b < 8; ++b) red[(wave * 8 + b) * 64 + lane] = acc[b];
        __syncthreads();
        if (wave == 0) { const int s = col >> 5, cr = col & 31, phys = 256 * (s >> 2) + 128 * mat + 32 * (s & 3) + cr;
#pragma unroll
            for (int b = 0; b < 8; ++b) { float sum = 0.f;
                for (int w = 0; w < nwv; ++w) sum += red[(w * 8 + b) * 64 + lane];
                wsp<float>(p, WS_SHW)[b * 5632 + phys] = sum; } }
    }
}
struct ColPre { f32x4 c[8]; };
struct RowPre { f32x4 a[4]; };
DI void store8bf(bf16_t* dst, const float (&f)[8]) { st16(dst, pack8(f)); }
DI float ssq16(const float (&v)[2][8]) { float q = 0.f;
#pragma unroll
    for (int b = 0; b < 2; ++b)
#pragma unroll
        for (int j = 0; j < 8; ++j) q += v[b][j] * v[b][j];
    q += xorl<16>(q); return sum32(q); }
DI f32x4 ld4(const float* p) { return *(const f32x4*)p; }
DI f32x4 ld4u(const bf16_t* p) { return __builtin_bit_cast(f32x4, *(const u32x4*)p); }
DI void un8(const f32x4 raw, float (&f)[8]) { unpack8(__builtin_bit_cast(u32x4, raw), f); }

struct EpiZ {
    static constexpr bool HAS_MID = false; static constexpr int NTYPES = 7;
    Params p;
    DI void midpre(RowPre&, int, int, int, int) const {}
    DI void mid(const RowPre&, int, int, int, int, float (&)[2][8]) const {}
    DI int type(int pn, int wc) const { const int s = 4 * pn + wc;
        if (s < 16) return 0; if (s == 16) return 1; if (s < 25) return 2; if (s < 37) { const int t = (s - 25) >> 1; return (t == 2 || t == 4) ? 3 : 4; } if (s < 40) return 5; return 6; }
    template <int T> DI void ubegin(ColPre& U, int, int pn, int wc, int fq) const {
        const int s = 4 * pn + wc; (void)s;
        if constexpr (T == 1) { U.c[0] = ld4(p.in[I_MKG] + 64 + 8 * fq); U.c[1] = ld4(p.in[I_MKG] + 68 + 8 * fq); }
        if constexpr (T == 2 || T == 3) { const float* gain = (T == 2) ? p.in[I_NQG] : ((((s - 25) >> 1) == 2) ? p.in[I_NKSG] : p.in[I_NKWG]);
            U.c[0] = ld4(gain + 8 * fq); U.c[1] = ld4(gain + 8 * fq + 4); U.c[2] = ld4(gain + 32 + 8 * fq); U.c[3] = ld4(gain + 36 + 8 * fq); }
    }
    template <int T> DI void pre(RowPre& R, int row, int, int, int fq) const {
        if constexpr (T == 1) { const int i0 = 8 * (fq & 1); const float* cs = ropeCM(p) + (size_t)row * 16 + i0; const float* sn = ropeSM(p) + (size_t)row * 16 + i0;
            R.a[0] = ld4(cs); R.a[1] = ld4(cs + 4); R.a[2] = ld4(sn); R.a[3] = ld4(sn + 4); }
        if constexpr (T == 2 || T == 3) { const float* cs = ropeCN(p) + (size_t)row * 8; const float* sn = ropeSN(p) + (size_t)row * 8;
            R.a[0] = ld4(cs); R.a[1] = ld4(cs + 4); R.a[2] = ld4(sn); R.a[3] = ld4(sn + 4); }
    }
    DI void normrope(const ColPre& U, const RowPre& R, int fq, float (&v)[2][8], float post, bf16_t* dst) const {
        const float rstd = rsqrtf(ssq16(v) * (1.f / 64.f) + EPS);
#pragma unroll
        for (int b = 0; b < 2; ++b)
#pragma unroll
            for (int j = 0; j < 8; ++j) v[b][j] *= rstd * U.c[2 * b + (j >> 2)][j & 3];
#pragma unroll
        for (int j = 0; j < 8; ++j) { const float own = v[0][j], oth = xorl<16>(own); const float c = R.a[j >> 2][j & 3], s = R.a[2 + (j >> 2)][j & 3];
            if (fq == 0) v[0][j] = own * c - oth * s; else if (fq == 1) v[0][j] = own * c + oth * s; }
#pragma unroll
        for (int b = 0; b < 2; ++b) {
#pragma unroll
            for (int j = 0; j < 8; ++j) v[b][j] *= post;
            store8bf(dst + 32 * b + 8 * fq, v[b]); }
    }
    template <int T> DI void apply(const ColPre& U, const RowPre& R, int row, int pn, int wc, int fq, float (&v)[2][8]) const {
        const int s = 4 * pn + wc; (void)s;
        if constexpr (T == 0) {
            bf16_t* d = wsp<bf16_t>(p, WS_R1) + (size_t)row * 1024 + 64 * s + 8 * fq;
            const float q = ssq16(v); store8bf(d, v[0]); store8bf(d + 32, v[1]);
            if (fq == 0) wsp<float>(p, WS_SSQA)[(size_t)row * 16 + s] = q;
        } else if constexpr (T == 1) {
            float q = 0.f;
#pragma unroll
            for (int j = 0; j < 8; ++j) q += v[0][j] * v[0][j];
            q += xorl<16>(q); q = sum32(q);
            if (fq == 0) wsp<float>(p, WS_SSQPE)[row] = q;
            float o[8];
#pragma unroll
            for (int j = 0; j < 8; ++j) { const float own = v[0][j] * U.c[j >> 2][j & 3], oth = xor32(own, fq >> 1); const float c = R.a[j >> 2][j & 3], sn = R.a[2 + (j >> 2)][j & 3];
                o[j] = (fq < 2) ? own * c - oth * sn : own * c + oth * sn; }
            store8bf(wsp<bf16_t>(p, WS_KPE) + (size_t)row * 32 + 8 * fq, o);
#pragma unroll
            for (int j = 0; j < 8; ++j) o[j] = sigmoidf(v[1][j]);
            store8bf(wsp<bf16_t>(p, WS_GN) + (size_t)row * 32 + 8 * fq, o);
        } else if constexpr (T == 2) {
            normrope(U, R, fq, v, C2N, wsp<bf16_t>(p, WS_QN) + (size_t)row * 512 + 64 * (s - 17));
        } else if constexpr (T == 3 || T == 4) {
            const int t = (s - 25) >> 1, g = (s - 25) & 1;
            bf16_t* d = wsp<bf16_t>(p, WS_KC + (size_t)t * 4 * MiB) + (size_t)row * 128 + 64 * g;
            if constexpr (T == 3) normrope(U, R, fq, v, 1.0f, d);
            else { store8bf(d + 8 * fq, v[0]); store8bf(d + 32 + 8 * fq, v[1]); }
        } else if constexpr (T == 5) {
        } else {
            bf16_t* d = wsp<bf16_t>(p, WS_R2) + (size_t)row * 2048 + 64 * (s - 40) + 8 * fq;
#pragma unroll
            for (int b = 0; b < 2; ++b) { float o[8];
#pragma unroll
                for (int j = 0; j < 8; ++j) o[j] = sigmoidf(v[b][j]);
                store8bf(d + 32 * b, o); }
        }
    }
};
struct EpiQ {
    static constexpr bool HAS_MID = false; static constexpr int NTYPES = 1;
    Params p;
    DI int type(int, int) const { return 0; }
    DI void midpre(RowPre&, int, int, int, int) const {}
    DI void mid(const RowPre&, int, int, int, int, float (&)[2][8]) const {}
    template <int T> DI void ubegin(ColPre&, int, int, int, int) const {}
    template <int T> DI void pre(RowPre& R, int row, int, int, int) const { const float* sq = wsp<float>(p, WS_SSQA) + (size_t)row * 16; R.a[0] = ld4(sq); R.a[1] = ld4(sq + 4); R.a[2] = ld4(sq + 8); }
    template <int T> DI void apply(const ColPre&, const RowPre& R, int row, int pn, int wc, int fq, float (&v)[2][8]) const {
        const float s = ((R.a[0].x + R.a[0].y) + (R.a[0].z + R.a[0].w)) + ((R.a[1].x + R.a[1].y) + (R.a[1].z + R.a[1].w)) + ((R.a[2].x + R.a[2].y) + (R.a[2].z + R.a[2].w));
        const float rstd = rsqrtf(s * (1.f / 768.f) + EPS);
        bf16_t* d = qraw(p) + (size_t)row * 768 + 256 * pn + 32 * wc + 8 * fq;
#pragma unroll
        for (int b = 0; b < 2; ++b) { float o[8];
#pragma unroll
            for (int j = 0; j < 8; ++j) o[j] = v[b][j] * rstd;
            store8bf(d + 128 * b, o); }
    }
};
struct EpiKV {
    static constexpr bool HAS_MID = false; static constexpr int NTYPES = 1;
    Params p;
    DI int type(int, int) const { return 0; }
    DI void midpre(RowPre&, int, int, int, int) const {}
    DI void mid(const RowPre&, int, int, int, int, float (&)[2][8]) const {}
    template <int T> DI void ubegin(ColPre&, int, int, int, int) const {}
    template <int T> DI void pre(RowPre& R, int row, int pn, int wc, int fq) const { R.a[0] = ld4(wsp<float>(p, WS_SSQA) + (size_t)row * 16 + 12);
        if (4 * pn + wc < 8) { R.a[1].x = wsp<float>(p, WS_SSQPE)[row]; R.a[2] = ld4u(wsp<bf16_t>(p, WS_KPE) + (size_t)row * 32 + 8 * fq); } }
    template <int T> DI void apply(const ColPre&, const RowPre& R, int row, int pn, int wc, int fq, float (&v)[2][8]) const {
        const int s = 4 * pn + wc;
        const float rstd = rsqrtf(((R.a[0].x + R.a[0].y) + (R.a[0].z + R.a[0].w)) * (1.f / 256.f) + EPS);
#pragma unroll
        for (int b = 0; b < 2; ++b)
#pragma unroll
            for (int j = 0; j < 8; ++j) v[b][j] *= rstd;
        if (s < 8) { const float rk = rsqrtf((ssq16(v) + R.a[1].x) * (1.f / 96.f) + EPS);
#pragma unroll
            for (int b = 0; b < 2; ++b)
#pragma unroll
                for (int j = 0; j < 8; ++j) v[b][j] *= rk;
            float pe[8]; un8(R.a[2], pe);
#pragma unroll
            for (int j = 0; j < 8; ++j) pe[j] *= rk;
            bf16_t* d = wsp<bf16_t>(p, WS_KN) + (size_t)row * 768 + 96 * s + 8 * fq; store8bf(d, v[0]); store8bf(d + 32, v[1]); store8bf(d + 64, pe); }
        else { bf16_t* d = wsp<bf16_t>(p, WS_VM) + (size_t)row * 512 + 64 * (s - 8) + 8 * fq; store8bf(d, v[0]); store8bf(d + 32, v[1]); }
    }
};
struct EpiMerge {
    static constexpr bool HAS_MID = true; static constexpr int NTYPES = 1;
    Params p;
    DI int type(int, int) const { return 0; }
    DI void midpre(RowPre& R, int row, int pn, int wc, int fq) const {
        const bf16_t* g = wsp<bf16_t>(p, WS_R2) + (size_t)row * 2048 + 256 * pn + 32 * wc + 8 * fq;
        R.a[0] = ld4u(g); R.a[1] = ld4u(g + 128); R.a[2] = ld4u(g + 1024); R.a[3] = ld4u(g + 1024 + 128); }
    DI void mid(const RowPre& R, int, int, int, int, float (&v)[2][8]) const {
#pragma unroll
        for (int b = 0; b < 2; ++b) { float s1[8], s2[8]; un8(R.a[b], s1); un8(R.a[2 + b], s2);
#pragma unroll
            for (int j = 0; j < 8; ++j) v[b][j] *= s1[j] * __builtin_amdgcn_rcpf(s2[j]); }
    }
    template <int T> DI void ubegin(ColPre&, int, int, int, int) const {}
    template <int T> DI void pre(RowPre& R, int row, int pn, int wc, int fq) const {
        const bf16_t* g = wsp<bf16_t>(p, WS_R2) + (size_t)row * 2048 + 1024 + 256 * pn + 32 * wc + 8 * fq; R.a[0] = ld4u(g); R.a[1] = ld4u(g + 128); }
    template <int T> DI void apply(const ColPre&, const RowPre& R, int row, int pn, int wc, int fq, float (&v)[2][8]) const {
        bf16_t* d = wsp<bf16_t>(p, WS_R2) + (size_t)row * 2048 + 1024 + 256 * pn + 32 * wc + 8 * fq;
#pragma unroll
        for (int b = 0; b < 2; ++b) { float s2[8], o[8]; un8(R.a[b], s2);
#pragma unroll
            for (int j = 0; j < 8; ++j) o[j] = v[b][j] * s2[j];
            store8bf(d + 128 * b, o); }
    }
};
struct EpiOut {
    static constexpr bool HAS_MID = false; static constexpr int NTYPES = 1;
    Params p;
    DI int type(int, int) const { return 0; }
    DI void midpre(RowPre&, int, int, int, int) const {}
    DI void mid(const RowPre&, int, int, int, int, float (&)[2][8]) const {}
    template <int T> DI void ubegin(ColPre& U, int row0, int pn, int wc, int fq) const {
        const int b_ = row0 / SEQ, col = 256 * pn + 32 * wc + 8 * fq; const float* md = wsp<float>(p, WS_MOD) + b_ * 6144 + col; const float* g2 = p.in[I_N2G] + col;
#pragma unroll
        for (int i = 0; i < 4; ++i) { const int o = 128 * (i >> 1) + 4 * (i & 1); U.c[i] = ld4(md + 2 * 1024 + o); const f32x4 sc = ld4(md + 4 * 1024 + o), gg = ld4(g2 + o); U.c[4 + i] = gg * (1.0f + sc); }
    }
    template <int T> DI void pre(RowPre& R, int row, int pn, int wc, int fq) const { const float* x = p.in[I_X] + (size_t)row * DM + 256 * pn + 32 * wc + 8 * fq;
        R.a[0] = ld4(x); R.a[1] = ld4(x + 4); R.a[2] = ld4(x + 128); R.a[3] = ld4(x + 132); }
    template <int T> DI void apply(const ColPre& U, const RowPre& R, int row, int pn, int wc, int fq, float (&v)[2][8]) const {
        const int col = 256 * pn + 32 * wc + 8 * fq; bf16_t* d = wsp<bf16_t>(p, WS_R2) + (size_t)row * 2048 + col;   bf16_t* a2 = wsp<bf16_t>(p, WS_R1) + (size_t)row * DM + col;
        float q = 0.f;
#pragma unroll
        for (int b = 0; b < 2; ++b) { float o8[8], x8[8];
#pragma unroll
            for (int h = 0; h < 2; ++h) { const f32x4 g = U.c[2 * b + h], xv = R.a[2 * b + h], gs = U.c[4 + 2 * b + h];
                f32x4 o; o.x = xv.x + g.x * v[b][4 * h]; o.y = xv.y + g.y * v[b][4 * h + 1]; o.z = xv.z + g.z * v[b][4 * h + 2]; o.w = xv.w + g.w * v[b][4 * h + 3];
                x8[4 * h] = o.x; x8[4 * h + 1] = o.y; x8[4 * h + 2] = o.z; x8[4 * h + 3] = o.w;
                q += (o.x * o.x + o.y * o.y) + (o.z * o.z + o.w * o.w);
                o8[4 * h] = o.x * gs.x; o8[4 * h + 1] = o.y * gs.y; o8[4 * h + 2] = o.z * gs.z; o8[4 * h + 3] = o.w * gs.w; }
            store8bf(d + 128 * b, x8); store8bf(a2 + 128 * b, o8); }
        q += xorl<16>(q); q = sum32(q);
        if (fq == 0) wsp<float>(p, WS_SSQA)[(size_t)row * 16 + 4 * pn + wc] = q;
    }
};
struct EpiGU {
    static constexpr bool HAS_MID = false; static constexpr int NTYPES = 1;
    Params p;
    DI int type(int, int) const { return 0; }
    DI void midpre(RowPre&, int, int, int, int) const {}
    DI void mid(const RowPre&, int, int, int, int, float (&)[2][8]) const {}
    template <int T> DI void ubegin(ColPre& U, int row0, int pn, int wc, int fq) const { const float* sh = wsp<float>(p, WS_SHW) + (row0 / SEQ) * 5632 + 256 * pn + 32 * wc + 8 * fq;
        U.c[0] = ld4(sh); U.c[1] = ld4(sh + 4); U.c[2] = ld4(sh + 128); U.c[3] = ld4(sh + 132); }
    template <int T> DI void pre(RowPre& R, int row, int, int, int) const { const float* sq = wsp<float>(p, WS_SSQA) + (size_t)row * 16; R.a[0] = ld4(sq); R.a[1] = ld4(sq + 4); R.a[2] = ld4(sq + 8); R.a[3] = ld4(sq + 12); }
    template <int T> DI void apply(const ColPre& U, const RowPre& R, int row, int pn, int wc, int fq, float (&v)[2][8]) const {
        const int s = 4 * pn + wc; float o[8];
        const float tot = (((R.a[0].x + R.a[0].y) + (R.a[0].z + R.a[0].w)) + ((R.a[1].x + R.a[1].y) + (R.a[1].z + R.a[1].w))) + (((R.a[2].x + R.a[2].y) + (R.a[2].z + R.a[2].w)) + ((R.a[3].x + R.a[3].y) + (R.a[3].z + R.a[3].w)));
        const float rstd = rsqrtf(tot * (1.f / DM) + EPS);
#pragma unroll
        for (int j = 0; j < 8; ++j) o[j] = siluf(rstd * v[0][j] + U.c[j >> 2][j & 3]) * (rstd * v[1][j] + U.c[2 + (j >> 2)][j & 3]);
        store8bf(wsp<bf16_t>(p, WS_HID) + (size_t)row * DFF + 32 * s + 8 * fq, o);
    }
};
struct EpiDown {
    static constexpr bool HAS_MID = false; static constexpr int NTYPES = 1;
    Params p;
    DI int type(int, int) const { return 0; }
    DI void midpre(RowPre&, int, int, int, int) const {}
    DI void mid(const RowPre&, int, int, int, int, float (&)[2][8]) const {}
    template <int T> DI void ubegin(ColPre& U, int row0, int pn, int wc, int fq) const { const float* gt = wsp<float>(p, WS_MOD) + (row0 / SEQ) * 6144 + 5 * 1024 + 256 * pn + 32 * wc + 8 * fq;
        U.c[0] = ld4(gt); U.c[1] = ld4(gt + 4); U.c[2] = ld4(gt + 128); U.c[3] = ld4(gt + 132); }
    template <int T> DI void pre(RowPre& R, int row, int pn, int wc, int fq) const { const bf16_t* x = wsp<bf16_t>(p, WS_R2) + (size_t)row * 2048 + 256 * pn + 32 * wc + 8 * fq;
        R.a[0] = ld4u(x); R.a[1] = ld4u(x + 128); }
    template <int T> DI void apply(const ColPre& U, const RowPre& R, int row, int pn, int wc, int fq, float (&v)[2][8]) const {
        float* d = p.out + (size_t)row * DM + 256 * pn + 32 * wc + 8 * fq;
#pragma unroll
        for (int b = 0; b < 2; ++b) { float x8[8]; un8(R.a[b], x8);
#pragma unroll
            for (int h = 0; h < 2; ++h) { const f32x4 g = U.c[2 * b + h];
                f32x4 o; o.x = x8[4 * h] + g.x * v[b][4 * h]; o.y = x8[4 * h + 1] + g.y * v[b][4 * h + 1]; o.z = x8[4 * h + 2] + g.z * v[b][4 * h + 2]; o.w = x8[4 * h + 3] + g.w * v[b][4 * h + 3]; *(f32x4*)(d + 128 * b + 4 * h) = o; } }
    }
};
namespace pg8 {
#define PG8_LAS __attribute__((address_space(3)))
typedef short bf16x8 __attribute__((ext_vector_type(8)));
constexpr int BM = 256, BK = 64, HALF = 128, HTB = HALF * BK * 2  , STAGE_BYTES = 8 * HTB, NXCD = 8;
#ifndef PG8_WGM
#define PG8_WGM 8
#endif
constexpr int WGM = PG8_WGM;

__host__ __device__ __forceinline__ int lds_byte(int r, int c) { const int st = (r >> 4) * 2 + (c >> 5), rr = r & 15, cc = c & 31, ob = rr * 64 + cc * 2; return st * 1024 + (ob ^ (((ob >> 9) & 1) << 5)); }
__host__ __device__ __forceinline__ void stage_rc(int b, int& R, int& C) { const int st = b / 1024, sb = b % 1024, swz = sb ^ (((sb >> 9) & 1) << 5); R = (st >> 1) * 16 + swz / 64; C = (st & 1) * 32 + (swz % 64) / 2; }
__host__ __device__ __forceinline__ int perm32(int rho) { const int n = rho >> 4, i = rho & 15; return 8 * (i >> 2) + 4 * n + (i & 3); }

struct Unit { int pm, pn; };
struct Gemm { const bf16_t* A; const bf16_t* Bt; int M, N, K, lda, ldb, kstepA; };

struct StaticOrder {
    int nM, nN, nwg, G, c;
    __host__ __device__ void init(int M, int N, int G_, int c_) { nM = M / BM; nN = N / BM; nwg = nM * nN; G = G_; c = c_; }
    __host__ __device__ bool next(int i, Unit& u) const {
        const long L = (long)i * G + c; if (L >= nwg) return false;
        int wgid = (int)L; { const int q = nwg / NXCD, r = nwg % NXCD, xcd = wgid % NXCD, off = wgid / NXCD; wgid = (xcd < r ? xcd * (q + 1) : r * (q + 1) + (xcd - r) * q) + off; }
        const int nig = WGM * nN, gid = wgid / nig, fm = gid * WGM, gsz = (nM - fm) < WGM ? (nM - fm) : WGM;
        u.pm = fm + ((wgid % nig) % gsz); u.pn = (wgid % nig) / gsz; return true;
    }
    __device__ __forceinline__ void a_ready(const Unit&) const {}
    __device__ __forceinline__ void done(const Unit&) const {}
};

template <class Epi, class Sched, bool ALIGN_EPI = false, bool SP2 = false>
__device__ __forceinline__ void gemm_phase(PG8_LAS unsigned char* lds, const Gemm g, const Sched& S, const Epi& E, int wid0) {
    const int tid = opaque_tid(wid0), wid = __builtin_amdgcn_readfirstlane(tid >> 6), lane = tid & 63, wr = wid >> 2, wc = wid & 3, fr = lane & 15, fq = lane >> 4;
    const int K = g.K; int nt = K / BK; asm volatile("" : "+s"(nt));
    unsigned voffA[2], voffB[2];
#pragma unroll
    for (int i = 0; i < 2; ++i) { int R, C; stage_rc(tid * 16 + i * 8192, R, C); const int Rb = Epi::PERM ? ((R & ~31) + perm32(R & 31)) : R;
        voffA[i] = (unsigned)(R * g.lda + C) * 2u; voffB[i] = (unsigned)(Rb * g.ldb + C) * 2u; }
    const size_t kstep = (size_t)(BK * 2), kstepA = (size_t)g.kstepA;
    const size_t hstepB = (size_t)HALF * g.ldb * 2, hstepA = (size_t)HALF * g.lda * 2;
    const size_t tstepB = 2 * hstepB, tstepA = 2 * hstepA;
    const unsigned ldsw = (unsigned)wid * 1024u;
    const int aoff = lds_byte(wr * 64 + fr, fq * 8), boff = lds_byte(wc * 32 + fr, fq * 8);
#define PG8_SA(b, h) (((b) * 2 + (h)) * HTB)
#define PG8_SB(b, h) ((4 + (b) * 2 + (h)) * HTB)
#define PG8_STAGE(bufoff, gbase, voff) do { _Pragma("unroll") for (int _i = 0; _i < 2; ++_i) \
        __builtin_amdgcn_global_load_lds((const unsigned*)((const char*)(gbase) + (voff)[_i]), (PG8_LAS unsigned*)(lds + (bufoff) + ldsw + _i * 8192), 16, 0, 0); } while (0)
#define PG8_LDA(dst, b, h) do { _Pragma("unroll") for (int m = 0; m < 4; ++m) _Pragma("unroll") for (int k = 0; k < 2; ++k) dst[m][k] = *(const PG8_LAS bf16x8*)(lds + PG8_SA(b, h) + aoff + m * 2048 + k * 1024); } while (0)
#define PG8_LDB(dst, b, h) do { _Pragma("unroll") for (int n = 0; n < 2; ++n) _Pragma("unroll") for (int k = 0; k < 2; ++k) dst[n][k] = *(const PG8_LAS bf16x8*)(lds + PG8_SB(b, h) + boff + n * 2048 + k * 1024); } while (0)
#define PG8_MMA(ai, bj, At, Bt) do { __builtin_amdgcn_s_setprio(1); _Pragma("unroll") for (int m = 0; m < 4; ++m) _Pragma("unroll") for (int n = 0; n < 2; ++n) _Pragma("unroll") for (int k = 0; k < 2; ++k) \
        acc[ai][bj][m][n] = __builtin_amdgcn_mfma_f32_16x16x32_bf16(Bt[n][k], At[m][k], acc[ai][bj][m][n], 0, 0, 0); __builtin_amdgcn_s_setprio(0); } while (0)
#define PG8_WAIT_V(n) asm volatile("s_waitcnt vmcnt(" #n ")" ::: "memory")
#define PG8_WAIT_L(n) asm volatile("s_waitcnt lgkmcnt(" #n ")" ::: "memory")
#define PG8_BAR __builtin_amdgcn_s_barrier()
#define PG8_SCHED __builtin_amdgcn_sched_barrier(0)
    Unit cur, nxt; int ui = 0;
    if (!S.next(0, cur)) return;
    f32x4 acc[2][2][4][2];
#pragma unroll
    for (int a = 0; a < 2; ++a)
#pragma unroll
        for (int b = 0; b < 2; ++b)
#pragma unroll
            for (int m = 0; m < 4; ++m)
#pragma unroll
                for (int n = 0; n < 2; ++n) acc[a][b][m][n] = (f32x4){0.f, 0.f, 0.f, 0.f};
    bf16x8 At[4][2], B0[2][2], B1[2][2];
    const char* cA = (const char*)g.A + (size_t)cur.pm * tstepA; const char* cB = (const char*)g.Bt + (size_t)cur.pn * tstepB;
    S.a_ready(cur);
    if constexpr (SP2) {
        PG8_STAGE(PG8_SB(0, 0), cB, voffB); PG8_STAGE(PG8_SB(0, 1), cB + hstepB, voffB); PG8_STAGE(PG8_SA(0, 0), cA, voffA); PG8_STAGE(PG8_SA(0, 1), cA + hstepA, voffA);
        if (wr == 1) PG8_BAR;
        PG8_WAIT_V(2); PG8_BAR;
        PG8_STAGE(PG8_SB(1, 0), cB + kstep, voffB); PG8_STAGE(PG8_SA(1, 0), cA + kstepA, voffA); PG8_STAGE(PG8_SB(1, 1), cB + hstepB + kstep, voffB);
        PG8_WAIT_V(6); PG8_BAR;
    } else {
        PG8_STAGE(PG8_SB(0, 0), cB, voffB); PG8_STAGE(PG8_SA(0, 0), cA, voffA); PG8_STAGE(PG8_SB(0, 1), cB + hstepB, voffB); PG8_STAGE(PG8_SA(0, 1), cA + hstepA, voffA);
        if (wr == 1) PG8_BAR;
        PG8_WAIT_V(4); PG8_BAR;
        PG8_STAGE(PG8_SB(1, 0), cB + kstep, voffB); PG8_STAGE(PG8_SA(1, 0), cA + kstepA, voffA); PG8_STAGE(PG8_SB(1, 1), cB + hstepB + kstep, voffB);
        PG8_WAIT_V(6); PG8_BAR;
    }
    for (;;) {
        const bool has_next = S.next(ui + 1, nxt);
        const char* nA = has_next ? (const char*)g.A + (size_t)nxt.pm * tstepA : cA; const char* nB = has_next ? (const char*)g.Bt + (size_t)nxt.pn * tstepB : cB;
        for (int hh_ = 0; hh_ < (Epi::HAS_MID ? 2 : 1); ++hh_) {
        if constexpr (Epi::HAS_MID) { if (hh_ == 1) E.mid(acc, cur, wr, wc, fr, fq); }
        const int t0_ = Epi::HAS_MID ? hh_ * (nt >> 1) : 0, t1_ = Epi::HAS_MID ? (hh_ + 1) * (nt >> 1) : nt;
        for (int t = t0_; t < t1_; t += 2) {
            const bool last = (t == nt - 2);
            const char* a1 = cA + (size_t)(t + 1) * kstepA;
            const char* a2 = last ? nA : cA + (size_t)(t + 2) * kstepA; const char* b2 = last ? nB : cB + (size_t)(t + 2) * kstep;
            const char* a3 = a2 + kstepA; const char* b3 = b2 + kstep;
            if (last && has_next) S.a_ready(nxt);
            if constexpr (SP2) {
            PG8_LDB(B0, 0, 0); PG8_LDB(B1, 0, 1); PG8_SCHED; PG8_LDA(At, 0, 0); PG8_STAGE(PG8_SA(1, 1), a1 + hstepA, voffA);
            PG8_WAIT_V(8); PG8_WAIT_L(0); PG8_BAR; PG8_MMA(0, 0, At, B0); PG8_MMA(0, 1, At, B1); PG8_BAR; PG8_SCHED;
            PG8_LDA(At, 0, 1); PG8_STAGE(PG8_SB(0, 0), b2, voffB); PG8_STAGE(PG8_SB(0, 1), b2 + hstepB, voffB); PG8_STAGE(PG8_SA(0, 0), a2, voffA);
            PG8_WAIT_V(8); PG8_WAIT_L(0); PG8_BAR; PG8_MMA(1, 0, At, B0); PG8_MMA(1, 1, At, B1); PG8_BAR; PG8_SCHED;
            PG8_LDB(B0, 1, 0); PG8_LDB(B1, 1, 1); PG8_SCHED; PG8_LDA(At, 1, 0); PG8_STAGE(PG8_SA(0, 1), a2 + hstepA, voffA);
            PG8_WAIT_V(8); PG8_WAIT_L(0); PG8_BAR; PG8_MMA(0, 0, At, B0); PG8_MMA(0, 1, At, B1); PG8_BAR; PG8_SCHED;
            PG8_LDA(At, 1, 1); PG8_STAGE(PG8_SB(1, 0), b3, voffB); PG8_STAGE(PG8_SB(1, 1), b3 + hstepB, voffB); PG8_STAGE(PG8_SA(1, 0), a3, voffA);
            PG8_WAIT_V(8); PG8_WAIT_L(0); PG8_BAR; PG8_MMA(1, 0, At, B0); PG8_MMA(1, 1, At, B1); PG8_BAR; PG8_SCHED;
            } else {
            PG8_LDB(B0, 0, 0); PG8_SCHED; PG8_LDA(At, 0, 0); PG8_STAGE(PG8_SA(1, 1), a1 + hstepA, voffA);
            PG8_WAIT_L(8); PG8_BAR; PG8_WAIT_L(0); PG8_MMA(0, 0, At, B0); PG8_BAR; PG8_SCHED;
            PG8_LDB(B1, 0, 1); PG8_STAGE(PG8_SB(0, 0), b2, voffB);
            PG8_BAR; PG8_WAIT_L(0); PG8_MMA(0, 1, At, B1); PG8_BAR;
            PG8_LDA(At, 0, 1); PG8_STAGE(PG8_SA(0, 0), a2, voffA);
            PG8_BAR; PG8_WAIT_L(0); PG8_MMA(1, 0, At, B0); PG8_BAR; PG8_SCHED;
            PG8_STAGE(PG8_SB(0, 1), b2 + hstepB, voffB);
            PG8_WAIT_V(6); PG8_BAR; PG8_MMA(1, 1, At, B1); PG8_BAR;
            PG8_LDB(B0, 1, 0); PG8_SCHED; PG8_LDA(At, 1, 0); PG8_STAGE(PG8_SA(0, 1), a2 + hstepA, voffA);
            PG8_WAIT_L(8); PG8_BAR; PG8_WAIT_L(0); PG8_MMA(0, 0, At, B0); PG8_BAR; PG8_SCHED;
            PG8_LDB(B1, 1, 1); PG8_STAGE(PG8_SB(1, 0), b3, voffB);
            PG8_BAR; PG8_WAIT_L(0); PG8_MMA(0, 1, At, B1); PG8_BAR;
            PG8_LDA(At, 1, 1); PG8_STAGE(PG8_SA(1, 0), a3, voffA);
            PG8_BAR; PG8_WAIT_L(0); PG8_MMA(1, 0, At, B0); PG8_BAR; PG8_SCHED;
            PG8_STAGE(PG8_SB(1, 1), b3 + hstepB, voffB);
            PG8_WAIT_V(6); PG8_BAR; PG8_MMA(1, 1, At, B1); PG8_BAR;
            }
        }
        }
        if constexpr (ALIGN_EPI) { if (wr == 0) PG8_BAR; }
        if constexpr (!Epi::AFTER_DRAIN) { E(acc, cur, wr, wc, fr, fq); S.done(cur); }
        if (!has_next) break;
#pragma unroll
        for (int a = 0; a < 2; ++a)
#pragma unroll
            for (int b = 0; b < 2; ++b)
#pragma unroll
                for (int m = 0; m < 4; ++m)
#pragma unroll
                    for (int n = 0; n < 2; ++n) acc[a][b][m][n] = (f32x4){0.f, 0.f, 0.f, 0.f};
        cur = nxt; cA = nA; cB = nB; ++ui;
        if constexpr (ALIGN_EPI) { if (wr == 1) PG8_BAR; }
    }
    PG8_WAIT_V(0);
    if constexpr (!ALIGN_EPI) { if (wr == 0) PG8_BAR; }
    PG8_BAR;
    if constexpr (Epi::AFTER_DRAIN) { E.fused(acc, cur, wr, wc, fr, fq, lds, wid, lane); S.done(cur); }
#undef PG8_SA
#undef PG8_SB
#undef PG8_STAGE
#undef PG8_LDA
#undef PG8_LDB
#undef PG8_MMA
#undef PG8_WAIT_V
#undef PG8_WAIT_L
#undef PG8_BAR
#undef PG8_SCHED
}
}

#ifndef PG8_SP2V
#define PG8_SP2V true
#endif
template <class SE> struct EpiAdapt {
    static constexpr bool PERM = true, AFTER_DRAIN = false, HAS_MID = SE::HAS_MID;
    SE se;
    template <int T> DI void run(f32x4 (&acc)[2][2][4][2], const pg8::Unit& u, int wr, int wc, int fr, int fq) const {
        int frr = fr; asm volatile("" : "+v"(frr));
        const int rbase = u.pm * 256 + wr * 64;
        ColPre U; se.template ubegin<T>(U, rbase, u.pn, wc, fq);
        RowPre R[2]; se.template pre<T>(R[0], rbase + frr, u.pn, wc, fq);
#pragma unroll
        for (int it = 0; it < 8; ++it) {
            const int ai = it >> 2, m = it & 3; const int row = rbase + ai * 128 + m * 16 + frr;
            if (it < 7) se.template pre<T>(R[(it + 1) & 1], rbase + ((it + 1) >> 2) * 128 + ((it + 1) & 3) * 16 + frr, u.pn, wc, fq);
            float v[2][8];
#pragma unroll
            for (int bj = 0; bj < 2; ++bj)
#pragma unroll
                for (int n = 0; n < 2; ++n) { v[bj][4 * n] = acc[ai][bj][m][n][0]; v[bj][4 * n + 1] = acc[ai][bj][m][n][1]; v[bj][4 * n + 2] = acc[ai][bj][m][n][2]; v[bj][4 * n + 3] = acc[ai][bj][m][n][3]; }
            se.template apply<T>(U, R[it & 1], row, u.pn, wc, fq, v);
        }
    }
    template <int T> DI void disp(int ty, f32x4 (&acc)[2][2][4][2], const pg8::Unit& u, int wr, int wc, int fr, int fq) const {
        if constexpr (T < SE::NTYPES) { if (ty == T) run<T>(acc, u, wr, wc, fr, fq); else disp<T + 1>(ty, acc, u, wr, wc, fr, fq); }
    }
    DI void operator()(f32x4 (&acc)[2][2][4][2], const pg8::Unit& u, int wr, int wc, int fr, int fq) const { disp<0>(se.type(u.pn, wc), acc, u, wr, wc, fr, fq); }
    DI void mid(f32x4 (&acc)[2][2][4][2], const pg8::Unit& u, int wr, int wc, int fr, int fq) const {
        int frr = fr; asm volatile("" : "+v"(frr));
        const int rbase = u.pm * 256 + wr * 64;
        RowPre R[2]; se.midpre(R[0], rbase + frr, u.pn, wc, fq);
#pragma unroll
        for (int it = 0; it < 8; ++it) {
            const int ai = it >> 2, m = it & 3; const int row = rbase + ai * 128 + m * 16 + frr;
            if (it < 7) se.midpre(R[(it + 1) & 1], rbase + ((it + 1) >> 2) * 128 + ((it + 1) & 3) * 16 + frr, u.pn, wc, fq);
            float v[2][8];
#pragma unroll
            for (int bj = 0; bj < 2; ++bj)
#pragma unroll
                for (int n = 0; n < 2; ++n) { v[bj][4 * n] = acc[ai][bj][m][n][0]; v[bj][4 * n + 1] = acc[ai][bj][m][n][1]; v[bj][4 * n + 2] = acc[ai][bj][m][n][2]; v[bj][4 * n + 3] = acc[ai][bj][m][n][3]; }
            se.mid(R[it & 1], row, u.pn, wc, fq, v);
#pragma unroll
            for (int bj = 0; bj < 2; ++bj)
#pragma unroll
                for (int n = 0; n < 2; ++n) { acc[ai][bj][m][n][0] = v[bj][4 * n]; acc[ai][bj][m][n][1] = v[bj][4 * n + 1]; acc[ai][bj][m][n][2] = v[bj][4 * n + 2]; acc[ai][bj][m][n][3] = v[bj][4 * n + 3]; }
        }
    }
};
template <class SE, bool ALIGN = true> DI void gemm_fast(PG8_LAS unsigned char* lds, const bf16_t* A, int lda, const bf16_t* Bt, int M, int N, int K, const SE& se, int G, int c, int wid0) {
    pg8::Gemm g{A, Bt, M, N, K, lda, K, 128}; pg8::StaticOrder S; S.init(M, N, G, c);
    EpiAdapt<SE> E{se};
    pg8::gemm_phase<EpiAdapt<SE>, pg8::StaticOrder, ALIGN, PG8_SP2V>(lds, g, S, E, wid0);
}
struct RangeOrder {
    int base, cnt, nN;
    DI bool next(int i, pg8::Unit& u) const { if (i >= cnt) return false; const int L = base + i; u.pm = L / nN; u.pn = L % nN; return true; }
    DI void a_ready(const pg8::Unit&) const {}
    DI void done(const pg8::Unit&) const {}
};
template <class SE> DI void gemm_fast_range(PG8_LAS unsigned char* lds, const bf16_t* A, int lda, const bf16_t* Bt, int M, int N, int K, const SE& se, int base, int cnt, int wid0) {
    pg8::Gemm g{A, Bt, M, N, K, lda, K, 128}; RangeOrder S{base, cnt, N / 256};
    EpiAdapt<SE> E{se};
    pg8::gemm_phase<EpiAdapt<SE>, RangeOrder, true, true>(lds, g, S, E, wid0);
}
struct OneUnit {
    int pm, pn;
    DI bool next(int i, pg8::Unit& u) const { if (i > 0) return false; u.pm = pm; u.pn = pn; return true; }
    DI void a_ready(const pg8::Unit&) const {}
    DI void done(const pg8::Unit&) const {}
};
struct EpiCmpH {
    static constexpr bool HAS_MID = false; static constexpr int NTYPES = 1;
    float* H;
    DI int type(int, int) const { return 0; }
    DI void midpre(RowPre&, int, int, int, int) const {}
    DI void mid(const RowPre&, int, int, int, int, float (&)[2][8]) const {}
    template <int T> DI void ubegin(ColPre&, int, int, int, int) const {}
    template <int T> DI void pre(RowPre&, int, int, int, int) const {}
    template <int T> DI void apply(const ColPre&, const RowPre&, int row, int pn, int wc, int fq, float (&v)[2][8]) const {
        float* d = H + (size_t)row * 256 + 32 * wc + 8 * fq;
#pragma unroll
        for (int b = 0; b < 2; ++b) { st16f(d + 128 * b, (f32x4){v[b][0], v[b][1], v[b][2], v[b][3]}); st16f(d + 128 * b + 4, (f32x4){v[b][4], v[b][5], v[b][6], v[b][7]}); }
    }
};
DI void cmp_hidden_fast(const Params& p, PG8_LAS unsigned char* lds, int cu, int wid0) {
    const int kv = cu >> 4, g = (cu >> 3) & 1, pm = (cu >> 1) & 3, sp = cu & 1;
    const bf16_t* A = wsp<bf16_t>(p, kv ? WS_VC : WS_KC) + g * 64 + (size_t)(16 * sp) * 128;
    const bf16_t* Bt = wsp<bf16_t>(p, WS_CW1) + (size_t)kv * 256 * 2048 + 1024 * sp;
    pg8::Gemm gm{A, Bt, 1024, 256, 1024, 2048, 2048, 256}; OneUnit S{pm, 0};
    EpiCmpH se{cmph(p) + (size_t)((kv * 2 + g) * 2 + sp) * 1024 * 256};
    EpiAdapt<EpiCmpH> E{se};
    pg8::gemm_phase<EpiAdapt<EpiCmpH>, OneUnit, true, true>(lds, gm, S, E, wid0);
}
template <bool SPLIT> DI void cmp_out(const Params& p, int gw, int ngw, int lane, int bfix, LAS float* ldsw, int tid) {
    static_assert(SPLIT, "split-K partials only");
    const float* H = cmph(p);
    if (bfix >= 0) { const float* w2g = ((gw >> 7) ? p.in[I_CW2V] : p.in[I_CW2K]); f32x4 t[8];
#pragma unroll
        for (int it = 0; it < 8; ++it) t[it] = *(const f32x4*)(w2g + 4 * tid + 2048 * it);
#pragma unroll
        for (int it = 0; it < 8; ++it) *(LAS f32x4*)(ldsw + 4 * tid + 2048 * it) = t[it];
        __syncthreads(); }
    for (int i = gw; i < ((bfix < 0) ? 2048 : 256); i += ngw) {
        const int kg = (bfix < 0) ? (i >> 9) : (i >> 6), g = kg & 1, kv = kg >> 1;
        const int r0 = (bfix < 0) ? 2 * (i & 511) : (bfix * 128 + 2 * (i & 63));
        const int b = r0 >> 7, n0 = r0 & 127;
        bf16_t* dst = wsp<bf16_t>(p, kv ? WS_VCF : WS_KCF) + (size_t)r0 * 128 + g * 64 + lane;
        const float* w2 = (kv ? p.in[I_CW2V] : p.in[I_CW2K]) + lane;
        const float* h = H + ((size_t)((kv * 2 + g) * 2) * 1024 + r0) * 256; const float* cb = wsp<float>(p, WS_CB1) + kv * 256;
        float hv[2][4];
#pragma unroll
        for (int q = 0; q < 4; ++q) { const int j = 64 * q + lane; const float cbj = (cb[j] + cb[512 + j]) + (cb[1024 + j] + cb[1536 + j]);
            hv[0][q] = siluf((h[j] + h[(size_t)1024 * 256 + j]) + cbj); hv[1][q] = siluf((h[256 + j] + h[(size_t)1024 * 256 + 256 + j]) + cbj); }
        float acc[2] = {0.f, 0.f};
#pragma unroll
        for (int q = 0; q < 4; ++q)
#pragma unroll 16
            for (int jj = 0; jj < 64; ++jj) { const float w = (bfix >= 0) ? ldsw[(64 * q + jj) * 64 + lane] : w2[(64 * q + jj) * 64];
                acc[0] += __int_as_float(__builtin_amdgcn_readlane(__float_as_int(hv[0][q]), jj)) * w;
                acc[1] += __int_as_float(__builtin_amdgcn_readlane(__float_as_int(hv[1][q]), jj)) * w; }
#pragma unroll
        for (int e = 0; e < 2; ++e) {
            float y = acc[e];
            if (kv == 0) {
                const float rstd = rsqrtf(wave_sum(y * y) * (1.f / 64.f) + EPS);
                y = y * rstd * p.in[I_NKCG][lane];
                const int prow = b * SEQ + 16 * (n0 + e) + 31; const float oth = xorl<8>(y);
                if (lane < 16) { const int pr = (prow < MT) ? prow : MT - 1; const float c = ropeCN(p)[(size_t)pr * 8 + (lane & 7)], s = ropeSN(p)[(size_t)pr * 8 + (lane & 7)]; y = (lane < 8) ? y * c - oth * s : y * c + oth * s; }
            }
            if (n0 + e == 127) y = 0.f;
            dst[e * 128] = (bf16_t)f2bf(y);
        }
    }
}

DI unsigned select_blocks(const float (&imp)[32], int cur) {
    if (cur < 8) return (2u << cur) - 1u;
    unsigned mask = 1u | (1u << cur) | (1u << (cur - 1));
#pragma unroll 1
    for (int it = 0; it < 5; ++it) {
        float best = -1.0f; int bi = 1;
#pragma unroll
        for (int j = 1; j < 32; ++j) { const bool ok = (j <= cur - 2) && !((mask >> j) & 1u); if (ok && imp[j] > best) { best = imp[j]; bi = j; } }
        mask |= 1u << bi;
    }
    return mask;
}

namespace fa {
typedef short bf16x8 __attribute__((ext_vector_type(8)));
typedef short s16x4 __attribute__((ext_vector_type(4)));
typedef float f32x16 __attribute__((ext_vector_type(16)));
typedef LAS const char* lds_cptr;
typedef LAS char* lds_ptr;
constexpr int KBUF = 12288, VBUF = 8192;
constexpr int KCS = 1056;
constexpr int L_K = 0, L_V = 2 * KBUF, L_WS = 3 * 12 * KCS + 2 * 8192, L_OST = L_WS + 8 * 256, L_END = L_OST + 8 * 8192;
static_assert(L_V + 2 * VBUF <= L_WS && L_END <= 131072, "attention LDS map");
#define FA_SBAR() __builtin_amdgcn_sched_barrier(0)
DI int crow(int r, int hi) { return (r & 3) + 8 * (r >> 2) + 4 * hi; }
typedef float f32x2_t __attribute__((ext_vector_type(2))); typedef __bf16 bf16x2_t __attribute__((ext_vector_type(2)));
DI unsigned cvtpk(float lo, float hi) { f32x2_t v = {lo, hi}; bf16x2_t b = __builtin_convertvector(v, bf16x2_t); return __builtin_bit_cast(unsigned, b); }

template <int DK, int CS = 1024> DI void qkt(f32x16& p0, f32x16& p1, lds_cptr kb, const bf16x8* qr) {
    f32x16 z;
#pragma unroll
    for (int i = 0; i < 16; ++i) z[i] = 0.f;
#pragma unroll
    for (int d0 = 0; d0 < DK / 16; ++d0) {
        const bf16x8 b0 = *(const LAS bf16x8*)(kb + d0 * 2 * CS);
        const bf16x8 b1 = *(const LAS bf16x8*)(kb + d0 * 2 * CS + 512);
        if (d0 == 0) { p0 = __builtin_amdgcn_mfma_f32_32x32x16_bf16(b0, qr[0], z, 0, 0, 0); p1 = __builtin_amdgcn_mfma_f32_32x32x16_bf16(b1, qr[0], z, 0, 0, 0); }
        else { p0 = __builtin_amdgcn_mfma_f32_32x32x16_bf16(b0, qr[d0], p0, 0, 0, 0); p1 = __builtin_amdgcn_mfma_f32_32x32x16_bf16(b1, qr[d0], p1, 0, 0, 0); }
    }
}
typedef short v4i16_t __attribute__((ext_vector_type(4)));
DI s16x4 vtr(int addr) { return __builtin_bit_cast(s16x4, __builtin_amdgcn_ds_read_tr16_b64_v4i16((LAS v4i16_t*)(uintptr_t)(unsigned)addr)); }
DI bf16x8 vfrag(int addr) { const s16x4 lo = vtr(addr), hi = vtr(addr + 512); return (bf16x8){lo[0], lo[1], lo[2], lo[3], hi[0], hi[1], hi[2], hi[3]}; }
DI void pv(f32x16* o, int vb, bf16x8 pa0, bf16x8 pa1, bf16x8 pa2, bf16x8 pa3) {
#pragma unroll
    for (int d0 = 0; d0 < 2; ++d0) { s16x4 lo[4], hi[4];
#pragma unroll
        for (int ks = 0; ks < 4; ++ks) { lo[ks] = vtr(vb + d0 * 4096 + ks * 1024); hi[ks] = vtr(vb + d0 * 4096 + ks * 1024 + 512); }
#define FA_PK(k) (bf16x8){lo[k][0], lo[k][1], lo[k][2], lo[k][3], hi[k][0], hi[k][1], hi[k][2], hi[k][3]}
        o[d0] = __builtin_amdgcn_mfma_f32_32x32x16_bf16(pa0, FA_PK(0), o[d0], 0, 0, 0);
        o[d0] = __builtin_amdgcn_mfma_f32_32x32x16_bf16(pa1, FA_PK(1), o[d0], 0, 0, 0);
        o[d0] = __builtin_amdgcn_mfma_f32_32x32x16_bf16(pa2, FA_PK(2), o[d0], 0, 0, 0);
        o[d0] = __builtin_amdgcn_mfma_f32_32x32x16_bf16(pa3, FA_PK(3), o[d0], 0, 0, 0);
#undef FA_PK
    }
}
DI void pack_p(const f32x16& p0, const f32x16& p1, bf16x8& a0, bf16x8& a1, bf16x8& a2, bf16x8& a3) {
    u32x4 w0, w1, w2, w3;
    w0.x = cvtpk(p0[0], p0[1]); w0.y = cvtpk(p0[2], p0[3]); w0.z = cvtpk(p0[4], p0[5]); w0.w = cvtpk(p0[6], p0[7]);
    w1.x = cvtpk(p0[8], p0[9]); w1.y = cvtpk(p0[10], p0[11]); w1.z = cvtpk(p0[12], p0[13]); w1.w = cvtpk(p0[14], p0[15]);
    w2.x = cvtpk(p1[0], p1[1]); w2.y = cvtpk(p1[2], p1[3]); w2.z = cvtpk(p1[4], p1[5]); w2.w = cvtpk(p1[6], p1[7]);
    w3.x = cvtpk(p1[8], p1[9]); w3.y = cvtpk(p1[10], p1[11]); w3.z = cvtpk(p1[12], p1[13]); w3.w = cvtpk(p1[14], p1[15]);
    a0 = __builtin_bit_cast(bf16x8, w0); a1 = __builtin_bit_cast(bf16x8, w1); a2 = __builtin_bit_cast(bf16x8, w2); a3 = __builtin_bit_cast(bf16x8, w3);
}
DI void mask_range(f32x16& p0, f32x16& p1, int key0, int lo, int hi_, int hf) {
#pragma unroll
    for (int r = 0; r < 16; ++r) { const int k = key0 + crow(r, hf); if (k < lo || k > hi_) p0[r] = -INFINITY; if (k + 32 < lo || k + 32 > hi_) p1[r] = -INFINITY; }
}
DI float max3(float a, float b, float c) { return fmaxf(fmaxf(a, b), c); }
DI float rowmax32(const f32x16& p0, const f32x16& p1) {
    float a = max3(p0[0], p0[1], p0[2]), b = max3(p0[3], p0[4], p0[5]), c = max3(p0[6], p0[7], p0[8]), d = max3(p0[9], p0[10], p0[11]);
    a = max3(a, p0[12], p0[13]); b = max3(b, p0[14], p0[15]); c = max3(c, p1[0], p1[1]); d = max3(d, p1[2], p1[3]);
    a = max3(a, p1[4], p1[5]); b = max3(b, p1[6], p1[7]); c = max3(c, p1[8], p1[9]); d = max3(d, p1[10], p1[11]);
    a = max3(a, p1[12], p1[13]); b = max3(b, p1[14], p1[15]);
    return max32(fmaxf(fmaxf(a, b), fmaxf(c, d)));
}
struct State { float m, l; f32x16 o[2]; };
DI void st_init(State& s) { s.m = -INFINITY; s.l = 0.f;
#pragma unroll
    for (int i = 0; i < 16; ++i) { s.o[0][i] = 0.f; s.o[1][i] = 0.f; } }
DI void softmax_pv(State& st, f32x16& p0, f32x16& p1, int vb, LAS float* wsf, int r32, int hf) {
    const float rm = rowmax32(p0, p1);
    const float mn = fmaxf(st.m, rm), mu = (mn == -INFINITY) ? 0.f : mn;
    const float alpha = __builtin_amdgcn_exp2f(st.m - mu);
    st.m = mn;
    float ls0 = 0.f, ls1 = 0.f, ls2 = 0.f, ls3 = 0.f;
#pragma unroll
    for (int r = 0; r < 16; r += 2) { p0[r] = __builtin_amdgcn_exp2f(p0[r] - mu); p1[r] = __builtin_amdgcn_exp2f(p1[r] - mu); p0[r + 1] = __builtin_amdgcn_exp2f(p0[r + 1] - mu); p1[r + 1] = __builtin_amdgcn_exp2f(p1[r + 1] - mu);
        ls0 += p0[r]; ls1 += p1[r]; ls2 += p0[r + 1]; ls3 += p1[r + 1]; }
    st.l = st.l * alpha + ((ls0 + ls1) + (ls2 + ls3));
    if (__any(alpha != 1.0f)) {
        if (hf == 0) wsf[r32] = alpha;
        asm volatile("s_waitcnt lgkmcnt(0)" ::: "memory");
#pragma unroll
        for (int g = 0; g < 4; ++g) { const f32x4 a = *(const LAS f32x4*)(wsf + 8 * g + 4 * hf);
            st.o[0][4 * g] *= a.x; st.o[0][4 * g + 1] *= a.y; st.o[0][4 * g + 2] *= a.z; st.o[0][4 * g + 3] *= a.w;
            st.o[1][4 * g] *= a.x; st.o[1][4 * g + 1] *= a.y; st.o[1][4 * g + 2] *= a.z; st.o[1][4 * g + 3] *= a.w; }
    }
    bf16x8 a0, a1, a2, a3; pack_p(p0, p1, a0, a1, a2, a3);
    pv(st.o, vb, a0, a1, a2, a3);
}
DI void accum_scaled(f32x16* acc, const f32x16* o, float fac_row, LAS float* wsf, int r32, int hf) {
    if (hf == 0) wsf[32 + r32] = fac_row;
    asm volatile("s_waitcnt lgkmcnt(0)" ::: "memory");
#pragma unroll
    for (int g = 0; g < 4; ++g) { const f32x4 a = *(const LAS f32x4*)(wsf + 32 + 8 * g + 4 * hf);
        acc[0][4 * g] += o[0][4 * g] * a.x; acc[0][4 * g + 1] += o[0][4 * g + 1] * a.y; acc[0][4 * g + 2] += o[0][4 * g + 2] * a.z; acc[0][4 * g + 3] += o[0][4 * g + 3] * a.w;
        acc[1][4 * g] += o[1][4 * g] * a.x; acc[1][4 * g + 1] += o[1][4 * g + 1] * a.y; acc[1][4 * g + 2] += o[1][4 * g + 2] * a.z; acc[1][4 * g + 3] += o[1][4 * g + 3] * a.w; }
}
template <bool FIRST> DI void accum_lds(LAS float* accw, const f32x16* o, float fac_row, LAS float* wsf, int r32, int hf) {
    if (hf == 0) wsf[32 + r32] = fac_row;
    asm volatile("s_waitcnt lgkmcnt(0)" ::: "memory");
#pragma unroll
    for (int r = 0; r < 16; ++r) { const int orow = crow(r, hf); const float a = wsf[32 + orow];
        LAS float* d0 = accw + orow * 64 + r32; LAS float* d1 = d0 + 32;
        if (FIRST) { *d0 = o[0][r] * a; *d1 = o[1][r] * a; } else { *d0 += o[0][r] * a; *d1 += o[1][r] * a; } }
}
DI void stage_rows(const f32x16* acc, LAS bf16_t* stg, int r32, int hf) {
#pragma unroll
    for (int r = 0; r < 16; ++r) { const int orow = crow(r, hf);
        stg[orow * 64 + r32] = (bf16_t)f2bf(acc[0][r]); stg[orow * 64 + 32 + r32] = (bf16_t)f2bf(acc[1][r]); }
    asm volatile("s_waitcnt lgkmcnt(0)" ::: "memory");
}

struct TileSrc { const unsigned char* k; const unsigned char* v; unsigned ko, vo; long kstep, vstep; int klds; bool k2on; };
#ifndef FA_THRL
#define FA_THRL 8.0f
#endif
template <int DK, class MaskF>
DI void pipe_attn(LAS unsigned char* lds, const TileSrc src, int T, const bf16x8 (&qr)[DK / 16], const MaskF& maskf, f32x16 (&o)[2], float& l_out,
                  int wv, int lane, int r32, int hf, LAS float* wsf) {
    constexpr int KB = (DK / 8) * KCS;
    constexpr int PL_V = 3 * KB;
    const LAS unsigned char* kfrag0 = lds + L_K + hf * KCS + r32 * 16;
    const int vfrag0 = (int)(uintptr_t)(lds + L_K + PL_V) + ((lane >> 4) & 1) * 32 + (lane & 3) * 8 + (4 * hf + ((lane & 15) >> 2)) * 64;
    LAS unsigned char* kst0 = lds + L_K + src.klds; LAS unsigned char* kst1 = kst0 + 32 * 16; LAS unsigned char* vst0 = lds + L_K + PL_V + wv * 1024 + lane * 16;
    u32x4 kreg, kreg2, vreg;
    const bool k2on = (DK == 96) && src.k2on, kon = (DK == 64) || src.k2on;
#define PL_KADDR(i) (src.k + (long)(i) * src.kstep)
#define PL_KLOAD(i) do { if (kon) kreg = *(const u32x4*)(PL_KADDR(i) + (size_t)src.ko); if (k2on) kreg2 = *(const u32x4*)(PL_KADDR(i) + 32 * 768 * 2 + (size_t)src.ko); } while (0)
#define PL_KSTORE(buf) do { if (kon) *(LAS u32x4*)(kst0 + (buf) * KB) = kreg; if (k2on) *(LAS u32x4*)(kst1 + (buf) * KB) = kreg2; } while (0)
#define PL_VLOAD(i) (vreg = *(const u32x4*)(src.v + (long)(i) * src.vstep + (size_t)src.vo))
    __syncthreads();
    { u32x4 ka_, kb_, kc_, ka2_, kb2_, kc2_; const int t1 = (T > 1) ? 1 : 0, t2 = (T > 2) ? 2 : 0;
      if (kon) { ka_ = *(const u32x4*)(PL_KADDR(0) + (size_t)src.ko); kb_ = *(const u32x4*)(PL_KADDR(t1) + (size_t)src.ko); kc_ = *(const u32x4*)(PL_KADDR(t2) + (size_t)src.ko); } PL_VLOAD(0);
      if (k2on) { ka2_ = *(const u32x4*)(PL_KADDR(0) + 32 * 768 * 2 + (size_t)src.ko); kb2_ = *(const u32x4*)(PL_KADDR(t1) + 32 * 768 * 2 + (size_t)src.ko); kc2_ = *(const u32x4*)(PL_KADDR(t2) + 32 * 768 * 2 + (size_t)src.ko); }
      if (kon) { *(LAS u32x4*)(kst0) = ka_; *(LAS u32x4*)(kst0 + KB) = kb_; *(LAS u32x4*)(kst0 + 2 * KB) = kc_; } *(LAS u32x4*)(vst0) = vreg;
      if (k2on) { *(LAS u32x4*)(kst1) = ka2_; *(LAS u32x4*)(kst1 + KB) = kb2_; *(LAS u32x4*)(kst1 + 2 * KB) = kc2_; } }
    if (T > 3) PL_KLOAD(3);
    if (T > 1) PL_VLOAD(1);
    __syncthreads();
    float mhat, l_reg = 0.f; f32x16 negm; bool resc = false;
    f32x16 pA0, pA1, pB0, pB1;
#pragma unroll
    for (int i = 0; i < 16; ++i) { o[0][i] = 0.f; o[1][i] = 0.f; }
    qkt<DK, KCS>(pA0, pA1, (lds_cptr)kfrag0, qr); maskf(pA0, pA1, 0);
    { const float rm = rowmax32(pA0, pA1); mhat = rm;
#pragma unroll
      for (int r = 0; r < 16; ++r) { pA0[r] = __builtin_amdgcn_exp2f(pA0[r] - rm); pA1[r] = __builtin_amdgcn_exp2f(pA1[r] - rm); negm[r] = -rm; }
      asm volatile("" : "+v"(negm)); }
    __syncthreads();
    u32x4 pw0, pw1, pw2, pw3;
    int kb_cur = 1, kb_st = 0, vb_prev = 0;
#define PL_PIN(x) asm volatile("" : "+v"(x))
#define PL_SB() __builtin_amdgcn_sched_barrier(0)
#define PL_KF(j) (*(const LAS bf16x8*)(kp_ + ((j) >> 1) * 2 * KCS + ((j) & 1) * 512))
#define PL_VF(i) vfrag(vp_ + ((i) >> 2) * 4096 + ((i) & 3) * 1024)
#define PL_PAF(k) __builtin_bit_cast(bf16x8, pw##k)
#define PL_WORK(A0, A1, A2, A3, W0, W1, PW) do { sacc += A0; sacc += A1; sacc += A2; sacc += A3; PL_PIN(sacc); W0; W1; PL_PIN(PW); } while (0)
#define PL_GAPB(MF, X, B) do { MF; X[B] = __builtin_amdgcn_exp2f(X[B]); X[B + 1] = __builtin_amdgcn_exp2f(X[B + 1]); X[B + 2] = __builtin_amdgcn_exp2f(X[B + 2]); X[B + 3] = __builtin_amdgcn_exp2f(X[B + 3]); PL_PIN(X); PL_SB(); } while (0)
#define PL_MF(a, b, c) ({ __builtin_amdgcn_s_setprio(1); __builtin_amdgcn_sched_barrier(0); f32x16 r__ = __builtin_amdgcn_mfma_f32_32x32x16_bf16(a, b, c, 0, 0, 0); __builtin_amdgcn_sched_barrier(0); __builtin_amdgcn_s_setprio(0); r__; })
#define PL_STEP(C0, C1, P0, P1, t) do { const int t_ = (t); \
        if (t_ + 2 < T) PL_KSTORE(kb_st); \
        *(LAS u32x4*)(vst0 + (vb_prev ^ 1) * 8192) = vreg; \
        if (t_ + 3 < T) PL_KLOAD(t_ + 3); if (t_ + 1 < T) PL_VLOAD(t_ + 1); \
        PL_SB(); const LAS unsigned char* kp_ = kfrag0 + kb_cur * KB; const int vp_ = vfrag0 + vb_prev * 8192; \
        bf16x8 k0 = PL_KF(0), k1 = PL_KF(1), k2 = PL_KF(2); PL_SB(); float sacc = (P0[0] + P0[1]); \
        C0 = PL_MF(k0, qr[0], negm); k0 = PL_KF(3); PL_WORK(P0[2], P0[3], P0[4], P0[5],     pw0[0] = cvtpk(P0[0], P0[1]),   pw0[1] = cvtpk(P0[2], P0[3]),   pw0); PL_SB(); \
        C1 = PL_MF(k1, qr[0], negm); k1 = PL_KF(4); PL_WORK(P0[6], P0[7], P0[8], P0[9],     pw0[2] = cvtpk(P0[4], P0[5]),   pw0[3] = cvtpk(P0[6], P0[7]),   pw0); PL_SB(); \
        C0 = PL_MF(k2, qr[1], C0);   k2 = PL_KF(5); PL_WORK(P0[10], P0[11], P0[12], P0[13], pw1[0] = cvtpk(P0[8], P0[9]),   pw1[1] = cvtpk(P0[10], P0[11]), pw1); PL_SB(); \
        C1 = PL_MF(k0, qr[1], C1);   k0 = PL_KF(6); PL_WORK(P0[14], P0[15], P1[0], P1[1],   pw1[2] = cvtpk(P0[12], P0[13]), pw1[3] = cvtpk(P0[14], P0[15]), pw1); PL_SB(); \
        C0 = PL_MF(k1, qr[2], C0);   k1 = PL_KF(7); PL_WORK(P1[2], P1[3], P1[4], P1[5],     pw2[0] = cvtpk(P1[0], P1[1]),   pw2[1] = cvtpk(P1[2], P1[3]),   pw2); PL_SB(); \
        C1 = PL_MF(k2, qr[2], C1);   if (DK == 96) k2 = PL_KF(8); PL_WORK(P1[6], P1[7], P1[8], P1[9],     pw2[2] = cvtpk(P1[4], P1[5]),   pw2[3] = cvtpk(P1[6], P1[7]),   pw2); PL_SB(); \
        C0 = PL_MF(k0, qr[3], C0);   if (DK == 96) k0 = PL_KF(9); PL_WORK(P1[10], P1[11], P1[12], P1[13], pw3[0] = cvtpk(P1[8], P1[9]),   pw3[1] = cvtpk(P1[10], P1[11]), pw3); PL_SB(); \
        C1 = PL_MF(k1, qr[3], C1);   if (DK == 96) k1 = PL_KF(10); PL_WORK(P1[14], P1[15], 0.f, 0.f,       pw3[2] = cvtpk(P1[12], P1[13]), pw3[3] = cvtpk(P1[14], P1[15]), pw3); PL_SB(); \
        if (DK == 96) { C0 = PL_MF(k2, qr[DK / 16 - 2], C0); k2 = PL_KF(11); PL_SB(); C1 = PL_MF(k0, qr[DK / 16 - 2], C1); PL_SB(); C0 = PL_MF(k1, qr[DK / 16 - 1], C0); PL_SB(); C1 = PL_MF(k2, qr[DK / 16 - 1], C1); PL_SB(); } \
        l_reg += sacc; \
        bf16x8 v0 = PL_VF(0), v1 = PL_VF(4), v2 = PL_VF(1); \
        maskf(C0, C1, t_); \
        { const float rm = rowmax32(C0, C1); resc = false; \
          if (__builtin_expect(__any(rm > FA_THRL), 0)) { const float dl = fmaxf(rm, 0.f); mhat += dl; \
              _Pragma("unroll") for (int r = 0; r < 16; ++r) { C0[r] -= dl; C1[r] -= dl; } \
              _Pragma("unroll") for (int r = 0; r < 16; ++r) negm[r] = -mhat; \
              asm volatile("" : "+v"(negm)); \
              const float f_ = __builtin_amdgcn_exp2f(-dl); l_reg *= f_; if (hf == 0) wsf[r32] = f_; resc = true; } } \
        PL_SB(); \
        PL_GAPB(o[0] = PL_MF(PL_PAF(0), v0, o[0]); v0 = PL_VF(5), C0, 0); \
        PL_GAPB(o[1] = PL_MF(PL_PAF(0), v1, o[1]); v1 = PL_VF(2), C0, 4); \
        PL_GAPB(o[0] = PL_MF(PL_PAF(1), v2, o[0]); v2 = PL_VF(6), C0, 8); \
        PL_GAPB(o[1] = PL_MF(PL_PAF(1), v0, o[1]); v0 = PL_VF(3), C0, 12); \
        PL_GAPB(o[0] = PL_MF(PL_PAF(2), v1, o[0]); v1 = PL_VF(7), C1, 0); \
        PL_GAPB(o[1] = PL_MF(PL_PAF(2), v2, o[1]), C1, 4); \
        PL_GAPB(o[0] = PL_MF(PL_PAF(3), v0, o[0]), C1, 8); \
        PL_GAPB(o[1] = PL_MF(PL_PAF(3), v1, o[1]), C1, 12); \
        __syncthreads(); \
        if (resc) { \
            _Pragma("unroll") for (int g_ = 0; g_ < 4; ++g_) { const f32x4 a_ = *(const LAS f32x4*)(wsf + 8 * g_ + 4 * hf); \
                o[0][4 * g_] *= a_.x; o[0][4 * g_ + 1] *= a_.y; o[0][4 * g_ + 2] *= a_.z; o[0][4 * g_ + 3] *= a_.w; o[1][4 * g_] *= a_.x; o[1][4 * g_ + 1] *= a_.y; o[1][4 * g_ + 2] *= a_.z; o[1][4 * g_ + 3] *= a_.w; } } \
        kb_cur = (kb_cur == 2) ? 0 : kb_cur + 1; kb_st = (kb_st == 2) ? 0 : kb_st + 1; vb_prev ^= 1; \
    } while (0)
    int t = 1;
    for (; t + 1 < T; t += 2) { PL_STEP(pB0, pB1, pA0, pA1, t); PL_STEP(pA0, pA1, pB0, pB1, t + 1); }
    const bool tail = t < T;
    if (tail) PL_STEP(pB0, pB1, pA0, pA1, t);
#define PL_DRAIN(P0, P1) do { float sacc = 0.f; _Pragma("unroll") for (int r = 0; r < 16; ++r) sacc += P0[r] + P1[r]; l_reg += sacc; \
        bf16x8 a0_, a1_, a2_, a3_; pack_p(P0, P1, a0_, a1_, a2_, a3_); pv(o, vfrag0 + vb_prev * 8192, a0_, a1_, a2_, a3_); } while (0)
    if (tail) PL_DRAIN(pB0, pB1); else PL_DRAIN(pA0, pA1);
    l_out = l_reg;
    __syncthreads();
#undef PL_KLOAD
#undef PL_KADDR
#undef PL_KSTORE
#undef PL_VLOAD
#undef PL_PIN
#undef PL_SB
#undef PL_KF
#undef PL_VF
#undef PL_PAF
#undef PL_WORK
#undef PL_GAPB
#undef PL_MF
#undef PL_STEP
#undef PL_DRAIN
}

DI void mla_unit(const Params& p, LAS unsigned char* lds, int b, int h, int qb, int wid0) {
    const int tid = opaque_tid(wid0), lane = tid & 63, r32 = lane & 31, hf = lane >> 5; const int wv = __builtin_amdgcn_readfirstlane(tid >> 6);
    const bf16_t* KN = wsp<bf16_t>(p, WS_KN); const bf16_t* VM = wsp<bf16_t>(p, WS_VM); bf16_t* OC = wsp<bf16_t>(p, WS_R1);
    const int rowbase = b * SEQ, q0 = qb * 256, tq = q0 + wv * 32 + r32, row = rowbase + tq;
    LAS float* wsf = (LAS float*)(lds + L_WS) + wv * 64;
    bf16x8 qr[6];
    {
        const bf16_t* src = qraw(p) + (size_t)row * 768 + h * 96 + 8 * hf; float q[6][8]; float ss = 0.f;
#pragma unroll
        for (int d0 = 0; d0 < 6; ++d0) { unpack8(*(const u32x4*)(src + 16 * d0), q[d0]);
#pragma unroll
            for (int e = 0; e < 8; ++e) ss += q[d0][e] * q[d0][e]; }
        ss = sum32(ss);
        const float rstd = rsqrtf(ss * (1.f / 96.f) + EPS); const float* qg = p.in[I_MQG] + 8 * hf; const float* kg = p.in[I_MKG] + 8 * hf;
#pragma unroll
        for (int d0 = 0; d0 < 6; ++d0)
#pragma unroll
            for (int e = 0; e < 8; ++e) q[d0][e] *= rstd * qg[16 * d0 + e];
        const float* cs = ropeCM(p) + (size_t)row * 16 + 8 * hf; const float* sn = ropeSM(p) + (size_t)row * 16 + 8 * hf;
#pragma unroll
        for (int e = 0; e < 8; ++e) { const float x1 = q[4][e], x2 = q[5][e]; q[4][e] = x1 * cs[e] - x2 * sn[e]; q[5][e] = x2 * cs[e] + x1 * sn[e]; }
#pragma unroll
        for (int d0 = 0; d0 < 6; ++d0) { float f[8];
#pragma unroll
            for (int e = 0; e < 8; ++e) f[e] = q[d0][e] * ((d0 < 4) ? kg[16 * d0 + e] * C2M : C2M);
            qr[d0] = __builtin_bit_cast(bf16x8, pack8(f)); }
    }
    const int NT = 4 * (qb + 1);
    TileSrc src; { const int k1 = tid / 12, c1 = tid % 12;
        src.k = (const unsigned char*)(KN + (size_t)rowbase * 768 + h * 96); src.ko = (unsigned)(k1 * 768 + c1 * 8) * 2u; src.klds = c1 * KCS + k1 * 16; src.k2on = wv < 6; }
    src.kstep = 64 * 768 * 2;
    src.v = (const unsigned char*)(VM + (size_t)rowbase * 512 + h * 64); src.vo = (unsigned)((16 * (wv & 3) + (lane >> 2)) * 512 + (wv >> 2) * 32 + (lane & 3) * 8) * 2u; src.vstep = 64 * 512 * 2;
    const int qlo = q0 + wv * 32;
    auto mk = [&](f32x16& p0, f32x16& p1, int i) { if (i * 64 + 63 > qlo) mask_range(p0, p1, i * 64, 0, tq, hf); };
    f32x16 ob[2]; float lb;
    pipe_attn<96>(lds, src, NT, qr, mk, ob, lb, wv, lane, r32, hf, wsf);
    const float lt = sum32(lb);
    f32x16 acc[2];
#pragma unroll
    for (int i = 0; i < 16; ++i) { acc[0][i] = 0.f; acc[1][i] = 0.f; }
    accum_scaled(acc, ob, 1.0f / lt, wsf, r32, hf);
    LAS bf16_t* stg = (LAS bf16_t*)(lds + L_OST) + wv * 4096;
    stage_rows(acc, stg, r32, hf);
#pragma unroll
    for (int i = 0; i < 4; ++i) { const int rr = i * 8 + (lane >> 3), ch = lane & 7; const u32x4 v = *(const LAS u32x4*)(stg + rr * 64 + ch * 8);
        st16(OC + (size_t)(rowbase + q0 + wv * 32 + rr) * 1024 + h * 64 + ch * 8, v); }
}

DI void nsa_unit(const Params& p, LAS unsigned char* lds, int b, int g, int c, int wid0) {
    const int tid = opaque_tid(wid0), lane = tid & 63, r32 = lane & 31, hf = lane >> 5; const int wv = __builtin_amdgcn_readfirstlane(tid >> 6);
    const bf16_t* QN = wsp<bf16_t>(p, WS_QN); const bf16_t* KCF = wsp<bf16_t>(p, WS_KCF); const bf16_t* VCF = wsp<bf16_t>(p, WS_VCF);
    const bf16_t* KS = wsp<bf16_t>(p, WS_KS); const bf16_t* VS = wsp<bf16_t>(p, WS_VS); const bf16_t* KW = wsp<bf16_t>(p, WS_KW); const bf16_t* VW = wsp<bf16_t>(p, WS_VW);
    const bf16_t* GN = wsp<bf16_t>(p, WS_GN); bf16_t* OC = wsp<bf16_t>(p, WS_R1);
    const int rowbase = b * SEQ, tt = 8 * wv + (r32 >> 2), hd = g * 4 + (r32 & 3), tq = 64 * c + tt, row = rowbase + tq;
    LAS float* wsf = (LAS float*)(lds + L_WS) + wv * 64;
    bf16x8 qr[4];
#pragma unroll
    for (int d0 = 0; d0 < 4; ++d0) qr[d0] = *(const bf16x8*)(QN + (size_t)row * 512 + hd * 64 + 16 * d0 + 8 * hf);
    LAS float* accw = (LAS float*)(lds + L_OST) + wv * 2048;
    const int vboff = ((lane >> 4) & 1) * 32 + (lane & 3) * 8 + (4 * hf + ((lane & 15) >> 2)) * 64;
    u32x4 ka, vv;
#define NSA_LOAD(KB, VB, krow0) do { ka = *(const u32x4*)((KB) + (size_t)((krow0) + lane) * 128 + g * 64 + wv * 8); \
        vv = *(const u32x4*)((VB) + (size_t)((krow0) + 16 * (wv & 3) + (lane >> 2)) * 128 + g * 64 + (wv >> 2) * 32 + (lane & 3) * 8); } while (0)
#define NSA_STORE(koff, voff) do { *(LAS u32x4*)(lds + (koff) + wv * 1024 + lane * 16) = ka; *(LAS u32x4*)(lds + (voff) + wv * 1024 + lane * 16) = vv; } while (0)
    unsigned selmask;
    {
        const int ntile = (4 * c + 3 > 64) ? 2 : 1;
        const int nmax = (tq >= 31) ? ((tq - 31) >> 4) : -1;
        __syncthreads();
        { NSA_LOAD(KCF, VCF, b * 128); const u32x4 ka1_ = ka, vv1_ = vv; if (ntile == 2) NSA_LOAD(KCF, VCF, b * 128 + 64);
          *(LAS u32x4*)(lds + L_K + wv * 1024 + lane * 16) = ka1_; *(LAS u32x4*)(lds + L_V + wv * 1024 + lane * 16) = vv1_; if (ntile == 2) NSA_STORE(L_K + 8192, L_V + 8192); }
        __syncthreads();
        f32x16 pa0, pa1, pb0, pb1;
        qkt<64>(pa0, pa1, (lds_cptr)(lds + L_K) + hf * 1024 + r32 * 16, qr); mask_range(pa0, pa1, 0, 0, nmax, hf);
        float m = rowmax32(pa0, pa1);
        if (ntile == 2) { qkt<64>(pb0, pb1, (lds_cptr)(lds + L_K + 8192) + hf * 1024 + r32 * 16, qr); mask_range(pb0, pb1, 64, 0, nmax, hf); m = fmaxf(m, rowmax32(pb0, pb1)); }
        else {
#pragma unroll
            for (int i = 0; i < 16; ++i) { pb0[i] = -INFINITY; pb1[i] = -INFINITY; } }
        const float mu = (m == -INFINITY) ? 0.f : m;
        float ls = 0.f;
#pragma unroll
        for (int r = 0; r < 16; ++r) { pa0[r] = __builtin_amdgcn_exp2f(pa0[r] - mu); pa1[r] = __builtin_amdgcn_exp2f(pa1[r] - mu); pb0[r] = __builtin_amdgcn_exp2f(pb0[r] - mu); pb1[r] = __builtin_amdgcn_exp2f(pb1[r] - mu);
            ls += (pa0[r] + pa1[r]) + (pb0[r] + pb1[r]); }
        ls = sum32(ls);
        const float rl = (ls > 0.f) ? 1.0f / ls : 0.f;
#pragma unroll
        for (int r = 0; r < 16; ++r) { pa0[r] *= rl; pa1[r] *= rl; pb0[r] *= rl; pb1[r] *= rl; }
        float own[16], ee[16];
#pragma unroll
        for (int q = 0; q < 4; ++q) {
            own[q] = (pa0[4 * q] + pa0[4 * q + 1]) + (pa0[4 * q + 2] + pa0[4 * q + 3]); ee[q] = pa0[4 * q + 3];
            own[4 + q] = (pa1[4 * q] + pa1[4 * q + 1]) + (pa1[4 * q + 2] + pa1[4 * q + 3]); ee[4 + q] = pa1[4 * q + 3];
            own[8 + q] = (pb0[4 * q] + pb0[4 * q + 1]) + (pb0[4 * q + 2] + pb0[4 * q + 3]); ee[8 + q] = pb0[4 * q + 3];
            own[12 + q] = (pb1[4 * q] + pb1[4 * q + 1]) + (pb1[4 * q + 2] + pb1[4 * q + 3]); ee[12 + q] = pb1[4 * q + 3]; }
        float eo[16];
#pragma unroll
        for (int k = 0; k < 16; ++k) eo[k] = xor32(ee[k], hf);
#pragma unroll
        for (int k = 0; k < 16; ++k) { const float add = hf ? eo[k] : ((k > 0) ? eo[k - 1] : 0.f); own[k] += add; }
#pragma unroll
        for (int k = 0; k < 16; ++k) { own[k] += xorl<1>(own[k]); own[k] += xorl<2>(own[k]); }
        float imp[32];
#pragma unroll
        for (int k = 0; k < 16; ++k) { const float oth = xor32(own[k], hf); imp[2 * k] = hf ? oth : own[k]; imp[2 * k + 1] = hf ? own[k] : oth; }
        selmask = select_blocks(imp, c);
        State sc; st_init(sc);
        { bf16x8 a0, a1, a2, a3; pack_p(pa0, pa1, a0, a1, a2, a3); pv(sc.o, (int)(uintptr_t)(lds + L_V) + vboff, a0, a1, a2, a3); }
        if (ntile == 2) { bf16x8 a0, a1, a2, a3; pack_p(pb0, pb1, a0, a1, a2, a3); pv(sc.o, (int)(uintptr_t)(lds + L_V + 8192) + vboff, a0, a1, a2, a3); }
        accum_lds<true>(accw, sc.o, bf2f(GN[(size_t)row * 32 + hd * 3]), wsf, r32, hf);
    }
#pragma unroll 1
    for (int br = 1; br < 3; ++br) {
        const bf16_t* KB = (br == 1) ? KS : KW; const bf16_t* VB = (br == 1) ? VS : VW;
        const int NT = (br == 1) ? (c + 1) : ((c + 1 < 5) ? c + 1 : 5);
        TileSrc src; src.k = (const unsigned char*)(KB + (size_t)(rowbase + c * 64) * 128 + g * 64); src.ko = (unsigned)((wv * 8 + (lane >> 3)) * 128 + (lane & 7) * 8) * 2u;
        src.klds = (lane & 7) * KCS + (wv * 8 + (lane >> 3)) * 16; src.k2on = false;
        src.v = (const unsigned char*)(VB + (size_t)(rowbase + c * 64) * 128 + g * 64); src.vo = (unsigned)((16 * (wv & 3) + (lane >> 2)) * 128 + (wv >> 2) * 32 + (lane & 3) * 8) * 2u;
        src.kstep = -64 * 128 * 2; src.vstep = -64 * 128 * 2;
        f32x16 ob[2]; float lb;
        if (br == 1) {
            auto mk = [&](f32x16& p0, f32x16& p1, int i) { const int j = c - i;
                if (i == 0) mask_range(p0, p1, j * 64, 0, tq, hf);
                if (!((selmask >> j) & 1u)) {
#pragma unroll
                    for (int r = 0; r < 16; ++r) { p0[r] = -INFINITY; p1[r] = -INFINITY; } } };
            pipe_attn<64>(lds, src, NT, qr, mk, ob, lb, wv, lane, r32, hf, wsf);
        } else {
            const int lo = tq - 255;
            auto mk = [&](f32x16& p0, f32x16& p1, int i) { if (i == 0 || i == 4) mask_range(p0, p1, (c - i) * 64, lo, tq, hf); };
            pipe_attn<64>(lds, src, NT, qr, mk, ob, lb, wv, lane, r32, hf, wsf);
        }
        const float lt = sum32(lb);
        accum_lds<false>(accw, ob, bf2f(GN[(size_t)row * 32 + hd * 3 + br]) / lt, wsf, r32, hf);
    }
#undef NSA_LOAD
#undef NSA_STORE
    asm volatile("s_waitcnt lgkmcnt(0)" ::: "memory");
#pragma unroll
    for (int i = 0; i < 4; ++i) { const int rr = i * 8 + (lane >> 3), ch = lane & 7; const f32x4 a = *(const LAS f32x4*)(accw + rr * 64 + ch * 8), b2 = *(const LAS f32x4*)(accw + rr * 64 + ch * 8 + 4);
        u32x4 v; v.x = pk2(a.x, a.y); v.y = pk2(a.z, a.w); v.z = pk2(b2.x, b2.y); v.w = pk2(b2.z, b2.w);
        st16(OC + (size_t)(rowbase + 64 * c + 8 * wv + (rr >> 2)) * 1024 + 512 + (g * 4 + (rr & 3)) * 64 + ch * 8, v); }
}
#undef FA_SBAR
}

DI void stage_attn_fast(const Params& p, LAS unsigned char* lds, int bid, int nb, bool do_mla, bool do_nsa, int wid0) {
    const int v0 = (nb % 8 == 0) ? (bid % 8) * (nb / 8) + bid / 8 : bid;
    if (do_mla) for (int u = v0; u < 256; u += nb) { const int bh = u >> 2, s = u & 3; fa::mla_unit(p, lds, bh >> 3, bh & 7, 7 - s, wid0); fa::mla_unit(p, lds, bh >> 3, bh & 7, s, wid0); }
    if (do_nsa) for (int u = v0; u < 256; u += nb) { const int bg = u >> 4, s = u & 15; fa::nsa_unit(p, lds, bg >> 1, bg & 1, 31 - s, wid0); fa::nsa_unit(p, lds, bg >> 1, bg & 1, s, wid0); }
    __syncthreads();
}
#define XB_TMO      128
#define XB_XCNT(j)  (256  + 64 * (j))
#define XB_XSUB(j)  (1280 + 64 * (j))
#define XB_XGEN(j)  (2304 + 64 * (j))
#define XB_TOP      3328
#define XB_TOPGEN   3392
#define XCD_BAR_WORDS 3456
#define XB_SPIN_CAP (1u << 18)

__device__ __forceinline__ unsigned xb_ld(unsigned* p)              { return __hip_atomic_load(p, __ATOMIC_RELAXED, __HIP_MEMORY_SCOPE_AGENT); }
__device__ __forceinline__ unsigned xb_add(unsigned* p, unsigned v) { return __hip_atomic_fetch_add(p, v, __ATOMIC_RELAXED, __HIP_MEMORY_SCOPE_AGENT); }
__device__ __forceinline__ unsigned xb_xcc_id() { return (unsigned)__builtin_amdgcn_s_getreg((3 << 11) | 20) & 0xFu; }
#define XB_SPIN(cond, bar) do { unsigned _sp = 0; while (cond) { __builtin_amdgcn_s_sleep(1); \
    if ((++_sp & 255u) == 0u) { if (xb_ld(&(bar)[XB_TMO])) break; if (_sp > XB_SPIN_CAP) { atomicAdd(&(bar)[XB_TMO], 1u); break; } } } } while (0)

struct XcdBarrier {
    unsigned* bar; unsigned x;
    volatile LAS unsigned* st;
};

__device__ __forceinline__ XcdBarrier xcd_barrier_post(unsigned* bar, volatile LAS unsigned* st, bool t0) {
    XcdBarrier b; b.bar = bar; b.x = xb_xcc_id(); b.st = st;
    if (t0) (void)xb_add(&bar[XB_XCNT(b.x)], 1u);
    return b;
}
__device__ __forceinline__ void xcd_barrier_complete(unsigned* bar, unsigned x, unsigned& nloc, unsigned& nx) {
    const unsigned G = gridDim.x * gridDim.y * gridDim.z;
    unsigned sum, cnt, mine, sp = 0u;
    for (;;) {
        sum = 0u; cnt = 0u; mine = 0u;
#pragma unroll
        for (unsigned j = 0; j < 16; ++j) { const unsigned c = xb_ld(&bar[XB_XCNT(j)]); sum += c; cnt += (c > 0u) ? 1u : 0u; mine = (j == x) ? c : mine; }
        if (sum == G) break;
        __builtin_amdgcn_s_sleep(1);
        if ((++sp & 255u) == 0u) { if (xb_ld(&bar[XB_TMO])) break; if (sp > XB_SPIN_CAP) { atomicAdd(&bar[XB_TMO], 1u); break; } }
    }
    nloc = mine > 0u ? mine : 1u; nx = cnt > 0u ? cnt : 1u;
}

__device__ __forceinline__ void xcd_barrier(const XcdBarrier& b, bool t0) {
    asm volatile("s_waitcnt vmcnt(0)" ::: "memory");
    __syncthreads();
    if (t0) {
        unsigned* bar = b.bar;
        __builtin_amdgcn_s_waitcnt(0);
        unsigned nloc = b.st[0], nx = b.st[1];
        if (nloc == 0u) { xcd_barrier_complete(bar, b.x, nloc, nx); b.st[0] = nloc; b.st[1] = nx; }
        const unsigned old = xb_add(&bar[XB_XSUB(b.x)], 1u);
        const unsigned gen = old / nloc;
        if (old + 1u == (gen + 1u) * nloc) {
            __builtin_amdgcn_fence(__ATOMIC_RELEASE, "agent");
            asm volatile("s_waitcnt vmcnt(0)" ::: "memory");
            const unsigned og = xb_add(&bar[XB_TOP], 1u);
            const unsigned tg = og / nx;
            if (og + 1u == (tg + 1u) * nx) xb_add(&bar[XB_TOPGEN], 1u);
            else XB_SPIN(xb_ld(&bar[XB_TOPGEN]) == tg, bar);
            __builtin_amdgcn_fence(__ATOMIC_ACQUIRE, "agent");
            xb_add(&bar[XB_XGEN(b.x)], 1u);
            asm volatile("s_waitcnt vmcnt(0)" ::: "memory");
        } else {
            XB_SPIN(xb_ld(&bar[XB_XGEN(b.x)]) == gen, bar);
            __builtin_amdgcn_fence(__ATOMIC_ACQUIRE, "agent");
            asm volatile("s_waitcnt vmcnt(0)" ::: "memory");
        }
    }
    __syncthreads();
}

__device__ __forceinline__ void group_barrier(unsigned* cnt, unsigned target, unsigned* rel, unsigned* cnt2, unsigned target2, bool one_xcd, bool t0) {
    asm volatile("s_waitcnt vmcnt(0)" ::: "memory");
    __syncthreads();
    if (t0) {
        __builtin_amdgcn_s_waitcnt(0);
        if (!one_xcd) { __builtin_amdgcn_fence(__ATOMIC_RELEASE, "agent"); asm volatile("s_waitcnt vmcnt(0)" ::: "memory"); }
        const unsigned early2 = target2 ? xb_ld(cnt2) : 0u;
        const unsigned old = xb_add(cnt, 1u);
        if (rel && old + 1u == target) {
            __builtin_amdgcn_fence(__ATOMIC_RELEASE, "agent");
            asm volatile("s_waitcnt vmcnt(0)" ::: "memory");
            (void)xb_add(rel, 1u);
        }
        unsigned sp = 0u;
        while (xb_ld(cnt) < target) { __builtin_amdgcn_s_sleep(1); if (++sp > (1u << 22)) break; }
        if (target2 && early2 < target2) while (xb_ld(cnt2) < target2) { __builtin_amdgcn_s_sleep(1); if (++sp > (1u << 22)) break; }
        __builtin_amdgcn_fence(__ATOMIC_ACQUIRE, "agent");
        asm volatile("s_waitcnt vmcnt(0)" ::: "memory");
    }
    __syncthreads();
}
__device__ __forceinline__ void publish_count(unsigned* cnt, bool t0) {
    asm volatile("s_waitcnt vmcnt(0)" ::: "memory");
    __syncthreads();
    if (t0) { __builtin_amdgcn_s_waitcnt(0); __builtin_amdgcn_fence(__ATOMIC_RELEASE, "agent"); asm volatile("s_waitcnt vmcnt(0)" ::: "memory"); (void)xb_add(cnt, 1u); }
}
constexpr int LDS_BYTES = 147456;

typedef const Params __attribute__((address_space(4)))* KParamsPtr;
#if defined(__HIP_DEVICE_COMPILE__)
DI KParamsPtr kparams() { KParamsPtr k = (KParamsPtr)__builtin_amdgcn_kernarg_segment_ptr(); asm volatile("" : "+s"(k)); return k; }
#define PHASE_PARAMS() const Params p = *kparams()
#else
#define PHASE_PARAMS() const Params p = p_arg
#endif
constexpr int CW_BAR = 4096, CW_CMP = 8192, CW_GXCC = 8704, CW_WD = 9216, CW_P4 = 9280, CW_W1 = 9344, CW_GRP = 9408, CW_REL = 13504;

__global__ void __launch_bounds__(512, 2) fwd_megakernel(Params p_arg) {
    extern __shared__ __attribute__((aligned(16))) unsigned char dlds[];
    LAS unsigned char* lds = (LAS unsigned char*)dlds;
    const int G = gridDim.x, c = blockIdx.x, ngw = G * NWAVE, ngt = G * NTHR;
    const int wid0 = __builtin_amdgcn_readfirstlane(threadIdx.x >> 6);
#define TIDS() const int tid = opaque_tid(wid0), lane = tid & 63, wave = tid >> 6, gw = c * NWAVE + wave, gtid = c * NTHR + tid; (void)lane; (void)gw; (void)gtid
    volatile LAS unsigned* MISC = (volatile LAS unsigned*)(lds + 131072 + 320);
    { TIDS(); if (tid < 32) MISC[tid] = 0u; }
    __syncthreads();
    XcdBarrier bar;
    { PHASE_PARAMS(); TIDS(); bar = xcd_barrier_post((unsigned*)(p.ws + WS_CTL) + CW_BAR, MISC + 8, tid == 0); }
    { PHASE_PARAMS(); TIDS(); if (tid == 0) (void)__hip_atomic_fetch_or((unsigned*)(p.ws + WS_CTL) + CW_GXCC + 64 * (c & 7), 1u << xb_xcc_id(), __ATOMIC_RELAXED, __HIP_MEMORY_SCOPE_AGENT); }
#define GRID_SYNC() do { TIDS(); xcd_barrier(bar, tid == 0); } while (0)
#define GROUP_SYNC_X(k, rel, cnt2, target2, fast) do { PHASE_PARAMS(); TIDS(); if (G == 256) { unsigned* ctl_ = (unsigned*)(p.ws + WS_CTL); \
        group_barrier(ctl_ + CW_GRP + 64 * (8 * (k) + (c & 7)), 32u, (rel) ? ctl_ + CW_REL + 64 * (c & 7) : (unsigned*)nullptr, ctl_ + (cnt2), (target2), tid == 0 && (fast) && MISC[12] != 0u, tid == 0); } else xcd_barrier(bar, tid == 0); } while (0)
#define GROUP_SYNC(k, cnt2, target2) GROUP_SYNC_X(k, false, cnt2, target2, true)

    { PHASE_PARAMS();
      { TIDS(); stage_weights<0>(p, gw, ngw, (float*)dlds + wave * (64 * 33), lane); }
      __syncthreads();
      if (G == 256) { if (c < 224) stage_mod(p, c, G, (float*)dlds, wid0); else { TIDS(); stage_rope(p, tid, (c - 224) * NTHR + tid, (G - 224) * NTHR, (float*)dlds + 16384); } }
      else { stage_mod(p, c, G, (float*)dlds, wid0); __syncthreads(); { TIDS(); stage_rope(p, tid, gtid, ngt, (float*)dlds + 16384); } } }
    GRID_SYNC();
    { PHASE_PARAMS(); TIDS(); if (tid == 0) MISC[12] = (__builtin_popcount(xb_ld((unsigned*)(p.ws + WS_CTL) + CW_GXCC + 64 * (c & 7))) == 1) ? 1u : 0u; }
    { PHASE_PARAMS(); TIDS();
      if (G == 256) stage_normmod(p.in[I_X], p.in[I_N1G], wsp<float>(p, WS_MOD), 0, 1, wsp<bf16_t>(p, WS_R0), SEQ * (c & 7) + 64 * (c >> 3) + wave, NWAVE, 64 / NWAVE, lane);
      else stage_normmod(p.in[I_X], p.in[I_N1G], wsp<float>(p, WS_MOD), 0, 1, wsp<bf16_t>(p, WS_R0), gw, ngw, (gw < MT) ? (MT - gw + ngw - 1) / ngw : 0, lane); }
    GROUP_SYNC(4, CW_WD, 0u);
    { PHASE_PARAMS(); EpiZ E{p}; gemm_fast(lds, wsp<bf16_t>(p, WS_R0), 1024, wsp<bf16_t>(p, WS_WIN), MT, ZN, 1024, E, G, c, wid0); }
    { PHASE_PARAMS(); const int nz = (MT / 256) * (ZN / 256), first = nz % G;
      if (c >= first) { { TIDS(); stage_weights<1>(p, (c - first) * NWAVE + wave, (G - first) * NWAVE, (float*)dlds + wave * (64 * 33), lane); }
                        __syncthreads(); stage_shw(p, c - first, G - first, (float*)dlds, wid0);
                        { TIDS(); publish_count((unsigned*)(p.ws + WS_CTL) + CW_W1, tid == 0); } } }
    GROUP_SYNC_X(5, true, CW_REL + 64 * ((c & 7) ^ 1), (((c >> 3) >= 24 && (c >> 3) < 28) ? 1u : 0u), true);
    { PHASE_PARAMS();
      int qb, qc, kb, kc;
      const int v = c;
      int cu0 = (v + 64) % G;
      if (G == 256) { const int x = c & 7, j = c >> 3;
          qb = 24 * x + j; qc = (j < 24) ? 1 : 0; kb = (j < 24) ? 32 * x + j : (j >= 28 ? 32 * x + 24 + 2 * (j - 28) : 0); kc = (j < 24) ? 1 : (j >= 28 ? 2 : 0);
          cu0 = (j >= 24 && j < 28) ? ((((j - 24) & 1) << 4) | ((((j - 24) >> 1) & 1) << 3) | ((x >> 1) << 1) | (x & 1)) : 32; }
      else { const int pq = (192 + G - 1) / G, pk = (256 + G - 1) / G; qb = v * pq; qc = (192 - qb < pq) ? ((192 - qb > 0) ? 192 - qb : 0) : pq; kb = v * pk; kc = (256 - kb < pk) ? ((256 - kb > 0) ? 256 - kb : 0) : pk; }
      { EpiQ E{p}; gemm_fast_range(lds, wsp<bf16_t>(p, WS_R1), 1024, wsp<bf16_t>(p, WS_WQB), MT, 768, 768, E, qb, qc, wid0); }
      for (int cu = cu0; cu < 32; cu += G) cmp_hidden_fast(p, lds, cu, wid0);
      { EpiKV E{p}; gemm_fast_range(lds, wsp<bf16_t>(p, WS_R1) + 768, 1024, wsp<bf16_t>(p, WS_WKVB), MT, 1024, 256, E, kb, kc, wid0); }
    }
    GROUP_SYNC_X(6, false, CW_GRP + 64 * (8 * 6 + ((c & 7) ^ 1)), 32u, !((c >> 3) >= 24 && (c >> 3) < 28));
    { PHASE_PARAMS(); TIDS(); if (G == 256) cmp_out<true>(p, (c >> 3) * NWAVE + wave, 32 * NWAVE, lane, c & 7, (LAS float*)lds, tid); else cmp_out<true>(p, gw, ngw, lane, -1, (LAS float*)lds, tid);
      asm volatile("s_waitcnt vmcnt(0)" ::: "memory"); __syncthreads();
      if (tid == 0) { if (!(G == 256 && MISC[12] != 0u)) { __builtin_amdgcn_fence(__ATOMIC_RELEASE, "agent"); asm volatile("s_waitcnt vmcnt(0)" ::: "memory"); }
          __hip_atomic_fetch_add((unsigned*)(p.ws + WS_CTL) + CW_CMP + ((G == 256) ? 64 * (c & 7) : 0), 1u, __ATOMIC_RELAXED, __HIP_MEMORY_SCOPE_AGENT); } }
    { PHASE_PARAMS(); stage_attn_fast(p, lds, c, G, true, false, wid0); }
    { PHASE_PARAMS(); TIDS();
      if (tid == 0) { unsigned* cnt = (unsigned*)(p.ws + WS_CTL) + CW_CMP + ((G == 256) ? 64 * (c & 7) : 0); unsigned sp = 0;
          while (__hip_atomic_load(cnt, __ATOMIC_RELAXED, __HIP_MEMORY_SCOPE_AGENT) < (unsigned)((G == 256) ? 32 : G)) { __builtin_amdgcn_s_sleep(2); if (++sp > (1u << 22)) break; }
          __builtin_amdgcn_fence(__ATOMIC_ACQUIRE, "agent"); asm volatile("s_waitcnt vmcnt(0)" ::: "memory"); }
      __syncthreads(); }
    { PHASE_PARAMS(); stage_attn_fast(p, lds, c, G, false, true, wid0); }
    { PHASE_PARAMS(); TIDS(); if (tid == 0) (void)xb_add((unsigned*)(p.ws + WS_CTL) + CW_P4, 1u); }
    { const int nz = (MT / 256) * (ZN / 256), first = nz % G; GROUP_SYNC(3, CW_W1, (unsigned)(G - first)); }
    { PHASE_PARAMS(); EpiMerge E{p}; gemm_fast(lds, wsp<bf16_t>(p, WS_R1), 1024, wsp<bf16_t>(p, WS_WO), MT, 1024, 1024, E, G, c, wid0); }
    GROUP_SYNC(0, CW_WD, 0u);
    { PHASE_PARAMS(); EpiOut E{p}; gemm_fast(lds, wsp<bf16_t>(p, WS_R2) + 1024, 2048, wsp<bf16_t>(p, WS_WOUT), MT, 1024, 1024, E, G, c, wid0); }
    GROUP_SYNC(1, CW_P4, (unsigned)G);
    { PHASE_PARAMS(); const int ng = (MT / 256) * (5632 / 256), first = ng % G;
      if (c >= first) { TIDS(); stage_weights<2>(p, (c - first) * NWAVE + wave, (G - first) * NWAVE, (float*)dlds + wave * (64 * 33), lane);
                        publish_count((unsigned*)(p.ws + WS_CTL) + CW_WD, tid == 0); __syncthreads(); } }
    { PHASE_PARAMS(); EpiGU E{p}; gemm_fast(lds, wsp<bf16_t>(p, WS_R1), 1024, wsp<bf16_t>(p, WS_WGU), MT, 5632, 1024, E, G, c, wid0); }
    { const int ng = (MT / 256) * (5632 / 256), first = ng % G; GROUP_SYNC(2, CW_WD, (unsigned)(G - first)); }
    { PHASE_PARAMS(); EpiDown E{p}; gemm_fast(lds, wsp<bf16_t>(p, WS_HID), DFF, wsp<bf16_t>(p, WS_WD), MT, 1024, DFF, E, G, c, wid0); }
}

extern "C" void kernel_launch(void* const* d_in, const int* in_sizes, int n_in, void* d_out, int out_size, void* d_ws, size_t ws_size, hipStream_t stream) {
    if (n_in != 30 || out_size != MT * DM || ws_size < WS_END) { fprintf(stderr, "kernel_launch: unexpected shapes (n_in %d out %d ws %zu)\n", n_in, out_size, ws_size); return; }
    static int grid = 0;
    if (grid == 0) {
        int dev = 0, cus = 0, per_cu = 0;
        (void)hipGetDevice(&dev); (void)hipDeviceGetAttribute(&cus, hipDeviceAttributeMultiprocessorCount, dev);
        (void)hipFuncSetAttribute((const void*)fwd_megakernel, hipFuncAttributeMaxDynamicSharedMemorySize, LDS_BYTES);
        (void)hipOccupancyMaxActiveBlocksPerMultiprocessor(&per_cu, (const void*)fwd_megakernel, NTHR, LDS_BYTES);
        if (per_cu < 1) fprintf(stderr, "kernel_launch: occupancy query says %d blocks per CU\n", per_cu);
        grid = cus;
        (void)hipGetLastError();
    }
    Params p{};
    for (int i = 0; i < 30; ++i) p.in[i] = (const float*)d_in[i];
    p.out = (float*)d_out; p.ws = (unsigned char*)d_ws;
    (void)hipMemsetAsync((char*)d_ws + WS_CTL, 0, 65536, stream);
    void* args[] = {&p};
    hipError_t e = hipLaunchCooperativeKernel((const void*)fwd_megakernel, dim3(grid), dim3(NTHR), args, LDS_BYTES, stream);
    if (e != hipSuccess) fprintf(stderr, "kernel_launch: cooperative launch failed: %s (grid %d)\n", hipGetErrorString(e), grid);
}
```

```cpp
#include <hip/hip_runtime.h>
#include <cstdint>
#include <cstdio>

typedef unsigned short bf16_t;
typedef unsigned u32x4 __attribute__((ext_vector_type(4)));
typedef unsigned u32x2 __attribute__((ext_vector_type(2)));
typedef float f32x4 __attribute__((ext_vector_type(4)));
typedef float f32x2 __attribute__((ext_vector_type(2)));
#define DI __device__ __forceinline__

constexpr int NB = 8, SEQ = 2048, DM = 1024, MT = NB * SEQ;
constexpr int DFF = 2816, NMOD = 6;
constexpr int ZN = 4608;
constexpr float EPS = 1e-6f;
constexpr float LOG2E = 1.4426950408889634f;
constexpr float C2N = 0.125f * LOG2E;
constexpr float C2M = 0.10206207261596575f * LOG2E;
constexpr int NTHR = 512, NWAVE = 8;
constexpr int O_CQ = 0, O_CKV = 768, O_KPE = 1024, O_QN = 1056, O_KC = 1568, O_VC = 1696, O_KS = 1824, O_VS = 1952, O_KW = 2080, O_VW = 2208,
              O_GN = 2336, O_GM = 2360, O_GNM = 3384, D_IN = 4408;

constexpr size_t MiB = 1u << 20;
constexpr size_t WS_CTL = 0;
constexpr size_t WS_MOD = 1 * MiB;
constexpr size_t WS_CB1 = 1 * MiB + 256 * 1024;
constexpr size_t WS_SSQPE = 1 * MiB + 320 * 1024;
constexpr size_t WS_SSQKN = 1 * MiB + 512 * 1024;
constexpr size_t WS_SSQA = 2 * MiB;
constexpr size_t WS_KCF = 3 * MiB;
constexpr size_t WS_VCF = 3 * MiB + 256 * 1024;
constexpr size_t WS_SHW = 3 * MiB + 512 * 1024;
constexpr size_t WS_WIN = 4 * MiB;
constexpr size_t WS_WQB = 13 * MiB;
constexpr size_t WS_WKVB = 15 * MiB;
constexpr size_t WS_WO = 16 * MiB;
constexpr size_t WS_WOUT = 18 * MiB;
constexpr size_t WS_WGU = 20 * MiB;
constexpr size_t WS_WD = 31 * MiB;
constexpr size_t WS_CW1 = 37 * MiB;
constexpr size_t WS_R0 = 40 * MiB;
constexpr size_t WS_R1 = 72 * MiB;
constexpr size_t WS_R2 = 104 * MiB;
constexpr size_t WS_QN = 168 * MiB;
constexpr size_t WS_KC = 184 * MiB, WS_VC = 188 * MiB, WS_KS = 192 * MiB, WS_VS = 196 * MiB, WS_KW = 200 * MiB, WS_VW = 204 * MiB;
constexpr size_t WS_KPE = 208 * MiB;
constexpr size_t WS_GN = 209 * MiB;
constexpr size_t WS_KN = 210 * MiB;
constexpr size_t WS_VM = 234 * MiB;
constexpr size_t WS_ROPE = 250 * MiB;
constexpr size_t WS_HID = 168 * MiB;
constexpr size_t WS_END = 256 * MiB;

struct Params {
    const float* in[30];
    float* out;
    unsigned char* ws;
};
enum { I_X = 0, I_C, I_POS, I_ADAW, I_ADAB, I_N1G, I_WIN, I_QAG, I_WQB, I_KVAG, I_WKVB, I_MQG, I_MKG, I_NQG, I_NKCG, I_NKSG, I_NKWG,
       I_CPK, I_CW1K, I_CW2K, I_CPV, I_CW1V, I_CW2V, I_WOM, I_WON, I_WOUT, I_N2G, I_WG, I_WU, I_WDN };

template <class T> DI T* wsp(const Params& p, size_t off) { return (T*)(p.ws + off); }
DI bf16_t* qraw(const Params& p) { return (bf16_t*)p.out; }
DI float* cmph(const Params& p) { return p.out + (size_t)6 * 1024 * 1024; }

#ifndef WT_STORES
#define WT_STORES 0
#endif
DI void st16(void* p, u32x4 v) {
#if WT_STORES
    asm volatile("global_store_dwordx4 %0, %1, off sc1\n\ts_nop 1" :: "v"(p), "v"(v) : "memory");
#else
    *(u32x4*)p = v;
#endif
}
DI void st16f(void* p, f32x4 v) { st16(p, __builtin_bit_cast(u32x4, v)); }
DI int lane_id() { return (int)__builtin_amdgcn_mbcnt_hi(~0u, __builtin_amdgcn_mbcnt_lo(~0u, 0u)); }
DI int opaque_lane() { int l; asm volatile("v_mbcnt_lo_u32_b32 %0, -1, 0\n\tv_mbcnt_hi_u32_b32 %0, -1, %0" : "=v"(l)); return l; }
DI int opaque_tid(int wid0) { int l; asm volatile("v_mbcnt_lo_u32_b32 %0, -1, 0\n\tv_mbcnt_hi_u32_b32 %0, -1, %0" : "=v"(l)); return (wid0 << 6) | l; }
DI unsigned f2bf(float f) { unsigned u = __float_as_uint(f); return (u + 0x7fffu + ((u >> 16) & 1u)) >> 16; }
DI unsigned pk2(float lo, float hi) { return f2bf(lo) | (f2bf(hi) << 16); }
DI float bf2f(unsigned short b) { return __uint_as_float(((unsigned)b) << 16); }
DI float bflo(unsigned w) { return __uint_as_float(w << 16); }
DI float bfhi(unsigned w) { return __uint_as_float(w & 0xffff0000u); }
DI void unpack8(const u32x4 w, float (&f)[8]) { f[0] = bflo(w.x); f[1] = bfhi(w.x); f[2] = bflo(w.y); f[3] = bfhi(w.y); f[4] = bflo(w.z); f[5] = bfhi(w.z); f[6] = bflo(w.w); f[7] = bfhi(w.w); }
DI u32x4 pack8(const float (&f)[8]) { u32x4 w; w.x = pk2(f[0], f[1]); w.y = pk2(f[2], f[3]); w.z = pk2(f[4], f[5]); w.w = pk2(f[6], f[7]); return w; }
DI float sigmoidf(float x) { return __builtin_amdgcn_rcpf(1.0f + __expf(-x)); }
DI float siluf(float x) { return x * __builtin_amdgcn_rcpf(1.0f + __expf(-x)); }
template <int X> DI float xorl(float v) { return __int_as_float(__builtin_amdgcn_ds_swizzle(__float_as_int(v), (X << 10) | 0x1f)); }
DI void halves(float v, float& lo, float& hi) { auto rr = __builtin_amdgcn_permlane32_swap(__float_as_uint(v), __float_as_uint(v), false, false); lo = __uint_as_float(rr[0]); hi = __uint_as_float(rr[1]); }
DI float xor32(float v, int hf) { float lo, hi; halves(v, lo, hi); return hf ? lo : hi; }
DI float sum32(float v) { float lo, hi; halves(v, lo, hi); return lo + hi; }
DI float max32(float v) { float lo, hi; halves(v, lo, hi); return fmaxf(lo, hi); }
DI float wave_sum(float v) { v += xorl<1>(v); v += xorl<2>(v); v += xorl<4>(v); v += xorl<8>(v); v += xorl<16>(v); return sum32(v); }
DI void sincos_rad(float ang, float& c, float& s) {
    double rev = (double)ang * 0.15915494309189535; rev -= __builtin_rint(rev);
    const float fr = (float)rev; s = __builtin_amdgcn_sinf(fr); c = __builtin_amdgcn_cosf(fr);
}
#define LAS __attribute__((address_space(3)))
#if defined(__HIP_DEVICE_COMPILE__)
DI const float* karg_in(int i) { typedef const float* KPtr; const KPtr __attribute__((address_space(4)))* k = (const KPtr __attribute__((address_space(4)))*)__builtin_amdgcn_kernarg_segment_ptr(); return k[i]; }
#else
DI const float* karg_in(int) { return nullptr; }
#endif
DI void tr_load(const float* W, int ldw, int c0, int ncols, int k0, float (&v)[32], int lane) {
    const int cc = lane & 31, kh = lane >> 5;
    if (c0 >= 0 && cc < ncols) {
        const float* src = W + (size_t)(k0 + kh) * ldw + c0 + cc;
#pragma unroll
        for (int i = 0; i < 32; ++i) v[i] = src[(size_t)(2 * i) * ldw];
    } else {
#pragma unroll
        for (int i = 0; i < 32; ++i) v[i] = 0.f;
    }
}
DI void tr_finish(const float* rs, bf16_t* dst, int ldd, int n0, int k0, float (&v)[32], float* scr, int lane) {
    const int cc = lane & 31, kh = lane >> 5;
    if (rs) {
#pragma unroll
        for (int i = 0; i < 32; ++i) v[i] *= rs[k0 + 2 * i + kh];
    }
#pragma unroll
    for (int i = 0; i < 32; ++i) scr[(2 * i + kh) * 33 + cc] = v[i];
    __builtin_amdgcn_s_waitcnt(0xc07f);
    asm volatile("" ::: "memory");
    const int c = lane & 7;
#pragma unroll
    for (int j = 0; j < 4; ++j) { const int n = (lane >> 3) + 8 * j; const float* s = scr + (8 * c) * 33 + n;
        u32x4 o; o.x = pk2(s[0 * 33], s[1 * 33]); o.y = pk2(s[2 * 33], s[3 * 33]); o.z = pk2(s[4 * 33], s[5 * 33]); o.w = pk2(s[6 * 33], s[7 * 33]);
        st16(dst + (size_t)(n0 + n) * ldd + k0 + 8 * c, o); }
    __builtin_amdgcn_s_waitcnt(0xc07f);
    asm volatile("" ::: "memory");
}
DI void transpose_item(const float* W, int ldw, int c0, int ncols, const float* rs, bf16_t* dst, int ldd, int n0, int k0, float* scr, int lane) {
    float v[32];
    tr_load(W, ldw, c0, ncols, k0, v, lane); tr_finish(rs, dst, ldd, n0, k0, v, scr, lane);
}
DI int zsrc(int s, int L0, int& ncols) {
    ncols = 32;
    if (s < 16) return 64 * s + L0;
    if (s == 16) { if (L0 == 0) return O_KPE; ncols = 24; return O_GN; }
    if (s < 25) return O_QN + 64 * (s - 17) + L0;
    if (s < 27) return O_KC + 64 * (s - 25) + L0;
    if (s < 29) return O_VC + 64 * (s - 27) + L0;
    if (s < 31) return O_KS + 64 * (s - 29) + L0;
    if (s < 33) return O_VS + 64 * (s - 31) + L0;
    if (s < 35) return O_KW + 64 * (s - 33) + L0;
    if (s < 37) return O_VW + 64 * (s - 35) + L0;
    if (s < 40) return -1;
    if (s < 56) return O_GM + 64 * (s - 40) + L0;
    return O_GNM + 64 * (s - 56) + L0;
}
template <int PART> DI void stage_weights(const Params& p, int gw, int ngw, float* scr, int lane) {
    constexpr int I_IN = (ZN / 32) * (DM / 64);
    constexpr int I_QB = (768 / 32) * (768 / 64);
    constexpr int I_KVB = (1024 / 32) * (256 / 64);
    constexpr int I_O = (1024 / 32) * (1024 / 64);
    constexpr int I_OUT = I_O;
    constexpr int I_GU = (5632 / 32) * (1024 / 64);
    constexpr int I_D = (1024 / 32) * (DFF / 64);
    constexpr int I_C1 = 2 * (256 / 32) * (2048 / 64);
    if constexpr (PART == 1) {
        auto item = [&](int r) {
            if (r < I_GU) { const int nb = r / 16, kb = r % 16; const int pn = nb >> 3, bj = (nb >> 2) & 1, wc = nb & 3, s = 4 * pn + wc;
                transpose_item(bj ? p.in[I_WU] : p.in[I_WG], DFF, 32 * s, 32, nullptr, wsp<bf16_t>(p, WS_WGU), 1024, nb * 32, kb * 64, scr, lane); return; }
            r -= I_GU;
            if (r < I_O) { const int nb = r / 16, kb = r % 16;
                if (kb < 8) transpose_item(p.in[I_WOM], 1024, nb * 32, 32, nullptr, wsp<bf16_t>(p, WS_WO), 1024, nb * 32, kb * 64, scr, lane);
                else transpose_item(p.in[I_WON] - (size_t)512 * 1024, 1024, nb * 32, 32, nullptr, wsp<bf16_t>(p, WS_WO), 1024, nb * 32, kb * 64, scr, lane); }
            else { const int r2 = r - I_O, nb = r2 / 16, kb = r2 % 16; transpose_item(p.in[I_WOUT], 1024, nb * 32, 32, nullptr, wsp<bf16_t>(p, WS_WOUT), 1024, nb * 32, kb * 64, scr, lane); } };
        constexpr int NI = I_GU + I_O + I_OUT;
        if (ngw == 1024) { constexpr int N1 = 2560, NL = (128 - 88) * 8;
            for (int r = gw; r < N1; r += 1024) item(r);
            if (gw >= 88 * 8) for (int r = N1 + (gw - 88 * 8); r < NI; r += NL) item(r); }
        else for (int r = gw; r < NI; r += ngw) item(r);
        return;
    }
    if constexpr (PART == 2) {
        for (int r = gw; r < I_D; r += ngw) { const int nb = r / 44, kb = r % 44; transpose_item(p.in[I_WDN], 1024, nb * 32, 32, nullptr, wsp<bf16_t>(p, WS_WD), DFF, nb * 32, kb * 64, scr, lane); }
        return;
    }
    constexpr int NITEMS = I_IN + I_QB + I_KVB + I_C1;
#define TW_DECODE(it_, wi_, ri_, do_, ldw_, c0_, nc_, ldd_, n0_, k0_) do { int r = (it_); \
        if (r < I_IN) { const int nb = r / 16, kb = r % 16; const int pn = nb >> 3, bj = (nb >> 2) & 1, wc = nb & 3; int ncx; c0_ = zsrc(4 * pn + wc, 32 * bj, ncx); nc_ = ncx; \
            wi_ = I_WIN; ri_ = -1; do_ = WS_WIN; ldw_ = D_IN; ldd_ = DM; n0_ = nb * 32; k0_ = kb * 64; break; } r -= I_IN; \
        if (r < I_QB) { const int nb = r / 12, kb = r % 12; wi_ = I_WQB; ri_ = I_QAG; do_ = WS_WQB; ldw_ = 768; c0_ = nb * 32; nc_ = 32; ldd_ = 768; n0_ = nb * 32; k0_ = kb * 64; break; } r -= I_QB; \
        if (r < I_KVB) { const int nb = r / 4, kb = r % 4; const int pn = nb >> 3, bj = (nb >> 2) & 1, wc = nb & 3, s = 4 * pn + wc; \
            c0_ = (s < 8) ? (128 * s + 32 * bj) : (128 * (s - 8) + 64 + 32 * bj); \
            wi_ = I_WKVB; ri_ = I_KVAG; do_ = WS_WKVB; ldw_ = 1024; nc_ = 32; ldd_ = 256; n0_ = nb * 32; k0_ = kb * 64; break; } r -= I_KVB; \
        { const int kv = r / 256, rr = r % 256, nb = rr / 32, kb = rr % 32; \
          wi_ = kv ? I_CW1V : I_CW1K; ri_ = -1; do_ = WS_CW1 + (size_t)kv * 256 * 2048 * 2; ldw_ = 256; c0_ = nb * 32; nc_ = 32; ldd_ = 2048; n0_ = nb * 32; k0_ = kb * 64; } } while (0)
    int it = gw;
    if (it < NITEMS) {
        int wia, ria, wib = 0, rib = -1; size_t doa, dob = 0; int ldwa, c0a, nca, ldda, n0a, k0a, ldwb = 0, c0b = 0, ncb = 0, lddb = 0, n0b = 0, k0b = 0;
        float va[32], vb[32];
        TW_DECODE(it, wia, ria, doa, ldwa, c0a, nca, ldda, n0a, k0a);
        tr_load(karg_in(wia), ldwa, c0a, nca, k0a, va, lane);
        for (;;) {
            const int nx = it + ngw; const bool hn = nx < NITEMS;
            if (hn) { TW_DECODE(nx, wib, rib, dob, ldwb, c0b, ncb, lddb, n0b, k0b); tr_load(karg_in(wib), ldwb, c0b, ncb, k0b, vb, lane); }
            tr_finish((ria >= 0) ? karg_in(ria) : (const float*)nullptr, (bf16_t*)(p.ws + doa), ldda, n0a, k0a, va, scr, lane);
            if (!hn) break;
            ria = rib; doa = dob; ldda = lddb; n0a = n0b; k0a = k0b; it = nx;
#pragma unroll
            for (int i = 0; i < 32; ++i) va[i] = vb[i];
        }
    }
#undef TW_DECODE
}
DI void stage_mod(const Params& p, int bid, int nb, float* lds, int wid0) {
    const int tid = opaque_tid(wid0), wave = tid >> 6, lane = tid & 63, nwv = blockDim.x >> 6;
    if (bid >= 224) return;
    float* sl = lds; float* red = lds + 8192;
    for (int i = tid; i < 8192; i += blockDim.x) sl[i] = siluf(p.in[I_C][i]);
    __syncthreads();
    for (int u = bid; u < 224; u += nb) {
        float acc[8];
#pragma unroll
        for (int b = 0; b < 8; ++b) acc[b] = 0.f;
        if (u < 192) {
            const int kh = lane >> 5; const float* W = p.in[I_ADAW] + u * 32 + (lane & 31); const int kn = 1024 / nwv;
            for (int k = wave * kn + kh; k < (wave + 1) * kn; k += 64) { float w[32];
#pragma unroll
                for (int e = 0; e < 32; ++e) w[e] = W[(size_t)(k + 2 * e) * 6144];
#pragma unroll
                for (int e = 0; e < 32; ++e)
#pragma unroll
                    for (int b = 0; b < 8; ++b) acc[b] += sl[b * 1024 + k + 2 * e] * w[e]; }
        } else {
            const int kq = (u - 192) >> 3, kv = ((u - 192) >> 2) & 1; const float* W = (kv ? p.in[I_CW1V] : p.in[I_CW1K]) + ((u - 192) & 3) * 64 + lane; const float* pos = kv ? p.in[I_CPV] : p.in[I_CPK]; const int kn = 512 / nwv;
            for (int k = kq * 512 + wave * kn; k < kq * 512 + (wave + 1) * kn; k += 32) { float w[32];
#pragma unroll
                for (int e = 0; e < 32; ++e) w[e] = W[(size_t)(k + e) * 256];
#pragma unroll
                for (int e = 0; e < 32; ++e) acc[0] += pos[k + e] * w[e]; }
        }
        __syncthreads();
#pragma unroll
        for (int b = 0; b < 8; ++b) red[(wave * 8 + b) * 64 + lane] = acc[b];
        __syncthreads();
        if (wave == 0) {
#pragma unroll
            for (int b = 0; b < 8; ++b) { float s = 0.f;
                if (u < 192) { for (int w = 0; w < nwv; ++w) s += red[(w * 8 + b) * 64 + (lane & 31)] + red[(w * 8 + b) * 64 + 32 + (lane & 31)];
                    if (lane < 32) wsp<float>(p, WS_MOD)[b * 6144 + u * 32 + lane] = s + p.in[I_ADAB][u * 32 + lane]; }
                else { for (int w = 0; w < nwv; ++w) s += red[(w * 8 + b) * 64 + lane];
                    if (b == 0) wsp<float>(p, WS_CB1)[((u - 192) >> 3) * 512 + ((u - 192) & 7) * 64 + lane] = s; } }
        }
    }
}
DI void stage_rope(const Params& p, int tid, int gtid, int ngt, float* invt) {
    if (tid < 24) invt[tid] = (tid < 16) ? (float)pow(500000.0, -(double)tid / 16.0) : (float)pow(500000.0, -(double)(tid - 16) / 8.0);
    __syncthreads();
    float* T = wsp<float>(p, WS_ROPE); const int* pos = (const int*)p.in[I_POS];
    for (int i = gtid; i < MT * 24; i += ngt) {
        const int row = i / 24, j = i % 24; const float ps = (float)pos[row]; float c, s;
        sincos_rad(ps * invt[j], c, s);
        if (j < 16) { T[(size_t)row * 16 + j] = c; T[(size_t)MT * 16 + (size_t)row * 16 + j] = s; }
        else { T[(size_t)MT * 32 + (size_t)row * 8 + (j - 16)] = c; T[(size_t)MT * 40 + (size_t)row * 8 + (j - 16)] = s; }
    }
}
DI const float* ropeCM(const Params& p) { return wsp<float>(p, WS_ROPE); }
DI const float* ropeSM(const Params& p) { return wsp<float>(p, WS_ROPE) + (size_t)MT * 16; }
DI const float* ropeCN(const Params& p) { return wsp<float>(p, WS_ROPE) + (size_t)MT * 32; }
DI const float* ropeSN(const Params& p) { return wsp<float>(p, WS_ROPE) + (size_t)MT * 40; }

DI void stage_normmod(const float* X, const float* gain, const float* mod, int sh_idx, int sc_idx, bf16_t* Hout, int m0, int mstep, int cnt, int lane) {
    f32x4 v[4], n1[4], n2[4], gs[4], sh[4];
    int bcur = -1;
#define NM_LOAD(dst, row) do { const f32x4* xr_ = (const f32x4*)(X + (size_t)(row) * DM) + lane; _Pragma("unroll") for (int j = 0; j < 4; ++j) dst[j] = xr_[64 * j]; } while (0)
    if (cnt > 0) NM_LOAD(n1, m0);
    if (cnt > 1) NM_LOAD(n2, m0 + mstep);
    for (int i = 0; i < cnt; ++i) {
        const int m = m0 + i * mstep, b = m / SEQ;
#pragma unroll
        for (int j = 0; j < 4; ++j) { v[j] = n1[j]; n1[j] = n2[j]; }
        if (i + 2 < cnt) NM_LOAD(n2, m + 2 * mstep);
        if (b != bcur) { bcur = b;
            const f32x4* g4 = (const f32x4*)gain + lane; const f32x4* sc4 = (const f32x4*)(mod + b * 6144 + sc_idx * 1024) + lane; const f32x4* sh4 = (const f32x4*)(mod + b * 6144 + sh_idx * 1024) + lane;
#pragma unroll
            for (int j = 0; j < 4; ++j) { gs[j] = g4[64 * j] * (1.0f + sc4[64 * j]); sh[j] = sh4[64 * j]; } }
        float s = 0.f;
#pragma unroll
        for (int j = 0; j < 4; ++j) s += (v[j].x * v[j].x + v[j].y * v[j].y) + (v[j].z * v[j].z + v[j].w * v[j].w);
        const float rstd = rsqrtf(wave_sum(s) * (1.f / DM) + EPS);
        u32x2* o8 = (u32x2*)(Hout + (size_t)m * DM) + lane;
#pragma unroll
        for (int j = 0; j < 4; ++j) { const f32x4 y = v[j] * rstd * gs[j] + sh[j]; u32x2 w; w.x = pk2(y.x, y.y); w.y = pk2(y.z, y.w); o8[64 * j] = w; }
    }
#undef NM_LOAD
}

DI void stage_shw(const Params& p, int ub, int nbk, float* lds, int wid0) {
    const int tid = opaque_tid(wid0), wave = tid >> 6, lane = tid & 63, nwv = blockDim.x >> 6;
    if (ub >= 88) return;
    float* sl = lds; float* red = lds + 8192;
    for (int i = tid; i < 8192; i += blockDim.x) sl[i] = wsp<float>(p, WS_MOD)[(i >> 10) * 6144 + 3 * 1024 + (i & 1023)];
    __syncthreads();
    for (int u = ub; u < 88; u += nbk) {
        const int mat = u / 44, col = 64 * (u % 44) + lane; const float* W = (mat ? p.in[I_WU] : p.in[I_WG]) + col; const int kn = 1024 / nwv;
        float acc[8];
#pragma unroll
        for (int b = 0; b < 8; ++b) acc[b] = 0.f;
        for (int k = wave * kn; k < (wave + 1) * kn; k += 8) { float w[8];
#pragma unroll
            for (int e = 0; e < 8; ++e) w[e] = W[(size_t)(k + e) * DFF];
#pragma unroll
            for (int e = 0; e < 8; ++e)
#pragma unroll
                for (int b = 0; b < 8; ++b) acc[b] += sl[b * 1024 + k + e] * w[e]; }
        __syncthreads();
#pragma unroll
        for (int b = 0; b < 8; ++b) red[(wave * 8 + b) * 64 + lane] = acc[b];
        __syncthreads();
        if (wave == 0) { const int s = col >> 5, cr = col & 31, phys = 256 * (s >> 2) + 128 * mat + 32 * (s & 3) + cr;
#pragma unroll
            for (int b = 0; b < 8; ++b) { float sum = 0.f;
                for (int w = 0; w < nwv; ++w) sum += red[(w * 8 + b) * 64 + lane];
                wsp<float>(p, WS_SHW)[b * 5632 + phys] = sum; } }
    }
}
struct ColPre { f32x4 c[8]; };
struct RowPre { f32x4 a[4]; };
DI void store8bf(bf16_t* dst, const float (&f)[8]) { st16(dst, pack8(f)); }
DI float ssq16(const float (&v)[2][8]) { float q = 0.f;
#pragma unroll
    for (int b = 0; b < 2; ++b)
#pragma unroll
        for (int j = 0; j < 8; ++j) q += v[b][j] * v[b][j];
    q += xorl<16>(q); return sum32(q); }
DI f32x4 ld4(const float* p) { return *(const f32x4*)p; }
DI f32x4 ld4u(const bf16_t* p) { return __builtin_bit_cast(f32x4, *(const u32x4*)p); }
DI void un8(const f32x4 raw, float (&f)[8]) { unpack8(__builtin_bit_cast(u32x4, raw), f); }

struct EpiZ {
    static constexpr bool HAS_MID = false; static constexpr int NTYPES = 7;
    Params p;
    DI void midpre(RowPre&, int, int, int, int) const {}
    DI void mid(const RowPre&, int, int, int, int, float (&)[2][8]) const {}
    DI int type(int pn, int wc) const { const int s = 4 * pn + wc;
        if (s < 16) return 0; if (s == 16) return 1; if (s < 25) return 2; if (s < 37) { const int t = (s - 25) >> 1; return (t == 2 || t == 4) ? 3 : 4; } if (s < 40) return 5; return 6; }
    template <int T> DI void ubegin(ColPre& U, int, int pn, int wc, int fq) const {
        const int s = 4 * pn + wc; (void)s;
        if constexpr (T == 1) { U.c[0] = ld4(p.in[I_MKG] + 64 + 8 * fq); U.c[1] = ld4(p.in[I_MKG] + 68 + 8 * fq); }
        if constexpr (T == 2 || T == 3) { const float* gain = (T == 2) ? p.in[I_NQG] : ((((s - 25) >> 1) == 2) ? p.in[I_NKSG] : p.in[I_NKWG]);
            U.c[0] = ld4(gain + 8 * fq); U.c[1] = ld4(gain + 8 * fq + 4); U.c[2] = ld4(gain + 32 + 8 * fq); U.c[3] = ld4(gain + 36 + 8 * fq); }
    }
    template <int T> DI void pre(RowPre& R, int row, int, int, int fq) const {
        if constexpr (T == 1) { const int i0 = 8 * (fq & 1); const float* cs = ropeCM(p) + (size_t)row * 16 + i0; const float* sn = ropeSM(p) + (size_t)row * 16 + i0;
            R.a[0] = ld4(cs); R.a[1] = ld4(cs + 4); R.a[2] = ld4(sn); R.a[3] = ld4(sn + 4); }
        if constexpr (T == 2 || T == 3) { const float* cs = ropeCN(p) + (size_t)row * 8; const float* sn = ropeSN(p) + (size_t)row * 8;
            R.a[0] = ld4(cs); R.a[1] = ld4(cs + 4); R.a[2] = ld4(sn); R.a[3] = ld4(sn + 4); }
    }
    DI void normrope(const ColPre& U, const RowPre& R, int fq, float (&v)[2][8], float post, bf16_t* dst) const {
        const float rstd = rsqrtf(ssq16(v) * (1.f / 64.f) + EPS);
#pragma unroll
        for (int b = 0; b < 2; ++b)
#pragma unroll
            for (int j = 0; j < 8; ++j) v[b][j] *= rstd * U.c[2 * b + (j >> 2)][j & 3];
#pragma unroll
        for (int j = 0; j < 8; ++j) { const float own = v[0][j], oth = xorl<16>(own); const float c = R.a[j >> 2][j & 3], s = R.a[2 + (j >> 2)][j & 3];
            if (fq == 0) v[0][j] = own * c - oth * s; else if (fq == 1) v[0][j] = own * c + oth * s; }
#pragma unroll
        for (int b = 0; b < 2; ++b) {
#pragma unroll
            for (int j = 0; j < 8; ++j) v[b][j] *= post;
            store8bf(dst + 32 * b + 8 * fq, v[b]); }
    }
    template <int T> DI void apply(const ColPre& U, const RowPre& R, int row, int pn, int wc, int fq, float (&v)[2][8]) const {
        const int s = 4 * pn + wc; (void)s;
        if constexpr (T == 0) {
            bf16_t* d = wsp<bf16_t>(p, WS_R1) + (size_t)row * 1024 + 64 * s + 8 * fq;
            const float q = ssq16(v); store8bf(d, v[0]); store8bf(d + 32, v[1]);
            if (fq == 0) wsp<float>(p, WS_SSQA)[(size_t)row * 16 + s] = q;
        } else if constexpr (T == 1) {
            float q = 0.f;
#pragma unroll
            for (int j = 0; j < 8; ++j) q += v[0][j] * v[0][j];
            q += xorl<16>(q); q = sum32(q);
            if (fq == 0) wsp<float>(p, WS_SSQPE)[row] = q;
            float o[8];
#pragma unroll
            for (int j = 0; j < 8; ++j) { const float own = v[0][j] * U.c[j >> 2][j & 3], oth = xor32(own, fq >> 1); const float c = R.a[j >> 2][j & 3], sn = R.a[2 + (j >> 2)][j & 3];
                o[j] = (fq < 2) ? own * c - oth * sn : own * c + oth * sn; }
            store8bf(wsp<bf16_t>(p, WS_KPE) + (size_t)row * 32 + 8 * fq, o);
#pragma unroll
            for (int j = 0; j < 8; ++j) o[j] = sigmoidf(v[1][j]);
            store8bf(wsp<bf16_t>(p, WS_GN) + (size_t)row * 32 + 8 * fq, o);
        } else if constexpr (T == 2) {
            normrope(U, R, fq, v, C2N, wsp<bf16_t>(p, WS_QN) + (size_t)row * 512 + 64 * (s - 17));
        } else if constexpr (T == 3 || T == 4) {
            const int t = (s - 25) >> 1, g = (s - 25) & 1;
            bf16_t* d = wsp<bf16_t>(p, WS_KC + (size_t)t * 4 * MiB) + (size_t)row * 128 + 64 * g;
            if constexpr (T == 3) normrope(U, R, fq, v, 1.0f, d);
            else { store8bf(d + 8 * fq, v[0]); store8bf(d + 32 + 8 * fq, v[1]); }
        } else if constexpr (T == 5) {
        } else {
            bf16_t* d = wsp<bf16_t>(p, WS_R2) + (size_t)row * 2048 + 64 * (s - 40) + 8 * fq;
#pragma unroll
            for (int b = 0; b < 2; ++b) { float o[8];
#pragma unroll
                for (int j = 0; j < 8; ++j) o[j] = sigmoidf(v[b][j]);
                store8bf(d + 32 * b, o); }
        }
    }
};
struct EpiQ {
    static constexpr bool HAS_MID = false; static constexpr int NTYPES = 1;
    Params p;
    DI int type(int, int) const { return 0; }
    DI void midpre(RowPre&, int, int, int, int) const {}
    DI void mid(const RowPre&, int, int, int, int, float (&)[2][8]) const {}
    template <int T> DI void ubegin(ColPre&, int, int, int, int) const {}
    template <int T> DI void pre(RowPre& R, int row, int, int, int) const { const float* sq = wsp<float>(p, WS_SSQA) + (size_t)row * 16; R.a[0] = ld4(sq); R.a[1] = ld4(sq + 4); R.a[2] = ld4(sq + 8); }
    template <int T> DI void apply(const ColPre&, const RowPre& R, int row, int pn, int wc, int fq, float (&v)[2][8]) const {
        const float s = ((R.a[0].x + R.a[0].y) + (R.a[0].z + R.a[0].w)) + ((R.a[1].x + R.a[1].y) + (R.a[1].z + R.a[1].w)) + ((R.a[2].x + R.a[2].y) + (R.a[2].z + R.a[2].w));
        const float rstd = rsqrtf(s * (1.f / 768.f) + EPS);
        bf16_t* d = qraw(p) + (size_t)row * 768 + 256 * pn + 32 * wc + 8 * fq;
#pragma unroll
        for (int b = 0; b < 2; ++b) { float o[8];
#pragma unroll
            for (int j = 0; j < 8; ++j) o[j] = v[b][j] * rstd;
            store8bf(d + 128 * b, o); }
    }
};
struct EpiKV {
    static constexpr bool HAS_MID = false; static constexpr int NTYPES = 1;
    Params p;
    DI int type(int, int) const { return 0; }
    DI void midpre(RowPre&, int, int, int, int) const {}
    DI void mid(const RowPre&, int, int, int, int, float (&)[2][8]) const {}
    template <int T> DI void ubegin(ColPre&, int, int, int, int) const {}
    template <int T> DI void pre(RowPre& R, int row, int pn, int wc, int fq) const { R.a[0] = ld4(wsp<float>(p, WS_SSQA) + (size_t)row * 16 + 12);
        if (4 * pn + wc < 8) { R.a[1].x = wsp<float>(p, WS_SSQPE)[row]; R.a[2] = ld4u(wsp<bf16_t>(p, WS_KPE) + (size_t)row * 32 + 8 * fq); } }
    template <int T> DI void apply(const ColPre&, const RowPre& R, int row, int pn, int wc, int fq, float (&v)[2][8]) const {
        const int s = 4 * pn + wc;
        const float rstd = rsqrtf(((R.a[0].x + R.a[0].y) + (R.a[0].z + R.a[0].w)) * (1.f / 256.f) + EPS);
#pragma unroll
        for (int b = 0; b < 2; ++b)
#pragma unroll
            for (int j = 0; j < 8; ++j) v[b][j] *= rstd;
        if (s < 8) { const float rk = rsqrtf((ssq16(v) + R.a[1].x) * (1.f / 96.f) + EPS);
#pragma unroll
            for (int b = 0; b < 2; ++b)
#pragma unroll
                for (int j = 0; j < 8; ++j) v[b][j] *= rk;
            float pe[8]; un8(R.a[2], pe);
#pragma unroll
            for (int j = 0; j < 8; ++j) pe[j] *= rk;
            bf16_t* d = wsp<bf16_t>(p, WS_KN) + (size_t)row * 768 + 96 * s + 8 * fq; store8bf(d, v[0]); store8bf(d + 32, v[1]); store8bf(d + 64, pe); }
        else { bf16_t* d = wsp<bf16_t>(p, WS_VM) + (size_t)row * 512 + 64 * (s - 8) + 8 * fq; store8bf(d, v[0]); store8bf(d + 32, v[1]); }
    }
};
struct EpiMerge {
    static constexpr bool HAS_MID = true; static constexpr int NTYPES = 1;
    Params p;
    DI int type(int, int) const { return 0; }
    DI void midpre(RowPre& R, int row, int pn, int wc, int fq) const {
        const bf16_t* g = wsp<bf16_t>(p, WS_R2) + (size_t)row * 2048 + 256 * pn + 32 * wc + 8 * fq;
        R.a[0] = ld4u(g); R.a[1] = ld4u(g + 128); R.a[2] = ld4u(g + 1024); R.a[3] = ld4u(g + 1024 + 128); }
    DI void mid(const RowPre& R, int, int, int, int, float (&v)[2][8]) const {
#pragma unroll
        for (int b = 0; b < 2; ++b) { float s1[8], s2[8]; un8(R.a[b], s1); un8(R.a[2 + b], s2);
#pragma unroll
            for (int j = 0; j < 8; ++j) v[b][j] *= s1[j] * __builtin_amdgcn_rcpf(s2[j]); }
    }
    template <int T> DI void ubegin(ColPre&, int, int, int, int) const {}
    template <int T> DI void pre(RowPre& R, int row, int pn, int wc, int fq) const {
        const bf16_t* g = wsp<bf16_t>(p, WS_R2) + (size_t)row * 2048 + 1024 + 256 * pn + 32 * wc + 8 * fq; R.a[0] = ld4u(g); R.a[1] = ld4u(g + 128); }
    template <int T> DI void apply(const ColPre&, const RowPre& R, int row, int pn, int wc, int fq, float (&v)[2][8]) const {
        bf16_t* d = wsp<bf16_t>(p, WS_R2) + (size_t)row * 2048 + 1024 + 256 * pn + 32 * wc + 8 * fq;
#pragma unroll
        for (int b = 0; b < 2; ++b) { float s2[8], o[8]; un8(R.a[b], s2);
#pragma unroll
            for (int j = 0; j < 8; ++j) o[j] = v[b][j] * s2[j];
            store8bf(d + 128 * b, o); }
    }
};
struct EpiOut {
    static constexpr bool HAS_MID = false; static constexpr int NTYPES = 1;
    Params p;
    DI int type(int, int) const { return 0; }
    DI void midpre(RowPre&, int, int, int, int) const {}
    DI void mid(const RowPre&, int, int, int, int, float (&)[2][8]) const {}
    template <int T> DI void ubegin(ColPre& U, int row0, int pn, int wc, int fq) const {
        const int b_ = row0 / SEQ, col = 256 * pn + 32 * wc + 8 * fq; const float* md = wsp<float>(p, WS_MOD) + b_ * 6144 + col; const float* g2 = p.in[I_N2G] + col;
#pragma unroll
        for (int i = 0; i < 4; ++i) { const int o = 128 * (i >> 1) + 4 * (i & 1); U.c[i] = ld4(md + 2 * 1024 + o); const f32x4 sc = ld4(md + 4 * 1024 + o), gg = ld4(g2 + o); U.c[4 + i] = gg * (1.0f + sc); }
    }
    template <int T> DI void pre(RowPre& R, int row, int pn, int wc, int fq) const { const float* x = p.in[I_X] + (size_t)row * DM + 256 * pn + 32 * wc + 8 * fq;
        R.a[0] = ld4(x); R.a[1] = ld4(x + 4); R.a[2] = ld4(x + 128); R.a[3] = ld4(x + 132); }
    template <int T> DI void apply(const ColPre& U, const RowPre& R, int row, int pn, int wc, int fq, float (&v)[2][8]) const {
        const int col = 256 * pn + 32 * wc + 8 * fq; bf16_t* d = wsp<bf16_t>(p, WS_R2) + (size_t)row * 2048 + col;   bf16_t* a2 = wsp<bf16_t>(p, WS_R1) + (size_t)row * DM + col;
        float q = 0.f;
#pragma unroll
        for (int b = 0; b < 2; ++b) { float o8[8], x8[8];
#pragma unroll
            for (int h = 0; h < 2; ++h) { const f32x4 g = U.c[2 * b + h], xv = R.a[2 * b + h], gs = U.c[4 + 2 * b + h];
                f32x4 o; o.x = xv.x + g.x * v[b][4 * h]; o.y = xv.y + g.y * v[b][4 * h + 1]; o.z = xv.z + g.z * v[b][4 * h + 2]; o.w = xv.w + g.w * v[b][4 * h + 3];
                x8[4 * h] = o.x; x8[4 * h + 1] = o.y; x8[4 * h + 2] = o.z; x8[4 * h + 3] = o.w;
                q += (o.x * o.x + o.y * o.y) + (o.z * o.z + o.w * o.w);
                o8[4 * h] = o.x * gs.x; o8[4 * h + 1] = o.y * gs.y; o8[4 * h + 2] = o.z * gs.z; o8[4 * h + 3] = o.w * gs.w; }
            store8bf(d + 128 * b, x8); store8bf(a2 + 128 * b, o8); }
        q += xorl<16>(q); q = sum32(q);
        if (fq == 0) wsp<float>(p, WS_SSQA)[(size_t)row * 16 + 4 * pn + wc] = q;
    }
};
struct EpiGU {
    static constexpr bool HAS_MID = false; static constexpr int NTYPES = 1;
    Params p;
    DI int type(int, int) const { return 0; }
    DI void midpre(RowPre&, int, int, int, int) const {}
    DI void mid(const RowPre&, int, int, int, int, float (&)[2][8]) const {}
    template <int T> DI void ubegin(ColPre& U, int row0, int pn, int wc, int fq) const { const float* sh = wsp<float>(p, WS_SHW) + (row0 / SEQ) * 5632 + 256 * pn + 32 * wc + 8 * fq;
        U.c[0] = ld4(sh); U.c[1] = ld4(sh + 4); U.c[2] = ld4(sh + 128); U.c[3] = ld4(sh + 132); }
    template <int T> DI void pre(RowPre& R, int row, int, int, int) const { const float* sq = wsp<float>(p, WS_SSQA) + (size_t)row * 16; R.a[0] = ld4(sq); R.a[1] = ld4(sq + 4); R.a[2] = ld4(sq + 8); R.a[3] = ld4(sq + 12); }
    template <int T> DI void apply(const ColPre& U, const RowPre& R, int row, int pn, int wc, int fq, float (&v)[2][8]) const {
        const int s = 4 * pn + wc; float o[8];
        const float tot = (((R.a[0].x + R.a[0].y) + (R.a[0].z + R.a[0].w)) + ((R.a[1].x + R.a[1].y) + (R.a[1].z + R.a[1].w))) + (((R.a[2].x + R.a[2].y) + (R.a[2].z + R.a[2].w)) + ((R.a[3].x + R.a[3].y) + (R.a[3].z + R.a[3].w)));
        const float rstd = rsqrtf(tot * (1.f / DM) + EPS);
#pragma unroll
        for (int j = 0; j < 8; ++j) o[j] = siluf(rstd * v[0][j] + U.c[j >> 2][j & 3]) * (rstd * v[1][j] + U.c[2 + (j >> 2)][j & 3]);
        store8bf(wsp<bf16_t>(p, WS_HID) + (size_t)row * DFF + 32 * s + 8 * fq, o);
    }
};
struct EpiDown {
    static constexpr bool HAS_MID = false; static constexpr int NTYPES = 1;
    Params p;
    DI int type(int, int) const { return 0; }
    DI void midpre(RowPre&, int, int, int, int) const {}
    DI void mid(const RowPre&, int, int, int, int, float (&)[2][8]) const {}
    template <int T> DI void ubegin(ColPre& U, int row0, int pn, int wc, int fq) const { const float* gt = wsp<float>(p, WS_MOD) + (row0 / SEQ) * 6144 + 5 * 1024 + 256 * pn + 32 * wc + 8 * fq;
        U.c[0] = ld4(gt); U.c[1] = ld4(gt + 4); U.c[2] = ld4(gt + 128); U.c[3] = ld4(gt + 132); }
    template <int T> DI void pre(RowPre& R, int row, int pn, int wc, int fq) const { const bf16_t* x = wsp<bf16_t>(p, WS_R2) + (size_t)row * 2048 + 256 * pn + 32 * wc + 8 * fq;
        R.a[0] = ld4u(x); R.a[1] = ld4u(x + 128); }
    template <int T> DI void apply(const ColPre& U, const RowPre& R, int row, int pn, int wc, int fq, float (&v)[2][8]) const {
        float* d = p.out + (size_t)row * DM + 256 * pn + 32 * wc + 8 * fq;
#pragma unroll
        for (int b = 0; b < 2; ++b) { float x8[8]; un8(R.a[b], x8);
#pragma unroll
            for (int h = 0; h < 2; ++h) { const f32x4 g = U.c[2 * b + h];
                f32x4 o; o.x = x8[4 * h] + g.x * v[b][4 * h]; o.y = x8[4 * h + 1] + g.y * v[b][4 * h + 1]; o.z = x8[4 * h + 2] + g.z * v[b][4 * h + 2]; o.w = x8[4 * h + 3] + g.w * v[b][4 * h + 3]; *(f32x4*)(d + 128 * b + 4 * h) = o; } }
    }
};
namespace pg8 {
#define PG8_LAS __attribute__((address_space(3)))
typedef short bf16x8 __attribute__((ext_vector_type(8)));
constexpr int BM = 256, BK = 64, HALF = 128, HTB = HALF * BK * 2  , STAGE_BYTES = 8 * HTB, NXCD = 8;
#ifndef PG8_WGM
#define PG8_WGM 8
#endif
constexpr int WGM = PG8_WGM;

__host__ __device__ __forceinline__ int lds_byte(int r, int c) { const int st = (r >> 4) * 2 + (c >> 5), rr = r & 15, cc = c & 31, ob = rr * 64 + cc * 2; return st * 1024 + (ob ^ (((ob >> 9) & 1) << 5)); }
__host__ __device__ __forceinline__ void stage_rc(int b, int& R, int& C) { const int st = b / 1024, sb = b % 1024, swz = sb ^ (((sb >> 9) & 1) << 5); R = (st >> 1) * 16 + swz / 64; C = (st & 1) * 32 + (swz % 64) / 2; }
__host__ __device__ __forceinline__ int perm32(int rho) { const int n = rho >> 4, i = rho & 15; return 8 * (i >> 2) + 4 * n + (i & 3); }

struct Unit { int pm, pn; };
struct Gemm { const bf16_t* A; const bf16_t* Bt; int M, N, K, lda, ldb, kstepA; };

struct StaticOrder {
    int nM, nN, nwg, G, c;
    __host__ __device__ void init(int M, int N, int G_, int c_) { nM = M / BM; nN = N / BM; nwg = nM * nN; G = G_; c = c_; }
    __host__ __device__ bool next(int i, Unit& u) const {
        const long L = (long)i * G + c; if (L >= nwg) return false;
        int wgid = (int)L; { const int q = nwg / NXCD, r = nwg % NXCD, xcd = wgid % NXCD, off = wgid / NXCD; wgid = (xcd < r ? xcd * (q + 1) : r * (q + 1) + (xcd - r) * q) + off; }
        const int nig = WGM * nN, gid = wgid / nig, fm = gid * WGM, gsz = (nM - fm) < WGM ? (nM - fm) : WGM;
        u.pm = fm + ((wgid % nig) % gsz); u.pn = (wgid % nig) / gsz; return true;
    }
    __device__ __forceinline__ void a_ready(const Unit&) const {}
    __device__ __forceinline__ void done(const Unit&) const {}
};

template <class Epi, class Sched, bool ALIGN_EPI = false, bool SP2 = false>
__device__ __forceinline__ void gemm_phase(PG8_LAS unsigned char* lds, const Gemm g, const Sched& S, const Epi& E, int wid0) {
    const int tid = opaque_tid(wid0), wid = __builtin_amdgcn_readfirstlane(tid >> 6), lane = tid & 63, wr = wid >> 2, wc = wid & 3, fr = lane & 15, fq = lane >> 4;
    const int K = g.K; int nt = K / BK; asm volatile("" : "+s"(nt));
    unsigned voffA[2], voffB[2];
#pragma unroll
    for (int i = 0; i < 2; ++i) { int R, C; stage_rc(tid * 16 + i * 8192, R, C); const int Rb = Epi::PERM ? ((R & ~31) + perm32(R & 31)) : R;
        voffA[i] = (unsigned)(R * g.lda + C) * 2u; voffB[i] = (unsigned)(Rb * g.ldb + C) * 2u; }
    const size_t kstep = (size_t)(BK * 2), kstepA = (size_t)g.kstepA;
    const size_t hstepB = (size_t)HALF * g.ldb * 2, hstepA = (size_t)HALF * g.lda * 2;
    const size_t tstepB = 2 * hstepB, tstepA = 2 * hstepA;
    const unsigned ldsw = (unsigned)wid * 1024u;
    const int aoff = lds_byte(wr * 64 + fr, fq * 8), boff = lds_byte(wc * 32 + fr, fq * 8);
#define PG8_SA(b, h) (((b) * 2 + (h)) * HTB)
#define PG8_SB(b, h) ((4 + (b) * 2 + (h)) * HTB)
#define PG8_STAGE(bufoff, gbase, voff) do { _Pragma("unroll") for (int _i = 0; _i < 2; ++_i) \
        __builtin_amdgcn_global_load_lds((const unsigned*)((const char*)(gbase) + (voff)[_i]), (PG8_LAS unsigned*)(lds + (bufoff) + ldsw + _i * 8192), 16, 0, 0); } while (0)
#define PG8_LDA(dst, b, h) do { _Pragma("unroll") for (int m = 0; m < 4; ++m) _Pragma("unroll") for (int k = 0; k < 2; ++k) dst[m][k] = *(const PG8_LAS bf16x8*)(lds + PG8_SA(b, h) + aoff + m * 2048 + k * 1024); } while (0)
#define PG8_LDB(dst, b, h) do { _Pragma("unroll") for (int n = 0; n < 2; ++n) _Pragma("unroll") for (int k = 0; k < 2; ++k) dst[n][k] = *(const PG8_LAS bf16x8*)(lds + PG8_SB(b, h) + boff + n * 2048 + k * 1024); } while (0)
#define PG8_MMA(ai, bj, At, Bt) do { __builtin_amdgcn_s_setprio(1); _Pragma("unroll") for (int m = 0; m < 4; ++m) _Pragma("unroll") for (int n = 0; n < 2; ++n) _Pragma("unroll") for (int k = 0; k < 2; ++k) \
        acc[ai][bj][m][n] = __builtin_amdgcn_mfma_f32_16x16x32_bf16(Bt[n][k], At[m][k], acc[ai][bj][m][n], 0, 0, 0); __builtin_amdgcn_s_setprio(0); } while (0)
#define PG8_WAIT_V(n) asm volatile("s_waitcnt vmcnt(" #n ")" ::: "memory")
#define PG8_WAIT_L(n) asm volatile("s_waitcnt lgkmcnt(" #n ")" ::: "memory")
#define PG8_BAR __builtin_amdgcn_s_barrier()
#define PG8_SCHED __builtin_amdgcn_sched_barrier(0)
    Unit cur, nxt; int ui = 0;
    if (!S.next(0, cur)) return;
    f32x4 acc[2][2][4][2];
#pragma unroll
    for (int a = 0; a < 2; ++a)
#pragma unroll
        for (int b = 0; b < 2; ++b)
#pragma unroll
            for (int m = 0; m < 4; ++m)
#pragma unroll
                for (int n = 0; n < 2; ++n) acc[a][b][m][n] = (f32x4){0.f, 0.f, 0.f, 0.f};
    bf16x8 At[4][2], B0[2][2], B1[2][2];
    const char* cA = (const char*)g.A + (size_t)cur.pm * tstepA; const char* cB = (const char*)g.Bt + (size_t)cur.pn * tstepB;
    S.a_ready(cur);
    if constexpr (SP2) {
        PG8_STAGE(PG8_SB(0, 0), cB, voffB); PG8_STAGE(PG8_SB(0, 1), cB + hstepB, voffB); PG8_STAGE(PG8_SA(0, 0), cA, voffA); PG8_STAGE(PG8_SA(0, 1), cA + hstepA, voffA);
        if (wr == 1) PG8_BAR;
        PG8_WAIT_V(2); PG8_BAR;
        PG8_STAGE(PG8_SB(1, 0), cB + kstep, voffB); PG8_STAGE(PG8_SA(1, 0), cA + kstepA, voffA); PG8_STAGE(PG8_SB(1, 1), cB + hstepB + kstep, voffB);
        PG8_WAIT_V(6); PG8_BAR;
    } else {
        PG8_STAGE(PG8_SB(0, 0), cB, voffB); PG8_STAGE(PG8_SA(0, 0), cA, voffA); PG8_STAGE(PG8_SB(0, 1), cB + hstepB, voffB); PG8_STAGE(PG8_SA(0, 1), cA + hstepA, voffA);
        if (wr == 1) PG8_BAR;
        PG8_WAIT_V(4); PG8_BAR;
        PG8_STAGE(PG8_SB(1, 0), cB + kstep, voffB); PG8_STAGE(PG8_SA(1, 0), cA + kstepA, voffA); PG8_STAGE(PG8_SB(1, 1), cB + hstepB + kstep, voffB);
        PG8_WAIT_V(6); PG8_BAR;
    }
    for (;;) {
        const bool has_next = S.next(ui + 1, nxt);
        const char* nA = has_next ? (const char*)g.A + (size_t)nxt.pm * tstepA : cA; const char* nB = has_next ? (const char*)g.Bt + (size_t)nxt.pn * tstepB : cB;
        for (int hh_ = 0; hh_ < (Epi::HAS_MID ? 2 : 1); ++hh_) {
        if constexpr (Epi::HAS_MID) { if (hh_ == 1) E.mid(acc, cur, wr, wc, fr, fq); }
        const int t0_ = Epi::HAS_MID ? hh_ * (nt >> 1) : 0, t1_ = Epi::HAS_MID ? (hh_ + 1) * (nt >> 1) : nt;
        for (int t = t0_; t < t1_; t += 2) {
            const bool last = (t == nt - 2);
            const char* a1 = cA + (size_t)(t + 1) * kstepA;
            const char* a2 = last ? nA : cA + (size_t)(t + 2) * kstepA; const char* b2 = last ? nB : cB + (size_t)(t + 2) * kstep;
            const char* a3 = a2 + kstepA; const char* b3 = b2 + kstep;
            if (last && has_next) S.a_ready(nxt);
            if constexpr (SP2) {
            PG8_LDB(B0, 0, 0); PG8_LDB(B1, 0, 1); PG8_SCHED; PG8_LDA(At, 0, 0); PG8_STAGE(PG8_SA(1, 1), a1 + hstepA, voffA);
            PG8_WAIT_V(8); PG8_WAIT_L(0); PG8_BAR; PG8_MMA(0, 0, At, B0); PG8_MMA(0, 1, At, B1); PG8_BAR; PG8_SCHED;
            PG8_LDA(At, 0, 1); PG8_STAGE(PG8_SB(0, 0), b2, voffB); PG8_STAGE(PG8_SB(0, 1), b2 + hstepB, voffB); PG8_STAGE(PG8_SA(0, 0), a2, voffA);
            PG8_WAIT_V(8); PG8_WAIT_L(0); PG8_BAR; PG8_MMA(1, 0, At, B0); PG8_MMA(1, 1, At, B1); PG8_BAR; PG8_SCHED;
            PG8_LDB(B0, 1, 0); PG8_LDB(B1, 1, 1); PG8_SCHED; PG8_LDA(At, 1, 0); PG8_STAGE(PG8_SA(0, 1), a2 + hstepA, voffA);
            PG8_WAIT_V(8); PG8_WAIT_L(0); PG8_BAR; PG8_MMA(0, 0, At, B0); PG8_MMA(0, 1, At, B1); PG8_BAR; PG8_SCHED;
            PG8_LDA(At, 1, 1); PG8_STAGE(PG8_SB(1, 0), b3, voffB); PG8_STAGE(PG8_SB(1, 1), b3 + hstepB, voffB); PG8_STAGE(PG8_SA(1, 0), a3, voffA);
            PG8_WAIT_V(8); PG8_WAIT_L(0); PG8_BAR; PG8_MMA(1, 0, At, B0); PG8_MMA(1, 1, At, B1); PG8_BAR; PG8_SCHED;
            } else {
            PG8_LDB(B0, 0, 0); PG8_SCHED; PG8_LDA(At, 0, 0); PG8_STAGE(PG8_SA(1, 1), a1 + hstepA, voffA);
            PG8_WAIT_L(8); PG8_BAR; PG8_WAIT_L(0); PG8_MMA(0, 0, At, B0); PG8_BAR; PG8_SCHED;
            PG8_LDB(B1, 0, 1); PG8_STAGE(PG8_SB(0, 0), b2, voffB);
            PG8_BAR; PG8_WAIT_L(0); PG8_MMA(0, 1, At, B1); PG8_BAR;
            PG8_LDA(At, 0, 1); PG8_STAGE(PG8_SA(0, 0), a2, voffA);
            PG8_BAR; PG8_WAIT_L(0); PG8_MMA(1, 0, At, B0); PG8_BAR; PG8_SCHED;
            PG8_STAGE(PG8_SB(0, 1), b2 + hstepB, voffB);
            PG8_WAIT_V(6); PG8_BAR; PG8_MMA(1, 1, At, B1); PG8_BAR;
            PG8_LDB(B0, 1, 0); PG8_SCHED; PG8_LDA(At, 1, 0); PG8_STAGE(PG8_SA(0, 1), a2 + hstepA, voffA);
            PG8_WAIT_L(8); PG8_BAR; PG8_WAIT_L(0); PG8_MMA(0, 0, At, B0); PG8_BAR; PG8_SCHED;
            PG8_LDB(B1, 1, 1); PG8_STAGE(PG8_SB(1, 0), b3, voffB);
            PG8_BAR; PG8_WAIT_L(0); PG8_MMA(0, 1, At, B1); PG8_BAR;
            PG8_LDA(At, 1, 1); PG8_STAGE(PG8_SA(1, 0), a3, voffA);
            PG8_BAR; PG8_WAIT_L(0); PG8_MMA(1, 0, At, B0); PG8_BAR; PG8_SCHED;
            PG8_STAGE(PG8_SB(1, 1), b3 + hstepB, voffB);
            PG8_WAIT_V(6); PG8_BAR; PG8_MMA(1, 1, At, B1); PG8_BAR;
            }
        }
        }
        if constexpr (ALIGN_EPI) { if (wr == 0) PG8_BAR; }
        if constexpr (!Epi::AFTER_DRAIN) { E(acc, cur, wr, wc, fr, fq); S.done(cur); }
        if (!has_next) break;
#pragma unroll
        for (int a = 0; a < 2; ++a)
#pragma unroll
            for (int b = 0; b < 2; ++b)
#pragma unroll
                for (int m = 0; m < 4; ++m)
#pragma unroll
                    for (int n = 0; n < 2; ++n) acc[a][b][m][n] = (f32x4){0.f, 0.f, 0.f, 0.f};
        cur = nxt; cA = nA; cB = nB; ++ui;
        if constexpr (ALIGN_EPI) { if (wr == 1) PG8_BAR; }
    }
    PG8_WAIT_V(0);
    if constexpr (!ALIGN_EPI) { if (wr == 0) PG8_BAR; }
    PG8_BAR;
    if constexpr (Epi::AFTER_DRAIN) { E.fused(acc, cur, wr, wc, fr, fq, lds, wid, lane); S.done(cur); }
#undef PG8_SA
#undef PG8_SB
#undef PG8_STAGE
#undef PG8_LDA
#undef PG8_LDB
#undef PG8_MMA
#undef PG8_WAIT_V
#undef PG8_WAIT_L
#undef PG8_BAR
#undef PG8_SCHED
}
}

#ifndef PG8_SP2V
#define PG8_SP2V true
#endif
template <class SE> struct EpiAdapt {
    static constexpr bool PERM = true, AFTER_DRAIN = false, HAS_MID = SE::HAS_MID;
    SE se;
    template <int T> DI void run(f32x4 (&acc)[2][2][4][2], const pg8::Unit& u, int wr, int wc, int fr, int fq) const {
        int frr = fr; asm volatile("" : "+v"(frr));
        const int rbase = u.pm * 256 + wr * 64;
        ColPre U; se.template ubegin<T>(U, rbase, u.pn, wc, fq);
        RowPre R[2]; se.template pre<T>(R[0], rbase + frr, u.pn, wc, fq);
#pragma unroll
        for (int it = 0; it < 8; ++it) {
            const int ai = it >> 2, m = it & 3; const int row = rbase + ai * 128 + m * 16 + frr;
            if (it < 7) se.template pre<T>(R[(it + 1) & 1], rbase + ((it + 1) >> 2) * 128 + ((it + 1) & 3) * 16 + frr, u.pn, wc, fq);
            float v[2][8];
#pragma unroll
            for (int bj = 0; bj < 2; ++bj)
#pragma unroll
                for (int n = 0; n < 2; ++n) { v[bj][4 * n] = acc[ai][bj][m][n][0]; v[bj][4 * n + 1] = acc[ai][bj][m][n][1]; v[bj][4 * n + 2] = acc[ai][bj][m][n][2]; v[bj][4 * n + 3] = acc[ai][bj][m][n][3]; }
            se.template apply<T>(U, R[it & 1], row, u.pn, wc, fq, v);
        }
    }
    template <int T> DI void disp(int ty, f32x4 (&acc)[2][2][4][2], const pg8::Unit& u, int wr, int wc, int fr, int fq) const {
        if constexpr (T < SE::NTYPES) { if (ty == T) run<T>(acc, u, wr, wc, fr, fq); else disp<T + 1>(ty, acc, u, wr, wc, fr, fq); }
    }
    DI void operator()(f32x4 (&acc)[2][2][4][2], const pg8::Unit& u, int wr, int wc, int fr, int fq) const { disp<0>(se.type(u.pn, wc), acc, u, wr, wc, fr, fq); }
    DI void mid(f32x4 (&acc)[2][2][4][2], const pg8::Unit& u, int wr, int wc, int fr, int fq) const {
        int frr = fr; asm volatile("" : "+v"(frr));
        const int rbase = u.pm * 256 + wr * 64;
        RowPre R[2]; se.midpre(R[0], rbase + frr, u.pn, wc, fq);
#pragma unroll
        for (int it = 0; it < 8; ++it) {
            const int ai = it >> 2, m = it & 3; const int row = rbase + ai * 128 + m * 16 + frr;
            if (it < 7) se.midpre(R[(it + 1) & 1], rbase + ((it + 1) >> 2) * 128 + ((it + 1) & 3) * 16 + frr, u.pn, wc, fq);
            float v[2][8];
#pragma unroll
            for (int bj = 0; bj < 2; ++bj)
#pragma unroll
                for (int n = 0; n < 2; ++n) { v[bj][4 * n] = acc[ai][bj][m][n][0]; v[bj][4 * n + 1] = acc[ai][bj][m][n][1]; v[bj][4 * n + 2] = acc[ai][bj][m][n][2]; v[bj][4 * n + 3] = acc[ai][bj][m][n][3]; }
            se.mid(R[it & 1], row, u.pn, wc, fq, v);
#pragma unroll
            for (int bj = 0; bj < 2; ++bj)
#pragma unroll
                for (int n = 0; n < 2; ++n) { acc[ai][bj][m][n][0] = v[bj][4 * n]; acc[ai][bj][m][n][1] = v[bj][4 * n + 1]; acc[ai][bj][m][n][2] = v[bj][4 * n + 2]; acc[ai][bj][m][n][3] = v[bj][4 * n + 3]; }
        }
    }
};
template <class SE, bool ALIGN = true> DI void gemm_fast(PG8_LAS unsigned char* lds, const bf16_t* A, int lda, const bf16_t* Bt, int M, int N, int K, const SE& se, int G, int c, int wid0) {
    pg8::Gemm g{A, Bt, M, N, K, lda, K, 128}; pg8::StaticOrder S; S.init(M, N, G, c);
    EpiAdapt<SE> E{se};
    pg8::gemm_phase<EpiAdapt<SE>, pg8::StaticOrder, ALIGN, PG8_SP2V>(lds, g, S, E, wid0);
}
struct RangeOrder {
    int base, cnt, nN;
    DI bool next(int i, pg8::Unit& u) const { if (i >= cnt) return false; const int L = base + i; u.pm = L / nN; u.pn = L % nN; return true; }
    DI void a_ready(const pg8::Unit&) const {}
    DI void done(const pg8::Unit&) const {}
};
template <class SE> DI void gemm_fast_range(PG8_LAS unsigned char* lds, const bf16_t* A, int lda, const bf16_t* Bt, int M, int N, int K, const SE& se, int base, int cnt, int wid0) {
    pg8::Gemm g{A, Bt, M, N, K, lda, K, 128}; RangeOrder S{base, cnt, N / 256};
    EpiAdapt<SE> E{se};
    pg8::gemm_phase<EpiAdapt<SE>, RangeOrder, true, true>(lds, g, S, E, wid0);
}
struct OneUnit {
    int pm, pn;
    DI bool next(int i, pg8::Unit& u) const { if (i > 0) return false; u.pm = pm; u.pn = pn; return true; }
    DI void a_ready(const pg8::Unit&) const {}
    DI void done(const pg8::Unit&) const {}
};
struct EpiCmpH {
    static constexpr bool HAS_MID = false; static constexpr int NTYPES = 1;
    float* H;
    DI int type(int, int) const { return 0; }
    DI void midpre(RowPre&, int, int, int, int) const {}
    DI void mid(const RowPre&, int, int, int, int, float (&)[2][8]) const {}
    template <int T> DI void ubegin(ColPre&, int, int, int, int) const {}
    template <int T> DI void pre(RowPre&, int, int, int, int) const {}
    template <int T> DI void apply(const ColPre&, const RowPre&, int row, int pn, int wc, int fq, float (&v)[2][8]) const {
        float* d = H + (size_t)row * 256 + 32 * wc + 8 * fq;
#pragma unroll
        for (int b = 0; b < 2; ++b) { st16f(d + 128 * b, (f32x4){v[b][0], v[b][1], v[b][2], v[b][3]}); st16f(d + 128 * b + 4, (f32x4){v[b][4], v[b][5], v[b][6], v[b][7]}); }
    }
};
DI void cmp_hidden_fast(const Params& p, PG8_LAS unsigned char* lds, int cu, int wid0) {
    const int kv = cu >> 4, g = (cu >> 3) & 1, pm = (cu >> 1) & 3, sp = cu & 1;
    const bf16_t* A = wsp<bf16_t>(p, kv ? WS_VC : WS_KC) + g * 64 + (size_t)(16 * sp) * 128;
    const bf16_t* Bt = wsp<bf16_t>(p, WS_CW1) + (size_t)kv * 256 * 2048 + 1024 * sp;
    pg8::Gemm gm{A, Bt, 1024, 256, 1024, 2048, 2048, 256}; OneUnit S{pm, 0};
    EpiCmpH se{cmph(p) + (size_t)((kv * 2 + g) * 2 + sp) * 1024 * 256};
    EpiAdapt<EpiCmpH> E{se};
    pg8::gemm_phase<EpiAdapt<EpiCmpH>, OneUnit, true, true>(lds, gm, S, E, wid0);
}
template <bool SPLIT> DI void cmp_out(const Params& p, int gw, int ngw, int lane, int bfix, LAS float* ldsw, int tid) {
    static_assert(SPLIT, "split-K partials only");
    const float* H = cmph(p);
    if (bfix >= 0) { const float* w2g = ((gw >> 7) ? p.in[I_CW2V] : p.in[I_CW2K]); f32x4 t[8];
#pragma unroll
        for (int it = 0; it < 8; ++it) t[it] = *(const f32x4*)(w2g + 4 * tid + 2048 * it);
#pragma unroll
        for (int it = 0; it < 8; ++it) *(LAS f32x4*)(ldsw + 4 * tid + 2048 * it) = t[it];
        __syncthreads(); }
    for (int i = gw; i < ((bfix < 0) ? 2048 : 256); i += ngw) {
        const int kg = (bfix < 0) ? (i >> 9) : (i >> 6), g = kg & 1, kv = kg >> 1;
        const int r0 = (bfix < 0) ? 2 * (i & 511) : (bfix * 128 + 2 * (i & 63));
        const int b = r0 >> 7, n0 = r0 & 127;
        bf16_t* dst = wsp<bf16_t>(p, kv ? WS_VCF : WS_KCF) + (size_t)r0 * 128 + g * 64 + lane;
        const float* w2 = (kv ? p.in[I_CW2V] : p.in[I_CW2K]) + lane;
        const float* h = H + ((size_t)((kv * 2 + g) * 2) * 1024 + r0) * 256; const float* cb = wsp<float>(p, WS_CB1) + kv * 256;
        float hv[2][4];
#pragma unroll
        for (int q = 0; q < 4; ++q) { const int j = 64 * q + lane; const float cbj = (cb[j] + cb[512 + j]) + (cb[1024 + j] + cb[1536 + j]);
            hv[0][q] = siluf((h[j] + h[(size_t)1024 * 256 + j]) + cbj); hv[1][q] = siluf((h[256 + j] + h[(size_t)1024 * 256 + 256 + j]) + cbj); }
        float acc[2] = {0.f, 0.f};
#pragma unroll
        for (int q = 0; q < 4; ++q)
#pragma unroll 16
            for (int jj = 0; jj < 64; ++jj) { const float w = (bfix >= 0) ? ldsw[(64 * q + jj) * 64 + lane] : w2[(64 * q + jj) * 64];
                acc[0] += __int_as_float(__builtin_amdgcn_readlane(__float_as_int(hv[0][q]), jj)) * w;
                acc[1] += __int_as_float(__builtin_amdgcn_readlane(__float_as_int(hv[1][q]), jj)) * w; }
#pragma unroll
        for (int e = 0; e < 2; ++e) {
            float y = acc[e];
            if (kv == 0) {
                const float rstd = rsqrtf(wave_sum(y * y) * (1.f / 64.f) + EPS);
                y = y * rstd * p.in[I_NKCG][lane];
                const int prow = b * SEQ + 16 * (n0 + e) + 31; const float oth = xorl<8>(y);
                if (lane < 16) { const int pr = (prow < MT) ? prow : MT - 1; const float c = ropeCN(p)[(size_t)pr * 8 + (lane & 7)], s = ropeSN(p)[(size_t)pr * 8 + (lane & 7)]; y = (lane < 8) ? y * c - oth * s : y * c + oth * s; }
            }
            if (n0 + e == 127) y = 0.f;
            dst[e * 128] = (bf16_t)f2bf(y);
        }
    }
}

DI unsigned select_blocks(const float (&imp)[32], int cur) {
    if (cur < 8) return (2u << cur) - 1u;
    unsigned mask = 1u | (1u << cur) | (1u << (cur - 1));
#pragma unroll 1
    for (int it = 0; it < 5; ++it) {
        float best = -1.0f; int bi = 1;
#pragma unroll
        for (int j = 1; j < 32; ++j) { const bool ok = (j <= cur - 2) && !((mask >> j) & 1u); if (ok && imp[j] > best) { best = imp[j]; bi = j; } }
        mask |= 1u << bi;
    }
    return mask;
}

namespace fa {
typedef short bf16x8 __attribute__((ext_vector_type(8)));
typedef short s16x4 __attribute__((ext_vector_type(4)));
typedef float f32x16 __attribute__((ext_vector_type(16)));
typedef LAS const char* lds_cptr;
typedef LAS char* lds_ptr;
constexpr int KBUF = 12288, VBUF = 8192;
constexpr int KCS = 1056;
constexpr int L_K = 0, L_V = 2 * KBUF, L_WS = 3 * 12 * KCS + 2 * 8192, L_OST = L_WS + 8 * 256, L_END = L_OST + 8 * 8192;
static_assert(L_V + 2 * VBUF <= L_WS && L_END <= 131072, "attention LDS map");
#define FA_SBAR() __builtin_amdgcn_sched_barrier(0)
DI int crow(int r, int hi) { return (r & 3) + 8 * (r >> 2) + 4 * hi; }
typedef float f32x2_t __attribute__((ext_vector_type(2))); typedef __bf16 bf16x2_t __attribute__((ext_vector_type(2)));
DI unsigned cvtpk(float lo, float hi) { f32x2_t v = {lo, hi}; bf16x2_t b = __builtin_convertvector(v, bf16x2_t); return __builtin_bit_cast(unsigned, b); }

template <int DK, int CS = 1024> DI void qkt(f32x16& p0, f32x16& p1, lds_cptr kb, const bf16x8* qr) {
    f32x16 z;
#pragma unroll
    for (int i = 0; i < 16; ++i) z[i] = 0.f;
#pragma unroll
    for (int d0 = 0; d0 < DK / 16; ++d0) {
        const bf16x8 b0 = *(const LAS bf16x8*)(kb + d0 * 2 * CS);
        const bf16x8 b1 = *(const LAS bf16x8*)(kb + d0 * 2 * CS + 512);
        if (d0 == 0) { p0 = __builtin_amdgcn_mfma_f32_32x32x16_bf16(b0, qr[0], z, 0, 0, 0); p1 = __builtin_amdgcn_mfma_f32_32x32x16_bf16(b1, qr[0], z, 0, 0, 0); }
        else { p0 = __builtin_amdgcn_mfma_f32_32x32x16_bf16(b0, qr[d0], p0, 0, 0, 0); p1 = __builtin_amdgcn_mfma_f32_32x32x16_bf16(b1, qr[d0], p1, 0, 0, 0); }
    }
}
typedef short v4i16_t __attribute__((ext_vector_type(4)));
DI s16x4 vtr(int addr) { return __builtin_bit_cast(s16x4, __builtin_amdgcn_ds_read_tr16_b64_v4i16((LAS v4i16_t*)(uintptr_t)(unsigned)addr)); }
DI bf16x8 vfrag(int addr) { const s16x4 lo = vtr(addr), hi = vtr(addr + 512); return (bf16x8){lo[0], lo[1], lo[2], lo[3], hi[0], hi[1], hi[2], hi[3]}; }
DI void pv(f32x16* o, int vb, bf16x8 pa0, bf16x8 pa1, bf16x8 pa2, bf16x8 pa3) {
#pragma unroll
    for (int d0 = 0; d0 < 2; ++d0) { s16x4 lo[4], hi[4];
#pragma unroll
        for (int ks = 0; ks < 4; ++ks) { lo[ks] = vtr(vb + d0 * 4096 + ks * 1024); hi[ks] = vtr(vb + d0 * 4096 + ks * 1024 + 512); }
#define FA_PK(k) (bf16x8){lo[k][0], lo[k][1], lo[k][2], lo[k][3], hi[k][0], hi[k][1], hi[k][2], hi[k][3]}
        o[d0] = __builtin_amdgcn_mfma_f32_32x32x16_bf16(pa0, FA_PK(0), o[d0], 0, 0, 0);
        o[d0] = __builtin_amdgcn_mfma_f32_32x32x16_bf16(pa1, FA_PK(1), o[d0], 0, 0, 0);
        o[d0] = __builtin_amdgcn_mfma_f32_32x32x16_bf16(pa2, FA_PK(2), o[d0], 0, 0, 0);
        o[d0] = __builtin_amdgcn_mfma_f32_32x32x16_bf16(pa3, FA_PK(3), o[d0], 0, 0, 0);
#undef FA_PK
    }
}
DI void pack_p(const f32x16& p0, const f32x16& p1, bf16x8& a0, bf16x8& a1, bf16x8& a2, bf16x8& a3) {
    u32x4 w0, w1, w2, w3;
    w0.x = cvtpk(p0[0], p0[1]); w0.y = cvtpk(p0[2], p0[3]); w0.z = cvtpk(p0[4], p0[5]); w0.w = cvtpk(p0[6], p0[7]);
    w1.x = cvtpk(p0[8], p0[9]); w1.y = cvtpk(p0[10], p0[11]); w1.z = cvtpk(p0[12], p0[13]); w1.w = cvtpk(p0[14], p0[15]);
    w2.x = cvtpk(p1[0], p1[1]); w2.y = cvtpk(p1[2], p1[3]); w2.z = cvtpk(p1[4], p1[5]); w2.w = cvtpk(p1[6], p1[7]);
    w3.x = cvtpk(p1[8], p1[9]); w3.y = cvtpk(p1[10], p1[11]); w3.z = cvtpk(p1[12], p1[13]); w3.w = cvtpk(p1[14], p1[15]);
    a0 = __builtin_bit_cast(bf16x8, w0); a1 = __builtin_bit_cast(bf16x8, w1); a2 = __builtin_bit_cast(bf16x8, w2); a3 = __builtin_bit_cast(bf16x8, w3);
}
DI void mask_range(f32x16& p0, f32x16& p1, int key0, int lo, int hi_, int hf) {
#pragma unroll
    for (int r = 0; r < 16; ++r) { const int k = key0 + crow(r, hf); if (k < lo || k > hi_) p0[r] = -INFINITY; if (k + 32 < lo || k + 32 > hi_) p1[r] = -INFINITY; }
}
DI float max3(float a, float b, float c) { return fmaxf(fmaxf(a, b), c); }
DI float rowmax32(const f32x16& p0, const f32x16& p1) {
    float a = max3(p0[0], p0[1], p0[2]), b = max3(p0[3], p0[4], p0[5]), c = max3(p0[6], p0[7], p0[8]), d = max3(p0[9], p0[10], p0[11]);
    a = max3(a, p0[12], p0[13]); b = max3(b, p0[14], p0[15]); c = max3(c, p1[0], p1[1]); d = max3(d, p1[2], p1[3]);
    a = max3(a, p1[4], p1[5]); b = max3(b, p1[6], p1[7]); c = max3(c, p1[8], p1[9]); d = max3(d, p1[10], p1[11]);
    a = max3(a, p1[12], p1[13]); b = max3(b, p1[14], p1[15]);
    return max32(fmaxf(fmaxf(a, b), fmaxf(c, d)));
}
struct State { float m, l; f32x16 o[2]; };
DI void st_init(State& s) { s.m = -INFINITY; s.l = 0.f;
#pragma unroll
    for (int i = 0; i < 16; ++i) { s.o[0][i] = 0.f; s.o[1][i] = 0.f; } }
DI void softmax_pv(State& st, f32x16& p0, f32x16& p1, int vb, LAS float* wsf, int r32, int hf) {
    const float rm = rowmax32(p0, p1);
    const float mn = fmaxf(st.m, rm), mu = (mn == -INFINITY) ? 0.f : mn;
    const float alpha = __builtin_amdgcn_exp2f(st.m - mu);
    st.m = mn;
    float ls0 = 0.f, ls1 = 0.f, ls2 = 0.f, ls3 = 0.f;
#pragma unroll
    for (int r = 0; r < 16; r += 2) { p0[r] = __builtin_amdgcn_exp2f(p0[r] - mu); p1[r] = __builtin_amdgcn_exp2f(p1[r] - mu); p0[r + 1] = __builtin_amdgcn_exp2f(p0[r + 1] - mu); p1[r + 1] = __builtin_amdgcn_exp2f(p1[r + 1] - mu);
        ls0 += p0[r]; ls1 += p1[r]; ls2 += p0[r + 1]; ls3 += p1[r + 1]; }
    st.l = st.l * alpha + ((ls0 + ls1) + (ls2 + ls3));
    if (__any(alpha != 1.0f)) {
        if (hf == 0) wsf[r32] = alpha;
        asm volatile("s_waitcnt lgkmcnt(0)" ::: "memory");
#pragma unroll
        for (int g = 0; g < 4; ++g) { const f32x4 a = *(const LAS f32x4*)(wsf + 8 * g + 4 * hf);
            st.o[0][4 * g] *= a.x; st.o[0][4 * g + 1] *= a.y; st.o[0][4 * g + 2] *= a.z; st.o[0][4 * g + 3] *= a.w;
            st.o[1][4 * g] *= a.x; st.o[1][4 * g + 1] *= a.y; st.o[1][4 * g + 2] *= a.z; st.o[1][4 * g + 3] *= a.w; }
    }
    bf16x8 a0, a1, a2, a3; pack_p(p0, p1, a0, a1, a2, a3);
    pv(st.o, vb, a0, a1, a2, a3);
}
DI void accum_scaled(f32x16* acc, const f32x16* o, float fac_row, LAS float* wsf, int r32, int hf) {
    if (hf == 0) wsf[32 + r32] = fac_row;
    asm volatile("s_waitcnt lgkmcnt(0)" ::: "memory");
#pragma unroll
    for (int g = 0; g < 4; ++g) { const f32x4 a = *(const LAS f32x4*)(wsf + 32 + 8 * g + 4 * hf);
        acc[0][4 * g] += o[0][4 * g] * a.x; acc[0][4 * g + 1] += o[0][4 * g + 1] * a.y; acc[0][4 * g + 2] += o[0][4 * g + 2] * a.z; acc[0][4 * g + 3] += o[0][4 * g + 3] * a.w;
        acc[1][4 * g] += o[1][4 * g] * a.x; acc[1][4 * g + 1] += o[1][4 * g + 1] * a.y; acc[1][4 * g + 2] += o[1][4 * g + 2] * a.z; acc[1][4 * g + 3] += o[1][4 * g + 3] * a.w; }
}
template <bool FIRST> DI void accum_lds(LAS float* accw, const f32x16* o, float fac_row, LAS float* wsf, int r32, int hf) {
    if (hf == 0) wsf[32 + r32] = fac_row;
    asm volatile("s_waitcnt lgkmcnt(0)" ::: "memory");
#pragma unroll
    for (int r = 0; r < 16; ++r) { const int orow = crow(r, hf); const float a = wsf[32 + orow];
        LAS float* d0 = accw + orow * 64 + r32; LAS float* d1 = d0 + 32;
        if (FIRST) { *d0 = o[0][r] * a; *d1 = o[1][r] * a; } else { *d0 += o[0][r] * a; *d1 += o[1][r] * a; } }
}
DI void stage_rows(const f32x16* acc, LAS bf16_t* stg, int r32, int hf) {
#pragma unroll
    for (int r = 0; r < 16; ++r) { const int orow = crow(r, hf);
        stg[orow * 64 + r32] = (bf16_t)f2bf(acc[0][r]); stg[orow * 64 + 32 + r32] = (bf16_t)f2bf(acc[1][r]); }
    asm volatile("s_waitcnt lgkmcnt(0)" ::: "memory");
}

struct TileSrc { const unsigned char* k; const unsigned char* v; unsigned ko, vo; long kstep, vstep; int klds; bool k2on; };
#ifndef FA_THRL
#define FA_THRL 8.0f
#endif
template <int DK, class MaskF>
DI void pipe_attn(LAS unsigned char* lds, const TileSrc src, int T, const bf16x8 (&qr)[DK / 16], const MaskF& maskf, f32x16 (&o)[2], float& l_out,
                  int wv, int lane, int r32, int hf, LAS float* wsf) {
    constexpr int KB = (DK / 8) * KCS;
    constexpr int PL_V = 3 * KB;
    const LAS unsigned char* kfrag0 = lds + L_K + hf * KCS + r32 * 16;
    const int vfrag0 = (int)(uintptr_t)(lds + L_K + PL_V) + ((lane >> 4) & 1) * 32 + (lane & 3) * 8 + (4 * hf + ((lane & 15) >> 2)) * 64;
    LAS unsigned char* kst0 = lds + L_K + src.klds; LAS unsigned char* kst1 = kst0 + 32 * 16; LAS unsigned char* vst0 = lds + L_K + PL_V + wv * 1024 + lane * 16;
    u32x4 kreg, kreg2, vreg;
    const bool k2on = (DK == 96) && src.k2on, kon = (DK == 64) || src.k2on;
#define PL_KADDR(i) (src.k + (long)(i) * src.kstep)
#define PL_KLOAD(i) do { if (kon) kreg = *(const u32x4*)(PL_KADDR(i) + (size_t)src.ko); if (k2on) kreg2 = *(const u32x4*)(PL_KADDR(i) + 32 * 768 * 2 + (size_t)src.ko); } while (0)
#define PL_KSTORE(buf) do { if (kon) *(LAS u32x4*)(kst0 + (buf) * KB) = kreg; if (k2on) *(LAS u32x4*)(kst1 + (buf) * KB) = kreg2; } while (0)
#define PL_VLOAD(i) (vreg = *(const u32x4*)(src.v + (long)(i) * src.vstep + (size_t)src.vo))
    __syncthreads();
    { u32x4 ka_, kb_, kc_, ka2_, kb2_, kc2_; const int t1 = (T > 1) ? 1 : 0, t2 = (T > 2) ? 2 : 0;
      if (kon) { ka_ = *(const u32x4*)(PL_KADDR(0) + (size_t)src.ko); kb_ = *(const u32x4*)(PL_KADDR(t1) + (size_t)src.ko); kc_ = *(const u32x4*)(PL_KADDR(t2) + (size_t)src.ko); } PL_VLOAD(0);
      if (k2on) { ka2_ = *(const u32x4*)(PL_KADDR(0) + 32 * 768 * 2 + (size_t)src.ko); kb2_ = *(const u32x4*)(PL_KADDR(t1) + 32 * 768 * 2 + (size_t)src.ko); kc2_ = *(const u32x4*)(PL_KADDR(t2) + 32 * 768 * 2 + (size_t)src.ko); }
      if (kon) { *(LAS u32x4*)(kst0) = ka_; *(LAS u32x4*)(kst0 + KB) = kb_; *(LAS u32x4*)(kst0 + 2 * KB) = kc_; } *(LAS u32x4*)(vst0) = vreg;
      if (k2on) { *(LAS u32x4*)(kst1) = ka2_; *(LAS u32x4*)(kst1 + KB) = kb2_; *(LAS u32x4*)(kst1 + 2 * KB) = kc2_; } }
    if (T > 3) PL_KLOAD(3);
    if (T > 1) PL_VLOAD(1);
    __syncthreads();
    float mhat, l_reg = 0.f; f32x16 negm; bool resc = false;
    f32x16 pA0, pA1, pB0, pB1;
#pragma unroll
    for (int i = 0; i < 16; ++i) { o[0][i] = 0.f; o[1][i] = 0.f; }
    qkt<DK, KCS>(pA0, pA1, (lds_cptr)kfrag0, qr); maskf(pA0, pA1, 0);
    { const float rm = rowmax32(pA0, pA1); mhat = rm;
#pragma unroll
      for (int r = 0; r < 16; ++r) { pA0[r] = __builtin_amdgcn_exp2f(pA0[r] - rm); pA1[r] = __builtin_amdgcn_exp2f(pA1[r] - rm); negm[r] = -rm; }
      asm volatile("" : "+v"(negm)); }
    __syncthreads();
    u32x4 pw0, pw1, pw2, pw3;
    int kb_cur = 1, kb_st = 0, vb_prev = 0;
#define PL_PIN(x) asm volatile("" : "+v"(x))
#define PL_SB() __builtin_amdgcn_sched_barrier(0)
#define PL_KF(j) (*(const LAS bf16x8*)(kp_ + ((j) >> 1) * 2 * KCS + ((j) & 1) * 512))
#define PL_VF(i) vfrag(vp_ + ((i) >> 2) * 4096 + ((i) & 3) * 1024)
#define PL_PAF(k) __builtin_bit_cast(bf16x8, pw##k)
#define PL_WORK(A0, A1, A2, A3, W0, W1, PW) do { sacc += A0; sacc += A1; sacc += A2; sacc += A3; PL_PIN(sacc); W0; W1; PL_PIN(PW); } while (0)
#define PL_GAPB(MF, X, B) do { MF; X[B] = __builtin_amdgcn_exp2f(X[B]); X[B + 1] = __builtin_amdgcn_exp2f(X[B + 1]); X[B + 2] = __builtin_amdgcn_exp2f(X[B + 2]); X[B + 3] = __builtin_amdgcn_exp2f(X[B + 3]); PL_PIN(X); PL_SB(); } while (0)
#define PL_MF(a, b, c) ({ __builtin_amdgcn_s_setprio(1); __builtin_amdgcn_sched_barrier(0); f32x16 r__ = __builtin_amdgcn_mfma_f32_32x32x16_bf16(a, b, c, 0, 0, 0); __builtin_amdgcn_sched_barrier(0); __builtin_amdgcn_s_setprio(0); r__; })
#define PL_STEP(C0, C1, P0, P1, t) do { const int t_ = (t); \
        if (t_ + 2 < T) PL_KSTORE(kb_st); \
        *(LAS u32x4*)(vst0 + (vb_prev ^ 1) * 8192) = vreg; \
        if (t_ + 3 < T) PL_KLOAD(t_ + 3); if (t_ + 1 < T) PL_VLOAD(t_ + 1); \
        PL_SB(); const LAS unsigned char* kp_ = kfrag0 + kb_cur * KB; const int vp_ = vfrag0 + vb_prev * 8192; \
        bf16x8 k0 = PL_KF(0), k1 = PL_KF(1), k2 = PL_KF(2); PL_SB(); float sacc = (P0[0] + P0[1]); \
        C0 = PL_MF(k0, qr[0], negm); k0 = PL_KF(3); PL_WORK(P0[2], P0[3], P0[4], P0[5],     pw0[0] = cvtpk(P0[0], P0[1]),   pw0[1] = cvtpk(P0[2], P0[3]),   pw0); PL_SB(); \
        C1 = PL_MF(k1, qr[0], negm); k1 = PL_KF(4); PL_WORK(P0[6], P0[7], P0[8], P0[9],     pw0[2] = cvtpk(P0[4], P0[5]),   pw0[3] = cvtpk(P0[6], P0[7]),   pw0); PL_SB(); \
        C0 = PL_MF(k2, qr[1], C0);   k2 = PL_KF(5); PL_WORK(P0[10], P0[11], P0[12], P0[13], pw1[0] = cvtpk(P0[8], P0[9]),   pw1[1] = cvtpk(P0[10], P0[11]), pw1); PL_SB(); \
        C1 = PL_MF(k0, qr[1], C1);   k0 = PL_KF(6); PL_WORK(P0[14], P0[15], P1[0], P1[1],   pw1[2] = cvtpk(P0[12], P0[13]), pw1[3] = cvtpk(P0[14], P0[15]), pw1); PL_SB(); \
        C0 = PL_MF(k1, qr[2], C0);   k1 = PL_KF(7); PL_WORK(P1[2], P1[3], P1[4], P1[5],     pw2[0] = cvtpk(P1[0], P1[1]),   pw2[1] = cvtpk(P1[2], P1[3]),   pw2); PL_SB(); \
        C1 = PL_MF(k2, qr[2], C1);   if (DK == 96) k2 = PL_KF(8); PL_WORK(P1[6], P1[7], P1[8], P1[9],     pw2[2] = cvtpk(P1[4], P1[5]),   pw2[3] = cvtpk(P1[6], P1[7]),   pw2); PL_SB(); \
        C0 = PL_MF(k0, qr[3], C0);   if (DK == 96) k0 = PL_KF(9); PL_WORK(P1[10], P1[11], P1[12], P1[13], pw3[0] = cvtpk(P1[8], P1[9]),   pw3[1] = cvtpk(P1[10], P1[11]), pw3); PL_SB(); \
        C1 = PL_MF(k1, qr[3], C1);   if (DK == 96) k1 = PL_KF(10); PL_WORK(P1[14], P1[15], 0.f, 0.f,       pw3[2] = cvtpk(P1[12], P1[13]), pw3[3] = cvtpk(P1[14], P1[15]), pw3); PL_SB(); \
        if (DK == 96) { C0 = PL_MF(k2, qr[DK / 16 - 2], C0); k2 = PL_KF(11); PL_SB(); C1 = PL_MF(k0, qr[DK / 16 - 2], C1); PL_SB(); C0 = PL_MF(k1, qr[DK / 16 - 1], C0); PL_SB(); C1 = PL_MF(k2, qr[DK / 16 - 1], C1); PL_SB(); } \
        l_reg += sacc; \
        bf16x8 v0 = PL_VF(0), v1 = PL_VF(4), v2 = PL_VF(1); \
        maskf(C0, C1, t_); \
        { const float rm = rowmax32(C0, C1); resc = false; \
          if (__builtin_expect(__any(rm > FA_THRL), 0)) { const float dl = fmaxf(rm, 0.f); mhat += dl; \
              _Pragma("unroll") for (int r = 0; r < 16; ++r) { C0[r] -= dl; C1[r] -= dl; } \
              _Pragma("unroll") for (int r = 0; r < 16; ++r) negm[r] = -mhat; \
              asm volatile("" : "+v"(negm)); \
              const float f_ = __builtin_amdgcn_exp2f(-dl); l_reg *= f_; if (hf == 0) wsf[r32] = f_; resc = true; } } \
        PL_SB(); \
        PL_GAPB(o[0] = PL_MF(PL_PAF(0), v0, o[0]); v0 = PL_VF(5), C0, 0); \
        PL_GAPB(o[1] = PL_MF(PL_PAF(0), v1, o[1]); v1 = PL_VF(2), C0, 4); \
        PL_GAPB(o[0] = PL_MF(PL_PAF(1), v2, o[0]); v2 = PL_VF(6), C0, 8); \
        PL_GAPB(o[1] = PL_MF(PL_PAF(1), v0, o[1]); v0 = PL_VF(3), C0, 12); \
        PL_GAPB(o[0] = PL_MF(PL_PAF(2), v1, o[0]); v1 = PL_VF(7), C1, 0); \
        PL_GAPB(o[1] = PL_MF(PL_PAF(2), v2, o[1]), C1, 4); \
        PL_GAPB(o[0] = PL_MF(PL_PAF(3), v0, o[0]), C1, 8); \
        PL_GAPB(o[1] = PL_MF(PL_PAF(3), v1, o[1]), C1, 12); \
        __syncthreads(); \
        if (resc) { \
            _Pragma("unroll") for (int g_ = 0; g_ < 4; ++g_) { const f32x4 a_ = *(const LAS f32x4*)(wsf + 8 * g_ + 4 * hf); \
                o[0][4 * g_] *= a_.x; o[0][4 * g_ + 1] *= a_.y; o[0][4 * g_ + 2] *= a_.z; o[0][4 * g_ + 3] *= a_.w; o[1][4 * g_] *= a_.x; o[1][4 * g_ + 1] *= a_.y; o[1][4 * g_ + 2] *= a_.z; o[1][4 * g_ + 3] *= a_.w; } } \
        kb_cur = (kb_cur == 2) ? 0 : kb_cur + 1; kb_st = (kb_st == 2) ? 0 : kb_st + 1; vb_prev ^= 1; \
    } while (0)
    int t = 1;
    for (; t + 1 < T; t += 2) { PL_STEP(pB0, pB1, pA0, pA1, t); PL_STEP(pA0, pA1, pB0, pB1, t + 1); }
    const bool tail = t < T;
    if (tail) PL_STEP(pB0, pB1, pA0, pA1, t);
#define PL_DRAIN(P0, P1) do { float sacc = 0.f; _Pragma("unroll") for (int r = 0; r < 16; ++r) sacc += P0[r] + P1[r]; l_reg += sacc; \
        bf16x8 a0_, a1_, a2_, a3_; pack_p(P0, P1, a0_, a1_, a2_, a3_); pv(o, vfrag0 + vb_prev * 8192, a0_, a1_, a2_, a3_); } while (0)
    if (tail) PL_DRAIN(pB0, pB1); else PL_DRAIN(pA0, pA1);
    l_out = l_reg;
    __syncthreads();
#undef PL_KLOAD
#undef PL_KADDR
#undef PL_KSTORE
#undef PL_VLOAD
#undef PL_PIN
#undef PL_SB
#undef PL_KF
#undef PL_VF
#undef PL_PAF
#undef PL_WORK
#undef PL_GAPB
#undef PL_MF
#undef PL_STEP
#undef PL_DRAIN
}

DI void mla_unit(const Params& p, LAS unsigned char* lds, int b, int h, int qb, int wid0) {
    const int tid = opaque_tid(wid0), lane = tid & 63, r32 = lane & 31, hf = lane >> 5; const int wv = __builtin_amdgcn_readfirstlane(tid >> 6);
    const bf16_t* KN = wsp<bf16_t>(p, WS_KN); const bf16_t* VM = wsp<bf16_t>(p, WS_VM); bf16_t* OC = wsp<bf16_t>(p, WS_R1);
    const int rowbase = b * SEQ, q0 = qb * 256, tq = q0 + wv * 32 + r32, row = rowbase + tq;
    LAS float* wsf = (LAS float*)(lds + L_WS) + wv * 64;
    bf16x8 qr[6];
    {
        const bf16_t* src = qraw(p) + (size_t)row * 768 + h * 96 + 8 * hf; float q[6][8]; float ss = 0.f;
#pragma unroll
        for (int d0 = 0; d0 < 6; ++d0) { unpack8(*(const u32x4*)(src + 16 * d0), q[d0]);
#pragma unroll
            for (int e = 0; e < 8; ++e) ss += q[d0][e] * q[d0][e]; }
        ss = sum32(ss);
        const float rstd = rsqrtf(ss * (1.f / 96.f) + EPS); const float* qg = p.in[I_MQG] + 8 * hf; const float* kg = p.in[I_MKG] + 8 * hf;
#pragma unroll
        for (int d0 = 0; d0 < 6; ++d0)
#pragma unroll
            for (int e = 0; e < 8; ++e) q[d0][e] *= rstd * qg[16 * d0 + e];
        const float* cs = ropeCM(p) + (size_t)row * 16 + 8 * hf; const float* sn = ropeSM(p) + (size_t)row * 16 + 8 * hf;
#pragma unroll
        for (int e = 0; e < 8; ++e) { const float x1 = q[4][e], x2 = q[5][e]; q[4][e] = x1 * cs[e] - x2 * sn[e]; q[5][e] = x2 * cs[e] + x1 * sn[e]; }
#pragma unroll
        for (int d0 = 0; d0 < 6; ++d0) { float f[8];
#pragma unroll
            for (int e = 0; e < 8; ++e) f[e] = q[d0][e] * ((d0 < 4) ? kg[16 * d0 + e] * C2M : C2M);
            qr[d0] = __builtin_bit_cast(bf16x8, pack8(f)); }
    }
    const int NT = 4 * (qb + 1);
    TileSrc src; { const int k1 = tid / 12, c1 = tid % 12;
        src.k = (const unsigned char*)(KN + (size_t)rowbase * 768 + h * 96); src.ko = (unsigned)(k1 * 768 + c1 * 8) * 2u; src.klds = c1 * KCS + k1 * 16; src.k2on = wv < 6; }
    src.kstep = 64 * 768 * 2;
    src.v = (const unsigned char*)(VM + (size_t)rowbase * 512 + h * 64); src.vo = (unsigned)((16 * (wv & 3) + (lane >> 2)) * 512 + (wv >> 2) * 32 + (lane & 3) * 8) * 2u; src.vstep = 64 * 512 * 2;
    const int qlo = q0 + wv * 32;
    auto mk = [&](f32x16& p0, f32x16& p1, int i) { if (i * 64 + 63 > qlo) mask_range(p0, p1, i * 64, 0, tq, hf); };
    f32x16 ob[2]; float lb;
    pipe_attn<96>(lds, src, NT, qr, mk, ob, lb, wv, lane, r32, hf, wsf);
    const float lt = sum32(lb);
    f32x16 acc[2];
#pragma unroll
    for (int i = 0; i < 16; ++i) { acc[0][i] = 0.f; acc[1][i] = 0.f; }
    accum_scaled(acc, ob, 1.0f / lt, wsf, r32, hf);
    LAS bf16_t* stg = (LAS bf16_t*)(lds + L_OST) + wv * 4096;
    stage_rows(acc, stg, r32, hf);
#pragma unroll
    for (int i = 0; i < 4; ++i) { const int rr = i * 8 + (lane >> 3), ch = lane & 7; const u32x4 v = *(const LAS u32x4*)(stg + rr * 64 + ch * 8);
        st16(OC + (size_t)(rowbase + q0 + wv * 32 + rr) * 1024 + h * 64 + ch * 8, v); }
}

DI void nsa_unit(const Params& p, LAS unsigned char* lds, int b, int g, int c, int wid0) {
    const int tid = opaque_tid(wid0), lane = tid & 63, r32 = lane & 31, hf = lane >> 5; const int wv = __builtin_amdgcn_readfirstlane(tid >> 6);
    const bf16_t* QN = wsp<bf16_t>(p, WS_QN); const bf16_t* KCF = wsp<bf16_t>(p, WS_KCF); const bf16_t* VCF = wsp<bf16_t>(p, WS_VCF);
    const bf16_t* KS = wsp<bf16_t>(p, WS_KS); const bf16_t* VS = wsp<bf16_t>(p, WS_VS); const bf16_t* KW = wsp<bf16_t>(p, WS_KW); const bf16_t* VW = wsp<bf16_t>(p, WS_VW);
    const bf16_t* GN = wsp<bf16_t>(p, WS_GN); bf16_t* OC = wsp<bf16_t>(p, WS_R1);
    const int rowbase = b * SEQ, tt = 8 * wv + (r32 >> 2), hd = g * 4 + (r32 & 3), tq = 64 * c + tt, row = rowbase + tq;
    LAS float* wsf = (LAS float*)(lds + L_WS) + wv * 64;
    bf16x8 qr[4];
#pragma unroll
    for (int d0 = 0; d0 < 4; ++d0) qr[d0] = *(const bf16x8*)(QN + (size_t)row * 512 + hd * 64 + 16 * d0 + 8 * hf);
    LAS float* accw = (LAS float*)(lds + L_OST) + wv * 2048;
    const int vboff = ((lane >> 4) & 1) * 32 + (lane & 3) * 8 + (4 * hf + ((lane & 15) >> 2)) * 64;
    u32x4 ka, vv;
#define NSA_LOAD(KB, VB, krow0) do { ka = *(const u32x4*)((KB) + (size_t)((krow0) + lane) * 128 + g * 64 + wv * 8); \
        vv = *(const u32x4*)((VB) + (size_t)((krow0) + 16 * (wv & 3) + (lane >> 2)) * 128 + g * 64 + (wv >> 2) * 32 + (lane & 3) * 8); } while (0)
#define NSA_STORE(koff, voff) do { *(LAS u32x4*)(lds + (koff) + wv * 1024 + lane * 16) = ka; *(LAS u32x4*)(lds + (voff) + wv * 1024 + lane * 16) = vv; } while (0)
    unsigned selmask;
    {
        const int ntile = (4 * c + 3 > 64) ? 2 : 1;
        const int nmax = (tq >= 31) ? ((tq - 31) >> 4) : -1;
        __syncthreads();
        { NSA_LOAD(KCF, VCF, b * 128); const u32x4 ka1_ = ka, vv1_ = vv; if (ntile == 2) NSA_LOAD(KCF, VCF, b * 128 + 64);
          *(LAS u32x4*)(lds + L_K + wv * 1024 + lane * 16) = ka1_; *(LAS u32x4*)(lds + L_V + wv * 1024 + lane * 16) = vv1_; if (ntile == 2) NSA_STORE(L_K + 8192, L_V + 8192); }
        __syncthreads();
        f32x16 pa0, pa1, pb0, pb1;
        qkt<64>(pa0, pa1, (lds_cptr)(lds + L_K) + hf * 1024 + r32 * 16, qr); mask_range(pa0, pa1, 0, 0, nmax, hf);
        float m = rowmax32(pa0, pa1);
        if (ntile == 2) { qkt<64>(pb0, pb1, (lds_cptr)(lds + L_K + 8192) + hf * 1024 + r32 * 16, qr); mask_range(pb0, pb1, 64, 0, nmax, hf); m = fmaxf(m, rowmax32(pb0, pb1)); }
        else {
#pragma unroll
            for (int i = 0; i < 16; ++i) { pb0[i] = -INFINITY; pb1[i] = -INFINITY; } }
        const float mu = (m == -INFINITY) ? 0.f : m;
        float ls = 0.f;
#pragma unroll
        for (int r = 0; r < 16; ++r) { pa0[r] = __builtin_amdgcn_exp2f(pa0[r] - mu); pa1[r] = __builtin_amdgcn_exp2f(pa1[r] - mu); pb0[r] = __builtin_amdgcn_exp2f(pb0[r] - mu); pb1[r] = __builtin_amdgcn_exp2f(pb1[r] - mu);
            ls += (pa0[r] + pa1[r]) + (pb0[r] + pb1[r]); }
        ls = sum32(ls);
        const float rl = (ls > 0.f) ? 1.0f / ls : 0.f;
#pragma unroll
        for (int r = 0; r < 16; ++r) { pa0[r] *= rl; pa1[r] *= rl; pb0[r] *= rl; pb1[r] *= rl; }
        float own[16], ee[16];
#pragma unroll
        for (int q = 0; q < 4; ++q) {
            own[q] = (pa0[4 * q] + pa0[4 * q + 1]) + (pa0[4 * q + 2] + pa0[4 * q + 3]); ee[q] = pa0[4 * q + 3];
            own[4 + q] = (pa1[4 * q] + pa1[4 * q + 1]) + (pa1[4 * q + 2] + pa1[4 * q + 3]); ee[4 + q] = pa1[4 * q + 3];
            own[8 + q] = (pb0[4 * q] + pb0[4 * q + 1]) + (pb0[4 * q + 2] + pb0[4 * q + 3]); ee[8 + q] = pb0[4 * q + 3];
            own[12 + q] = (pb1[4 * q] + pb1[4 * q + 1]) + (pb1[4 * q + 2] + pb1[4 * q + 3]); ee[12 + q] = pb1[4 * q + 3]; }
        float eo[16];
#pragma unroll
        for (int k = 0; k < 16; ++k) eo[k] = xor32(ee[k], hf);
#pragma unroll
        for (int k = 0; k < 16; ++k) { const float add = hf ? eo[k] : ((k > 0) ? eo[k - 1] : 0.f); own[k] += add; }
#pragma unroll
        for (int k = 0; k < 16; ++k) { own[k] += xorl<1>(own[k]); own[k] += xorl<2>(own[k]); }
        float imp[32];
#pragma unroll
        for (int k = 0; k < 16; ++k) { const float oth = xor32(own[k], hf); imp[2 * k] = hf ? oth : own[k]; imp[2 * k + 1] = hf ? own[k] : oth; }
        selmask = select_blocks(imp, c);
        State sc; st_init(sc);
        { bf16x8 a0, a1, a2, a3; pack_p(pa0, pa1, a0, a1, a2, a3); pv(sc.o, (int)(uintptr_t)(lds + L_V) + vboff, a0, a1, a2, a3); }
        if (ntile == 2) { bf16x8 a0, a1, a2, a3; pack_p(pb0, pb1, a0, a1, a2, a3); pv(sc.o, (int)(uintptr_t)(lds + L_V + 8192) + vboff, a0, a1, a2, a3); }
        accum_lds<true>(accw, sc.o, bf2f(GN[(size_t)row * 32 + hd * 3]), wsf, r32, hf);
    }
#pragma unroll 1
    for (int br = 1; br < 3; ++br) {
        const bf16_t* KB = (br == 1) ? KS : KW; const bf16_t* VB = (br == 1) ? VS : VW;
        const int NT = (br == 1) ? (c + 1) : ((c + 1 < 5) ? c + 1 : 5);
        TileSrc src; src.k = (const unsigned char*)(KB + (size_t)(rowbase + c * 64) * 128 + g * 64); src.ko = (unsigned)((wv * 8 + (lane >> 3)) * 128 + (lane & 7) * 8) * 2u;
        src.klds = (lane & 7) * KCS + (wv * 8 + (lane >> 3)) * 16; src.k2on = false;
        src.v = (const unsigned char*)(VB + (size_t)(rowbase + c * 64) * 128 + g * 64); src.vo = (unsigned)((16 * (wv & 3) + (lane >> 2)) * 128 + (wv >> 2) * 32 + (lane & 3) * 8) * 2u;
        src.kstep = -64 * 128 * 2; src.vstep = -64 * 128 * 2;
        f32x16 ob[2]; float lb;
        if (br == 1) {
            auto mk = [&](f32x16& p0, f32x16& p1, int i) { const int j = c - i;
                if (i == 0) mask_range(p0, p1, j * 64, 0, tq, hf);
                if (!((selmask >> j) & 1u)) {
#pragma unroll
                    for (int r = 0; r < 16; ++r) { p0[r] = -INFINITY; p1[r] = -INFINITY; } } };
            pipe_attn<64>(lds, src, NT, qr, mk, ob, lb, wv, lane, r32, hf, wsf);
        } else {
            const int lo = tq - 255;
            auto mk = [&](f32x16& p0, f32x16& p1, int i) { if (i == 0 || i == 4) mask_range(p0, p1, (c - i) * 64, lo, tq, hf); };
            pipe_attn<64>(lds, src, NT, qr, mk, ob, lb, wv, lane, r32, hf, wsf);
        }
        const float lt = sum32(lb);
        accum_lds<false>(accw, ob, bf2f(GN[(size_t)row * 32 + hd * 3 + br]) / lt, wsf, r32, hf);
    }
#undef NSA_LOAD
#undef NSA_STORE
    asm volatile("s_waitcnt lgkmcnt(0)" ::: "memory");
#pragma unroll
    for (int i = 0; i < 4; ++i) { const int rr = i * 8 + (lane >> 3), ch = lane & 7; const f32x4 a = *(const LAS f32x4*)(accw + rr * 64 + ch * 8), b2 = *(const LAS f32x4*)(accw + rr * 64 + ch * 8 + 4);
        u32x4 v; v.x = pk2(a.x, a.y); v.y = pk2(a.z, a.w); v.z = pk2(b2.x, b2.y); v.w = pk2(b2.z, b2.w);
        st16(OC + (size_t)(rowbase + 64 * c + 8 * wv + (rr >> 2)) * 1024 + 512 + (g * 4 + (rr & 3)) * 64 + ch * 8, v); }
}
#undef FA_SBAR
}

DI void stage_attn_fast(const Params& p, LAS unsigned char* lds, int bid, int nb, bool do_mla, bool do_nsa, int wid0) {
    const int v0 = (nb % 8 == 0) ? (bid % 8) * (nb / 8) + bid / 8 : bid;
    if (do_mla) for (int u = v0; u < 256; u += nb) { const int bh = u >> 2, s = u & 3; fa::mla_unit(p, lds, bh >> 3, bh & 7, 7 - s, wid0); fa::mla_unit(p, lds, bh >> 3, bh & 7, s, wid0); }
    if (do_nsa) for (int u = v0; u < 256; u += nb) { const int bg = u >> 4, s = u & 15; fa::nsa_unit(p, lds, bg >> 1, bg & 1, 31 - s, wid0); fa::nsa_unit(p, lds, bg >> 1, bg & 1, s, wid0); }
    __syncthreads();
}
#define XB_TMO      128
#define XB_XCNT(j)  (256  + 64 * (j))
#define XB_XSUB(j)  (1280 + 64 * (j))
#define XB_XGEN(j)  (2304 + 64 * (j))
#define XB_TOP      3328
#define XB_TOPGEN   3392
#define XCD_BAR_WORDS 3456
#define XB_SPIN_CAP (1u << 18)

__device__ __forceinline__ unsigned xb_ld(unsigned* p)              { return __hip_atomic_load(p, __ATOMIC_RELAXED, __HIP_MEMORY_SCOPE_AGENT); }
__device__ __forceinline__ unsigned xb_add(unsigned* p, unsigned v) { return __hip_atomic_fetch_add(p, v, __ATOMIC_RELAXED, __HIP_MEMORY_SCOPE_AGENT); }
__device__ __forceinline__ unsigned xb_xcc_id() { return (unsigned)__builtin_amdgcn_s_getreg((3 << 11) | 20) & 0xFu; }
#define XB_SPIN(cond, bar) do { unsigned _sp = 0; while (cond) { __builtin_amdgcn_s_sleep(1); \
    if ((++_sp & 255u) == 0u) { if (xb_ld(&(bar)[XB_TMO])) break; if (_sp > XB_SPIN_CAP) { atomicAdd(&(bar)[XB_TMO], 1u); break; } } } } while (0)

struct XcdBarrier {
    unsigned* bar; unsigned x;
    volatile LAS unsigned* st;
};

__device__ __forceinline__ XcdBarrier xcd_barrier_post(unsigned* bar, volatile LAS unsigned* st, bool t0) {
    XcdBarrier b; b.bar = bar; b.x = xb_xcc_id(); b.st = st;
    if (t0) (void)xb_add(&bar[XB_XCNT(b.x)], 1u);
    return b;
}
__device__ __forceinline__ void xcd_barrier_complete(unsigned* bar, unsigned x, unsigned& nloc, unsigned& nx) {
    const unsigned G = gridDim.x * gridDim.y * gridDim.z;
    unsigned sum, cnt, mine, sp = 0u;
    for (;;) {
        sum = 0u; cnt = 0u; mine = 0u;
#pragma unroll
        for (unsigned j = 0; j < 16; ++j) { const unsigned c = xb_ld(&bar[XB_XCNT(j)]); sum += c; cnt += (c > 0u) ? 1u : 0u; mine = (j == x) ? c : mine; }
        if (sum == G) break;
        __builtin_amdgcn_s_sleep(1);
        if ((++sp & 255u) == 0u) { if (xb_ld(&bar[XB_TMO])) break; if (sp > XB_SPIN_CAP) { atomicAdd(&bar[XB_TMO], 1u); break; } }
    }
    nloc = mine > 0u ? mine : 1u; nx = cnt > 0u ? cnt : 1u;
}

__device__ __forceinline__ void xcd_barrier(const XcdBarrier& b, bool t0) {
    asm volatile("s_waitcnt vmcnt(0)" ::: "memory");
    __syncthreads();
    if (t0) {
        unsigned* bar = b.bar;
        __builtin_amdgcn_s_waitcnt(0);
        unsigned nloc = b.st[0], nx = b.st[1];
        if (nloc == 0u) { xcd_barrier_complete(bar, b.x, nloc, nx); b.st[0] = nloc; b.st[1] = nx; }
        const unsigned old = xb_add(&bar[XB_XSUB(b.x)], 1u);
        const unsigned gen = old / nloc;
        if (old + 1u == (gen + 1u) * nloc) {
            __builtin_amdgcn_fence(__ATOMIC_RELEASE, "agent");
            asm volatile("s_waitcnt vmcnt(0)" ::: "memory");
            const unsigned og = xb_add(&bar[XB_TOP], 1u);
            const unsigned tg = og / nx;
            if (og + 1u == (tg + 1u) * nx) xb_add(&bar[XB_TOPGEN], 1u);
            else XB_SPIN(xb_ld(&bar[XB_TOPGEN]) == tg, bar);
            __builtin_amdgcn_fence(__ATOMIC_ACQUIRE, "agent");
            xb_add(&bar[XB_XGEN(b.x)], 1u);
            asm volatile("s_waitcnt vmcnt(0)" ::: "memory");
        } else {
            XB_SPIN(xb_ld(&bar[XB_XGEN(b.x)]) == gen, bar);
            __builtin_amdgcn_fence(__ATOMIC_ACQUIRE, "agent");
            asm volatile("s_waitcnt vmcnt(0)" ::: "memory");
        }
    }
    __syncthreads();
}

__device__ __forceinline__ void group_barrier(unsigned* cnt, unsigned target, unsigned* rel, unsigned* cnt2, unsigned target2, bool one_xcd, bool t0) {
    asm volatile("s_waitcnt vmcnt(0)" ::: "memory");
    __syncthreads();
    if (t0) {
        __builtin_amdgcn_s_waitcnt(0);
        if (!one_xcd) { __builtin_amdgcn_fence(__ATOMIC_RELEASE, "agent"); asm volatile("s_waitcnt vmcnt(0)" ::: "memory"); }
        const unsigned early2 = target2 ? xb_ld(cnt2) : 0u;
        const unsigned old = xb_add(cnt, 1u);
        if (rel && old + 1u == target) {
            __builtin_amdgcn_fence(__ATOMIC_RELEASE, "agent");
            asm volatile("s_waitcnt vmcnt(0)" ::: "memory");
            (void)xb_add(rel, 1u);
        }
        unsigned sp = 0u;
        while (xb_ld(cnt) < target) { __builtin_amdgcn_s_sleep(1); if (++sp > (1u << 22)) break; }
        if (target2 && early2 < target2) while (xb_ld(cnt2) < target2) { __builtin_amdgcn_s_sleep(1); if (++sp > (1u << 22)) break; }
        __builtin_amdgcn_fence(__ATOMIC_ACQUIRE, "agent");
        asm volatile("s_waitcnt vmcnt(0)" ::: "memory");
    }
    __syncthreads();
}
__device__ __forceinline__ void publish_count(unsigned* cnt, bool t0) {
    asm volatile("s_waitcnt vmcnt(0)" ::: "memory");
    __syncthreads();
    if (t0) { __builtin_amdgcn_s_waitcnt(0); __builtin_amdgcn_fence(__ATOMIC_RELEASE, "agent"); asm volatile("s_waitcnt vmcnt(0)" ::: "memory"); (void)xb_add(cnt, 1u); }
}
constexpr int LDS_BYTES = 147456;

typedef const Params __attribute__((address_space(4)))* KParamsPtr;
#if defined(__HIP_DEVICE_COMPILE__)
DI KParamsPtr kparams() { KParamsPtr k = (KParamsPtr)__builtin_amdgcn_kernarg_segment_ptr(); asm volatile("" : "+s"(k)); return k; }
#define PHASE_PARAMS() const Params p = *kparams()
#else
#define PHASE_PARAMS() const Params p = p_arg
#endif
constexpr int CW_BAR = 4096, CW_CMP = 8192, CW_GXCC = 8704, CW_WD = 9216, CW_P4 = 9280, CW_W1 = 9344, CW_GRP = 9408, CW_REL = 13504;

__global__ void __launch_bounds__(512, 2) fwd_megakernel(Params p_arg) {
    extern __shared__ __attribute__((aligned(16))) unsigned char dlds[];
    LAS unsigned char* lds = (LAS unsigned char*)dlds;
    const int G = gridDim.x, c = blockIdx.x, ngw = G * NWAVE, ngt = G * NTHR;
    const int wid0 = __builtin_amdgcn_readfirstlane(threadIdx.x >> 6);
#define TIDS() const int tid = opaque_tid(wid0), lane = tid & 63, wave = tid >> 6, gw = c * NWAVE + wave, gtid = c * NTHR + tid; (void)lane; (void)gw; (void)gtid
    volatile LAS unsigned* MISC = (volatile LAS unsigned*)(lds + 131072 + 320);
    { TIDS(); if (tid < 32) MISC[tid] = 0u; }
    __syncthreads();
    XcdBarrier bar;
    { PHASE_PARAMS(); TIDS(); bar = xcd_barrier_post((unsigned*)(p.ws + WS_CTL) + CW_BAR, MISC + 8, tid == 0); }
    { PHASE_PARAMS(); TIDS(); if (tid == 0) (void)__hip_atomic_fetch_or((unsigned*)(p.ws + WS_CTL) + CW_GXCC + 64 * (c & 7), 1u << xb_xcc_id(), __ATOMIC_RELAXED, __HIP_MEMORY_SCOPE_AGENT); }
#define GRID_SYNC() do { TIDS(); xcd_barrier(bar, tid == 0); } while (0)
#define GROUP_SYNC_X(k, rel, cnt2, target2, fast) do { PHASE_PARAMS(); TIDS(); if (G == 256) { unsigned* ctl_ = (unsigned*)(p.ws + WS_CTL); \
        group_barrier(ctl_ + CW_GRP + 64 * (8 * (k) + (c & 7)), 32u, (rel) ? ctl_ + CW_REL + 64 * (c & 7) : (unsigned*)nullptr, ctl_ + (cnt2), (target2), tid == 0 && (fast) && MISC[12] != 0u, tid == 0); } else xcd_barrier(bar, tid == 0); } while (0)
#define GROUP_SYNC(k, cnt2, target2) GROUP_SYNC_X(k, false, cnt2, target2, true)

    { PHASE_PARAMS();
      { TIDS(); stage_weights<0>(p, gw, ngw, (float*)dlds + wave * (64 * 33), lane); }
      __syncthreads();
      if (G == 256) { if (c < 224) stage_mod(p, c, G, (float*)dlds, wid0); else { TIDS(); stage_rope(p, tid, (c - 224) * NTHR + tid, (G - 224) * NTHR, (float*)dlds + 16384); } }
      else { stage_mod(p, c, G, (float*)dlds, wid0); __syncthreads(); { TIDS(); stage_rope(p, tid, gtid, ngt, (float*)dlds + 16384); } } }
    GRID_SYNC();
    { PHASE_PARAMS(); TIDS(); if (tid == 0) MISC[12] = (__builtin_popcount(xb_ld((unsigned*)(p.ws + WS_CTL) + CW_GXCC + 64 * (c & 7))) == 1) ? 1u : 0u; }
    { PHASE_PARAMS(); TIDS();
      if (G == 256) stage_normmod(p.in[I_X], p.in[I_N1G], wsp<float>(p, WS_MOD), 0, 1, wsp<bf16_t>(p, WS_R0), SEQ * (c & 7) + 64 * (c >> 3) + wave, NWAVE, 64 / NWAVE, lane);
      else stage_normmod(p.in[I_X], p.in[I_N1G], wsp<float>(p, WS_MOD), 0, 1, wsp<bf16_t>(p, WS_R0), gw, ngw, (gw < MT) ? (MT - gw + ngw - 1) / ngw : 0, lane); }
    GROUP_SYNC(4, CW_WD, 0u);
    { PHASE_PARAMS(); EpiZ E{p}; gemm_fast(lds, wsp<bf16_t>(p, WS_R0), 1024, wsp<bf16_t>(p, WS_WIN), MT, ZN, 1024, E, G, c, wid0); }
    { PHASE_PARAMS(); const int nz = (MT / 256) * (ZN / 256), first = nz % G;
      if (c >= first) { { TIDS(); stage_weights<1>(p, (c - first) * NWAVE + wave, (G - first) * NWAVE, (float*)dlds + wave * (64 * 33), lane); }
                        __syncthreads(); stage_shw(p, c - first, G - first, (float*)dlds, wid0);
                        { TIDS(); publish_count((unsigned*)(p.ws + WS_CTL) + CW_W1, tid == 0); } } }
    GROUP_SYNC_X(5, true, CW_REL + 64 * ((c & 7) ^ 1), (((c >> 3) >= 24 && (c >> 3) < 28) ? 1u : 0u), true);
    { PHASE_PARAMS();
      int qb, qc, kb, kc;
      const int v = c;
      int cu0 = (v + 64) % G;
      if (G == 256) { const int x = c & 7, j = c >> 3;
          qb = 24 * x + j; qc = (j < 24) ? 1 : 0; kb = (j < 24) ? 32 * x + j : (j >= 28 ? 32 * x + 24 + 2 * (j - 28) : 0); kc = (j < 24) ? 1 : (j >= 28 ? 2 : 0);
          cu0 = (j >= 24 && j < 28) ? ((((j - 24) & 1) << 4) | ((((j - 24) >> 1) & 1) << 3) | ((x >> 1) << 1) | (x & 1)) : 32; }
      else { const int pq = (192 + G - 1) / G, pk = (256 + G - 1) / G; qb = v * pq; qc = (192 - qb < pq) ? ((192 - qb > 0) ? 192 - qb : 0) : pq; kb = v * pk; kc = (256 - kb < pk) ? ((256 - kb > 0) ? 256 - kb : 0) : pk; }
      { EpiQ E{p}; gemm_fast_range(lds, wsp<bf16_t>(p, WS_R1), 1024, wsp<bf16_t>(p, WS_WQB), MT, 768, 768, E, qb, qc, wid0); }
      for (int cu = cu0; cu < 32; cu += G) cmp_hidden_fast(p, lds, cu, wid0);
      { EpiKV E{p}; gemm_fast_range(lds, wsp<bf16_t>(p, WS_R1) + 768, 1024, wsp<bf16_t>(p, WS_WKVB), MT, 1024, 256, E, kb, kc, wid0); }
    }
    GROUP_SYNC_X(6, false, CW_GRP + 64 * (8 * 6 + ((c & 7) ^ 1)), 32u, !((c >> 3) >= 24 && (c >> 3) < 28));
    { PHASE_PARAMS(); TIDS(); if (G == 256) cmp_out<true>(p, (c >> 3) * NWAVE + wave, 32 * NWAVE, lane, c & 7, (LAS float*)lds, tid); else cmp_out<true>(p, gw, ngw, lane, -1, (LAS float*)lds, tid);
      asm volatile("s_waitcnt vmcnt(0)" ::: "memory"); __syncthreads();
      if (tid == 0) { if (!(G == 256 && MISC[12] != 0u)) { __builtin_amdgcn_fence(__ATOMIC_RELEASE, "agent"); asm volatile("s_waitcnt vmcnt(0)" ::: "memory"); }
          __hip_atomic_fetch_add((unsigned*)(p.ws + WS_CTL) + CW_CMP + ((G == 256) ? 64 * (c & 7) : 0), 1u, __ATOMIC_RELAXED, __HIP_MEMORY_SCOPE_AGENT); } }
    { PHASE_PARAMS(); stage_attn_fast(p, lds, c, G, true, false, wid0); }
    { PHASE_PARAMS(); TIDS();
      if (tid == 0) { unsigned* cnt = (unsigned*)(p.ws + WS_CTL) + CW_CMP + ((G == 256) ? 64 * (c & 7) : 0); unsigned sp = 0;
          while (__hip_atomic_load(cnt, __ATOMIC_RELAXED, __HIP_MEMORY_SCOPE_AGENT) < (unsigned)((G == 256) ? 32 : G)) { __builtin_amdgcn_s_sleep(2); if (++sp > (1u << 22)) break; }
          __builtin_amdgcn_fence(__ATOMIC_ACQUIRE, "agent"); asm volatile("s_waitcnt vmcnt(0)" ::: "memory"); }
      __syncthreads(); }
    { PHASE_PARAMS(); stage_attn_fast(p, lds, c, G, false, true, wid0); }
    { PHASE_PARAMS(); TIDS(); if (tid == 0) (void)xb_add((unsigned*)(p.ws + WS_CTL) + CW_P4, 1u); }
    { const int nz = (MT / 256) * (ZN / 256), first = nz % G; GROUP_SYNC(3, CW_W1, (unsigned)(G - first)); }
    { PHASE_PARAMS(); EpiMerge E{p}; gemm_fast(lds, wsp<bf16_t>(p, WS_R1), 1024, wsp<bf16_t>(p, WS_WO), MT, 1024, 1024, E, G, c, wid0); }
    GROUP_SYNC(0, CW_WD, 0u);
    { PHASE_PARAMS(); EpiOut E{p}; gemm_fast(lds, wsp<bf16_t>(p, WS_R2) + 1024, 2048, wsp<bf16_t>(p, WS_WOUT), MT, 1024, 1024, E, G, c, wid0); }
    GROUP_SYNC(1, CW_P4, (unsigned)G);
    { PHASE_PARAMS(); EpiGU E{p}; gemm_fast(lds, wsp<bf16_t>(p, WS_R1), 1024, wsp<bf16_t>(p, WS_WGU), MT, 5632, 1024, E, G, c, wid0); }
    { PHASE_PARAMS(); const int ng = (MT / 256) * (5632 / 256), first = ng % G;
      if (c >= first) { TIDS(); stage_weights<2>(p, (c - first) * NWAVE + wave, (G - first) * NWAVE, (float*)dlds + wave * (64 * 33), lane);
                        publish_count((unsigned*)(p.ws + WS_CTL) + CW_WD, tid == 0); } }
    { const int ng = (MT / 256) * (5632 / 256), first = ng % G; GROUP_SYNC(2, CW_WD, (unsigned)(G - first)); }
    { PHASE_PARAMS(); EpiDown E{p}; gemm_fast(lds, wsp<bf16_t>(p, WS_HID), DFF, wsp<bf16_t>(p, WS_WD), MT, 1024, DFF, E, G, c, wid0); }
}

extern "C" void kernel_launch(void* const* d_in, const int* in_sizes, int n_in, void* d_out, int out_size, void* d_ws, size_t ws_size, hipStream_t stream) {
    if (n_in != 30 || out_size != MT * DM || ws_size < WS_END) { fprintf(stderr, "kernel_launch: unexpected shapes (n_in %d out %d ws %zu)\n", n_in, out_size, ws_size); return; }
    static int grid = 0;
    if (grid == 0) {
        int dev = 0, cus = 0, per_cu = 0;
        (void)hipGetDevice(&dev); (void)hipDeviceGetAttribute(&cus, hipDeviceAttributeMultiprocessorCount, dev);
        (void)hipFuncSetAttribute((const void*)fwd_megakernel, hipFuncAttributeMaxDynamicSharedMemorySize, LDS_BYTES);
        (void)hipOccupancyMaxActiveBlocksPerMultiprocessor(&per_cu, (const void*)fwd_megakernel, NTHR, LDS_BYTES);
        if (per_cu < 1) fprintf(stderr, "kernel_launch: occupancy query says %d blocks per CU\n", per_cu);
        grid = cus;
        (void)hipGetLastError();
    }
    Params p{};
    for (int i = 0; i < 30; ++i) p.in[i] = (const float*)d_in[i];
    p.out = (float*)d_out; p.ws = (unsigned char*)d_ws;
    (void)hipMemsetAsync((char*)d_ws + WS_CTL, 0, 65536, stream);
    void* args[] = {&p};
    hipError_t e = hipLaunchCooperativeKernel((const void*)fwd_megakernel, dim3(grid), dim3(NTHR), args, LDS_BYTES, stream);
    if (e != hipSuccess) fprintf(stderr, "kernel_launch: cooperative launch failed: %s (grid %d)\n", hipGetErrorString(e), grid);
}
```
